# Optimizing an MI355X kernel written in HIP

```python
import math
import jax
import jax.numpy as jnp
from jax import lax
import numpy as np

D_MODEL = 2048
BATCH = 4
SEQ = 4096
DEPTH = 2

CTX_LEN = 256
GRID_W = 64

D_MIX = D_MODEL
N_GROUPS_MIX = 4
D_GRP = D_MIX // N_GROUPS_MIX
HEAD_DIM = 64
N_HEADS_GRP = D_GRP // HEAD_DIM

SC_WIDTH = 3

RW_DECAY_LORA = 64
RW_ICLR_LORA = 64
RW_GATE_LORA = 128
RW_DECAY_SCALE = 0.6065306597126334
RW_GN_EPS = 64e-5

NA_KH = 8
NA_KW = 16
NA_QCB = 16
NA_KCB = NA_QCB + NA_KW
NA_SCALE = HEAD_DIM ** -0.5
NEG_INF = -1e30

SSD_STATE = 128
SSD_GROUPS = 2
SSD_CONV = 3
SSD_CHUNK = 128
SSD_BC = SSD_GROUPS * SSD_STATE
SSD_XBC = D_GRP + 2 * SSD_BC
DT_MIN = 1e-3
DT_MAX = 1e-1
ROPE_BASE = 10000.0

PEER_HEADS = 8
PEER_KEYS = 128
PEER_EXPERTS = PEER_KEYS * PEER_KEYS
PEER_DKEY = 256
PEER_TOPK = 16
PEER_TOKEN_BLOCK = 128

SC_SIZES = (D_GRP, D_GRP, D_GRP)
RW_SIZES = (D_GRP, D_GRP, D_GRP, RW_DECAY_LORA, RW_ICLR_LORA, RW_GATE_LORA)
NA_SIZES = (D_GRP, D_GRP, D_GRP)
SSD_SIZES = (D_GRP, SSD_XBC, 2 * N_HEADS_GRP)
GROUP_SIZES = (3 * D_GRP, 3 * D_GRP + RW_DECAY_LORA + RW_ICLR_LORA + RW_GATE_LORA, 3 * D_GRP, D_GRP + SSD_XBC + 2 * N_HEADS_GRP)
P_TOTAL = GROUP_SIZES[0] + GROUP_SIZES[1] + GROUP_SIZES[2] + GROUP_SIZES[3]

kernel_name = 'hybrid_dit_conv_rwkv7_natten_ssd_peer'


def _split(u, sizes):
    outs, start = [], 0
    for s in sizes:
        outs.append(u[..., start:start + s])
        start += s
    return outs


def _heads(u):
    return u.reshape(u.shape[:-1] + (N_HEADS_GRP, HEAD_DIM))


def _rmsnorm(x, g, eps=1e-6):
    x32 = x.astype(jnp.float32)
    y = x32 * lax.rsqrt(jnp.mean(x32 * x32, axis=-1, keepdims=True) + eps)
    return (y * g.astype(jnp.float32)).astype(x.dtype)


def _modulate(x, g, shift, scale):
    return _rmsnorm(x, g) * (1.0 + scale[:, None]) + shift[:, None]


def _dwconv(u, w, b=None):
    k = w.shape[0]
    y = lax.conv_general_dilated(u, w[:, None, :].astype(u.dtype), window_strides=(1,), padding=[(k // 2, k // 2)],
                                 dimension_numbers=('NWC', 'WIO', 'NWC'), feature_group_count=u.shape[-1])
    return y if b is None else y + b


def _rope_1d(u, pos):
    d2 = u.shape[-1] // 2
    freqs = jnp.power(ROPE_BASE, -jnp.arange(d2, dtype=jnp.float32) / d2)
    ang = pos.astype(jnp.float32)[:, None] * freqs
    cos, sin = jnp.cos(ang)[None, :, None, :], jnp.sin(ang)[None, :, None, :]
    u1, u2 = u[..., :d2], u[..., d2:]
    return jnp.concatenate([u1 * cos - u2 * sin, u1 * sin + u2 * cos], axis=-1)


def _rope_2d(u, rows, cols):
    half = u.shape[-1] // 2
    return jnp.concatenate([_rope_1d(u[..., :half], rows), _rope_1d(u[..., half:], cols)], axis=-1)


def short_conv_mixer(p_lat, p_ctx, conv_w, ctx_out):
    def one(p):
        bg, cg, h = _split(p, SC_SIZES)
        return bg * _dwconv(cg * h, conv_w)
    return one(p_lat), (one(p_ctx) if ctx_out else None)


def _rwkv_scan(state0, w, k, v, kk, a, r, reverse):
    seq = [jnp.moveaxis(t, 1, 0) for t in (w, k, v, kk, a)]
    if r is not None:
        seq.append(jnp.moveaxis(r, 1, 0))

    def step(s, inp):
        w_t, k_t, v_t, kk_t, a_t = inp[:5]
        sa = jnp.einsum('bhvk,bhk->bhv', s, -kk_t)
        s = (s * w_t[:, :, None, :] + sa[..., None] * (kk_t * a_t)[:, :, None, :]
             + v_t[..., None] * k_t[:, :, None, :])
        out = jnp.einsum('bhvk,bhk->bhv', s, inp[5]) if len(inp) == 6 else None
        return s, out

    s, ys = lax.scan(step, state0, tuple(seq), reverse=reverse)
    return s, (None if r is None else jnp.moveaxis(ys, 0, 1))


def rwkv7_mixer(p_lat, p_ctx, w0, w_up, a0, a_up, g_up, k_k, k_a, r_k, ln_w, ln_b, ctx_out):
    f32 = jnp.float32

    def prep(p):
        r, k, v, wd, ad, gd = [t.astype(f32) for t in _split(p, RW_SIZES)]
        kk = _heads(k * k_k)
        kk = kk * lax.rsqrt(jnp.sum(kk * kk, axis=-1, keepdims=True) + 1e-12)
        return r, k, v, jnp.tanh(wd), ad, gd, kk

    def direction(pp, d):
        r, k, v, twd, ad, gd, kk = pp
        w = jnp.exp(-RW_DECAY_SCALE * jax.nn.sigmoid(w0[d] + twd @ w_up[d]))
        a = jax.nn.sigmoid(a0[d] + ad @ a_up[d])
        kd = k * (1.0 + (a - 1.0) * k_a)
        return _heads(w), _heads(kd), _heads(a)

    def finish(pp, y, bonus):
        gd = pp[5]
        mu = jnp.mean(y, axis=-1, keepdims=True)
        var = jnp.mean(jnp.square(y - mu), axis=-1, keepdims=True)
        y = (y - mu) * lax.rsqrt(var + RW_GN_EPS) * _heads(ln_w) + _heads(ln_b)
        y = (y + bonus).reshape(y.shape[:-2] + (D_GRP,))
        return (y * (jax.nn.sigmoid(gd) @ g_up)).astype(p_lat.dtype)

    lat, cx = prep(p_lat), prep(p_ctx)
    s0 = jnp.zeros((p_lat.shape[0], N_HEADS_GRP, HEAD_DIM, HEAD_DIM), f32)
    rk = _heads(r_k)
    y_lat = b_lat = y_ctx = b_ctx = 0.0
    for d, rev in ((0, False), (1, True)):
        wc, kc, ac = direction(cx, d)
        s_ctx, yc = _rwkv_scan(s0, wc, kc, _heads(cx[2]), cx[6], ac, _heads(cx[0]) if ctx_out else None, rev)
        wl, kl, al = direction(lat, d)
        _, yl = _rwkv_scan(s_ctx, wl, kl, _heads(lat[2]), lat[6], al, _heads(lat[0]), rev)
        y_lat = y_lat + yl
        b_lat = b_lat + jnp.sum(_heads(lat[0]) * kl * rk, axis=-1, keepdims=True) * _heads(lat[2])
        if ctx_out:
            y_ctx = y_ctx + yc
            b_ctx = b_ctx + jnp.sum(_heads(cx[0]) * kc * rk, axis=-1, keepdims=True) * _heads(cx[2])
    return finish(lat, y_lat, b_lat), (finish(cx, y_ctx, b_ctx) if ctx_out else None)


def _na_layout(rows, kh, rpb):
    r = np.arange(rows)
    row0 = np.clip(r - kh // 2, 0, rows - kh)
    key_rows = row0[:, None] + np.arange(kh)
    ncb = GRID_W // NA_QCB
    j = np.arange(ncb)
    col0 = np.clip(j * NA_QCB - NA_KW // 2, 0, GRID_W - NA_KCB)
    key_cols = col0[:, None] + np.arange(NA_KCB)
    q_cols = j[:, None] * NA_QCB + np.arange(NA_QCB)
    win0 = np.clip(q_cols - NA_KW // 2, 0, GRID_W - NA_KW)
    valid = (key_cols[:, None, :] >= win0[..., None]) & (key_cols[:, None, :] < win0[..., None] + NA_KW)
    idx = (key_rows[:, None, :, None] * GRID_W + key_cols[None, :, None, :]).reshape(rows, ncb, kh * NA_KCB)
    dr = key_rows - r[:, None] + NA_KH - 1
    dc = np.clip(key_cols[:, None, :] - q_cols[..., None], 1 - NA_KW, NA_KW - 1) + NA_KW - 1
    bias = rpb[:, dr[:, None, None, :, None], dc[None, :, :, None, :]].astype(jnp.float32)
    bias = jnp.where(valid[None, None, :, :, None, :], bias, NEG_INF)
    return idx, bias.reshape(rpb.shape[0], rows, ncb, NA_QCB, kh * NA_KCB)


def na_mixer(p_lat, p_ctx, q_norm, k_norm, rpb, ctx_out):
    f32 = jnp.float32
    b, seq = p_lat.shape[:2]
    rows = seq // GRID_W
    kh = min(NA_KH, rows)
    ncb = GRID_W // NA_QCB
    q, k, v = [_heads(t) for t in _split(p_lat, NA_SIZES)]
    qc, kc, vc = [_heads(t) for t in _split(p_ctx, NA_SIZES)]
    q, k, kc = _rmsnorm(q, q_norm), _rmsnorm(k, k_norm), _rmsnorm(kc, k_norm)
    idx, bias = _na_layout(rows, kh, rpb)
    qb = q.reshape(b, rows, ncb, NA_QCB, N_HEADS_GRP, HEAD_DIM)
    kg, vg = k[:, idx], v[:, idx]
    s_nb = jnp.einsum('brjqhd,brjkhd->bhrjqk', qb, kg).astype(f32) * NA_SCALE + bias
    s_cx = jnp.einsum('brjqhd,bchd->bhrjqc', qb, kc).astype(f32) * NA_SCALE
    p = jax.nn.softmax(jnp.concatenate([s_nb, s_cx], axis=-1), axis=-1).astype(v.dtype)
    nk = kh * NA_KCB
    o = (jnp.einsum('bhrjqk,brjkhd->brjqhd', p[..., :nk], vg)
         + jnp.einsum('bhrjqc,bchd->brjqhd', p[..., nk:], vc))
    out_ctx = None
    if ctx_out:
        qc = _rmsnorm(qc, q_norm)
        sc = jnp.einsum('bqhd,bkhd->bhqk', qc, kc).astype(f32) * NA_SCALE
        pc = jax.nn.softmax(sc, axis=-1).astype(vc.dtype)
        out_ctx = jnp.einsum('bhqk,bkhd->bqhd', pc, vc).reshape(b, -1, D_GRP)
    return o.reshape(b, seq, D_GRP), out_ctx


def _segsum(a):
    t = a.shape[-1]
    rep = jnp.broadcast_to(a[..., None], a.shape + (t,))
    rep = jnp.where(np.tril(np.ones((t, t), bool), -1), rep, 0.0)
    seg = jnp.cumsum(rep, axis=-2)
    return jnp.where(np.tril(np.ones((t, t), bool)), seg, -jnp.inf)


def _ssd_chunked(x, dt, a, bm, cm, s0, with_y):
    b, seq, h, p = x.shape
    n = bm.shape[-1]
    nc, cl = seq // SSD_CHUNK, SSD_CHUNK
    xc = (x * dt[..., None]).reshape(b, nc, cl, h, p)
    bc = bm.reshape(b, nc, cl, h, n)
    cc = cm.reshape(b, nc, cl, h, n)
    da = jnp.moveaxis((dt * a).reshape(b, nc, cl, h), -1, 1)
    da_cum = jnp.cumsum(da, axis=-1)
    decay_to_end = jnp.exp(da_cum[..., -1:] - da_cum)
    chunk_states = jnp.einsum('bclhn,bhcl,bclhp->bchpn', bc, decay_to_end, xc)
    states = jnp.concatenate([s0[:, None], chunk_states], axis=1)
    chunk_decay = jnp.exp(_segsum(jnp.pad(da_cum[..., -1], ((0, 0), (0, 0), (1, 0)))))
    states = jnp.einsum('bhzc,bchpn->bzhpn', chunk_decay, states)
    final = states[:, -1]
    if not with_y:
        return final, None
    intra = jnp.exp(_segsum(da))
    y = jnp.einsum('bclhn,bcshn,bhcls,bcshp->bclhp', cc, bc, intra, xc)
    y = y + jnp.einsum('bclhn,bchpn,bhcl->bclhp', cc, states[:, :-1], jnp.exp(da_cum))
    return final, y.reshape(b, seq, h, p)


def _ssd_direction(pp, s0, d, dt_bias, a_log, with_y):
    z, xh, bm, cm, dt = pp
    a = -jnp.exp(a_log[d].astype(jnp.float32))
    dtd = jax.nn.softplus(dt[..., d, :] + dt_bias[d])
    seqs = (xh, dtd, bm, cm)
    if d == 1:
        seqs = tuple(jnp.flip(t, axis=1) for t in seqs)
    s, y = _ssd_chunked(seqs[0], seqs[1], a, seqs[2], seqs[3], s0, with_y)
    if d == 1 and y is not None:
        y = jnp.flip(y, axis=1)
    return s, y


def ssd_mixer(p_lat, p_ctx, conv_w, conv_b, dt_bias, a_log, d_skip, norm_g, ctx_out):
    f32 = jnp.float32
    b, seq = p_lat.shape[:2]
    t = jnp.arange(seq)
    rows, cols = t // GRID_W, t % GRID_W

    def prep(p, rope):
        z, xbc, dt = _split(p, SSD_SIZES)
        xbc = jax.nn.silu(_dwconv(xbc, conv_w, conv_b)).astype(f32)
        xs, bm, cm = _split(xbc, (D_GRP, SSD_BC, SSD_BC))
        bm = bm.reshape(bm.shape[:-1] + (SSD_GROUPS, SSD_STATE))
        cm = cm.reshape(cm.shape[:-1] + (SSD_GROUPS, SSD_STATE))
        if rope:
            bm, cm = _rope_2d(bm, rows, cols), _rope_2d(cm, rows, cols)
        rep = N_HEADS_GRP // SSD_GROUPS
        bm, cm = jnp.repeat(bm, rep, axis=2), jnp.repeat(cm, rep, axis=2)
        dt = dt.astype(f32).reshape(dt.shape[:-1] + (2, N_HEADS_GRP))
        return z, _heads(xs), bm, cm, dt

    def finish(pp, y):
        z, xh = pp[0], pp[1]
        y = (y + d_skip[:, None] * xh).reshape(xh.shape[:2] + (D_GRP,))
        return _rmsnorm(y * jax.nn.silu(z.astype(f32)), norm_g).astype(p_lat.dtype)

    lat, cx = prep(p_lat, True), prep(p_ctx, False)
    s0 = jnp.zeros((b, N_HEADS_GRP, HEAD_DIM, SSD_STATE), f32)
    y_lat = y_ctx = 0.0
    for d in (0, 1):
        s_ctx, yc = _ssd_direction(cx, s0, d, dt_bias, a_log, ctx_out)
        _, yl = _ssd_direction(lat, s_ctx, d, dt_bias, a_log, True)
        y_lat = y_lat + yl
        if ctx_out:
            y_ctx = y_ctx + yc
    return finish(lat, y_lat), (finish(cx, y_ctx) if ctx_out else None)


def peer_ffn(h, wq, sub_keys, exp_u, exp_v):
    n_tok, d = h.shape
    q = (h @ wq).reshape(n_tok, PEER_HEADS, 2, PEER_DKEY // 2)
    s = jnp.einsum('thpd,hpkd->thpk', q, sub_keys).astype(jnp.float32)
    sv, si = lax.top_k(s, PEER_TOPK)
    cand = (sv[:, :, 0, :, None] + sv[:, :, 1, None, :]).reshape(n_tok, PEER_HEADS, PEER_TOPK * PEER_TOPK)
    cv, ci = lax.top_k(cand, PEER_TOPK)
    i0 = jnp.take_along_axis(si[:, :, 0], ci // PEER_TOPK, axis=-1)
    i1 = jnp.take_along_axis(si[:, :, 1], ci % PEER_TOPK, axis=-1)
    ids = (i0 * PEER_KEYS + i1).reshape(n_tok, PEER_HEADS * PEER_TOPK)
    gates = jax.nn.softmax(cv, axis=-1).reshape(n_tok, PEER_HEADS * PEER_TOPK).astype(h.dtype)
    nb = n_tok // PEER_TOKEN_BLOCK

    def block(args):
        hb, ib, gb = args
        act = jax.nn.gelu(jnp.einsum('tkd,td->tk', exp_u[ib], hb))
        return jnp.einsum('tk,tkd->td', gb * act, exp_v[ib])

    out = lax.map(block, (h.reshape(nb, PEER_TOKEN_BLOCK, d),
                          ids.reshape(nb, PEER_TOKEN_BLOCK, -1),
                          gates.reshape(nb, PEER_TOKEN_BLOCK, -1)))
    return out.reshape(n_tok, d)


def setup_inputs(seed: int = 0) -> dict:
    keys = iter(jax.random.split(jax.random.key(seed), 40))

    def normal(shape, std):
        return std * jax.random.normal(next(keys), shape, jnp.float32)

    def near_one(shape, std=0.02):
        return 1.0 + normal(shape, std)

    dl, d = DEPTH, D_MODEL
    dt0 = jnp.exp(jax.random.uniform(next(keys), (dl, 2, N_HEADS_GRP), jnp.float32, math.log(DT_MIN), math.log(DT_MAX)))
    a_init = jax.random.uniform(next(keys), (dl, 2, N_HEADS_GRP), jnp.float32, 1.0, 16.0)
    return {
        'x': normal((BATCH, SEQ, d), 1.0),
        'c': normal((BATCH, d), 1.0),
        'ctx': normal((BATCH, CTX_LEN, d), 1.0),
        'c_ctx': normal((d,), 1.0),
        'w_ada': normal((dl, d, 6 * d), 0.5 * d ** -0.5),
        'b_ada': normal((dl, 6 * d), 0.02),
        'norm_mix': near_one((dl, d)),
        'norm_ffn': near_one((dl, d)),
        'w_in': normal((dl, d, P_TOTAL), d ** -0.5),
        'w_out': normal((dl, D_MIX, d), D_MIX ** -0.5),
        'sc_conv_w': normal((dl, SC_WIDTH, D_GRP), SC_WIDTH ** -0.5),
        'rw_w0': normal((dl, 2, D_GRP), 0.5),
        'rw_w_up': normal((dl, 2, RW_DECAY_LORA, D_GRP), RW_DECAY_LORA ** -0.5),
        'rw_a0': normal((dl, 2, D_GRP), 0.5),
        'rw_a_up': normal((dl, 2, RW_ICLR_LORA, D_GRP), RW_ICLR_LORA ** -0.5),
        'rw_g_up': normal((dl, RW_GATE_LORA, D_GRP), RW_GATE_LORA ** -0.5),
        'rw_k_k': near_one((dl, D_GRP), 0.1),
        'rw_k_a': near_one((dl, D_GRP), 0.1),
        'rw_r_k': normal((dl, D_GRP), 0.1),
        'rw_ln_w': near_one((dl, D_GRP)),
        'rw_ln_b': normal((dl, D_GRP), 0.02),
        'na_q_norm': near_one((dl, HEAD_DIM)),
        'na_k_norm': near_one((dl, HEAD_DIM)),
        'na_rpb': normal((dl, N_HEADS_GRP, 2 * NA_KH - 1, 2 * NA_KW - 1), 0.02),
        'ssd_conv_w': normal((dl, SSD_CONV, SSD_XBC), SSD_CONV ** -0.5),
        'ssd_conv_b': normal((dl, SSD_XBC), 0.02),
        'ssd_dt_bias': dt0 + jnp.log(-jnp.expm1(-dt0)),
        'ssd_a_log': jnp.log(a_init),
        'ssd_d': near_one((dl, N_HEADS_GRP), 0.1),
        'ssd_norm': near_one((dl, D_GRP)),
        'peer_wq': normal((dl, d, PEER_HEADS * PEER_DKEY), d ** -0.5),
        'peer_keys': normal((dl, PEER_HEADS, 2, PEER_KEYS, PEER_DKEY // 2), (PEER_DKEY // 2) ** -0.5),
        'peer_u': normal((dl, PEER_EXPERTS, d), d ** -0.5),
        'peer_v': normal((dl, PEER_EXPERTS, d), 1.0),
    }


def reference(x, c, ctx, c_ctx, w_ada, b_ada, norm_mix, norm_ffn, w_in, w_out, sc_conv_w,
              rw_w0, rw_w_up, rw_a0, rw_a_up, rw_g_up, rw_k_k, rw_k_a, rw_r_k, rw_ln_w, rw_ln_b,
              na_q_norm, na_k_norm, na_rpb,
              ssd_conv_w, ssd_conv_b, ssd_dt_bias, ssd_a_log, ssd_d, ssd_norm,
              peer_wq, peer_keys, peer_u, peer_v):
    b, seq, d = x.shape
    c_act = jax.nn.silu(c)
    cc_act = jax.nn.silu(c_ctx)[None]
    for l in range(DEPTH):
        ctx_out = l < DEPTH - 1
        m = jnp.split(c_act @ w_ada[l] + b_ada[l], 6, axis=-1)
        mc = jnp.split(cc_act @ w_ada[l] + b_ada[l], 6, axis=-1)
        p_lat = _split(_modulate(x, norm_mix[l], m[0], m[1]) @ w_in[l], GROUP_SIZES)
        p_ctx = _split(_modulate(ctx, norm_mix[l], mc[0], mc[1]) @ w_in[l], GROUP_SIZES)
        mixed = (
            short_conv_mixer(p_lat[0], p_ctx[0], sc_conv_w[l], ctx_out),
            rwkv7_mixer(p_lat[1], p_ctx[1], rw_w0[l], rw_w_up[l], rw_a0[l], rw_a_up[l], rw_g_up[l],
                        rw_k_k[l], rw_k_a[l], rw_r_k[l], rw_ln_w[l], rw_ln_b[l], ctx_out),
            na_mixer(p_lat[2], p_ctx[2], na_q_norm[l], na_k_norm[l], na_rpb[l], ctx_out),
            ssd_mixer(p_lat[3], p_ctx[3], ssd_conv_w[l], ssd_conv_b[l], ssd_dt_bias[l], ssd_a_log[l],
                      ssd_d[l], ssd_norm[l], ctx_out),
        )
        x = x + m[2][:, None] * (jnp.concatenate([o[0] for o in mixed], axis=-1) @ w_out[l])
        t_lat = _modulate(x, norm_ffn[l], m[3], m[4]).reshape(b * seq, d)
        if ctx_out:
            ctx = ctx + mc[2][:, None] * (jnp.concatenate([o[1] for o in mixed], axis=-1) @ w_out[l])
            t_ctx = _modulate(ctx, norm_ffn[l], mc[3], mc[4]).reshape(-1, d)
            f = peer_ffn(jnp.concatenate([t_lat, t_ctx], axis=0), peer_wq[l], peer_keys[l], peer_u[l], peer_v[l])
            ctx = ctx + mc[5][:, None] * f[b * seq:].reshape(ctx.shape)
            f = f[:b * seq]
        else:
            f = peer_ffn(t_lat, peer_wq[l], peer_keys[l], peer_u[l], peer_v[l])
        x = x + m[5][:, None] * f.reshape(b, seq, d)
    return x
```

```cpp
#include <hip/hip_runtime.h>
#include <cstdio>
#include <cstdint>
#ifndef RPT
#define RPT 0
#endif

constexpr int DM = 2048, NBATCH = 4, SEQL = 4096, CTXL = 256, NLAT = NBATCH * SEQL, NCTX = NBATCH * CTXL, NTOK = NLAT + NCTX;
constexpr int PT = 6416, PTP = 6656;
constexpr int A_BG = 0, A_CG = 512, A_H = 1024;
constexpr int B_R = 1536, B_K = 2048, B_V = 2560, B_WD = 3072, B_AD = 3136, B_GD = 3200;
constexpr int C_Q = 3328, C_K = 3840, C_V = 4352;
constexpr int D_Z = 4864, D_X = 5376, D_DT = 6400;
constexpr int NPOS = CTXL + SEQL;
constexpr int NCH = 34;
constexpr int KSPL = 32;

enum { I_X = 0, I_C, I_CTX, I_CCTX, I_WADA, I_BADA, I_NMIX, I_NFFN, I_WIN, I_WOUT, I_SCW, I_RW0, I_RWUP, I_RA0, I_RAUP, I_RGUP, I_RKK, I_RKA, I_RRK, I_RLNW, I_RLNB,
       I_NAQ, I_NAK, I_RPB, I_SCONVW, I_SCONVB, I_SDTB, I_SALOG, I_SD, I_SNORM, I_PWQ, I_PKEYS, I_PU, I_PV, N_IN };

constexpr size_t WS_CTL   = 0;
constexpr size_t WS_ROPE  = 65536;
constexpr size_t WS_MODP  = WS_ROPE + 16384;
constexpr size_t WS_MOD   = WS_MODP + (size_t)KSPL * 2 * 5 * 12288 * 4;
constexpr size_t WS_WIN   = WS_MOD + (size_t)2 * 5 * 12288 * 4;
constexpr size_t WS_WOUT  = WS_WIN + (size_t)2 * PTP * DM * 2;
constexpr size_t WS_WQ    = WS_WOUT + (size_t)2 * DM * DM * 2;
constexpr size_t WS_KEYS  = WS_WQ + (size_t)2 * DM * DM * 2;
constexpr size_t WS_WUPT  = WS_KEYS + (size_t)2 * 8 * 2 * 128 * 128 * 2;
constexpr size_t WS_GUPT  = WS_WUPT + (size_t)2 * 4 * 512 * 64 * 2;
constexpr size_t WS_PU    = WS_GUPT + (size_t)2 * 512 * 128 * 2;
constexpr size_t WS_PV    = WS_PU + (size_t)2 * 16384 * DM;
constexpr size_t WS_P     = WS_PV + (size_t)2 * 16384 * DM;
constexpr size_t WS_MIX   = WS_P + (size_t)NTOK * PTP * 2;
constexpr size_t WS_CTXS  = WS_MIX + (size_t)NTOK * DM * 2;
constexpr size_t WS_XN    = WS_CTXS + (size_t)NCTX * DM * 4;
constexpr size_t WS_IDS   = WS_XN + (size_t)NTOK * DM * 2;
constexpr size_t WS_GATES = WS_IDS + (size_t)NTOK * 128 * 4;
constexpr size_t WS_PART  = WS_GATES + (size_t)NTOK * 128 * 4;
constexpr size_t WS_RWF   = WS_XN;
constexpr size_t WS_RWY   = WS_RWF + (size_t)64 * 272 * 10496;
constexpr size_t WS_BON   = WS_RWY + (size_t)2 * NTOK * 512 * 2;
constexpr size_t WS_XBC   = WS_BON + (size_t)2 * NTOK * 8 * 4;
constexpr size_t WS_DTS   = WS_XBC + (size_t)NTOK * 1024 * 2;
constexpr size_t WS_DEC   = WS_DTS + (size_t)NTOK * 16 * 4;
constexpr size_t WS_SST   = WS_DEC + (size_t)NTOK * 16 * 4;
constexpr size_t WS_SCD   = WS_SST + (size_t)64 * NCH * 8192 * 4;
constexpr size_t WS_YS    = WS_SCD + 16384;
constexpr size_t WS_QN    = WS_YS + (size_t)NTOK * 512 * 4;
constexpr size_t WS_KN    = WS_QN + (size_t)NTOK * 512 * 2;
constexpr size_t WS_VTL   = WS_KN + (size_t)NTOK * 512 * 2;
constexpr size_t WS_VTC   = WS_VTL + (size_t)4 * 8 * 64 * 64 * 96 * 2;
constexpr size_t WS_END   = WS_VTC + (size_t)4 * 8 * 64 * 256 * 2;
static_assert(WS_END < (size_t)1020 * 1024 * 1024, "workspace");
static_assert(WS_GATES + (size_t)NTOK * 128 * 4 <= WS_PART && WS_PART + (size_t)16 * NTOK * 128 * 4 <= WS_END, "alias");

constexpr int LDS_BYTES = 147456;
constexpr int LDS_BAR_OFF = LDS_BYTES - 16;
constexpr int LDS_XI_OFF = LDS_BYTES - 48;
constexpr int CTL_TICKET = 8192;

#define LAS __attribute__((address_space(3)))
typedef unsigned short bf16_t;
typedef _Float16 f16_t;
typedef short bf16x8 __attribute__((ext_vector_type(8)));
typedef float f32x4 __attribute__((ext_vector_type(4)));
typedef unsigned u32x4 __attribute__((ext_vector_type(4)));
typedef unsigned u32x2 __attribute__((ext_vector_type(2)));

__device__ __forceinline__ float bf2f(bf16_t h) { return __uint_as_float(((unsigned)h) << 16); }
__device__ __forceinline__ float bflo(unsigned u) { return __uint_as_float(u << 16); }
__device__ __forceinline__ float bfhi(unsigned u) { return __uint_as_float(u & 0xffff0000u); }
__device__ __forceinline__ bf16_t f2bf(float f) { unsigned u = __float_as_uint(f); u += 0x7FFFu + ((u >> 16) & 1u); return (bf16_t)(u >> 16); }
typedef float f32x2_t __attribute__((ext_vector_type(2)));
typedef __bf16 bf16x2_t __attribute__((ext_vector_type(2)));
__device__ __forceinline__ unsigned pk_bf16(float lo, float hi) { const f32x2_t v = {lo, hi}; const bf16x2_t r = __builtin_convertvector(v, bf16x2_t); return __builtin_bit_cast(unsigned, r); }
__device__ __forceinline__ bf16x8 pack8(const f32x4 a, const f32x4 b) { union { bf16x8 v; unsigned u[4]; } r; r.u[0] = pk_bf16(a[0], a[1]); r.u[1] = pk_bf16(a[2], a[3]); r.u[2] = pk_bf16(b[0], b[1]); r.u[3] = pk_bf16(b[2], b[3]); return r.v; }
template <int CTRL> __device__ __forceinline__ float dpp_f(float v) { return __int_as_float(__builtin_amdgcn_update_dpp(0, __float_as_int(v), CTRL, 0xF, 0xF, true)); }
__device__ __forceinline__ float sum4(float x)  { x += dpp_f<0xB1>(x); x += dpp_f<0x4E>(x); return x; }
__device__ __forceinline__ float sum8(float x)  { x = sum4(x); x += dpp_f<0x141>(x); return x; }
__device__ __forceinline__ float sum16(float x) { x = sum8(x); x += dpp_f<0x140>(x); return x; }
__device__ __forceinline__ float xor16_f(float x) { return __int_as_float(__builtin_amdgcn_ds_swizzle(__float_as_int(x), 0x401F)); }
__device__ __forceinline__ float sum_x32(float x) { const auto r = __builtin_amdgcn_permlane32_swap(__float_as_uint(x), __float_as_uint(x), false, false); return __uint_as_float(r[0]) + __uint_as_float(r[1]); }
__device__ __forceinline__ float max_x32(float x) { const auto r = __builtin_amdgcn_permlane32_swap(__float_as_uint(x), __float_as_uint(x), false, false); return fmaxf(__uint_as_float(r[0]), __uint_as_float(r[1])); }
__device__ __forceinline__ float wave_sum(float x) { x = sum16(x); x += xor16_f(x); return sum_x32(x); }
__device__ __forceinline__ float max16(float x) { x = fmaxf(x, dpp_f<0xB1>(x)); x = fmaxf(x, dpp_f<0x4E>(x)); x = fmaxf(x, dpp_f<0x141>(x)); x = fmaxf(x, dpp_f<0x140>(x)); return x; }
__device__ __forceinline__ float wave_max(float x) { x = max16(x); x = fmaxf(x, xor16_f(x)); return max_x32(x); }
__device__ __forceinline__ float rcpf_(float x) { return __builtin_amdgcn_rcpf(x); }
__device__ __forceinline__ float sigmoidf_(float x) { return rcpf_(1.0f + __expf(-x)); }
__device__ __forceinline__ float siluf_(float x) { return x * rcpf_(1.0f + __expf(-x)); }
__device__ __forceinline__ float tanhf_(float x) { const float e = __expf(2.0f * x); return 1.0f - 2.0f * rcpf_(e + 1.0f); }
__device__ __forceinline__ float geluf_(float x) { return 0.5f * x * (1.0f + tanhf_(0.7978845608028654f * (x + 0.044715f * x * x * x))); }

namespace pg8 {
#define PG8_LAS __attribute__((address_space(3)))
typedef unsigned short bf16_t;
typedef short bf16x8 __attribute__((ext_vector_type(8)));
typedef float f32x4 __attribute__((ext_vector_type(4)));
typedef unsigned u32x4 __attribute__((ext_vector_type(4)));
constexpr int BM = 256, BK = 64, HALF = 128, HTB = HALF * BK * 2  , STAGE_BYTES = 8 * HTB, NXCD = 8, WGM = 8;

__host__ __device__ __forceinline__ int lds_byte(int r, int c) { const int st = (r >> 4) * 2 + (c >> 5), rr = r & 15, cc = c & 31, ob = rr * 64 + cc * 2; return st * 1024 + (ob ^ (((ob >> 9) & 1) << 5)); }
__host__ __device__ __forceinline__ void stage_rc(int b, int& R, int& C) { const int st = b / 1024, sb = b % 1024, swz = sb ^ (((sb >> 9) & 1) << 5); R = (st >> 1) * 16 + swz / 64; C = (st & 1) * 32 + (swz % 64) / 2; }
__host__ __device__ __forceinline__ int perm32(int rho) { const int n = rho >> 4, i = rho & 15; return 8 * (i >> 2) + 4 * n + (i & 3); }

struct Unit { int pm, pn; };
struct Gemm { const bf16_t* A; const bf16_t* Bt; int M, N, K; };

struct StaticOrder {
    int nM, nN, nwg, G, c;
    __host__ __device__ void init(int M, int N, int G_, int c_) { nM = M / BM; nN = N / BM; nwg = nM * nN; G = G_; c = c_; }
    __host__ __device__ bool next(int i, Unit& u) const {
        const long L = (long)i * G + c; if (L >= nwg) return false;
        int wgid = (int)L; { const int q = nwg / NXCD, r = nwg % NXCD, xcd = wgid % NXCD, off = wgid / NXCD; wgid = (xcd < r ? xcd * (q + 1) : r * (q + 1) + (xcd - r) * q) + off; }
        const int nig = WGM * nN, gid = wgid / nig, fm = gid * WGM, gsz = (nM - fm) < WGM ? (nM - fm) : WGM;
        u.pm = fm + ((wgid % nig) % gsz); u.pn = (wgid % nig) / gsz; return true;
    }
    __device__ __forceinline__ void a_ready(const Unit&) const {}
    __device__ __forceinline__ void done(const Unit&) const {}
};

__device__ __forceinline__ unsigned cvt_pk_bf16(float lo, float hi) { return ::pk_bf16(lo, hi); }
struct EpiBf16 {
    static constexpr bool PERM = true, AFTER_DRAIN = false;
    bf16_t* O; int ldc;
    __device__ __forceinline__ void operator()(const f32x4 (&acc)[2][2][4][2], const Unit& u, int wr, int wc, int fr, int fq) const {
        const int row0 = u.pm * BM + wr * 64 + fr; const int col0 = u.pn * BM + wc * 32 + 8 * fq;
#pragma unroll
        for (int ai = 0; ai < 2; ++ai)
#pragma unroll
            for (int m = 0; m < 4; ++m) { bf16_t* rowp = O + (size_t)(row0 + ai * HALF + m * 16) * ldc + col0;
#pragma unroll
                for (int bj = 0; bj < 2; ++bj) { const f32x4 v0 = acc[ai][bj][m][0], v1 = acc[ai][bj][m][1];
                    u32x4 w; w.x = cvt_pk_bf16(v0[0], v0[1]); w.y = cvt_pk_bf16(v0[2], v0[3]); w.z = cvt_pk_bf16(v1[0], v1[1]); w.w = cvt_pk_bf16(v1[2], v1[3]);
                    *(u32x4*)(rowp + bj * HALF) = w; } }
    }
};
struct EpiResid {
    static constexpr bool PERM = false, AFTER_DRAIN = false;
    const float* xi_lat; const float* xi_ctx; float* xo_lat; float* xo_ctx; const float* gate;
    __device__ __forceinline__ void operator()(const f32x4 (&acc)[2][2][4][2], const Unit& u, int wr, int wc, int fr, int fq) const {
        const bool isctx = u.pm >= 64; const int v = isctx ? 4 : (u.pm >> 4);
        const int row0 = (isctx ? (u.pm - 64) : u.pm) * BM + wr * 64 + fr, col0 = u.pn * BM + wc * 32 + 4 * fq;
        const float* xi = isctx ? xi_ctx : xi_lat; float* xo = isctx ? xo_ctx : xo_lat;
        const float* gp = gate + (size_t)v * 12288 + col0;
        f32x4 gv[2][2];
#pragma unroll
        for (int bj = 0; bj < 2; ++bj)
#pragma unroll
            for (int n = 0; n < 2; ++n) gv[bj][n] = *(const f32x4*)(gp + bj * HALF + n * 16);
#pragma unroll
        for (int ai = 0; ai < 2; ++ai)
#pragma unroll
            for (int m = 0; m < 4; ++m) { const size_t off = (size_t)(row0 + ai * HALF + m * 16) * 2048 + col0;
#pragma unroll
                for (int bj = 0; bj < 2; ++bj)
#pragma unroll
                    for (int n = 0; n < 2; ++n) { const f32x4 xv = *(const f32x4*)(xi + off + bj * HALF + n * 16);
                        *(f32x4*)(xo + off + bj * HALF + n * 16) = xv + gv[bj][n] * acc[ai][bj][m][n]; }
                asm volatile("" ::: "memory"); }
    }
};

template <class Epi, class Sched>
__device__ __forceinline__ void gemm_phase(PG8_LAS unsigned char* lds, const Gemm g, const Sched& S, const Epi& E, const int tid) {
    const int wid = __builtin_amdgcn_readfirstlane(tid >> 6), lane = tid & 63, wr = wid >> 2, wc = wid & 3, fr = lane & 15, fq = lane >> 4;
    const int K = g.K, nt = K / BK;
    unsigned voffA[2], voffB[2];
#pragma unroll
    for (int i = 0; i < 2; ++i) { int R, C; stage_rc(tid * 16 + i * 8192, R, C); const int Rb = Epi::PERM ? ((R & ~31) + perm32(R & 31)) : R;
        voffA[i] = (unsigned)(R * K + C) * 2u; voffB[i] = (unsigned)(Rb * K + C) * 2u; }
    const size_t kstep = (size_t)(BK * 2);
    const size_t hstep = (size_t)HALF * K * 2;
    const size_t tstep = 2 * hstep;
    const unsigned ldsw = (unsigned)wid * 1024u;
    const int aoff = lds_byte(wr * 64 + fr, fq * 8), boff = lds_byte(wc * 32 + fr, fq * 8);
#define PG8_SA(b, h) (((b) * 2 + (h)) * HTB)
#define PG8_SB(b, h) ((4 + (b) * 2 + (h)) * HTB)
#define PG8_STAGE(bufoff, gbase, voff) do { _Pragma("unroll") for (int _i = 0; _i < 2; ++_i) \
        __builtin_amdgcn_global_load_lds((const unsigned*)((const char*)(gbase) + (voff)[_i]), (PG8_LAS unsigned*)(lds + (bufoff) + ldsw + _i * 8192), 16, 0, 0); } while (0)
#define PG8_LDA(dst, b, h) do { _Pragma("unroll") for (int m = 0; m < 4; ++m) _Pragma("unroll") for (int k = 0; k < 2; ++k) dst[m][k] = *(const PG8_LAS bf16x8*)(lds + PG8_SA(b, h) + aoff + m * 2048 + k * 1024); } while (0)
#define PG8_LDB(dst, b, h) do { _Pragma("unroll") for (int n = 0; n < 2; ++n) _Pragma("unroll") for (int k = 0; k < 2; ++k) dst[n][k] = *(const PG8_LAS bf16x8*)(lds + PG8_SB(b, h) + boff + n * 2048 + k * 1024); } while (0)
#define PG8_MMA(ai, bj, At, Bt) do { __builtin_amdgcn_s_setprio(1); _Pragma("unroll") for (int m = 0; m < 4; ++m) _Pragma("unroll") for (int n = 0; n < 2; ++n) _Pragma("unroll") for (int k = 0; k < 2; ++k) \
        acc[ai][bj][m][n] = __builtin_amdgcn_mfma_f32_16x16x32_bf16(Bt[n][k], At[m][k], acc[ai][bj][m][n], 0, 0, 0); __builtin_amdgcn_s_setprio(0); } while (0)
#define PG8_WAIT_V(n) asm volatile("s_waitcnt vmcnt(" #n ")" ::: "memory")
#define PG8_WAIT_L(n) asm volatile("s_waitcnt lgkmcnt(" #n ")" ::: "memory")
#define PG8_BAR __builtin_amdgcn_s_barrier()
#define PG8_SCHED __builtin_amdgcn_sched_barrier(0)
    Unit cur, nxt; int ui = 0;
    if (!S.next(0, cur)) return;
    f32x4 acc[2][2][4][2];
#pragma unroll
    for (int a = 0; a < 2; ++a)
#pragma unroll
        for (int b = 0; b < 2; ++b)
#pragma unroll
            for (int m = 0; m < 4; ++m)
#pragma unroll
                for (int n = 0; n < 2; ++n) acc[a][b][m][n] = (f32x4){0.f, 0.f, 0.f, 0.f};
    bf16x8 At[4][2], B0[2][2], B1[2][2];
    const char* cA = (const char*)g.A + (size_t)cur.pm * tstep; const char* cB = (const char*)g.Bt + (size_t)cur.pn * tstep;
    S.a_ready(cur);
    PG8_STAGE(PG8_SB(0, 0), cB, voffB); PG8_STAGE(PG8_SA(0, 0), cA, voffA); PG8_STAGE(PG8_SB(0, 1), cB + hstep, voffB); PG8_STAGE(PG8_SA(0, 1), cA + hstep, voffA);
    if (wr == 1) PG8_BAR;
    PG8_WAIT_V(4); PG8_BAR;
    PG8_STAGE(PG8_SB(1, 0), cB + kstep, voffB); PG8_STAGE(PG8_SA(1, 0), cA + kstep, voffA); PG8_STAGE(PG8_SB(1, 1), cB + hstep + kstep, voffB);
    PG8_WAIT_V(6); PG8_BAR;
    for (;;) {
        const bool has_next = S.next(ui + 1, nxt);
        const char* nA = has_next ? (const char*)g.A + (size_t)nxt.pm * tstep : cA; const char* nB = has_next ? (const char*)g.Bt + (size_t)nxt.pn * tstep : cB;
        for (int t = 0; t < nt; t += 2) {
            const bool last = (t == nt - 2);
            const char* a1 = cA + (size_t)(t + 1) * kstep;
            const char* a2 = last ? nA : cA + (size_t)(t + 2) * kstep; const char* b2 = last ? nB : cB + (size_t)(t + 2) * kstep;
            const char* a3 = a2 + kstep; const char* b3 = b2 + kstep;
            if (last && has_next) S.a_ready(nxt);
            PG8_LDB(B0, 0, 0); PG8_SCHED; PG8_LDA(At, 0, 0); PG8_STAGE(PG8_SA(1, 1), a1 + hstep, voffA);
            PG8_WAIT_L(8); PG8_BAR; PG8_WAIT_L(0); PG8_MMA(0, 0, At, B0); PG8_BAR; PG8_SCHED;
            PG8_LDB(B1, 0, 1); PG8_STAGE(PG8_SB(0, 0), b2, voffB);
            PG8_BAR; PG8_WAIT_L(0); PG8_MMA(0, 1, At, B1); PG8_BAR;
            PG8_LDA(At, 0, 1); PG8_STAGE(PG8_SA(0, 0), a2, voffA);
            PG8_BAR; PG8_WAIT_L(0); PG8_MMA(1, 0, At, B0); PG8_BAR; PG8_SCHED;
            PG8_STAGE(PG8_SB(0, 1), b2 + hstep, voffB);
            PG8_WAIT_V(6); PG8_BAR; PG8_MMA(1, 1, At, B1); PG8_BAR;
            PG8_LDB(B0, 1, 0); PG8_SCHED; PG8_LDA(At, 1, 0); PG8_STAGE(PG8_SA(0, 1), a2 + hstep, voffA);
            PG8_WAIT_L(8); PG8_BAR; PG8_WAIT_L(0); PG8_MMA(0, 0, At, B0); PG8_BAR; PG8_SCHED;
            PG8_LDB(B1, 1, 1); PG8_STAGE(PG8_SB(1, 0), b3, voffB);
            PG8_BAR; PG8_WAIT_L(0); PG8_MMA(0, 1, At, B1); PG8_BAR;
            PG8_LDA(At, 1, 1); PG8_STAGE(PG8_SA(1, 0), a3, voffA);
            PG8_BAR; PG8_WAIT_L(0); PG8_MMA(1, 0, At, B0); PG8_BAR; PG8_SCHED;
            PG8_STAGE(PG8_SB(1, 1), b3 + hstep, voffB);
            PG8_WAIT_V(6); PG8_BAR; PG8_MMA(1, 1, At, B1); PG8_BAR;
        }
        if constexpr (!Epi::AFTER_DRAIN) { E(acc, cur, wr, wc, fr, fq); S.done(cur); }
        if (!has_next) break;
#pragma unroll
        for (int a = 0; a < 2; ++a)
#pragma unroll
            for (int b = 0; b < 2; ++b)
#pragma unroll
                for (int m = 0; m < 4; ++m)
#pragma unroll
                    for (int n = 0; n < 2; ++n) acc[a][b][m][n] = (f32x4){0.f, 0.f, 0.f, 0.f};
        cur = nxt; cA = nA; cB = nB; ++ui;
    }
    PG8_WAIT_V(0);
    if (wr == 0) PG8_BAR;
    PG8_BAR;
    if constexpr (Epi::AFTER_DRAIN) { E.fused(acc, cur, wr, wc, fr, fq, lds, wid, lane); S.done(cur); }
#undef PG8_SA
#undef PG8_SB
#undef PG8_STAGE
#undef PG8_LDA
#undef PG8_LDB
#undef PG8_MMA
#undef PG8_WAIT_V
#undef PG8_WAIT_L
#undef PG8_BAR
#undef PG8_SCHED
}
}

#define XB_TMO      128
#define XB_XCNT(j)  (256  + 64 * (j))
#define XB_XSUB(j)  (1280 + 64 * (j))
#define XB_XGEN(j)  (2304 + 64 * (j))
#define XB_TOP      3328
#define XB_TOPGEN   3392
#define XCD_BAR_WORDS 3456
#define XB_SPIN_CAP (1u << 18)
#define LAS __attribute__((address_space(3)))

__device__ __forceinline__ unsigned xb_ld(unsigned* p)              { return __hip_atomic_load(p, __ATOMIC_RELAXED, __HIP_MEMORY_SCOPE_AGENT); }
__device__ __forceinline__ unsigned xb_add(unsigned* p, unsigned v) { return __hip_atomic_fetch_add(p, v, __ATOMIC_RELAXED, __HIP_MEMORY_SCOPE_AGENT); }
__device__ __forceinline__ unsigned xb_xcc_id() { return (unsigned)__builtin_amdgcn_s_getreg((3 << 11) | 20) & 0xFu; }
#define XB_SPIN(cond, bar) do { unsigned _sp = 0; while (cond) { __builtin_amdgcn_s_sleep(1); \
    if ((++_sp & 255u) == 0u) { if (xb_ld(&(bar)[XB_TMO])) break; if (_sp > XB_SPIN_CAP) { atomicAdd(&(bar)[XB_TMO], 1u); break; } } } } while (0)

struct XcdBarrier {
    unsigned* bar; unsigned x;
    volatile LAS unsigned* st;
};

__device__ __forceinline__ XcdBarrier xcd_barrier_post(unsigned* bar, volatile LAS unsigned* st) {
    XcdBarrier b; b.bar = bar; b.x = xb_xcc_id(); b.st = st;
    if (threadIdx.x == 0) (void)xb_add(&bar[XB_XCNT(b.x)], 1u);
    return b;
}
__device__ __forceinline__ void xcd_barrier_complete(unsigned* bar, unsigned x, unsigned& nloc, unsigned& nx) {
    const unsigned G = gridDim.x * gridDim.y * gridDim.z;
    unsigned sum, cnt, mine, sp = 0u;
    for (;;) {
        sum = 0u; cnt = 0u; mine = 0u;
#pragma unroll
        for (unsigned j = 0; j < 16; ++j) { const unsigned c = xb_ld(&bar[XB_XCNT(j)]); sum += c; cnt += (c > 0u) ? 1u : 0u; mine = (j == x) ? c : mine; }
        if (sum == G) break;
        __builtin_amdgcn_s_sleep(1);
        if ((++sp & 255u) == 0u) { if (xb_ld(&bar[XB_TMO])) break; if (sp > XB_SPIN_CAP) { atomicAdd(&bar[XB_TMO], 1u); break; } }
    }
    nloc = mine > 0u ? mine : 1u; nx = cnt > 0u ? cnt : 1u;
}

__device__ __forceinline__ void xcd_barrier(const XcdBarrier& b) {
    asm volatile("s_waitcnt vmcnt(0)" ::: "memory");
    __syncthreads();
    if (threadIdx.x == 0) {
        unsigned* bar = b.bar;
        __builtin_amdgcn_s_waitcnt(0);
        unsigned nloc = b.st[0], nx = b.st[1];
        if (nloc == 0u) { xcd_barrier_complete(bar, b.x, nloc, nx); b.st[0] = nloc; b.st[1] = nx; }
        const unsigned old = xb_add(&bar[XB_XSUB(b.x)], 1u);
        const unsigned gen = old / nloc;
        if (old + 1u == (gen + 1u) * nloc) {
            __builtin_amdgcn_fence(__ATOMIC_RELEASE, "agent");
            asm volatile("s_waitcnt vmcnt(0)" ::: "memory");
            const unsigned og = xb_add(&bar[XB_TOP], 1u);
            const unsigned tg = og / nx;
            if (og + 1u == (tg + 1u) * nx) xb_add(&bar[XB_TOPGEN], 1u);
            else XB_SPIN(xb_ld(&bar[XB_TOPGEN]) == tg, bar);
            __builtin_amdgcn_fence(__ATOMIC_ACQUIRE, "agent");
            xb_add(&bar[XB_XGEN(b.x)], 1u);
            asm volatile("s_waitcnt vmcnt(0)" ::: "memory");
        } else {
            XB_SPIN(xb_ld(&bar[XB_XGEN(b.x)]) == gen, bar);
            __builtin_amdgcn_fence(__ATOMIC_ACQUIRE, "agent");
            asm volatile("s_waitcnt vmcnt(0)" ::: "memory");
        }
    }
    __syncthreads();
}

typedef const float* cfp_t;
typedef __attribute__((address_space(4))) const cfp_t* ka_t;
struct Ctx {
    LAS unsigned char* lds; int tid, lane, wave, bid, G;
};

__device__ __forceinline__ void task_ada(const Ctx& F, const float* c, const float* c_ctx, const float* w_ada, float* modp, int task) {
    LAS float* s_act = (LAS float*)F.lds;
    const int l = task / (KSPL * 6), rem = task % (KSPL * 6), ks = rem / 6, cc = rem % 6;
    __syncthreads();
    if (F.tid < 320) { const int v = F.tid >> 6, k = ks * 64 + (F.tid & 63); const float x = v < 4 ? c[v * 2048 + k] : c_ctx[k]; s_act[F.tid] = siluf_(x); }
    __syncthreads();
    const int col4 = cc * 512 + F.tid;
    const float4* wp = (const float4*)(w_ada + ((size_t)l * 2048 + ks * 64) * 12288) + col4;
    float4 acc[5];
#pragma unroll
    for (int v = 0; v < 5; ++v) acc[v] = make_float4(0.f, 0.f, 0.f, 0.f);
#pragma unroll 8
    for (int k = 0; k < 64; ++k) {
        const float4 w = wp[(size_t)k * 3072];
#pragma unroll
        for (int v = 0; v < 5; ++v) { const float a = s_act[v * 64 + k]; acc[v].x += a * w.x; acc[v].y += a * w.y; acc[v].z += a * w.z; acc[v].w += a * w.w; }
    }
#pragma unroll
    for (int v = 0; v < 5; ++v) ((float4*)(modp + (((size_t)ks * 2 + l) * 5 + v) * 12288))[col4] = acc[v];
}
__device__ __forceinline__ void task_wt(const Ctx& F, const float* W, int N, bf16_t* Wt, int ntile) {
    LAS bf16_t* T = (LAS bf16_t*)F.lds;
    const int nq = F.tid & 15, kr = F.tid >> 4, n0 = ntile * 64;
    for (int kc = 0; kc < 16; ++kc) {
        float4 v[4];
#pragma unroll
        for (int j = 0; j < 4; ++j) { const int k = kc * 128 + kr + 32 * j, n = n0 + 4 * nq;
            v[j] = (n < N) ? *(const float4*)(W + (size_t)k * N + n) : make_float4(0.f, 0.f, 0.f, 0.f); }
        __syncthreads();
#pragma unroll
        for (int j = 0; j < 4; ++j) { const int kl = kr + 32 * j;
            T[(4 * nq + 0) * 136 + kl] = f2bf(v[j].x); T[(4 * nq + 1) * 136 + kl] = f2bf(v[j].y); T[(4 * nq + 2) * 136 + kl] = f2bf(v[j].z); T[(4 * nq + 3) * 136 + kl] = f2bf(v[j].w); }
        __syncthreads();
        { const int n = F.tid >> 3, kg = F.tid & 7;
          const u32x4 a = *(LAS u32x4*)(T + n * 136 + kg * 16), b = *(LAS u32x4*)(T + n * 136 + kg * 16 + 8);
          bf16_t* dst = Wt + (size_t)(n0 + n) * 2048 + kc * 128 + kg * 16; *(u32x4*)dst = a; *(u32x4*)(dst + 8) = b; }
    }
    __syncthreads();
}
__device__ __forceinline__ void task_cvt(const Ctx& F, const float* src, bf16_t* dst, size_t off) {
#pragma unroll 4
    for (int it = 0; it < 16; ++it) { const size_t e = off + (size_t)it * 4096 + F.tid * 8;
        const float4 a = *(const float4*)(src + e), b = *(const float4*)(src + e + 4);
        u32x4 o; o.x = pk_bf16(a.x, a.y); o.y = pk_bf16(a.z, a.w); o.z = pk_bf16(b.x, b.y); o.w = pk_bf16(b.z, b.w);
        *(u32x4*)(dst + e) = o; }
}
__device__ __forceinline__ void task_cvt8(const Ctx& F, const float* src, unsigned char* dst, size_t off, float scale) {
#pragma unroll 2
    for (int it = 0; it < 8; ++it) { const size_t e = off + (size_t)it * 8192 + F.tid * 16;
        u32x4 o;
#pragma unroll
        for (int w = 0; w < 4; ++w) { const float4 a = *(const float4*)(src + e + 4 * w);
            const float x0 = fminf(fmaxf(a.x * scale, -448.f), 448.f), x1 = fminf(fmaxf(a.y * scale, -448.f), 448.f), x2 = fminf(fmaxf(a.z * scale, -448.f), 448.f), x3 = fminf(fmaxf(a.w * scale, -448.f), 448.f);
            int p = __builtin_amdgcn_cvt_pk_fp8_f32(x0, x1, 0, false); p = __builtin_amdgcn_cvt_pk_fp8_f32(x2, x3, p, true); o[w] = (unsigned)p; }
        const size_t row = e >> 11; const int col = (int)(e & 2047);
        *(u32x4*)(dst + (row >> 14) * ((size_t)16384 * 2048) + ((size_t)(col >> 7) * 16384 + (row & 16383)) * 128 + (col & 127)) = o; }
}
constexpr float PEER_U_SCALE = 64.0f;
__device__ __forceinline__ void task_lorat(const Ctx& F, const float* src, bf16_t* dst, int nj) {
    const int ch = F.tid;
    for (int j8 = 0; j8 < nj / 8; ++j8) { float v[8];
#pragma unroll
        for (int q = 0; q < 8; ++q) v[q] = src[(size_t)(j8 * 8 + q) * 512 + ch];
        u32x4 o; o.x = pk_bf16(v[0], v[1]); o.y = pk_bf16(v[2], v[3]); o.z = pk_bf16(v[4], v[5]); o.w = pk_bf16(v[6], v[7]);
        *(u32x4*)(dst + (size_t)ch * nj + j8 * 8) = o; }
}
constexpr int T_ADA = 2 * KSPL * 6, T_WT1 = 2 * 104, T_WT2 = 2 * 32, T_WT3 = 2 * 32, T_PEER = 2048, T_KEYS = 8, T_LORA = 10;
__device__ __forceinline__ void phase_prologue(const Ctx& F, ka_t in, unsigned char* ws) {
    const int total = T_ADA + T_WT1 + T_WT2 + T_WT3 + T_PEER + T_KEYS + T_LORA + 1;
    for (int t0 = F.bid; t0 < total; t0 += F.G) {
        int t = t0;
        if (t < T_ADA) { task_ada(F, in[I_C], in[I_CCTX], in[I_WADA], (float*)(ws + WS_MODP), t); continue; } t -= T_ADA;
        if (t < T_WT1) { const int l = t / 104, nt = t % 104; task_wt(F, in[I_WIN] + (size_t)l * 2048 * PT, PT, (bf16_t*)(ws + WS_WIN) + (size_t)l * PTP * 2048, nt); continue; } t -= T_WT1;
        if (t < T_WT2) { const int l = t / 32, nt = t % 32; task_wt(F, in[I_WOUT] + (size_t)l * 2048 * 2048, 2048, (bf16_t*)(ws + WS_WOUT) + (size_t)l * 2048 * 2048, nt); continue; } t -= T_WT2;
        if (t < T_WT3) { const int l = t / 32, nt = t % 32; task_wt(F, in[I_PWQ] + (size_t)l * 2048 * 2048, 2048, (bf16_t*)(ws + WS_WQ) + (size_t)l * 2048 * 2048, nt); continue; } t -= T_WT3;
        if (t < T_PEER) { const bool isv = t >= 1024; const int c = t & 1023; task_cvt8(F, in[isv ? I_PV : I_PU], ws + (isv ? WS_PV : WS_PU), (size_t)c * 65536, isv ? 1.0f : PEER_U_SCALE); continue; } t -= T_PEER;
        if (t < T_KEYS) { task_cvt(F, in[I_PKEYS], (bf16_t*)(ws + WS_KEYS), (size_t)t * 65536); continue; } t -= T_KEYS;
        if (t < T_LORA) {
            if (t < 8) { const int l = t >> 2, wh = t & 3;
                task_lorat(F, in[wh < 2 ? I_RWUP : I_RAUP] + ((size_t)l * 2 + (wh & 1)) * 64 * 512, (bf16_t*)(ws + WS_WUPT) + ((size_t)l * 4 + wh) * 512 * 64, 64); }
            else { const int l = t - 8; task_lorat(F, in[I_RGUP] + (size_t)l * 128 * 512, (bf16_t*)(ws + WS_GUPT) + (size_t)l * 512 * 128, 128); }
            continue; } t -= T_LORA;
        { float* rope = (float*)(ws + WS_ROPE);
          for (int e = F.tid; e < 2048; e += 512) { const int pos = e >> 5, i = e & 31; const float fr = powf(10000.0f, -(float)i / 32.0f), ang = (float)pos * fr;
              rope[2 * e] = cosf(ang); rope[2 * e + 1] = sinf(ang); } }
    }
}
__device__ __forceinline__ void phase_modreduce(const Ctx& F, const float* b_ada, const float* modp, float* mod) {
    for (int idx = F.bid * 512 + F.tid; idx < 2 * 5 * 12288; idx += F.G * 512) {
        const int l = idx / 61440, rem = idx % 61440, v = rem / 12288, n = rem % 12288;
        float s = b_ada[l * 12288 + n];
        for (int ks = 0; ks < KSPL; ++ks) s += modp[(((size_t)ks * 2 + l) * 5 + v) * 12288 + n];
        mod[idx] = s;
    }
}

__device__ __forceinline__ void norm_store(const float (&x)[32], const float* gw, const float* shift, const float* scale, bf16_t* dst, int lane) {
    float ss = 0.f;
#pragma unroll
    for (int q = 0; q < 32; ++q) ss += x[q] * x[q];
    ss = wave_sum(ss);
    const float rs = rsqrtf(ss * (1.0f / 2048.0f) + 1e-6f);
#pragma unroll
    for (int j = 0; j < 4; ++j) { const int e = j * 512 + lane * 8;
        const float4 g0 = *(const float4*)(gw + e), g1 = *(const float4*)(gw + e + 4), h0 = *(const float4*)(shift + e), h1 = *(const float4*)(shift + e + 4), c0 = *(const float4*)(scale + e), c1 = *(const float4*)(scale + e + 4);
        const float y0 = x[j * 8 + 0] * rs * g0.x * (1.f + c0.x) + h0.x, y1 = x[j * 8 + 1] * rs * g0.y * (1.f + c0.y) + h0.y, y2 = x[j * 8 + 2] * rs * g0.z * (1.f + c0.z) + h0.z, y3 = x[j * 8 + 3] * rs * g0.w * (1.f + c0.w) + h0.w;
        const float y4 = x[j * 8 + 4] * rs * g1.x * (1.f + c1.x) + h1.x, y5 = x[j * 8 + 5] * rs * g1.y * (1.f + c1.y) + h1.y, y6 = x[j * 8 + 6] * rs * g1.z * (1.f + c1.z) + h1.z, y7 = x[j * 8 + 7] * rs * g1.w * (1.f + c1.w) + h1.w;
        u32x4 o; o.x = pk_bf16(y0, y1); o.y = pk_bf16(y2, y3); o.z = pk_bf16(y4, y5); o.w = pk_bf16(y6, y7);
        *(u32x4*)(dst + e) = o; }
}
__device__ __forceinline__ void phase_norm(const Ctx& F, const float* xlat, const float* xctx, const float* gw, const float* mod, int shift_i, int scale_i, bf16_t* dst, int nrows) {
    for (int row = F.bid * 8 + F.wave; row < nrows; row += F.G * 8) {
        const bool isctx = row >= NLAT; const float* xr = isctx ? xctx + (size_t)(row - NLAT) * 2048 : xlat + (size_t)row * 2048;
        const int v = isctx ? 4 : (row >> 12);
        float x[32];
#pragma unroll
        for (int j = 0; j < 4; ++j) { const int e = j * 512 + F.lane * 8; const float4 a = *(const float4*)(xr + e), b = *(const float4*)(xr + e + 4);
            x[j * 8 + 0] = a.x; x[j * 8 + 1] = a.y; x[j * 8 + 2] = a.z; x[j * 8 + 3] = a.w; x[j * 8 + 4] = b.x; x[j * 8 + 5] = b.y; x[j * 8 + 6] = b.z; x[j * 8 + 7] = b.w; }
        norm_store(x, gw, mod + (size_t)v * 12288 + shift_i * 2048, mod + (size_t)v * 12288 + scale_i * 2048, dst + (size_t)row * 2048, F.lane);
    }
}

struct LayerW {
    const float *sc_w, *rw_w0, *rw_wup, *rw_a0, *rw_aup, *rw_gup, *rw_kk, *rw_ka, *rw_rk, *rw_lnw, *rw_lnb, *na_q, *na_k, *rpb, *s_cw, *s_cb, *s_dtb, *s_alog, *s_d, *s_norm;
};
__device__ __forceinline__ void unpack8(const u32x4 q, float (&f)[8]) { f[0] = bflo(q[0]); f[1] = bfhi(q[0]); f[2] = bflo(q[1]); f[3] = bfhi(q[1]); f[4] = bflo(q[2]); f[5] = bfhi(q[2]); f[6] = bflo(q[3]); f[7] = bfhi(q[3]); }
__device__ __forceinline__ u32x4 pack8f(const float (&f)[8]) { u32x4 o; o[0] = pk_bf16(f[0], f[1]); o[1] = pk_bf16(f[2], f[3]); o[2] = pk_bf16(f[4], f[5]); o[3] = pk_bf16(f[6], f[7]); return o; }
__device__ __forceinline__ void load8f(const float* p, float (&f)[8]) { const float4 a = *(const float4*)p, b = *(const float4*)(p + 4); f[0] = a.x; f[1] = a.y; f[2] = a.z; f[3] = a.w; f[4] = b.x; f[5] = b.y; f[6] = b.z; f[7] = b.w; }
__device__ __forceinline__ void phase_prep(const Ctx& F, const LayerW& W, unsigned char* ws) {
    const bf16_t* P = (const bf16_t*)(ws + WS_P);
    bf16_t* MIX = (bf16_t*)(ws + WS_MIX);
    bf16_t* XBC = (bf16_t*)(ws + WS_XBC); float* DTS = (float*)(ws + WS_DTS); float* DEC = (float*)(ws + WS_DEC);
    bf16_t* QN = (bf16_t*)(ws + WS_QN); bf16_t* KN = (bf16_t*)(ws + WS_KN); bf16_t* VTL = (bf16_t*)(ws + WS_VTL); bf16_t* VTC = (bf16_t*)(ws + WS_VTC);
    const float* ROPE = (const float*)(ws + WS_ROPE);
    for (int tile = F.bid; tile < NTOK / 8; tile += F.G) {
        int ln = F.lane; asm volatile("" : "+v"(ln));
        const int ch0 = ln * 8;
        const bool lat = tile < NLAT / 8;
        const int b = lat ? (tile >> 9) : ((tile - NLAT / 8) >> 5);
        const int t0 = lat ? (tile & 511) * 8 : ((tile - NLAT / 8) & 31) * 8;
        const int L = lat ? SEQL : CTXL;
        const int g0 = lat ? b * SEQL + t0 : NLAT + b * CTXL + t0;
        const bf16_t* Pr = P + (size_t)g0 * PTP;
        if (F.wave == 0 || F.wave == 4) {
            const bool gated = F.wave == 0;
            const float* cw = gated ? W.sc_w : W.s_cw; const int cstride = gated ? 512 : 1024;
            float w0[8], w1[8], w2[8], cb[8];
            load8f(cw + ch0, w0); load8f(cw + cstride + ch0, w1); load8f(cw + 2 * cstride + ch0, w2);
            if (gated) {
#pragma unroll
                for (int e = 0; e < 8; ++e) cb[e] = 0.f;
            } else load8f(W.s_cb + ch0, cb);
            const int col = gated ? A_CG : D_X;
#pragma unroll 1
            for (int tb = 0; tb < 8; tb += 4) {
            u32x4 ra[6], rb[6], rg[4];
#pragma unroll
            for (int q = 0; q < 6; ++q) { const int tq = t0 + tb - 1 + q; const bool ok = (tq >= 0) && (tq < L);
                ra[q] = ok ? *(const u32x4*)(Pr + (ptrdiff_t)(tb + q - 1) * PTP + col + ch0) : (u32x4){0u, 0u, 0u, 0u};
                if (gated) rb[q] = ok ? *(const u32x4*)(Pr + (ptrdiff_t)(tb + q - 1) * PTP + A_H + ch0) : (u32x4){0u, 0u, 0u, 0u}; }
            if (gated) {
#pragma unroll
                for (int tt = 0; tt < 4; ++tt) rg[tt] = *(const u32x4*)(Pr + (size_t)(tb + tt) * PTP + A_BG + ch0); }
            float up[8], uc[8], un[8];
            { float x[8], y[8]; unpack8(ra[0], x); if (gated) { unpack8(rb[0], y);
#pragma unroll
                for (int e = 0; e < 8; ++e) x[e] *= y[e]; }
#pragma unroll
              for (int e = 0; e < 8; ++e) up[e] = x[e];
              unpack8(ra[1], x); if (gated) { unpack8(rb[1], y);
#pragma unroll
                for (int e = 0; e < 8; ++e) x[e] *= y[e]; }
#pragma unroll
              for (int e = 0; e < 8; ++e) uc[e] = x[e]; }
#pragma unroll
            for (int tt = 0; tt < 4; ++tt) {
                { float x[8], y[8]; unpack8(ra[tt + 2], x); if (gated) { unpack8(rb[tt + 2], y);
#pragma unroll
                    for (int e = 0; e < 8; ++e) x[e] *= y[e]; }
#pragma unroll
                  for (int e = 0; e < 8; ++e) un[e] = x[e]; }
                float o[8];
                if (gated) { float bg[8]; unpack8(rg[tt], bg);
#pragma unroll
                    for (int e = 0; e < 8; ++e) o[e] = bg[e] * (w0[e] * up[e] + w1[e] * uc[e] + w2[e] * un[e]);
                    *(u32x4*)(MIX + (size_t)(g0 + tb + tt) * 2048 + ch0) = pack8f(o);
                } else {
#pragma unroll
                    for (int e = 0; e < 8; ++e) o[e] = siluf_(w0[e] * up[e] + w1[e] * uc[e] + w2[e] * un[e] + cb[e]);
                    *(u32x4*)(XBC + (size_t)(g0 + tb + tt) * 1024 + ch0) = pack8f(o); }
#pragma unroll
                for (int e = 0; e < 8; ++e) { up[e] = uc[e]; uc[e] = un[e]; }
            }
            }
        } else if (F.wave == 1 || F.wave == 2) {
            const bool isq = F.wave == 1; const int col = isq ? C_Q : C_K; bf16_t* dst = isq ? QN : KN;
            float nw[8]; load8f((isq ? W.na_q : W.na_k) + (ln & 7) * 8, nw);
            const float sc = isq ? 0.125f : 1.0f;
            u32x4 rq[8];
#pragma unroll
            for (int tt = 0; tt < 8; ++tt) rq[tt] = *(const u32x4*)(Pr + (size_t)tt * PTP + col + ch0);
#pragma unroll
            for (int tt = 0; tt < 8; ++tt) { float x[8]; unpack8(rq[tt], x); float ss = 0.f;
#pragma unroll
                for (int e = 0; e < 8; ++e) ss += x[e] * x[e];
                ss = sum8(ss); const float rs = rsqrtf(ss * (1.f / 64.f) + 1e-6f) * sc;
#pragma unroll
                for (int e = 0; e < 8; ++e) x[e] = x[e] * rs * nw[e];
                *(u32x4*)(dst + (size_t)(g0 + tt) * 512 + ch0) = pack8f(x); }
        } else if (F.wave == 3) {
            u32x4 rv[8];
#pragma unroll
            for (int tt = 0; tt < 8; ++tt) rv[tt] = *(const u32x4*)(Pr + (size_t)tt * PTP + C_V + ch0);
            const int h = ln >> 3;
#pragma unroll
            for (int e = 0; e < 8; ++e) { const int i = (ln & 7) * 8 + e;
                unsigned short v[8];
#pragma unroll
                for (int tt = 0; tt < 8; ++tt) v[tt] = (unsigned short)((e & 1) ? (rv[tt][e >> 1] >> 16) : (rv[tt][e >> 1] & 0xffffu));
                u32x2 c0; c0.x = (unsigned)v[0] | ((unsigned)v[1] << 16); c0.y = (unsigned)v[2] | ((unsigned)v[3] << 16);
                u32x2 c1; c1.x = (unsigned)v[4] | ((unsigned)v[5] << 16); c1.y = (unsigned)v[6] | ((unsigned)v[7] << 16);
                if (lat) { const int row = t0 >> 6, x0 = (t0 & 63) >> 2, x1 = x0 + 1;
                    bf16_t* base = VTL + ((size_t)((b * 8 + h) * 64 + i) * 64 + row) * 96;
                    if (x0 <= 11) *(u32x2*)(base + x0 * 8) = c0;
                    if (x0 >= 4)  *(u32x2*)(base + (x0 - 4) * 8 + 4) = c0;
                    if (x1 <= 11) *(u32x2*)(base + x1 * 8) = c1;
                    if (x1 >= 4)  *(u32x2*)(base + (x1 - 4) * 8 + 4) = c1;
                } else { const int m = t0 >> 5, o = t0 & 31, gq = (o & 15) >> 2, hf = (o >> 4) * 4;
                    bf16_t* base = VTC + ((size_t)((b * 8 + h) * 64 + i) * 8 + m) * 32;
                    *(u32x2*)(base + gq * 8 + hf) = c0; *(u32x2*)(base + (gq + 1) * 8 + hf) = c1; } }
        } else if (F.wave == 5) {
            if (ln < 32) {
                const int pg = ln, which = pg >> 4, gi = (pg >> 3) & 1, half = (pg >> 2) & 1, i0 = (pg & 3) * 8;
                const int c1 = 512 + which * 256 + gi * 128 + half * 64 + i0, c2 = c1 + 32;
                float wa0[8], wa1[8], wa2[8], ba[8], wb0[8], wb1[8], wb2[8], bb[8];
                load8f(W.s_cw + c1, wa0); load8f(W.s_cw + 1024 + c1, wa1); load8f(W.s_cw + 2048 + c1, wa2); load8f(W.s_cb + c1, ba);
                load8f(W.s_cw + c2, wb0); load8f(W.s_cw + 1024 + c2, wb1); load8f(W.s_cw + 2048 + c2, wb2); load8f(W.s_cb + c2, bb);
#pragma unroll 1
                for (int tb = 0; tb < 8; tb += 2) {
                u32x4 ra[4], rb[4];
#pragma unroll
                for (int q = 0; q < 4; ++q) { const int tq = t0 + tb - 1 + q; const bool ok = (tq >= 0) && (tq < L);
                    ra[q] = ok ? *(const u32x4*)(Pr + (ptrdiff_t)(tb + q - 1) * PTP + D_X + c1) : (u32x4){0u, 0u, 0u, 0u};
                    rb[q] = ok ? *(const u32x4*)(Pr + (ptrdiff_t)(tb + q - 1) * PTP + D_X + c2) : (u32x4){0u, 0u, 0u, 0u}; }
                float ap[8], ac[8], an[8], bp[8], bc[8], bn[8];
                unpack8(ra[0], ap); unpack8(ra[1], ac); unpack8(rb[0], bp); unpack8(rb[1], bc);
#pragma unroll
                for (int tt = 0; tt < 2; ++tt) { unpack8(ra[tt + 2], an); unpack8(rb[tt + 2], bn);
                    float y1[8], y2[8];
#pragma unroll
                    for (int e = 0; e < 8; ++e) { y1[e] = siluf_(wa0[e] * ap[e] + wa1[e] * ac[e] + wa2[e] * an[e] + ba[e]); y2[e] = siluf_(wb0[e] * bp[e] + wb1[e] * bc[e] + wb2[e] * bn[e] + bb[e]); }
                    if (lat) { const int t = t0 + tb + tt, pos = half ? (t & 63) : (t >> 6);
                        float cs[16];
#pragma unroll
                        for (int q = 0; q < 4; ++q) { const float4 v = *(const float4*)(ROPE + (size_t)(pos * 32 + i0) * 2 + 4 * q); cs[4 * q] = v.x; cs[4 * q + 1] = v.y; cs[4 * q + 2] = v.z; cs[4 * q + 3] = v.w; }
#pragma unroll
                        for (int e = 0; e < 8; ++e) { const float o1 = y1[e] * cs[2 * e] - y2[e] * cs[2 * e + 1], o2 = y1[e] * cs[2 * e + 1] + y2[e] * cs[2 * e]; y1[e] = o1; y2[e] = o2; } }
                    *(u32x4*)(XBC + (size_t)(g0 + tb + tt) * 1024 + c1) = pack8f(y1); *(u32x4*)(XBC + (size_t)(g0 + tb + tt) * 1024 + c2) = pack8f(y2);
#pragma unroll
                    for (int e = 0; e < 8; ++e) { ap[e] = ac[e]; ac[e] = an[e]; bp[e] = bc[e]; bc[e] = bn[e]; }
                }
                }
            }
        } else if (F.wave == 6) {
#pragma unroll
            for (int q = 0; q < 2; ++q) { const int it = ln + 64 * q, tt = it >> 4, j = it & 15;
                const float x = bf2f(Pr[(size_t)tt * PTP + D_DT + j]) + W.s_dtb[j];
                const float sp = fmaxf(x, 0.f) + log1pf(__expf(-fabsf(x)));
                DTS[(size_t)(g0 + tt) * 16 + j] = sp; DEC[(size_t)(g0 + tt) * 16 + j] = -sp * __expf(W.s_alog[j]); }
        }
    }
}

constexpr int SB_PITCH = 136;
__device__ __forceinline__ void ssd_scan_L(const Ctx& F, LAS float* sL, const float* LA, int g0, int h) {
    const int d = (F.tid >> 7) & 1, t = F.tid & 127;
    float v = 0.f;
    if (F.tid < 256) { v = LA[(size_t)(g0 + t) * 16 + d * 8 + h]; sL[F.tid] = v; }
    __syncthreads();
#pragma unroll
    for (int off = 1; off < 128; off <<= 1) {
        float o = 0.f;
        if (F.tid < 256) { const int tp = d ? t + off : t - off; if (tp >= 0 && tp < 128) o = sL[d * 128 + tp]; }
        __syncthreads();
        if (F.tid < 256) { v += o; sL[F.tid] = v; }
        __syncthreads();
    }
}
template <bool PASS2>
__device__ __forceinline__ void ssd_task(const Ctx& F, const LayerW& W, unsigned char* ws, int task) {
    const bf16_t* XBC = (const bf16_t*)(ws + WS_XBC); const float* DTS = (const float*)(ws + WS_DTS); const float* LA = (const float*)(ws + WS_DEC);
    float* SST = (float*)(ws + WS_SST); float* SCD = (float*)(ws + WS_SCD); float* YS = (float*)(ws + WS_YS);
    const int c = task % NCH, bh = task / NCH, h = bh & 7, b = bh >> 3, gi = h >> 2;
    const int g0 = c < 2 ? NLAT + b * CTXL + c * 128 : b * SEQL + (c - 2) * 128;
    const int w = F.wave, l16 = F.lane & 15, g = F.lane >> 4;
    const f32x4 z4 = {0.f, 0.f, 0.f, 0.f};
    LAS float* sL = (LAS float*)(F.lds + 131072);
    LAS float* sDT = sL + 256;
    __syncthreads();
    if (F.tid < 256) { const int s = F.tid >> 1, d = F.tid & 1; sDT[F.tid] = DTS[(size_t)(g0 + s) * 16 + d * 8 + h]; }
    ssd_scan_L(F, sL, LA, g0, h);
    if (!PASS2) {
        LAS bf16_t* sBT = (LAS bf16_t*)F.lds;
        LAS bf16_t* sXT = sBT + 128 * SB_PITCH;
#pragma unroll
        for (int q = 0; q < 4; ++q) { const int v = F.tid + 512 * q, s = v >> 4, part = v & 15;
            const u32x4 bv = *(const u32x4*)(XBC + (size_t)(g0 + s) * 1024 + 512 + gi * 128 + part * 8);
#pragma unroll
            for (int e = 0; e < 4; ++e) { sBT[(part * 8 + 2 * e) * SB_PITCH + s] = (bf16_t)(bv[e] & 0xffffu); sBT[(part * 8 + 2 * e + 1) * SB_PITCH + s] = (bf16_t)(bv[e] >> 16); } }
#pragma unroll
        for (int q = 0; q < 2; ++q) { const int v = F.tid + 512 * q, s = v >> 3, part = v & 7;
            const u32x4 xv = *(const u32x4*)(XBC + (size_t)(g0 + s) * 1024 + h * 64 + part * 8);
            const float sc0 = sDT[s * 2] * __expf(sL[127] - sL[s]), sc1 = sDT[s * 2 + 1] * __expf(sL[128] - sL[128 + s]);
#pragma unroll
            for (int e = 0; e < 4; ++e) { const float lo = bflo(xv[e]), hi = bfhi(xv[e]); const int p = part * 8 + 2 * e;
                sXT[p * SB_PITCH + s] = f2bf(lo * sc0); sXT[(p + 1) * SB_PITCH + s] = f2bf(hi * sc0);
                sXT[(64 + p) * SB_PITCH + s] = f2bf(lo * sc1); sXT[(64 + p + 1) * SB_PITCH + s] = f2bf(hi * sc1); } }
        __syncthreads();
        bf16x8 bfr[4];
#pragma unroll
        for (int ks = 0; ks < 4; ++ks) bfr[ks] = *(const LAS bf16x8*)(sBT + (16 * w + l16) * SB_PITCH + 32 * ks + 8 * g);
#pragma unroll
        for (int d = 0; d < 2; ++d) {
            float* st = SST + ((size_t)((b * 8 + h) * 2 + d) * NCH + c) * 8192;
#pragma unroll
            for (int pt = 0; pt < 4; ++pt) { f32x4 acc = z4;
#pragma unroll
                for (int ks = 0; ks < 4; ++ks) acc = __builtin_amdgcn_mfma_f32_16x16x32_bf16(*(const LAS bf16x8*)(sXT + (d * 64 + 16 * pt + l16) * SB_PITCH + 32 * ks + 8 * g), bfr[ks], acc, 0, 0, 0);
#pragma unroll
                for (int r = 0; r < 4; ++r) st[(16 * pt + 4 * g + r) * 128 + 16 * w + l16] = acc[r]; }
            if (F.tid == 0) SCD[((b * 8 + h) * 2 + d) * NCH + c] = __expf(d ? sL[128] : sL[127]);
        }
    } else {
        LAS bf16_t* sB = (LAS bf16_t*)F.lds;
        LAS bf16_t* sC = sB + 128 * SB_PITCH;
        LAS bf16_t* sXT = sC + 128 * SB_PITCH;
        LAS bf16_t* sS = sXT + 64 * SB_PITCH;
#pragma unroll
        for (int q = 0; q < 4; ++q) { const int v = F.tid + 512 * q, s = v >> 4, part = v & 15;
            *(LAS u32x4*)(sB + s * SB_PITCH + part * 8) = *(const u32x4*)(XBC + (size_t)(g0 + s) * 1024 + 512 + gi * 128 + part * 8);
            *(LAS u32x4*)(sC + s * SB_PITCH + part * 8) = *(const u32x4*)(XBC + (size_t)(g0 + s) * 1024 + 768 + gi * 128 + part * 8); }
#pragma unroll
        for (int q = 0; q < 2; ++q) { const int v = F.tid + 512 * q, s = v >> 3, part = v & 7;
            const u32x4 xv = *(const u32x4*)(XBC + (size_t)(g0 + s) * 1024 + h * 64 + part * 8);
#pragma unroll
            for (int e = 0; e < 4; ++e) { sXT[(part * 8 + 2 * e) * SB_PITCH + s] = (bf16_t)(xv[e] & 0xffffu); sXT[(part * 8 + 2 * e + 1) * SB_PITCH + s] = (bf16_t)(xv[e] >> 16); } }
#pragma unroll
        for (int q = 0; q < 4; ++q) { const int v = F.tid + 512 * q, d = v >> 10, p = (v >> 4) & 63, part = v & 15;
            const float* sp = SST + ((size_t)((b * 8 + h) * 2 + d) * NCH + c) * 8192 + p * 128 + part * 8;
            const float4 a0 = *(const float4*)sp, a1 = *(const float4*)(sp + 4);
            u32x4 o; o.x = pk_bf16(a0.x, a0.y); o.y = pk_bf16(a0.z, a0.w); o.z = pk_bf16(a1.x, a1.y); o.w = pk_bf16(a1.z, a1.w);
            *(LAS u32x4*)(sS + (d * 64 + p) * SB_PITCH + part * 8) = o; }
        __syncthreads();
        const int t = 16 * w + l16;
        bf16x8 cfr[4];
#pragma unroll
        for (int ks = 0; ks < 4; ++ks) cfr[ks] = *(const LAS bf16x8*)(sC + t * SB_PITCH + 32 * ks + 8 * g);
        f32x4 gt[8];
#pragma unroll
        for (int a = 0; a < 8; ++a) { f32x4 acc = z4;
#pragma unroll
            for (int ks = 0; ks < 4; ++ks) acc = __builtin_amdgcn_mfma_f32_16x16x32_bf16(*(const LAS bf16x8*)(sB + (16 * a + l16) * SB_PITCH + 32 * ks + 8 * g), cfr[ks], acc, 0, 0, 0);
            gt[a] = acc; }
        f32x4 ysum[4] = {z4, z4, z4, z4};
#pragma unroll
        for (int d = 0; d < 2; ++d) {
            const float Lt = sL[d * 128 + t], eLt = __expf(Lt);
            f32x4 acc[4];
#pragma unroll
            for (int pt = 0; pt < 4; ++pt) { f32x4 a = z4;
#pragma unroll
                for (int ks = 0; ks < 4; ++ks) a = __builtin_amdgcn_mfma_f32_16x16x32_bf16(*(const LAS bf16x8*)(sS + (d * 64 + 16 * pt + l16) * SB_PITCH + 32 * ks + 8 * g), cfr[ks], a, 0, 0, 0);
                acc[pt] = a * eLt; }
#pragma unroll
            for (int m = 0; m < 4; ++m) {
                const bool need = d ? (2 * m + 1 >= w) : (2 * m <= w);
                if (need) {
                    f32x4 wt[2];
#pragma unroll
                    for (int u = 0; u < 2; ++u) { const int a = 2 * m + u;
                        const f32x4 Ls = *(const LAS f32x4*)(sL + d * 128 + 16 * a + 4 * g);
#pragma unroll
                        for (int r = 0; r < 4; ++r) { const int s = 16 * a + 4 * g + r; const bool ok = d ? (s >= t) : (s <= t);
                            const float dts = sDT[s * 2 + d];
                            wt[u][r] = ok ? gt[a][r] * __expf(Lt - Ls[r]) * dts : 0.f; } }
                    const bf16x8 bfrag = pack8(wt[0], wt[1]);
#pragma unroll
                    for (int pt = 0; pt < 4; ++pt) { union { bf16x8 v; u32x2 hh[2]; } af;
                        af.hh[0] = *(const LAS u32x2*)(sXT + (16 * pt + l16) * SB_PITCH + 32 * m + 4 * g); af.hh[1] = *(const LAS u32x2*)(sXT + (16 * pt + l16) * SB_PITCH + 32 * m + 16 + 4 * g);
                        acc[pt] = __builtin_amdgcn_mfma_f32_16x16x32_bf16(af.v, bfrag, acc[pt], 0, 0, 0); }
                }
            }
#pragma unroll
            for (int pt = 0; pt < 4; ++pt) ysum[pt] = ysum[pt] + acc[pt];
        }
        const float dsk = W.s_d[h];
#pragma unroll
        for (int pt = 0; pt < 4; ++pt) { const int p = 16 * pt + 4 * g;
            const u32x2 xv = *(const u32x2*)(XBC + (size_t)(g0 + t) * 1024 + h * 64 + p);
            *(float4*)(YS + (size_t)(g0 + t) * 512 + h * 64 + p) = make_float4(ysum[pt][0] + dsk * bflo(xv.x), ysum[pt][1] + dsk * bfhi(xv.x), ysum[pt][2] + dsk * bflo(xv.y), ysum[pt][3] + dsk * bfhi(xv.y)); }
    }
}
template <int D> __device__ __forceinline__ void ssd_combine_one(float4* base, const float* scd) {
    float4 carry = make_float4(0.f, 0.f, 0.f, 0.f);
#pragma unroll
    for (int k0 = 0; k0 < NCH; k0 += 17) {
        float4 tmp[17];
#pragma unroll
        for (int k = 0; k < 17; ++k) { const int kk = k0 + k, c = D ? (kk < 2 ? 1 - kk : 35 - kk) : kk; tmp[k] = base[(size_t)c * 2048]; }
#pragma unroll
        for (int k = 0; k < 17; ++k) { const int kk = k0 + k, c = D ? (kk < 2 ? 1 - kk : 35 - kk) : kk; const float a = scd[c];
            base[(size_t)c * 2048] = carry;
            carry.x = a * carry.x + tmp[k].x; carry.y = a * carry.y + tmp[k].y; carry.z = a * carry.z + tmp[k].z; carry.w = a * carry.w + tmp[k].w; }
    }
}
__device__ __forceinline__ void phase_ssd_combine(const Ctx& F, unsigned char* ws) {
    float4* SST4 = (float4*)(ws + WS_SST); const float* SCD = (const float*)(ws + WS_SCD);
    for (int gt = F.bid * 512 + F.tid; gt < 64 * 2048; gt += F.G * 512) {
        const int sidx = gt >> 11, e4 = gt & 2047;
        float4* base = SST4 + (size_t)sidx * NCH * 2048 + e4;
        if (sidx & 1) ssd_combine_one<1>(base, SCD + sidx * NCH); else ssd_combine_one<0>(base, SCD + sidx * NCH);
    }
}

constexpr int RWF_CHUNK = 10496;
constexpr int RW_NCHUNK = NPOS / 16;
template <int CTRL> __device__ __forceinline__ float dpp_id1(float v) { return __int_as_float(__builtin_amdgcn_update_dpp(0x3f800000, __float_as_int(v), CTRL, 0xF, 0xF, false)); }
__device__ __forceinline__ float sel4(int g, float a, float b, float c, float d) { return g == 0 ? a : (g == 1 ? b : (g == 2 ? c : d)); }

template <int D> __device__ __forceinline__ void rwkv_pre_dir(const bf16_t* wupt, const bf16x8 (&bw)[2], const bf16x8 (&ba)[2], const f32x4 (&kk)[4], const f32x4 (&rr)[4], const f32x4 (&kx)[4],
        const float* w0p, const float* a0p, const float* kap, const float* rkp, float& bon, LAS unsigned char* wl, unsigned char* dst, int l16, int g) {
    LAS float* LT = (LAS float*)wl; LAS float* AT = LT + 256; LAS bf16_t* BT = (LAS bf16_t*)(wl + 2048); LAS bf16_t* KT = BT + 1024;
    const int lane = g * 16 + l16;
    bf16x8* o = (bf16x8*)dst;
    const f32x4 z4 = {0.f, 0.f, 0.f, 0.f};
    bf16x8 af[2], bf[2], kf[2], rf[2];
#pragma unroll
    for (int p = 0; p < 2; ++p) {
        f32x4 al[2], be[2], ka[2], rh[2];
#pragma unroll
        for (int mm = 0; mm < 2; ++mm) { const int m = 2 * p + mm; asm volatile("" ::: "memory");
            const bf16_t* wpw = wupt + ((size_t)D * 512 + 16 * m + l16) * 64 + 8 * g; const bf16_t* wpa = wupt + ((size_t)(2 + D) * 512 + 16 * m + l16) * 64 + 8 * g;
            f32x4 aw = __builtin_amdgcn_mfma_f32_16x16x32_bf16(*(const bf16x8*)wpw, bw[0], z4, 0, 0, 0); aw = __builtin_amdgcn_mfma_f32_16x16x32_bf16(*(const bf16x8*)(wpw + 32), bw[1], aw, 0, 0, 0);
            f32x4 aa = __builtin_amdgcn_mfma_f32_16x16x32_bf16(*(const bf16x8*)wpa, ba[0], z4, 0, 0, 0); aa = __builtin_amdgcn_mfma_f32_16x16x32_bf16(*(const bf16x8*)(wpa + 32), ba[1], aa, 0, 0, 0);
            const float4 w0 = *(const float4*)(w0p + 16 * m + 4 * g), a0 = *(const float4*)(a0p + 16 * m + 4 * g), kav = *(const float4*)(kap + 16 * m + 4 * g), rkv = *(const float4*)(rkp + 16 * m + 4 * g);
            const float w0a[4] = {w0.x, w0.y, w0.z, w0.w}, a0a[4] = {a0.x, a0.y, a0.z, a0.w}, kaa[4] = {kav.x, kav.y, kav.z, kav.w}, rka[4] = {rkv.x, rkv.y, rkv.z, rkv.w};
            f32x4 gcv;
#pragma unroll
            for (int r = 0; r < 4; ++r) {
                const float w = __expf(-0.6065306597126334f * sigmoidf_(w0a[r] + aw[r])), a = sigmoidf_(a0a[r] + aa[r]);
                const float kd = kx[m][r] * (1.f + (a - 1.f) * kaa[r]), bb = kk[m][r] * a;
                bon += rr[m][r] * kd * rka[r];
                float G = w;
                if (D == 0) { G *= dpp_id1<0x111>(G); G *= dpp_id1<0x112>(G); G *= dpp_id1<0x114>(G); G *= dpp_id1<0x118>(G); }
                else        { G *= dpp_id1<0x101>(G); G *= dpp_id1<0x102>(G); G *= dpp_id1<0x104>(G); G *= dpp_id1<0x108>(G); }
                const float Gex = (D == 0) ? dpp_id1<0x111>(G) : dpp_id1<0x101>(G);
                const float iG = rcpf_(G);
                al[mm][r] = Gex * kk[m][r]; be[mm][r] = bb * iG; ka[mm][r] = kd * iG; rh[mm][r] = G * rr[m][r]; gcv[r] = G;
                const int k = 16 * m + 4 * g + r; BT[k * 16 + l16] = f2bf(be[mm][r]); KT[k * 16 + l16] = f2bf(ka[mm][r]);
            }
            if (l16 == ((D == 0) ? 15 : 0)) *(float4*)((float*)(dst + 10240) + 16 * m + 4 * g) = make_float4(gcv[0], gcv[1], gcv[2], gcv[3]);
        }
        af[p] = pack8(al[0], al[1]); bf[p] = pack8(be[0], be[1]); kf[p] = pack8(ka[0], ka[1]); rf[p] = pack8(rh[0], rh[1]);
        o[64 * p + lane] = af[p]; o[128 + 64 * p + lane] = rf[p];
        __builtin_amdgcn_sched_barrier(0);
    }
    f32x4 Lm = __builtin_amdgcn_mfma_f32_16x16x32_bf16(af[0], bf[0], z4, 0, 0, 0); Lm = __builtin_amdgcn_mfma_f32_16x16x32_bf16(af[1], bf[1], Lm, 0, 0, 0);
    f32x4 Am = __builtin_amdgcn_mfma_f32_16x16x32_bf16(af[0], kf[0], z4, 0, 0, 0); Am = __builtin_amdgcn_mfma_f32_16x16x32_bf16(af[1], kf[1], Am, 0, 0, 0);
    f32x4 Bb = __builtin_amdgcn_mfma_f32_16x16x32_bf16(bf[0], rf[0], z4, 0, 0, 0); Bb = __builtin_amdgcn_mfma_f32_16x16x32_bf16(bf[1], rf[1], Bb, 0, 0, 0);
    f32x4 Bk = __builtin_amdgcn_mfma_f32_16x16x32_bf16(kf[0], rf[0], z4, 0, 0, 0); Bk = __builtin_amdgcn_mfma_f32_16x16x32_bf16(kf[1], rf[1], Bk, 0, 0, 0);
#pragma unroll
    for (int r = 0; r < 4; ++r) { const int row = 4 * g + r;
        const bool strict = (D == 0) ? (l16 < row) : (l16 > row);
        const bool incl = (D == 0) ? (row <= l16) : (row >= l16);
        Lm[r] = strict ? Lm[r] : 0.f; Am[r] = strict ? Am[r] : 0.f; Bb[r] = incl ? Bb[r] : 0.f; Bk[r] = incl ? Bk[r] : 0.f; }
    *(LAS f32x4*)(LT + l16 * 16 + 4 * g) = Lm; *(LAS f32x4*)(AT + l16 * 16 + 4 * g) = Am;
    o[320 + lane] = pack8(Bb, Bk);
    asm volatile("" ::: "memory");
#pragma unroll
    for (int m = 0; m < 4; ++m) { union { bf16x8 v; u32x2 h[2]; } f;
        f.h[0] = *(LAS u32x2*)(BT + (16 * m + l16) * 16 + 4 * g); f.h[1] = *(LAS u32x2*)(KT + (16 * m + l16) * 16 + 4 * g);
        o[384 + 64 * m + lane] = f.v; }
    __builtin_amdgcn_sched_barrier(0);
    float x[16];
    if (D == 0) {
#pragma unroll
        for (int c = 15; c >= 0; --c) { float s = (c == l16) ? 1.f : 0.f; asm volatile("" ::: "memory");
#pragma unroll
            for (int i = c + 1; i < 16; ++i) s -= x[i] * LT[c * 16 + i];
            x[c] = s; }
    } else {
#pragma unroll
        for (int c = 0; c < 16; ++c) { float s = (c == l16) ? 1.f : 0.f; asm volatile("" ::: "memory");
#pragma unroll
            for (int i = 0; i < c; ++i) s -= x[i] * LT[c * 16 + i];
            x[c] = s; }
    }
    f32x4 tm0, tm1;
#pragma unroll
    for (int r = 0; r < 4; ++r) tm0[r] = -sel4(g, x[r], x[4 + r], x[8 + r], x[12 + r]);
#pragma unroll
    for (int r = 0; r < 4; ++r) { float yv[4];
#pragma unroll
        for (int q = 0; q < 4; ++q) { const int c = 4 * q + r; float s = 0.f; asm volatile("" ::: "memory");
#pragma unroll
            for (int i = 0; i < 16; ++i) if ((D == 0) ? (i > c) : (i < c)) s += x[i] * AT[c * 16 + i];
            yv[q] = s; }
        tm1[r] = -sel4(g, yv[0], yv[1], yv[2], yv[3]); }
    o[256 + lane] = pack8(tm0, tm1);
    asm volatile("" ::: "memory");
}
__device__ __forceinline__ void rwkv_pre_task(const Ctx& F, const LayerW& W, unsigned char* ws, const bf16_t* WUPT, int task, int dsel) {
    const bf16_t* P = (const bf16_t*)(ws + WS_P); float* BON = (float*)(ws + WS_BON); unsigned char* RWF = ws + WS_RWF;
    const int cidx = task % RW_NCHUNK, bh = task / RW_NCHUNK, h = bh & 7, b = bh >> 3;
    int ln_ = F.lane; asm volatile("" : "+v"(ln_));
    const int l16 = ln_ & 15, g = ln_ >> 4;
    const int pos = cidx * 16 + l16;
    const int tok = pos < CTXL ? NLAT + b * CTXL + pos : b * SEQL + (pos - CTXL);
    const bf16_t* Pr = P + (size_t)tok * PTP;
    LAS unsigned char* wl = F.lds + F.wave * 8192;
    bf16x8 bw[2], ba[2];
#pragma unroll
    for (int p = 0; p < 2; ++p) { const u32x4 q = *(const u32x4*)(Pr + B_WD + 32 * p + 8 * g); union { bf16x8 v; unsigned u[4]; } tq;
#pragma unroll
        for (int e = 0; e < 4; ++e) tq.u[e] = pk_bf16(tanhf_(bflo(q[e])), tanhf_(bfhi(q[e])));
        bw[p] = tq.v; ba[p] = *(const bf16x8*)(Pr + B_AD + 32 * p + 8 * g); }
    f32x4 kk[4], rr[4], kx[4];
    float ssq = 0.f;
#pragma unroll
    for (int m = 0; m < 4; ++m) { const int co = h * 64 + 16 * m + 4 * g;
        const u32x2 rq = *(const u32x2*)(Pr + B_R + co), kq = *(const u32x2*)(Pr + B_K + co); const float4 kkw = *(const float4*)(W.rw_kk + co);
        rr[m] = (f32x4){bflo(rq.x), bfhi(rq.x), bflo(rq.y), bfhi(rq.y)}; kx[m] = (f32x4){bflo(kq.x), bfhi(kq.x), bflo(kq.y), bfhi(kq.y)};
        kk[m] = (f32x4){kx[m][0] * kkw.x, kx[m][1] * kkw.y, kx[m][2] * kkw.z, kx[m][3] * kkw.w};
        ssq += kk[m][0] * kk[m][0] + kk[m][1] * kk[m][1] + kk[m][2] * kk[m][2] + kk[m][3] * kk[m][3]; }
    ssq += xor16_f(ssq); ssq = sum_x32(ssq);
    { const float rn = rsqrtf(ssq + 1e-12f);
#pragma unroll
      for (int m = 0; m < 4; ++m) kk[m] = kk[m] * rn; }
    float bon = 0.f;
    const int co = h * 64;
    const int c0 = cidx, c1 = cidx < 16 ? 15 - cidx : 287 - cidx;
    if (dsel == 0) rwkv_pre_dir<0>(WUPT + (size_t)co * 64, bw, ba, kk, rr, kx, W.rw_w0 + co, W.rw_a0 + co, W.rw_ka + co, W.rw_rk + co, bon, wl, RWF + ((size_t)(bh * 2 + 0) * RW_NCHUNK + c0) * RWF_CHUNK, l16, g);
    else           rwkv_pre_dir<1>(WUPT + (size_t)co * 64, bw, ba, kk, rr, kx, W.rw_w0 + 512 + co, W.rw_a0 + 512 + co, W.rw_ka + co, W.rw_rk + co, bon, wl, RWF + ((size_t)(bh * 2 + 1) * RW_NCHUNK + c1) * RWF_CHUNK, l16, g);
    bon += xor16_f(bon); bon = sum_x32(bon);
    if (g == 0) BON[((size_t)dsel * NTOK + tok) * 8 + h] = bon;
}
struct RwFrag { bf16x8 a0, a1, r0, r1, tm, bb, bk0, bk1, bk2, bk3; f32x4 g0, g1, g2, g3; u32x2 v; };
__device__ __forceinline__ void rwkv_scan(const Ctx& F, unsigned char* ws, int sidx) {
    if (F.wave >= 4) return;
    const bf16_t* P = (const bf16_t*)(ws + WS_P); bf16_t* RWY = (bf16_t*)(ws + WS_RWY);
    const int d = sidx & 1, h = (sidx >> 1) & 7, b = sidx >> 4, n = F.wave, l16 = F.lane & 15, g = F.lane >> 4;
    const unsigned char* base = ws + WS_RWF + (size_t)sidx * RW_NCHUNK * RWF_CHUNK;
    const int vcol = B_V + h * 64 + 16 * n + l16;
#define RW_CIDX(c) (d ? ((c) < 16 ? 15 - (c) : 287 - (c)) : (c))
#define RW_TOK(cidx, i) (((cidx) * 16 + (i)) < CTXL ? NLAT + b * CTXL + (cidx) * 16 + (i) : b * SEQL + ((cidx) * 16 + (i) - CTXL))
#define RW_LOADF(fr, c) do { const bf16x8* q_ = (const bf16x8*)(base + (size_t)(c) * RWF_CHUNK) + F.lane; \
        fr.a0 = q_[0]; fr.a1 = q_[64]; fr.r0 = q_[128]; fr.r1 = q_[192]; fr.tm = q_[256]; fr.bb = q_[320]; fr.bk0 = q_[384]; fr.bk1 = q_[448]; fr.bk2 = q_[512]; fr.bk3 = q_[576]; \
        const f32x4* gp_ = (const f32x4*)(base + (size_t)(c) * RWF_CHUNK + 10240) + g; fr.g0 = gp_[0]; fr.g1 = gp_[4]; fr.g2 = gp_[8]; fr.g3 = gp_[12]; \
        const int ci_ = RW_CIDX(c); unsigned short v_[4]; _Pragma("unroll") for (int j_ = 0; j_ < 4; ++j_) v_[j_] = P[(size_t)RW_TOK(ci_, 4 * g + j_) * PTP + vcol]; \
        fr.v.x = (unsigned)v_[0] | ((unsigned)v_[1] << 16); fr.v.y = (unsigned)v_[2] | ((unsigned)v_[3] << 16); } while (0)
    f32x4 st0 = {0.f, 0.f, 0.f, 0.f}, st1 = st0, st2 = st0, st3 = st0;
    const f32x4 z4 = {0.f, 0.f, 0.f, 0.f};
#define RW_STEP(fr, c) do { \
        const bf16x8 s0_ = pack8(st0, st1), s1_ = pack8(st2, st3); \
        f32x4 x1_ = __builtin_amdgcn_mfma_f32_16x16x32_bf16(fr.a0, s0_, z4, 0, 0, 0); x1_ = __builtin_amdgcn_mfma_f32_16x16x32_bf16(fr.a1, s1_, x1_, 0, 0, 0); \
        f32x4 x2_ = __builtin_amdgcn_mfma_f32_16x16x32_bf16(fr.r0, s0_, z4, 0, 0, 0); x2_ = __builtin_amdgcn_mfma_f32_16x16x32_bf16(fr.r1, s1_, x2_, 0, 0, 0); \
        union { bf16x8 v; unsigned u[4]; } bx_; bx_.u[0] = pk_bf16(x1_[0], x1_[1]); bx_.u[1] = pk_bf16(x1_[2], x1_[3]); bx_.u[2] = fr.v.x; bx_.u[3] = fr.v.y; \
        const f32x4 e_ = __builtin_amdgcn_mfma_f32_16x16x32_bf16(fr.tm, bx_.v, z4, 0, 0, 0); \
        union { bf16x8 v; unsigned u[4]; } be_; be_.u[0] = pk_bf16(e_[0], e_[1]); be_.u[1] = pk_bf16(e_[2], e_[3]); be_.u[2] = fr.v.x; be_.u[3] = fr.v.y; \
        const f32x4 o_ = __builtin_amdgcn_mfma_f32_16x16x32_bf16(fr.bb, be_.v, x2_, 0, 0, 0); \
        st0 = __builtin_amdgcn_mfma_f32_16x16x32_bf16(fr.bk0, be_.v, st0, 0, 0, 0) * fr.g0; st1 = __builtin_amdgcn_mfma_f32_16x16x32_bf16(fr.bk1, be_.v, st1, 0, 0, 0) * fr.g1; \
        st2 = __builtin_amdgcn_mfma_f32_16x16x32_bf16(fr.bk2, be_.v, st2, 0, 0, 0) * fr.g2; st3 = __builtin_amdgcn_mfma_f32_16x16x32_bf16(fr.bk3, be_.v, st3, 0, 0, 0) * fr.g3; \
        const int ci_ = RW_CIDX(c); \
        _Pragma("unroll") for (int j_ = 0; j_ < 4; ++j_) RWY[((size_t)d * NTOK + RW_TOK(ci_, 4 * g + j_)) * 512 + h * 64 + 16 * n + l16] = f2bf(o_[j_]); } while (0)
    RwFrag fa, fb, fc;
#define RW_CL(c) ((c) < RW_NCHUNK ? (c) : RW_NCHUNK - 1)
    RW_LOADF(fa, 0); RW_LOADF(fb, 1);
    int c = 0;
    for (; c + 3 <= RW_NCHUNK; c += 3) {
        RW_LOADF(fc, RW_CL(c + 2)); RW_STEP(fa, c);
        RW_LOADF(fa, RW_CL(c + 3)); RW_STEP(fb, c + 1);
        RW_LOADF(fb, RW_CL(c + 4)); RW_STEP(fc, c + 2);
    }
    if (c < RW_NCHUNK) { RW_STEP(fa, c); if (c + 1 < RW_NCHUNK) RW_STEP(fb, c + 1); }
#undef RW_CL
#undef RW_CIDX
#undef RW_TOK
#undef RW_LOADF
#undef RW_STEP
}

__device__ __forceinline__ void na_tile(const Ctx& F, unsigned char* ws, const LAS float* sBias, int tile) {
    const bf16_t* QN = (const bf16_t*)(ws + WS_QN); const bf16_t* KN = (const bf16_t*)(ws + WS_KN);
    const bf16_t* VTL = (const bf16_t*)(ws + WS_VTL); const bf16_t* VTC = (const bf16_t*)(ws + WS_VTC); bf16_t* MIX = (bf16_t*)(ws + WS_MIX);
    const int h = F.wave, l16 = F.lane & 15, g = F.lane >> 4;
    const bool lat = tile < 1024;
    int b, r = 0, j = 0, gq;
    if (lat) { b = tile >> 8; r = (tile >> 2) & 63; j = tile & 3; gq = b * SEQL + r * 64 + j * 16 + l16; }
    else { const int tc = tile - 1024; b = tc >> 4; gq = NLAT + b * CTXL + (tc & 15) * 16 + l16; }
    const int row0 = min(max(r - 4, 0), 56), col0 = min(max(16 * j - 8, 0), 32);
    bf16x8 qf0, qf1;
    { const bf16_t* qp = QN + (size_t)gq * 512 + h * 64 + g * 8; qf0 = *(const bf16x8*)qp; qf1 = *(const bf16x8*)(qp + 32); }
    f32x4 acc[32];
    const f32x4 zero4 = {0.f, 0.f, 0.f, 0.f};
    const int cq = 16 * j + l16, win0 = min(max(cq - 8, 0), 48);
    const bf16_t* knb = KN + (size_t)(b * SEQL + row0 * 64 + col0 + l16) * 512 + h * 64 + g * 8;
    const bf16_t* kcx = KN + (size_t)(NLAT + b * CTXL + l16) * 512 + h * 64 + g * 8;
    bf16x8 kA[8], kB[8];
#define NA_KLOAD(buf, B) do { _Pragma("unroll") for (int q_ = 0; q_ < 4; ++q_) { const int T_ = 4 * (B) + q_; \
        const bf16_t* kp_ = T_ < 16 ? knb + (size_t)((T_ >> 1) * 64 + (T_ & 1) * 16) * 512 : kcx + (size_t)(T_ - 16) * 16 * 512; buf[2 * q_] = *(const bf16x8*)kp_; buf[2 * q_ + 1] = *(const bf16x8*)(kp_ + 32); } } while (0)
#define NA_KCOMP(buf, B) do { _Pragma("unroll") for (int q_ = 0; q_ < 4; ++q_) { const int T_ = 4 * (B) + q_; \
        f32x4 a_ = __builtin_amdgcn_mfma_f32_16x16x32_bf16(buf[2 * q_], qf0, zero4, 0, 0, 0); a_ = __builtin_amdgcn_mfma_f32_16x16x32_bf16(buf[2 * q_ + 1], qf1, a_, 0, 0, 0); \
        if (T_ < 16) { const int ir_ = T_ >> 1, hh_ = T_ & 1, kr_ = row0 + ir_; const LAS float* bias_ = sBias + (kr_ - r + 7) * 31; \
            _Pragma("unroll") for (int e_ = 0; e_ < 4; ++e_) { const int kc_ = col0 + 16 * hh_ + 4 * g + e_; const bool ok_ = (kc_ >= win0) && (kc_ < win0 + 16); \
                const int dc_ = min(max(kc_ - cq + 15, 0), 30); a_[e_] = ok_ ? a_[e_] + bias_[dc_] : -1e30f; } } \
        acc[T_] = a_; } } while (0)
#define NA_FENCE() asm volatile("" ::: "memory")
    if (lat) {
        NA_KLOAD(kA, 0);
        NA_KLOAD(kB, 1); NA_FENCE(); NA_KCOMP(kA, 0);
        NA_KLOAD(kA, 2); NA_FENCE(); NA_KCOMP(kB, 1);
        NA_KLOAD(kB, 3); NA_FENCE(); NA_KCOMP(kA, 2);
        NA_KLOAD(kA, 4); NA_FENCE(); NA_KCOMP(kB, 3);
        NA_KLOAD(kB, 5); NA_FENCE(); NA_KCOMP(kA, 4);
        NA_KLOAD(kA, 6); NA_FENCE(); NA_KCOMP(kB, 5);
        NA_KLOAD(kB, 7); NA_FENCE(); NA_KCOMP(kA, 6);
        NA_FENCE(); NA_KCOMP(kB, 7);
    } else {
#pragma unroll
        for (int T = 0; T < 16; ++T) acc[T] = (f32x4){-1e30f, -1e30f, -1e30f, -1e30f};
        NA_KLOAD(kA, 4);
        NA_KLOAD(kB, 5); NA_FENCE(); NA_KCOMP(kA, 4);
        NA_KLOAD(kA, 6); NA_FENCE(); NA_KCOMP(kB, 5);
        NA_KLOAD(kB, 7); NA_FENCE(); NA_KCOMP(kA, 6);
        NA_FENCE(); NA_KCOMP(kB, 7);
    }
    const bf16_t* vnb = VTL + ((size_t)((b * 8 + h) * 64 + l16) * 64 + row0) * 96 + (col0 / 4 + g) * 8;
    const bf16_t* vcx = VTC + (size_t)((b * 8 + h) * 64 + l16) * 8 * 32 + g * 8;
    bf16x8 vA[8], vB[8];
#define NA_VLOAD(buf, PB) do { _Pragma("unroll") for (int u_ = 0; u_ < 2; ++u_) { const int m_ = 2 * (PB) + u_; \
        _Pragma("unroll") for (int dt_ = 0; dt_ < 4; ++dt_) buf[4 * u_ + dt_] = *(const bf16x8*)(m_ < 8 ? vnb + (size_t)(dt_ * 16 * 64 + m_) * 96 : vcx + (size_t)dt_ * 16 * 8 * 32 + (m_ - 8) * 32); } } while (0)
#define NA_VCOMP(buf, PB) do { _Pragma("unroll") for (int u_ = 0; u_ < 2; ++u_) { const int m_ = 2 * (PB) + u_; const bf16x8 pf_ = pack8(acc[2 * m_], acc[2 * m_ + 1]); \
        _Pragma("unroll") for (int dt_ = 0; dt_ < 4; ++dt_) o[dt_] = __builtin_amdgcn_mfma_f32_16x16x32_bf16(buf[4 * u_ + dt_], pf_, o[dt_], 0, 0, 0); } } while (0)
    if (lat) { NA_VLOAD(vA, 0); } else { NA_VLOAD(vA, 4); }
    NA_FENCE();
    float mx = -1e30f;
#pragma unroll
    for (int T = 0; T < 32; ++T) mx = fmaxf(fmaxf(fmaxf(acc[T][0], acc[T][1]), fmaxf(acc[T][2], acc[T][3])), mx);
    mx = fmaxf(mx, xor16_f(mx)); mx = max_x32(mx);
    float lsum = 0.f;
#pragma unroll
    for (int T = 0; T < 32; ++T) {
#pragma unroll
        for (int q = 0; q < 4; ++q) { const float pv = __expf(acc[T][q] - mx); acc[T][q] = pv; lsum += pv; } }
    lsum += xor16_f(lsum); lsum = sum_x32(lsum);
    const float inv = 1.0f / lsum;
    f32x4 o[4] = {zero4, zero4, zero4, zero4};
    if (lat) { NA_VLOAD(vB, 1); } else { NA_VLOAD(vB, 5); }
    NA_FENCE();
    if (lat) {
        NA_VCOMP(vA, 0); NA_VLOAD(vA, 2); NA_FENCE();
        NA_VCOMP(vB, 1); NA_VLOAD(vB, 3); NA_FENCE();
        NA_VCOMP(vA, 2); NA_VLOAD(vA, 4); NA_FENCE();
        NA_VCOMP(vB, 3); NA_VLOAD(vB, 5); NA_FENCE();
    }
    NA_VCOMP(vA, 4); NA_VLOAD(vA, 6); NA_FENCE();
    NA_VCOMP(vB, 5); NA_VLOAD(vB, 7); NA_FENCE();
    NA_VCOMP(vA, 6);
    NA_VCOMP(vB, 7);
#undef NA_KLOAD
#undef NA_KCOMP
#undef NA_VLOAD
#undef NA_VCOMP
#undef NA_FENCE
#pragma unroll
    for (int dt = 0; dt < 4; ++dt) { u32x2 w; w.x = pk_bf16(o[dt][0] * inv, o[dt][1] * inv); w.y = pk_bf16(o[dt][2] * inv, o[dt][3] * inv);
        *(u32x2*)(MIX + (size_t)gq * 2048 + 1024 + h * 64 + dt * 16 + 4 * g) = w; }
}
__device__ __forceinline__ void na_phase(const Ctx& F, const LayerW& W, unsigned char* ws, int blk, int nblk, int ntile) {
    LAS float* sBias = (LAS float*)(F.lds + F.wave * 2048);
    __syncthreads();
    for (int idx = F.lane; idx < 465; idx += 64) sBias[idx] = W.rpb[F.wave * 465 + idx];
    asm volatile("" ::: "memory");
    for (int tile = blk; tile < ntile; tile += nblk) na_tile(F, ws, sBias, tile);
}

__device__ __forceinline__ void phase_finish(const Ctx& F, const LayerW& W, unsigned char* ws, const bf16_t* GUPT, int ntok) {
    const bf16_t* P = (const bf16_t*)(ws + WS_P); bf16_t* MIX = (bf16_t*)(ws + WS_MIX);
    const bf16_t* RWY = (const bf16_t*)(ws + WS_RWY); const float* BON = (const float*)(ws + WS_BON); const float* YS = (const float*)(ws + WS_YS);
    const f32x4 z4 = {0.f, 0.f, 0.f, 0.f};
    for (int task = F.bid * 8 + F.wave; task < (ntok / 16) * 8; task += F.G * 8) {
        int ln = F.lane; asm volatile("" : "+v"(ln));
        const int l16 = ln & 15, g = ln >> 4, h = task & 7, tok = (task >> 3) * 16 + l16;
        const bf16_t* Pr = P + (size_t)tok * PTP;
        bf16x8 sg[4];
#pragma unroll
        for (int ks = 0; ks < 4; ++ks) { const u32x4 q = *(const u32x4*)(Pr + B_GD + 32 * ks + 8 * g); union { bf16x8 v; unsigned u[4]; } s;
#pragma unroll
            for (int e = 0; e < 4; ++e) s.u[e] = pk_bf16(sigmoidf_(bflo(q[e])), sigmoidf_(bfhi(q[e])));
            sg[ks] = s.v; }
        f32x4 y[4]; float s1 = 0.f;
#pragma unroll
        for (int m = 0; m < 4; ++m) { const int co = h * 64 + 16 * m + 4 * g;
            const u32x2 a = *(const u32x2*)(RWY + (size_t)tok * 512 + co), bq = *(const u32x2*)(RWY + ((size_t)NTOK + tok) * 512 + co);
            y[m] = (f32x4){bflo(a.x) + bflo(bq.x), bfhi(a.x) + bfhi(bq.x), bflo(a.y) + bflo(bq.y), bfhi(a.y) + bfhi(bq.y)};
            s1 += (y[m][0] + y[m][1]) + (y[m][2] + y[m][3]); }
        s1 += xor16_f(s1); s1 = sum_x32(s1);
        const float mu = s1 * (1.f / 64.f); float s2 = 0.f;
#pragma unroll
        for (int m = 0; m < 4; ++m) { y[m] = y[m] - mu; s2 += (y[m][0] * y[m][0] + y[m][1] * y[m][1]) + (y[m][2] * y[m][2] + y[m][3] * y[m][3]); }
        s2 += xor16_f(s2); s2 = sum_x32(s2);
        const float rs = rsqrtf(s2 * (1.f / 64.f) + 64e-5f);
        const float bon = BON[(size_t)tok * 8 + h] + BON[((size_t)NTOK + tok) * 8 + h];
#pragma unroll
        for (int m = 0; m < 4; ++m) { const int co = h * 64 + 16 * m + 4 * g;
            f32x4 ga = z4;
#pragma unroll
            for (int ks = 0; ks < 4; ++ks) ga = __builtin_amdgcn_mfma_f32_16x16x32_bf16(*(const bf16x8*)(GUPT + (size_t)(h * 64 + 16 * m + l16) * 128 + 32 * ks + 8 * g), sg[ks], ga, 0, 0, 0);
            const float4 lw = *(const float4*)(W.rw_lnw + co), lb = *(const float4*)(W.rw_lnb + co); const u32x2 vq = *(const u32x2*)(Pr + B_V + co);
            const float o0 = (y[m][0] * rs * lw.x + lb.x + bon * bflo(vq.x)) * ga[0], o1 = (y[m][1] * rs * lw.y + lb.y + bon * bfhi(vq.x)) * ga[1];
            const float o2 = (y[m][2] * rs * lw.z + lb.z + bon * bflo(vq.y)) * ga[2], o3 = (y[m][3] * rs * lw.w + lb.w + bon * bfhi(vq.y)) * ga[3];
            u32x2 o; o.x = pk_bf16(o0, o1); o.y = pk_bf16(o2, o3);
            *(u32x2*)(MIX + (size_t)tok * 2048 + 512 + co) = o; }
    }
    for (int tok = F.bid * 8 + F.wave; tok < ntok; tok += F.G * 8) {
        const int c0 = F.lane * 8;
        float ys[8], z[8], gw[8];
        load8f(YS + (size_t)tok * 512 + c0, ys); unpack8(*(const u32x4*)(P + (size_t)tok * PTP + D_Z + c0), z); load8f(W.s_norm + c0, gw);
        float ss = 0.f;
#pragma unroll
        for (int e = 0; e < 8; ++e) { ys[e] *= siluf_(z[e]); ss += ys[e] * ys[e]; }
        ss = wave_sum(ss);
        const float rs = rsqrtf(ss * (1.f / 512.f) + 1e-6f);
#pragma unroll
        for (int e = 0; e < 8; ++e) ys[e] = ys[e] * rs * gw[e];
        *(u32x4*)(MIX + (size_t)tok * 2048 + 1536 + c0) = pack8f(ys);
    }
}

constexpr int RADIX_LOW_BIT = 10;
constexpr int RADIX_STEPS = 14;
__device__ __forceinline__ unsigned ordkey(float x) { const unsigned u = __float_as_uint(x); return (u & 0x80000000u) ? ~u : (u | 0x80000000u); }
template <int CTRL> __device__ __forceinline__ int dpp_i0(int v) { return __builtin_amdgcn_update_dpp(0, v, CTRL, 0xF, 0xF, true); }
__device__ __forceinline__ int rowscan_incl(int x) { x += dpp_i0<0x111>(x); x += dpp_i0<0x112>(x); x += dpp_i0<0x114>(x); x += dpp_i0<0x118>(x); return x; }
__device__ __forceinline__ void phase_scores(const Ctx& F, unsigned char* ws, int layer, int ntok) {
    const bf16_t* Q = (const bf16_t*)(ws + WS_P); const bf16_t* KEYS = (const bf16_t*)(ws + WS_KEYS) + (size_t)layer * 8 * 2 * 128 * 128;
    int* IDS = (int*)(ws + WS_IDS); float* GATES = (float*)(ws + WS_GATES);
    LAS bf16_t* sK = (LAS bf16_t*)F.lds;
    LAS float* sVv = (LAS float*)(F.lds + 2 * 128 * 136 * 2 + F.wave * 5120);
    LAS int* sVi = (LAS int*)(sVv + 512);
    const int ntg = ntok / 128, ntask = 8 * ntg;
    const int l16 = F.lane & 15, g = F.lane >> 4;
    const f32x4 z4 = {0.f, 0.f, 0.f, 0.f};
    int cur_h = -1;
    for (int task = F.bid; task < ntask; task += F.G) {
        const int h = task / ntg, tg = task % ntg;
        if (h != cur_h) { __syncthreads();
#pragma unroll
            for (int q = 0; q < 8; ++q) { const int v = F.tid + 512 * q, row = v >> 4, part = v & 15;
                *(LAS u32x4*)(sK + row * 136 + part * 8) = *(const u32x4*)(KEYS + ((size_t)h * 256 + row) * 128 + part * 8); }
            cur_h = h; __syncthreads(); }
        const int t0 = tg * 128 + F.wave * 16;
#pragma unroll 1
        for (int p = 0; p < 2; ++p) {
            bf16x8 qf[4];
#pragma unroll
            for (int ks = 0; ks < 4; ++ks) qf[ks] = *(const bf16x8*)(Q + (size_t)(t0 + l16) * 2048 + h * 256 + p * 128 + 32 * ks + 8 * g);
            f32x4 acc[8];
#pragma unroll
            for (int kt = 0; kt < 8; ++kt) { f32x4 a = z4;
#pragma unroll
                for (int ks = 0; ks < 4; ++ks) a = __builtin_amdgcn_mfma_f32_16x16x32_bf16(qf[ks], *(const LAS bf16x8*)(sK + (p * 128 + 16 * kt + l16) * 136 + 32 * ks + 8 * g), a, 0, 0, 0);
                acc[kt] = a; }
            float lo0, lo1, lo2, lo3, hi0, hi1, hi2, hi3;
            { float m0 = acc[0][0], m1 = acc[0][1], m2 = acc[0][2], m3 = acc[0][3];
#pragma unroll
              for (int kt = 1; kt < 8; ++kt) { m0 = fmaxf(m0, acc[kt][0]); m1 = fmaxf(m1, acc[kt][1]); m2 = fmaxf(m2, acc[kt][2]); m3 = fmaxf(m3, acc[kt][3]); }
              hi0 = max16(m0); hi1 = max16(m1); hi2 = max16(m2); hi3 = max16(m3);
              lo0 = -max16(-m0); lo1 = -max16(-m1); lo2 = -max16(-m2); lo3 = -max16(-m3); }
#pragma unroll 1
            for (int it = 0; it < RADIX_STEPS; ++it) {
                const float c0 = 0.5f * (lo0 + hi0), c1 = 0.5f * (lo1 + hi1), c2 = 0.5f * (lo2 + hi2), c3 = 0.5f * (lo3 + hi3); int n0 = 0, n1 = 0, n2 = 0, n3 = 0;
#pragma unroll
                for (int kt = 0; kt < 8; ++kt) { n0 += acc[kt][0] >= c0; n1 += acc[kt][1] >= c1; n2 += acc[kt][2] >= c2; n3 += acc[kt][3] >= c3; }
                const bool k0 = sum16((float)n0) >= 16.f, k1 = sum16((float)n1) >= 16.f, k2 = sum16((float)n2) >= 16.f, k3 = sum16((float)n3) >= 16.f;
                lo0 = k0 ? c0 : lo0; hi0 = k0 ? hi0 : c0; lo1 = k1 ? c1 : lo1; hi1 = k1 ? hi1 : c1; lo2 = k2 ? c2 : lo2; hi2 = k2 ? hi2 : c2; lo3 = k3 ? c3 : lo3; hi3 = k3 ? hi3 : c3; }
#pragma unroll
            for (int r = 0; r < 4; ++r) { const float T = r == 0 ? lo0 : (r == 1 ? lo1 : (r == 2 ? lo2 : lo3));
                int cl = 0;
#pragma unroll
                for (int kt = 0; kt < 8; ++kt) cl += acc[kt][r] >= T;
                int rank = rowscan_incl(cl) - cl;
                LAS float* dv = sVv + ((4 * g + r) * 2 + p) * 16; LAS int* di = sVi + ((4 * g + r) * 2 + p) * 16;
#pragma unroll
                for (int kt = 0; kt < 8; ++kt) { const bool sel = acc[kt][r] >= T;
                    if (sel && rank < 16) { dv[rank] = acc[kt][r]; di[rank] = 16 * kt + l16; }
                    rank += sel ? 1 : 0; } }
        }
        asm volatile("" ::: "memory");
#pragma unroll 1
        for (int r = 0; r < 4; ++r) { const int tk = 4 * g + r;
            LAS float* sS = (LAS float*)(sVi + 512);
            LAS int* sI = (LAS int*)(sS + 128);
#pragma unroll
            for (int p = 0; p < 2; ++p) { const float v = sVv[(tk * 2 + p) * 16 + l16]; const int ix = sVi[(tk * 2 + p) * 16 + l16];
                const unsigned key = (ordkey(v) & ~15u) | (unsigned)(15 - l16); int rk = 0;
#pragma unroll
                for (int q = 0; q < 4; ++q) { const f32x4 o = *(const LAS f32x4*)(sVv + (tk * 2 + p) * 16 + 4 * q);
#pragma unroll
                    for (int e = 0; e < 4; ++e) rk += ((ordkey(o[e]) & ~15u) | (unsigned)(15 - (4 * q + e))) > key; }
                sS[(g * 2 + p) * 16 + rk] = v; sI[(g * 2 + p) * 16 + rk] = ix; }
            asm volatile("" ::: "memory");
            float cv[4]; int pi[4], pj[4];
#pragma unroll
            for (int q = 0; q < 4; ++q) { const int e = l16 + 16 * q; int i, j;
                if (e < 16) { i = 0; j = e; } else if (e < 24) { i = 1; j = e - 16; } else if (e < 29) { i = 2; j = e - 24; } else if (e < 33) { i = 3; j = e - 29; }
                else if (e < 36) { i = 4; j = e - 33; } else if (e < 42) { i = 5 + ((e - 36) >> 1); j = (e - 36) & 1; } else { i = 8 + (e - 42); j = 0; }
                const bool ok = e < 50; i = ok ? i : 15; j = ok ? j : 15;
                pi[q] = i; pj[q] = j; cv[q] = ok ? sS[(g * 2) * 16 + i] + sS[(g * 2 + 1) * 16 + j] : -3.0e38f; }
            float lo = sS[(g * 2) * 16 + 15] + sS[(g * 2 + 1) * 16], hi = sS[(g * 2) * 16] + sS[(g * 2 + 1) * 16];
            const float mx = hi;
#pragma unroll 1
            for (int it = 0; it < RADIX_STEPS; ++it) { const float cm = 0.5f * (lo + hi); int n = 0;
#pragma unroll
                for (int q = 0; q < 4; ++q) n += cv[q] >= cm;
                const bool kk = sum16((float)n) >= 16.f; lo = kk ? cm : lo; hi = kk ? hi : cm; }
            int cl = 0; float es = 0.f;
#pragma unroll
            for (int q = 0; q < 4; ++q) { const bool sel = cv[q] >= lo; cl += sel; es += sel ? __expf(cv[q] - mx) : 0.f; }
            int rank = rowscan_incl(cl) - cl;
            const float einv = 1.0f / sum16(es);
            const size_t ob = (size_t)(t0 + tk) * 128 + h * 16;
#pragma unroll
            for (int q = 0; q < 4; ++q) { const bool sel = cv[q] >= lo;
                if (sel && rank < 16) { IDS[ob + rank] = sI[(g * 2) * 16 + pi[q]] * 128 + sI[(g * 2 + 1) * 16 + pj[q]]; GATES[ob + rank] = __expf(cv[q] - mx) * einv; }
                rank += sel ? 1 : 0; }
            asm volatile("" ::: "memory");
        }
        asm volatile("" ::: "memory");
    }
}

struct XInfo { int xi, nx, rank, nloc; };
__device__ __forceinline__ void fp8x16_to_f32(const u32x4 q, float (&f)[16]) {
#pragma unroll
    for (int w = 0; w < 4; ++w) { const auto a = __builtin_amdgcn_cvt_pk_f32_fp8((int)q[w], false); const auto b = __builtin_amdgcn_cvt_pk_f32_fp8((int)q[w], true);
        f[4 * w] = a[0]; f[4 * w + 1] = a[1]; f[4 * w + 2] = b[0]; f[4 * w + 3] = b[1]; }
}
typedef long i64_t;
template <int IDMASK> __device__ __forceinline__ void phase_experts_u(const Ctx& F, unsigned char* ws, int layer, int ntok, const XInfo X, float* PART) {
    const bf16_t* H = (const bf16_t*)(ws + WS_XN); const unsigned char* PU8 = ws + WS_PU + (size_t)layer * 16384 * 2048;
    const int* IDS = (const int*)(ws + WS_IDS);
    const int e8 = F.lane >> 3, c = F.lane & 7, l16 = F.lane & 15, g = F.lane >> 4;
    const int tfirst = X.rank * 8 + F.wave, tstride = X.nloc * 8;
    const int nk = tfirst < ntok ? (ntok - tfirst + tstride - 1) / tstride : 0;
    const f32x4 z4 = {0.f, 0.f, 0.f, 0.f};
    LAS unsigned char* buf = F.lds + F.wave * 12288; LAS float* res = (LAS float*)(buf + 8192);
    const int woff = e8 * 128 + c * 16;
    const int srcoff = 16 * (c ^ e8);
    const int roff0 = l16 * 128 + (((2 * g) ^ (l16 & 7)) * 16), roff1 = l16 * 128 + (((2 * g + 1) ^ (l16 & 7)) * 16);
#define EU_TOK(k) (tfirst + min((k), nk - 1) * tstride)
#define EU_LOADI(I, k) do { const int* ip_ = IDS + (size_t)EU_TOK(k) * 128 + e8; _Pragma("unroll") for (int q_ = 0; q_ < 16; ++q_) I[q_] = ip_[8 * q_]; } while (0)
#define EU_LOADX(HX, k) do { const u32x4* hp_ = (const u32x4*)(H + (size_t)EU_TOK(k) * 2048 + s * 128 + 32 * g); HX[0] = hp_[0]; HX[1] = hp_[1]; HX[2] = hp_[2]; HX[3] = hp_[3]; } while (0)
#define EU_ISSUE(Q, I, hf) do { _Pragma("unroll") for (int i_ = 0; i_ < 8; ++i_) Q[i_] = *(const u32x4*)(PU8 + ((size_t)s * 16384 + I[(hf) * 8 + i_]) * 128 + srcoff); } while (0)
#define EU_CONSUME(Q, hf, slot) do { _Pragma("unroll") for (int i_ = 0; i_ < 8; ++i_) *(LAS u32x4*)(buf + i_ * 1024 + woff) = Q[i_]; \
        asm volatile("" ::: "memory"); \
        _Pragma("unroll") for (int q_ = 0; q_ < 4; ++q_) { const u32x4 p0_ = *(const LAS u32x4*)(buf + q_ * 2048 + roff0), p1_ = *(const LAS u32x4*)(buf + q_ * 2048 + roff1); f32x4 a_ = z4; \
            a_ = __builtin_amdgcn_mfma_f32_16x16x32_fp8_fp8(((i64_t)p0_[1] << 32) | (i64_t)p0_[0], hb[0], a_, 0, 0, 0); \
            a_ = __builtin_amdgcn_mfma_f32_16x16x32_fp8_fp8(((i64_t)p0_[3] << 32) | (i64_t)p0_[2], hb[1], a_, 0, 0, 0); \
            a_ = __builtin_amdgcn_mfma_f32_16x16x32_fp8_fp8(((i64_t)p1_[1] << 32) | (i64_t)p1_[0], hb[2], a_, 0, 0, 0); \
            a_ = __builtin_amdgcn_mfma_f32_16x16x32_fp8_fp8(((i64_t)p1_[3] << 32) | (i64_t)p1_[2], hb[3], a_, 0, 0, 0); \
            if (l16 == (hf) * 4 + q_) *(LAS f32x4*)(res + (slot) * 128 + 16 * ((hf) * 4 + q_) + 4 * g) = a_; } \
        asm volatile("" ::: "memory"); } while (0)
    for (int s = X.xi; s < 16; s += X.nx) {
        if (nk == 0) continue;
        int id[2][16]; u32x4 hx[2][4]; u32x4 qa[8], qb[8];
        EU_LOADI(id[0], 0); EU_LOADX(hx[0], 0); EU_ISSUE(qa, id[0], 0); EU_ISSUE(qb, id[0], 1);
        EU_LOADI(id[1], 1);
        for (int k0 = 0; k0 < nk; k0 += 8) {
#pragma unroll
            for (int j = 0; j < 8; ++j) { const int k = k0 + j;
                i64_t hb[4];
#pragma unroll
                for (int m = 0; m < 4; ++m) { const u32x4 v = hx[j & 1][m];
                    int lo = __builtin_amdgcn_cvt_pk_fp8_f32(bflo(v[0]), bfhi(v[0]), 0, false); lo = __builtin_amdgcn_cvt_pk_fp8_f32(bflo(v[1]), bfhi(v[1]), lo, true);
                    int hi = __builtin_amdgcn_cvt_pk_fp8_f32(bflo(v[2]), bfhi(v[2]), 0, false); hi = __builtin_amdgcn_cvt_pk_fp8_f32(bflo(v[3]), bfhi(v[3]), hi, true);
                    hb[m] = ((i64_t)(unsigned)hi << 32) | (i64_t)(unsigned)lo; }
                EU_LOADX(hx[(j + 1) & 1], k + 1);
                EU_LOADI(id[j & 1], k + 2);
                EU_CONSUME(qa, 0, j);
                EU_ISSUE(qa, id[(j + 1) & 1], 0);
                EU_CONSUME(qb, 1, j);
                EU_ISSUE(qb, id[(j + 1) & 1], 1);
            }
            { const int u = F.lane >> 3, jj = F.lane & 7, ku = k0 + u;
              if (ku < nk) { float* dst = PART + ((size_t)s * NTOK + tfirst + ku * tstride) * 128 + 16 * jj;
#pragma unroll
                  for (int w = 0; w < 4; ++w) *(f32x4*)(dst + 4 * w) = *(const LAS f32x4*)(res + u * 128 + 16 * jj + 4 * w); }
              asm volatile("" ::: "memory"); }
        }
    }
#undef EU_TOK
#undef EU_LOADI
#undef EU_LOADX
#undef EU_ISSUE
#undef EU_CONSUME
}
__device__ __forceinline__ void phase_experts_combine(const Ctx& F, unsigned char* ws, int ntok) {
    const float* PART = (const float*)(ws + WS_PART); float* GATES = (float*)(ws + WS_GATES);
    for (int idx = F.bid * 512 + F.tid; idx < ntok * 32; idx += F.G * 512) {
        float4 a = make_float4(0.f, 0.f, 0.f, 0.f);
#pragma unroll
        for (int s = 0; s < 16; ++s) { const float4 v = *(const float4*)(PART + (size_t)s * NTOK * 128 + (size_t)idx * 4); a.x += v.x; a.y += v.y; a.z += v.z; a.w += v.w; }
        float4 g = *(const float4*)(GATES + (size_t)idx * 4);
        g.x *= geluf_(a.x * (1.0f / PEER_U_SCALE)); g.y *= geluf_(a.y * (1.0f / PEER_U_SCALE)); g.z *= geluf_(a.z * (1.0f / PEER_U_SCALE)); g.w *= geluf_(a.w * (1.0f / PEER_U_SCALE));
        *(float4*)(GATES + (size_t)idx * 4) = g;
    }
}
__device__ __forceinline__ void phase_experts_v(const Ctx& F, unsigned char* ws, float* out, float* CTXS, int layer, int ntok, const XInfo X) {
    const unsigned char* PV8 = ws + WS_PV + (size_t)layer * 16384 * 2048;
    const int* IDS = (const int*)(ws + WS_IDS); const float* COEF = (const float*)(ws + WS_GATES); const float* MOD = (const float*)(ws + WS_MOD);
    const int e8 = F.lane >> 3, c = F.lane & 7;
    const int tfirst = X.rank * 8 + F.wave, tstride = X.nloc * 8;
    const int nk = tfirst < ntok ? (ntok - tfirst + tstride - 1) / tstride : 0;
    LAS float* res = (LAS float*)(F.lds + F.wave * 4096);
#define EV_TOK(k) (tfirst + min((k), nk - 1) * tstride)
#define EV_LOADI(I, k) do { const u32x4* ip_ = (const u32x4*)(IDS + (size_t)EV_TOK(k) * 128 + e8 * 16); I[0] = ip_[0]; I[1] = ip_[1]; I[2] = ip_[2]; I[3] = ip_[3]; } while (0)
#define EV_LOADC(C, k) do { const u32x4* cp_ = (const u32x4*)(COEF + (size_t)EV_TOK(k) * 128 + e8 * 16); C[0] = cp_[0]; C[1] = cp_[1]; C[2] = cp_[2]; C[3] = cp_[3]; } while (0)
#define EV_ROW(id) (*(const u32x4*)(PV8 + ((size_t)s * 16384 + (id)) * 128 + c * 16))
#define EV_ISSUE(Q, I, hf) do { _Pragma("unroll") for (int i_ = 0; i_ < 8; ++i_) Q[i_] = EV_ROW(I[(hf) * 2 + (i_ >> 2)][i_ & 3]); } while (0)
#define EV_HALF(Q, C, hf) do { _Pragma("unroll") for (int i_ = 0; i_ < 8; ++i_) { const float cf_ = __uint_as_float(C[(hf) * 2 + (i_ >> 2)][i_ & 3]); const f32x2_t c2_ = {cf_, cf_}; \
            _Pragma("unroll") for (int w_ = 0; w_ < 4; ++w_) { const f32x2_t lo_ = __builtin_amdgcn_cvt_pk_f32_fp8((int)Q[i_][w_], false), hi_ = __builtin_amdgcn_cvt_pk_f32_fp8((int)Q[i_][w_], true); \
                ac2[2 * w_] = lo_ * c2_ + ac2[2 * w_]; ac2[2 * w_ + 1] = hi_ * c2_ + ac2[2 * w_ + 1]; } } } while (0)
    for (int s = X.xi; s < 16; s += X.nx) {
        if (nk == 0) continue;
        u32x4 id[2][4], cf[2][4]; u32x4 qa[8], qb[8];
        EV_LOADI(id[0], 0); EV_LOADC(cf[0], 0); EV_ISSUE(qa, id[0], 0); EV_ISSUE(qb, id[0], 1);
        EV_LOADI(id[1], 1);
        for (int k0 = 0; k0 < nk; k0 += 8) {
#pragma unroll
            for (int j = 0; j < 8; ++j) { const int k = k0 + j;
                f32x2_t ac2[8];
#pragma unroll
                for (int e = 0; e < 8; ++e) ac2[e] = (f32x2_t){0.f, 0.f};
                EV_LOADC(cf[(j + 1) & 1], k + 1);
                EV_HALF(qa, cf[j & 1], 0);
                EV_ISSUE(qa, id[(j + 1) & 1], 0);
                EV_HALF(qb, cf[j & 1], 1);
                EV_ISSUE(qb, id[(j + 1) & 1], 1);
                EV_LOADI(id[j & 1], k + 2);
                float acc[16];
#pragma unroll
                for (int e = 0; e < 8; ++e) { acc[2 * e] = ac2[e][0]; acc[2 * e + 1] = ac2[e][1]; }
#pragma unroll
                for (int e = 0; e < 16; ++e) { float v = acc[e]; v += dpp_f<0x128>(v); v += xor16_f(v); acc[e] = sum_x32(v); }
                if (e8 == 0) {
#pragma unroll
                    for (int w = 0; w < 4; ++w) *(LAS f32x4*)(res + j * 128 + c * 16 + 4 * w) = (f32x4){acc[4 * w], acc[4 * w + 1], acc[4 * w + 2], acc[4 * w + 3]}; }
                asm volatile("" ::: "memory");
            }
            { const int u = F.lane >> 3, jj = F.lane & 7, ku = k0 + u;
              if (ku < nk) { const int tu = tfirst + ku * tstride;
                  const bool isctx = tu >= NLAT; const int vv = isctx ? 4 : (tu >> 12);
                  float* xr = (isctx ? CTXS + (size_t)(tu - NLAT) * 2048 : out + (size_t)tu * 2048) + s * 128 + jj * 16;
                  const float* m5 = MOD + ((size_t)layer * 5 + vv) * 12288 + 5 * 2048 + s * 128 + jj * 16;
#pragma unroll
                  for (int w = 0; w < 4; ++w) { float4 x = *(const float4*)(xr + 4 * w); const float4 m = *(const float4*)(m5 + 4 * w); const f32x4 a = *(const LAS f32x4*)(res + u * 128 + jj * 16 + 4 * w);
                      x.x += m.x * a[0]; x.y += m.y * a[1]; x.z += m.z * a[2]; x.w += m.w * a[3]; *(float4*)(xr + 4 * w) = x; } }
              asm volatile("" ::: "memory"); }
        }
    }
#undef EV_TOK
#undef EV_LOADI
#undef EV_LOADC
#undef EV_ROW
#undef EV_ISSUE
#undef EV_HALF
}

struct Params { const float* in[N_IN]; float* out; unsigned char* ws; };

__device__ __forceinline__ LayerW make_w(ka_t in, int l) {
    LayerW W;
    W.sc_w = in[I_SCW] + (size_t)l * 3 * 512; W.rw_w0 = in[I_RW0] + (size_t)l * 2 * 512; W.rw_wup = in[I_RWUP] + (size_t)l * 2 * 64 * 512;
    W.rw_a0 = in[I_RA0] + (size_t)l * 2 * 512; W.rw_aup = in[I_RAUP] + (size_t)l * 2 * 64 * 512; W.rw_gup = in[I_RGUP] + (size_t)l * 128 * 512;
    W.rw_kk = in[I_RKK] + (size_t)l * 512; W.rw_ka = in[I_RKA] + (size_t)l * 512; W.rw_rk = in[I_RRK] + (size_t)l * 512;
    W.rw_lnw = in[I_RLNW] + (size_t)l * 512; W.rw_lnb = in[I_RLNB] + (size_t)l * 512;
    W.na_q = in[I_NAQ] + (size_t)l * 64; W.na_k = in[I_NAK] + (size_t)l * 64; W.rpb = in[I_RPB] + (size_t)l * 8 * 15 * 31;
    W.s_cw = in[I_SCONVW] + (size_t)l * 3 * 1024; W.s_cb = in[I_SCONVB] + (size_t)l * 1024; W.s_dtb = in[I_SDTB] + (size_t)l * 16; W.s_alog = in[I_SALOG] + (size_t)l * 16;
    W.s_d = in[I_SD] + (size_t)l * 8; W.s_norm = in[I_SNORM] + (size_t)l * 512;
    return W;
}

__global__ void __launch_bounds__(512, 2) hybrid_fwd(Params p) {
    extern __shared__ __attribute__((aligned(16))) unsigned char shm[];
    Ctx F; F.lds = (LAS unsigned char*)shm; F.tid = threadIdx.x; F.lane = F.tid & 63; F.wave = __builtin_amdgcn_readfirstlane(F.tid >> 6); F.bid = blockIdx.x; F.G = gridDim.x;
    volatile LAS unsigned* bst = (volatile LAS unsigned*)(F.lds + LDS_BAR_OFF);
    if (F.tid < 4) bst[F.tid] = 0u;
    __syncthreads();
    (void)xcd_barrier_post((unsigned*)(p.ws + WS_CTL), bst);
    volatile LAS int* lxi = (volatile LAS int*)(F.lds + LDS_XI_OFF);
    if (F.tid == 0) lxi[2] = (int)xb_add((unsigned*)(p.ws + WS_CTL) + CTL_TICKET + 64 * xb_xcc_id(), 1u);
#define RPT_PHASE(id, ...) do { __VA_ARGS__ if (RPT == (id)) { GRID_BAR(); PH_BEGIN(); __VA_ARGS__ } } while (0)
#define GRID_BAR() do { ka_t kb_ = (ka_t)__builtin_amdgcn_kernarg_segment_ptr(); asm volatile("" : "+s"(kb_)); unsigned xx_ = xb_xcc_id(); asm volatile("" : "+s"(xx_)); \
        XcdBarrier b_; b_.bar = (unsigned*)((unsigned char*)kb_[N_IN + 1] + WS_CTL); b_.x = xx_; b_.st = (volatile LAS unsigned*)(F.lds + LDS_BAR_OFF); xcd_barrier(b_); } while (0)
    ka_t in; unsigned char* ws; float* out;
#define PH_BEGIN() do { int t_ = threadIdx.x; asm volatile("; PHASE_MARK" : "+v"(t_)); F.tid = t_; F.lane = t_ & 63; F.wave = __builtin_amdgcn_readfirstlane(t_ >> 6); \
        int b_ = blockIdx.x, g_ = gridDim.x; asm volatile("" : "+s"(b_), "+s"(g_)); F.bid = b_; F.G = g_; \
        ka_t k_ = (ka_t)__builtin_amdgcn_kernarg_segment_ptr(); asm volatile("" : "+s"(k_)); in = k_; \
        out = (float*)in[N_IN]; ws = (unsigned char*)in[N_IN + 1]; } while (0)

    PH_BEGIN();
    RPT_PHASE(1, phase_prologue(F, in, ws););
    GRID_BAR();
    if (F.tid == 0) {
        const unsigned* bw = (const unsigned*)(ws + WS_CTL); const unsigned myx = xb_xcc_id(); int xi = 0, nx = 0, nloc = 1;
        for (unsigned j = 0; j < 16; ++j) { const unsigned cnt = xb_ld((unsigned*)&bw[XB_XCNT(j)]); if (cnt > 0u) { if (j < myx) ++xi; ++nx; } if (j == myx) nloc = (int)cnt; }
        lxi[0] = xi; lxi[1] = nx > 0 ? nx : 1; lxi[3] = nloc > 0 ? nloc : 1; }
    __syncthreads();
    PH_BEGIN();
    phase_modreduce(F, in[I_BADA], (const float*)(ws + WS_MODP), (float*)(ws + WS_MOD));
    GRID_BAR();

#pragma unroll 1
    for (int l = 0; l < 2; ++l) {
        const int M = (l == 0) ? NTOK : NLAT;
        if (l == 0) { PH_BEGIN(); phase_norm(F, in[I_X], in[I_CTX], in[I_NMIX], (const float*)(ws + WS_MOD), 0, 1, (bf16_t*)(ws + WS_XN), NTOK); GRID_BAR(); }

        PH_BEGIN();
        RPT_PHASE(2, { pg8::Gemm g{(const bf16_t*)(ws + WS_XN), (const bf16_t*)(ws + WS_WIN) + (size_t)l * PTP * 2048, NTOK, PTP, 2048}; pg8::StaticOrder S; S.init(NTOK, PTP, F.G, F.bid);
          pg8::EpiBf16 E{(bf16_t*)(ws + WS_P), PTP}; pg8::gemm_phase<pg8::EpiBf16, pg8::StaticOrder>(F.lds, g, S, E, F.tid); });
        GRID_BAR();

        PH_BEGIN();
        { const LayerW W = make_w(in, l); phase_prep(F, W, ws);
            if (RPT == 31) phase_prep(F, W, ws);
            const bf16_t* WUPT = (const bf16_t*)(ws + WS_WUPT) + (size_t)l * 4 * 512 * 64;
            for (int rep = 0; rep < (RPT == 32 ? 2 : 1); ++rep) {
            for (int task = F.bid * 8 + F.wave; task < 4 * 8 * RW_NCHUNK; task += F.G * 8) rwkv_pre_task(F, W, ws, WUPT, task, 0);
            for (int task = F.bid * 8 + F.wave; task < 4 * 8 * RW_NCHUNK; task += F.G * 8) rwkv_pre_task(F, W, ws, WUPT, task, 1); } }
        GRID_BAR();

        PH_BEGIN();
        RPT_PHASE(4, { const LayerW W = make_w(in, l); for (int task = F.bid; task < 4 * 8 * NCH; task += F.G) ssd_task<false>(F, W, ws, task); });
        GRID_BAR();
        PH_BEGIN();
        phase_ssd_combine(F, ws);
        GRID_BAR();

        PH_BEGIN();
        { if (F.bid < 64) rwkv_scan(F, ws, F.bid);
        else { const LayerW W = make_w(in, l); const int blk = F.bid - 64, nblk = F.G - 64;
            for (int task = blk; task < 4 * 8 * NCH; task += nblk) ssd_task<true>(F, W, ws, task);
            na_phase(F, W, ws, blk, nblk, (l == 0) ? 1088 : 1024); } }
        if (RPT == 51) { GRID_BAR(); PH_BEGIN(); if (F.bid < 64) rwkv_scan(F, ws, F.bid); }
        if (RPT == 52) { GRID_BAR(); PH_BEGIN(); if (F.bid >= 64) { const LayerW W = make_w(in, l); const int blk = F.bid - 64, nblk = F.G - 64;
            for (int task = blk; task < 4 * 8 * NCH; task += nblk) ssd_task<true>(F, W, ws, task); } }
        if (RPT == 53) { GRID_BAR(); PH_BEGIN(); if (F.bid >= 64) { const LayerW W = make_w(in, l); const int blk = F.bid - 64, nblk = F.G - 64;
            na_phase(F, W, ws, blk, nblk, (l == 0) ? 1088 : 1024); } }
        GRID_BAR();

        PH_BEGIN();
        RPT_PHASE(6, { const LayerW W = make_w(in, l); phase_finish(F, W, ws, (const bf16_t*)(ws + WS_GUPT) + (size_t)l * 512 * 128, M); });
        GRID_BAR();

        PH_BEGIN();
        { pg8::Gemm g{(const bf16_t*)(ws + WS_MIX), (const bf16_t*)(ws + WS_WOUT) + (size_t)l * 2048 * 2048, M, 2048, 2048}; pg8::StaticOrder S; S.init(M, 2048, F.G, F.bid);
          float* CTXS = (float*)(ws + WS_CTXS);
          pg8::EpiResid E{l == 0 ? in[I_X] : out, l == 0 ? in[I_CTX] : CTXS, out, CTXS, (const float*)(ws + WS_MOD) + (size_t)l * 5 * 12288 + 2 * 2048};
          pg8::gemm_phase<pg8::EpiResid, pg8::StaticOrder>(F.lds, g, S, E, F.tid); }
        GRID_BAR();

        PH_BEGIN();
        RPT_PHASE(7, phase_norm(F, out, (const float*)(ws + WS_CTXS), in[I_NFFN] + (size_t)l * 2048, (const float*)(ws + WS_MOD) + (size_t)l * 5 * 12288, 3, 4, (bf16_t*)(ws + WS_XN), M););
        GRID_BAR();
        PH_BEGIN();
        RPT_PHASE(8, { pg8::Gemm g{(const bf16_t*)(ws + WS_XN), (const bf16_t*)(ws + WS_WQ) + (size_t)l * 2048 * 2048, M, 2048, 2048}; pg8::StaticOrder S; S.init(M, 2048, F.G, F.bid);
          pg8::EpiBf16 E{(bf16_t*)(ws + WS_P), 2048}; pg8::gemm_phase<pg8::EpiBf16, pg8::StaticOrder>(F.lds, g, S, E, F.tid); });
        GRID_BAR();
        PH_BEGIN();
        RPT_PHASE(9, phase_scores(F, ws, l, M););
        GRID_BAR();
        PH_BEGIN();
        RPT_PHASE(10, { XInfo X; X.xi = lxi[0]; X.nx = lxi[1]; X.rank = lxi[2]; X.nloc = lxi[3]; phase_experts_u<0x3fff>(F, ws, l, M, X, (float*)(ws + WS_PART)); });
        if (RPT == 101) { GRID_BAR(); PH_BEGIN(); XInfo X; X.xi = lxi[0]; X.nx = lxi[1]; X.rank = lxi[2]; X.nloc = lxi[3]; phase_experts_u<0x3ff>(F, ws, l, M, X, (float*)(ws + WS_P)); }
        if (RPT == 102) { GRID_BAR(); PH_BEGIN(); XInfo X; X.xi = lxi[0]; X.nx = lxi[1]; X.rank = lxi[2]; X.nloc = lxi[3]; phase_experts_u<0x3fff>(F, ws, l, M, X, (float*)(ws + WS_P)); }
        GRID_BAR();
        PH_BEGIN();
        phase_experts_combine(F, ws, M);
        GRID_BAR();
        PH_BEGIN();
        if (RPT == 11) { XInfo X; X.xi = lxi[0]; X.nx = lxi[1]; X.rank = lxi[2]; X.nloc = lxi[3]; phase_experts_v(F, ws, (float*)(ws + WS_P), (float*)(ws + WS_P) + (size_t)NLAT * 2048, l, M, X); GRID_BAR(); PH_BEGIN(); }
        { XInfo X; X.xi = lxi[0]; X.nx = lxi[1]; X.rank = lxi[2]; X.nloc = lxi[3]; phase_experts_v(F, ws, out, (float*)(ws + WS_CTXS), l, M, X); }
        if (l == 0) { GRID_BAR(); PH_BEGIN();
            phase_norm(F, out, (const float*)(ws + WS_CTXS), in[I_NMIX] + 2048, (const float*)(ws + WS_MOD) + (size_t)5 * 12288, 0, 1, (bf16_t*)(ws + WS_XN), NTOK); GRID_BAR(); }
    }
}

extern "C" void kernel_launch(void* const* d_in, const int* in_sizes, int n_in, void* d_out, int out_size, void* d_ws, size_t ws_size, hipStream_t stream) {
    static int grid = 0;
    if (grid == 0) {
        if (n_in != N_IN || out_size != NLAT * DM || ws_size < WS_END) { fprintf(stderr, "kernel_launch: unexpected shapes (n_in %d out %d ws %zu, need %zu)\n", n_in, out_size, ws_size, (size_t)WS_END); grid = -1; return; }
        int dev = 0, cus = 0, per_cu = 0;
        (void)hipGetDevice(&dev); (void)hipDeviceGetAttribute(&cus, hipDeviceAttributeMultiprocessorCount, dev);
        if (hipFuncSetAttribute((const void*)hybrid_fwd, hipFuncAttributeMaxDynamicSharedMemorySize, LDS_BYTES) != hipSuccess) { fprintf(stderr, "kernel_launch: hipFuncSetAttribute failed\n"); grid = -1; return; }
        (void)hipOccupancyMaxActiveBlocksPerMultiprocessor(&per_cu, (const void*)hybrid_fwd, 512, LDS_BYTES);
        (void)hipGetLastError();
        fprintf(stderr, "kernel_launch: %d CUs, occupancy query %d block(s)/CU, ws %zu B (need %zu)\n", cus, per_cu, ws_size, (size_t)WS_END);
        grid = cus;
        if (grid < 136) { fprintf(stderr, "kernel_launch: needs at least 136 CUs\n"); grid = -1; return; }
    }
    if (grid < 0) return;
    (void)hipMemsetAsync((char*)d_ws + WS_CTL, 0, 65536, stream);
    Params p{};
    for (int i = 0; i < N_IN; ++i) p.in[i] = (const float*)d_in[i];
    p.out = (float*)d_out; p.ws = (unsigned char*)d_ws;
    hipLaunchKernelGGL(hybrid_fwd, dim3(grid), dim3(512), LDS_BYTES, stream, p);
}
```

```cpp
#include <hip/hip_runtime.h>
#include <cstdio>
#include <cstdint>
#ifndef RPT
#define RPT 0
#endif

constexpr int DM = 2048, NBATCH = 4, SEQL = 4096, CTXL = 256, NLAT = NBATCH * SEQL, NCTX = NBATCH * CTXL, NTOK = NLAT + NCTX;
constexpr int PT = 6416, PTP = 6656;
constexpr int A_BG = 0, A_CG = 512, A_H = 1024;
constexpr int B_R = 1536, B_K = 2048, B_V = 2560, B_WD = 3072, B_AD = 3136, B_GD = 3200;
constexpr int C_Q = 3328, C_K = 3840, C_V = 4352;
constexpr int D_Z = 4864, D_X = 5376, D_DT = 6400;
constexpr int NPOS = CTXL + SEQL;
constexpr int NCH = 34;
constexpr int KSPL = 32;

enum { I_X = 0, I_C, I_CTX, I_CCTX, I_WADA, I_BADA, I_NMIX, I_NFFN, I_WIN, I_WOUT, I_SCW, I_RW0, I_RWUP, I_RA0, I_RAUP, I_RGUP, I_RKK, I_RKA, I_RRK, I_RLNW, I_RLNB,
       I_NAQ, I_NAK, I_RPB, I_SCONVW, I_SCONVB, I_SDTB, I_SALOG, I_SD, I_SNORM, I_PWQ, I_PKEYS, I_PU, I_PV, N_IN };

constexpr size_t WS_CTL   = 0;
constexpr size_t WS_ROPE  = 65536;
constexpr size_t WS_MODP  = WS_ROPE + 16384;
constexpr size_t WS_MOD   = WS_MODP + (size_t)KSPL * 2 * 5 * 12288 * 4;
constexpr size_t WS_WIN   = WS_MOD + (size_t)2 * 5 * 12288 * 4;
constexpr size_t WS_WOUT  = WS_WIN + (size_t)2 * PTP * DM * 2;
constexpr size_t WS_WQ    = WS_WOUT + (size_t)2 * DM * DM * 2;
constexpr size_t WS_KEYS  = WS_WQ + (size_t)2 * DM * DM * 2;
constexpr size_t WS_WUPT  = WS_KEYS + (size_t)2 * 8 * 2 * 128 * 128 * 2;
constexpr size_t WS_GUPT  = WS_WUPT + (size_t)2 * 4 * 512 * 64 * 2;
constexpr size_t WS_PU    = WS_GUPT + (size_t)2 * 512 * 128 * 2;
constexpr size_t WS_PV    = WS_PU + (size_t)2 * 16384 * DM;
constexpr size_t WS_P     = WS_PV + (size_t)2 * 16384 * DM;
constexpr size_t WS_MIX   = WS_P + (size_t)NTOK * PTP * 2;
constexpr size_t WS_CTXS  = WS_MIX + (size_t)NTOK * DM * 2;
constexpr size_t WS_XN    = WS_CTXS + (size_t)NCTX * DM * 4;
constexpr size_t WS_IDS   = WS_XN + (size_t)NTOK * DM * 2;
constexpr size_t WS_GATES = WS_IDS + (size_t)NTOK * 128 * 4;
constexpr size_t WS_PART  = WS_GATES + (size_t)NTOK * 128 * 4;
constexpr size_t WS_RWF   = WS_XN;
constexpr size_t WS_RWY   = WS_RWF + (size_t)64 * 272 * 10496;
constexpr size_t WS_BON   = WS_RWY + (size_t)2 * NTOK * 512 * 2;
constexpr size_t WS_XBC   = WS_BON + (size_t)2 * NTOK * 8 * 4;
constexpr size_t WS_DTS   = WS_XBC + (size_t)NTOK * 1024 * 2;
constexpr size_t WS_DEC   = WS_DTS + (size_t)NTOK * 16 * 4;
constexpr size_t WS_SST   = WS_DEC + (size_t)NTOK * 16 * 4;
constexpr size_t WS_SCD   = WS_SST + (size_t)64 * NCH * 8192 * 4;
constexpr size_t WS_YS    = WS_SCD + 16384;
constexpr size_t WS_QN    = WS_YS + (size_t)NTOK * 512 * 4;
constexpr size_t WS_KN    = WS_QN + (size_t)NTOK * 512 * 2;
constexpr size_t WS_VTL   = WS_KN + (size_t)NTOK * 512 * 2;
constexpr size_t WS_VTC   = WS_VTL + (size_t)4 * 8 * 64 * 64 * 96 * 2;
constexpr size_t WS_END   = WS_VTC + (size_t)4 * 8 * 64 * 256 * 2;
static_assert(WS_END < (size_t)1020 * 1024 * 1024, "workspace");
static_assert(WS_GATES + (size_t)NTOK * 128 * 4 <= WS_PART && WS_PART + (size_t)16 * NTOK * 128 * 4 <= WS_END, "alias");

constexpr int LDS_BYTES = 147456;
constexpr int LDS_BAR_OFF = LDS_BYTES - 16;
constexpr int LDS_XI_OFF = LDS_BYTES - 48;
constexpr int CTL_TICKET = 8192;

#define LAS __attribute__((address_space(3)))
typedef unsigned short bf16_t;
typedef _Float16 f16_t;
typedef short bf16x8 __attribute__((ext_vector_type(8)));
typedef float f32x4 __attribute__((ext_vector_type(4)));
typedef unsigned u32x4 __attribute__((ext_vector_type(4)));
typedef unsigned u32x2 __attribute__((ext_vector_type(2)));

__device__ __forceinline__ float bf2f(bf16_t h) { return __uint_as_float(((unsigned)h) << 16); }
__device__ __forceinline__ float bflo(unsigned u) { return __uint_as_float(u << 16); }
__device__ __forceinline__ float bfhi(unsigned u) { return __uint_as_float(u & 0xffff0000u); }
__device__ __forceinline__ bf16_t f2bf(float f) { unsigned u = __float_as_uint(f); u += 0x7FFFu + ((u >> 16) & 1u); return (bf16_t)(u >> 16); }
typedef float f32x2_t __attribute__((ext_vector_type(2)));
typedef __bf16 bf16x2_t __attribute__((ext_vector_type(2)));
__device__ __forceinline__ unsigned pk_bf16(float lo, float hi) { const f32x2_t v = {lo, hi}; const bf16x2_t r = __builtin_convertvector(v, bf16x2_t); return __builtin_bit_cast(unsigned, r); }
__device__ __forceinline__ bf16x8 pack8(const f32x4 a, const f32x4 b) { union { bf16x8 v; unsigned u[4]; } r; r.u[0] = pk_bf16(a[0], a[1]); r.u[1] = pk_bf16(a[2], a[3]); r.u[2] = pk_bf16(b[0], b[1]); r.u[3] = pk_bf16(b[2], b[3]); return r.v; }
template <int CTRL> __device__ __forceinline__ float dpp_f(float v) { return __int_as_float(__builtin_amdgcn_update_dpp(0, __float_as_int(v), CTRL, 0xF, 0xF, true)); }
__device__ __forceinline__ float sum4(float x)  { x += dpp_f<0xB1>(x); x += dpp_f<0x4E>(x); return x; }
__device__ __forceinline__ float sum8(float x)  { x = sum4(x); x += dpp_f<0x141>(x); return x; }
__device__ __forceinline__ float sum16(float x) { x = sum8(x); x += dpp_f<0x140>(x); return x; }
__device__ __forceinline__ float xor16_f(float x) { return __int_as_float(__builtin_amdgcn_ds_swizzle(__float_as_int(x), 0x401F)); }
__device__ __forceinline__ float sum_x32(float x) { const auto r = __builtin_amdgcn_permlane32_swap(__float_as_uint(x), __float_as_uint(x), false, false); return __uint_as_float(r[0]) + __uint_as_float(r[1]); }
__device__ __forceinline__ float max_x32(float x) { const auto r = __builtin_amdgcn_permlane32_swap(__float_as_uint(x), __float_as_uint(x), false, false); return fmaxf(__uint_as_float(r[0]), __uint_as_float(r[1])); }
__device__ __forceinline__ float wave_sum(float x) { x = sum16(x); x += xor16_f(x); return sum_x32(x); }
__device__ __forceinline__ float max16(float x) { x = fmaxf(x, dpp_f<0xB1>(x)); x = fmaxf(x, dpp_f<0x4E>(x)); x = fmaxf(x, dpp_f<0x141>(x)); x = fmaxf(x, dpp_f<0x140>(x)); return x; }
__device__ __forceinline__ float wave_max(float x) { x = max16(x); x = fmaxf(x, xor16_f(x)); return max_x32(x); }
__device__ __forceinline__ float rcpf_(float x) { return __builtin_amdgcn_rcpf(x); }
__device__ __forceinline__ float sigmoidf_(float x) { return rcpf_(1.0f + __expf(-x)); }
__device__ __forceinline__ float siluf_(float x) { return x * rcpf_(1.0f + __expf(-x)); }
__device__ __forceinline__ float tanhf_(float x) { const float e = __expf(2.0f * x); return 1.0f - 2.0f * rcpf_(e + 1.0f); }
__device__ __forceinline__ float geluf_(float x) { return 0.5f * x * (1.0f + tanhf_(0.7978845608028654f * (x + 0.044715f * x * x * x))); }

namespace pg8 {
#define PG8_LAS __attribute__((address_space(3)))
typedef unsigned short bf16_t;
typedef short bf16x8 __attribute__((ext_vector_type(8)));
typedef float f32x4 __attribute__((ext_vector_type(4)));
typedef unsigned u32x4 __attribute__((ext_vector_type(4)));
constexpr int BM = 256, BK = 64, HALF = 128, HTB = HALF * BK * 2  , STAGE_BYTES = 8 * HTB, NXCD = 8, WGM = 8;

__host__ __device__ __forceinline__ int lds_byte(int r, int c) { const int st = (r >> 4) * 2 + (c >> 5), rr = r & 15, cc = c & 31, ob = rr * 64 + cc * 2; return st * 1024 + (ob ^ (((ob >> 9) & 1) << 5)); }
__host__ __device__ __forceinline__ void stage_rc(int b, int& R, int& C) { const int st = b / 1024, sb = b % 1024, swz = sb ^ (((sb >> 9) & 1) << 5); R = (st >> 1) * 16 + swz / 64; C = (st & 1) * 32 + (swz % 64) / 2; }
__host__ __device__ __forceinline__ int perm32(int rho) { const int n = rho >> 4, i = rho & 15; return 8 * (i >> 2) + 4 * n + (i & 3); }

struct Unit { int pm, pn; };
struct Gemm { const bf16_t* A; const bf16_t* Bt; int M, N, K; };

struct StaticOrder {
    int nM, nN, nwg, G, c;
    __host__ __device__ void init(int M, int N, int G_, int c_) { nM = M / BM; nN = N / BM; nwg = nM * nN; G = G_; c = c_; }
    __host__ __device__ bool next(int i, Unit& u) const {
        const long L = (long)i * G + c; if (L >= nwg) return false;
        int wgid = (int)L; { const int q = nwg / NXCD, r = nwg % NXCD, xcd = wgid % NXCD, off = wgid / NXCD; wgid = (xcd < r ? xcd * (q + 1) : r * (q + 1) + (xcd - r) * q) + off; }
        const int nig = WGM * nN, gid = wgid / nig, fm = gid * WGM, gsz = (nM - fm) < WGM ? (nM - fm) : WGM;
        u.pm = fm + ((wgid % nig) % gsz); u.pn = (wgid % nig) / gsz; return true;
    }
    __device__ __forceinline__ void a_ready(const Unit&) const {}
    __device__ __forceinline__ void done(const Unit&) const {}
};

__device__ __forceinline__ unsigned cvt_pk_bf16(float lo, float hi) { return ::pk_bf16(lo, hi); }
struct EpiBf16 {
    static constexpr bool PERM = true, AFTER_DRAIN = false;
    bf16_t* O; int ldc;
    __device__ __forceinline__ void operator()(const f32x4 (&acc)[2][2][4][2], const Unit& u, int wr, int wc, int fr, int fq) const {
        const int row0 = u.pm * BM + wr * 64 + fr; const int col0 = u.pn * BM + wc * 32 + 8 * fq;
#pragma unroll
        for (int ai = 0; ai < 2; ++ai)
#pragma unroll
            for (int m = 0; m < 4; ++m) { bf16_t* rowp = O + (size_t)(row0 + ai * HALF + m * 16) * ldc + col0;
#pragma unroll
                for (int bj = 0; bj < 2; ++bj) { const f32x4 v0 = acc[ai][bj][m][0], v1 = acc[ai][bj][m][1];
                    u32x4 w; w.x = cvt_pk_bf16(v0[0], v0[1]); w.y = cvt_pk_bf16(v0[2], v0[3]); w.z = cvt_pk_bf16(v1[0], v1[1]); w.w = cvt_pk_bf16(v1[2], v1[3]);
                    *(u32x4*)(rowp + bj * HALF) = w; } }
    }
};
struct EpiResid {
    static constexpr bool PERM = false, AFTER_DRAIN = false;
    const float* xi_lat; const float* xi_ctx; float* xo_lat; float* xo_ctx; const float* gate;
    __device__ __forceinline__ void operator()(const f32x4 (&acc)[2][2][4][2], const Unit& u, int wr, int wc, int fr, int fq) const {
        const bool isctx = u.pm >= 64; const int v = isctx ? 4 : (u.pm >> 4);
        const int row0 = (isctx ? (u.pm - 64) : u.pm) * BM + wr * 64 + fr, col0 = u.pn * BM + wc * 32 + 4 * fq;
        const float* xi = isctx ? xi_ctx : xi_lat; float* xo = isctx ? xo_ctx : xo_lat;
        const float* gp = gate + (size_t)v * 12288 + col0;
        f32x4 gv[2][2];
#pragma unroll
        for (int bj = 0; bj < 2; ++bj)
#pragma unroll
            for (int n = 0; n < 2; ++n) gv[bj][n] = *(const f32x4*)(gp + bj * HALF + n * 16);
#pragma unroll
        for (int ai = 0; ai < 2; ++ai)
#pragma unroll
            for (int m = 0; m < 4; ++m) { const size_t off = (size_t)(row0 + ai * HALF + m * 16) * 2048 + col0;
#pragma unroll
                for (int bj = 0; bj < 2; ++bj)
#pragma unroll
                    for (int n = 0; n < 2; ++n) { const f32x4 xv = *(const f32x4*)(xi + off + bj * HALF + n * 16);
                        *(f32x4*)(xo + off + bj * HALF + n * 16) = xv + gv[bj][n] * acc[ai][bj][m][n]; }
                asm volatile("" ::: "memory"); }
    }
};

template <class Epi, class Sched>
__device__ __forceinline__ void gemm_phase(PG8_LAS unsigned char* lds, const Gemm g, const Sched& S, const Epi& E, const int tid) {
    const int wid = __builtin_amdgcn_readfirstlane(tid >> 6), lane = tid & 63, wr = wid >> 2, wc = wid & 3, fr = lane & 15, fq = lane >> 4;
    const int K = g.K, nt = K / BK;
    unsigned voffA[2], voffB[2];
#pragma unroll
    for (int i = 0; i < 2; ++i) { int R, C; stage_rc(tid * 16 + i * 8192, R, C); const int Rb = Epi::PERM ? ((R & ~31) + perm32(R & 31)) : R;
        voffA[i] = (unsigned)(R * K + C) * 2u; voffB[i] = (unsigned)(Rb * K + C) * 2u; }
    const size_t kstep = (size_t)(BK * 2);
    const size_t hstep = (size_t)HALF * K * 2;
    const size_t tstep = 2 * hstep;
    const unsigned ldsw = (unsigned)wid * 1024u;
    const int aoff = lds_byte(wr * 64 + fr, fq * 8), boff = lds_byte(wc * 32 + fr, fq * 8);
#define PG8_SA(b, h) (((b) * 2 + (h)) * HTB)
#define PG8_SB(b, h) ((4 + (b) * 2 + (h)) * HTB)
#define PG8_STAGE(bufoff, gbase, voff) do { _Pragma("unroll") for (int _i = 0; _i < 2; ++_i) \
        __builtin_amdgcn_global_load_lds((const unsigned*)((const char*)(gbase) + (voff)[_i]), (PG8_LAS unsigned*)(lds + (bufoff) + ldsw + _i * 8192), 16, 0, 0); } while (0)
#define PG8_LDA(dst, b, h) do { _Pragma("unroll") for (int m = 0; m < 4; ++m) _Pragma("unroll") for (int k = 0; k < 2; ++k) dst[m][k] = *(const PG8_LAS bf16x8*)(lds + PG8_SA(b, h) + aoff + m * 2048 + k * 1024); } while (0)
#define PG8_LDB(dst, b, h) do { _Pragma("unroll") for (int n = 0; n < 2; ++n) _Pragma("unroll") for (int k = 0; k < 2; ++k) dst[n][k] = *(const PG8_LAS bf16x8*)(lds + PG8_SB(b, h) + boff + n * 2048 + k * 1024); } while (0)
#define PG8_MMA(ai, bj, At, Bt) do { __builtin_amdgcn_s_setprio(1); _Pragma("unroll") for (int m = 0; m < 4; ++m) _Pragma("unroll") for (int n = 0; n < 2; ++n) _Pragma("unroll") for (int k = 0; k < 2; ++k) \
        acc[ai][bj][m][n] = __builtin_amdgcn_mfma_f32_16x16x32_bf16(Bt[n][k], At[m][k], acc[ai][bj][m][n], 0, 0, 0); __builtin_amdgcn_s_setprio(0); } while (0)
#define PG8_WAIT_V(n) asm volatile("s_waitcnt vmcnt(" #n ")" ::: "memory")
#define PG8_WAIT_L(n) asm volatile("s_waitcnt lgkmcnt(" #n ")" ::: "memory")
#define PG8_BAR __builtin_amdgcn_s_barrier()
#define PG8_SCHED __builtin_amdgcn_sched_barrier(0)
    Unit cur, nxt; int ui = 0;
    if (!S.next(0, cur)) return;
    f32x4 acc[2][2][4][2];
#pragma unroll
    for (int a = 0; a < 2; ++a)
#pragma unroll
        for (int b = 0; b < 2; ++b)
#pragma unroll
            for (int m = 0; m < 4; ++m)
#pragma unroll
                for (int n = 0; n < 2; ++n) acc[a][b][m][n] = (f32x4){0.f, 0.f, 0.f, 0.f};
    bf16x8 At[4][2], B0[2][2], B1[2][2];
    const char* cA = (const char*)g.A + (size_t)cur.pm * tstep; const char* cB = (const char*)g.Bt + (size_t)cur.pn * tstep;
    S.a_ready(cur);
    PG8_STAGE(PG8_SB(0, 0), cB, voffB); PG8_STAGE(PG8_SA(0, 0), cA, voffA); PG8_STAGE(PG8_SB(0, 1), cB + hstep, voffB); PG8_STAGE(PG8_SA(0, 1), cA + hstep, voffA);
    if (wr == 1) PG8_BAR;
    PG8_WAIT_V(4); PG8_BAR;
    PG8_STAGE(PG8_SB(1, 0), cB + kstep, voffB); PG8_STAGE(PG8_SA(1, 0), cA + kstep, voffA); PG8_STAGE(PG8_SB(1, 1), cB + hstep + kstep, voffB);
    PG8_WAIT_V(6); PG8_BAR;
    for (;;) {
        const bool has_next = S.next(ui + 1, nxt);
        const char* nA = has_next ? (const char*)g.A + (size_t)nxt.pm * tstep : cA; const char* nB = has_next ? (const char*)g.Bt + (size_t)nxt.pn * tstep : cB;
        for (int t = 0; t < nt; t += 2) {
            const bool last = (t == nt - 2);
            const char* a1 = cA + (size_t)(t + 1) * kstep;
            const char* a2 = last ? nA : cA + (size_t)(t + 2) * kstep; const char* b2 = last ? nB : cB + (size_t)(t + 2) * kstep;
            const char* a3 = a2 + kstep; const char* b3 = b2 + kstep;
            if (last && has_next) S.a_ready(nxt);
            PG8_LDB(B0, 0, 0); PG8_SCHED; PG8_LDA(At, 0, 0); PG8_STAGE(PG8_SA(1, 1), a1 + hstep, voffA);
            PG8_WAIT_L(8); PG8_BAR; PG8_WAIT_L(0); PG8_MMA(0, 0, At, B0); PG8_BAR; PG8_SCHED;
            PG8_LDB(B1, 0, 1); PG8_STAGE(PG8_SB(0, 0), b2, voffB);
            PG8_BAR; PG8_WAIT_L(0); PG8_MMA(0, 1, At, B1); PG8_BAR;
            PG8_LDA(At, 0, 1); PG8_STAGE(PG8_SA(0, 0), a2, voffA);
            PG8_BAR; PG8_WAIT_L(0); PG8_MMA(1, 0, At, B0); PG8_BAR; PG8_SCHED;
            PG8_STAGE(PG8_SB(0, 1), b2 + hstep, voffB);
            PG8_WAIT_V(6); PG8_BAR; PG8_MMA(1, 1, At, B1); PG8_BAR;
            PG8_LDB(B0, 1, 0); PG8_SCHED; PG8_LDA(At, 1, 0); PG8_STAGE(PG8_SA(0, 1), a2 + hstep, voffA);
            PG8_WAIT_L(8); PG8_BAR; PG8_WAIT_L(0); PG8_MMA(0, 0, At, B0); PG8_BAR; PG8_SCHED;
            PG8_LDB(B1, 1, 1); PG8_STAGE(PG8_SB(1, 0), b3, voffB);
            PG8_BAR; PG8_WAIT_L(0); PG8_MMA(0, 1, At, B1); PG8_BAR;
            PG8_LDA(At, 1, 1); PG8_STAGE(PG8_SA(1, 0), a3, voffA);
            PG8_BAR; PG8_WAIT_L(0); PG8_MMA(1, 0, At, B0); PG8_BAR; PG8_SCHED;
            PG8_STAGE(PG8_SB(1, 1), b3 + hstep, voffB);
            PG8_WAIT_V(6); PG8_BAR; PG8_MMA(1, 1, At, B1); PG8_BAR;
        }
        if constexpr (!Epi::AFTER_DRAIN) { E(acc, cur, wr, wc, fr, fq); S.done(cur); }
        if (!has_next) break;
#pragma unroll
        for (int a = 0; a < 2; ++a)
#pragma unroll
            for (int b = 0; b < 2; ++b)
#pragma unroll
                for (int m = 0; m < 4; ++m)
#pragma unroll
                    for (int n = 0; n < 2; ++n) acc[a][b][m][n] = (f32x4){0.f, 0.f, 0.f, 0.f};
        cur = nxt; cA = nA; cB = nB; ++ui;
    }
    PG8_WAIT_V(0);
    if (wr == 0) PG8_BAR;
    PG8_BAR;
    if constexpr (Epi::AFTER_DRAIN) { E.fused(acc, cur, wr, wc, fr, fq, lds, wid, lane); S.done(cur); }
#undef PG8_SA
#undef PG8_SB
#undef PG8_STAGE
#undef PG8_LDA
#undef PG8_LDB
#undef PG8_MMA
#undef PG8_WAIT_V
#undef PG8_WAIT_L
#undef PG8_BAR
#undef PG8_SCHED
}
}

#define XB_TMO      128
#define XB_XCNT(j)  (256  + 64 * (j))
#define XB_XSUB(j)  (1280 + 64 * (j))
#define XB_XGEN(j)  (2304 + 64 * (j))
#define XB_TOP      3328
#define XB_TOPGEN   3392
#define XCD_BAR_WORDS 3456
#define XB_SPIN_CAP (1u << 18)
#define LAS __attribute__((address_space(3)))

__device__ __forceinline__ unsigned xb_ld(unsigned* p)              { return __hip_atomic_load(p, __ATOMIC_RELAXED, __HIP_MEMORY_SCOPE_AGENT); }
__device__ __forceinline__ unsigned xb_add(unsigned* p, unsigned v) { return __hip_atomic_fetch_add(p, v, __ATOMIC_RELAXED, __HIP_MEMORY_SCOPE_AGENT); }
__device__ __forceinline__ unsigned xb_xcc_id() { return (unsigned)__builtin_amdgcn_s_getreg((3 << 11) | 20) & 0xFu; }
#define XB_SPIN(cond, bar) do { unsigned _sp = 0; while (cond) { __builtin_amdgcn_s_sleep(1); \
    if ((++_sp & 255u) == 0u) { if (xb_ld(&(bar)[XB_TMO])) break; if (_sp > XB_SPIN_CAP) { atomicAdd(&(bar)[XB_TMO], 1u); break; } } } } while (0)

struct XcdBarrier {
    unsigned* bar; unsigned x;
    volatile LAS unsigned* st;
};

__device__ __forceinline__ XcdBarrier xcd_barrier_post(unsigned* bar, volatile LAS unsigned* st) {
    XcdBarrier b; b.bar = bar; b.x = xb_xcc_id(); b.st = st;
    if (threadIdx.x == 0) (void)xb_add(&bar[XB_XCNT(b.x)], 1u);
    return b;
}
__device__ __forceinline__ void xcd_barrier_complete(unsigned* bar, unsigned x, unsigned& nloc, unsigned& nx) {
    const unsigned G = gridDim.x * gridDim.y * gridDim.z;
    unsigned sum, cnt, mine, sp = 0u;
    for (;;) {
        sum = 0u; cnt = 0u; mine = 0u;
#pragma unroll
        for (unsigned j = 0; j < 16; ++j) { const unsigned c = xb_ld(&bar[XB_XCNT(j)]); sum += c; cnt += (c > 0u) ? 1u : 0u; mine = (j == x) ? c : mine; }
        if (sum == G) break;
        __builtin_amdgcn_s_sleep(1);
        if ((++sp & 255u) == 0u) { if (xb_ld(&bar[XB_TMO])) break; if (sp > XB_SPIN_CAP) { atomicAdd(&bar[XB_TMO], 1u); break; } }
    }
    nloc = mine > 0u ? mine : 1u; nx = cnt > 0u ? cnt : 1u;
}

__device__ __forceinline__ void xcd_barrier(const XcdBarrier& b) {
    asm volatile("s_waitcnt vmcnt(0)" ::: "memory");
    __syncthreads();
    if (threadIdx.x == 0) {
        unsigned* bar = b.bar;
        __builtin_amdgcn_s_waitcnt(0);
        unsigned nloc = b.st[0], nx = b.st[1];
        if (nloc == 0u) { xcd_barrier_complete(bar, b.x, nloc, nx); b.st[0] = nloc; b.st[1] = nx; }
        const unsigned old = xb_add(&bar[XB_XSUB(b.x)], 1u);
        const unsigned gen = old / nloc;
        if (old + 1u == (gen + 1u) * nloc) {
            __builtin_amdgcn_fence(__ATOMIC_RELEASE, "agent");
            asm volatile("s_waitcnt vmcnt(0)" ::: "memory");
            const unsigned og = xb_add(&bar[XB_TOP], 1u);
            const unsigned tg = og / nx;
            if (og + 1u == (tg + 1u) * nx) xb_add(&bar[XB_TOPGEN], 1u);
            else XB_SPIN(xb_ld(&bar[XB_TOPGEN]) == tg, bar);
            __builtin_amdgcn_fence(__ATOMIC_ACQUIRE, "agent");
            xb_add(&bar[XB_XGEN(b.x)], 1u);
            asm volatile("s_waitcnt vmcnt(0)" ::: "memory");
        } else {
            XB_SPIN(xb_ld(&bar[XB_XGEN(b.x)]) == gen, bar);
            __builtin_amdgcn_fence(__ATOMIC_ACQUIRE, "agent");
            asm volatile("s_waitcnt vmcnt(0)" ::: "memory");
        }
    }
    __syncthreads();
}

typedef const float* cfp_t;
typedef __attribute__((address_space(4))) const cfp_t* ka_t;
struct Ctx {
    LAS unsigned char* lds; int tid, lane, wave, bid, G;
};

__device__ __forceinline__ void task_ada(const Ctx& F, const float* c, const float* c_ctx, const float* w_ada, float* modp, int task) {
    LAS float* s_act = (LAS float*)F.lds;
    const int l = task / (KSPL * 6), rem = task % (KSPL * 6), ks = rem / 6, cc = rem % 6;
    __syncthreads();
    if (F.tid < 320) { const int v = F.tid >> 6, k = ks * 64 + (F.tid & 63); const float x = v < 4 ? c[v * 2048 + k] : c_ctx[k]; s_act[F.tid] = siluf_(x); }
    __syncthreads();
    const int col4 = cc * 512 + F.tid;
    const float4* wp = (const float4*)(w_ada + ((size_t)l * 2048 + ks * 64) * 12288) + col4;
    float4 acc[5];
#pragma unroll
    for (int v = 0; v < 5; ++v) acc[v] = make_float4(0.f, 0.f, 0.f, 0.f);
#pragma unroll 8
    for (int k = 0; k < 64; ++k) {
        const float4 w = wp[(size_t)k * 3072];
#pragma unroll
        for (int v = 0; v < 5; ++v) { const float a = s_act[v * 64 + k]; acc[v].x += a * w.x; acc[v].y += a * w.y; acc[v].z += a * w.z; acc[v].w += a * w.w; }
    }
#pragma unroll
    for (int v = 0; v < 5; ++v) ((float4*)(modp + (((size_t)ks * 2 + l) * 5 + v) * 12288))[col4] = acc[v];
}
__device__ __forceinline__ void task_wt(const Ctx& F, const float* W, int N, bf16_t* Wt, int ntile) {
    LAS bf16_t* T = (LAS bf16_t*)F.lds;
    const int nq = F.tid & 15, kr = F.tid >> 4, n0 = ntile * 64;
    for (int kc = 0; kc < 16; ++kc) {
        float4 v[4];
#pragma unroll
        for (int j = 0; j < 4; ++j) { const int k = kc * 128 + kr + 32 * j, n = n0 + 4 * nq;
            v[j] = (n < N) ? *(const float4*)(W + (size_t)k * N + n) : make_float4(0.f, 0.f, 0.f, 0.f); }
        __syncthreads();
#pragma unroll
        for (int j = 0; j < 4; ++j) { const int kl = kr + 32 * j;
            T[(4 * nq + 0) * 136 + kl] = f2bf(v[j].x); T[(4 * nq + 1) * 136 + kl] = f2bf(v[j].y); T[(4 * nq + 2) * 136 + kl] = f2bf(v[j].z); T[(4 * nq + 3) * 136 + kl] = f2bf(v[j].w); }
        __syncthreads();
        { const int n = F.tid >> 3, kg = F.tid & 7;
          const u32x4 a = *(LAS u32x4*)(T + n * 136 + kg * 16), b = *(LAS u32x4*)(T + n * 136 + kg * 16 + 8);
          bf16_t* dst = Wt + (size_t)(n0 + n) * 2048 + kc * 128 + kg * 16; *(u32x4*)dst = a; *(u32x4*)(dst + 8) = b; }
    }
    __syncthreads();
}
__device__ __forceinline__ void task_cvt(const Ctx& F, const float* src, bf16_t* dst, size_t off) {
#pragma unroll 4
    for (int it = 0; it < 16; ++it) { const size_t e = off + (size_t)it * 4096 + F.tid * 8;
        const float4 a = *(const float4*)(src + e), b = *(const float4*)(src + e + 4);
        u32x4 o; o.x = pk_bf16(a.x, a.y); o.y = pk_bf16(a.z, a.w); o.z = pk_bf16(b.x, b.y); o.w = pk_bf16(b.z, b.w);
        *(u32x4*)(dst + e) = o; }
}
__device__ __forceinline__ void task_cvt8(const Ctx& F, const float* src, unsigned char* dst, size_t off, float scale) {
#pragma unroll 2
    for (int it = 0; it < 8; ++it) { const size_t e = off + (size_t)it * 8192 + F.tid * 16;
        u32x4 o;
#pragma unroll
        for (int w = 0; w < 4; ++w) { const float4 a = *(const float4*)(src + e + 4 * w);
            const float x0 = fminf(fmaxf(a.x * scale, -448.f), 448.f), x1 = fminf(fmaxf(a.y * scale, -448.f), 448.f), x2 = fminf(fmaxf(a.z * scale, -448.f), 448.f), x3 = fminf(fmaxf(a.w * scale, -448.f), 448.f);
            int p = __builtin_amdgcn_cvt_pk_fp8_f32(x0, x1, 0, false); p = __builtin_amdgcn_cvt_pk_fp8_f32(x2, x3, p, true); o[w] = (unsigned)p; }
        const size_t row = e >> 11; const int col = (int)(e & 2047);
        *(u32x4*)(dst + (row >> 14) * ((size_t)16384 * 2048) + ((size_t)(col >> 7) * 16384 + (row & 16383)) * 128 + (col & 127)) = o; }
}
constexpr float PEER_U_SCALE = 64.0f;
__device__ __forceinline__ void task_lorat(const Ctx& F, const float* src, bf16_t* dst, int nj) {
    const int ch = F.tid;
    for (int j8 = 0; j8 < nj / 8; ++j8) { float v[8];
#pragma unroll
        for (int q = 0; q < 8; ++q) v[q] = src[(size_t)(j8 * 8 + q) * 512 + ch];
        u32x4 o; o.x = pk_bf16(v[0], v[1]); o.y = pk_bf16(v[2], v[3]); o.z = pk_bf16(v[4], v[5]); o.w = pk_bf16(v[6], v[7]);
        *(u32x4*)(dst + (size_t)ch * nj + j8 * 8) = o; }
}
constexpr int T_ADA = 2 * KSPL * 6, T_WT1 = 2 * 104, T_WT2 = 2 * 32, T_WT3 = 2 * 32, T_PEER = 2048, T_KEYS = 8, T_LORA = 10;
__device__ __forceinline__ void phase_prologue(const Ctx& F, ka_t in, unsigned char* ws) {
    const int total = T_ADA + T_WT1 + T_WT2 + T_WT3 + T_PEER + T_KEYS + T_LORA + 1;
    for (int t0 = F.bid; t0 < total; t0 += F.G) {
        int t = t0;
        if (t < T_ADA) { task_ada(F, in[I_C], in[I_CCTX], in[I_WADA], (float*)(ws + WS_MODP), t); continue; } t -= T_ADA;
        if (t < T_WT1) { const int l = t / 104, nt = t % 104; task_wt(F, in[I_WIN] + (size_t)l * 2048 * PT, PT, (bf16_t*)(ws + WS_WIN) + (size_t)l * PTP * 2048, nt); continue; } t -= T_WT1;
        if (t < T_WT2) { const int l = t / 32, nt = t % 32; task_wt(F, in[I_WOUT] + (size_t)l * 2048 * 2048, 2048, (bf16_t*)(ws + WS_WOUT) + (size_t)l * 2048 * 2048, nt); continue; } t -= T_WT2;
        if (t < T_WT3) { const int l = t / 32, nt = t % 32; task_wt(F, in[I_PWQ] + (size_t)l * 2048 * 2048, 2048, (bf16_t*)(ws + WS_WQ) + (size_t)l * 2048 * 2048, nt); continue; } t -= T_WT3;
        if (t < T_PEER) { const bool isv = t >= 1024; const int c = t & 1023; task_cvt8(F, in[isv ? I_PV : I_PU], ws + (isv ? WS_PV : WS_PU), (size_t)c * 65536, isv ? 1.0f : PEER_U_SCALE); continue; } t -= T_PEER;
        if (t < T_KEYS) { task_cvt(F, in[I_PKEYS], (bf16_t*)(ws + WS_KEYS), (size_t)t * 65536); continue; } t -= T_KEYS;
        if (t < T_LORA) {
            if (t < 8) { const int l = t >> 2, wh = t & 3;
                task_lorat(F, in[wh < 2 ? I_RWUP : I_RAUP] + ((size_t)l * 2 + (wh & 1)) * 64 * 512, (bf16_t*)(ws + WS_WUPT) + ((size_t)l * 4 + wh) * 512 * 64, 64); }
            else { const int l = t - 8; task_lorat(F, in[I_RGUP] + (size_t)l * 128 * 512, (bf16_t*)(ws + WS_GUPT) + (size_t)l * 512 * 128, 128); }
            continue; } t -= T_LORA;
        { float* rope = (float*)(ws + WS_ROPE);
          for (int e = F.tid; e < 2048; e += 512) { const int pos = e >> 5, i = e & 31; const float fr = powf(10000.0f, -(float)i / 32.0f), ang = (float)pos * fr;
              rope[2 * e] = cosf(ang); rope[2 * e + 1] = sinf(ang); } }
    }
}
__device__ __forceinline__ void phase_modreduce(const Ctx& F, const float* b_ada, const float* modp, float* mod) {
    for (int idx = F.bid * 512 + F.tid; idx < 2 * 5 * 12288; idx += F.G * 512) {
        const int l = idx / 61440, rem = idx % 61440, v = rem / 12288, n = rem % 12288;
        float s = b_ada[l * 12288 + n];
        for (int ks = 0; ks < KSPL; ++ks) s += modp[(((size_t)ks * 2 + l) * 5 + v) * 12288 + n];
        mod[idx] = s;
    }
}

__device__ __forceinline__ void norm_store(const float (&x)[32], const float* gw, const float* shift, const float* scale, bf16_t* dst, int lane) {
    float ss = 0.f;
#pragma unroll
    for (int q = 0; q < 32; ++q) ss += x[q] * x[q];
    ss = wave_sum(ss);
    const float rs = rsqrtf(ss * (1.0f / 2048.0f) + 1e-6f);
#pragma unroll
    for (int j = 0; j < 4; ++j) { const int e = j * 512 + lane * 8;
        const float4 g0 = *(const float4*)(gw + e), g1 = *(const float4*)(gw + e + 4), h0 = *(const float4*)(shift + e), h1 = *(const float4*)(shift + e + 4), c0 = *(const float4*)(scale + e), c1 = *(const float4*)(scale + e + 4);
        const float y0 = x[j * 8 + 0] * rs * g0.x * (1.f + c0.x) + h0.x, y1 = x[j * 8 + 1] * rs * g0.y * (1.f + c0.y) + h0.y, y2 = x[j * 8 + 2] * rs * g0.z * (1.f + c0.z) + h0.z, y3 = x[j * 8 + 3] * rs * g0.w * (1.f + c0.w) + h0.w;
        const float y4 = x[j * 8 + 4] * rs * g1.x * (1.f + c1.x) + h1.x, y5 = x[j * 8 + 5] * rs * g1.y * (1.f + c1.y) + h1.y, y6 = x[j * 8 + 6] * rs * g1.z * (1.f + c1.z) + h1.z, y7 = x[j * 8 + 7] * rs * g1.w * (1.f + c1.w) + h1.w;
        u32x4 o; o.x = pk_bf16(y0, y1); o.y = pk_bf16(y2, y3); o.z = pk_bf16(y4, y5); o.w = pk_bf16(y6, y7);
        *(u32x4*)(dst + e) = o; }
}
__device__ __forceinline__ void phase_norm(const Ctx& F, const float* xlat, const float* xctx, const float* gw, const float* mod, int shift_i, int scale_i, bf16_t* dst, int nrows) {
    for (int row = F.bid * 8 + F.wave; row < nrows; row += F.G * 8) {
        const bool isctx = row >= NLAT; const float* xr = isctx ? xctx + (size_t)(row - NLAT) * 2048 : xlat + (size_t)row * 2048;
        const int v = isctx ? 4 : (row >> 12);
        float x[32];
#pragma unroll
        for (int j = 0; j < 4; ++j) { const int e = j * 512 + F.lane * 8; const float4 a = *(const float4*)(xr + e), b = *(const float4*)(xr + e + 4);
            x[j * 8 + 0] = a.x; x[j * 8 + 1] = a.y; x[j * 8 + 2] = a.z; x[j * 8 + 3] = a.w; x[j * 8 + 4] = b.x; x[j * 8 + 5] = b.y; x[j * 8 + 6] = b.z; x[j * 8 + 7] = b.w; }
        norm_store(x, gw, mod + (size_t)v * 12288 + shift_i * 2048, mod + (size_t)v * 12288 + scale_i * 2048, dst + (size_t)row * 2048, F.lane);
    }
}

struct LayerW {
    const float *sc_w, *rw_w0, *rw_wup, *rw_a0, *rw_aup, *rw_gup, *rw_kk, *rw_ka, *rw_rk, *rw_lnw, *rw_lnb, *na_q, *na_k, *rpb, *s_cw, *s_cb, *s_dtb, *s_alog, *s_d, *s_norm;
};
__device__ __forceinline__ void unpack8(const u32x4 q, float (&f)[8]) { f[0] = bflo(q[0]); f[1] = bfhi(q[0]); f[2] = bflo(q[1]); f[3] = bfhi(q[1]); f[4] = bflo(q[2]); f[5] = bfhi(q[2]); f[6] = bflo(q[3]); f[7] = bfhi(q[3]); }
__device__ __forceinline__ u32x4 pack8f(const float (&f)[8]) { u32x4 o; o[0] = pk_bf16(f[0], f[1]); o[1] = pk_bf16(f[2], f[3]); o[2] = pk_bf16(f[4], f[5]); o[3] = pk_bf16(f[6], f[7]); return o; }
__device__ __forceinline__ void load8f(const float* p, float (&f)[8]) { const float4 a = *(const float4*)p, b = *(const float4*)(p + 4); f[0] = a.x; f[1] = a.y; f[2] = a.z; f[3] = a.w; f[4] = b.x; f[5] = b.y; f[6] = b.z; f[7] = b.w; }
__device__ __forceinline__ void phase_prep(const Ctx& F, const LayerW& W, unsigned char* ws) {
    const bf16_t* P = (const bf16_t*)(ws + WS_P);
    bf16_t* MIX = (bf16_t*)(ws + WS_MIX);
    bf16_t* XBC = (bf16_t*)(ws + WS_XBC); float* DTS = (float*)(ws + WS_DTS); float* DEC = (float*)(ws + WS_DEC);
    bf16_t* QN = (bf16_t*)(ws + WS_QN); bf16_t* KN = (bf16_t*)(ws + WS_KN); bf16_t* VTL = (bf16_t*)(ws + WS_VTL); bf16_t* VTC = (bf16_t*)(ws + WS_VTC);
    const float* ROPE = (const float*)(ws + WS_ROPE);
    for (int tile = F.bid; tile < NTOK / 8; tile += F.G) {
        int ln = F.lane; asm volatile("" : "+v"(ln));
        const int ch0 = ln * 8;
        const bool lat = tile < NLAT / 8;
        const int b = lat ? (tile >> 9) : ((tile - NLAT / 8) >> 5);
        const int t0 = lat ? (tile & 511) * 8 : ((tile - NLAT / 8) & 31) * 8;
        const int L = lat ? SEQL : CTXL;
        const int g0 = lat ? b * SEQL + t0 : NLAT + b * CTXL + t0;
        const bf16_t* Pr = P + (size_t)g0 * PTP;
        if (F.wave == 0 || F.wave == 4) {
            const bool gated = F.wave == 0;
            const float* cw = gated ? W.sc_w : W.s_cw; const int cstride = gated ? 512 : 1024;
            float w0[8], w1[8], w2[8], cb[8];
            load8f(cw + ch0, w0); load8f(cw + cstride + ch0, w1); load8f(cw + 2 * cstride + ch0, w2);
            if (gated) {
#pragma unroll
                for (int e = 0; e < 8; ++e) cb[e] = 0.f;
            } else load8f(W.s_cb + ch0, cb);
            const int col = gated ? A_CG : D_X;
#pragma unroll 1
            for (int tb = 0; tb < 8; tb += 4) {
            u32x4 ra[6], rb[6], rg[4];
#pragma unroll
            for (int q = 0; q < 6; ++q) { const int tq = t0 + tb - 1 + q; const bool ok = (tq >= 0) && (tq < L);
                ra[q] = ok ? *(const u32x4*)(Pr + (ptrdiff_t)(tb + q - 1) * PTP + col + ch0) : (u32x4){0u, 0u, 0u, 0u};
                if (gated) rb[q] = ok ? *(const u32x4*)(Pr + (ptrdiff_t)(tb + q - 1) * PTP + A_H + ch0) : (u32x4){0u, 0u, 0u, 0u}; }
            if (gated) {
#pragma unroll
                for (int tt = 0; tt < 4; ++tt) rg[tt] = *(const u32x4*)(Pr + (size_t)(tb + tt) * PTP + A_BG + ch0); }
            float up[8], uc[8], un[8];
            { float x[8], y[8]; unpack8(ra[0], x); if (gated) { unpack8(rb[0], y);
#pragma unroll
                for (int e = 0; e < 8; ++e) x[e] *= y[e]; }
#pragma unroll
              for (int e = 0; e < 8; ++e) up[e] = x[e];
              unpack8(ra[1], x); if (gated) { unpack8(rb[1], y);
#pragma unroll
                for (int e = 0; e < 8; ++e) x[e] *= y[e]; }
#pragma unroll
              for (int e = 0; e < 8; ++e) uc[e] = x[e]; }
#pragma unroll
            for (int tt = 0; tt < 4; ++tt) {
                { float x[8], y[8]; unpack8(ra[tt + 2], x); if (gated) { unpack8(rb[tt + 2], y);
#pragma unroll
                    for (int e = 0; e < 8; ++e) x[e] *= y[e]; }
#pragma unroll
                  for (int e = 0; e < 8; ++e) un[e] = x[e]; }
                float o[8];
                if (gated) { float bg[8]; unpack8(rg[tt], bg);
#pragma unroll
                    for (int e = 0; e < 8; ++e) o[e] = bg[e] * (w0[e] * up[e] + w1[e] * uc[e] + w2[e] * un[e]);
                    *(u32x4*)(MIX + (size_t)(g0 + tb + tt) * 2048 + ch0) = pack8f(o);
                } else {
#pragma unroll
                    for (int e = 0; e < 8; ++e) o[e] = siluf_(w0[e] * up[e] + w1[e] * uc[e] + w2[e] * un[e] + cb[e]);
                    *(u32x4*)(XBC + (size_t)(g0 + tb + tt) * 1024 + ch0) = pack8f(o); }
#pragma unroll
                for (int e = 0; e < 8; ++e) { up[e] = uc[e]; uc[e] = un[e]; }
            }
            }
        } else if (F.wave == 1 || F.wave == 2) {
            const bool isq = F.wave == 1; const int col = isq ? C_Q : C_K; bf16_t* dst = isq ? QN : KN;
            float nw[8]; load8f((isq ? W.na_q : W.na_k) + (ln & 7) * 8, nw);
            const float sc = isq ? 0.125f : 1.0f;
            u32x4 rq[8];
#pragma unroll
            for (int tt = 0; tt < 8; ++tt) rq[tt] = *(const u32x4*)(Pr + (size_t)tt * PTP + col + ch0);
#pragma unroll
            for (int tt = 0; tt < 8; ++tt) { float x[8]; unpack8(rq[tt], x); float ss = 0.f;
#pragma unroll
                for (int e = 0; e < 8; ++e) ss += x[e] * x[e];
                ss = sum8(ss); const float rs = rsqrtf(ss * (1.f / 64.f) + 1e-6f) * sc;
#pragma unroll
                for (int e = 0; e < 8; ++e) x[e] = x[e] * rs * nw[e];
                *(u32x4*)(dst + (size_t)(g0 + tt) * 512 + ch0) = pack8f(x); }
        } else if (F.wave == 3) {
            u32x4 rv[8];
#pragma unroll
            for (int tt = 0; tt < 8; ++tt) rv[tt] = *(const u32x4*)(Pr + (size_t)tt * PTP + C_V + ch0);
            const int h = ln >> 3;
#pragma unroll
            for (int e = 0; e < 8; ++e) { const int i = (ln & 7) * 8 + e;
                unsigned short v[8];
#pragma unroll
                for (int tt = 0; tt < 8; ++tt) v[tt] = (unsigned short)((e & 1) ? (rv[tt][e >> 1] >> 16) : (rv[tt][e >> 1] & 0xffffu));
                u32x2 c0; c0.x = (unsigned)v[0] | ((unsigned)v[1] << 16); c0.y = (unsigned)v[2] | ((unsigned)v[3] << 16);
                u32x2 c1; c1.x = (unsigned)v[4] | ((unsigned)v[5] << 16); c1.y = (unsigned)v[6] | ((unsigned)v[7] << 16);
                if (lat) { const int row = t0 >> 6, x0 = (t0 & 63) >> 2, x1 = x0 + 1;
                    bf16_t* base = VTL + ((size_t)((b * 8 + h) * 64 + i) * 64 + row) * 96;
                    if (x0 <= 11) *(u32x2*)(base + x0 * 8) = c0;
                    if (x0 >= 4)  *(u32x2*)(base + (x0 - 4) * 8 + 4) = c0;
                    if (x1 <= 11) *(u32x2*)(base + x1 * 8) = c1;
                    if (x1 >= 4)  *(u32x2*)(base + (x1 - 4) * 8 + 4) = c1;
                } else { const int m = t0 >> 5, o = t0 & 31, gq = (o & 15) >> 2, hf = (o >> 4) * 4;
                    bf16_t* base = VTC + ((size_t)((b * 8 + h) * 64 + i) * 8 + m) * 32;
                    *(u32x2*)(base + gq * 8 + hf) = c0; *(u32x2*)(base + (gq + 1) * 8 + hf) = c1; } }
        } else if (F.wave == 5) {
            if (ln < 32) {
                const int pg = ln, which = pg >> 4, gi = (pg >> 3) & 1, half = (pg >> 2) & 1, i0 = (pg & 3) * 8;
                const int c1 = 512 + which * 256 + gi * 128 + half * 64 + i0, c2 = c1 + 32;
                float wa0[8], wa1[8], wa2[8], ba[8], wb0[8], wb1[8], wb2[8], bb[8];
                load8f(W.s_cw + c1, wa0); load8f(W.s_cw + 1024 + c1, wa1); load8f(W.s_cw + 2048 + c1, wa2); load8f(W.s_cb + c1, ba);
                load8f(W.s_cw + c2, wb0); load8f(W.s_cw + 1024 + c2, wb1); load8f(W.s_cw + 2048 + c2, wb2); load8f(W.s_cb + c2, bb);
#pragma unroll 1
                for (int tb = 0; tb < 8; tb += 2) {
                u32x4 ra[4], rb[4];
#pragma unroll
                for (int q = 0; q < 4; ++q) { const int tq = t0 + tb - 1 + q; const bool ok = (tq >= 0) && (tq < L);
                    ra[q] = ok ? *(const u32x4*)(Pr + (ptrdiff_t)(tb + q - 1) * PTP + D_X + c1) : (u32x4){0u, 0u, 0u, 0u};
                    rb[q] = ok ? *(const u32x4*)(Pr + (ptrdiff_t)(tb + q - 1) * PTP + D_X + c2) : (u32x4){0u, 0u, 0u, 0u}; }
                float ap[8], ac[8], an[8], bp[8], bc[8], bn[8];
                unpack8(ra[0], ap); unpack8(ra[1], ac); unpack8(rb[0], bp); unpack8(rb[1], bc);
#pragma unroll
                for (int tt = 0; tt < 2; ++tt) { unpack8(ra[tt + 2], an); unpack8(rb[tt + 2], bn);
                    float y1[8], y2[8];
#pragma unroll
                    for (int e = 0; e < 8; ++e) { y1[e] = siluf_(wa0[e] * ap[e] + wa1[e] * ac[e] + wa2[e] * an[e] + ba[e]); y2[e] = siluf_(wb0[e] * bp[e] + wb1[e] * bc[e] + wb2[e] * bn[e] + bb[e]); }
                    if (lat) { const int t = t0 + tb + tt, pos = half ? (t & 63) : (t >> 6);
                        float cs[16];
#pragma unroll
                        for (int q = 0; q < 4; ++q) { const float4 v = *(const float4*)(ROPE + (size_t)(pos * 32 + i0) * 2 + 4 * q); cs[4 * q] = v.x; cs[4 * q + 1] = v.y; cs[4 * q + 2] = v.z; cs[4 * q + 3] = v.w; }
#pragma unroll
                        for (int e = 0; e < 8; ++e) { const float o1 = y1[e] * cs[2 * e] - y2[e] * cs[2 * e + 1], o2 = y1[e] * cs[2 * e + 1] + y2[e] * cs[2 * e]; y1[e] = o1; y2[e] = o2; } }
                    *(u32x4*)(XBC + (size_t)(g0 + tb + tt) * 1024 + c1) = pack8f(y1); *(u32x4*)(XBC + (size_t)(g0 + tb + tt) * 1024 + c2) = pack8f(y2);
#pragma unroll
                    for (int e = 0; e < 8; ++e) { ap[e] = ac[e]; ac[e] = an[e]; bp[e] = bc[e]; bc[e] = bn[e]; }
                }
                }
            }
        } else if (F.wave == 6) {
#pragma unroll
            for (int q = 0; q < 2; ++q) { const int it = ln + 64 * q, tt = it >> 4, j = it & 15;
                const float x = bf2f(Pr[(size_t)tt * PTP + D_DT + j]) + W.s_dtb[j];
                const float sp = fmaxf(x, 0.f) + log1pf(__expf(-fabsf(x)));
                DTS[(size_t)(g0 + tt) * 16 + j] = sp; DEC[(size_t)(g0 + tt) * 16 + j] = -sp * __expf(W.s_alog[j]); }
        }
    }
}

constexpr int SB_PITCH = 136;
__device__ __forceinline__ void ssd_scan_L(const Ctx& F, LAS float* sL, const float* LA, int g0, int h) {
    const int d = (F.tid >> 7) & 1, t = F.tid & 127;
    float v = 0.f;
    if (F.tid < 256) { v = LA[(size_t)(g0 + t) * 16 + d * 8 + h]; sL[F.tid] = v; }
    __syncthreads();
#pragma unroll
    for (int off = 1; off < 128; off <<= 1) {
        float o = 0.f;
        if (F.tid < 256) { const int tp = d ? t + off : t - off; if (tp >= 0 && tp < 128) o = sL[d * 128 + tp]; }
        __syncthreads();
        if (F.tid < 256) { v += o; sL[F.tid] = v; }
        __syncthreads();
    }
}
template <bool PASS2>
__device__ __forceinline__ void ssd_task(const Ctx& F, const LayerW& W, unsigned char* ws, int task) {
    const bf16_t* XBC = (const bf16_t*)(ws + WS_XBC); const float* DTS = (const float*)(ws + WS_DTS); const float* LA = (const float*)(ws + WS_DEC);
    float* SST = (float*)(ws + WS_SST); float* SCD = (float*)(ws + WS_SCD); float* YS = (float*)(ws + WS_YS);
    const int c = task % NCH, bh = task / NCH, h = bh & 7, b = bh >> 3, gi = h >> 2;
    const int g0 = c < 2 ? NLAT + b * CTXL + c * 128 : b * SEQL + (c - 2) * 128;
    const int w = F.wave, l16 = F.lane & 15, g = F.lane >> 4;
    const f32x4 z4 = {0.f, 0.f, 0.f, 0.f};
    LAS float* sL = (LAS float*)(F.lds + 131072);
    LAS float* sDT = sL + 256;
    __syncthreads();
    if (F.tid < 256) { const int s = F.tid >> 1, d = F.tid & 1; sDT[F.tid] = DTS[(size_t)(g0 + s) * 16 + d * 8 + h]; }
    ssd_scan_L(F, sL, LA, g0, h);
    if (!PASS2) {
        LAS bf16_t* sBT = (LAS bf16_t*)F.lds;
        LAS bf16_t* sXT = sBT + 128 * SB_PITCH;
#pragma unroll
        for (int q = 0; q < 4; ++q) { const int v = F.tid + 512 * q, s = v >> 4, part = v & 15;
            const u32x4 bv = *(const u32x4*)(XBC + (size_t)(g0 + s) * 1024 + 512 + gi * 128 + part * 8);
#pragma unroll
            for (int e = 0; e < 4; ++e) { sBT[(part * 8 + 2 * e) * SB_PITCH + s] = (bf16_t)(bv[e] & 0xffffu); sBT[(part * 8 + 2 * e + 1) * SB_PITCH + s] = (bf16_t)(bv[e] >> 16); } }
#pragma unroll
        for (int q = 0; q < 2; ++q) { const int v = F.tid + 512 * q, s = v >> 3, part = v & 7;
            const u32x4 xv = *(const u32x4*)(XBC + (size_t)(g0 + s) * 1024 + h * 64 + part * 8);
            const float sc0 = sDT[s * 2] * __expf(sL[127] - sL[s]), sc1 = sDT[s * 2 + 1] * __expf(sL[128] - sL[128 + s]);
#pragma unroll
            for (int e = 0; e < 4; ++e) { const float lo = bflo(xv[e]), hi = bfhi(xv[e]); const int p = part * 8 + 2 * e;
                sXT[p * SB_PITCH + s] = f2bf(lo * sc0); sXT[(p + 1) * SB_PITCH + s] = f2bf(hi * sc0);
                sXT[(64 + p) * SB_PITCH + s] = f2bf(lo * sc1); sXT[(64 + p + 1) * SB_PITCH + s] = f2bf(hi * sc1); } }
        __syncthreads();
        bf16x8 bfr[4];
#pragma unroll
        for (int ks = 0; ks < 4; ++ks) bfr[ks] = *(const LAS bf16x8*)(sBT + (16 * w + l16) * SB_PITCH + 32 * ks + 8 * g);
#pragma unroll
        for (int d = 0; d < 2; ++d) {
            float* st = SST + ((size_t)((b * 8 + h) * 2 + d) * NCH + c) * 8192;
#pragma unroll
            for (int pt = 0; pt < 4; ++pt) { f32x4 acc = z4;
#pragma unroll
                for (int ks = 0; ks < 4; ++ks) acc = __builtin_amdgcn_mfma_f32_16x16x32_bf16(*(const LAS bf16x8*)(sXT + (d * 64 + 16 * pt + l16) * SB_PITCH + 32 * ks + 8 * g), bfr[ks], acc, 0, 0, 0);
#pragma unroll
                for (int r = 0; r < 4; ++r) st[(16 * pt + 4 * g + r) * 128 + 16 * w + l16] = acc[r]; }
            if (F.tid == 0) SCD[((b * 8 + h) * 2 + d) * NCH + c] = __expf(d ? sL[128] : sL[127]);
        }
    } else {
        LAS bf16_t* sB = (LAS bf16_t*)F.lds;
        LAS bf16_t* sC = sB + 128 * SB_PITCH;
        LAS bf16_t* sXT = sC + 128 * SB_PITCH;
        LAS bf16_t* sS = sXT + 64 * SB_PITCH;
#pragma unroll
        for (int q = 0; q < 4; ++q) { const int v = F.tid + 512 * q, s = v >> 4, part = v & 15;
            *(LAS u32x4*)(sB + s * SB_PITCH + part * 8) = *(const u32x4*)(XBC + (size_t)(g0 + s) * 1024 + 512 + gi * 128 + part * 8);
            *(LAS u32x4*)(sC + s * SB_PITCH + part * 8) = *(const u32x4*)(XBC + (size_t)(g0 + s) * 1024 + 768 + gi * 128 + part * 8); }
#pragma unroll
        for (int q = 0; q < 2; ++q) { const int v = F.tid + 512 * q, s = v >> 3, part = v & 7;
            const u32x4 xv = *(const u32x4*)(XBC + (size_t)(g0 + s) * 1024 + h * 64 + part * 8);
#pragma unroll
            for (int e = 0; e < 4; ++e) { sXT[(part * 8 + 2 * e) * SB_PITCH + s] = (bf16_t)(xv[e] & 0xffffu); sXT[(part * 8 + 2 * e + 1) * SB_PITCH + s] = (bf16_t)(xv[e] >> 16); } }
#pragma unroll
        for (int q = 0; q < 4; ++q) { const int v = F.tid + 512 * q, d = v >> 10, p = (v >> 4) & 63, part = v & 15;
            const float* sp = SST + ((size_t)((b * 8 + h) * 2 + d) * NCH + c) * 8192 + p * 128 + part * 8;
            const float4 a0 = *(const float4*)sp, a1 = *(const float4*)(sp + 4);
            u32x4 o; o.x = pk_bf16(a0.x, a0.y); o.y = pk_bf16(a0.z, a0.w); o.z = pk_bf16(a1.x, a1.y); o.w = pk_bf16(a1.z, a1.w);
            *(LAS u32x4*)(sS + (d * 64 + p) * SB_PITCH + part * 8) = o; }
        __syncthreads();
        const int t = 16 * w + l16;
        bf16x8 cfr[4];
#pragma unroll
        for (int ks = 0; ks < 4; ++ks) cfr[ks] = *(const LAS bf16x8*)(sC + t * SB_PITCH + 32 * ks + 8 * g);
        f32x4 gt[8];
#pragma unroll
        for (int a = 0; a < 8; ++a) { f32x4 acc = z4;
#pragma unroll
            for (int ks = 0; ks < 4; ++ks) acc = __builtin_amdgcn_mfma_f32_16x16x32_bf16(*(const LAS bf16x8*)(sB + (16 * a + l16) * SB_PITCH + 32 * ks + 8 * g), cfr[ks], acc, 0, 0, 0);
            gt[a] = acc; }
        f32x4 ysum[4] = {z4, z4, z4, z4};
#pragma unroll
        for (int d = 0; d < 2; ++d) {
            const float Lt = sL[d * 128 + t], eLt = __expf(Lt);
            f32x4 acc[4];
#pragma unroll
            for (int pt = 0; pt < 4; ++pt) { f32x4 a = z4;
#pragma unroll
                for (int ks = 0; ks < 4; ++ks) a = __builtin_amdgcn_mfma_f32_16x16x32_bf16(*(const LAS bf16x8*)(sS + (d * 64 + 16 * pt + l16) * SB_PITCH + 32 * ks + 8 * g), cfr[ks], a, 0, 0, 0);
                acc[pt] = a * eLt; }
#pragma unroll
            for (int m = 0; m < 4; ++m) {
                const bool need = d ? (2 * m + 1 >= w) : (2 * m <= w);
                if (need) {
                    f32x4 wt[2];
#pragma unroll
                    for (int u = 0; u < 2; ++u) { const int a = 2 * m + u;
                        const f32x4 Ls = *(const LAS f32x4*)(sL + d * 128 + 16 * a + 4 * g);
#pragma unroll
                        for (int r = 0; r < 4; ++r) { const int s = 16 * a + 4 * g + r; const bool ok = d ? (s >= t) : (s <= t);
                            const float dts = sDT[s * 2 + d];
                            wt[u][r] = ok ? gt[a][r] * __expf(Lt - Ls[r]) * dts : 0.f; } }
                    const bf16x8 bfrag = pack8(wt[0], wt[1]);
#pragma unroll
                    for (int pt = 0; pt < 4; ++pt) { union { bf16x8 v; u32x2 hh[2]; } af;
                        af.hh[0] = *(const LAS u32x2*)(sXT + (16 * pt + l16) * SB_PITCH + 32 * m + 4 * g); af.hh[1] = *(const LAS u32x2*)(sXT + (16 * pt + l16) * SB_PITCH + 32 * m + 16 + 4 * g);
                        acc[pt] = __builtin_amdgcn_mfma_f32_16x16x32_bf16(af.v, bfrag, acc[pt], 0, 0, 0); }
                }
            }
#pragma unroll
            for (int pt = 0; pt < 4; ++pt) ysum[pt] = ysum[pt] + acc[pt];
        }
        const float dsk = W.s_d[h];
#pragma unroll
        for (int pt = 0; pt < 4; ++pt) { const int p = 16 * pt + 4 * g;
            const u32x2 xv = *(const u32x2*)(XBC + (size_t)(g0 + t) * 1024 + h * 64 + p);
            *(float4*)(YS + (size_t)(g0 + t) * 512 + h * 64 + p) = make_float4(ysum[pt][0] + dsk * bflo(xv.x), ysum[pt][1] + dsk * bfhi(xv.x), ysum[pt][2] + dsk * bflo(xv.y), ysum[pt][3] + dsk * bfhi(xv.y)); }
    }
}
template <int D> __device__ __forceinline__ void ssd_combine_one(float4* base, const float* scd) {
    float4 carry = make_float4(0.f, 0.f, 0.f, 0.f);
#pragma unroll
    for (int k0 = 0; k0 < NCH; k0 += 17) {
        float4 tmp[17];
#pragma unroll
        for (int k = 0; k < 17; ++k) { const int kk = k0 + k, c = D ? (kk < 2 ? 1 - kk : 35 - kk) : kk; tmp[k] = base[(size_t)c * 2048]; }
#pragma unroll
        for (int k = 0; k < 17; ++k) { const int kk = k0 + k, c = D ? (kk < 2 ? 1 - kk : 35 - kk) : kk; const float a = scd[c];
            base[(size_t)c * 2048] = carry;
            carry.x = a * carry.x + tmp[k].x; carry.y = a * carry.y + tmp[k].y; carry.z = a * carry.z + tmp[k].z; carry.w = a * carry.w + tmp[k].w; }
    }
}
__device__ __forceinline__ void phase_ssd_combine(const Ctx& F, unsigned char* ws) {
    float4* SST4 = (float4*)(ws + WS_SST); const float* SCD = (const float*)(ws + WS_SCD);
    for (int gt = F.bid * 512 + F.tid; gt < 64 * 2048; gt += F.G * 512) {
        const int sidx = gt >> 11, e4 = gt & 2047;
        float4* base = SST4 + (size_t)sidx * NCH * 2048 + e4;
        if (sidx & 1) ssd_combine_one<1>(base, SCD + sidx * NCH); else ssd_combine_one<0>(base, SCD + sidx * NCH);
    }
}

constexpr int RWF_CHUNK = 10496;
constexpr int RW_NCHUNK = NPOS / 16;
template <int CTRL> __device__ __forceinline__ float dpp_id1(float v) { return __int_as_float(__builtin_amdgcn_update_dpp(0x3f800000, __float_as_int(v), CTRL, 0xF, 0xF, false)); }
__device__ __forceinline__ float sel4(int g, float a, float b, float c, float d) { return g == 0 ? a : (g == 1 ? b : (g == 2 ? c : d)); }

template <int D> __device__ __forceinline__ void rwkv_pre_dir(const bf16_t* wupt, const bf16x8 (&bw)[2], const bf16x8 (&ba)[2], const f32x4 (&kk)[4], const f32x4 (&rr)[4], const f32x4 (&kx)[4],
        const float* w0p, const float* a0p, const float* kap, const float* rkp, float& bon, LAS unsigned char* wl, unsigned char* dst, int l16, int g) {
    LAS float* LT = (LAS float*)wl; LAS float* AT = LT + 256; LAS bf16_t* BT = (LAS bf16_t*)(wl + 2048); LAS bf16_t* KT = BT + 1024;
    const int lane = g * 16 + l16;
    bf16x8* o = (bf16x8*)dst;
    const f32x4 z4 = {0.f, 0.f, 0.f, 0.f};
    bf16x8 af[2], bf[2], kf[2], rf[2];
#pragma unroll
    for (int p = 0; p < 2; ++p) {
        f32x4 al[2], be[2], ka[2], rh[2];
#pragma unroll
        for (int mm = 0; mm < 2; ++mm) { const int m = 2 * p + mm; asm volatile("" ::: "memory");
            const bf16_t* wpw = wupt + ((size_t)D * 512 + 16 * m + l16) * 64 + 8 * g; const bf16_t* wpa = wupt + ((size_t)(2 + D) * 512 + 16 * m + l16) * 64 + 8 * g;
            f32x4 aw = __builtin_amdgcn_mfma_f32_16x16x32_bf16(*(const bf16x8*)wpw, bw[0], z4, 0, 0, 0); aw = __builtin_amdgcn_mfma_f32_16x16x32_bf16(*(const bf16x8*)(wpw + 32), bw[1], aw, 0, 0, 0);
            f32x4 aa = __builtin_amdgcn_mfma_f32_16x16x32_bf16(*(const bf16x8*)wpa, ba[0], z4, 0, 0, 0); aa = __builtin_amdgcn_mfma_f32_16x16x32_bf16(*(const bf16x8*)(wpa + 32), ba[1], aa, 0, 0, 0);
            const float4 w0 = *(const float4*)(w0p + 16 * m + 4 * g), a0 = *(const float4*)(a0p + 16 * m + 4 * g), kav = *(const float4*)(kap + 16 * m + 4 * g), rkv = *(const float4*)(rkp + 16 * m + 4 * g);
            const float w0a[4] = {w0.x, w0.y, w0.z, w0.w}, a0a[4] = {a0.x, a0.y, a0.z, a0.w}, kaa[4] = {kav.x, kav.y, kav.z, kav.w}, rka[4] = {rkv.x, rkv.y, rkv.z, rkv.w};
            f32x4 gcv;
#pragma unroll
            for (int r = 0; r < 4; ++r) {
                const float w = __expf(-0.6065306597126334f * sigmoidf_(w0a[r] + aw[r])), a = sigmoidf_(a0a[r] + aa[r]);
                const float kd = kx[m][r] * (1.f + (a - 1.f) * kaa[r]), bb = kk[m][r] * a;
                bon += rr[m][r] * kd * rka[r];
                float G = w;
                if (D == 0) { G *= dpp_id1<0x111>(G); G *= dpp_id1<0x112>(G); G *= dpp_id1<0x114>(G); G *= dpp_id1<0x118>(G); }
                else        { G *= dpp_id1<0x101>(G); G *= dpp_id1<0x102>(G); G *= dpp_id1<0x104>(G); G *= dpp_id1<0x108>(G); }
                const float Gex = (D == 0) ? dpp_id1<0x111>(G) : dpp_id1<0x101>(G);
                const float iG = rcpf_(G);
                al[mm][r] = Gex * kk[m][r]; be[mm][r] = bb * iG; ka[mm][r] = kd * iG; rh[mm][r] = G * rr[m][r]; gcv[r] = G;
                const int k = 16 * m + 4 * g + r; BT[k * 16 + l16] = f2bf(be[mm][r]); KT[k * 16 + l16] = f2bf(ka[mm][r]);
            }
            if (l16 == ((D == 0) ? 15 : 0)) *(float4*)((float*)(dst + 10240) + 16 * m + 4 * g) = make_float4(gcv[0], gcv[1], gcv[2], gcv[3]);
        }
        af[p] = pack8(al[0], al[1]); bf[p] = pack8(be[0], be[1]); kf[p] = pack8(ka[0], ka[1]); rf[p] = pack8(rh[0], rh[1]);
        o[64 * p + lane] = af[p]; o[128 + 64 * p + lane] = rf[p];
        __builtin_amdgcn_sched_barrier(0);
    }
    f32x4 Lm = __builtin_amdgcn_mfma_f32_16x16x32_bf16(af[0], bf[0], z4, 0, 0, 0); Lm = __builtin_amdgcn_mfma_f32_16x16x32_bf16(af[1], bf[1], Lm, 0, 0, 0);
    f32x4 Am = __builtin_amdgcn_mfma_f32_16x16x32_bf16(af[0], kf[0], z4, 0, 0, 0); Am = __builtin_amdgcn_mfma_f32_16x16x32_bf16(af[1], kf[1], Am, 0, 0, 0);
    f32x4 Bb = __builtin_amdgcn_mfma_f32_16x16x32_bf16(bf[0], rf[0], z4, 0, 0, 0); Bb = __builtin_amdgcn_mfma_f32_16x16x32_bf16(bf[1], rf[1], Bb, 0, 0, 0);
    f32x4 Bk = __builtin_amdgcn_mfma_f32_16x16x32_bf16(kf[0], rf[0], z4, 0, 0, 0); Bk = __builtin_amdgcn_mfma_f32_16x16x32_bf16(kf[1], rf[1], Bk, 0, 0, 0);
#pragma unroll
    for (int r = 0; r < 4; ++r) { const int row = 4 * g + r;
        const bool strict = (D == 0) ? (l16 < row) : (l16 > row);
        const bool incl = (D == 0) ? (row <= l16) : (row >= l16);
        Lm[r] = strict ? Lm[r] : 0.f; Am[r] = strict ? Am[r] : 0.f; Bb[r] = incl ? Bb[r] : 0.f; Bk[r] = incl ? Bk[r] : 0.f; }
    *(LAS f32x4*)(LT + l16 * 16 + 4 * g) = Lm; *(LAS f32x4*)(AT + l16 * 16 + 4 * g) = Am;
    o[320 + lane] = pack8(Bb, Bk);
    asm volatile("" ::: "memory");
#pragma unroll
    for (int m = 0; m < 4; ++m) { union { bf16x8 v; u32x2 h[2]; } f;
        f.h[0] = *(LAS u32x2*)(BT + (16 * m + l16) * 16 + 4 * g); f.h[1] = *(LAS u32x2*)(KT + (16 * m + l16) * 16 + 4 * g);
        o[384 + 64 * m + lane] = f.v; }
    __builtin_amdgcn_sched_barrier(0);
    float x[16];
    if (D == 0) {
#pragma unroll
        for (int c = 15; c >= 0; --c) { float s = (c == l16) ? 1.f : 0.f; asm volatile("" ::: "memory");
#pragma unroll
            for (int i = c + 1; i < 16; ++i) s -= x[i] * LT[c * 16 + i];
            x[c] = s; }
    } else {
#pragma unroll
        for (int c = 0; c < 16; ++c) { float s = (c == l16) ? 1.f : 0.f; asm volatile("" ::: "memory");
#pragma unroll
            for (int i = 0; i < c; ++i) s -= x[i] * LT[c * 16 + i];
            x[c] = s; }
    }
    f32x4 tm0, tm1;
#pragma unroll
    for (int r = 0; r < 4; ++r) tm0[r] = -sel4(g, x[r], x[4 + r], x[8 + r], x[12 + r]);
#pragma unroll
    for (int r = 0; r < 4; ++r) { float yv[4];
#pragma unroll
        for (int q = 0; q < 4; ++q) { const int c = 4 * q + r; float s = 0.f; asm volatile("" ::: "memory");
#pragma unroll
            for (int i = 0; i < 16; ++i) if ((D == 0) ? (i > c) : (i < c)) s += x[i] * AT[c * 16 + i];
            yv[q] = s; }
        tm1[r] = -sel4(g, yv[0], yv[1], yv[2], yv[3]); }
    o[256 + lane] = pack8(tm0, tm1);
    asm volatile("" ::: "memory");
}
__device__ __forceinline__ void rwkv_pre_task(const Ctx& F, const LayerW& W, unsigned char* ws, const bf16_t* WUPT, int task, int dsel) {
    const bf16_t* P = (const bf16_t*)(ws + WS_P); float* BON = (float*)(ws + WS_BON); unsigned char* RWF = ws + WS_RWF;
    const int cidx = task % RW_NCHUNK, bh = task / RW_NCHUNK, h = bh & 7, b = bh >> 3;
    int ln_ = F.lane; asm volatile("" : "+v"(ln_));
    const int l16 = ln_ & 15, g = ln_ >> 4;
    const int pos = cidx * 16 + l16;
    const int tok = pos < CTXL ? NLAT + b * CTXL + pos : b * SEQL + (pos - CTXL);
    const bf16_t* Pr = P + (size_t)tok * PTP;
    LAS unsigned char* wl = F.lds + F.wave * 8192;
    bf16x8 bw[2], ba[2];
#pragma unroll
    for (int p = 0; p < 2; ++p) { const u32x4 q = *(const u32x4*)(Pr + B_WD + 32 * p + 8 * g); union { bf16x8 v; unsigned u[4]; } tq;
#pragma unroll
        for (int e = 0; e < 4; ++e) tq.u[e] = pk_bf16(tanhf_(bflo(q[e])), tanhf_(bfhi(q[e])));
        bw[p] = tq.v; ba[p] = *(const bf16x8*)(Pr + B_AD + 32 * p + 8 * g); }
    f32x4 kk[4], rr[4], kx[4];
    float ssq = 0.f;
#pragma unroll
    for (int m = 0; m < 4; ++m) { const int co = h * 64 + 16 * m + 4 * g;
        const u32x2 rq = *(const u32x2*)(Pr + B_R + co), kq = *(const u32x2*)(Pr + B_K + co); const float4 kkw = *(const float4*)(W.rw_kk + co);
        rr[m] = (f32x4){bflo(rq.x), bfhi(rq.x), bflo(rq.y), bfhi(rq.y)}; kx[m] = (f32x4){bflo(kq.x), bfhi(kq.x), bflo(kq.y), bfhi(kq.y)};
        kk[m] = (f32x4){kx[m][0] * kkw.x, kx[m][1] * kkw.y, kx[m][2] * kkw.z, kx[m][3] * kkw.w};
        ssq += kk[m][0] * kk[m][0] + kk[m][1] * kk[m][1] + kk[m][2] * kk[m][2] + kk[m][3] * kk[m][3]; }
    ssq += xor16_f(ssq); ssq = sum_x32(ssq);
    { const float rn = rsqrtf(ssq + 1e-12f);
#pragma unroll
      for (int m = 0; m < 4; ++m) kk[m] = kk[m] * rn; }
    float bon = 0.f;
    const int co = h * 64;
    const int c0 = cidx, c1 = cidx < 16 ? 15 - cidx : 287 - cidx;
    if (dsel == 0) rwkv_pre_dir<0>(WUPT + (size_t)co * 64, bw, ba, kk, rr, kx, W.rw_w0 + co, W.rw_a0 + co, W.rw_ka + co, W.rw_rk + co, bon, wl, RWF + ((size_t)(bh * 2 + 0) * RW_NCHUNK + c0) * RWF_CHUNK, l16, g);
    else           rwkv_pre_dir<1>(WUPT + (size_t)co * 64, bw, ba, kk, rr, kx, W.rw_w0 + 512 + co, W.rw_a0 + 512 + co, W.rw_ka + co, W.rw_rk + co, bon, wl, RWF + ((size_t)(bh * 2 + 1) * RW_NCHUNK + c1) * RWF_CHUNK, l16, g);
    bon += xor16_f(bon); bon = sum_x32(bon);
    if (g == 0) BON[((size_t)dsel * NTOK + tok) * 8 + h] = bon;
}
struct RwFrag { bf16x8 a0, a1, r0, r1, tm, bb, bk0, bk1, bk2, bk3; f32x4 g0, g1, g2, g3; u32x2 v; };
__device__ __forceinline__ void rwkv_scan(const Ctx& F, unsigned char* ws, int sidx) {
    if (F.wave >= 4) return;
    const bf16_t* P = (const bf16_t*)(ws + WS_P); bf16_t* RWY = (bf16_t*)(ws + WS_RWY);
    const int d = sidx & 1, h = (sidx >> 1) & 7, b = sidx >> 4, n = F.wave, l16 = F.lane & 15, g = F.lane >> 4;
    const unsigned char* base = ws + WS_RWF + (size_t)sidx * RW_NCHUNK * RWF_CHUNK;
    const int vcol = B_V + h * 64 + 16 * n + l16;
#define RW_CIDX(c) (d ? ((c) < 16 ? 15 - (c) : 287 - (c)) : (c))
#define RW_TOK(cidx, i) (((cidx) * 16 + (i)) < CTXL ? NLAT + b * CTXL + (cidx) * 16 + (i) : b * SEQL + ((cidx) * 16 + (i) - CTXL))
#define RW_LOADF(fr, c) do { const bf16x8* q_ = (const bf16x8*)(base + (size_t)(c) * RWF_CHUNK) + F.lane; \
        fr.a0 = q_[0]; fr.a1 = q_[64]; fr.r0 = q_[128]; fr.r1 = q_[192]; fr.tm = q_[256]; fr.bb = q_[320]; fr.bk0 = q_[384]; fr.bk1 = q_[448]; fr.bk2 = q_[512]; fr.bk3 = q_[576]; \
        const f32x4* gp_ = (const f32x4*)(base + (size_t)(c) * RWF_CHUNK + 10240) + g; fr.g0 = gp_[0]; fr.g1 = gp_[4]; fr.g2 = gp_[8]; fr.g3 = gp_[12]; \
        const int ci_ = RW_CIDX(c); unsigned short v_[4]; _Pragma("unroll") for (int j_ = 0; j_ < 4; ++j_) v_[j_] = P[(size_t)RW_TOK(ci_, 4 * g + j_) * PTP + vcol]; \
        fr.v.x = (unsigned)v_[0] | ((unsigned)v_[1] << 16); fr.v.y = (unsigned)v_[2] | ((unsigned)v_[3] << 16); } while (0)
    f32x4 st0 = {0.f, 0.f, 0.f, 0.f}, st1 = st0, st2 = st0, st3 = st0;
    const f32x4 z4 = {0.f, 0.f, 0.f, 0.f};
#define RW_STEP(fr, c) do { \
        const bf16x8 s0_ = pack8(st0, st1), s1_ = pack8(st2, st3); \
        f32x4 x1_ = __builtin_amdgcn_mfma_f32_16x16x32_bf16(fr.a0, s0_, z4, 0, 0, 0); x1_ = __builtin_amdgcn_mfma_f32_16x16x32_bf16(fr.a1, s1_, x1_, 0, 0, 0); \
        f32x4 x2_ = __builtin_amdgcn_mfma_f32_16x16x32_bf16(fr.r0, s0_, z4, 0, 0, 0); x2_ = __builtin_amdgcn_mfma_f32_16x16x32_bf16(fr.r1, s1_, x2_, 0, 0, 0); \
        union { bf16x8 v; unsigned u[4]; } bx_; bx_.u[0] = pk_bf16(x1_[0], x1_[1]); bx_.u[1] = pk_bf16(x1_[2], x1_[3]); bx_.u[2] = fr.v.x; bx_.u[3] = fr.v.y; \
        const f32x4 e_ = __builtin_amdgcn_mfma_f32_16x16x32_bf16(fr.tm, bx_.v, z4, 0, 0, 0); \
        union { bf16x8 v; unsigned u[4]; } be_; be_.u[0] = pk_bf16(e_[0], e_[1]); be_.u[1] = pk_bf16(e_[2], e_[3]); be_.u[2] = fr.v.x; be_.u[3] = fr.v.y; \
        const f32x4 o_ = __builtin_amdgcn_mfma_f32_16x16x32_bf16(fr.bb, be_.v, x2_, 0, 0, 0); \
        st0 = __builtin_amdgcn_mfma_f32_16x16x32_bf16(fr.bk0, be_.v, st0, 0, 0, 0) * fr.g0; st1 = __builtin_amdgcn_mfma_f32_16x16x32_bf16(fr.bk1, be_.v, st1, 0, 0, 0) * fr.g1; \
        st2 = __builtin_amdgcn_mfma_f32_16x16x32_bf16(fr.bk2, be_.v, st2, 0, 0, 0) * fr.g2; st3 = __builtin_amdgcn_mfma_f32_16x16x32_bf16(fr.bk3, be_.v, st3, 0, 0, 0) * fr.g3; \
        const int ci_ = RW_CIDX(c); \
        _Pragma("unroll") for (int j_ = 0; j_ < 4; ++j_) RWY[((size_t)d * NTOK + RW_TOK(ci_, 4 * g + j_)) * 512 + h * 64 + 16 * n + l16] = f2bf(o_[j_]); } while (0)
    RwFrag fa, fb, fc;
#define RW_CL(c) ((c) < RW_NCHUNK ? (c) : RW_NCHUNK - 1)
    RW_LOADF(fa, 0); RW_LOADF(fb, 1);
    int c = 0;
    for (; c + 3 <= RW_NCHUNK; c += 3) {
        RW_LOADF(fc, RW_CL(c + 2)); RW_STEP(fa, c);
        RW_LOADF(fa, RW_CL(c + 3)); RW_STEP(fb, c + 1);
        RW_LOADF(fb, RW_CL(c + 4)); RW_STEP(fc, c + 2);
    }
    if (c < RW_NCHUNK) { RW_STEP(fa, c); if (c + 1 < RW_NCHUNK) RW_STEP(fb, c + 1); }
#undef RW_CL
#undef RW_CIDX
#undef RW_TOK
#undef RW_LOADF
#undef RW_STEP
}

__device__ __forceinline__ void na_tile(const Ctx& F, unsigned char* ws, const LAS float* sBias, int tile) {
    const bf16_t* QN = (const bf16_t*)(ws + WS_QN); const bf16_t* KN = (const bf16_t*)(ws + WS_KN);
    const bf16_t* VTL = (const bf16_t*)(ws + WS_VTL); const bf16_t* VTC = (const bf16_t*)(ws + WS_VTC); bf16_t* MIX = (bf16_t*)(ws + WS_MIX);
    const int h = F.wave, l16 = F.lane & 15, g = F.lane >> 4;
    const bool lat = tile < 1024;
    int b, r = 0, j = 0, gq;
    if (lat) { b = tile >> 8; r = (tile >> 2) & 63; j = tile & 3; gq = b * SEQL + r * 64 + j * 16 + l16; }
    else { const int tc = tile - 1024; b = tc >> 4; gq = NLAT + b * CTXL + (tc & 15) * 16 + l16; }
    const int row0 = min(max(r - 4, 0), 56), col0 = min(max(16 * j - 8, 0), 32);
    bf16x8 qf0, qf1;
    { const bf16_t* qp = QN + (size_t)gq * 512 + h * 64 + g * 8; qf0 = *(const bf16x8*)qp; qf1 = *(const bf16x8*)(qp + 32); }
    const f32x4 zero4 = {0.f, 0.f, 0.f, 0.f};
    const int cq = 16 * j + l16, win0 = min(max(cq - 8, 0), 48);
    const bf16_t* knb = KN + (size_t)(b * SEQL + row0 * 64 + col0 + l16) * 512 + h * 64 + g * 8;
    const bf16_t* kcx = KN + (size_t)(NLAT + b * CTXL + l16) * 512 + h * 64 + g * 8;
    const bf16_t* vnb = VTL + ((size_t)((b * 8 + h) * 64 + l16) * 64 + row0) * 96 + (col0 / 4 + g) * 8;
    const bf16_t* vcx = VTC + (size_t)((b * 8 + h) * 64 + l16) * 8 * 32 + g * 8;
    float mrun = -1e30f, lrun = 0.f;
    f32x4 o[4] = {zero4, zero4, zero4, zero4};
#pragma unroll
    for (int hf = 0; hf < 2; ++hf) {
        if (hf == 0 && !lat) continue;
        bf16x8 fr[32];
#pragma unroll
        for (int T = 0; T < 16; ++T) { const bf16_t* kp = hf == 0 ? knb + (size_t)((T >> 1) * 64 + (T & 1) * 16) * 512 : kcx + (size_t)T * 16 * 512;
            fr[2 * T] = *(const bf16x8*)kp; fr[2 * T + 1] = *(const bf16x8*)(kp + 32); }
        asm volatile("" ::: "memory");
        f32x4 acc[16];
#pragma unroll
        for (int T = 0; T < 16; ++T) { f32x4 a = __builtin_amdgcn_mfma_f32_16x16x32_bf16(fr[2 * T], qf0, zero4, 0, 0, 0); a = __builtin_amdgcn_mfma_f32_16x16x32_bf16(fr[2 * T + 1], qf1, a, 0, 0, 0);
            if (hf == 0) { const int ir = T >> 1, hh = T & 1, kr = row0 + ir; const LAS float* bias = sBias + (kr - r + 7) * 31;
#pragma unroll
                for (int e = 0; e < 4; ++e) { const int kc = col0 + 16 * hh + 4 * g + e; const bool ok = (kc >= win0) && (kc < win0 + 16);
                    const int dc = min(max(kc - cq + 15, 0), 30); a[e] = ok ? a[e] + bias[dc] : -1e30f; } }
            acc[T] = a; }
#pragma unroll
        for (int m = 0; m < 8; ++m)
#pragma unroll
            for (int dt = 0; dt < 4; ++dt) fr[4 * m + dt] = *(const bf16x8*)(hf == 0 ? vnb + (size_t)(dt * 16 * 64 + m) * 96 : vcx + (size_t)dt * 16 * 8 * 32 + m * 32);
        asm volatile("" ::: "memory");
        float mx = mrun;
#pragma unroll
        for (int T = 0; T < 16; ++T) mx = fmaxf(fmaxf(fmaxf(acc[T][0], acc[T][1]), fmaxf(acc[T][2], acc[T][3])), mx);
        mx = fmaxf(mx, xor16_f(mx)); mx = max_x32(mx);
        const float alpha = __expf(mrun - mx);
        float lsum = 0.f;
#pragma unroll
        for (int T = 0; T < 16; ++T) {
#pragma unroll
            for (int q = 0; q < 4; ++q) { const float pv = __expf(acc[T][q] - mx); acc[T][q] = pv; lsum += pv; } }
        lsum += xor16_f(lsum); lsum = sum_x32(lsum);
        lrun = lrun * alpha + lsum; mrun = mx;
#pragma unroll
        for (int dt = 0; dt < 4; ++dt) o[dt] = o[dt] * alpha;
#pragma unroll
        for (int m = 0; m < 8; ++m) { const bf16x8 pf = pack8(acc[2 * m], acc[2 * m + 1]);
#pragma unroll
            for (int dt = 0; dt < 4; ++dt) o[dt] = __builtin_amdgcn_mfma_f32_16x16x32_bf16(fr[4 * m + dt], pf, o[dt], 0, 0, 0); }
    }
    const float inv = 1.0f / lrun;
#pragma unroll
    for (int dt = 0; dt < 4; ++dt) { u32x2 w; w.x = pk_bf16(o[dt][0] * inv, o[dt][1] * inv); w.y = pk_bf16(o[dt][2] * inv, o[dt][3] * inv);
        *(u32x2*)(MIX + (size_t)gq * 2048 + 1024 + h * 64 + dt * 16 + 4 * g) = w; }
}
__device__ __forceinline__ void na_phase(const Ctx& F, const LayerW& W, unsigned char* ws, int blk, int nblk, int ntile) {
    LAS float* sBias = (LAS float*)(F.lds + F.wave * 2048);
    __syncthreads();
    for (int idx = F.lane; idx < 465; idx += 64) sBias[idx] = W.rpb[F.wave * 465 + idx];
    asm volatile("" ::: "memory");
    for (int tile = blk; tile < ntile; tile += nblk) na_tile(F, ws, sBias, tile);
}

__device__ __forceinline__ void phase_finish(const Ctx& F, const LayerW& W, unsigned char* ws, const bf16_t* GUPT, int ntok) {
    const bf16_t* P = (const bf16_t*)(ws + WS_P); bf16_t* MIX = (bf16_t*)(ws + WS_MIX);
    const bf16_t* RWY = (const bf16_t*)(ws + WS_RWY); const float* BON = (const float*)(ws + WS_BON); const float* YS = (const float*)(ws + WS_YS);
    const f32x4 z4 = {0.f, 0.f, 0.f, 0.f};
    for (int task = F.bid * 8 + F.wave; task < (ntok / 16) * 8; task += F.G * 8) {
        int ln = F.lane; asm volatile("" : "+v"(ln));
        const int l16 = ln & 15, g = ln >> 4, h = task & 7, tok = (task >> 3) * 16 + l16;
        const bf16_t* Pr = P + (size_t)tok * PTP;
        bf16x8 sg[4];
#pragma unroll
        for (int ks = 0; ks < 4; ++ks) { const u32x4 q = *(const u32x4*)(Pr + B_GD + 32 * ks + 8 * g); union { bf16x8 v; unsigned u[4]; } s;
#pragma unroll
            for (int e = 0; e < 4; ++e) s.u[e] = pk_bf16(sigmoidf_(bflo(q[e])), sigmoidf_(bfhi(q[e])));
            sg[ks] = s.v; }
        f32x4 y[4]; float s1 = 0.f;
#pragma unroll
        for (int m = 0; m < 4; ++m) { const int co = h * 64 + 16 * m + 4 * g;
            const u32x2 a = *(const u32x2*)(RWY + (size_t)tok * 512 + co), bq = *(const u32x2*)(RWY + ((size_t)NTOK + tok) * 512 + co);
            y[m] = (f32x4){bflo(a.x) + bflo(bq.x), bfhi(a.x) + bfhi(bq.x), bflo(a.y) + bflo(bq.y), bfhi(a.y) + bfhi(bq.y)};
            s1 += (y[m][0] + y[m][1]) + (y[m][2] + y[m][3]); }
        s1 += xor16_f(s1); s1 = sum_x32(s1);
        const float mu = s1 * (1.f / 64.f); float s2 = 0.f;
#pragma unroll
        for (int m = 0; m < 4; ++m) { y[m] = y[m] - mu; s2 += (y[m][0] * y[m][0] + y[m][1] * y[m][1]) + (y[m][2] * y[m][2] + y[m][3] * y[m][3]); }
        s2 += xor16_f(s2); s2 = sum_x32(s2);
        const float rs = rsqrtf(s2 * (1.f / 64.f) + 64e-5f);
        const float bon = BON[(size_t)tok * 8 + h] + BON[((size_t)NTOK + tok) * 8 + h];
#pragma unroll
        for (int m = 0; m < 4; ++m) { const int co = h * 64 + 16 * m + 4 * g;
            f32x4 ga = z4;
#pragma unroll
            for (int ks = 0; ks < 4; ++ks) ga = __builtin_amdgcn_mfma_f32_16x16x32_bf16(*(const bf16x8*)(GUPT + (size_t)(h * 64 + 16 * m + l16) * 128 + 32 * ks + 8 * g), sg[ks], ga, 0, 0, 0);
            const float4 lw = *(const float4*)(W.rw_lnw + co), lb = *(const float4*)(W.rw_lnb + co); const u32x2 vq = *(const u32x2*)(Pr + B_V + co);
            const float o0 = (y[m][0] * rs * lw.x + lb.x + bon * bflo(vq.x)) * ga[0], o1 = (y[m][1] * rs * lw.y + lb.y + bon * bfhi(vq.x)) * ga[1];
            const float o2 = (y[m][2] * rs * lw.z + lb.z + bon * bflo(vq.y)) * ga[2], o3 = (y[m][3] * rs * lw.w + lb.w + bon * bfhi(vq.y)) * ga[3];
            u32x2 o; o.x = pk_bf16(o0, o1); o.y = pk_bf16(o2, o3);
            *(u32x2*)(MIX + (size_t)tok * 2048 + 512 + co) = o; }
    }
    for (int tok = F.bid * 8 + F.wave; tok < ntok; tok += F.G * 8) {
        const int c0 = F.lane * 8;
        float ys[8], z[8], gw[8];
        load8f(YS + (size_t)tok * 512 + c0, ys); unpack8(*(const u32x4*)(P + (size_t)tok * PTP + D_Z + c0), z); load8f(W.s_norm + c0, gw);
        float ss = 0.f;
#pragma unroll
        for (int e = 0; e < 8; ++e) { ys[e] *= siluf_(z[e]); ss += ys[e] * ys[e]; }
        ss = wave_sum(ss);
        const float rs = rsqrtf(ss * (1.f / 512.f) + 1e-6f);
#pragma unroll
        for (int e = 0; e < 8; ++e) ys[e] = ys[e] * rs * gw[e];
        *(u32x4*)(MIX + (size_t)tok * 2048 + 1536 + c0) = pack8f(ys);
    }
}

constexpr int RADIX_LOW_BIT = 10;
constexpr int RADIX_STEPS = 14;
__device__ __forceinline__ unsigned ordkey(float x) { const unsigned u = __float_as_uint(x); return (u & 0x80000000u) ? ~u : (u | 0x80000000u); }
template <int CTRL> __device__ __forceinline__ int dpp_i0(int v) { return __builtin_amdgcn_update_dpp(0, v, CTRL, 0xF, 0xF, true); }
__device__ __forceinline__ int rowscan_incl(int x) { x += dpp_i0<0x111>(x); x += dpp_i0<0x112>(x); x += dpp_i0<0x114>(x); x += dpp_i0<0x118>(x); return x; }
__device__ __forceinline__ void phase_scores(const Ctx& F, unsigned char* ws, int layer, int ntok) {
    const bf16_t* Q = (const bf16_t*)(ws + WS_P); const bf16_t* KEYS = (const bf16_t*)(ws + WS_KEYS) + (size_t)layer * 8 * 2 * 128 * 128;
    int* IDS = (int*)(ws + WS_IDS); float* GATES = (float*)(ws + WS_GATES);
    LAS bf16_t* sK = (LAS bf16_t*)F.lds;
    LAS float* sVv = (LAS float*)(F.lds + 2 * 128 * 136 * 2 + F.wave * 5120);
    LAS int* sVi = (LAS int*)(sVv + 512);
    const int ntg = ntok / 128, ntask = 8 * ntg;
    const int l16 = F.lane & 15, g = F.lane >> 4;
    const f32x4 z4 = {0.f, 0.f, 0.f, 0.f};
    int cur_h = -1;
    for (int task = F.bid; task < ntask; task += F.G) {
        const int h = task / ntg, tg = task % ntg;
        if (h != cur_h) { __syncthreads();
#pragma unroll
            for (int q = 0; q < 8; ++q) { const int v = F.tid + 512 * q, row = v >> 4, part = v & 15;
                *(LAS u32x4*)(sK + row * 136 + part * 8) = *(const u32x4*)(KEYS + ((size_t)h * 256 + row) * 128 + part * 8); }
            cur_h = h; __syncthreads(); }
        const int t0 = tg * 128 + F.wave * 16;
#pragma unroll 1
        for (int p = 0; p < 2; ++p) {
            bf16x8 qf[4];
#pragma unroll
            for (int ks = 0; ks < 4; ++ks) qf[ks] = *(const bf16x8*)(Q + (size_t)(t0 + l16) * 2048 + h * 256 + p * 128 + 32 * ks + 8 * g);
            f32x4 acc[8];
#pragma unroll
            for (int kt = 0; kt < 8; ++kt) { f32x4 a = z4;
#pragma unroll
                for (int ks = 0; ks < 4; ++ks) a = __builtin_amdgcn_mfma_f32_16x16x32_bf16(qf[ks], *(const LAS bf16x8*)(sK + (p * 128 + 16 * kt + l16) * 136 + 32 * ks + 8 * g), a, 0, 0, 0);
                acc[kt] = a; }
            float lo0, lo1, lo2, lo3, hi0, hi1, hi2, hi3;
            { float m0 = acc[0][0], m1 = acc[0][1], m2 = acc[0][2], m3 = acc[0][3];
#pragma unroll
              for (int kt = 1; kt < 8; ++kt) { m0 = fmaxf(m0, acc[kt][0]); m1 = fmaxf(m1, acc[kt][1]); m2 = fmaxf(m2, acc[kt][2]); m3 = fmaxf(m3, acc[kt][3]); }
              hi0 = max16(m0); hi1 = max16(m1); hi2 = max16(m2); hi3 = max16(m3);
              lo0 = -max16(-m0); lo1 = -max16(-m1); lo2 = -max16(-m2); lo3 = -max16(-m3); }
#pragma unroll 1
            for (int it = 0; it < RADIX_STEPS; ++it) {
                const float c0 = 0.5f * (lo0 + hi0), c1 = 0.5f * (lo1 + hi1), c2 = 0.5f * (lo2 + hi2), c3 = 0.5f * (lo3 + hi3); int n0 = 0, n1 = 0, n2 = 0, n3 = 0;
#pragma unroll
                for (int kt = 0; kt < 8; ++kt) { n0 += acc[kt][0] >= c0; n1 += acc[kt][1] >= c1; n2 += acc[kt][2] >= c2; n3 += acc[kt][3] >= c3; }
                const bool k0 = sum16((float)n0) >= 16.f, k1 = sum16((float)n1) >= 16.f, k2 = sum16((float)n2) >= 16.f, k3 = sum16((float)n3) >= 16.f;
                lo0 = k0 ? c0 : lo0; hi0 = k0 ? hi0 : c0; lo1 = k1 ? c1 : lo1; hi1 = k1 ? hi1 : c1; lo2 = k2 ? c2 : lo2; hi2 = k2 ? hi2 : c2; lo3 = k3 ? c3 : lo3; hi3 = k3 ? hi3 : c3; }
#pragma unroll
            for (int r = 0; r < 4; ++r) { const float T = r == 0 ? lo0 : (r == 1 ? lo1 : (r == 2 ? lo2 : lo3));
                int cl = 0;
#pragma unroll
                for (int kt = 0; kt < 8; ++kt) cl += acc[kt][r] >= T;
                int rank = rowscan_incl(cl) - cl;
                LAS float* dv = sVv + ((4 * g + r) * 2 + p) * 16; LAS int* di = sVi + ((4 * g + r) * 2 + p) * 16;
#pragma unroll
                for (int kt = 0; kt < 8; ++kt) { const bool sel = acc[kt][r] >= T;
                    if (sel && rank < 16) { dv[rank] = acc[kt][r]; di[rank] = 16 * kt + l16; }
                    rank += sel ? 1 : 0; } }
        }
        asm volatile("" ::: "memory");
#pragma unroll 1
        for (int r = 0; r < 4; ++r) { const int tk = 4 * g + r;
            LAS float* sS = (LAS float*)(sVi + 512);
            LAS int* sI = (LAS int*)(sS + 128);
#pragma unroll
            for (int p = 0; p < 2; ++p) { const float v = sVv[(tk * 2 + p) * 16 + l16]; const int ix = sVi[(tk * 2 + p) * 16 + l16];
                const unsigned key = (ordkey(v) & ~15u) | (unsigned)(15 - l16); int rk = 0;
#pragma unroll
                for (int q = 0; q < 4; ++q) { const f32x4 o = *(const LAS f32x4*)(sVv + (tk * 2 + p) * 16 + 4 * q);
#pragma unroll
                    for (int e = 0; e < 4; ++e) rk += ((ordkey(o[e]) & ~15u) | (unsigned)(15 - (4 * q + e))) > key; }
                sS[(g * 2 + p) * 16 + rk] = v; sI[(g * 2 + p) * 16 + rk] = ix; }
            asm volatile("" ::: "memory");
            float cv[4]; int pi[4], pj[4];
#pragma unroll
            for (int q = 0; q < 4; ++q) { const int e = l16 + 16 * q; int i, j;
                if (e < 16) { i = 0; j = e; } else if (e < 24) { i = 1; j = e - 16; } else if (e < 29) { i = 2; j = e - 24; } else if (e < 33) { i = 3; j = e - 29; }
                else if (e < 36) { i = 4; j = e - 33; } else if (e < 42) { i = 5 + ((e - 36) >> 1); j = (e - 36) & 1; } else { i = 8 + (e - 42); j = 0; }
                const bool ok = e < 50; i = ok ? i : 15; j = ok ? j : 15;
                pi[q] = i; pj[q] = j; cv[q] = ok ? sS[(g * 2) * 16 + i] + sS[(g * 2 + 1) * 16 + j] : -3.0e38f; }
            float lo = sS[(g * 2) * 16 + 15] + sS[(g * 2 + 1) * 16], hi = sS[(g * 2) * 16] + sS[(g * 2 + 1) * 16];
            const float mx = hi;
#pragma unroll 1
            for (int it = 0; it < RADIX_STEPS; ++it) { const float cm = 0.5f * (lo + hi); int n = 0;
#pragma unroll
                for (int q = 0; q < 4; ++q) n += cv[q] >= cm;
                const bool kk = sum16((float)n) >= 16.f; lo = kk ? cm : lo; hi = kk ? hi : cm; }
            int cl = 0; float es = 0.f;
#pragma unroll
            for (int q = 0; q < 4; ++q) { const bool sel = cv[q] >= lo; cl += sel; es += sel ? __expf(cv[q] - mx) : 0.f; }
            int rank = rowscan_incl(cl) - cl;
            const float einv = 1.0f / sum16(es);
            const size_t ob = (size_t)(t0 + tk) * 128 + h * 16;
#pragma unroll
            for (int q = 0; q < 4; ++q) { const bool sel = cv[q] >= lo;
                if (sel && rank < 16) { IDS[ob + rank] = sI[(g * 2) * 16 + pi[q]] * 128 + sI[(g * 2 + 1) * 16 + pj[q]]; GATES[ob + rank] = __expf(cv[q] - mx) * einv; }
                rank += sel ? 1 : 0; }
            asm volatile("" ::: "memory");
        }
        asm volatile("" ::: "memory");
    }
}

struct XInfo { int xi, nx, rank, nloc; };
__device__ __forceinline__ void fp8x16_to_f32(const u32x4 q, float (&f)[16]) {
#pragma unroll
    for (int w = 0; w < 4; ++w) { const auto a = __builtin_amdgcn_cvt_pk_f32_fp8((int)q[w], false); const auto b = __builtin_amdgcn_cvt_pk_f32_fp8((int)q[w], true);
        f[4 * w] = a[0]; f[4 * w + 1] = a[1]; f[4 * w + 2] = b[0]; f[4 * w + 3] = b[1]; }
}
typedef long i64_t;
template <int IDMASK> __device__ __forceinline__ void phase_experts_u(const Ctx& F, unsigned char* ws, int layer, int ntok, const XInfo X, float* PART) {
    const bf16_t* H = (const bf16_t*)(ws + WS_XN); const unsigned char* PU8 = ws + WS_PU + (size_t)layer * 16384 * 2048;
    const int* IDS = (const int*)(ws + WS_IDS);
    const int e8 = F.lane >> 3, c = F.lane & 7, l16 = F.lane & 15, g = F.lane >> 4;
    const int tfirst = X.rank * 8 + F.wave, tstride = X.nloc * 8;
    const int nk = tfirst < ntok ? (ntok - tfirst + tstride - 1) / tstride : 0;
    const f32x4 z4 = {0.f, 0.f, 0.f, 0.f};
    LAS unsigned char* buf = F.lds + F.wave * 12288; LAS float* res = (LAS float*)(buf + 8192);
    const int woff = e8 * 128 + c * 16;
    const int srcoff = 16 * (c ^ e8);
    const int roff0 = l16 * 128 + (((2 * g) ^ (l16 & 7)) * 16), roff1 = l16 * 128 + (((2 * g + 1) ^ (l16 & 7)) * 16);
#define EU_TOK(k) (tfirst + min((k), nk - 1) * tstride)
#define EU_LOADI(I, k) do { const int* ip_ = IDS + (size_t)EU_TOK(k) * 128 + e8; _Pragma("unroll") for (int q_ = 0; q_ < 16; ++q_) I[q_] = ip_[8 * q_]; } while (0)
#define EU_LOADX(HX, k) do { const u32x4* hp_ = (const u32x4*)(H + (size_t)EU_TOK(k) * 2048 + s * 128 + 32 * g); HX[0] = hp_[0]; HX[1] = hp_[1]; HX[2] = hp_[2]; HX[3] = hp_[3]; } while (0)
#define EU_ISSUE(Q, I, hf) do { _Pragma("unroll") for (int i_ = 0; i_ < 8; ++i_) Q[i_] = *(const u32x4*)(PU8 + ((size_t)s * 16384 + I[(hf) * 8 + i_]) * 128 + srcoff); } while (0)
#define EU_CONSUME(Q, hf, slot) do { _Pragma("unroll") for (int i_ = 0; i_ < 8; ++i_) *(LAS u32x4*)(buf + i_ * 1024 + woff) = Q[i_]; \
        asm volatile("" ::: "memory"); \
        _Pragma("unroll") for (int q_ = 0; q_ < 4; ++q_) { const u32x4 p0_ = *(const LAS u32x4*)(buf + q_ * 2048 + roff0), p1_ = *(const LAS u32x4*)(buf + q_ * 2048 + roff1); f32x4 a_ = z4; \
            a_ = __builtin_amdgcn_mfma_f32_16x16x32_fp8_fp8(((i64_t)p0_[1] << 32) | (i64_t)p0_[0], hb[0], a_, 0, 0, 0); \
            a_ = __builtin_amdgcn_mfma_f32_16x16x32_fp8_fp8(((i64_t)p0_[3] << 32) | (i64_t)p0_[2], hb[1], a_, 0, 0, 0); \
            a_ = __builtin_amdgcn_mfma_f32_16x16x32_fp8_fp8(((i64_t)p1_[1] << 32) | (i64_t)p1_[0], hb[2], a_, 0, 0, 0); \
            a_ = __builtin_amdgcn_mfma_f32_16x16x32_fp8_fp8(((i64_t)p1_[3] << 32) | (i64_t)p1_[2], hb[3], a_, 0, 0, 0); \
            if (l16 == (hf) * 4 + q_) *(LAS f32x4*)(res + (slot) * 128 + 16 * ((hf) * 4 + q_) + 4 * g) = a_; } \
        asm volatile("" ::: "memory"); } while (0)
    for (int s = X.xi; s < 16; s += X.nx) {
        if (nk == 0) continue;
        int id[2][16]; u32x4 hx[2][4]; u32x4 qa[8], qb[8];
        EU_LOADI(id[0], 0); EU_LOADX(hx[0], 0); EU_ISSUE(qa, id[0], 0); EU_ISSUE(qb, id[0], 1);
        EU_LOADI(id[1], 1);
        for (int k0 = 0; k0 < nk; k0 += 8) {
#pragma unroll
            for (int j = 0; j < 8; ++j) { const int k = k0 + j;
                i64_t hb[4];
#pragma unroll
                for (int m = 0; m < 4; ++m) { const u32x4 v = hx[j & 1][m];
                    int lo = __builtin_amdgcn_cvt_pk_fp8_f32(bflo(v[0]), bfhi(v[0]), 0, false); lo = __builtin_amdgcn_cvt_pk_fp8_f32(bflo(v[1]), bfhi(v[1]), lo, true);
                    int hi = __builtin_amdgcn_cvt_pk_fp8_f32(bflo(v[2]), bfhi(v[2]), 0, false); hi = __builtin_amdgcn_cvt_pk_fp8_f32(bflo(v[3]), bfhi(v[3]), hi, true);
                    hb[m] = ((i64_t)(unsigned)hi << 32) | (i64_t)(unsigned)lo; }
                EU_LOADX(hx[(j + 1) & 1], k + 1);
                EU_LOADI(id[j & 1], k + 2);
                EU_CONSUME(qa, 0, j);
                EU_ISSUE(qa, id[(j + 1) & 1], 0);
                EU_CONSUME(qb, 1, j);
                EU_ISSUE(qb, id[(j + 1) & 1], 1);
            }
            { const int u = F.lane >> 3, jj = F.lane & 7, ku = k0 + u;
              if (ku < nk) { float* dst = PART + ((size_t)s * NTOK + tfirst + ku * tstride) * 128 + 16 * jj;
#pragma unroll
                  for (int w = 0; w < 4; ++w) *(f32x4*)(dst + 4 * w) = *(const LAS f32x4*)(res + u * 128 + 16 * jj + 4 * w); }
              asm volatile("" ::: "memory"); }
        }
    }
#undef EU_TOK
#undef EU_LOADI
#undef EU_LOADX
#undef EU_ISSUE
#undef EU_CONSUME
}
__device__ __forceinline__ void phase_experts_combine(const Ctx& F, unsigned char* ws, int ntok) {
    const float* PART = (const float*)(ws + WS_PART); float* GATES = (float*)(ws + WS_GATES);
    for (int idx = F.bid * 512 + F.tid; idx < ntok * 32; idx += F.G * 512) {
        float4 a = make_float4(0.f, 0.f, 0.f, 0.f);
#pragma unroll
        for (int s = 0; s < 16; ++s) { const float4 v = *(const float4*)(PART + (size_t)s * NTOK * 128 + (size_t)idx * 4); a.x += v.x; a.y += v.y; a.z += v.z; a.w += v.w; }
        float4 g = *(const float4*)(GATES + (size_t)idx * 4);
        g.x *= geluf_(a.x * (1.0f / PEER_U_SCALE)); g.y *= geluf_(a.y * (1.0f / PEER_U_SCALE)); g.z *= geluf_(a.z * (1.0f / PEER_U_SCALE)); g.w *= geluf_(a.w * (1.0f / PEER_U_SCALE));
        *(float4*)(GATES + (size_t)idx * 4) = g;
    }
}
__device__ __forceinline__ void phase_experts_v(const Ctx& F, unsigned char* ws, float* out, float* CTXS, int layer, int ntok, const XInfo X) {
    const unsigned char* PV8 = ws + WS_PV + (size_t)layer * 16384 * 2048;
    const int* IDS = (const int*)(ws + WS_IDS); const float* COEF = (const float*)(ws + WS_GATES); const float* MOD = (const float*)(ws + WS_MOD);
    const int e8 = F.lane >> 3, c = F.lane & 7;
    const int tfirst = X.rank * 8 + F.wave, tstride = X.nloc * 8;
    const int nk = tfirst < ntok ? (ntok - tfirst + tstride - 1) / tstride : 0;
    LAS float* res = (LAS float*)(F.lds + F.wave * 4096);
#define EV_TOK(k) (tfirst + min((k), nk - 1) * tstride)
#define EV_LOADI(I, k) do { const u32x4* ip_ = (const u32x4*)(IDS + (size_t)EV_TOK(k) * 128 + e8 * 16); I[0] = ip_[0]; I[1] = ip_[1]; I[2] = ip_[2]; I[3] = ip_[3]; } while (0)
#define EV_LOADC(C, k) do { const u32x4* cp_ = (const u32x4*)(COEF + (size_t)EV_TOK(k) * 128 + e8 * 16); C[0] = cp_[0]; C[1] = cp_[1]; C[2] = cp_[2]; C[3] = cp_[3]; } while (0)
#define EV_ROW(id) (*(const u32x4*)(PV8 + ((size_t)s * 16384 + (id)) * 128 + c * 16))
#define EV_ISSUE(Q, I, hf) do { _Pragma("unroll") for (int i_ = 0; i_ < 8; ++i_) Q[i_] = EV_ROW(I[(hf) * 2 + (i_ >> 2)][i_ & 3]); } while (0)
#define EV_HALF(Q, C, hf) do { _Pragma("unroll") for (int i_ = 0; i_ < 8; ++i_) { const float cf_ = __uint_as_float(C[(hf) * 2 + (i_ >> 2)][i_ & 3]); const f32x2_t c2_ = {cf_, cf_}; \
            _Pragma("unroll") for (int w_ = 0; w_ < 4; ++w_) { const f32x2_t lo_ = __builtin_amdgcn_cvt_pk_f32_fp8((int)Q[i_][w_], false), hi_ = __builtin_amdgcn_cvt_pk_f32_fp8((int)Q[i_][w_], true); \
                ac2[2 * w_] = lo_ * c2_ + ac2[2 * w_]; ac2[2 * w_ + 1] = hi_ * c2_ + ac2[2 * w_ + 1]; } } } while (0)
    for (int s = X.xi; s < 16; s += X.nx) {
        if (nk == 0) continue;
        u32x4 id[2][4], cf[2][4]; u32x4 qa[8], qb[8];
        EV_LOADI(id[0], 0); EV_LOADC(cf[0], 0); EV_ISSUE(qa, id[0], 0); EV_ISSUE(qb, id[0], 1);
        EV_LOADI(id[1], 1);
        for (int k0 = 0; k0 < nk; k0 += 8) {
#pragma unroll
            for (int j = 0; j < 8; ++j) { const int k = k0 + j;
                f32x2_t ac2[8];
#pragma unroll
                for (int e = 0; e < 8; ++e) ac2[e] = (f32x2_t){0.f, 0.f};
                EV_LOADC(cf[(j + 1) & 1], k + 1);
                EV_HALF(qa, cf[j & 1], 0);
                EV_ISSUE(qa, id[(j + 1) & 1], 0);
                EV_HALF(qb, cf[j & 1], 1);
                EV_ISSUE(qb, id[(j + 1) & 1], 1);
                EV_LOADI(id[j & 1], k + 2);
                float acc[16];
#pragma unroll
                for (int e = 0; e < 8; ++e) { acc[2 * e] = ac2[e][0]; acc[2 * e + 1] = ac2[e][1]; }
#pragma unroll
                for (int e = 0; e < 16; ++e) { float v = acc[e]; v += dpp_f<0x128>(v); v += xor16_f(v); acc[e] = sum_x32(v); }
                if (e8 == 0) {
#pragma unroll
                    for (int w = 0; w < 4; ++w) *(LAS f32x4*)(res + j * 128 + c * 16 + 4 * w) = (f32x4){acc[4 * w], acc[4 * w + 1], acc[4 * w + 2], acc[4 * w + 3]}; }
                asm volatile("" ::: "memory");
            }
            { const int u = F.lane >> 3, jj = F.lane & 7, ku = k0 + u;
              if (ku < nk) { const int tu = tfirst + ku * tstride;
                  const bool isctx = tu >= NLAT; const int vv = isctx ? 4 : (tu >> 12);
                  float* xr = (isctx ? CTXS + (size_t)(tu - NLAT) * 2048 : out + (size_t)tu * 2048) + s * 128 + jj * 16;
                  const float* m5 = MOD + ((size_t)layer * 5 + vv) * 12288 + 5 * 2048 + s * 128 + jj * 16;
#pragma unroll
                  for (int w = 0; w < 4; ++w) { float4 x = *(const float4*)(xr + 4 * w); const float4 m = *(const float4*)(m5 + 4 * w); const f32x4 a = *(const LAS f32x4*)(res + u * 128 + jj * 16 + 4 * w);
                      x.x += m.x * a[0]; x.y += m.y * a[1]; x.z += m.z * a[2]; x.w += m.w * a[3]; *(float4*)(xr + 4 * w) = x; } }
              asm volatile("" ::: "memory"); }
        }
    }
#undef EV_TOK
#undef EV_LOADI
#undef EV_LOADC
#undef EV_ROW
#undef EV_ISSUE
#undef EV_HALF
}

struct Params { const float* in[N_IN]; float* out; unsigned char* ws; };

__device__ __forceinline__ LayerW make_w(ka_t in, int l) {
    LayerW W;
    W.sc_w = in[I_SCW] + (size_t)l * 3 * 512; W.rw_w0 = in[I_RW0] + (size_t)l * 2 * 512; W.rw_wup = in[I_RWUP] + (size_t)l * 2 * 64 * 512;
    W.rw_a0 = in[I_RA0] + (size_t)l * 2 * 512; W.rw_aup = in[I_RAUP] + (size_t)l * 2 * 64 * 512; W.rw_gup = in[I_RGUP] + (size_t)l * 128 * 512;
    W.rw_kk = in[I_RKK] + (size_t)l * 512; W.rw_ka = in[I_RKA] + (size_t)l * 512; W.rw_rk = in[I_RRK] + (size_t)l * 512;
    W.rw_lnw = in[I_RLNW] + (size_t)l * 512; W.rw_lnb = in[I_RLNB] + (size_t)l * 512;
    W.na_q = in[I_NAQ] + (size_t)l * 64; W.na_k = in[I_NAK] + (size_t)l * 64; W.rpb = in[I_RPB] + (size_t)l * 8 * 15 * 31;
    W.s_cw = in[I_SCONVW] + (size_t)l * 3 * 1024; W.s_cb = in[I_SCONVB] + (size_t)l * 1024; W.s_dtb = in[I_SDTB] + (size_t)l * 16; W.s_alog = in[I_SALOG] + (size_t)l * 16;
    W.s_d = in[I_SD] + (size_t)l * 8; W.s_norm = in[I_SNORM] + (size_t)l * 512;
    return W;
}

__global__ void __launch_bounds__(512, 2) hybrid_fwd(Params p) {
    extern __shared__ __attribute__((aligned(16))) unsigned char shm[];
    Ctx F; F.lds = (LAS unsigned char*)shm; F.tid = threadIdx.x; F.lane = F.tid & 63; F.wave = __builtin_amdgcn_readfirstlane(F.tid >> 6); F.bid = blockIdx.x; F.G = gridDim.x;
    volatile LAS unsigned* bst = (volatile LAS unsigned*)(F.lds + LDS_BAR_OFF);
    if (F.tid < 4) bst[F.tid] = 0u;
    __syncthreads();
    (void)xcd_barrier_post((unsigned*)(p.ws + WS_CTL), bst);
    volatile LAS int* lxi = (volatile LAS int*)(F.lds + LDS_XI_OFF);
    if (F.tid == 0) lxi[2] = (int)xb_add((unsigned*)(p.ws + WS_CTL) + CTL_TICKET + 64 * xb_xcc_id(), 1u);
#define RPT_PHASE(id, ...) do { __VA_ARGS__ if (RPT == (id)) { GRID_BAR(); PH_BEGIN(); __VA_ARGS__ } } while (0)
#define GRID_BAR() do { ka_t kb_ = (ka_t)__builtin_amdgcn_kernarg_segment_ptr(); asm volatile("" : "+s"(kb_)); unsigned xx_ = xb_xcc_id(); asm volatile("" : "+s"(xx_)); \
        XcdBarrier b_; b_.bar = (unsigned*)((unsigned char*)kb_[N_IN + 1] + WS_CTL); b_.x = xx_; b_.st = (volatile LAS unsigned*)(F.lds + LDS_BAR_OFF); xcd_barrier(b_); } while (0)
    ka_t in; unsigned char* ws; float* out;
#define PH_BEGIN() do { int t_ = threadIdx.x; asm volatile("; PHASE_MARK" : "+v"(t_)); F.tid = t_; F.lane = t_ & 63; F.wave = __builtin_amdgcn_readfirstlane(t_ >> 6); \
        int b_ = blockIdx.x, g_ = gridDim.x; asm volatile("" : "+s"(b_), "+s"(g_)); F.bid = b_; F.G = g_; \
        ka_t k_ = (ka_t)__builtin_amdgcn_kernarg_segment_ptr(); asm volatile("" : "+s"(k_)); in = k_; \
        out = (float*)in[N_IN]; ws = (unsigned char*)in[N_IN + 1]; } while (0)

    PH_BEGIN();
    RPT_PHASE(1, phase_prologue(F, in, ws););
    GRID_BAR();
    if (F.tid == 0) {
        const unsigned* bw = (const unsigned*)(ws + WS_CTL); const unsigned myx = xb_xcc_id(); int xi = 0, nx = 0, nloc = 1;
        for (unsigned j = 0; j < 16; ++j) { const unsigned cnt = xb_ld((unsigned*)&bw[XB_XCNT(j)]); if (cnt > 0u) { if (j < myx) ++xi; ++nx; } if (j == myx) nloc = (int)cnt; }
        lxi[0] = xi; lxi[1] = nx > 0 ? nx : 1; lxi[3] = nloc > 0 ? nloc : 1; }
    __syncthreads();
    PH_BEGIN();
    phase_modreduce(F, in[I_BADA], (const float*)(ws + WS_MODP), (float*)(ws + WS_MOD));
    GRID_BAR();

#pragma unroll 1
    for (int l = 0; l < 2; ++l) {
        const int M = (l == 0) ? NTOK : NLAT;
        if (l == 0) { PH_BEGIN(); phase_norm(F, in[I_X], in[I_CTX], in[I_NMIX], (const float*)(ws + WS_MOD), 0, 1, (bf16_t*)(ws + WS_XN), NTOK); GRID_BAR(); }

        PH_BEGIN();
        RPT_PHASE(2, { pg8::Gemm g{(const bf16_t*)(ws + WS_XN), (const bf16_t*)(ws + WS_WIN) + (size_t)l * PTP * 2048, NTOK, PTP, 2048}; pg8::StaticOrder S; S.init(NTOK, PTP, F.G, F.bid);
          pg8::EpiBf16 E{(bf16_t*)(ws + WS_P), PTP}; pg8::gemm_phase<pg8::EpiBf16, pg8::StaticOrder>(F.lds, g, S, E, F.tid); });
        GRID_BAR();

        PH_BEGIN();
        { const LayerW W = make_w(in, l); phase_prep(F, W, ws);
            if (RPT == 31) phase_prep(F, W, ws);
            const bf16_t* WUPT = (const bf16_t*)(ws + WS_WUPT) + (size_t)l * 4 * 512 * 64;
            for (int rep = 0; rep < (RPT == 32 ? 2 : 1); ++rep) {
            for (int task = F.bid * 8 + F.wave; task < 4 * 8 * RW_NCHUNK; task += F.G * 8) rwkv_pre_task(F, W, ws, WUPT, task, 0);
            for (int task = F.bid * 8 + F.wave; task < 4 * 8 * RW_NCHUNK; task += F.G * 8) rwkv_pre_task(F, W, ws, WUPT, task, 1); } }
        GRID_BAR();

        PH_BEGIN();
        RPT_PHASE(4, { const LayerW W = make_w(in, l); for (int task = F.bid; task < 4 * 8 * NCH; task += F.G) ssd_task<false>(F, W, ws, task); });
        GRID_BAR();
        PH_BEGIN();
        phase_ssd_combine(F, ws);
        GRID_BAR();

        PH_BEGIN();
        { if (F.bid < 64) rwkv_scan(F, ws, F.bid);
        else { const LayerW W = make_w(in, l); const int blk = F.bid - 64, nblk = F.G - 64;
            for (int task = blk; task < 4 * 8 * NCH; task += nblk) ssd_task<true>(F, W, ws, task);
            na_phase(F, W, ws, blk, nblk, (l == 0) ? 1088 : 1024); } }
        if (RPT == 51) { GRID_BAR(); PH_BEGIN(); if (F.bid < 64) rwkv_scan(F, ws, F.bid); }
        if (RPT == 52) { GRID_BAR(); PH_BEGIN(); if (F.bid >= 64) { const LayerW W = make_w(in, l); const int blk = F.bid - 64, nblk = F.G - 64;
            for (int task = blk; task < 4 * 8 * NCH; task += nblk) ssd_task<true>(F, W, ws, task); } }
        if (RPT == 53) { GRID_BAR(); PH_BEGIN(); if (F.bid >= 64) { const LayerW W = make_w(in, l); const int blk = F.bid - 64, nblk = F.G - 64;
            na_phase(F, W, ws, blk, nblk, (l == 0) ? 1088 : 1024); } }
        GRID_BAR();

        PH_BEGIN();
        RPT_PHASE(6, { const LayerW W = make_w(in, l); phase_finish(F, W, ws, (const bf16_t*)(ws + WS_GUPT) + (size_t)l * 512 * 128, M); });
        GRID_BAR();

        PH_BEGIN();
        { pg8::Gemm g{(const bf16_t*)(ws + WS_MIX), (const bf16_t*)(ws + WS_WOUT) + (size_t)l * 2048 * 2048, M, 2048, 2048}; pg8::StaticOrder S; S.init(M, 2048, F.G, F.bid);
          float* CTXS = (float*)(ws + WS_CTXS);
          pg8::EpiResid E{l == 0 ? in[I_X] : out, l == 0 ? in[I_CTX] : CTXS, out, CTXS, (const float*)(ws + WS_MOD) + (size_t)l * 5 * 12288 + 2 * 2048};
          pg8::gemm_phase<pg8::EpiResid, pg8::StaticOrder>(F.lds, g, S, E, F.tid); }
        GRID_BAR();

        PH_BEGIN();
        RPT_PHASE(7, phase_norm(F, out, (const float*)(ws + WS_CTXS), in[I_NFFN] + (size_t)l * 2048, (const float*)(ws + WS_MOD) + (size_t)l * 5 * 12288, 3, 4, (bf16_t*)(ws + WS_XN), M););
        GRID_BAR();
        PH_BEGIN();
        RPT_PHASE(8, { pg8::Gemm g{(const bf16_t*)(ws + WS_XN), (const bf16_t*)(ws + WS_WQ) + (size_t)l * 2048 * 2048, M, 2048, 2048}; pg8::StaticOrder S; S.init(M, 2048, F.G, F.bid);
          pg8::EpiBf16 E{(bf16_t*)(ws + WS_P), 2048}; pg8::gemm_phase<pg8::EpiBf16, pg8::StaticOrder>(F.lds, g, S, E, F.tid); });
        GRID_BAR();
        PH_BEGIN();
        RPT_PHASE(9, phase_scores(F, ws, l, M););
        GRID_BAR();
        PH_BEGIN();
        RPT_PHASE(10, { XInfo X; X.xi = lxi[0]; X.nx = lxi[1]; X.rank = lxi[2]; X.nloc = lxi[3]; phase_experts_u<0x3fff>(F, ws, l, M, X, (float*)(ws + WS_PART)); });
        if (RPT == 101) { GRID_BAR(); PH_BEGIN(); XInfo X; X.xi = lxi[0]; X.nx = lxi[1]; X.rank = lxi[2]; X.nloc = lxi[3]; phase_experts_u<0x3ff>(F, ws, l, M, X, (float*)(ws + WS_P)); }
        if (RPT == 102) { GRID_BAR(); PH_BEGIN(); XInfo X; X.xi = lxi[0]; X.nx = lxi[1]; X.rank = lxi[2]; X.nloc = lxi[3]; phase_experts_u<0x3fff>(F, ws, l, M, X, (float*)(ws + WS_P)); }
        GRID_BAR();
        PH_BEGIN();
        phase_experts_combine(F, ws, M);
        GRID_BAR();
        PH_BEGIN();
        if (RPT == 11) { XInfo X; X.xi = lxi[0]; X.nx = lxi[1]; X.rank = lxi[2]; X.nloc = lxi[3]; phase_experts_v(F, ws, (float*)(ws + WS_P), (float*)(ws + WS_P) + (size_t)NLAT * 2048, l, M, X); GRID_BAR(); PH_BEGIN(); }
        { XInfo X; X.xi = lxi[0]; X.nx = lxi[1]; X.rank = lxi[2]; X.nloc = lxi[3]; phase_experts_v(F, ws, out, (float*)(ws + WS_CTXS), l, M, X); }
        if (l == 0) { GRID_BAR(); PH_BEGIN();
            phase_norm(F, out, (const float*)(ws + WS_CTXS), in[I_NMIX] + 2048, (const float*)(ws + WS_MOD) + (size_t)5 * 12288, 0, 1, (bf16_t*)(ws + WS_XN), NTOK); GRID_BAR(); }
    }
}

extern "C" void kernel_launch(void* const* d_in, const int* in_sizes, int n_in, void* d_out, int out_size, void* d_ws, size_t ws_size, hipStream_t stream) {
    static int grid = 0;
    if (grid == 0) {
        if (n_in != N_IN || out_size != NLAT * DM || ws_size < WS_END) { fprintf(stderr, "kernel_launch: unexpected shapes (n_in %d out %d ws %zu, need %zu)\n", n_in, out_size, ws_size, (size_t)WS_END); grid = -1; return; }
        int dev = 0, cus = 0, per_cu = 0;
        (void)hipGetDevice(&dev); (void)hipDeviceGetAttribute(&cus, hipDeviceAttributeMultiprocessorCount, dev);
        if (hipFuncSetAttribute((const void*)hybrid_fwd, hipFuncAttributeMaxDynamicSharedMemorySize, LDS_BYTES) != hipSuccess) { fprintf(stderr, "kernel_launch: hipFuncSetAttribute failed\n"); grid = -1; return; }
        (void)hipOccupancyMaxActiveBlocksPerMultiprocessor(&per_cu, (const void*)hybrid_fwd, 512, LDS_BYTES);
        (void)hipGetLastError();
        fprintf(stderr, "kernel_launch: %d CUs, occupancy query %d block(s)/CU, ws %zu B (need %zu)\n", cus, per_cu, ws_size, (size_t)WS_END);
        grid = cus;
        if (grid < 136) { fprintf(stderr, "kernel_launch: needs at least 136 CUs\n"); grid = -1; return; }
    }
    if (grid < 0) return;
    (void)hipMemsetAsync((char*)d_ws + WS_CTL, 0, 65536, stream);
    Params p{};
    for (int i = 0; i < N_IN; ++i) p.in[i] = (const float*)d_in[i];
    p.out = (float*)d_out; p.ws = (unsigned char*)d_ws;
    hipLaunchKernelGGL(hybrid_fwd, dim3(grid), dim3(512), LDS_BYTES, stream, p);
}
```

```cpp
#include <hip/hip_runtime.h>
#include <cstdio>
#include <cstdint>
#ifndef RPT
#define RPT 0
#endif

constexpr int DM = 2048, NBATCH = 4, SEQL = 4096, CTXL = 256, NLAT = NBATCH * SEQL, NCTX = NBATCH * CTXL, NTOK = NLAT + NCTX;
constexpr int PT = 6416, PTP = 6656;
constexpr int A_BG = 0, A_CG = 512, A_H = 1024;
constexpr int B_R = 1536, B_K = 2048, B_V = 2560, B_WD = 3072, B_AD = 3136, B_GD = 3200;
constexpr int C_Q = 3328, C_K = 3840, C_V = 4352;
constexpr int D_Z = 4864, D_X = 5376, D_DT = 6400;
constexpr int NPOS = CTXL + SEQL;
constexpr int NCH = 34;
constexpr int KSPL = 32;

enum { I_X = 0, I_C, I_CTX, I_CCTX, I_WADA, I_BADA, I_NMIX, I_NFFN, I_WIN, I_WOUT, I_SCW, I_RW0, I_RWUP, I_RA0, I_RAUP, I_RGUP, I_RKK, I_RKA, I_RRK, I_RLNW, I_RLNB,
       I_NAQ, I_NAK, I_RPB, I_SCONVW, I_SCONVB, I_SDTB, I_SALOG, I_SD, I_SNORM, I_PWQ, I_PKEYS, I_PU, I_PV, N_IN };

constexpr size_t WS_CTL   = 0;
constexpr size_t WS_ROPE  = 65536;
constexpr size_t WS_MODP  = WS_ROPE + 16384;
constexpr size_t WS_MOD   = WS_MODP + (size_t)KSPL * 2 * 5 * 12288 * 4;
constexpr size_t WS_WIN   = WS_MOD + (size_t)2 * 5 * 12288 * 4;
constexpr size_t WS_WOUT  = WS_WIN + (size_t)2 * PTP * DM * 2;
constexpr size_t WS_WQ    = WS_WOUT + (size_t)2 * DM * DM * 2;
constexpr size_t WS_KEYS  = WS_WQ + (size_t)2 * DM * DM * 2;
constexpr size_t WS_WUPT  = WS_KEYS + (size_t)2 * 8 * 2 * 128 * 128 * 2;
constexpr size_t WS_GUPT  = WS_WUPT + (size_t)2 * 4 * 512 * 64 * 2;
constexpr size_t WS_PU    = WS_GUPT + (size_t)2 * 512 * 128 * 2;
constexpr size_t WS_PV    = WS_PU + (size_t)2 * 16384 * DM;
constexpr size_t WS_P     = WS_PV + (size_t)2 * 16384 * DM;
constexpr size_t WS_MIX   = WS_P + (size_t)NTOK * PTP * 2;
constexpr size_t WS_CTXS  = WS_MIX + (size_t)NTOK * DM * 2;
constexpr size_t WS_XN    = WS_CTXS + (size_t)NCTX * DM * 4;
constexpr size_t WS_IDS   = WS_XN + (size_t)NTOK * DM * 2;
constexpr size_t WS_GATES = WS_IDS + (size_t)NTOK * 128 * 4;
constexpr size_t WS_PART  = WS_GATES + (size_t)NTOK * 128 * 4;
constexpr size_t WS_RWF   = WS_XN;
constexpr size_t WS_RWY   = WS_RWF + (size_t)64 * 272 * 10496;
constexpr size_t WS_BON   = WS_RWY + (size_t)2 * NTOK * 512 * 2;
constexpr size_t WS_XBC   = WS_BON + (size_t)2 * NTOK * 8 * 4;
constexpr size_t WS_DTS   = WS_XBC + (size_t)NTOK * 1024 * 2;
constexpr size_t WS_DEC   = WS_DTS + (size_t)NTOK * 16 * 4;
constexpr size_t WS_SST   = WS_DEC + (size_t)NTOK * 16 * 4;
constexpr size_t WS_SCD   = WS_SST + (size_t)64 * NCH * 8192 * 4;
constexpr size_t WS_YS    = WS_SCD + 16384;
constexpr size_t WS_QN    = WS_YS + (size_t)NTOK * 512 * 4;
constexpr size_t WS_KN    = WS_QN + (size_t)NTOK * 512 * 2;
constexpr size_t WS_VTL   = WS_KN + (size_t)NTOK * 512 * 2;
constexpr size_t WS_VTC   = WS_VTL + (size_t)4 * 8 * 64 * 64 * 96 * 2;
constexpr size_t WS_END   = WS_VTC + (size_t)4 * 8 * 64 * 256 * 2;
static_assert(WS_END < (size_t)1020 * 1024 * 1024, "workspace");
static_assert(WS_GATES + (size_t)NTOK * 128 * 4 <= WS_PART && WS_PART + (size_t)16 * NTOK * 128 * 4 <= WS_END, "alias");

constexpr int LDS_BYTES = 147456;
constexpr int LDS_BAR_OFF = LDS_BYTES - 16;
constexpr int LDS_XI_OFF = LDS_BYTES - 48;
constexpr int CTL_TICKET = 8192;

#define LAS __attribute__((address_space(3)))
typedef unsigned short bf16_t;
typedef _Float16 f16_t;
typedef short bf16x8 __attribute__((ext_vector_type(8)));
typedef float f32x4 __attribute__((ext_vector_type(4)));
typedef unsigned u32x4 __attribute__((ext_vector_type(4)));
typedef unsigned u32x2 __attribute__((ext_vector_type(2)));

__device__ __forceinline__ float bf2f(bf16_t h) { return __uint_as_float(((unsigned)h) << 16); }
__device__ __forceinline__ float bflo(unsigned u) { return __uint_as_float(u << 16); }
__device__ __forceinline__ float bfhi(unsigned u) { return __uint_as_float(u & 0xffff0000u); }
__device__ __forceinline__ bf16_t f2bf(float f) { unsigned u = __float_as_uint(f); u += 0x7FFFu + ((u >> 16) & 1u); return (bf16_t)(u >> 16); }
typedef float f32x2_t __attribute__((ext_vector_type(2)));
typedef __bf16 bf16x2_t __attribute__((ext_vector_type(2)));
__device__ __forceinline__ unsigned pk_bf16(float lo, float hi) { const f32x2_t v = {lo, hi}; const bf16x2_t r = __builtin_convertvector(v, bf16x2_t); return __builtin_bit_cast(unsigned, r); }
__device__ __forceinline__ bf16x8 pack8(const f32x4 a, const f32x4 b) { union { bf16x8 v; unsigned u[4]; } r; r.u[0] = pk_bf16(a[0], a[1]); r.u[1] = pk_bf16(a[2], a[3]); r.u[2] = pk_bf16(b[0], b[1]); r.u[3] = pk_bf16(b[2], b[3]); return r.v; }
template <int CTRL> __device__ __forceinline__ float dpp_f(float v) { return __int_as_float(__builtin_amdgcn_update_dpp(0, __float_as_int(v), CTRL, 0xF, 0xF, true)); }
__device__ __forceinline__ float sum4(float x)  { x += dpp_f<0xB1>(x); x += dpp_f<0x4E>(x); return x; }
__device__ __forceinline__ float sum8(float x)  { x = sum4(x); x += dpp_f<0x141>(x); return x; }
__device__ __forceinline__ float sum16(float x) { x = sum8(x); x += dpp_f<0x140>(x); return x; }
__device__ __forceinline__ float xor16_f(float x) { return __int_as_float(__builtin_amdgcn_ds_swizzle(__float_as_int(x), 0x401F)); }
__device__ __forceinline__ float sum_x32(float x) { const auto r = __builtin_amdgcn_permlane32_swap(__float_as_uint(x), __float_as_uint(x), false, false); return __uint_as_float(r[0]) + __uint_as_float(r[1]); }
__device__ __forceinline__ float max_x32(float x) { const auto r = __builtin_amdgcn_permlane32_swap(__float_as_uint(x), __float_as_uint(x), false, false); return fmaxf(__uint_as_float(r[0]), __uint_as_float(r[1])); }
__device__ __forceinline__ float wave_sum(float x) { x = sum16(x); x += xor16_f(x); return sum_x32(x); }
__device__ __forceinline__ float max16(float x) { x = fmaxf(x, dpp_f<0xB1>(x)); x = fmaxf(x, dpp_f<0x4E>(x)); x = fmaxf(x, dpp_f<0x141>(x)); x = fmaxf(x, dpp_f<0x140>(x)); return x; }
__device__ __forceinline__ float wave_max(float x) { x = max16(x); x = fmaxf(x, xor16_f(x)); return max_x32(x); }
__device__ __forceinline__ float rcpf_(float x) { return __builtin_amdgcn_rcpf(x); }
__device__ __forceinline__ float sigmoidf_(float x) { return rcpf_(1.0f + __expf(-x)); }
__device__ __forceinline__ float siluf_(float x) { return x * rcpf_(1.0f + __expf(-x)); }
__device__ __forceinline__ float tanhf_(float x) { const float e = __expf(2.0f * x); return 1.0f - 2.0f * rcpf_(e + 1.0f); }
__device__ __forceinline__ float geluf_(float x) { return 0.5f * x * (1.0f + tanhf_(0.7978845608028654f * (x + 0.044715f * x * x * x))); }

namespace pg8 {
#define PG8_LAS __attribute__((address_space(3)))
typedef unsigned short bf16_t;
typedef short bf16x8 __attribute__((ext_vector_type(8)));
typedef float f32x4 __attribute__((ext_vector_type(4)));
typedef unsigned u32x4 __attribute__((ext_vector_type(4)));
constexpr int BM = 256, BK = 64, HALF = 128, HTB = HALF * BK * 2  , STAGE_BYTES = 8 * HTB, NXCD = 8, WGM = 8;

__host__ __device__ __forceinline__ int lds_byte(int r, int c) { const int st = (r >> 4) * 2 + (c >> 5), rr = r & 15, cc = c & 31, ob = rr * 64 + cc * 2; return st * 1024 + (ob ^ (((ob >> 9) & 1) << 5)); }
__host__ __device__ __forceinline__ void stage_rc(int b, int& R, int& C) { const int st = b / 1024, sb = b % 1024, swz = sb ^ (((sb >> 9) & 1) << 5); R = (st >> 1) * 16 + swz / 64; C = (st & 1) * 32 + (swz % 64) / 2; }
__host__ __device__ __forceinline__ int perm32(int rho) { const int n = rho >> 4, i = rho & 15; return 8 * (i >> 2) + 4 * n + (i & 3); }

struct Unit { int pm, pn; };
struct Gemm { const bf16_t* A; const bf16_t* Bt; int M, N, K; };

struct StaticOrder {
    int nM, nN, nwg, G, c;
    __host__ __device__ void init(int M, int N, int G_, int c_) { nM = M / BM; nN = N / BM; nwg = nM * nN; G = G_; c = c_; }
    __host__ __device__ bool next(int i, Unit& u) const {
        const long L = (long)i * G + c; if (L >= nwg) return false;
        int wgid = (int)L; { const int q = nwg / NXCD, r = nwg % NXCD, xcd = wgid % NXCD, off = wgid / NXCD; wgid = (xcd < r ? xcd * (q + 1) : r * (q + 1) + (xcd - r) * q) + off; }
        const int nig = WGM * nN, gid = wgid / nig, fm = gid * WGM, gsz = (nM - fm) < WGM ? (nM - fm) : WGM;
        u.pm = fm + ((wgid % nig) % gsz); u.pn = (wgid % nig) / gsz; return true;
    }
    __device__ __forceinline__ void a_ready(const Unit&) const {}
    __device__ __forceinline__ void done(const Unit&) const {}
};

__device__ __forceinline__ unsigned cvt_pk_bf16(float lo, float hi) { return ::pk_bf16(lo, hi); }
struct EpiBf16 {
    static constexpr bool PERM = true, AFTER_DRAIN = false;
    bf16_t* O; int ldc;
    __device__ __forceinline__ void operator()(const f32x4 (&acc)[2][2][4][2], const Unit& u, int wr, int wc, int fr, int fq) const {
        const int row0 = u.pm * BM + wr * 64 + fr; const int col0 = u.pn * BM + wc * 32 + 8 * fq;
#pragma unroll
        for (int ai = 0; ai < 2; ++ai)
#pragma unroll
            for (int m = 0; m < 4; ++m) { bf16_t* rowp = O + (size_t)(row0 + ai * HALF + m * 16) * ldc + col0;
#pragma unroll
                for (int bj = 0; bj < 2; ++bj) { const f32x4 v0 = acc[ai][bj][m][0], v1 = acc[ai][bj][m][1];
                    u32x4 w; w.x = cvt_pk_bf16(v0[0], v0[1]); w.y = cvt_pk_bf16(v0[2], v0[3]); w.z = cvt_pk_bf16(v1[0], v1[1]); w.w = cvt_pk_bf16(v1[2], v1[3]);
                    *(u32x4*)(rowp + bj * HALF) = w; } }
    }
};
struct EpiResid {
    static constexpr bool PERM = false, AFTER_DRAIN = false;
    const float* xi_lat; const float* xi_ctx; float* xo_lat; float* xo_ctx; const float* gate;
    __device__ __forceinline__ void operator()(const f32x4 (&acc)[2][2][4][2], const Unit& u, int wr, int wc, int fr, int fq) const {
        const bool isctx = u.pm >= 64; const int v = isctx ? 4 : (u.pm >> 4);
        const int row0 = (isctx ? (u.pm - 64) : u.pm) * BM + wr * 64 + fr, col0 = u.pn * BM + wc * 32 + 4 * fq;
        const float* xi = isctx ? xi_ctx : xi_lat; float* xo = isctx ? xo_ctx : xo_lat;
        const float* gp = gate + (size_t)v * 12288 + col0;
        f32x4 gv[2][2];
#pragma unroll
        for (int bj = 0; bj < 2; ++bj)
#pragma unroll
            for (int n = 0; n < 2; ++n) gv[bj][n] = *(const f32x4*)(gp + bj * HALF + n * 16);
#pragma unroll
        for (int ai = 0; ai < 2; ++ai)
#pragma unroll
            for (int m = 0; m < 4; ++m) { const size_t off = (size_t)(row0 + ai * HALF + m * 16) * 2048 + col0;
#pragma unroll
                for (int bj = 0; bj < 2; ++bj)
#pragma unroll
                    for (int n = 0; n < 2; ++n) { const f32x4 xv = *(const f32x4*)(xi + off + bj * HALF + n * 16);
                        *(f32x4*)(xo + off + bj * HALF + n * 16) = xv + gv[bj][n] * acc[ai][bj][m][n]; }
                asm volatile("" ::: "memory"); }
    }
};

template <class Epi, class Sched>
__device__ __forceinline__ void gemm_phase(PG8_LAS unsigned char* lds, const Gemm g, const Sched& S, const Epi& E, const int tid) {
    const int wid = __builtin_amdgcn_readfirstlane(tid >> 6), lane = tid & 63, wr = wid >> 2, wc = wid & 3, fr = lane & 15, fq = lane >> 4;
    const int K = g.K, nt = K / BK;
    unsigned voffA[2], voffB[2];
#pragma unroll
    for (int i = 0; i < 2; ++i) { int R, C; stage_rc(tid * 16 + i * 8192, R, C); const int Rb = Epi::PERM ? ((R & ~31) + perm32(R & 31)) : R;
        voffA[i] = (unsigned)(R * K + C) * 2u; voffB[i] = (unsigned)(Rb * K + C) * 2u; }
    const size_t kstep = (size_t)(BK * 2);
    const size_t hstep = (size_t)HALF * K * 2;
    const size_t tstep = 2 * hstep;
    const unsigned ldsw = (unsigned)wid * 1024u;
    const int aoff = lds_byte(wr * 64 + fr, fq * 8), boff = lds_byte(wc * 32 + fr, fq * 8);
#define PG8_SA(b, h) (((b) * 2 + (h)) * HTB)
#define PG8_SB(b, h) ((4 + (b) * 2 + (h)) * HTB)
#define PG8_STAGE(bufoff, gbase, voff) do { _Pragma("unroll") for (int _i = 0; _i < 2; ++_i) \
        __builtin_amdgcn_global_load_lds((const unsigned*)((const char*)(gbase) + (voff)[_i]), (PG8_LAS unsigned*)(lds + (bufoff) + ldsw + _i * 8192), 16, 0, 0); } while (0)
#define PG8_LDA(dst, b, h) do { _Pragma("unroll") for (int m = 0; m < 4; ++m) _Pragma("unroll") for (int k = 0; k < 2; ++k) dst[m][k] = *(const PG8_LAS bf16x8*)(lds + PG8_SA(b, h) + aoff + m * 2048 + k * 1024); } while (0)
#define PG8_LDB(dst, b, h) do { _Pragma("unroll") for (int n = 0; n < 2; ++n) _Pragma("unroll") for (int k = 0; k < 2; ++k) dst[n][k] = *(const PG8_LAS bf16x8*)(lds + PG8_SB(b, h) + boff + n * 2048 + k * 1024); } while (0)
#define PG8_MMA(ai, bj, At, Bt) do { __builtin_amdgcn_s_setprio(1); _Pragma("unroll") for (int m = 0; m < 4; ++m) _Pragma("unroll") for (int n = 0; n < 2; ++n) _Pragma("unroll") for (int k = 0; k < 2; ++k) \
        acc[ai][bj][m][n] = __builtin_amdgcn_mfma_f32_16x16x32_bf16(Bt[n][k], At[m][k], acc[ai][bj][m][n], 0, 0, 0); __builtin_amdgcn_s_setprio(0); } while (0)
#define PG8_WAIT_V(n) asm volatile("s_waitcnt vmcnt(" #n ")" ::: "memory")
#define PG8_WAIT_L(n) asm volatile("s_waitcnt lgkmcnt(" #n ")" ::: "memory")
#define PG8_BAR __builtin_amdgcn_s_barrier()
#define PG8_SCHED __builtin_amdgcn_sched_barrier(0)
    Unit cur, nxt; int ui = 0;
    if (!S.next(0, cur)) return;
    f32x4 acc[2][2][4][2];
#pragma unroll
    for (int a = 0; a < 2; ++a)
#pragma unroll
        for (int b = 0; b < 2; ++b)
#pragma unroll
            for (int m = 0; m < 4; ++m)
#pragma unroll
                for (int n = 0; n < 2; ++n) acc[a][b][m][n] = (f32x4){0.f, 0.f, 0.f, 0.f};
    bf16x8 At[4][2], B0[2][2], B1[2][2];
    const char* cA = (const char*)g.A + (size_t)cur.pm * tstep; const char* cB = (const char*)g.Bt + (size_t)cur.pn * tstep;
    S.a_ready(cur);
    PG8_STAGE(PG8_SB(0, 0), cB, voffB); PG8_STAGE(PG8_SA(0, 0), cA, voffA); PG8_STAGE(PG8_SB(0, 1), cB + hstep, voffB); PG8_STAGE(PG8_SA(0, 1), cA + hstep, voffA);
    if (wr == 1) PG8_BAR;
    PG8_WAIT_V(4); PG8_BAR;
    PG8_STAGE(PG8_SB(1, 0), cB + kstep, voffB); PG8_STAGE(PG8_SA(1, 0), cA + kstep, voffA); PG8_STAGE(PG8_SB(1, 1), cB + hstep + kstep, voffB);
    PG8_WAIT_V(6); PG8_BAR;
    for (;;) {
        const bool has_next = S.next(ui + 1, nxt);
        const char* nA = has_next ? (const char*)g.A + (size_t)nxt.pm * tstep : cA; const char* nB = has_next ? (const char*)g.Bt + (size_t)nxt.pn * tstep : cB;
        for (int t = 0; t < nt; t += 2) {
            const bool last = (t == nt - 2);
            const char* a1 = cA + (size_t)(t + 1) * kstep;
            const char* a2 = last ? nA : cA + (size_t)(t + 2) * kstep; const char* b2 = last ? nB : cB + (size_t)(t + 2) * kstep;
            const char* a3 = a2 + kstep; const char* b3 = b2 + kstep;
            if (last && has_next) S.a_ready(nxt);
            PG8_LDB(B0, 0, 0); PG8_SCHED; PG8_LDA(At, 0, 0); PG8_STAGE(PG8_SA(1, 1), a1 + hstep, voffA);
            PG8_WAIT_L(8); PG8_BAR; PG8_WAIT_L(0); PG8_MMA(0, 0, At, B0); PG8_BAR; PG8_SCHED;
            PG8_LDB(B1, 0, 1); PG8_STAGE(PG8_SB(0, 0), b2, voffB);
            PG8_BAR; PG8_WAIT_L(0); PG8_MMA(0, 1, At, B1); PG8_BAR;
            PG8_LDA(At, 0, 1); PG8_STAGE(PG8_SA(0, 0), a2, voffA);
            PG8_BAR; PG8_WAIT_L(0); PG8_MMA(1, 0, At, B0); PG8_BAR; PG8_SCHED;
            PG8_STAGE(PG8_SB(0, 1), b2 + hstep, voffB);
            PG8_WAIT_V(6); PG8_BAR; PG8_MMA(1, 1, At, B1); PG8_BAR;
            PG8_LDB(B0, 1, 0); PG8_SCHED; PG8_LDA(At, 1, 0); PG8_STAGE(PG8_SA(0, 1), a2 + hstep, voffA);
            PG8_WAIT_L(8); PG8_BAR; PG8_WAIT_L(0); PG8_MMA(0, 0, At, B0); PG8_BAR; PG8_SCHED;
            PG8_LDB(B1, 1, 1); PG8_STAGE(PG8_SB(1, 0), b3, voffB);
            PG8_BAR; PG8_WAIT_L(0); PG8_MMA(0, 1, At, B1); PG8_BAR;
            PG8_LDA(At, 1, 1); PG8_STAGE(PG8_SA(1, 0), a3, voffA);
            PG8_BAR; PG8_WAIT_L(0); PG8_MMA(1, 0, At, B0); PG8_BAR; PG8_SCHED;
            PG8_STAGE(PG8_SB(1, 1), b3 + hstep, voffB);
            PG8_WAIT_V(6); PG8_BAR; PG8_MMA(1, 1, At, B1); PG8_BAR;
        }
        if constexpr (!Epi::AFTER_DRAIN) { E(acc, cur, wr, wc, fr, fq); S.done(cur); }
        if (!has_next) break;
#pragma unroll
        for (int a = 0; a < 2; ++a)
#pragma unroll
            for (int b = 0; b < 2; ++b)
#pragma unroll
                for (int m = 0; m < 4; ++m)
#pragma unroll
                    for (int n = 0; n < 2; ++n) acc[a][b][m][n] = (f32x4){0.f, 0.f, 0.f, 0.f};
        cur = nxt; cA = nA; cB = nB; ++ui;
    }
    PG8_WAIT_V(0);
    if (wr == 0) PG8_BAR;
    PG8_BAR;
    if constexpr (Epi::AFTER_DRAIN) { E.fused(acc, cur, wr, wc, fr, fq, lds, wid, lane); S.done(cur); }
#undef PG8_SA
#undef PG8_SB
#undef PG8_STAGE
#undef PG8_LDA
#undef PG8_LDB
#undef PG8_MMA
#undef PG8_WAIT_V
#undef PG8_WAIT_L
#undef PG8_BAR
#undef PG8_SCHED
}
}

#define XB_TMO      128
#define XB_XCNT(j)  (256  + 64 * (j))
#define XB_XSUB(j)  (1280 + 64 * (j))
#define XB_XGEN(j)  (2304 + 64 * (j))
#define XB_TOP      3328
#define XB_TOPGEN   3392
#define XCD_BAR_WORDS 3456
#define XB_SPIN_CAP (1u << 18)
#define LAS __attribute__((address_space(3)))

__device__ __forceinline__ unsigned xb_ld(unsigned* p)              { return __hip_atomic_load(p, __ATOMIC_RELAXED, __HIP_MEMORY_SCOPE_AGENT); }
__device__ __forceinline__ unsigned xb_add(unsigned* p, unsigned v) { return __hip_atomic_fetch_add(p, v, __ATOMIC_RELAXED, __HIP_MEMORY_SCOPE_AGENT); }
__device__ __forceinline__ unsigned xb_xcc_id() { return (unsigned)__builtin_amdgcn_s_getreg((3 << 11) | 20) & 0xFu; }
#define XB_SPIN(cond, bar) do { unsigned _sp = 0; while (cond) { __builtin_amdgcn_s_sleep(1); \
    if ((++_sp & 255u) == 0u) { if (xb_ld(&(bar)[XB_TMO])) break; if (_sp > XB_SPIN_CAP) { atomicAdd(&(bar)[XB_TMO], 1u); break; } } } } while (0)

struct XcdBarrier {
    unsigned* bar; unsigned x;
    volatile LAS unsigned* st;
};

__device__ __forceinline__ XcdBarrier xcd_barrier_post(unsigned* bar, volatile LAS unsigned* st) {
    XcdBarrier b; b.bar = bar; b.x = xb_xcc_id(); b.st = st;
    if (threadIdx.x == 0) (void)xb_add(&bar[XB_XCNT(b.x)], 1u);
    return b;
}
__device__ __forceinline__ void xcd_barrier_complete(unsigned* bar, unsigned x, unsigned& nloc, unsigned& nx) {
    const unsigned G = gridDim.x * gridDim.y * gridDim.z;
    unsigned sum, cnt, mine, sp = 0u;
    for (;;) {
        sum = 0u; cnt = 0u; mine = 0u;
#pragma unroll
        for (unsigned j = 0; j < 16; ++j) { const unsigned c = xb_ld(&bar[XB_XCNT(j)]); sum += c; cnt += (c > 0u) ? 1u : 0u; mine = (j == x) ? c : mine; }
        if (sum == G) break;
        __builtin_amdgcn_s_sleep(1);
        if ((++sp & 255u) == 0u) { if (xb_ld(&bar[XB_TMO])) break; if (sp > XB_SPIN_CAP) { atomicAdd(&bar[XB_TMO], 1u); break; } }
    }
    nloc = mine > 0u ? mine : 1u; nx = cnt > 0u ? cnt : 1u;
}

__device__ __forceinline__ void xcd_barrier(const XcdBarrier& b) {
    asm volatile("s_waitcnt vmcnt(0)" ::: "memory");
    __syncthreads();
    if (threadIdx.x == 0) {
        unsigned* bar = b.bar;
        __builtin_amdgcn_s_waitcnt(0);
        unsigned nloc = b.st[0], nx = b.st[1];
        if (nloc == 0u) { xcd_barrier_complete(bar, b.x, nloc, nx); b.st[0] = nloc; b.st[1] = nx; }
        const unsigned old = xb_add(&bar[XB_XSUB(b.x)], 1u);
        const unsigned gen = old / nloc;
        if (old + 1u == (gen + 1u) * nloc) {
            __builtin_amdgcn_fence(__ATOMIC_RELEASE, "agent");
            asm volatile("s_waitcnt vmcnt(0)" ::: "memory");
            const unsigned og = xb_add(&bar[XB_TOP], 1u);
            const unsigned tg = og / nx;
            if (og + 1u == (tg + 1u) * nx) xb_add(&bar[XB_TOPGEN], 1u);
            else XB_SPIN(xb_ld(&bar[XB_TOPGEN]) == tg, bar);
            __builtin_amdgcn_fence(__ATOMIC_ACQUIRE, "agent");
            xb_add(&bar[XB_XGEN(b.x)], 1u);
            asm volatile("s_waitcnt vmcnt(0)" ::: "memory");
        } else {
            XB_SPIN(xb_ld(&bar[XB_XGEN(b.x)]) == gen, bar);
            __builtin_amdgcn_fence(__ATOMIC_ACQUIRE, "agent");
            asm volatile("s_waitcnt vmcnt(0)" ::: "memory");
        }
    }
    __syncthreads();
}

typedef const float* cfp_t;
typedef __attribute__((address_space(4))) const cfp_t* ka_t;
struct Ctx {
    LAS unsigned char* lds; int tid, lane, wave, bid, G;
};

__device__ __forceinline__ void task_ada(const Ctx& F, const float* c, const float* c_ctx, const float* w_ada, float* modp, int task) {
    LAS float* s_act = (LAS float*)F.lds;
    const int l = task / (KSPL * 6), rem = task % (KSPL * 6), ks = rem / 6, cc = rem % 6;
    __syncthreads();
    if (F.tid < 320) { const int v = F.tid >> 6, k = ks * 64 + (F.tid & 63); const float x = v < 4 ? c[v * 2048 + k] : c_ctx[k]; s_act[F.tid] = siluf_(x); }
    __syncthreads();
    const int col4 = cc * 512 + F.tid;
    const float4* wp = (const float4*)(w_ada + ((size_t)l * 2048 + ks * 64) * 12288) + col4;
    float4 acc[5];
#pragma unroll
    for (int v = 0; v < 5; ++v) acc[v] = make_float4(0.f, 0.f, 0.f, 0.f);
#pragma unroll 8
    for (int k = 0; k < 64; ++k) {
        const float4 w = wp[(size_t)k * 3072];
#pragma unroll
        for (int v = 0; v < 5; ++v) { const float a = s_act[v * 64 + k]; acc[v].x += a * w.x; acc[v].y += a * w.y; acc[v].z += a * w.z; acc[v].w += a * w.w; }
    }
#pragma unroll
    for (int v = 0; v < 5; ++v) ((float4*)(modp + (((size_t)ks * 2 + l) * 5 + v) * 12288))[col4] = acc[v];
}
__device__ __forceinline__ void task_wt(const Ctx& F, const float* W, int N, bf16_t* Wt, int ntile) {
    LAS bf16_t* T = (LAS bf16_t*)F.lds;
    const int nq = F.tid & 15, kr = F.tid >> 4, n0 = ntile * 64;
    for (int kc = 0; kc < 16; ++kc) {
        float4 v[4];
#pragma unroll
        for (int j = 0; j < 4; ++j) { const int k = kc * 128 + kr + 32 * j, n = n0 + 4 * nq;
            v[j] = (n < N) ? *(const float4*)(W + (size_t)k * N + n) : make_float4(0.f, 0.f, 0.f, 0.f); }
        __syncthreads();
#pragma unroll
        for (int j = 0; j < 4; ++j) { const int kl = kr + 32 * j;
            T[(4 * nq + 0) * 136 + kl] = f2bf(v[j].x); T[(4 * nq + 1) * 136 + kl] = f2bf(v[j].y); T[(4 * nq + 2) * 136 + kl] = f2bf(v[j].z); T[(4 * nq + 3) * 136 + kl] = f2bf(v[j].w); }
        __syncthreads();
        { const int n = F.tid >> 3, kg = F.tid & 7;
          const u32x4 a = *(LAS u32x4*)(T + n * 136 + kg * 16), b = *(LAS u32x4*)(T + n * 136 + kg * 16 + 8);
          bf16_t* dst = Wt + (size_t)(n0 + n) * 2048 + kc * 128 + kg * 16; *(u32x4*)dst = a; *(u32x4*)(dst + 8) = b; }
    }
    __syncthreads();
}
__device__ __forceinline__ void task_cvt(const Ctx& F, const float* src, bf16_t* dst, size_t off) {
#pragma unroll 4
    for (int it = 0; it < 16; ++it) { const size_t e = off + (size_t)it * 4096 + F.tid * 8;
        const float4 a = *(const float4*)(src + e), b = *(const float4*)(src + e + 4);
        u32x4 o; o.x = pk_bf16(a.x, a.y); o.y = pk_bf16(a.z, a.w); o.z = pk_bf16(b.x, b.y); o.w = pk_bf16(b.z, b.w);
        *(u32x4*)(dst + e) = o; }
}
__device__ __forceinline__ void task_cvt8(const Ctx& F, const float* src, unsigned char* dst, size_t off, float scale) {
#pragma unroll 2
    for (int it = 0; it < 8; ++it) { const size_t e = off + (size_t)it * 8192 + F.tid * 16;
        u32x4 o;
#pragma unroll
        for (int w = 0; w < 4; ++w) { const float4 a = *(const float4*)(src + e + 4 * w);
            const float x0 = fminf(fmaxf(a.x * scale, -448.f), 448.f), x1 = fminf(fmaxf(a.y * scale, -448.f), 448.f), x2 = fminf(fmaxf(a.z * scale, -448.f), 448.f), x3 = fminf(fmaxf(a.w * scale, -448.f), 448.f);
            int p = __builtin_amdgcn_cvt_pk_fp8_f32(x0, x1, 0, false); p = __builtin_amdgcn_cvt_pk_fp8_f32(x2, x3, p, true); o[w] = (unsigned)p; }
        const size_t row = e >> 11; const int col = (int)(e & 2047);
        *(u32x4*)(dst + (row >> 14) * ((size_t)16384 * 2048) + ((size_t)(col >> 7) * 16384 + (row & 16383)) * 128 + (col & 127)) = o; }
}
constexpr float PEER_U_SCALE = 64.0f;
#define PEER_CONVERT_LAYER(F, in, ws, layer, blk, nblk) do { for (int t_ = (blk); t_ < 1024; t_ += (nblk)) { const bool isv_ = t_ >= 512; \
        task_cvt8(F, in[isv_ ? I_PV : I_PU], ws + (isv_ ? WS_PV : WS_PU), (size_t)(layer) * 16384 * 2048 + (size_t)(t_ & 511) * 65536, isv_ ? 1.0f : PEER_U_SCALE); } } while (0)
__device__ __forceinline__ void task_lorat(const Ctx& F, const float* src, bf16_t* dst, int nj) {
    const int ch = F.tid;
    for (int j8 = 0; j8 < nj / 8; ++j8) { float v[8];
#pragma unroll
        for (int q = 0; q < 8; ++q) v[q] = src[(size_t)(j8 * 8 + q) * 512 + ch];
        u32x4 o; o.x = pk_bf16(v[0], v[1]); o.y = pk_bf16(v[2], v[3]); o.z = pk_bf16(v[4], v[5]); o.w = pk_bf16(v[6], v[7]);
        *(u32x4*)(dst + (size_t)ch * nj + j8 * 8) = o; }
}
constexpr int T_ADA = 2 * KSPL * 6, T_WT1 = 2 * 104, T_WT2 = 2 * 32, T_WT3 = 2 * 32, T_PEER = 0, T_KEYS = 8, T_LORA = 10;
__device__ __forceinline__ void phase_prologue(const Ctx& F, ka_t in, unsigned char* ws) {
    const int total = T_ADA + T_WT1 + T_WT2 + T_WT3 + T_PEER + T_KEYS + T_LORA + 1;
    for (int t0 = F.bid; t0 < total; t0 += F.G) {
        int t = t0;
        if (t < T_ADA) { task_ada(F, in[I_C], in[I_CCTX], in[I_WADA], (float*)(ws + WS_MODP), t); continue; } t -= T_ADA;
        if (t < T_WT1) { const int l = t / 104, nt = t % 104; task_wt(F, in[I_WIN] + (size_t)l * 2048 * PT, PT, (bf16_t*)(ws + WS_WIN) + (size_t)l * PTP * 2048, nt); continue; } t -= T_WT1;
        if (t < T_WT2) { const int l = t / 32, nt = t % 32; task_wt(F, in[I_WOUT] + (size_t)l * 2048 * 2048, 2048, (bf16_t*)(ws + WS_WOUT) + (size_t)l * 2048 * 2048, nt); continue; } t -= T_WT2;
        if (t < T_WT3) { const int l = t / 32, nt = t % 32; task_wt(F, in[I_PWQ] + (size_t)l * 2048 * 2048, 2048, (bf16_t*)(ws + WS_WQ) + (size_t)l * 2048 * 2048, nt); continue; } t -= T_WT3;
        if (t < T_PEER) { const bool isv = t >= 1024; const int c = t & 1023; task_cvt8(F, in[isv ? I_PV : I_PU], ws + (isv ? WS_PV : WS_PU), (size_t)c * 65536, isv ? 1.0f : PEER_U_SCALE); continue; } t -= T_PEER;
        if (t < T_KEYS) { task_cvt(F, in[I_PKEYS], (bf16_t*)(ws + WS_KEYS), (size_t)t * 65536); continue; } t -= T_KEYS;
        if (t < T_LORA) {
            if (t < 8) { const int l = t >> 2, wh = t & 3;
                task_lorat(F, in[wh < 2 ? I_RWUP : I_RAUP] + ((size_t)l * 2 + (wh & 1)) * 64 * 512, (bf16_t*)(ws + WS_WUPT) + ((size_t)l * 4 + wh) * 512 * 64, 64); }
            else { const int l = t - 8; task_lorat(F, in[I_RGUP] + (size_t)l * 128 * 512, (bf16_t*)(ws + WS_GUPT) + (size_t)l * 512 * 128, 128); }
            continue; } t -= T_LORA;
        { float* rope = (float*)(ws + WS_ROPE);
          for (int e = F.tid; e < 2048; e += 512) { const int pos = e >> 5, i = e & 31; const float fr = powf(10000.0f, -(float)i / 32.0f), ang = (float)pos * fr;
              rope[2 * e] = cosf(ang); rope[2 * e + 1] = sinf(ang); } }
    }
}
__device__ __forceinline__ void phase_modreduce(const Ctx& F, const float* b_ada, const float* modp, float* mod) {
    for (int idx = F.bid * 512 + F.tid; idx < 2 * 5 * 12288; idx += F.G * 512) {
        const int l = idx / 61440, rem = idx % 61440, v = rem / 12288, n = rem % 12288;
        float s = b_ada[l * 12288 + n];
        for (int ks = 0; ks < KSPL; ++ks) s += modp[(((size_t)ks * 2 + l) * 5 + v) * 12288 + n];
        mod[idx] = s;
    }
}

__device__ __forceinline__ void norm_store(const float (&x)[32], const float* gw, const float* shift, const float* scale, bf16_t* dst, int lane) {
    float ss = 0.f;
#pragma unroll
    for (int q = 0; q < 32; ++q) ss += x[q] * x[q];
    ss = wave_sum(ss);
    const float rs = rsqrtf(ss * (1.0f / 2048.0f) + 1e-6f);
#pragma unroll
    for (int j = 0; j < 4; ++j) { const int e = j * 512 + lane * 8;
        const float4 g0 = *(const float4*)(gw + e), g1 = *(const float4*)(gw + e + 4), h0 = *(const float4*)(shift + e), h1 = *(const float4*)(shift + e + 4), c0 = *(const float4*)(scale + e), c1 = *(const float4*)(scale + e + 4);
        const float y0 = x[j * 8 + 0] * rs * g0.x * (1.f + c0.x) + h0.x, y1 = x[j * 8 + 1] * rs * g0.y * (1.f + c0.y) + h0.y, y2 = x[j * 8 + 2] * rs * g0.z * (1.f + c0.z) + h0.z, y3 = x[j * 8 + 3] * rs * g0.w * (1.f + c0.w) + h0.w;
        const float y4 = x[j * 8 + 4] * rs * g1.x * (1.f + c1.x) + h1.x, y5 = x[j * 8 + 5] * rs * g1.y * (1.f + c1.y) + h1.y, y6 = x[j * 8 + 6] * rs * g1.z * (1.f + c1.z) + h1.z, y7 = x[j * 8 + 7] * rs * g1.w * (1.f + c1.w) + h1.w;
        u32x4 o; o.x = pk_bf16(y0, y1); o.y = pk_bf16(y2, y3); o.z = pk_bf16(y4, y5); o.w = pk_bf16(y6, y7);
        *(u32x4*)(dst + e) = o; }
}
__device__ __forceinline__ void phase_norm(const Ctx& F, const float* xlat, const float* xctx, const float* gw, const float* mod, int shift_i, int scale_i, bf16_t* dst, int nrows) {
    for (int row = F.bid * 8 + F.wave; row < nrows; row += F.G * 8) {
        const bool isctx = row >= NLAT; const float* xr = isctx ? xctx + (size_t)(row - NLAT) * 2048 : xlat + (size_t)row * 2048;
        const int v = isctx ? 4 : (row >> 12);
        float x[32];
#pragma unroll
        for (int j = 0; j < 4; ++j) { const int e = j * 512 + F.lane * 8; const float4 a = *(const float4*)(xr + e), b = *(const float4*)(xr + e + 4);
            x[j * 8 + 0] = a.x; x[j * 8 + 1] = a.y; x[j * 8 + 2] = a.z; x[j * 8 + 3] = a.w; x[j * 8 + 4] = b.x; x[j * 8 + 5] = b.y; x[j * 8 + 6] = b.z; x[j * 8 + 7] = b.w; }
        norm_store(x, gw, mod + (size_t)v * 12288 + shift_i * 2048, mod + (size_t)v * 12288 + scale_i * 2048, dst + (size_t)row * 2048, F.lane);
    }
}

struct LayerW {
    const float *sc_w, *rw_w0, *rw_wup, *rw_a0, *rw_aup, *rw_gup, *rw_kk, *rw_ka, *rw_rk, *rw_lnw, *rw_lnb, *na_q, *na_k, *rpb, *s_cw, *s_cb, *s_dtb, *s_alog, *s_d, *s_norm;
};
__device__ __forceinline__ void unpack8(const u32x4 q, float (&f)[8]) { f[0] = bflo(q[0]); f[1] = bfhi(q[0]); f[2] = bflo(q[1]); f[3] = bfhi(q[1]); f[4] = bflo(q[2]); f[5] = bfhi(q[2]); f[6] = bflo(q[3]); f[7] = bfhi(q[3]); }
__device__ __forceinline__ u32x4 pack8f(const float (&f)[8]) { u32x4 o; o[0] = pk_bf16(f[0], f[1]); o[1] = pk_bf16(f[2], f[3]); o[2] = pk_bf16(f[4], f[5]); o[3] = pk_bf16(f[6], f[7]); return o; }
__device__ __forceinline__ void load8f(const float* p, float (&f)[8]) { const float4 a = *(const float4*)p, b = *(const float4*)(p + 4); f[0] = a.x; f[1] = a.y; f[2] = a.z; f[3] = a.w; f[4] = b.x; f[5] = b.y; f[6] = b.z; f[7] = b.w; }
__device__ __forceinline__ void phase_prep(const Ctx& F, const LayerW& W, unsigned char* ws) {
    const bf16_t* P = (const bf16_t*)(ws + WS_P);
    bf16_t* MIX = (bf16_t*)(ws + WS_MIX);
    bf16_t* XBC = (bf16_t*)(ws + WS_XBC); float* DTS = (float*)(ws + WS_DTS); float* DEC = (float*)(ws + WS_DEC);
    bf16_t* QN = (bf16_t*)(ws + WS_QN); bf16_t* KN = (bf16_t*)(ws + WS_KN); bf16_t* VTL = (bf16_t*)(ws + WS_VTL); bf16_t* VTC = (bf16_t*)(ws + WS_VTC);
    const float* ROPE = (const float*)(ws + WS_ROPE);
    for (int tile = F.bid; tile < NTOK / 8; tile += F.G) {
        int ln = F.lane; asm volatile("" : "+v"(ln));
        const int ch0 = ln * 8;
        const bool lat = tile < NLAT / 8;
        const int b = lat ? (tile >> 9) : ((tile - NLAT / 8) >> 5);
        const int t0 = lat ? (tile & 511) * 8 : ((tile - NLAT / 8) & 31) * 8;
        const int L = lat ? SEQL : CTXL;
        const int g0 = lat ? b * SEQL + t0 : NLAT + b * CTXL + t0;
        const bf16_t* Pr = P + (size_t)g0 * PTP;
        if (F.wave == 0 || F.wave == 4) {
            const bool gated = F.wave == 0;
            const float* cw = gated ? W.sc_w : W.s_cw; const int cstride = gated ? 512 : 1024;
            float w0[8], w1[8], w2[8], cb[8];
            load8f(cw + ch0, w0); load8f(cw + cstride + ch0, w1); load8f(cw + 2 * cstride + ch0, w2);
            if (gated) {
#pragma unroll
                for (int e = 0; e < 8; ++e) cb[e] = 0.f;
            } else load8f(W.s_cb + ch0, cb);
            const int col = gated ? A_CG : D_X;
#pragma unroll 1
            for (int tb = 0; tb < 8; tb += 4) {
            u32x4 ra[6], rb[6], rg[4];
#pragma unroll
            for (int q = 0; q < 6; ++q) { const int tq = t0 + tb - 1 + q; const bool ok = (tq >= 0) && (tq < L);
                ra[q] = ok ? *(const u32x4*)(Pr + (ptrdiff_t)(tb + q - 1) * PTP + col + ch0) : (u32x4){0u, 0u, 0u, 0u};
                if (gated) rb[q] = ok ? *(const u32x4*)(Pr + (ptrdiff_t)(tb + q - 1) * PTP + A_H + ch0) : (u32x4){0u, 0u, 0u, 0u}; }
            if (gated) {
#pragma unroll
                for (int tt = 0; tt < 4; ++tt) rg[tt] = *(const u32x4*)(Pr + (size_t)(tb + tt) * PTP + A_BG + ch0); }
            float up[8], uc[8], un[8];
            { float x[8], y[8]; unpack8(ra[0], x); if (gated) { unpack8(rb[0], y);
#pragma unroll
                for (int e = 0; e < 8; ++e) x[e] *= y[e]; }
#pragma unroll
              for (int e = 0; e < 8; ++e) up[e] = x[e];
              unpack8(ra[1], x); if (gated) { unpack8(rb[1], y);
#pragma unroll
                for (int e = 0; e < 8; ++e) x[e] *= y[e]; }
#pragma unroll
              for (int e = 0; e < 8; ++e) uc[e] = x[e]; }
#pragma unroll
            for (int tt = 0; tt < 4; ++tt) {
                { float x[8], y[8]; unpack8(ra[tt + 2], x); if (gated) { unpack8(rb[tt + 2], y);
#pragma unroll
                    for (int e = 0; e < 8; ++e) x[e] *= y[e]; }
#pragma unroll
                  for (int e = 0; e < 8; ++e) un[e] = x[e]; }
                float o[8];
                if (gated) { float bg[8]; unpack8(rg[tt], bg);
#pragma unroll
                    for (int e = 0; e < 8; ++e) o[e] = bg[e] * (w0[e] * up[e] + w1[e] * uc[e] + w2[e] * un[e]);
                    *(u32x4*)(MIX + (size_t)(g0 + tb + tt) * 2048 + ch0) = pack8f(o);
                } else {
#pragma unroll
                    for (int e = 0; e < 8; ++e) o[e] = siluf_(w0[e] * up[e] + w1[e] * uc[e] + w2[e] * un[e] + cb[e]);
                    *(u32x4*)(XBC + (size_t)(g0 + tb + tt) * 1024 + ch0) = pack8f(o); }
#pragma unroll
                for (int e = 0; e < 8; ++e) { up[e] = uc[e]; uc[e] = un[e]; }
            }
            }
        } else if (F.wave == 1 || F.wave == 2) {
            const bool isq = F.wave == 1; const int col = isq ? C_Q : C_K; bf16_t* dst = isq ? QN : KN;
            float nw[8]; load8f((isq ? W.na_q : W.na_k) + (ln & 7) * 8, nw);
            const float sc = isq ? 0.125f : 1.0f;
            u32x4 rq[8];
#pragma unroll
            for (int tt = 0; tt < 8; ++tt) rq[tt] = *(const u32x4*)(Pr + (size_t)tt * PTP + col + ch0);
#pragma unroll
            for (int tt = 0; tt < 8; ++tt) { float x[8]; unpack8(rq[tt], x); float ss = 0.f;
#pragma unroll
                for (int e = 0; e < 8; ++e) ss += x[e] * x[e];
                ss = sum8(ss); const float rs = rsqrtf(ss * (1.f / 64.f) + 1e-6f) * sc;
#pragma unroll
                for (int e = 0; e < 8; ++e) x[e] = x[e] * rs * nw[e];
                *(u32x4*)(dst + (size_t)(g0 + tt) * 512 + ch0) = pack8f(x); }
        } else if (F.wave == 3) {
            u32x4 rv[8];
#pragma unroll
            for (int tt = 0; tt < 8; ++tt) rv[tt] = *(const u32x4*)(Pr + (size_t)tt * PTP + C_V + ch0);
            const int h = ln >> 3;
#pragma unroll
            for (int e = 0; e < 8; ++e) { const int i = (ln & 7) * 8 + e;
                unsigned short v[8];
#pragma unroll
                for (int tt = 0; tt < 8; ++tt) v[tt] = (unsigned short)((e & 1) ? (rv[tt][e >> 1] >> 16) : (rv[tt][e >> 1] & 0xffffu));
                u32x2 c0; c0.x = (unsigned)v[0] | ((unsigned)v[1] << 16); c0.y = (unsigned)v[2] | ((unsigned)v[3] << 16);
                u32x2 c1; c1.x = (unsigned)v[4] | ((unsigned)v[5] << 16); c1.y = (unsigned)v[6] | ((unsigned)v[7] << 16);
                if (lat) { const int row = t0 >> 6, x0 = (t0 & 63) >> 2, x1 = x0 + 1;
                    bf16_t* base = VTL + ((size_t)((b * 8 + h) * 64 + i) * 64 + row) * 96;
                    if (x0 <= 11) *(u32x2*)(base + x0 * 8) = c0;
                    if (x0 >= 4)  *(u32x2*)(base + (x0 - 4) * 8 + 4) = c0;
                    if (x1 <= 11) *(u32x2*)(base + x1 * 8) = c1;
                    if (x1 >= 4)  *(u32x2*)(base + (x1 - 4) * 8 + 4) = c1;
                } else { const int m = t0 >> 5, o = t0 & 31, gq = (o & 15) >> 2, hf = (o >> 4) * 4;
                    bf16_t* base = VTC + ((size_t)((b * 8 + h) * 64 + i) * 8 + m) * 32;
                    *(u32x2*)(base + gq * 8 + hf) = c0; *(u32x2*)(base + (gq + 1) * 8 + hf) = c1; } }
        } else if (F.wave == 5) {
            if (ln < 32) {
                const int pg = ln, which = pg >> 4, gi = (pg >> 3) & 1, half = (pg >> 2) & 1, i0 = (pg & 3) * 8;
                const int c1 = 512 + which * 256 + gi * 128 + half * 64 + i0, c2 = c1 + 32;
                float wa0[8], wa1[8], wa2[8], ba[8], wb0[8], wb1[8], wb2[8], bb[8];
                load8f(W.s_cw + c1, wa0); load8f(W.s_cw + 1024 + c1, wa1); load8f(W.s_cw + 2048 + c1, wa2); load8f(W.s_cb + c1, ba);
                load8f(W.s_cw + c2, wb0); load8f(W.s_cw + 1024 + c2, wb1); load8f(W.s_cw + 2048 + c2, wb2); load8f(W.s_cb + c2, bb);
#pragma unroll 1
                for (int tb = 0; tb < 8; tb += 2) {
                u32x4 ra[4], rb[4];
#pragma unroll
                for (int q = 0; q < 4; ++q) { const int tq = t0 + tb - 1 + q; const bool ok = (tq >= 0) && (tq < L);
                    ra[q] = ok ? *(const u32x4*)(Pr + (ptrdiff_t)(tb + q - 1) * PTP + D_X + c1) : (u32x4){0u, 0u, 0u, 0u};
                    rb[q] = ok ? *(const u32x4*)(Pr + (ptrdiff_t)(tb + q - 1) * PTP + D_X + c2) : (u32x4){0u, 0u, 0u, 0u}; }
                float ap[8], ac[8], an[8], bp[8], bc[8], bn[8];
                unpack8(ra[0], ap); unpack8(ra[1], ac); unpack8(rb[0], bp); unpack8(rb[1], bc);
#pragma unroll
                for (int tt = 0; tt < 2; ++tt) { unpack8(ra[tt + 2], an); unpack8(rb[tt + 2], bn);
                    float y1[8], y2[8];
#pragma unroll
                    for (int e = 0; e < 8; ++e) { y1[e] = siluf_(wa0[e] * ap[e] + wa1[e] * ac[e] + wa2[e] * an[e] + ba[e]); y2[e] = siluf_(wb0[e] * bp[e] + wb1[e] * bc[e] + wb2[e] * bn[e] + bb[e]); }
                    if (lat) { const int t = t0 + tb + tt, pos = half ? (t & 63) : (t >> 6);
                        float cs[16];
#pragma unroll
                        for (int q = 0; q < 4; ++q) { const float4 v = *(const float4*)(ROPE + (size_t)(pos * 32 + i0) * 2 + 4 * q); cs[4 * q] = v.x; cs[4 * q + 1] = v.y; cs[4 * q + 2] = v.z; cs[4 * q + 3] = v.w; }
#pragma unroll
                        for (int e = 0; e < 8; ++e) { const float o1 = y1[e] * cs[2 * e] - y2[e] * cs[2 * e + 1], o2 = y1[e] * cs[2 * e + 1] + y2[e] * cs[2 * e]; y1[e] = o1; y2[e] = o2; } }
                    *(u32x4*)(XBC + (size_t)(g0 + tb + tt) * 1024 + c1) = pack8f(y1); *(u32x4*)(XBC + (size_t)(g0 + tb + tt) * 1024 + c2) = pack8f(y2);
#pragma unroll
                    for (int e = 0; e < 8; ++e) { ap[e] = ac[e]; ac[e] = an[e]; bp[e] = bc[e]; bc[e] = bn[e]; }
                }
                }
            }
        } else if (F.wave == 6) {
#pragma unroll
            for (int q = 0; q < 2; ++q) { const int it = ln + 64 * q, tt = it >> 4, j = it & 15;
                const float x = bf2f(Pr[(size_t)tt * PTP + D_DT + j]) + W.s_dtb[j];
                const float sp = fmaxf(x, 0.f) + log1pf(__expf(-fabsf(x)));
                DTS[(size_t)(g0 + tt) * 16 + j] = sp; DEC[(size_t)(g0 + tt) * 16 + j] = -sp * __expf(W.s_alog[j]); }
        }
    }
}

constexpr int SB_PITCH = 136;
__device__ __forceinline__ void ssd_scan_L(const Ctx& F, LAS float* sL, const float* LA, int g0, int h) {
    const int d = (F.tid >> 7) & 1, t = F.tid & 127;
    float v = 0.f;
    if (F.tid < 256) { v = LA[(size_t)(g0 + t) * 16 + d * 8 + h]; sL[F.tid] = v; }
    __syncthreads();
#pragma unroll
    for (int off = 1; off < 128; off <<= 1) {
        float o = 0.f;
        if (F.tid < 256) { const int tp = d ? t + off : t - off; if (tp >= 0 && tp < 128) o = sL[d * 128 + tp]; }
        __syncthreads();
        if (F.tid < 256) { v += o; sL[F.tid] = v; }
        __syncthreads();
    }
}
template <bool PASS2>
__device__ __forceinline__ void ssd_task(const Ctx& F, const LayerW& W, unsigned char* ws, int task) {
    const bf16_t* XBC = (const bf16_t*)(ws + WS_XBC); const float* DTS = (const float*)(ws + WS_DTS); const float* LA = (const float*)(ws + WS_DEC);
    float* SST = (float*)(ws + WS_SST); float* SCD = (float*)(ws + WS_SCD); float* YS = (float*)(ws + WS_YS);
    const int c = task % NCH, bh = task / NCH, h = bh & 7, b = bh >> 3, gi = h >> 2;
    const int g0 = c < 2 ? NLAT + b * CTXL + c * 128 : b * SEQL + (c - 2) * 128;
    const int w = F.wave, l16 = F.lane & 15, g = F.lane >> 4;
    const f32x4 z4 = {0.f, 0.f, 0.f, 0.f};
    LAS float* sL = (LAS float*)(F.lds + 131072);
    LAS float* sDT = sL + 256;
    __syncthreads();
    if (F.tid < 256) { const int s = F.tid >> 1, d = F.tid & 1; sDT[F.tid] = DTS[(size_t)(g0 + s) * 16 + d * 8 + h]; }
    ssd_scan_L(F, sL, LA, g0, h);
    if (!PASS2) {
        LAS bf16_t* sBT = (LAS bf16_t*)F.lds;
        LAS bf16_t* sXT = sBT + 128 * SB_PITCH;
#pragma unroll
        for (int q = 0; q < 4; ++q) { const int v = F.tid + 512 * q, s = v >> 4, part = v & 15;
            const u32x4 bv = *(const u32x4*)(XBC + (size_t)(g0 + s) * 1024 + 512 + gi * 128 + part * 8);
#pragma unroll
            for (int e = 0; e < 4; ++e) { sBT[(part * 8 + 2 * e) * SB_PITCH + s] = (bf16_t)(bv[e] & 0xffffu); sBT[(part * 8 + 2 * e + 1) * SB_PITCH + s] = (bf16_t)(bv[e] >> 16); } }
#pragma unroll
        for (int q = 0; q < 2; ++q) { const int v = F.tid + 512 * q, s = v >> 3, part = v & 7;
            const u32x4 xv = *(const u32x4*)(XBC + (size_t)(g0 + s) * 1024 + h * 64 + part * 8);
            const float sc0 = sDT[s * 2] * __expf(sL[127] - sL[s]), sc1 = sDT[s * 2 + 1] * __expf(sL[128] - sL[128 + s]);
#pragma unroll
            for (int e = 0; e < 4; ++e) { const float lo = bflo(xv[e]), hi = bfhi(xv[e]); const int p = part * 8 + 2 * e;
                sXT[p * SB_PITCH + s] = f2bf(lo * sc0); sXT[(p + 1) * SB_PITCH + s] = f2bf(hi * sc0);
                sXT[(64 + p) * SB_PITCH + s] = f2bf(lo * sc1); sXT[(64 + p + 1) * SB_PITCH + s] = f2bf(hi * sc1); } }
        __syncthreads();
        bf16x8 bfr[4];
#pragma unroll
        for (int ks = 0; ks < 4; ++ks) bfr[ks] = *(const LAS bf16x8*)(sBT + (16 * w + l16) * SB_PITCH + 32 * ks + 8 * g);
#pragma unroll
        for (int d = 0; d < 2; ++d) {
            float* st = SST + ((size_t)((b * 8 + h) * 2 + d) * NCH + c) * 8192;
#pragma unroll
            for (int pt = 0; pt < 4; ++pt) { f32x4 acc = z4;
#pragma unroll
                for (int ks = 0; ks < 4; ++ks) acc = __builtin_amdgcn_mfma_f32_16x16x32_bf16(*(const LAS bf16x8*)(sXT + (d * 64 + 16 * pt + l16) * SB_PITCH + 32 * ks + 8 * g), bfr[ks], acc, 0, 0, 0);
#pragma unroll
                for (int r = 0; r < 4; ++r) st[(16 * pt + 4 * g + r) * 128 + 16 * w + l16] = acc[r]; }
            if (F.tid == 0) SCD[((b * 8 + h) * 2 + d) * NCH + c] = __expf(d ? sL[128] : sL[127]);
        }
    } else {
        LAS bf16_t* sB = (LAS bf16_t*)F.lds;
        LAS bf16_t* sC = sB + 128 * SB_PITCH;
        LAS bf16_t* sXT = sC + 128 * SB_PITCH;
        LAS bf16_t* sS = sXT + 64 * SB_PITCH;
#pragma unroll
        for (int q = 0; q < 4; ++q) { const int v = F.tid + 512 * q, s = v >> 4, part = v & 15;
            *(LAS u32x4*)(sB + s * SB_PITCH + part * 8) = *(const u32x4*)(XBC + (size_t)(g0 + s) * 1024 + 512 + gi * 128 + part * 8);
            *(LAS u32x4*)(sC + s * SB_PITCH + part * 8) = *(const u32x4*)(XBC + (size_t)(g0 + s) * 1024 + 768 + gi * 128 + part * 8); }
#pragma unroll
        for (int q = 0; q < 2; ++q) { const int v = F.tid + 512 * q, s = v >> 3, part = v & 7;
            const u32x4 xv = *(const u32x4*)(XBC + (size_t)(g0 + s) * 1024 + h * 64 + part * 8);
#pragma unroll
            for (int e = 0; e < 4; ++e) { sXT[(part * 8 + 2 * e) * SB_PITCH + s] = (bf16_t)(xv[e] & 0xffffu); sXT[(part * 8 + 2 * e + 1) * SB_PITCH + s] = (bf16_t)(xv[e] >> 16); } }
#pragma unroll
        for (int q = 0; q < 4; ++q) { const int v = F.tid + 512 * q, d = v >> 10, p = (v >> 4) & 63, part = v & 15;
            const float* sp = SST + ((size_t)((b * 8 + h) * 2 + d) * NCH + c) * 8192 + p * 128 + part * 8;
            const float4 a0 = *(const float4*)sp, a1 = *(const float4*)(sp + 4);
            u32x4 o; o.x = pk_bf16(a0.x, a0.y); o.y = pk_bf16(a0.z, a0.w); o.z = pk_bf16(a1.x, a1.y); o.w = pk_bf16(a1.z, a1.w);
            *(LAS u32x4*)(sS + (d * 64 + p) * SB_PITCH + part * 8) = o; }
        __syncthreads();
        const int t = 16 * w + l16;
        bf16x8 cfr[4];
#pragma unroll
        for (int ks = 0; ks < 4; ++ks) cfr[ks] = *(const LAS bf16x8*)(sC + t * SB_PITCH + 32 * ks + 8 * g);
        f32x4 gt[8];
#pragma unroll
        for (int a = 0; a < 8; ++a) { f32x4 acc = z4;
#pragma unroll
            for (int ks = 0; ks < 4; ++ks) acc = __builtin_amdgcn_mfma_f32_16x16x32_bf16(*(const LAS bf16x8*)(sB + (16 * a + l16) * SB_PITCH + 32 * ks + 8 * g), cfr[ks], acc, 0, 0, 0);
            gt[a] = acc; }
        f32x4 ysum[4] = {z4, z4, z4, z4};
#pragma unroll
        for (int d = 0; d < 2; ++d) {
            const float Lt = sL[d * 128 + t], eLt = __expf(Lt);
            f32x4 acc[4];
#pragma unroll
            for (int pt = 0; pt < 4; ++pt) { f32x4 a = z4;
#pragma unroll
                for (int ks = 0; ks < 4; ++ks) a = __builtin_amdgcn_mfma_f32_16x16x32_bf16(*(const LAS bf16x8*)(sS + (d * 64 + 16 * pt + l16) * SB_PITCH + 32 * ks + 8 * g), cfr[ks], a, 0, 0, 0);
                acc[pt] = a * eLt; }
#pragma unroll
            for (int m = 0; m < 4; ++m) {
                const bool need = d ? (2 * m + 1 >= w) : (2 * m <= w);
                if (need) {
                    f32x4 wt[2];
#pragma unroll
                    for (int u = 0; u < 2; ++u) { const int a = 2 * m + u;
                        const f32x4 Ls = *(const LAS f32x4*)(sL + d * 128 + 16 * a + 4 * g);
#pragma unroll
                        for (int r = 0; r < 4; ++r) { const int s = 16 * a + 4 * g + r; const bool ok = d ? (s >= t) : (s <= t);
                            const float dts = sDT[s * 2 + d];
                            wt[u][r] = ok ? gt[a][r] * __expf(Lt - Ls[r]) * dts : 0.f; } }
                    const bf16x8 bfrag = pack8(wt[0], wt[1]);
#pragma unroll
                    for (int pt = 0; pt < 4; ++pt) { union { bf16x8 v; u32x2 hh[2]; } af;
                        af.hh[0] = *(const LAS u32x2*)(sXT + (16 * pt + l16) * SB_PITCH + 32 * m + 4 * g); af.hh[1] = *(const LAS u32x2*)(sXT + (16 * pt + l16) * SB_PITCH + 32 * m + 16 + 4 * g);
                        acc[pt] = __builtin_amdgcn_mfma_f32_16x16x32_bf16(af.v, bfrag, acc[pt], 0, 0, 0); }
                }
            }
#pragma unroll
            for (int pt = 0; pt < 4; ++pt) ysum[pt] = ysum[pt] + acc[pt];
        }
        const float dsk = W.s_d[h];
#pragma unroll
        for (int pt = 0; pt < 4; ++pt) { const int p = 16 * pt + 4 * g;
            const u32x2 xv = *(const u32x2*)(XBC + (size_t)(g0 + t) * 1024 + h * 64 + p);
            *(float4*)(YS + (size_t)(g0 + t) * 512 + h * 64 + p) = make_float4(ysum[pt][0] + dsk * bflo(xv.x), ysum[pt][1] + dsk * bfhi(xv.x), ysum[pt][2] + dsk * bflo(xv.y), ysum[pt][3] + dsk * bfhi(xv.y)); }
    }
}
template <int D> __device__ __forceinline__ void ssd_combine_one(float4* base, const float* scd) {
    float4 carry = make_float4(0.f, 0.f, 0.f, 0.f);
#pragma unroll
    for (int k0 = 0; k0 < NCH; k0 += 17) {
        float4 tmp[17];
#pragma unroll
        for (int k = 0; k < 17; ++k) { const int kk = k0 + k, c = D ? (kk < 2 ? 1 - kk : 35 - kk) : kk; tmp[k] = base[(size_t)c * 2048]; }
#pragma unroll
        for (int k = 0; k < 17; ++k) { const int kk = k0 + k, c = D ? (kk < 2 ? 1 - kk : 35 - kk) : kk; const float a = scd[c];
            base[(size_t)c * 2048] = carry;
            carry.x = a * carry.x + tmp[k].x; carry.y = a * carry.y + tmp[k].y; carry.z = a * carry.z + tmp[k].z; carry.w = a * carry.w + tmp[k].w; }
    }
}
__device__ __forceinline__ void phase_ssd_combine(const Ctx& F, unsigned char* ws) {
    float4* SST4 = (float4*)(ws + WS_SST); const float* SCD = (const float*)(ws + WS_SCD);
    for (int gt = F.bid * 512 + F.tid; gt < 64 * 2048; gt += F.G * 512) {
        const int sidx = gt >> 11, e4 = gt & 2047;
        float4* base = SST4 + (size_t)sidx * NCH * 2048 + e4;
        if (sidx & 1) ssd_combine_one<1>(base, SCD + sidx * NCH); else ssd_combine_one<0>(base, SCD + sidx * NCH);
    }
}

constexpr int RWF_CHUNK = 10496;
constexpr int RW_NCHUNK = NPOS / 16;
template <int CTRL> __device__ __forceinline__ float dpp_id1(float v) { return __int_as_float(__builtin_amdgcn_update_dpp(0x3f800000, __float_as_int(v), CTRL, 0xF, 0xF, false)); }
__device__ __forceinline__ float sel4(int g, float a, float b, float c, float d) { return g == 0 ? a : (g == 1 ? b : (g == 2 ? c : d)); }

template <int D> __device__ __forceinline__ void rwkv_pre_dir(const bf16_t* wupt, const bf16x8 (&bw)[2], const bf16x8 (&ba)[2], const f32x4 (&kk)[4], const f32x4 (&rr)[4], const f32x4 (&kx)[4],
        const float* w0p, const float* a0p, const float* kap, const float* rkp, float& bon, LAS unsigned char* wl, unsigned char* dst, int l16, int g) {
    LAS float* LT = (LAS float*)wl; LAS float* AT = LT + 256; LAS bf16_t* BT = (LAS bf16_t*)(wl + 2048); LAS bf16_t* KT = BT + 1024;
    const int lane = g * 16 + l16;
    bf16x8* o = (bf16x8*)dst;
    const f32x4 z4 = {0.f, 0.f, 0.f, 0.f};
    bf16x8 af[2], bf[2], kf[2], rf[2];
#pragma unroll
    for (int p = 0; p < 2; ++p) {
        f32x4 al[2], be[2], ka[2], rh[2];
#pragma unroll
        for (int mm = 0; mm < 2; ++mm) { const int m = 2 * p + mm; asm volatile("" ::: "memory");
            const bf16_t* wpw = wupt + ((size_t)D * 512 + 16 * m + l16) * 64 + 8 * g; const bf16_t* wpa = wupt + ((size_t)(2 + D) * 512 + 16 * m + l16) * 64 + 8 * g;
            f32x4 aw = __builtin_amdgcn_mfma_f32_16x16x32_bf16(*(const bf16x8*)wpw, bw[0], z4, 0, 0, 0); aw = __builtin_amdgcn_mfma_f32_16x16x32_bf16(*(const bf16x8*)(wpw + 32), bw[1], aw, 0, 0, 0);
            f32x4 aa = __builtin_amdgcn_mfma_f32_16x16x32_bf16(*(const bf16x8*)wpa, ba[0], z4, 0, 0, 0); aa = __builtin_amdgcn_mfma_f32_16x16x32_bf16(*(const bf16x8*)(wpa + 32), ba[1], aa, 0, 0, 0);
            const float4 w0 = *(const float4*)(w0p + 16 * m + 4 * g), a0 = *(const float4*)(a0p + 16 * m + 4 * g), kav = *(const float4*)(kap + 16 * m + 4 * g), rkv = *(const float4*)(rkp + 16 * m + 4 * g);
            const float w0a[4] = {w0.x, w0.y, w0.z, w0.w}, a0a[4] = {a0.x, a0.y, a0.z, a0.w}, kaa[4] = {kav.x, kav.y, kav.z, kav.w}, rka[4] = {rkv.x, rkv.y, rkv.z, rkv.w};
            f32x4 gcv;
#pragma unroll
            for (int r = 0; r < 4; ++r) {
                const float w = __expf(-0.6065306597126334f * sigmoidf_(w0a[r] + aw[r])), a = sigmoidf_(a0a[r] + aa[r]);
                const float kd = kx[m][r] * (1.f + (a - 1.f) * kaa[r]), bb = kk[m][r] * a;
                bon += rr[m][r] * kd * rka[r];
                float G = w;
                if (D == 0) { G *= dpp_id1<0x111>(G); G *= dpp_id1<0x112>(G); G *= dpp_id1<0x114>(G); G *= dpp_id1<0x118>(G); }
                else        { G *= dpp_id1<0x101>(G); G *= dpp_id1<0x102>(G); G *= dpp_id1<0x104>(G); G *= dpp_id1<0x108>(G); }
                const float Gex = (D == 0) ? dpp_id1<0x111>(G) : dpp_id1<0x101>(G);
                const float iG = rcpf_(G);
                al[mm][r] = Gex * kk[m][r]; be[mm][r] = bb * iG; ka[mm][r] = kd * iG; rh[mm][r] = G * rr[m][r]; gcv[r] = G;
                const int k = 16 * m + 4 * g + r; BT[k * 16 + l16] = f2bf(be[mm][r]); KT[k * 16 + l16] = f2bf(ka[mm][r]);
            }
            if (l16 == ((D == 0) ? 15 : 0)) *(float4*)((float*)(dst + 10240) + 16 * m + 4 * g) = make_float4(gcv[0], gcv[1], gcv[2], gcv[3]);
        }
        af[p] = pack8(al[0], al[1]); bf[p] = pack8(be[0], be[1]); kf[p] = pack8(ka[0], ka[1]); rf[p] = pack8(rh[0], rh[1]);
        o[64 * p + lane] = af[p]; o[128 + 64 * p + lane] = rf[p];
        __builtin_amdgcn_sched_barrier(0);
    }
    f32x4 Lm = __builtin_amdgcn_mfma_f32_16x16x32_bf16(af[0], bf[0], z4, 0, 0, 0); Lm = __builtin_amdgcn_mfma_f32_16x16x32_bf16(af[1], bf[1], Lm, 0, 0, 0);
    f32x4 Am = __builtin_amdgcn_mfma_f32_16x16x32_bf16(af[0], kf[0], z4, 0, 0, 0); Am = __builtin_amdgcn_mfma_f32_16x16x32_bf16(af[1], kf[1], Am, 0, 0, 0);
    f32x4 Bb = __builtin_amdgcn_mfma_f32_16x16x32_bf16(bf[0], rf[0], z4, 0, 0, 0); Bb = __builtin_amdgcn_mfma_f32_16x16x32_bf16(bf[1], rf[1], Bb, 0, 0, 0);
    f32x4 Bk = __builtin_amdgcn_mfma_f32_16x16x32_bf16(kf[0], rf[0], z4, 0, 0, 0); Bk = __builtin_amdgcn_mfma_f32_16x16x32_bf16(kf[1], rf[1], Bk, 0, 0, 0);
#pragma unroll
    for (int r = 0; r < 4; ++r) { const int row = 4 * g + r;
        const bool strict = (D == 0) ? (l16 < row) : (l16 > row);
        const bool incl = (D == 0) ? (row <= l16) : (row >= l16);
        Lm[r] = strict ? Lm[r] : 0.f; Am[r] = strict ? Am[r] : 0.f; Bb[r] = incl ? Bb[r] : 0.f; Bk[r] = incl ? Bk[r] : 0.f; }
    *(LAS f32x4*)(LT + l16 * 16 + 4 * g) = Lm; *(LAS f32x4*)(AT + l16 * 16 + 4 * g) = Am;
    o[320 + lane] = pack8(Bb, Bk);
    asm volatile("" ::: "memory");
#pragma unroll
    for (int m = 0; m < 4; ++m) { union { bf16x8 v; u32x2 h[2]; } f;
        f.h[0] = *(LAS u32x2*)(BT + (16 * m + l16) * 16 + 4 * g); f.h[1] = *(LAS u32x2*)(KT + (16 * m + l16) * 16 + 4 * g);
        o[384 + 64 * m + lane] = f.v; }
    __builtin_amdgcn_sched_barrier(0);
    float x[16];
    if (D == 0) {
#pragma unroll
        for (int c = 15; c >= 0; --c) { float s = (c == l16) ? 1.f : 0.f; asm volatile("" ::: "memory");
#pragma unroll
            for (int i = c + 1; i < 16; ++i) s -= x[i] * LT[c * 16 + i];
            x[c] = s; }
    } else {
#pragma unroll
        for (int c = 0; c < 16; ++c) { float s = (c == l16) ? 1.f : 0.f; asm volatile("" ::: "memory");
#pragma unroll
            for (int i = 0; i < c; ++i) s -= x[i] * LT[c * 16 + i];
            x[c] = s; }
    }
    f32x4 tm0, tm1;
#pragma unroll
    for (int r = 0; r < 4; ++r) tm0[r] = -sel4(g, x[r], x[4 + r], x[8 + r], x[12 + r]);
#pragma unroll
    for (int r = 0; r < 4; ++r) { float yv[4];
#pragma unroll
        for (int q = 0; q < 4; ++q) { const int c = 4 * q + r; float s = 0.f; asm volatile("" ::: "memory");
#pragma unroll
            for (int i = 0; i < 16; ++i) if ((D == 0) ? (i > c) : (i < c)) s += x[i] * AT[c * 16 + i];
            yv[q] = s; }
        tm1[r] = -sel4(g, yv[0], yv[1], yv[2], yv[3]); }
    o[256 + lane] = pack8(tm0, tm1);
    asm volatile("" ::: "memory");
}
__device__ __forceinline__ void rwkv_pre_task(const Ctx& F, const LayerW& W, unsigned char* ws, const bf16_t* WUPT, int task, int dsel) {
    const bf16_t* P = (const bf16_t*)(ws + WS_P); float* BON = (float*)(ws + WS_BON); unsigned char* RWF = ws + WS_RWF;
    const int cidx = task % RW_NCHUNK, bh = task / RW_NCHUNK, h = bh & 7, b = bh >> 3;
    int ln_ = F.lane; asm volatile("" : "+v"(ln_));
    const int l16 = ln_ & 15, g = ln_ >> 4;
    const int pos = cidx * 16 + l16;
    const int tok = pos < CTXL ? NLAT + b * CTXL + pos : b * SEQL + (pos - CTXL);
    const bf16_t* Pr = P + (size_t)tok * PTP;
    LAS unsigned char* wl = F.lds + F.wave * 8192;
    bf16x8 bw[2], ba[2];
#pragma unroll
    for (int p = 0; p < 2; ++p) { const u32x4 q = *(const u32x4*)(Pr + B_WD + 32 * p + 8 * g); union { bf16x8 v; unsigned u[4]; } tq;
#pragma unroll
        for (int e = 0; e < 4; ++e) tq.u[e] = pk_bf16(tanhf_(bflo(q[e])), tanhf_(bfhi(q[e])));
        bw[p] = tq.v; ba[p] = *(const bf16x8*)(Pr + B_AD + 32 * p + 8 * g); }
    f32x4 kk[4], rr[4], kx[4];
    float ssq = 0.f;
#pragma unroll
    for (int m = 0; m < 4; ++m) { const int co = h * 64 + 16 * m + 4 * g;
        const u32x2 rq = *(const u32x2*)(Pr + B_R + co), kq = *(const u32x2*)(Pr + B_K + co); const float4 kkw = *(const float4*)(W.rw_kk + co);
        rr[m] = (f32x4){bflo(rq.x), bfhi(rq.x), bflo(rq.y), bfhi(rq.y)}; kx[m] = (f32x4){bflo(kq.x), bfhi(kq.x), bflo(kq.y), bfhi(kq.y)};
        kk[m] = (f32x4){kx[m][0] * kkw.x, kx[m][1] * kkw.y, kx[m][2] * kkw.z, kx[m][3] * kkw.w};
        ssq += kk[m][0] * kk[m][0] + kk[m][1] * kk[m][1] + kk[m][2] * kk[m][2] + kk[m][3] * kk[m][3]; }
    ssq += xor16_f(ssq); ssq = sum_x32(ssq);
    { const float rn = rsqrtf(ssq + 1e-12f);
#pragma unroll
      for (int m = 0; m < 4; ++m) kk[m] = kk[m] * rn; }
    float bon = 0.f;
    const int co = h * 64;
    const int c0 = cidx, c1 = cidx < 16 ? 15 - cidx : 287 - cidx;
    if (dsel == 0) rwkv_pre_dir<0>(WUPT + (size_t)co * 64, bw, ba, kk, rr, kx, W.rw_w0 + co, W.rw_a0 + co, W.rw_ka + co, W.rw_rk + co, bon, wl, RWF + ((size_t)(bh * 2 + 0) * RW_NCHUNK + c0) * RWF_CHUNK, l16, g);
    else           rwkv_pre_dir<1>(WUPT + (size_t)co * 64, bw, ba, kk, rr, kx, W.rw_w0 + 512 + co, W.rw_a0 + 512 + co, W.rw_ka + co, W.rw_rk + co, bon, wl, RWF + ((size_t)(bh * 2 + 1) * RW_NCHUNK + c1) * RWF_CHUNK, l16, g);
    bon += xor16_f(bon); bon = sum_x32(bon);
    if (g == 0) BON[((size_t)dsel * NTOK + tok) * 8 + h] = bon;
}
struct RwFrag { bf16x8 a0, a1, r0, r1, tm, bb, bk0, bk1, bk2, bk3; f32x4 g0, g1, g2, g3; u32x2 v; };
__device__ __forceinline__ void rwkv_scan(const Ctx& F, unsigned char* ws, int sidx) {
    if (F.wave >= 4) return;
    const bf16_t* P = (const bf16_t*)(ws + WS_P); bf16_t* RWY = (bf16_t*)(ws + WS_RWY);
    const int d = sidx & 1, h = (sidx >> 1) & 7, b = sidx >> 4, n = F.wave, l16 = F.lane & 15, g = F.lane >> 4;
    const unsigned char* base = ws + WS_RWF + (size_t)sidx * RW_NCHUNK * RWF_CHUNK;
    const int vcol = B_V + h * 64 + 16 * n + l16;
#define RW_CIDX(c) (d ? ((c) < 16 ? 15 - (c) : 287 - (c)) : (c))
#define RW_TOK(cidx, i) (((cidx) * 16 + (i)) < CTXL ? NLAT + b * CTXL + (cidx) * 16 + (i) : b * SEQL + ((cidx) * 16 + (i) - CTXL))
#define RW_LOADF(fr, c) do { const bf16x8* q_ = (const bf16x8*)(base + (size_t)(c) * RWF_CHUNK) + F.lane; \
        fr.a0 = q_[0]; fr.a1 = q_[64]; fr.r0 = q_[128]; fr.r1 = q_[192]; fr.tm = q_[256]; fr.bb = q_[320]; fr.bk0 = q_[384]; fr.bk1 = q_[448]; fr.bk2 = q_[512]; fr.bk3 = q_[576]; \
        const f32x4* gp_ = (const f32x4*)(base + (size_t)(c) * RWF_CHUNK + 10240) + g; fr.g0 = gp_[0]; fr.g1 = gp_[4]; fr.g2 = gp_[8]; fr.g3 = gp_[12]; \
        const int ci_ = RW_CIDX(c); unsigned short v_[4]; _Pragma("unroll") for (int j_ = 0; j_ < 4; ++j_) v_[j_] = P[(size_t)RW_TOK(ci_, 4 * g + j_) * PTP + vcol]; \
        fr.v.x = (unsigned)v_[0] | ((unsigned)v_[1] << 16); fr.v.y = (unsigned)v_[2] | ((unsigned)v_[3] << 16); } while (0)
    f32x4 st0 = {0.f, 0.f, 0.f, 0.f}, st1 = st0, st2 = st0, st3 = st0;
    const f32x4 z4 = {0.f, 0.f, 0.f, 0.f};
#define RW_STEP(fr, c) do { \
        const bf16x8 s0_ = pack8(st0, st1), s1_ = pack8(st2, st3); \
        f32x4 x1_ = __builtin_amdgcn_mfma_f32_16x16x32_bf16(fr.a0, s0_, z4, 0, 0, 0); x1_ = __builtin_amdgcn_mfma_f32_16x16x32_bf16(fr.a1, s1_, x1_, 0, 0, 0); \
        f32x4 x2_ = __builtin_amdgcn_mfma_f32_16x16x32_bf16(fr.r0, s0_, z4, 0, 0, 0); x2_ = __builtin_amdgcn_mfma_f32_16x16x32_bf16(fr.r1, s1_, x2_, 0, 0, 0); \
        union { bf16x8 v; unsigned u[4]; } bx_; bx_.u[0] = pk_bf16(x1_[0], x1_[1]); bx_.u[1] = pk_bf16(x1_[2], x1_[3]); bx_.u[2] = fr.v.x; bx_.u[3] = fr.v.y; \
        const f32x4 e_ = __builtin_amdgcn_mfma_f32_16x16x32_bf16(fr.tm, bx_.v, z4, 0, 0, 0); \
        union { bf16x8 v; unsigned u[4]; } be_; be_.u[0] = pk_bf16(e_[0], e_[1]); be_.u[1] = pk_bf16(e_[2], e_[3]); be_.u[2] = fr.v.x; be_.u[3] = fr.v.y; \
        const f32x4 o_ = __builtin_amdgcn_mfma_f32_16x16x32_bf16(fr.bb, be_.v, x2_, 0, 0, 0); \
        st0 = __builtin_amdgcn_mfma_f32_16x16x32_bf16(fr.bk0, be_.v, st0, 0, 0, 0) * fr.g0; st1 = __builtin_amdgcn_mfma_f32_16x16x32_bf16(fr.bk1, be_.v, st1, 0, 0, 0) * fr.g1; \
        st2 = __builtin_amdgcn_mfma_f32_16x16x32_bf16(fr.bk2, be_.v, st2, 0, 0, 0) * fr.g2; st3 = __builtin_amdgcn_mfma_f32_16x16x32_bf16(fr.bk3, be_.v, st3, 0, 0, 0) * fr.g3; \
        const int ci_ = RW_CIDX(c); \
        _Pragma("unroll") for (int j_ = 0; j_ < 4; ++j_) RWY[((size_t)d * NTOK + RW_TOK(ci_, 4 * g + j_)) * 512 + h * 64 + 16 * n + l16] = f2bf(o_[j_]); } while (0)
    RwFrag fa, fb, fc;
#define RW_CL(c) ((c) < RW_NCHUNK ? (c) : RW_NCHUNK - 1)
    RW_LOADF(fa, 0); RW_LOADF(fb, 1);
    int c = 0;
    for (; c + 3 <= RW_NCHUNK; c += 3) {
        RW_LOADF(fc, RW_CL(c + 2)); RW_STEP(fa, c);
        RW_LOADF(fa, RW_CL(c + 3)); RW_STEP(fb, c + 1);
        RW_LOADF(fb, RW_CL(c + 4)); RW_STEP(fc, c + 2);
    }
    if (c < RW_NCHUNK) { RW_STEP(fa, c); if (c + 1 < RW_NCHUNK) RW_STEP(fb, c + 1); }
#undef RW_CL
#undef RW_CIDX
#undef RW_TOK
#undef RW_LOADF
#undef RW_STEP
}

__device__ __forceinline__ void na_tile(const Ctx& F, unsigned char* ws, const LAS float* sBias, int tile) {
    const bf16_t* QN = (const bf16_t*)(ws + WS_QN); const bf16_t* KN = (const bf16_t*)(ws + WS_KN);
    const bf16_t* VTL = (const bf16_t*)(ws + WS_VTL); const bf16_t* VTC = (const bf16_t*)(ws + WS_VTC); bf16_t* MIX = (bf16_t*)(ws + WS_MIX);
    const int h = F.wave, l16 = F.lane & 15, g = F.lane >> 4;
    const bool lat = tile < 1024;
    int b, r = 0, j = 0, gq;
    if (lat) { b = tile >> 8; r = (tile >> 2) & 63; j = tile & 3; gq = b * SEQL + r * 64 + j * 16 + l16; }
    else { const int tc = tile - 1024; b = tc >> 4; gq = NLAT + b * CTXL + (tc & 15) * 16 + l16; }
    const int row0 = min(max(r - 4, 0), 56), col0 = min(max(16 * j - 8, 0), 32);
    bf16x8 qf0, qf1;
    { const bf16_t* qp = QN + (size_t)gq * 512 + h * 64 + g * 8; qf0 = *(const bf16x8*)qp; qf1 = *(const bf16x8*)(qp + 32); }
    const f32x4 zero4 = {0.f, 0.f, 0.f, 0.f};
    const int cq = 16 * j + l16, win0 = min(max(cq - 8, 0), 48);
    const bf16_t* knb = KN + (size_t)(b * SEQL + row0 * 64 + col0 + l16) * 512 + h * 64 + g * 8;
    const bf16_t* kcx = KN + (size_t)(NLAT + b * CTXL + l16) * 512 + h * 64 + g * 8;
    const bf16_t* vnb = VTL + ((size_t)((b * 8 + h) * 64 + l16) * 64 + row0) * 96 + (col0 / 4 + g) * 8;
    const bf16_t* vcx = VTC + (size_t)((b * 8 + h) * 64 + l16) * 8 * 32 + g * 8;
    float mrun = -1e30f, lrun = 0.f;
    f32x4 o[4] = {zero4, zero4, zero4, zero4};
#pragma unroll
    for (int hf = 0; hf < 2; ++hf) {
        if (hf == 0 && !lat) continue;
        bf16x8 fr[32];
#pragma unroll
        for (int T = 0; T < 16; ++T) { const bf16_t* kp = hf == 0 ? knb + (size_t)((T >> 1) * 64 + (T & 1) * 16) * 512 : kcx + (size_t)T * 16 * 512;
            fr[2 * T] = *(const bf16x8*)kp; fr[2 * T + 1] = *(const bf16x8*)(kp + 32); }
        asm volatile("" ::: "memory");
        f32x4 acc[16];
#pragma unroll
        for (int T = 0; T < 16; ++T) { f32x4 a = __builtin_amdgcn_mfma_f32_16x16x32_bf16(fr[2 * T], qf0, zero4, 0, 0, 0); a = __builtin_amdgcn_mfma_f32_16x16x32_bf16(fr[2 * T + 1], qf1, a, 0, 0, 0);
            if (hf == 0) { const int ir = T >> 1, hh = T & 1, kr = row0 + ir; const LAS float* bias = sBias + (kr - r + 7) * 31;
#pragma unroll
                for (int e = 0; e < 4; ++e) { const int kc = col0 + 16 * hh + 4 * g + e; const bool ok = (kc >= win0) && (kc < win0 + 16);
                    const int dc = min(max(kc - cq + 15, 0), 30); a[e] = ok ? a[e] + bias[dc] : -1e30f; } }
            acc[T] = a; }
#pragma unroll
        for (int m = 0; m < 8; ++m)
#pragma unroll
            for (int dt = 0; dt < 4; ++dt) fr[4 * m + dt] = *(const bf16x8*)(hf == 0 ? vnb + (size_t)(dt * 16 * 64 + m) * 96 : vcx + (size_t)dt * 16 * 8 * 32 + m * 32);
        asm volatile("" ::: "memory");
        float mx = mrun;
#pragma unroll
        for (int T = 0; T < 16; ++T) mx = fmaxf(fmaxf(fmaxf(acc[T][0], acc[T][1]), fmaxf(acc[T][2], acc[T][3])), mx);
        mx = fmaxf(mx, xor16_f(mx)); mx = max_x32(mx);
        const float alpha = __expf(mrun - mx);
        float lsum = 0.f;
#pragma unroll
        for (int T = 0; T < 16; ++T) {
#pragma unroll
            for (int q = 0; q < 4; ++q) { const float pv = __expf(acc[T][q] - mx); acc[T][q] = pv; lsum += pv; } }
        lsum += xor16_f(lsum); lsum = sum_x32(lsum);
        lrun = lrun * alpha + lsum; mrun = mx;
#pragma unroll
        for (int dt = 0; dt < 4; ++dt) o[dt] = o[dt] * alpha;
#pragma unroll
        for (int m = 0; m < 8; ++m) { const bf16x8 pf = pack8(acc[2 * m], acc[2 * m + 1]);
#pragma unroll
            for (int dt = 0; dt < 4; ++dt) o[dt] = __builtin_amdgcn_mfma_f32_16x16x32_bf16(fr[4 * m + dt], pf, o[dt], 0, 0, 0); }
    }
    const float inv = 1.0f / lrun;
#pragma unroll
    for (int dt = 0; dt < 4; ++dt) { u32x2 w; w.x = pk_bf16(o[dt][0] * inv, o[dt][1] * inv); w.y = pk_bf16(o[dt][2] * inv, o[dt][3] * inv);
        *(u32x2*)(MIX + (size_t)gq * 2048 + 1024 + h * 64 + dt * 16 + 4 * g) = w; }
}
__device__ __forceinline__ void na_phase(const Ctx& F, const LayerW& W, unsigned char* ws, int blk, int nblk, int ntile) {
    LAS float* sBias = (LAS float*)(F.lds + F.wave * 2048);
    __syncthreads();
    for (int idx = F.lane; idx < 465; idx += 64) sBias[idx] = W.rpb[F.wave * 465 + idx];
    asm volatile("" ::: "memory");
    for (int tile = blk; tile < ntile; tile += nblk) na_tile(F, ws, sBias, tile);
}

__device__ __forceinline__ void phase_finish(const Ctx& F, const LayerW& W, unsigned char* ws, const bf16_t* GUPT, int ntok) {
    const bf16_t* P = (const bf16_t*)(ws + WS_P); bf16_t* MIX = (bf16_t*)(ws + WS_MIX);
    const bf16_t* RWY = (const bf16_t*)(ws + WS_RWY); const float* BON = (const float*)(ws + WS_BON); const float* YS = (const float*)(ws + WS_YS);
    const f32x4 z4 = {0.f, 0.f, 0.f, 0.f};
    for (int task = F.bid * 8 + F.wave; task < (ntok / 16) * 8; task += F.G * 8) {
        int ln = F.lane; asm volatile("" : "+v"(ln));
        const int l16 = ln & 15, g = ln >> 4, h = task & 7, tok = (task >> 3) * 16 + l16;
        const bf16_t* Pr = P + (size_t)tok * PTP;
        bf16x8 sg[4];
#pragma unroll
        for (int ks = 0; ks < 4; ++ks) { const u32x4 q = *(const u32x4*)(Pr + B_GD + 32 * ks + 8 * g); union { bf16x8 v; unsigned u[4]; } s;
#pragma unroll
            for (int e = 0; e < 4; ++e) s.u[e] = pk_bf16(sigmoidf_(bflo(q[e])), sigmoidf_(bfhi(q[e])));
            sg[ks] = s.v; }
        f32x4 y[4]; float s1 = 0.f;
#pragma unroll
        for (int m = 0; m < 4; ++m) { const int co = h * 64 + 16 * m + 4 * g;
            const u32x2 a = *(const u32x2*)(RWY + (size_t)tok * 512 + co), bq = *(const u32x2*)(RWY + ((size_t)NTOK + tok) * 512 + co);
            y[m] = (f32x4){bflo(a.x) + bflo(bq.x), bfhi(a.x) + bfhi(bq.x), bflo(a.y) + bflo(bq.y), bfhi(a.y) + bfhi(bq.y)};
            s1 += (y[m][0] + y[m][1]) + (y[m][2] + y[m][3]); }
        s1 += xor16_f(s1); s1 = sum_x32(s1);
        const float mu = s1 * (1.f / 64.f); float s2 = 0.f;
#pragma unroll
        for (int m = 0; m < 4; ++m) { y[m] = y[m] - mu; s2 += (y[m][0] * y[m][0] + y[m][1] * y[m][1]) + (y[m][2] * y[m][2] + y[m][3] * y[m][3]); }
        s2 += xor16_f(s2); s2 = sum_x32(s2);
        const float rs = rsqrtf(s2 * (1.f / 64.f) + 64e-5f);
        const float bon = BON[(size_t)tok * 8 + h] + BON[((size_t)NTOK + tok) * 8 + h];
#pragma unroll
        for (int m = 0; m < 4; ++m) { const int co = h * 64 + 16 * m + 4 * g;
            f32x4 ga = z4;
#pragma unroll
            for (int ks = 0; ks < 4; ++ks) ga = __builtin_amdgcn_mfma_f32_16x16x32_bf16(*(const bf16x8*)(GUPT + (size_t)(h * 64 + 16 * m + l16) * 128 + 32 * ks + 8 * g), sg[ks], ga, 0, 0, 0);
            const float4 lw = *(const float4*)(W.rw_lnw + co), lb = *(const float4*)(W.rw_lnb + co); const u32x2 vq = *(const u32x2*)(Pr + B_V + co);
            const float o0 = (y[m][0] * rs * lw.x + lb.x + bon * bflo(vq.x)) * ga[0], o1 = (y[m][1] * rs * lw.y + lb.y + bon * bfhi(vq.x)) * ga[1];
            const float o2 = (y[m][2] * rs * lw.z + lb.z + bon * bflo(vq.y)) * ga[2], o3 = (y[m][3] * rs * lw.w + lb.w + bon * bfhi(vq.y)) * ga[3];
            u32x2 o; o.x = pk_bf16(o0, o1); o.y = pk_bf16(o2, o3);
            *(u32x2*)(MIX + (size_t)tok * 2048 + 512 + co) = o; }
    }
    for (int tok = F.bid * 8 + F.wave; tok < ntok; tok += F.G * 8) {
        const int c0 = F.lane * 8;
        float ys[8], z[8], gw[8];
        load8f(YS + (size_t)tok * 512 + c0, ys); unpack8(*(const u32x4*)(P + (size_t)tok * PTP + D_Z + c0), z); load8f(W.s_norm + c0, gw);
        float ss = 0.f;
#pragma unroll
        for (int e = 0; e < 8; ++e) { ys[e] *= siluf_(z[e]); ss += ys[e] * ys[e]; }
        ss = wave_sum(ss);
        const float rs = rsqrtf(ss * (1.f / 512.f) + 1e-6f);
#pragma unroll
        for (int e = 0; e < 8; ++e) ys[e] = ys[e] * rs * gw[e];
        *(u32x4*)(MIX + (size_t)tok * 2048 + 1536 + c0) = pack8f(ys);
    }
}

constexpr int RADIX_LOW_BIT = 10;
constexpr int RADIX_STEPS = 14;
__device__ __forceinline__ unsigned ordkey(float x) { const unsigned u = __float_as_uint(x); return (u & 0x80000000u) ? ~u : (u | 0x80000000u); }
template <int CTRL> __device__ __forceinline__ int dpp_i0(int v) { return __builtin_amdgcn_update_dpp(0, v, CTRL, 0xF, 0xF, true); }
__device__ __forceinline__ int rowscan_incl(int x) { x += dpp_i0<0x111>(x); x += dpp_i0<0x112>(x); x += dpp_i0<0x114>(x); x += dpp_i0<0x118>(x); return x; }
__device__ __forceinline__ void phase_scores(const Ctx& F, unsigned char* ws, int layer, int ntok) {
    const bf16_t* Q = (const bf16_t*)(ws + WS_P); const bf16_t* KEYS = (const bf16_t*)(ws + WS_KEYS) + (size_t)layer * 8 * 2 * 128 * 128;
    int* IDS = (int*)(ws + WS_IDS); float* GATES = (float*)(ws + WS_GATES);
    LAS bf16_t* sK = (LAS bf16_t*)F.lds;
    LAS float* sVv = (LAS float*)(F.lds + 2 * 128 * 136 * 2 + F.wave * 5120);
    LAS int* sVi = (LAS int*)(sVv + 512);
    const int ntg = ntok / 128, ntask = 8 * ntg;
    const int l16 = F.lane & 15, g = F.lane >> 4;
    const f32x4 z4 = {0.f, 0.f, 0.f, 0.f};
    int cur_h = -1;
    for (int task = F.bid; task < ntask; task += F.G) {
        const int h = task / ntg, tg = task % ntg;
        if (h != cur_h) { __syncthreads();
#pragma unroll
            for (int q = 0; q < 8; ++q) { const int v = F.tid + 512 * q, row = v >> 4, part = v & 15;
                *(LAS u32x4*)(sK + row * 136 + part * 8) = *(const u32x4*)(KEYS + ((size_t)h * 256 + row) * 128 + part * 8); }
            cur_h = h; __syncthreads(); }
        const int t0 = tg * 128 + F.wave * 16;
#pragma unroll 1
        for (int p = 0; p < 2; ++p) {
            bf16x8 qf[4];
#pragma unroll
            for (int ks = 0; ks < 4; ++ks) qf[ks] = *(const bf16x8*)(Q + (size_t)(t0 + l16) * 2048 + h * 256 + p * 128 + 32 * ks + 8 * g);
            f32x4 acc[8];
#pragma unroll
            for (int kt = 0; kt < 8; ++kt) { f32x4 a = z4;
#pragma unroll
                for (int ks = 0; ks < 4; ++ks) a = __builtin_amdgcn_mfma_f32_16x16x32_bf16(qf[ks], *(const LAS bf16x8*)(sK + (p * 128 + 16 * kt + l16) * 136 + 32 * ks + 8 * g), a, 0, 0, 0);
                acc[kt] = a; }
            float lo0, lo1, lo2, lo3, hi0, hi1, hi2, hi3;
            { float m0 = acc[0][0], m1 = acc[0][1], m2 = acc[0][2], m3 = acc[0][3];
#pragma unroll
              for (int kt = 1; kt < 8; ++kt) { m0 = fmaxf(m0, acc[kt][0]); m1 = fmaxf(m1, acc[kt][1]); m2 = fmaxf(m2, acc[kt][2]); m3 = fmaxf(m3, acc[kt][3]); }
              hi0 = max16(m0); hi1 = max16(m1); hi2 = max16(m2); hi3 = max16(m3);
              lo0 = -max16(-m0); lo1 = -max16(-m1); lo2 = -max16(-m2); lo3 = -max16(-m3); }
#pragma unroll 1
            for (int it = 0; it < RADIX_STEPS; ++it) {
                const float c0 = 0.5f * (lo0 + hi0), c1 = 0.5f * (lo1 + hi1), c2 = 0.5f * (lo2 + hi2), c3 = 0.5f * (lo3 + hi3); int n0 = 0, n1 = 0, n2 = 0, n3 = 0;
#pragma unroll
                for (int kt = 0; kt < 8; ++kt) { n0 += acc[kt][0] >= c0; n1 += acc[kt][1] >= c1; n2 += acc[kt][2] >= c2; n3 += acc[kt][3] >= c3; }
                const bool k0 = sum16((float)n0) >= 16.f, k1 = sum16((float)n1) >= 16.f, k2 = sum16((float)n2) >= 16.f, k3 = sum16((float)n3) >= 16.f;
                lo0 = k0 ? c0 : lo0; hi0 = k0 ? hi0 : c0; lo1 = k1 ? c1 : lo1; hi1 = k1 ? hi1 : c1; lo2 = k2 ? c2 : lo2; hi2 = k2 ? hi2 : c2; lo3 = k3 ? c3 : lo3; hi3 = k3 ? hi3 : c3; }
#pragma unroll
            for (int r = 0; r < 4; ++r) { const float T = r == 0 ? lo0 : (r == 1 ? lo1 : (r == 2 ? lo2 : lo3));
                int cl = 0;
#pragma unroll
                for (int kt = 0; kt < 8; ++kt) cl += acc[kt][r] >= T;
                int rank = rowscan_incl(cl) - cl;
                LAS float* dv = sVv + ((4 * g + r) * 2 + p) * 16; LAS int* di = sVi + ((4 * g + r) * 2 + p) * 16;
#pragma unroll
                for (int kt = 0; kt < 8; ++kt) { const bool sel = acc[kt][r] >= T;
                    if (sel && rank < 16) { dv[rank] = acc[kt][r]; di[rank] = 16 * kt + l16; }
                    rank += sel ? 1 : 0; } }
        }
        asm volatile("" ::: "memory");
#pragma unroll 1
        for (int r = 0; r < 4; ++r) { const int tk = 4 * g + r;
            LAS float* sS = (LAS float*)(sVi + 512);
            LAS int* sI = (LAS int*)(sS + 128);
#pragma unroll
            for (int p = 0; p < 2; ++p) { const float v = sVv[(tk * 2 + p) * 16 + l16]; const int ix = sVi[(tk * 2 + p) * 16 + l16];
                const unsigned key = (ordkey(v) & ~15u) | (unsigned)(15 - l16); int rk = 0;
#pragma unroll
                for (int q = 0; q < 4; ++q) { const f32x4 o = *(const LAS f32x4*)(sVv + (tk * 2 + p) * 16 + 4 * q);
#pragma unroll
                    for (int e = 0; e < 4; ++e) rk += ((ordkey(o[e]) & ~15u) | (unsigned)(15 - (4 * q + e))) > key; }
                sS[(g * 2 + p) * 16 + rk] = v; sI[(g * 2 + p) * 16 + rk] = ix; }
            asm volatile("" ::: "memory");
            float cv[4]; int pi[4], pj[4];
#pragma unroll
            for (int q = 0; q < 4; ++q) { const int e = l16 + 16 * q; int i, j;
                if (e < 16) { i = 0; j = e; } else if (e < 24) { i = 1; j = e - 16; } else if (e < 29) { i = 2; j = e - 24; } else if (e < 33) { i = 3; j = e - 29; }
                else if (e < 36) { i = 4; j = e - 33; } else if (e < 42) { i = 5 + ((e - 36) >> 1); j = (e - 36) & 1; } else { i = 8 + (e - 42); j = 0; }
                const bool ok = e < 50; i = ok ? i : 15; j = ok ? j : 15;
                pi[q] = i; pj[q] = j; cv[q] = ok ? sS[(g * 2) * 16 + i] + sS[(g * 2 + 1) * 16 + j] : -3.0e38f; }
            float lo = sS[(g * 2) * 16 + 15] + sS[(g * 2 + 1) * 16], hi = sS[(g * 2) * 16] + sS[(g * 2 + 1) * 16];
            const float mx = hi;
#pragma unroll 1
            for (int it = 0; it < RADIX_STEPS; ++it) { const float cm = 0.5f * (lo + hi); int n = 0;
#pragma unroll
                for (int q = 0; q < 4; ++q) n += cv[q] >= cm;
                const bool kk = sum16((float)n) >= 16.f; lo = kk ? cm : lo; hi = kk ? hi : cm; }
            int cl = 0; float es = 0.f;
#pragma unroll
            for (int q = 0; q < 4; ++q) { const bool sel = cv[q] >= lo; cl += sel; es += sel ? __expf(cv[q] - mx) : 0.f; }
            int rank = rowscan_incl(cl) - cl;
            const float einv = 1.0f / sum16(es);
            const size_t ob = (size_t)(t0 + tk) * 128 + h * 16;
#pragma unroll
            for (int q = 0; q < 4; ++q) { const bool sel = cv[q] >= lo;
                if (sel && rank < 16) { IDS[ob + rank] = sI[(g * 2) * 16 + pi[q]] * 128 + sI[(g * 2 + 1) * 16 + pj[q]]; GATES[ob + rank] = __expf(cv[q] - mx) * einv; }
                rank += sel ? 1 : 0; }
            asm volatile("" ::: "memory");
        }
        asm volatile("" ::: "memory");
    }
}

struct XInfo { int xi, nx, rank, nloc; };
__device__ __forceinline__ void fp8x16_to_f32(const u32x4 q, float (&f)[16]) {
#pragma unroll
    for (int w = 0; w < 4; ++w) { const auto a = __builtin_amdgcn_cvt_pk_f32_fp8((int)q[w], false); const auto b = __builtin_amdgcn_cvt_pk_f32_fp8((int)q[w], true);
        f[4 * w] = a[0]; f[4 * w + 1] = a[1]; f[4 * w + 2] = b[0]; f[4 * w + 3] = b[1]; }
}
typedef long i64_t;
template <int IDMASK> __device__ __forceinline__ void phase_experts_u(const Ctx& F, unsigned char* ws, int layer, int ntok, const XInfo X, float* PART) {
    const bf16_t* H = (const bf16_t*)(ws + WS_XN); const unsigned char* PU8 = ws + WS_PU + (size_t)layer * 16384 * 2048;
    const int* IDS = (const int*)(ws + WS_IDS);
    const int e8 = F.lane >> 3, c = F.lane & 7, l16 = F.lane & 15, g = F.lane >> 4;
    const int tfirst = X.rank * 8 + F.wave, tstride = X.nloc * 8;
    const int nk = tfirst < ntok ? (ntok - tfirst + tstride - 1) / tstride : 0;
    const f32x4 z4 = {0.f, 0.f, 0.f, 0.f};
    LAS unsigned char* buf = F.lds + F.wave * 12288; LAS float* res = (LAS float*)(buf + 8192);
    const int woff = e8 * 128 + c * 16;
    const int srcoff = 16 * (c ^ e8);
    const int roff0 = l16 * 128 + (((2 * g) ^ (l16 & 7)) * 16), roff1 = l16 * 128 + (((2 * g + 1) ^ (l16 & 7)) * 16);
#define EU_TOK(k) (tfirst + min((k), nk - 1) * tstride)
#define EU_LOADI(I, k) do { const int* ip_ = IDS + (size_t)EU_TOK(k) * 128 + e8; _Pragma("unroll") for (int q_ = 0; q_ < 16; ++q_) I[q_] = ip_[8 * q_]; } while (0)
#define EU_LOADX(HX, k) do { const u32x4* hp_ = (const u32x4*)(H + (size_t)EU_TOK(k) * 2048 + s * 128 + 32 * g); HX[0] = hp_[0]; HX[1] = hp_[1]; HX[2] = hp_[2]; HX[3] = hp_[3]; } while (0)
#define EU_ISSUE(Q, I, hf) do { _Pragma("unroll") for (int i_ = 0; i_ < 8; ++i_) Q[i_] = *(const u32x4*)(PU8 + ((size_t)s * 16384 + I[(hf) * 8 + i_]) * 128 + srcoff); } while (0)
#define EU_CONSUME(Q, hf, slot) do { _Pragma("unroll") for (int i_ = 0; i_ < 8; ++i_) *(LAS u32x4*)(buf + i_ * 1024 + woff) = Q[i_]; \
        asm volatile("" ::: "memory"); \
        _Pragma("unroll") for (int q_ = 0; q_ < 4; ++q_) { const u32x4 p0_ = *(const LAS u32x4*)(buf + q_ * 2048 + roff0), p1_ = *(const LAS u32x4*)(buf + q_ * 2048 + roff1); f32x4 a_ = z4; \
            a_ = __builtin_amdgcn_mfma_f32_16x16x32_fp8_fp8(((i64_t)p0_[1] << 32) | (i64_t)p0_[0], hb[0], a_, 0, 0, 0); \
            a_ = __builtin_amdgcn_mfma_f32_16x16x32_fp8_fp8(((i64_t)p0_[3] << 32) | (i64_t)p0_[2], hb[1], a_, 0, 0, 0); \
            a_ = __builtin_amdgcn_mfma_f32_16x16x32_fp8_fp8(((i64_t)p1_[1] << 32) | (i64_t)p1_[0], hb[2], a_, 0, 0, 0); \
            a_ = __builtin_amdgcn_mfma_f32_16x16x32_fp8_fp8(((i64_t)p1_[3] << 32) | (i64_t)p1_[2], hb[3], a_, 0, 0, 0); \
            if (l16 == (hf) * 4 + q_) *(LAS f32x4*)(res + (slot) * 128 + 16 * ((hf) * 4 + q_) + 4 * g) = a_; } \
        asm volatile("" ::: "memory"); } while (0)
    for (int s = X.xi; s < 16; s += X.nx) {
        if (nk == 0) continue;
        int id[2][16]; u32x4 hx[2][4]; u32x4 qa[8], qb[8];
        EU_LOADI(id[0], 0); EU_LOADX(hx[0], 0); EU_ISSUE(qa, id[0], 0); EU_ISSUE(qb, id[0], 1);
        EU_LOADI(id[1], 1);
        for (int k0 = 0; k0 < nk; k0 += 8) {
#pragma unroll
            for (int j = 0; j < 8; ++j) { const int k = k0 + j;
                i64_t hb[4];
#pragma unroll
                for (int m = 0; m < 4; ++m) { const u32x4 v = hx[j & 1][m];
                    int lo = __builtin_amdgcn_cvt_pk_fp8_f32(bflo(v[0]), bfhi(v[0]), 0, false); lo = __builtin_amdgcn_cvt_pk_fp8_f32(bflo(v[1]), bfhi(v[1]), lo, true);
                    int hi = __builtin_amdgcn_cvt_pk_fp8_f32(bflo(v[2]), bfhi(v[2]), 0, false); hi = __builtin_amdgcn_cvt_pk_fp8_f32(bflo(v[3]), bfhi(v[3]), hi, true);
                    hb[m] = ((i64_t)(unsigned)hi << 32) | (i64_t)(unsigned)lo; }
                EU_LOADX(hx[(j + 1) & 1], k + 1);
                EU_LOADI(id[j & 1], k + 2);
                EU_CONSUME(qa, 0, j);
                EU_ISSUE(qa, id[(j + 1) & 1], 0);
                EU_CONSUME(qb, 1, j);
                EU_ISSUE(qb, id[(j + 1) & 1], 1);
            }
            { const int u = F.lane >> 3, jj = F.lane & 7, ku = k0 + u;
              if (ku < nk) { float* dst = PART + ((size_t)s * NTOK + tfirst + ku * tstride) * 128 + 16 * jj;
#pragma unroll
                  for (int w = 0; w < 4; ++w) *(f32x4*)(dst + 4 * w) = *(const LAS f32x4*)(res + u * 128 + 16 * jj + 4 * w); }
              asm volatile("" ::: "memory"); }
        }
    }
#undef EU_TOK
#undef EU_LOADI
#undef EU_LOADX
#undef EU_ISSUE
#undef EU_CONSUME
}
__device__ __forceinline__ void phase_experts_combine(const Ctx& F, unsigned char* ws, int ntok) {
    const float* PART = (const float*)(ws + WS_PART); float* GATES = (float*)(ws + WS_GATES);
    for (int idx = F.bid * 512 + F.tid; idx < ntok * 32; idx += F.G * 512) {
        float4 a = make_float4(0.f, 0.f, 0.f, 0.f);
#pragma unroll
        for (int s = 0; s < 16; ++s) { const float4 v = *(const float4*)(PART + (size_t)s * NTOK * 128 + (size_t)idx * 4); a.x += v.x; a.y += v.y; a.z += v.z; a.w += v.w; }
        float4 g = *(const float4*)(GATES + (size_t)idx * 4);
        g.x *= geluf_(a.x * (1.0f / PEER_U_SCALE)); g.y *= geluf_(a.y * (1.0f / PEER_U_SCALE)); g.z *= geluf_(a.z * (1.0f / PEER_U_SCALE)); g.w *= geluf_(a.w * (1.0f / PEER_U_SCALE));
        *(float4*)(GATES + (size_t)idx * 4) = g;
    }
}
__device__ __forceinline__ void phase_experts_v(const Ctx& F, unsigned char* ws, float* out, float* CTXS, int layer, int ntok, const XInfo X) {
    const unsigned char* PV8 = ws + WS_PV + (size_t)layer * 16384 * 2048;
    const int* IDS = (const int*)(ws + WS_IDS); const float* COEF = (const float*)(ws + WS_GATES); const float* MOD = (const float*)(ws + WS_MOD);
    const int e8 = F.lane >> 3, c = F.lane & 7;
    const int tfirst = X.rank * 8 + F.wave, tstride = X.nloc * 8;
    const int nk = tfirst < ntok ? (ntok - tfirst + tstride - 1) / tstride : 0;
    LAS float* res = (LAS float*)(F.lds + F.wave * 4096);
#define EV_TOK(k) (tfirst + min((k), nk - 1) * tstride)
#define EV_LOADI(I, k) do { const u32x4* ip_ = (const u32x4*)(IDS + (size_t)EV_TOK(k) * 128 + e8 * 16); I[0] = ip_[0]; I[1] = ip_[1]; I[2] = ip_[2]; I[3] = ip_[3]; } while (0)
#define EV_LOADC(C, k) do { const u32x4* cp_ = (const u32x4*)(COEF + (size_t)EV_TOK(k) * 128 + e8 * 16); C[0] = cp_[0]; C[1] = cp_[1]; C[2] = cp_[2]; C[3] = cp_[3]; } while (0)
#define EV_ROW(id) (*(const u32x4*)(PV8 + ((size_t)s * 16384 + (id)) * 128 + c * 16))
#define EV_ISSUE(Q, I, hf) do { _Pragma("unroll") for (int i_ = 0; i_ < 8; ++i_) Q[i_] = EV_ROW(I[(hf) * 2 + (i_ >> 2)][i_ & 3]); } while (0)
#define EV_HALF(Q, C, hf) do { _Pragma("unroll") for (int i_ = 0; i_ < 8; ++i_) { const float cf_ = __uint_as_float(C[(hf) * 2 + (i_ >> 2)][i_ & 3]); const f32x2_t c2_ = {cf_, cf_}; \
            _Pragma("unroll") for (int w_ = 0; w_ < 4; ++w_) { const f32x2_t lo_ = __builtin_amdgcn_cvt_pk_f32_fp8((int)Q[i_][w_], false), hi_ = __builtin_amdgcn_cvt_pk_f32_fp8((int)Q[i_][w_], true); \
                ac2[2 * w_] = lo_ * c2_ + ac2[2 * w_]; ac2[2 * w_ + 1] = hi_ * c2_ + ac2[2 * w_ + 1]; } } } while (0)
    for (int s = X.xi; s < 16; s += X.nx) {
        if (nk == 0) continue;
        u32x4 id[2][4], cf[2][4]; u32x4 qa[8], qb[8];
        EV_LOADI(id[0], 0); EV_LOADC(cf[0], 0); EV_ISSUE(qa, id[0], 0); EV_ISSUE(qb, id[0], 1);
        EV_LOADI(id[1], 1);
        for (int k0 = 0; k0 < nk; k0 += 8) {
#pragma unroll
            for (int j = 0; j < 8; ++j) { const int k = k0 + j;
                f32x2_t ac2[8];
#pragma unroll
                for (int e = 0; e < 8; ++e) ac2[e] = (f32x2_t){0.f, 0.f};
                EV_LOADC(cf[(j + 1) & 1], k + 1);
                EV_HALF(qa, cf[j & 1], 0);
                EV_ISSUE(qa, id[(j + 1) & 1], 0);
                EV_HALF(qb, cf[j & 1], 1);
                EV_ISSUE(qb, id[(j + 1) & 1], 1);
                EV_LOADI(id[j & 1], k + 2);
                float acc[16];
#pragma unroll
                for (int e = 0; e < 8; ++e) { acc[2 * e] = ac2[e][0]; acc[2 * e + 1] = ac2[e][1]; }
#pragma unroll
                for (int e = 0; e < 16; ++e) { float v = acc[e]; v += dpp_f<0x128>(v); v += xor16_f(v); acc[e] = sum_x32(v); }
                if (e8 == 0) {
#pragma unroll
                    for (int w = 0; w < 4; ++w) *(LAS f32x4*)(res + j * 128 + c * 16 + 4 * w) = (f32x4){acc[4 * w], acc[4 * w + 1], acc[4 * w + 2], acc[4 * w + 3]}; }
                asm volatile("" ::: "memory");
            }
            { const int u = F.lane >> 3, jj = F.lane & 7, ku = k0 + u;
              if (ku < nk) { const int tu = tfirst + ku * tstride;
                  const bool isctx = tu >= NLAT; const int vv = isctx ? 4 : (tu >> 12);
                  float* xr = (isctx ? CTXS + (size_t)(tu - NLAT) * 2048 : out + (size_t)tu * 2048) + s * 128 + jj * 16;
                  const float* m5 = MOD + ((size_t)layer * 5 + vv) * 12288 + 5 * 2048 + s * 128 + jj * 16;
#pragma unroll
                  for (int w = 0; w < 4; ++w) { float4 x = *(const float4*)(xr + 4 * w); const float4 m = *(const float4*)(m5 + 4 * w); const f32x4 a = *(const LAS f32x4*)(res + u * 128 + jj * 16 + 4 * w);
                      x.x += m.x * a[0]; x.y += m.y * a[1]; x.z += m.z * a[2]; x.w += m.w * a[3]; *(float4*)(xr + 4 * w) = x; } }
              asm volatile("" ::: "memory"); }
        }
    }
#undef EV_TOK
#undef EV_LOADI
#undef EV_LOADC
#undef EV_ROW
#undef EV_ISSUE
#undef EV_HALF
}

struct Params { const float* in[N_IN]; float* out; unsigned char* ws; };

__device__ __forceinline__ LayerW make_w(ka_t in, int l) {
    LayerW W;
    W.sc_w = in[I_SCW] + (size_t)l * 3 * 512; W.rw_w0 = in[I_RW0] + (size_t)l * 2 * 512; W.rw_wup = in[I_RWUP] + (size_t)l * 2 * 64 * 512;
    W.rw_a0 = in[I_RA0] + (size_t)l * 2 * 512; W.rw_aup = in[I_RAUP] + (size_t)l * 2 * 64 * 512; W.rw_gup = in[I_RGUP] + (size_t)l * 128 * 512;
    W.rw_kk = in[I_RKK] + (size_t)l * 512; W.rw_ka = in[I_RKA] + (size_t)l * 512; W.rw_rk = in[I_RRK] + (size_t)l * 512;
    W.rw_lnw = in[I_RLNW] + (size_t)l * 512; W.rw_lnb = in[I_RLNB] + (size_t)l * 512;
    W.na_q = in[I_NAQ] + (size_t)l * 64; W.na_k = in[I_NAK] + (size_t)l * 64; W.rpb = in[I_RPB] + (size_t)l * 8 * 15 * 31;
    W.s_cw = in[I_SCONVW] + (size_t)l * 3 * 1024; W.s_cb = in[I_SCONVB] + (size_t)l * 1024; W.s_dtb = in[I_SDTB] + (size_t)l * 16; W.s_alog = in[I_SALOG] + (size_t)l * 16;
    W.s_d = in[I_SD] + (size_t)l * 8; W.s_norm = in[I_SNORM] + (size_t)l * 512;
    return W;
}

__global__ void __launch_bounds__(512, 2) hybrid_fwd(Params p) {
    extern __shared__ __attribute__((aligned(16))) unsigned char shm[];
    Ctx F; F.lds = (LAS unsigned char*)shm; F.tid = threadIdx.x; F.lane = F.tid & 63; F.wave = __builtin_amdgcn_readfirstlane(F.tid >> 6); F.bid = blockIdx.x; F.G = gridDim.x;
    volatile LAS unsigned* bst = (volatile LAS unsigned*)(F.lds + LDS_BAR_OFF);
    if (F.tid < 4) bst[F.tid] = 0u;
    __syncthreads();
    (void)xcd_barrier_post((unsigned*)(p.ws + WS_CTL), bst);
    volatile LAS int* lxi = (volatile LAS int*)(F.lds + LDS_XI_OFF);
    if (F.tid == 0) lxi[2] = (int)xb_add((unsigned*)(p.ws + WS_CTL) + CTL_TICKET + 64 * xb_xcc_id(), 1u);
#define RPT_PHASE(id, ...) do { __VA_ARGS__ if (RPT == (id)) { GRID_BAR(); PH_BEGIN(); __VA_ARGS__ } } while (0)
#define GRID_BAR() do { ka_t kb_ = (ka_t)__builtin_amdgcn_kernarg_segment_ptr(); asm volatile("" : "+s"(kb_)); unsigned xx_ = xb_xcc_id(); asm volatile("" : "+s"(xx_)); \
        XcdBarrier b_; b_.bar = (unsigned*)((unsigned char*)kb_[N_IN + 1] + WS_CTL); b_.x = xx_; b_.st = (volatile LAS unsigned*)(F.lds + LDS_BAR_OFF); xcd_barrier(b_); } while (0)
    ka_t in; unsigned char* ws; float* out;
#define PH_BEGIN() do { int t_ = threadIdx.x; asm volatile("; PHASE_MARK" : "+v"(t_)); F.tid = t_; F.lane = t_ & 63; F.wave = __builtin_amdgcn_readfirstlane(t_ >> 6); \
        int b_ = blockIdx.x, g_ = gridDim.x; asm volatile("" : "+s"(b_), "+s"(g_)); F.bid = b_; F.G = g_; \
        ka_t k_ = (ka_t)__builtin_amdgcn_kernarg_segment_ptr(); asm volatile("" : "+s"(k_)); in = k_; \
        out = (float*)in[N_IN]; ws = (unsigned char*)in[N_IN + 1]; } while (0)

    PH_BEGIN();
    RPT_PHASE(1, phase_prologue(F, in, ws););
    GRID_BAR();
    if (F.tid == 0) {
        const unsigned* bw = (const unsigned*)(ws + WS_CTL); const unsigned myx = xb_xcc_id(); int xi = 0, nx = 0, nloc = 1;
        for (unsigned j = 0; j < 16; ++j) { const unsigned cnt = xb_ld((unsigned*)&bw[XB_XCNT(j)]); if (cnt > 0u) { if (j < myx) ++xi; ++nx; } if (j == myx) nloc = (int)cnt; }
        lxi[0] = xi; lxi[1] = nx > 0 ? nx : 1; lxi[3] = nloc > 0 ? nloc : 1; }
    __syncthreads();
    PH_BEGIN();
    phase_modreduce(F, in[I_BADA], (const float*)(ws + WS_MODP), (float*)(ws + WS_MOD));
    GRID_BAR();

#pragma unroll 1
    for (int l = 0; l < 2; ++l) {
        const int M = (l == 0) ? NTOK : NLAT;
        if (l == 0) { PH_BEGIN(); phase_norm(F, in[I_X], in[I_CTX], in[I_NMIX], (const float*)(ws + WS_MOD), 0, 1, (bf16_t*)(ws + WS_XN), NTOK); GRID_BAR(); }

        PH_BEGIN();
        RPT_PHASE(2, { pg8::Gemm g{(const bf16_t*)(ws + WS_XN), (const bf16_t*)(ws + WS_WIN) + (size_t)l * PTP * 2048, NTOK, PTP, 2048}; pg8::StaticOrder S; S.init(NTOK, PTP, F.G, F.bid);
          pg8::EpiBf16 E{(bf16_t*)(ws + WS_P), PTP}; pg8::gemm_phase<pg8::EpiBf16, pg8::StaticOrder>(F.lds, g, S, E, F.tid); });
        GRID_BAR();

        PH_BEGIN();
        { const LayerW W = make_w(in, l); phase_prep(F, W, ws);
            if (RPT == 31) phase_prep(F, W, ws);
            const bf16_t* WUPT = (const bf16_t*)(ws + WS_WUPT) + (size_t)l * 4 * 512 * 64;
            for (int rep = 0; rep < (RPT == 32 ? 2 : 1); ++rep) {
            for (int task = F.bid * 8 + F.wave; task < 4 * 8 * RW_NCHUNK; task += F.G * 8) rwkv_pre_task(F, W, ws, WUPT, task, 0);
            for (int task = F.bid * 8 + F.wave; task < 4 * 8 * RW_NCHUNK; task += F.G * 8) rwkv_pre_task(F, W, ws, WUPT, task, 1); } }
        GRID_BAR();

        PH_BEGIN();
        RPT_PHASE(4, { const LayerW W = make_w(in, l); for (int task = F.bid; task < 4 * 8 * NCH; task += F.G) ssd_task<false>(F, W, ws, task); });
        GRID_BAR();
        PH_BEGIN();
        phase_ssd_combine(F, ws);
        GRID_BAR();

        PH_BEGIN();
        { if (F.bid < 64) rwkv_scan(F, ws, F.bid);
        else { const LayerW W = make_w(in, l); const int blk = F.bid - 64, nblk = F.G - 64;
            for (int task = blk; task < 4 * 8 * NCH; task += nblk) ssd_task<true>(F, W, ws, task);
            na_phase(F, W, ws, blk, nblk, (l == 0) ? 1088 : 1024); } }
        if (RPT == 51) { GRID_BAR(); PH_BEGIN(); if (F.bid < 64) rwkv_scan(F, ws, F.bid); }
        if (RPT == 52) { GRID_BAR(); PH_BEGIN(); if (F.bid >= 64) { const LayerW W = make_w(in, l); const int blk = F.bid - 64, nblk = F.G - 64;
            for (int task = blk; task < 4 * 8 * NCH; task += nblk) ssd_task<true>(F, W, ws, task); } }
        if (RPT == 53) { GRID_BAR(); PH_BEGIN(); if (F.bid >= 64) { const LayerW W = make_w(in, l); const int blk = F.bid - 64, nblk = F.G - 64;
            na_phase(F, W, ws, blk, nblk, (l == 0) ? 1088 : 1024); } }
        GRID_BAR();

        PH_BEGIN();
        RPT_PHASE(6, { const LayerW W = make_w(in, l); phase_finish(F, W, ws, (const bf16_t*)(ws + WS_GUPT) + (size_t)l * 512 * 128, M); });
        GRID_BAR();

        PH_BEGIN();
        { pg8::Gemm g{(const bf16_t*)(ws + WS_MIX), (const bf16_t*)(ws + WS_WOUT) + (size_t)l * 2048 * 2048, M, 2048, 2048}; pg8::StaticOrder S; S.init(M, 2048, F.G, F.bid);
          float* CTXS = (float*)(ws + WS_CTXS);
          pg8::EpiResid E{l == 0 ? in[I_X] : out, l == 0 ? in[I_CTX] : CTXS, out, CTXS, (const float*)(ws + WS_MOD) + (size_t)l * 5 * 12288 + 2 * 2048};
          pg8::gemm_phase<pg8::EpiResid, pg8::StaticOrder>(F.lds, g, S, E, F.tid); }
        if (l == 0 && F.bid >= 32) PEER_CONVERT_LAYER(F, in, ws, 0, F.bid - 32, F.G - 32);
        GRID_BAR();

        PH_BEGIN();
        RPT_PHASE(7, phase_norm(F, out, (const float*)(ws + WS_CTXS), in[I_NFFN] + (size_t)l * 2048, (const float*)(ws + WS_MOD) + (size_t)l * 5 * 12288, 3, 4, (bf16_t*)(ws + WS_XN), M););
        GRID_BAR();
        PH_BEGIN();
        RPT_PHASE(8, { pg8::Gemm g{(const bf16_t*)(ws + WS_XN), (const bf16_t*)(ws + WS_WQ) + (size_t)l * 2048 * 2048, M, 2048, 2048}; pg8::StaticOrder S; S.init(M, 2048, F.G, F.bid);
          pg8::EpiBf16 E{(bf16_t*)(ws + WS_P), 2048}; pg8::gemm_phase<pg8::EpiBf16, pg8::StaticOrder>(F.lds, g, S, E, F.tid); });
        if (l == 0 && F.bid >= 32) PEER_CONVERT_LAYER(F, in, ws, 1, F.bid - 32, F.G - 32);
        GRID_BAR();
        PH_BEGIN();
        RPT_PHASE(9, phase_scores(F, ws, l, M););
        GRID_BAR();
        PH_BEGIN();
        RPT_PHASE(10, { XInfo X; X.xi = lxi[0]; X.nx = lxi[1]; X.rank = lxi[2]; X.nloc = lxi[3]; phase_experts_u<0x3fff>(F, ws, l, M, X, (float*)(ws + WS_PART)); });
        if (RPT == 101) { GRID_BAR(); PH_BEGIN(); XInfo X; X.xi = lxi[0]; X.nx = lxi[1]; X.rank = lxi[2]; X.nloc = lxi[3]; phase_experts_u<0x3ff>(F, ws, l, M, X, (float*)(ws + WS_P)); }
        if (RPT == 102) { GRID_BAR(); PH_BEGIN(); XInfo X; X.xi = lxi[0]; X.nx = lxi[1]; X.rank = lxi[2]; X.nloc = lxi[3]; phase_experts_u<0x3fff>(F, ws, l, M, X, (float*)(ws + WS_P)); }
        GRID_BAR();
        PH_BEGIN();
        phase_experts_combine(F, ws, M);
        GRID_BAR();
        PH_BEGIN();
        if (RPT == 11) { XInfo X; X.xi = lxi[0]; X.nx = lxi[1]; X.rank = lxi[2]; X.nloc = lxi[3]; phase_experts_v(F, ws, (float*)(ws + WS_P), (float*)(ws + WS_P) + (size_t)NLAT * 2048, l, M, X); GRID_BAR(); PH_BEGIN(); }
        { XInfo X; X.xi = lxi[0]; X.nx = lxi[1]; X.rank = lxi[2]; X.nloc = lxi[3]; phase_experts_v(F, ws, out, (float*)(ws + WS_CTXS), l, M, X); }
        if (l == 0) { GRID_BAR(); PH_BEGIN();
            phase_norm(F, out, (const float*)(ws + WS_CTXS), in[I_NMIX] + 2048, (const float*)(ws + WS_MOD) + (size_t)5 * 12288, 0, 1, (bf16_t*)(ws + WS_XN), NTOK); GRID_BAR(); }
    }
}

extern "C" void kernel_launch(void* const* d_in, const int* in_sizes, int n_in, void* d_out, int out_size, void* d_ws, size_t ws_size, hipStream_t stream) {
    static int grid = 0;
    if (grid == 0) {
        if (n_in != N_IN || out_size != NLAT * DM || ws_size < WS_END) { fprintf(stderr, "kernel_launch: unexpected shapes (n_in %d out %d ws %zu, need %zu)\n", n_in, out_size, ws_size, (size_t)WS_END); grid = -1; return; }
        int dev = 0, cus = 0, per_cu = 0;
        (void)hipGetDevice(&dev); (void)hipDeviceGetAttribute(&cus, hipDeviceAttributeMultiprocessorCount, dev);
        if (hipFuncSetAttribute((const void*)hybrid_fwd, hipFuncAttributeMaxDynamicSharedMemorySize, LDS_BYTES) != hipSuccess) { fprintf(stderr, "kernel_launch: hipFuncSetAttribute failed\n"); grid = -1; return; }
        (void)hipOccupancyMaxActiveBlocksPerMultiprocessor(&per_cu, (const void*)hybrid_fwd, 512, LDS_BYTES);
        (void)hipGetLastError();
        fprintf(stderr, "kernel_launch: %d CUs, occupancy query %d block(s)/CU, ws %zu B (need %zu)\n", cus, per_cu, ws_size, (size_t)WS_END);
        grid = cus;
        if (grid < 136) { fprintf(stderr, "kernel_launch: needs at least 136 CUs\n"); grid = -1; return; }
    }
    if (grid < 0) return;
    (void)hipMemsetAsync((char*)d_ws + WS_CTL, 0, 65536, stream);
    Params p{};
    for (int i = 0; i < N_IN; ++i) p.in[i] = (const float*)d_in[i];
    p.out = (float*)d_out; p.ws = (unsigned char*)d_ws;
    hipLaunchKernelGGL(hybrid_fwd, dim3(grid), dim3(512), LDS_BYTES, stream, p);
}
```

```cpp
#include <hip/hip_runtime.h>
#include <cstdio>
#include <cstdint>
#ifndef RPT
#define RPT 0
#endif

constexpr int DM = 2048, NBATCH = 4, SEQL = 4096, CTXL = 256, NLAT = NBATCH * SEQL, NCTX = NBATCH * CTXL, NTOK = NLAT + NCTX;
constexpr int PT = 6416, PTP = 6656;
constexpr int A_BG = 0, A_CG = 512, A_H = 1024;
constexpr int B_R = 1536, B_K = 2048, B_V = 2560, B_WD = 3072, B_AD = 3136, B_GD = 3200;
constexpr int C_Q = 3328, C_K = 3840, C_V = 4352;
constexpr int D_Z = 4864, D_X = 5376, D_DT = 6400;
constexpr int NPOS = CTXL + SEQL;
constexpr int NCH = 34;
constexpr int KSPL = 32;

enum { I_X = 0, I_C, I_CTX, I_CCTX, I_WADA, I_BADA, I_NMIX, I_NFFN, I_WIN, I_WOUT, I_SCW, I_RW0, I_RWUP, I_RA0, I_RAUP, I_RGUP, I_RKK, I_RKA, I_RRK, I_RLNW, I_RLNB,
       I_NAQ, I_NAK, I_RPB, I_SCONVW, I_SCONVB, I_SDTB, I_SALOG, I_SD, I_SNORM, I_PWQ, I_PKEYS, I_PU, I_PV, N_IN };

constexpr size_t WS_CTL   = 0;
constexpr size_t WS_ROPE  = 65536;
constexpr size_t WS_MODP  = WS_ROPE + 16384;
constexpr size_t WS_MOD   = WS_MODP + (size_t)KSPL * 2 * 5 * 12288 * 4;
constexpr size_t WS_WIN   = WS_MOD + (size_t)2 * 5 * 12288 * 4;
constexpr size_t WS_WOUT  = WS_WIN + (size_t)2 * PTP * DM * 2;
constexpr size_t WS_WQ    = WS_WOUT + (size_t)2 * DM * DM * 2;
constexpr size_t WS_KEYS  = WS_WQ + (size_t)2 * DM * DM * 2;
constexpr size_t WS_WUPT  = WS_KEYS + (size_t)2 * 8 * 2 * 128 * 128 * 2;
constexpr size_t WS_GUPT  = WS_WUPT + (size_t)2 * 4 * 512 * 64 * 2;
constexpr size_t WS_PU    = WS_GUPT + (size_t)2 * 512 * 128 * 2;
constexpr size_t WS_PV    = WS_PU + (size_t)2 * 16384 * DM;
constexpr size_t WS_P     = WS_PV + (size_t)2 * 16384 * DM;
constexpr size_t WS_MIX   = WS_P + (size_t)NTOK * PTP * 2;
constexpr size_t WS_CTXS  = WS_MIX + (size_t)NTOK * DM * 2;
constexpr size_t WS_XN    = WS_CTXS + (size_t)NCTX * DM * 4;
constexpr size_t WS_IDS   = WS_XN + (size_t)NTOK * DM * 2;
constexpr size_t WS_GATES = WS_IDS + (size_t)NTOK * 128 * 4;
constexpr size_t WS_PART  = WS_GATES + (size_t)NTOK * 128 * 4;
constexpr size_t WS_RWF   = WS_XN;
constexpr size_t WS_RWY   = WS_RWF + (size_t)64 * 272 * 10496;
constexpr size_t WS_BON   = WS_RWY + (size_t)2 * NTOK * 512 * 2;
constexpr size_t WS_XBC   = WS_BON + (size_t)2 * NTOK * 8 * 4;
constexpr size_t WS_DTS   = WS_XBC + (size_t)NTOK * 1024 * 2;
constexpr size_t WS_DEC   = WS_DTS + (size_t)NTOK * 16 * 4;
constexpr size_t WS_SST   = WS_DEC + (size_t)NTOK * 16 * 4;
constexpr size_t WS_SCD   = WS_SST + (size_t)64 * NCH * 8192 * 4;
constexpr size_t WS_YS    = WS_SCD + 16384;
constexpr size_t WS_QN    = WS_YS + (size_t)NTOK * 512 * 4;
constexpr size_t WS_KN    = WS_QN + (size_t)NTOK * 512 * 2;
constexpr size_t WS_VTL   = WS_KN + (size_t)NTOK * 512 * 2;
constexpr size_t WS_VTC   = WS_VTL + (size_t)4 * 8 * 64 * 64 * 96 * 2;
constexpr size_t WS_END   = WS_VTC + (size_t)4 * 8 * 64 * 256 * 2;
static_assert(WS_END < (size_t)1020 * 1024 * 1024, "workspace");
static_assert(WS_GATES + (size_t)NTOK * 128 * 4 <= WS_PART && WS_PART + (size_t)16 * NTOK * 128 * 4 <= WS_END, "alias");

constexpr int LDS_BYTES = 147456;
constexpr int LDS_BAR_OFF = LDS_BYTES - 16;
constexpr int LDS_XI_OFF = LDS_BYTES - 48;
constexpr int CTL_TICKET = 8192;

#define LAS __attribute__((address_space(3)))
typedef unsigned short bf16_t;
typedef _Float16 f16_t;
typedef short bf16x8 __attribute__((ext_vector_type(8)));
typedef float f32x4 __attribute__((ext_vector_type(4)));
typedef unsigned u32x4 __attribute__((ext_vector_type(4)));
typedef unsigned u32x2 __attribute__((ext_vector_type(2)));

__device__ __forceinline__ float bf2f(bf16_t h) { return __uint_as_float(((unsigned)h) << 16); }
__device__ __forceinline__ float bflo(unsigned u) { return __uint_as_float(u << 16); }
__device__ __forceinline__ float bfhi(unsigned u) { return __uint_as_float(u & 0xffff0000u); }
__device__ __forceinline__ bf16_t f2bf(float f) { unsigned u = __float_as_uint(f); u += 0x7FFFu + ((u >> 16) & 1u); return (bf16_t)(u >> 16); }
typedef float f32x2_t __attribute__((ext_vector_type(2)));
typedef __bf16 bf16x2_t __attribute__((ext_vector_type(2)));
__device__ __forceinline__ unsigned pk_bf16(float lo, float hi) { const f32x2_t v = {lo, hi}; const bf16x2_t r = __builtin_convertvector(v, bf16x2_t); return __builtin_bit_cast(unsigned, r); }
__device__ __forceinline__ bf16x8 pack8(const f32x4 a, const f32x4 b) { union { bf16x8 v; unsigned u[4]; } r; r.u[0] = pk_bf16(a[0], a[1]); r.u[1] = pk_bf16(a[2], a[3]); r.u[2] = pk_bf16(b[0], b[1]); r.u[3] = pk_bf16(b[2], b[3]); return r.v; }
template <int CTRL> __device__ __forceinline__ float dpp_f(float v) { return __int_as_float(__builtin_amdgcn_update_dpp(0, __float_as_int(v), CTRL, 0xF, 0xF, true)); }
__device__ __forceinline__ float sum4(float x)  { x += dpp_f<0xB1>(x); x += dpp_f<0x4E>(x); return x; }
__device__ __forceinline__ float sum8(float x)  { x = sum4(x); x += dpp_f<0x141>(x); return x; }
__device__ __forceinline__ float sum16(float x) { x = sum8(x); x += dpp_f<0x140>(x); return x; }
__device__ __forceinline__ float xor16_f(float x) { return __int_as_float(__builtin_amdgcn_ds_swizzle(__float_as_int(x), 0x401F)); }
__device__ __forceinline__ float sum_x32(float x) { const auto r = __builtin_amdgcn_permlane32_swap(__float_as_uint(x), __float_as_uint(x), false, false); return __uint_as_float(r[0]) + __uint_as_float(r[1]); }
__device__ __forceinline__ float max_x32(float x) { const auto r = __builtin_amdgcn_permlane32_swap(__float_as_uint(x), __float_as_uint(x), false, false); return fmaxf(__uint_as_float(r[0]), __uint_as_float(r[1])); }
__device__ __forceinline__ float wave_sum(float x) { x = sum16(x); x += xor16_f(x); return sum_x32(x); }
__device__ __forceinline__ float max16(float x) { x = fmaxf(x, dpp_f<0xB1>(x)); x = fmaxf(x, dpp_f<0x4E>(x)); x = fmaxf(x, dpp_f<0x141>(x)); x = fmaxf(x, dpp_f<0x140>(x)); return x; }
__device__ __forceinline__ float wave_max(float x) { x = max16(x); x = fmaxf(x, xor16_f(x)); return max_x32(x); }
__device__ __forceinline__ float rcpf_(float x) { return __builtin_amdgcn_rcpf(x); }
__device__ __forceinline__ float sigmoidf_(float x) { return rcpf_(1.0f + __expf(-x)); }
__device__ __forceinline__ float siluf_(float x) { return x * rcpf_(1.0f + __expf(-x)); }
__device__ __forceinline__ float tanhf_(float x) { const float e = __expf(2.0f * x); return 1.0f - 2.0f * rcpf_(e + 1.0f); }
__device__ __forceinline__ float geluf_(float x) { return 0.5f * x * (1.0f + tanhf_(0.7978845608028654f * (x + 0.044715f * x * x * x))); }

namespace pg8 {
#define PG8_LAS __attribute__((address_space(3)))
typedef unsigned short bf16_t;
typedef short bf16x8 __attribute__((ext_vector_type(8)));
typedef float f32x4 __attribute__((ext_vector_type(4)));
typedef unsigned u32x4 __attribute__((ext_vector_type(4)));
constexpr int BM = 256, BK = 64, HALF = 128, HTB = HALF * BK * 2  , STAGE_BYTES = 8 * HTB, NXCD = 8, WGM = 8;

__host__ __device__ __forceinline__ int lds_byte(int r, int c) { const int st = (r >> 4) * 2 + (c >> 5), rr = r & 15, cc = c & 31, ob = rr * 64 + cc * 2; return st * 1024 + (ob ^ (((ob >> 9) & 1) << 5)); }
__host__ __device__ __forceinline__ void stage_rc(int b, int& R, int& C) { const int st = b / 1024, sb = b % 1024, swz = sb ^ (((sb >> 9) & 1) << 5); R = (st >> 1) * 16 + swz / 64; C = (st & 1) * 32 + (swz % 64) / 2; }
__host__ __device__ __forceinline__ int perm32(int rho) { const int n = rho >> 4, i = rho & 15; return 8 * (i >> 2) + 4 * n + (i & 3); }

struct Unit { int pm, pn; };
struct Gemm { const bf16_t* A; const bf16_t* Bt; int M, N, K; };

struct StaticOrder {
    int nM, nN, nwg, G, c;
    __host__ __device__ void init(int M, int N, int G_, int c_) { nM = M / BM; nN = N / BM; nwg = nM * nN; G = G_; c = c_; }
    __host__ __device__ bool next(int i, Unit& u) const {
        const long L = (long)i * G + c; if (L >= nwg) return false;
        int wgid = (int)L; { const int q = nwg / NXCD, r = nwg % NXCD, xcd = wgid % NXCD, off = wgid / NXCD; wgid = (xcd < r ? xcd * (q + 1) : r * (q + 1) + (xcd - r) * q) + off; }
        const int nig = WGM * nN, gid = wgid / nig, fm = gid * WGM, gsz = (nM - fm) < WGM ? (nM - fm) : WGM;
        u.pm = fm + ((wgid % nig) % gsz); u.pn = (wgid % nig) / gsz; return true;
    }
    __device__ __forceinline__ void a_ready(const Unit&) const {}
    __device__ __forceinline__ void done(const Unit&) const {}
};

__device__ __forceinline__ unsigned cvt_pk_bf16(float lo, float hi) { return ::pk_bf16(lo, hi); }
struct EpiBf16 {
    static constexpr bool PERM = true, AFTER_DRAIN = false;
    bf16_t* O; int ldc;
    __device__ __forceinline__ void operator()(const f32x4 (&acc)[2][2][4][2], const Unit& u, int wr, int wc, int fr, int fq) const {
        const int row0 = u.pm * BM + wr * 64 + fr; const int col0 = u.pn * BM + wc * 32 + 8 * fq;
#pragma unroll
        for (int ai = 0; ai < 2; ++ai)
#pragma unroll
            for (int m = 0; m < 4; ++m) { bf16_t* rowp = O + (size_t)(row0 + ai * HALF + m * 16) * ldc + col0;
#pragma unroll
                for (int bj = 0; bj < 2; ++bj) { const f32x4 v0 = acc[ai][bj][m][0], v1 = acc[ai][bj][m][1];
                    u32x4 w; w.x = cvt_pk_bf16(v0[0], v0[1]); w.y = cvt_pk_bf16(v0[2], v0[3]); w.z = cvt_pk_bf16(v1[0], v1[1]); w.w = cvt_pk_bf16(v1[2], v1[3]);
                    *(u32x4*)(rowp + bj * HALF) = w; } }
    }
};
struct EpiResid {
    static constexpr bool PERM = false, AFTER_DRAIN = false;
    const float* xi_lat; const float* xi_ctx; float* xo_lat; float* xo_ctx; const float* gate;
    __device__ __forceinline__ void operator()(const f32x4 (&acc)[2][2][4][2], const Unit& u, int wr, int wc, int fr, int fq) const {
        const bool isctx = u.pm >= 64; const int v = isctx ? 4 : (u.pm >> 4);
        const int row0 = (isctx ? (u.pm - 64) : u.pm) * BM + wr * 64 + fr, col0 = u.pn * BM + wc * 32 + 4 * fq;
        const float* xi = isctx ? xi_ctx : xi_lat; float* xo = isctx ? xo_ctx : xo_lat;
        const float* gp = gate + (size_t)v * 12288 + col0;
        f32x4 gv[2][2];
#pragma unroll
        for (int bj = 0; bj < 2; ++bj)
#pragma unroll
            for (int n = 0; n < 2; ++n) gv[bj][n] = *(const f32x4*)(gp + bj * HALF + n * 16);
#pragma unroll
        for (int ai = 0; ai < 2; ++ai)
#pragma unroll
            for (int m = 0; m < 4; ++m) { const size_t off = (size_t)(row0 + ai * HALF + m * 16) * 2048 + col0;
#pragma unroll
                for (int bj = 0; bj < 2; ++bj)
#pragma unroll
                    for (int n = 0; n < 2; ++n) { const f32x4 xv = *(const f32x4*)(xi + off + bj * HALF + n * 16);
                        *(f32x4*)(xo + off + bj * HALF + n * 16) = xv + gv[bj][n] * acc[ai][bj][m][n]; }
                asm volatile("" ::: "memory"); }
    }
};

template <class Epi, class Sched>
__device__ __forceinline__ void gemm_phase(PG8_LAS unsigned char* lds, const Gemm g, const Sched& S, const Epi& E, const int tid) {
    const int wid = __builtin_amdgcn_readfirstlane(tid >> 6), lane = tid & 63, wr = wid >> 2, wc = wid & 3, fr = lane & 15, fq = lane >> 4;
    const int K = g.K, nt = K / BK;
    unsigned voffA[2], voffB[2];
#pragma unroll
    for (int i = 0; i < 2; ++i) { int R, C; stage_rc(tid * 16 + i * 8192, R, C); const int Rb = Epi::PERM ? ((R & ~31) + perm32(R & 31)) : R;
        voffA[i] = (unsigned)(R * K + C) * 2u; voffB[i] = (unsigned)(Rb * K + C) * 2u; }
    const size_t kstep = (size_t)(BK * 2);
    const size_t hstep = (size_t)HALF * K * 2;
    const size_t tstep = 2 * hstep;
    const unsigned ldsw = (unsigned)wid * 1024u;
    const int aoff = lds_byte(wr * 64 + fr, fq * 8), boff = lds_byte(wc * 32 + fr, fq * 8);
#define PG8_SA(b, h) (((b) * 2 + (h)) * HTB)
#define PG8_SB(b, h) ((4 + (b) * 2 + (h)) * HTB)
#define PG8_STAGE(bufoff, gbase, voff) do { _Pragma("unroll") for (int _i = 0; _i < 2; ++_i) \
        __builtin_amdgcn_global_load_lds((const unsigned*)((const char*)(gbase) + (voff)[_i]), (PG8_LAS unsigned*)(lds + (bufoff) + ldsw + _i * 8192), 16, 0, 0); } while (0)
#define PG8_LDA(dst, b, h) do { _Pragma("unroll") for (int m = 0; m < 4; ++m) _Pragma("unroll") for (int k = 0; k < 2; ++k) dst[m][k] = *(const PG8_LAS bf16x8*)(lds + PG8_SA(b, h) + aoff + m * 2048 + k * 1024); } while (0)
#define PG8_LDB(dst, b, h) do { _Pragma("unroll") for (int n = 0; n < 2; ++n) _Pragma("unroll") for (int k = 0; k < 2; ++k) dst[n][k] = *(const PG8_LAS bf16x8*)(lds + PG8_SB(b, h) + boff + n * 2048 + k * 1024); } while (0)
#define PG8_MMA(ai, bj, At, Bt) do { __builtin_amdgcn_s_setprio(1); _Pragma("unroll") for (int m = 0; m < 4; ++m) _Pragma("unroll") for (int n = 0; n < 2; ++n) _Pragma("unroll") for (int k = 0; k < 2; ++k) \
        acc[ai][bj][m][n] = __builtin_amdgcn_mfma_f32_16x16x32_bf16(Bt[n][k], At[m][k], acc[ai][bj][m][n], 0, 0, 0); __builtin_amdgcn_s_setprio(0); } while (0)
#define PG8_WAIT_V(n) asm volatile("s_waitcnt vmcnt(" #n ")" ::: "memory")
#define PG8_WAIT_L(n) asm volatile("s_waitcnt lgkmcnt(" #n ")" ::: "memory")
#define PG8_BAR __builtin_amdgcn_s_barrier()
#define PG8_SCHED __builtin_amdgcn_sched_barrier(0)
    Unit cur, nxt; int ui = 0;
    if (!S.next(0, cur)) return;
    f32x4 acc[2][2][4][2];
#pragma unroll
    for (int a = 0; a < 2; ++a)
#pragma unroll
        for (int b = 0; b < 2; ++b)
#pragma unroll
            for (int m = 0; m < 4; ++m)
#pragma unroll
                for (int n = 0; n < 2; ++n) acc[a][b][m][n] = (f32x4){0.f, 0.f, 0.f, 0.f};
    bf16x8 At[4][2], B0[2][2], B1[2][2];
    const char* cA = (const char*)g.A + (size_t)cur.pm * tstep; const char* cB = (const char*)g.Bt + (size_t)cur.pn * tstep;
    S.a_ready(cur);
    PG8_STAGE(PG8_SB(0, 0), cB, voffB); PG8_STAGE(PG8_SA(0, 0), cA, voffA); PG8_STAGE(PG8_SB(0, 1), cB + hstep, voffB); PG8_STAGE(PG8_SA(0, 1), cA + hstep, voffA);
    if (wr == 1) PG8_BAR;
    PG8_WAIT_V(4); PG8_BAR;
    PG8_STAGE(PG8_SB(1, 0), cB + kstep, voffB); PG8_STAGE(PG8_SA(1, 0), cA + kstep, voffA); PG8_STAGE(PG8_SB(1, 1), cB + hstep + kstep, voffB);
    PG8_WAIT_V(6); PG8_BAR;
    for (;;) {
        const bool has_next = S.next(ui + 1, nxt);
        const char* nA = has_next ? (const char*)g.A + (size_t)nxt.pm * tstep : cA; const char* nB = has_next ? (const char*)g.Bt + (size_t)nxt.pn * tstep : cB;
        for (int t = 0; t < nt; t += 2) {
            const bool last = (t == nt - 2);
            const char* a1 = cA + (size_t)(t + 1) * kstep;
            const char* a2 = last ? nA : cA + (size_t)(t + 2) * kstep; const char* b2 = last ? nB : cB + (size_t)(t + 2) * kstep;
            const char* a3 = a2 + kstep; const char* b3 = b2 + kstep;
            if (last && has_next) S.a_ready(nxt);
            PG8_LDB(B0, 0, 0); PG8_SCHED; PG8_LDA(At, 0, 0); PG8_STAGE(PG8_SA(1, 1), a1 + hstep, voffA);
            PG8_WAIT_L(8); PG8_BAR; PG8_WAIT_L(0); PG8_MMA(0, 0, At, B0); PG8_BAR; PG8_SCHED;
            PG8_LDB(B1, 0, 1); PG8_STAGE(PG8_SB(0, 0), b2, voffB);
            PG8_BAR; PG8_WAIT_L(0); PG8_MMA(0, 1, At, B1); PG8_BAR;
            PG8_LDA(At, 0, 1); PG8_STAGE(PG8_SA(0, 0), a2, voffA);
            PG8_BAR; PG8_WAIT_L(0); PG8_MMA(1, 0, At, B0); PG8_BAR; PG8_SCHED;
            PG8_STAGE(PG8_SB(0, 1), b2 + hstep, voffB);
            PG8_WAIT_V(6); PG8_BAR; PG8_MMA(1, 1, At, B1); PG8_BAR;
            PG8_LDB(B0, 1, 0); PG8_SCHED; PG8_LDA(At, 1, 0); PG8_STAGE(PG8_SA(0, 1), a2 + hstep, voffA);
            PG8_WAIT_L(8); PG8_BAR; PG8_WAIT_L(0); PG8_MMA(0, 0, At, B0); PG8_BAR; PG8_SCHED;
            PG8_LDB(B1, 1, 1); PG8_STAGE(PG8_SB(1, 0), b3, voffB);
            PG8_BAR; PG8_WAIT_L(0); PG8_MMA(0, 1, At, B1); PG8_BAR;
            PG8_LDA(At, 1, 1); PG8_STAGE(PG8_SA(1, 0), a3, voffA);
            PG8_BAR; PG8_WAIT_L(0); PG8_MMA(1, 0, At, B0); PG8_BAR; PG8_SCHED;
            PG8_STAGE(PG8_SB(1, 1), b3 + hstep, voffB);
            PG8_WAIT_V(6); PG8_BAR; PG8_MMA(1, 1, At, B1); PG8_BAR;
        }
        if constexpr (!Epi::AFTER_DRAIN) { E(acc, cur, wr, wc, fr, fq); S.done(cur); }
        if (!has_next) break;
#pragma unroll
        for (int a = 0; a < 2; ++a)
#pragma unroll
            for (int b = 0; b < 2; ++b)
#pragma unroll
                for (int m = 0; m < 4; ++m)
#pragma unroll
                    for (int n = 0; n < 2; ++n) acc[a][b][m][n] = (f32x4){0.f, 0.f, 0.f, 0.f};
        cur = nxt; cA = nA; cB = nB; ++ui;
    }
    PG8_WAIT_V(0);
    if (wr == 0) PG8_BAR;
    PG8_BAR;
    if constexpr (Epi::AFTER_DRAIN) { E.fused(acc, cur, wr, wc, fr, fq, lds, wid, lane); S.done(cur); }
#undef PG8_SA
#undef PG8_SB
#undef PG8_STAGE
#undef PG8_LDA
#undef PG8_LDB
#undef PG8_MMA
#undef PG8_WAIT_V
#undef PG8_WAIT_L
#undef PG8_BAR
#undef PG8_SCHED
}
}

#define XB_TMO      128
#define XB_XCNT(j)  (256  + 64 * (j))
#define XB_XSUB(j)  (1280 + 64 * (j))
#define XB_XGEN(j)  (2304 + 64 * (j))
#define XB_TOP      3328
#define XB_TOPGEN   3392
#define XCD_BAR_WORDS 3456
#define XB_SPIN_CAP (1u << 18)
#define LAS __attribute__((address_space(3)))

__device__ __forceinline__ unsigned xb_ld(unsigned* p)              { return __hip_atomic_load(p, __ATOMIC_RELAXED, __HIP_MEMORY_SCOPE_AGENT); }
__device__ __forceinline__ unsigned xb_add(unsigned* p, unsigned v) { return __hip_atomic_fetch_add(p, v, __ATOMIC_RELAXED, __HIP_MEMORY_SCOPE_AGENT); }
__device__ __forceinline__ unsigned xb_xcc_id() { return (unsigned)__builtin_amdgcn_s_getreg((3 << 11) | 20) & 0xFu; }
#define XB_SPIN(cond, bar) do { unsigned _sp = 0; while (cond) { __builtin_amdgcn_s_sleep(1); \
    if ((++_sp & 255u) == 0u) { if (xb_ld(&(bar)[XB_TMO])) break; if (_sp > XB_SPIN_CAP) { atomicAdd(&(bar)[XB_TMO], 1u); break; } } } } while (0)

struct XcdBarrier {
    unsigned* bar; unsigned x;
    volatile LAS unsigned* st;
};

__device__ __forceinline__ XcdBarrier xcd_barrier_post(unsigned* bar, volatile LAS unsigned* st) {
    XcdBarrier b; b.bar = bar; b.x = xb_xcc_id(); b.st = st;
    if (threadIdx.x == 0) (void)xb_add(&bar[XB_XCNT(b.x)], 1u);
    return b;
}
__device__ __forceinline__ void xcd_barrier_complete(unsigned* bar, unsigned x, unsigned& nloc, unsigned& nx) {
    const unsigned G = gridDim.x * gridDim.y * gridDim.z;
    unsigned sum, cnt, mine, sp = 0u;
    for (;;) {
        sum = 0u; cnt = 0u; mine = 0u;
#pragma unroll
        for (unsigned j = 0; j < 16; ++j) { const unsigned c = xb_ld(&bar[XB_XCNT(j)]); sum += c; cnt += (c > 0u) ? 1u : 0u; mine = (j == x) ? c : mine; }
        if (sum == G) break;
        __builtin_amdgcn_s_sleep(1);
        if ((++sp & 255u) == 0u) { if (xb_ld(&bar[XB_TMO])) break; if (sp > XB_SPIN_CAP) { atomicAdd(&bar[XB_TMO], 1u); break; } }
    }
    nloc = mine > 0u ? mine : 1u; nx = cnt > 0u ? cnt : 1u;
}

__device__ __forceinline__ void xcd_barrier(const XcdBarrier& b) {
    asm volatile("s_waitcnt vmcnt(0)" ::: "memory");
    __syncthreads();
    if (threadIdx.x == 0) {
        unsigned* bar = b.bar;
        __builtin_amdgcn_s_waitcnt(0);
        unsigned nloc = b.st[0], nx = b.st[1];
        if (nloc == 0u) { xcd_barrier_complete(bar, b.x, nloc, nx); b.st[0] = nloc; b.st[1] = nx; }
        const unsigned old = xb_add(&bar[XB_XSUB(b.x)], 1u);
        const unsigned gen = old / nloc;
        if (old + 1u == (gen + 1u) * nloc) {
            __builtin_amdgcn_fence(__ATOMIC_RELEASE, "agent");
            asm volatile("s_waitcnt vmcnt(0)" ::: "memory");
            const unsigned og = xb_add(&bar[XB_TOP], 1u);
            const unsigned tg = og / nx;
            if (og + 1u == (tg + 1u) * nx) xb_add(&bar[XB_TOPGEN], 1u);
            else XB_SPIN(xb_ld(&bar[XB_TOPGEN]) == tg, bar);
            __builtin_amdgcn_fence(__ATOMIC_ACQUIRE, "agent");
            xb_add(&bar[XB_XGEN(b.x)], 1u);
            asm volatile("s_waitcnt vmcnt(0)" ::: "memory");
        } else {
            XB_SPIN(xb_ld(&bar[XB_XGEN(b.x)]) == gen, bar);
            __builtin_amdgcn_fence(__ATOMIC_ACQUIRE, "agent");
            asm volatile("s_waitcnt vmcnt(0)" ::: "memory");
        }
    }
    __syncthreads();
}

typedef const float* cfp_t;
typedef __attribute__((address_space(4))) const cfp_t* ka_t;
struct Ctx {
    LAS unsigned char* lds; int tid, lane, wave, bid, G;
};

__device__ __forceinline__ void task_ada(const Ctx& F, const float* c, const float* c_ctx, const float* w_ada, float* modp, int task) {
    LAS float* s_act = (LAS float*)F.lds;
    const int l = task / (KSPL * 6), rem = task % (KSPL * 6), ks = rem / 6, cc = rem % 6;
    __syncthreads();
    if (F.tid < 320) { const int v = F.tid >> 6, k = ks * 64 + (F.tid & 63); const float x = v < 4 ? c[v * 2048 + k] : c_ctx[k]; s_act[F.tid] = siluf_(x); }
    __syncthreads();
    const int col4 = cc * 512 + F.tid;
    const float4* wp = (const float4*)(w_ada + ((size_t)l * 2048 + ks * 64) * 12288) + col4;
    float4 acc[5];
#pragma unroll
    for (int v = 0; v < 5; ++v) acc[v] = make_float4(0.f, 0.f, 0.f, 0.f);
#pragma unroll 8
    for (int k = 0; k < 64; ++k) {
        const float4 w = wp[(size_t)k * 3072];
#pragma unroll
        for (int v = 0; v < 5; ++v) { const float a = s_act[v * 64 + k]; acc[v].x += a * w.x; acc[v].y += a * w.y; acc[v].z += a * w.z; acc[v].w += a * w.w; }
    }
#pragma unroll
    for (int v = 0; v < 5; ++v) ((float4*)(modp + (((size_t)ks * 2 + l) * 5 + v) * 12288))[col4] = acc[v];
}
__device__ __forceinline__ void task_wt(const Ctx& F, const float* W, int N, bf16_t* Wt, int ntile) {
    LAS bf16_t* T = (LAS bf16_t*)F.lds;
    const int nq = F.tid & 15, kr = F.tid >> 4, n0 = ntile * 64;
    for (int kc = 0; kc < 16; ++kc) {
        float4 v[4];
#pragma unroll
        for (int j = 0; j < 4; ++j) { const int k = kc * 128 + kr + 32 * j, n = n0 + 4 * nq;
            v[j] = (n < N) ? *(const float4*)(W + (size_t)k * N + n) : make_float4(0.f, 0.f, 0.f, 0.f); }
        __syncthreads();
#pragma unroll
        for (int j = 0; j < 4; ++j) { const int kl = kr + 32 * j;
            T[(4 * nq + 0) * 136 + kl] = f2bf(v[j].x); T[(4 * nq + 1) * 136 + kl] = f2bf(v[j].y); T[(4 * nq + 2) * 136 + kl] = f2bf(v[j].z); T[(4 * nq + 3) * 136 + kl] = f2bf(v[j].w); }
        __syncthreads();
        { const int n = F.tid >> 3, kg = F.tid & 7;
          const u32x4 a = *(LAS u32x4*)(T + n * 136 + kg * 16), b = *(LAS u32x4*)(T + n * 136 + kg * 16 + 8);
          bf16_t* dst = Wt + (size_t)(n0 + n) * 2048 + kc * 128 + kg * 16; *(u32x4*)dst = a; *(u32x4*)(dst + 8) = b; }
    }
    __syncthreads();
}
__device__ __forceinline__ void task_cvt(const Ctx& F, const float* src, bf16_t* dst, size_t off) {
#pragma unroll 4
    for (int it = 0; it < 16; ++it) { const size_t e = off + (size_t)it * 4096 + F.tid * 8;
        const float4 a = *(const float4*)(src + e), b = *(const float4*)(src + e + 4);
        u32x4 o; o.x = pk_bf16(a.x, a.y); o.y = pk_bf16(a.z, a.w); o.z = pk_bf16(b.x, b.y); o.w = pk_bf16(b.z, b.w);
        *(u32x4*)(dst + e) = o; }
}
__device__ __forceinline__ void task_cvt8(const Ctx& F, const float* src, unsigned char* dst, size_t off, float scale) {
#pragma unroll 2
    for (int it = 0; it < 8; ++it) { const size_t e = off + (size_t)it * 8192 + F.tid * 16;
        u32x4 o;
#pragma unroll
        for (int w = 0; w < 4; ++w) { const float4 a = *(const float4*)(src + e + 4 * w);
            const float x0 = fminf(fmaxf(a.x * scale, -448.f), 448.f), x1 = fminf(fmaxf(a.y * scale, -448.f), 448.f), x2 = fminf(fmaxf(a.z * scale, -448.f), 448.f), x3 = fminf(fmaxf(a.w * scale, -448.f), 448.f);
            int p = __builtin_amdgcn_cvt_pk_fp8_f32(x0, x1, 0, false); p = __builtin_amdgcn_cvt_pk_fp8_f32(x2, x3, p, true); o[w] = (unsigned)p; }
        const size_t row = e >> 11; const int col = (int)(e & 2047);
        *(u32x4*)(dst + (row >> 14) * ((size_t)16384 * 2048) + ((size_t)(col >> 7) * 16384 + (row & 16383)) * 128 + (col & 127)) = o; }
}
constexpr float PEER_U_SCALE = 64.0f;
#define PEER_CONVERT_LAYER(F, in, ws, layer, blk, nblk) do { for (int t_ = (blk); t_ < 1024; t_ += (nblk)) { const bool isv_ = t_ >= 512; \
        task_cvt8(F, in[isv_ ? I_PV : I_PU], ws + (isv_ ? WS_PV : WS_PU), (size_t)(layer) * 16384 * 2048 + (size_t)(t_ & 511) * 65536, isv_ ? 1.0f : PEER_U_SCALE); } } while (0)
__device__ __forceinline__ void task_lorat(const Ctx& F, const float* src, bf16_t* dst, int nj) {
    const int ch = F.tid;
    for (int j8 = 0; j8 < nj / 8; ++j8) { float v[8];
#pragma unroll
        for (int q = 0; q < 8; ++q) v[q] = src[(size_t)(j8 * 8 + q) * 512 + ch];
        u32x4 o; o.x = pk_bf16(v[0], v[1]); o.y = pk_bf16(v[2], v[3]); o.z = pk_bf16(v[4], v[5]); o.w = pk_bf16(v[6], v[7]);
        *(u32x4*)(dst + (size_t)ch * nj + j8 * 8) = o; }
}
constexpr int T_ADA = 2 * KSPL * 6, T_WT1 = 2 * 104, T_WT2 = 2 * 32, T_WT3 = 2 * 32, T_PEER = 0, T_KEYS = 8, T_LORA = 10;
__device__ __forceinline__ void phase_prologue(const Ctx& F, ka_t in, unsigned char* ws) {
    const int total = T_ADA + T_WT1 + T_WT2 + T_WT3 + T_PEER + T_KEYS + T_LORA + 1;
    for (int t0 = F.bid; t0 < total; t0 += F.G) {
        int t = t0;
        if (t < T_ADA) { task_ada(F, in[I_C], in[I_CCTX], in[I_WADA], (float*)(ws + WS_MODP), t); continue; } t -= T_ADA;
        if (t < T_WT1) { const int l = t / 104, nt = t % 104; task_wt(F, in[I_WIN] + (size_t)l * 2048 * PT, PT, (bf16_t*)(ws + WS_WIN) + (size_t)l * PTP * 2048, nt); continue; } t -= T_WT1;
        if (t < T_WT2) { const int l = t / 32, nt = t % 32; task_wt(F, in[I_WOUT] + (size_t)l * 2048 * 2048, 2048, (bf16_t*)(ws + WS_WOUT) + (size_t)l * 2048 * 2048, nt); continue; } t -= T_WT2;
        if (t < T_WT3) { const int l = t / 32, nt = t % 32; task_wt(F, in[I_PWQ] + (size_t)l * 2048 * 2048, 2048, (bf16_t*)(ws + WS_WQ) + (size_t)l * 2048 * 2048, nt); continue; } t -= T_WT3;
        if (t < T_PEER) { const bool isv = t >= 1024; const int c = t & 1023; task_cvt8(F, in[isv ? I_PV : I_PU], ws + (isv ? WS_PV : WS_PU), (size_t)c * 65536, isv ? 1.0f : PEER_U_SCALE); continue; } t -= T_PEER;
        if (t < T_KEYS) { task_cvt(F, in[I_PKEYS], (bf16_t*)(ws + WS_KEYS), (size_t)t * 65536); continue; } t -= T_KEYS;
        if (t < T_LORA) {
            if (t < 8) { const int l = t >> 2, wh = t & 3;
                task_lorat(F, in[wh < 2 ? I_RWUP : I_RAUP] + ((size_t)l * 2 + (wh & 1)) * 64 * 512, (bf16_t*)(ws + WS_WUPT) + ((size_t)l * 4 + wh) * 512 * 64, 64); }
            else { const int l = t - 8; task_lorat(F, in[I_RGUP] + (size_t)l * 128 * 512, (bf16_t*)(ws + WS_GUPT) + (size_t)l * 512 * 128, 128); }
            continue; } t -= T_LORA;
        { float* rope = (float*)(ws + WS_ROPE);
          for (int e = F.tid; e < 2048; e += 512) { const int pos = e >> 5, i = e & 31; const float fr = powf(10000.0f, -(float)i / 32.0f), ang = (float)pos * fr;
              rope[2 * e] = cosf(ang); rope[2 * e + 1] = sinf(ang); } }
    }
}
__device__ __forceinline__ void phase_modreduce(const Ctx& F, const float* b_ada, const float* modp, float* mod) {
    for (int idx = F.bid * 512 + F.tid; idx < 2 * 5 * 12288; idx += F.G * 512) {
        const int l = idx / 61440, rem = idx % 61440, v = rem / 12288, n = rem % 12288;
        float s = b_ada[l * 12288 + n];
        for (int ks = 0; ks < KSPL; ++ks) s += modp[(((size_t)ks * 2 + l) * 5 + v) * 12288 + n];
        mod[idx] = s;
    }
}

__device__ __forceinline__ void norm_store(const float (&x)[32], const float* gw, const float* shift, const float* scale, bf16_t* dst, int lane) {
    float ss = 0.f;
#pragma unroll
    for (int q = 0; q < 32; ++q) ss += x[q] * x[q];
    ss = wave_sum(ss);
    const float rs = rsqrtf(ss * (1.0f / 2048.0f) + 1e-6f);
#pragma unroll
    for (int j = 0; j < 4; ++j) { const int e = j * 512 + lane * 8;
        const float4 g0 = *(const float4*)(gw + e), g1 = *(const float4*)(gw + e + 4), h0 = *(const float4*)(shift + e), h1 = *(const float4*)(shift + e + 4), c0 = *(const float4*)(scale + e), c1 = *(const float4*)(scale + e + 4);
        const float y0 = x[j * 8 + 0] * rs * g0.x * (1.f + c0.x) + h0.x, y1 = x[j * 8 + 1] * rs * g0.y * (1.f + c0.y) + h0.y, y2 = x[j * 8 + 2] * rs * g0.z * (1.f + c0.z) + h0.z, y3 = x[j * 8 + 3] * rs * g0.w * (1.f + c0.w) + h0.w;
        const float y4 = x[j * 8 + 4] * rs * g1.x * (1.f + c1.x) + h1.x, y5 = x[j * 8 + 5] * rs * g1.y * (1.f + c1.y) + h1.y, y6 = x[j * 8 + 6] * rs * g1.z * (1.f + c1.z) + h1.z, y7 = x[j * 8 + 7] * rs * g1.w * (1.f + c1.w) + h1.w;
        u32x4 o; o.x = pk_bf16(y0, y1); o.y = pk_bf16(y2, y3); o.z = pk_bf16(y4, y5); o.w = pk_bf16(y6, y7);
        *(u32x4*)(dst + e) = o; }
}
__device__ __forceinline__ void phase_norm(const Ctx& F, const float* xlat, const float* xctx, const float* gw, const float* mod, int shift_i, int scale_i, bf16_t* dst, int nrows) {
    for (int row = F.bid * 8 + F.wave; row < nrows; row += F.G * 8) {
        const bool isctx = row >= NLAT; const float* xr = isctx ? xctx + (size_t)(row - NLAT) * 2048 : xlat + (size_t)row * 2048;
        const int v = isctx ? 4 : (row >> 12);
        float x[32];
#pragma unroll
        for (int j = 0; j < 4; ++j) { const int e = j * 512 + F.lane * 8; const float4 a = *(const float4*)(xr + e), b = *(const float4*)(xr + e + 4);
            x[j * 8 + 0] = a.x; x[j * 8 + 1] = a.y; x[j * 8 + 2] = a.z; x[j * 8 + 3] = a.w; x[j * 8 + 4] = b.x; x[j * 8 + 5] = b.y; x[j * 8 + 6] = b.z; x[j * 8 + 7] = b.w; }
        norm_store(x, gw, mod + (size_t)v * 12288 + shift_i * 2048, mod + (size_t)v * 12288 + scale_i * 2048, dst + (size_t)row * 2048, F.lane);
    }
}

struct LayerW {
    const float *sc_w, *rw_w0, *rw_wup, *rw_a0, *rw_aup, *rw_gup, *rw_kk, *rw_ka, *rw_rk, *rw_lnw, *rw_lnb, *na_q, *na_k, *rpb, *s_cw, *s_cb, *s_dtb, *s_alog, *s_d, *s_norm;
};
__device__ __forceinline__ void unpack8(const u32x4 q, float (&f)[8]) { f[0] = bflo(q[0]); f[1] = bfhi(q[0]); f[2] = bflo(q[1]); f[3] = bfhi(q[1]); f[4] = bflo(q[2]); f[5] = bfhi(q[2]); f[6] = bflo(q[3]); f[7] = bfhi(q[3]); }
__device__ __forceinline__ u32x4 pack8f(const float (&f)[8]) { u32x4 o; o[0] = pk_bf16(f[0], f[1]); o[1] = pk_bf16(f[2], f[3]); o[2] = pk_bf16(f[4], f[5]); o[3] = pk_bf16(f[6], f[7]); return o; }
__device__ __forceinline__ void load8f(const float* p, float (&f)[8]) { const float4 a = *(const float4*)p, b = *(const float4*)(p + 4); f[0] = a.x; f[1] = a.y; f[2] = a.z; f[3] = a.w; f[4] = b.x; f[5] = b.y; f[6] = b.z; f[7] = b.w; }
__device__ __forceinline__ void phase_prep(const Ctx& F, const LayerW& W, unsigned char* ws) {
    const bf16_t* P = (const bf16_t*)(ws + WS_P);
    bf16_t* MIX = (bf16_t*)(ws + WS_MIX);
    bf16_t* XBC = (bf16_t*)(ws + WS_XBC); float* DTS = (float*)(ws + WS_DTS); float* DEC = (float*)(ws + WS_DEC);
    bf16_t* QN = (bf16_t*)(ws + WS_QN); bf16_t* KN = (bf16_t*)(ws + WS_KN); bf16_t* VTL = (bf16_t*)(ws + WS_VTL); bf16_t* VTC = (bf16_t*)(ws + WS_VTC);
    const float* ROPE = (const float*)(ws + WS_ROPE);
    for (int tile = F.bid; tile < NTOK / 8; tile += F.G) {
        int ln = F.lane; asm volatile("" : "+v"(ln));
        const int ch0 = ln * 8;
        const bool lat = tile < NLAT / 8;
        const int b = lat ? (tile >> 9) : ((tile - NLAT / 8) >> 5);
        const int t0 = lat ? (tile & 511) * 8 : ((tile - NLAT / 8) & 31) * 8;
        const int L = lat ? SEQL : CTXL;
        const int g0 = lat ? b * SEQL + t0 : NLAT + b * CTXL + t0;
        const bf16_t* Pr = P + (size_t)g0 * PTP;
        if (F.wave == 0 || F.wave == 4) {
            const bool gated = F.wave == 0;
            const float* cw = gated ? W.sc_w : W.s_cw; const int cstride = gated ? 512 : 1024;
            float w0[8], w1[8], w2[8], cb[8];
            load8f(cw + ch0, w0); load8f(cw + cstride + ch0, w1); load8f(cw + 2 * cstride + ch0, w2);
            if (gated) {
#pragma unroll
                for (int e = 0; e < 8; ++e) cb[e] = 0.f;
            } else load8f(W.s_cb + ch0, cb);
            const int col = gated ? A_CG : D_X;
#pragma unroll 1
            for (int tb = 0; tb < 8; tb += 4) {
            u32x4 ra[6], rb[6], rg[4];
#pragma unroll
            for (int q = 0; q < 6; ++q) { const int tq = t0 + tb - 1 + q; const bool ok = (tq >= 0) && (tq < L);
                ra[q] = ok ? *(const u32x4*)(Pr + (ptrdiff_t)(tb + q - 1) * PTP + col + ch0) : (u32x4){0u, 0u, 0u, 0u};
                if (gated) rb[q] = ok ? *(const u32x4*)(Pr + (ptrdiff_t)(tb + q - 1) * PTP + A_H + ch0) : (u32x4){0u, 0u, 0u, 0u}; }
            if (gated) {
#pragma unroll
                for (int tt = 0; tt < 4; ++tt) rg[tt] = *(const u32x4*)(Pr + (size_t)(tb + tt) * PTP + A_BG + ch0); }
            float up[8], uc[8], un[8];
            { float x[8], y[8]; unpack8(ra[0], x); if (gated) { unpack8(rb[0], y);
#pragma unroll
                for (int e = 0; e < 8; ++e) x[e] *= y[e]; }
#pragma unroll
              for (int e = 0; e < 8; ++e) up[e] = x[e];
              unpack8(ra[1], x); if (gated) { unpack8(rb[1], y);
#pragma unroll
                for (int e = 0; e < 8; ++e) x[e] *= y[e]; }
#pragma unroll
              for (int e = 0; e < 8; ++e) uc[e] = x[e]; }
#pragma unroll
            for (int tt = 0; tt < 4; ++tt) {
                { float x[8], y[8]; unpack8(ra[tt + 2], x); if (gated) { unpack8(rb[tt + 2], y);
#pragma unroll
                    for (int e = 0; e < 8; ++e) x[e] *= y[e]; }
#pragma unroll
                  for (int e = 0; e < 8; ++e) un[e] = x[e]; }
                float o[8];
                if (gated) { float bg[8]; unpack8(rg[tt], bg);
#pragma unroll
                    for (int e = 0; e < 8; ++e) o[e] = bg[e] * (w0[e] * up[e] + w1[e] * uc[e] + w2[e] * un[e]);
                    *(u32x4*)(MIX + (size_t)(g0 + tb + tt) * 2048 + ch0) = pack8f(o);
                } else {
#pragma unroll
                    for (int e = 0; e < 8; ++e) o[e] = siluf_(w0[e] * up[e] + w1[e] * uc[e] + w2[e] * un[e] + cb[e]);
                    *(u32x4*)(XBC + (size_t)(g0 + tb + tt) * 1024 + ch0) = pack8f(o); }
#pragma unroll
                for (int e = 0; e < 8; ++e) { up[e] = uc[e]; uc[e] = un[e]; }
            }
            }
        } else if (F.wave == 1 || F.wave == 2) {
            const bool isq = F.wave == 1; const int col = isq ? C_Q : C_K; bf16_t* dst = isq ? QN : KN;
            float nw[8]; load8f((isq ? W.na_q : W.na_k) + (ln & 7) * 8, nw);
            const float sc = isq ? 0.125f : 1.0f;
            u32x4 rq[8];
#pragma unroll
            for (int tt = 0; tt < 8; ++tt) rq[tt] = *(const u32x4*)(Pr + (size_t)tt * PTP + col + ch0);
#pragma unroll
            for (int tt = 0; tt < 8; ++tt) { float x[8]; unpack8(rq[tt], x); float ss = 0.f;
#pragma unroll
                for (int e = 0; e < 8; ++e) ss += x[e] * x[e];
                ss = sum8(ss); const float rs = rsqrtf(ss * (1.f / 64.f) + 1e-6f) * sc;
#pragma unroll
                for (int e = 0; e < 8; ++e) x[e] = x[e] * rs * nw[e];
                if (isq) *(u32x4*)(dst + (size_t)(g0 + tt) * 512 + ch0) = pack8f(x);
                else {
                    const int hh = ln >> 3, p = ln & 7, t = t0 + tt;
                    bf16_t* kd = lat ? dst + ((size_t)((((b * 8 + hh) * 64 + (t >> 6)) * 2 + (p >> 2)) * 4 + (p & 3)) * 64 + (t & 63)) * 8
                                     : dst + (size_t)NLAT * 512 + ((size_t)(((b * 8 + hh) * 2 + (p >> 2)) * 4 + (p & 3)) * 256 + t) * 8;
                    *(u32x4*)kd = pack8f(x); } }
        } else if (F.wave == 3) {
            u32x4 rv[8];
#pragma unroll
            for (int tt = 0; tt < 8; ++tt) rv[tt] = *(const u32x4*)(Pr + (size_t)tt * PTP + C_V + ch0);
            const int h = ln >> 3;
#pragma unroll
            for (int e = 0; e < 8; ++e) { const int i = (ln & 7) * 8 + e;
                unsigned short v[8];
#pragma unroll
                for (int tt = 0; tt < 8; ++tt) v[tt] = (unsigned short)((e & 1) ? (rv[tt][e >> 1] >> 16) : (rv[tt][e >> 1] & 0xffffu));
                u32x2 c0; c0.x = (unsigned)v[0] | ((unsigned)v[1] << 16); c0.y = (unsigned)v[2] | ((unsigned)v[3] << 16);
                u32x2 c1; c1.x = (unsigned)v[4] | ((unsigned)v[5] << 16); c1.y = (unsigned)v[6] | ((unsigned)v[7] << 16);
                if (lat) { const int row = t0 >> 6, x0 = (t0 & 63) >> 2, x1 = x0 + 1;
                    bf16_t* base = VTL + ((size_t)((b * 8 + h) * 64 + row) * 12 * 64 + i) * 8;
                    if (x0 <= 11) *(u32x2*)(base + x0 * 512) = c0;
                    if (x0 >= 4)  *(u32x2*)(base + (x0 - 4) * 512 + 4) = c0;
                    if (x1 <= 11) *(u32x2*)(base + x1 * 512) = c1;
                    if (x1 >= 4)  *(u32x2*)(base + (x1 - 4) * 512 + 4) = c1;
                } else { const int m = t0 >> 5, o = t0 & 31, gq = (o & 15) >> 2, hf = (o >> 4) * 4;
                    bf16_t* base = VTC + ((size_t)(((b * 8 + h) * 8 + m) * 4) * 64 + i) * 8;
                    *(u32x2*)(base + gq * 512 + hf) = c0; *(u32x2*)(base + (gq + 1) * 512 + hf) = c1; } }
        } else if (F.wave == 5) {
            if (ln < 32) {
                const int pg = ln, which = pg >> 4, gi = (pg >> 3) & 1, half = (pg >> 2) & 1, i0 = (pg & 3) * 8;
                const int c1 = 512 + which * 256 + gi * 128 + half * 64 + i0, c2 = c1 + 32;
                float wa0[8], wa1[8], wa2[8], ba[8], wb0[8], wb1[8], wb2[8], bb[8];
                load8f(W.s_cw + c1, wa0); load8f(W.s_cw + 1024 + c1, wa1); load8f(W.s_cw + 2048 + c1, wa2); load8f(W.s_cb + c1, ba);
                load8f(W.s_cw + c2, wb0); load8f(W.s_cw + 1024 + c2, wb1); load8f(W.s_cw + 2048 + c2, wb2); load8f(W.s_cb + c2, bb);
#pragma unroll 1
                for (int tb = 0; tb < 8; tb += 2) {
                u32x4 ra[4], rb[4];
#pragma unroll
                for (int q = 0; q < 4; ++q) { const int tq = t0 + tb - 1 + q; const bool ok = (tq >= 0) && (tq < L);
                    ra[q] = ok ? *(const u32x4*)(Pr + (ptrdiff_t)(tb + q - 1) * PTP + D_X + c1) : (u32x4){0u, 0u, 0u, 0u};
                    rb[q] = ok ? *(const u32x4*)(Pr + (ptrdiff_t)(tb + q - 1) * PTP + D_X + c2) : (u32x4){0u, 0u, 0u, 0u}; }
                float ap[8], ac[8], an[8], bp[8], bc[8], bn[8];
                unpack8(ra[0], ap); unpack8(ra[1], ac); unpack8(rb[0], bp); unpack8(rb[1], bc);
#pragma unroll
                for (int tt = 0; tt < 2; ++tt) { unpack8(ra[tt + 2], an); unpack8(rb[tt + 2], bn);
                    float y1[8], y2[8];
#pragma unroll
                    for (int e = 0; e < 8; ++e) { y1[e] = siluf_(wa0[e] * ap[e] + wa1[e] * ac[e] + wa2[e] * an[e] + ba[e]); y2[e] = siluf_(wb0[e] * bp[e] + wb1[e] * bc[e] + wb2[e] * bn[e] + bb[e]); }
                    if (lat) { const int t = t0 + tb + tt, pos = half ? (t & 63) : (t >> 6);
                        float cs[16];
#pragma unroll
                        for (int q = 0; q < 4; ++q) { const float4 v = *(const float4*)(ROPE + (size_t)(pos * 32 + i0) * 2 + 4 * q); cs[4 * q] = v.x; cs[4 * q + 1] = v.y; cs[4 * q + 2] = v.z; cs[4 * q + 3] = v.w; }
#pragma unroll
                        for (int e = 0; e < 8; ++e) { const float o1 = y1[e] * cs[2 * e] - y2[e] * cs[2 * e + 1], o2 = y1[e] * cs[2 * e + 1] + y2[e] * cs[2 * e]; y1[e] = o1; y2[e] = o2; } }
                    *(u32x4*)(XBC + (size_t)(g0 + tb + tt) * 1024 + c1) = pack8f(y1); *(u32x4*)(XBC + (size_t)(g0 + tb + tt) * 1024 + c2) = pack8f(y2);
#pragma unroll
                    for (int e = 0; e < 8; ++e) { ap[e] = ac[e]; ac[e] = an[e]; bp[e] = bc[e]; bc[e] = bn[e]; }
                }
                }
            }
        } else if (F.wave == 6) {
#pragma unroll
            for (int q = 0; q < 2; ++q) { const int it = ln + 64 * q, tt = it >> 4, j = it & 15;
                const float x = bf2f(Pr[(size_t)tt * PTP + D_DT + j]) + W.s_dtb[j];
                const float sp = fmaxf(x, 0.f) + log1pf(__expf(-fabsf(x)));
                DTS[(size_t)(g0 + tt) * 16 + j] = sp; DEC[(size_t)(g0 + tt) * 16 + j] = -sp * __expf(W.s_alog[j]); }
        }
    }
}

constexpr int SB_PITCH = 136;
__device__ __forceinline__ void ssd_scan_L(const Ctx& F, LAS float* sL, const float* LA, int g0, int h) {
    const int d = (F.tid >> 7) & 1, t = F.tid & 127;
    float v = 0.f;
    if (F.tid < 256) { v = LA[(size_t)(g0 + t) * 16 + d * 8 + h]; sL[F.tid] = v; }
    __syncthreads();
#pragma unroll
    for (int off = 1; off < 128; off <<= 1) {
        float o = 0.f;
        if (F.tid < 256) { const int tp = d ? t + off : t - off; if (tp >= 0 && tp < 128) o = sL[d * 128 + tp]; }
        __syncthreads();
        if (F.tid < 256) { v += o; sL[F.tid] = v; }
        __syncthreads();
    }
}
template <bool PASS2>
__device__ __forceinline__ void ssd_task(const Ctx& F, const LayerW& W, unsigned char* ws, int task) {
    const bf16_t* XBC = (const bf16_t*)(ws + WS_XBC); const float* DTS = (const float*)(ws + WS_DTS); const float* LA = (const float*)(ws + WS_DEC);
    float* SST = (float*)(ws + WS_SST); float* SCD = (float*)(ws + WS_SCD); float* YS = (float*)(ws + WS_YS);
    const int c = task % NCH, bh = task / NCH, h = bh & 7, b = bh >> 3, gi = h >> 2;
    const int g0 = c < 2 ? NLAT + b * CTXL + c * 128 : b * SEQL + (c - 2) * 128;
    const int w = F.wave, l16 = F.lane & 15, g = F.lane >> 4;
    const f32x4 z4 = {0.f, 0.f, 0.f, 0.f};
    LAS float* sL = (LAS float*)(F.lds + 131072);
    LAS float* sDT = sL + 256;
    __syncthreads();
    if (F.tid < 256) { const int s = F.tid >> 1, d = F.tid & 1; sDT[F.tid] = DTS[(size_t)(g0 + s) * 16 + d * 8 + h]; }
    ssd_scan_L(F, sL, LA, g0, h);
    if (!PASS2) {
        LAS bf16_t* sBT = (LAS bf16_t*)F.lds;
        LAS bf16_t* sXT = sBT + 128 * SB_PITCH;
#pragma unroll
        for (int q = 0; q < 4; ++q) { const int v = F.tid + 512 * q, s = v >> 4, part = v & 15;
            const u32x4 bv = *(const u32x4*)(XBC + (size_t)(g0 + s) * 1024 + 512 + gi * 128 + part * 8);
#pragma unroll
            for (int e = 0; e < 4; ++e) { sBT[(part * 8 + 2 * e) * SB_PITCH + s] = (bf16_t)(bv[e] & 0xffffu); sBT[(part * 8 + 2 * e + 1) * SB_PITCH + s] = (bf16_t)(bv[e] >> 16); } }
#pragma unroll
        for (int q = 0; q < 2; ++q) { const int v = F.tid + 512 * q, s = v >> 3, part = v & 7;
            const u32x4 xv = *(const u32x4*)(XBC + (size_t)(g0 + s) * 1024 + h * 64 + part * 8);
            const float sc0 = sDT[s * 2] * __expf(sL[127] - sL[s]), sc1 = sDT[s * 2 + 1] * __expf(sL[128] - sL[128 + s]);
#pragma unroll
            for (int e = 0; e < 4; ++e) { const float lo = bflo(xv[e]), hi = bfhi(xv[e]); const int p = part * 8 + 2 * e;
                sXT[p * SB_PITCH + s] = f2bf(lo * sc0); sXT[(p + 1) * SB_PITCH + s] = f2bf(hi * sc0);
                sXT[(64 + p) * SB_PITCH + s] = f2bf(lo * sc1); sXT[(64 + p + 1) * SB_PITCH + s] = f2bf(hi * sc1); } }
        __syncthreads();
        bf16x8 bfr[4];
#pragma unroll
        for (int ks = 0; ks < 4; ++ks) bfr[ks] = *(const LAS bf16x8*)(sBT + (16 * w + l16) * SB_PITCH + 32 * ks + 8 * g);
#pragma unroll
        for (int d = 0; d < 2; ++d) {
            float* st = SST + ((size_t)((b * 8 + h) * 2 + d) * NCH + c) * 8192;
#pragma unroll
            for (int pt = 0; pt < 4; ++pt) { f32x4 acc = z4;
#pragma unroll
                for (int ks = 0; ks < 4; ++ks) acc = __builtin_amdgcn_mfma_f32_16x16x32_bf16(*(const LAS bf16x8*)(sXT + (d * 64 + 16 * pt + l16) * SB_PITCH + 32 * ks + 8 * g), bfr[ks], acc, 0, 0, 0);
#pragma unroll
                for (int r = 0; r < 4; ++r) st[(16 * pt + 4 * g + r) * 128 + 16 * w + l16] = acc[r]; }
            if (F.tid == 0) SCD[((b * 8 + h) * 2 + d) * NCH + c] = __expf(d ? sL[128] : sL[127]);
        }
    } else {
        LAS bf16_t* sB = (LAS bf16_t*)F.lds;
        LAS bf16_t* sC = sB + 128 * SB_PITCH;
        LAS bf16_t* sXT = sC + 128 * SB_PITCH;
        LAS bf16_t* sS = sXT + 64 * SB_PITCH;
#pragma unroll
        for (int q = 0; q < 4; ++q) { const int v = F.tid + 512 * q, s = v >> 4, part = v & 15;
            *(LAS u32x4*)(sB + s * SB_PITCH + part * 8) = *(const u32x4*)(XBC + (size_t)(g0 + s) * 1024 + 512 + gi * 128 + part * 8);
            *(LAS u32x4*)(sC + s * SB_PITCH + part * 8) = *(const u32x4*)(XBC + (size_t)(g0 + s) * 1024 + 768 + gi * 128 + part * 8); }
#pragma unroll
        for (int q = 0; q < 2; ++q) { const int v = F.tid + 512 * q, s = v >> 3, part = v & 7;
            const u32x4 xv = *(const u32x4*)(XBC + (size_t)(g0 + s) * 1024 + h * 64 + part * 8);
#pragma unroll
            for (int e = 0; e < 4; ++e) { sXT[(part * 8 + 2 * e) * SB_PITCH + s] = (bf16_t)(xv[e] & 0xffffu); sXT[(part * 8 + 2 * e + 1) * SB_PITCH + s] = (bf16_t)(xv[e] >> 16); } }
#pragma unroll
        for (int q = 0; q < 4; ++q) { const int v = F.tid + 512 * q, d = v >> 10, p = (v >> 4) & 63, part = v & 15;
            const float* sp = SST + ((size_t)((b * 8 + h) * 2 + d) * NCH + c) * 8192 + p * 128 + part * 8;
            const float4 a0 = *(const float4*)sp, a1 = *(const float4*)(sp + 4);
            u32x4 o; o.x = pk_bf16(a0.x, a0.y); o.y = pk_bf16(a0.z, a0.w); o.z = pk_bf16(a1.x, a1.y); o.w = pk_bf16(a1.z, a1.w);
            *(LAS u32x4*)(sS + (d * 64 + p) * SB_PITCH + part * 8) = o; }
        __syncthreads();
        const int t = 16 * w + l16;
        bf16x8 cfr[4];
#pragma unroll
        for (int ks = 0; ks < 4; ++ks) cfr[ks] = *(const LAS bf16x8*)(sC + t * SB_PITCH + 32 * ks + 8 * g);
        f32x4 gt[8];
#pragma unroll
        for (int a = 0; a < 8; ++a) { f32x4 acc = z4;
#pragma unroll
            for (int ks = 0; ks < 4; ++ks) acc = __builtin_amdgcn_mfma_f32_16x16x32_bf16(*(const LAS bf16x8*)(sB + (16 * a + l16) * SB_PITCH + 32 * ks + 8 * g), cfr[ks], acc, 0, 0, 0);
            gt[a] = acc; }
        f32x4 ysum[4] = {z4, z4, z4, z4};
#pragma unroll
        for (int d = 0; d < 2; ++d) {
            const float Lt = sL[d * 128 + t], eLt = __expf(Lt);
            f32x4 acc[4];
#pragma unroll
            for (int pt = 0; pt < 4; ++pt) { f32x4 a = z4;
#pragma unroll
                for (int ks = 0; ks < 4; ++ks) a = __builtin_amdgcn_mfma_f32_16x16x32_bf16(*(const LAS bf16x8*)(sS + (d * 64 + 16 * pt + l16) * SB_PITCH + 32 * ks + 8 * g), cfr[ks], a, 0, 0, 0);
                acc[pt] = a * eLt; }
#pragma unroll
            for (int m = 0; m < 4; ++m) {
                const bool need = d ? (2 * m + 1 >= w) : (2 * m <= w);
                if (need) {
                    f32x4 wt[2];
#pragma unroll
                    for (int u = 0; u < 2; ++u) { const int a = 2 * m + u;
                        const f32x4 Ls = *(const LAS f32x4*)(sL + d * 128 + 16 * a + 4 * g);
#pragma unroll
                        for (int r = 0; r < 4; ++r) { const int s = 16 * a + 4 * g + r; const bool ok = d ? (s >= t) : (s <= t);
                            const float dts = sDT[s * 2 + d];
                            wt[u][r] = ok ? gt[a][r] * __expf(Lt - Ls[r]) * dts : 0.f; } }
                    const bf16x8 bfrag = pack8(wt[0], wt[1]);
#pragma unroll
                    for (int pt = 0; pt < 4; ++pt) { union { bf16x8 v; u32x2 hh[2]; } af;
                        af.hh[0] = *(const LAS u32x2*)(sXT + (16 * pt + l16) * SB_PITCH + 32 * m + 4 * g); af.hh[1] = *(const LAS u32x2*)(sXT + (16 * pt + l16) * SB_PITCH + 32 * m + 16 + 4 * g);
                        acc[pt] = __builtin_amdgcn_mfma_f32_16x16x32_bf16(af.v, bfrag, acc[pt], 0, 0, 0); }
                }
            }
#pragma unroll
            for (int pt = 0; pt < 4; ++pt) ysum[pt] = ysum[pt] + acc[pt];
        }
        const float dsk = W.s_d[h];
#pragma unroll
        for (int pt = 0; pt < 4; ++pt) { const int p = 16 * pt + 4 * g;
            const u32x2 xv = *(const u32x2*)(XBC + (size_t)(g0 + t) * 1024 + h * 64 + p);
            *(float4*)(YS + (size_t)(g0 + t) * 512 + h * 64 + p) = make_float4(ysum[pt][0] + dsk * bflo(xv.x), ysum[pt][1] + dsk * bfhi(xv.x), ysum[pt][2] + dsk * bflo(xv.y), ysum[pt][3] + dsk * bfhi(xv.y)); }
    }
}
template <int D> __device__ __forceinline__ void ssd_combine_one(float4* base, const float* scd) {
    float4 carry = make_float4(0.f, 0.f, 0.f, 0.f);
#pragma unroll
    for (int k0 = 0; k0 < NCH; k0 += 17) {
        float4 tmp[17];
#pragma unroll
        for (int k = 0; k < 17; ++k) { const int kk = k0 + k, c = D ? (kk < 2 ? 1 - kk : 35 - kk) : kk; tmp[k] = base[(size_t)c * 2048]; }
#pragma unroll
        for (int k = 0; k < 17; ++k) { const int kk = k0 + k, c = D ? (kk < 2 ? 1 - kk : 35 - kk) : kk; const float a = scd[c];
            base[(size_t)c * 2048] = carry;
            carry.x = a * carry.x + tmp[k].x; carry.y = a * carry.y + tmp[k].y; carry.z = a * carry.z + tmp[k].z; carry.w = a * carry.w + tmp[k].w; }
    }
}
__device__ __forceinline__ void phase_ssd_combine(const Ctx& F, unsigned char* ws) {
    float4* SST4 = (float4*)(ws + WS_SST); const float* SCD = (const float*)(ws + WS_SCD);
    for (int gt = F.bid * 512 + F.tid; gt < 64 * 2048; gt += F.G * 512) {
        const int sidx = gt >> 11, e4 = gt & 2047;
        float4* base = SST4 + (size_t)sidx * NCH * 2048 + e4;
        if (sidx & 1) ssd_combine_one<1>(base, SCD + sidx * NCH); else ssd_combine_one<0>(base, SCD + sidx * NCH);
    }
}

constexpr int RWF_CHUNK = 10496;
constexpr int RW_NCHUNK = NPOS / 16;
template <int CTRL> __device__ __forceinline__ float dpp_id1(float v) { return __int_as_float(__builtin_amdgcn_update_dpp(0x3f800000, __float_as_int(v), CTRL, 0xF, 0xF, false)); }
__device__ __forceinline__ float sel4(int g, float a, float b, float c, float d) { return g == 0 ? a : (g == 1 ? b : (g == 2 ? c : d)); }

template <int D> __device__ __forceinline__ void rwkv_pre_dir(const bf16_t* wupt, const bf16x8 (&bw)[2], const bf16x8 (&ba)[2], const f32x4 (&kk)[4], const f32x4 (&rr)[4], const f32x4 (&kx)[4],
        const float* w0p, const float* a0p, const float* kap, const float* rkp, float& bon, LAS unsigned char* wl, unsigned char* dst, int l16, int g) {
    LAS float* LT = (LAS float*)wl; LAS float* AT = LT + 256; LAS bf16_t* BT = (LAS bf16_t*)(wl + 2048); LAS bf16_t* KT = BT + 1024;
    const int lane = g * 16 + l16;
    bf16x8* o = (bf16x8*)dst;
    const f32x4 z4 = {0.f, 0.f, 0.f, 0.f};
    bf16x8 af[2], bf[2], kf[2], rf[2];
#pragma unroll
    for (int p = 0; p < 2; ++p) {
        f32x4 al[2], be[2], ka[2], rh[2];
#pragma unroll
        for (int mm = 0; mm < 2; ++mm) { const int m = 2 * p + mm; asm volatile("" ::: "memory");
            const bf16_t* wpw = wupt + ((size_t)D * 512 + 16 * m + l16) * 64 + 8 * g; const bf16_t* wpa = wupt + ((size_t)(2 + D) * 512 + 16 * m + l16) * 64 + 8 * g;
            f32x4 aw = __builtin_amdgcn_mfma_f32_16x16x32_bf16(*(const bf16x8*)wpw, bw[0], z4, 0, 0, 0); aw = __builtin_amdgcn_mfma_f32_16x16x32_bf16(*(const bf16x8*)(wpw + 32), bw[1], aw, 0, 0, 0);
            f32x4 aa = __builtin_amdgcn_mfma_f32_16x16x32_bf16(*(const bf16x8*)wpa, ba[0], z4, 0, 0, 0); aa = __builtin_amdgcn_mfma_f32_16x16x32_bf16(*(const bf16x8*)(wpa + 32), ba[1], aa, 0, 0, 0);
            const float4 w0 = *(const float4*)(w0p + 16 * m + 4 * g), a0 = *(const float4*)(a0p + 16 * m + 4 * g), kav = *(const float4*)(kap + 16 * m + 4 * g), rkv = *(const float4*)(rkp + 16 * m + 4 * g);
            const float w0a[4] = {w0.x, w0.y, w0.z, w0.w}, a0a[4] = {a0.x, a0.y, a0.z, a0.w}, kaa[4] = {kav.x, kav.y, kav.z, kav.w}, rka[4] = {rkv.x, rkv.y, rkv.z, rkv.w};
            f32x4 gcv;
#pragma unroll
            for (int r = 0; r < 4; ++r) {
                const float w = __expf(-0.6065306597126334f * sigmoidf_(w0a[r] + aw[r])), a = sigmoidf_(a0a[r] + aa[r]);
                const float kd = kx[m][r] * (1.f + (a - 1.f) * kaa[r]), bb = kk[m][r] * a;
                bon += rr[m][r] * kd * rka[r];
                float G = w;
                if (D == 0) { G *= dpp_id1<0x111>(G); G *= dpp_id1<0x112>(G); G *= dpp_id1<0x114>(G); G *= dpp_id1<0x118>(G); }
                else        { G *= dpp_id1<0x101>(G); G *= dpp_id1<0x102>(G); G *= dpp_id1<0x104>(G); G *= dpp_id1<0x108>(G); }
                const float Gex = (D == 0) ? dpp_id1<0x111>(G) : dpp_id1<0x101>(G);
                const float iG = rcpf_(G);
                al[mm][r] = Gex * kk[m][r]; be[mm][r] = bb * iG; ka[mm][r] = kd * iG; rh[mm][r] = G * rr[m][r]; gcv[r] = G;
                const int k = 16 * m + 4 * g + r; BT[k * 16 + l16] = f2bf(be[mm][r]); KT[k * 16 + l16] = f2bf(ka[mm][r]);
            }
            if (l16 == ((D == 0) ? 15 : 0)) *(float4*)((float*)(dst + 10240) + 16 * m + 4 * g) = make_float4(gcv[0], gcv[1], gcv[2], gcv[3]);
        }
        af[p] = pack8(al[0], al[1]); bf[p] = pack8(be[0], be[1]); kf[p] = pack8(ka[0], ka[1]); rf[p] = pack8(rh[0], rh[1]);
        o[64 * p + lane] = af[p]; o[128 + 64 * p + lane] = rf[p];
        __builtin_amdgcn_sched_barrier(0);
    }
    f32x4 Lm = __builtin_amdgcn_mfma_f32_16x16x32_bf16(af[0], bf[0], z4, 0, 0, 0); Lm = __builtin_amdgcn_mfma_f32_16x16x32_bf16(af[1], bf[1], Lm, 0, 0, 0);
    f32x4 Am = __builtin_amdgcn_mfma_f32_16x16x32_bf16(af[0], kf[0], z4, 0, 0, 0); Am = __builtin_amdgcn_mfma_f32_16x16x32_bf16(af[1], kf[1], Am, 0, 0, 0);
    f32x4 Bb = __builtin_amdgcn_mfma_f32_16x16x32_bf16(bf[0], rf[0], z4, 0, 0, 0); Bb = __builtin_amdgcn_mfma_f32_16x16x32_bf16(bf[1], rf[1], Bb, 0, 0, 0);
    f32x4 Bk = __builtin_amdgcn_mfma_f32_16x16x32_bf16(kf[0], rf[0], z4, 0, 0, 0); Bk = __builtin_amdgcn_mfma_f32_16x16x32_bf16(kf[1], rf[1], Bk, 0, 0, 0);
#pragma unroll
    for (int r = 0; r < 4; ++r) { const int row = 4 * g + r;
        const bool strict = (D == 0) ? (l16 < row) : (l16 > row);
        const bool incl = (D == 0) ? (row <= l16) : (row >= l16);
        Lm[r] = strict ? Lm[r] : 0.f; Am[r] = strict ? Am[r] : 0.f; Bb[r] = incl ? Bb[r] : 0.f; Bk[r] = incl ? Bk[r] : 0.f; }
    *(LAS f32x4*)(LT + l16 * 16 + 4 * g) = Lm; *(LAS f32x4*)(AT + l16 * 16 + 4 * g) = Am;
    o[320 + lane] = pack8(Bb, Bk);
    asm volatile("" ::: "memory");
#pragma unroll
    for (int m = 0; m < 4; ++m) { union { bf16x8 v; u32x2 h[2]; } f;
        f.h[0] = *(LAS u32x2*)(BT + (16 * m + l16) * 16 + 4 * g); f.h[1] = *(LAS u32x2*)(KT + (16 * m + l16) * 16 + 4 * g);
        o[384 + 64 * m + lane] = f.v; }
    __builtin_amdgcn_sched_barrier(0);
    float x[16];
    if (D == 0) {
#pragma unroll
        for (int c = 15; c >= 0; --c) { float s = (c == l16) ? 1.f : 0.f; asm volatile("" ::: "memory");
#pragma unroll
            for (int i = c + 1; i < 16; ++i) s -= x[i] * LT[c * 16 + i];
            x[c] = s; }
    } else {
#pragma unroll
        for (int c = 0; c < 16; ++c) { float s = (c == l16) ? 1.f : 0.f; asm volatile("" ::: "memory");
#pragma unroll
            for (int i = 0; i < c; ++i) s -= x[i] * LT[c * 16 + i];
            x[c] = s; }
    }
    f32x4 tm0, tm1;
#pragma unroll
    for (int r = 0; r < 4; ++r) tm0[r] = -sel4(g, x[r], x[4 + r], x[8 + r], x[12 + r]);
#pragma unroll
    for (int r = 0; r < 4; ++r) { float yv[4];
#pragma unroll
        for (int q = 0; q < 4; ++q) { const int c = 4 * q + r; float s = 0.f; asm volatile("" ::: "memory");
#pragma unroll
            for (int i = 0; i < 16; ++i) if ((D == 0) ? (i > c) : (i < c)) s += x[i] * AT[c * 16 + i];
            yv[q] = s; }
        tm1[r] = -sel4(g, yv[0], yv[1], yv[2], yv[3]); }
    o[256 + lane] = pack8(tm0, tm1);
    asm volatile("" ::: "memory");
}
__device__ __forceinline__ void rwkv_pre_task(const Ctx& F, const LayerW& W, unsigned char* ws, const bf16_t* WUPT, int task, int dsel) {
    const bf16_t* P = (const bf16_t*)(ws + WS_P); float* BON = (float*)(ws + WS_BON); unsigned char* RWF = ws + WS_RWF;
    const int cidx = task % RW_NCHUNK, bh = task / RW_NCHUNK, h = bh & 7, b = bh >> 3;
    int ln_ = F.lane; asm volatile("" : "+v"(ln_));
    const int l16 = ln_ & 15, g = ln_ >> 4;
    const int pos = cidx * 16 + l16;
    const int tok = pos < CTXL ? NLAT + b * CTXL + pos : b * SEQL + (pos - CTXL);
    const bf16_t* Pr = P + (size_t)tok * PTP;
    LAS unsigned char* wl = F.lds + F.wave * 8192;
    bf16x8 bw[2], ba[2];
#pragma unroll
    for (int p = 0; p < 2; ++p) { const u32x4 q = *(const u32x4*)(Pr + B_WD + 32 * p + 8 * g); union { bf16x8 v; unsigned u[4]; } tq;
#pragma unroll
        for (int e = 0; e < 4; ++e) tq.u[e] = pk_bf16(tanhf_(bflo(q[e])), tanhf_(bfhi(q[e])));
        bw[p] = tq.v; ba[p] = *(const bf16x8*)(Pr + B_AD + 32 * p + 8 * g); }
    f32x4 kk[4], rr[4], kx[4];
    float ssq = 0.f;
#pragma unroll
    for (int m = 0; m < 4; ++m) { const int co = h * 64 + 16 * m + 4 * g;
        const u32x2 rq = *(const u32x2*)(Pr + B_R + co), kq = *(const u32x2*)(Pr + B_K + co); const float4 kkw = *(const float4*)(W.rw_kk + co);
        rr[m] = (f32x4){bflo(rq.x), bfhi(rq.x), bflo(rq.y), bfhi(rq.y)}; kx[m] = (f32x4){bflo(kq.x), bfhi(kq.x), bflo(kq.y), bfhi(kq.y)};
        kk[m] = (f32x4){kx[m][0] * kkw.x, kx[m][1] * kkw.y, kx[m][2] * kkw.z, kx[m][3] * kkw.w};
        ssq += kk[m][0] * kk[m][0] + kk[m][1] * kk[m][1] + kk[m][2] * kk[m][2] + kk[m][3] * kk[m][3]; }
    ssq += xor16_f(ssq); ssq = sum_x32(ssq);
    { const float rn = rsqrtf(ssq + 1e-12f);
#pragma unroll
      for (int m = 0; m < 4; ++m) kk[m] = kk[m] * rn; }
    float bon = 0.f;
    const int co = h * 64;
    const int c0 = cidx, c1 = cidx < 16 ? 15 - cidx : 287 - cidx;
    if (dsel == 0) rwkv_pre_dir<0>(WUPT + (size_t)co * 64, bw, ba, kk, rr, kx, W.rw_w0 + co, W.rw_a0 + co, W.rw_ka + co, W.rw_rk + co, bon, wl, RWF + ((size_t)(bh * 2 + 0) * RW_NCHUNK + c0) * RWF_CHUNK, l16, g);
    else           rwkv_pre_dir<1>(WUPT + (size_t)co * 64, bw, ba, kk, rr, kx, W.rw_w0 + 512 + co, W.rw_a0 + 512 + co, W.rw_ka + co, W.rw_rk + co, bon, wl, RWF + ((size_t)(bh * 2 + 1) * RW_NCHUNK + c1) * RWF_CHUNK, l16, g);
    bon += xor16_f(bon); bon = sum_x32(bon);
    if (g == 0) BON[((size_t)dsel * NTOK + tok) * 8 + h] = bon;
}
struct RwFrag { bf16x8 a0, a1, r0, r1, tm, bb, bk0, bk1, bk2, bk3; f32x4 g0, g1, g2, g3; u32x2 v; };
__device__ __forceinline__ void rwkv_scan(const Ctx& F, unsigned char* ws, int sidx) {
    if (F.wave >= 4) return;
    const bf16_t* P = (const bf16_t*)(ws + WS_P); bf16_t* RWY = (bf16_t*)(ws + WS_RWY);
    const int d = sidx & 1, h = (sidx >> 1) & 7, b = sidx >> 4, n = F.wave, l16 = F.lane & 15, g = F.lane >> 4;
    const unsigned char* base = ws + WS_RWF + (size_t)sidx * RW_NCHUNK * RWF_CHUNK;
    const int vcol = B_V + h * 64 + 16 * n + l16;
#define RW_CIDX(c) (d ? ((c) < 16 ? 15 - (c) : 287 - (c)) : (c))
#define RW_TOK(cidx, i) (((cidx) * 16 + (i)) < CTXL ? NLAT + b * CTXL + (cidx) * 16 + (i) : b * SEQL + ((cidx) * 16 + (i) - CTXL))
#define RW_LOADF(fr, c) do { const bf16x8* q_ = (const bf16x8*)(base + (size_t)(c) * RWF_CHUNK) + F.lane; \
        fr.a0 = q_[0]; fr.a1 = q_[64]; fr.r0 = q_[128]; fr.r1 = q_[192]; fr.tm = q_[256]; fr.bb = q_[320]; fr.bk0 = q_[384]; fr.bk1 = q_[448]; fr.bk2 = q_[512]; fr.bk3 = q_[576]; \
        const f32x4* gp_ = (const f32x4*)(base + (size_t)(c) * RWF_CHUNK + 10240) + g; fr.g0 = gp_[0]; fr.g1 = gp_[4]; fr.g2 = gp_[8]; fr.g3 = gp_[12]; \
        const int ci_ = RW_CIDX(c); unsigned short v_[4]; _Pragma("unroll") for (int j_ = 0; j_ < 4; ++j_) v_[j_] = P[(size_t)RW_TOK(ci_, 4 * g + j_) * PTP + vcol]; \
        fr.v.x = (unsigned)v_[0] | ((unsigned)v_[1] << 16); fr.v.y = (unsigned)v_[2] | ((unsigned)v_[3] << 16); } while (0)
    f32x4 st0 = {0.f, 0.f, 0.f, 0.f}, st1 = st0, st2 = st0, st3 = st0;
    const f32x4 z4 = {0.f, 0.f, 0.f, 0.f};
#define RW_STEP(fr, c) do { \
        const bf16x8 s0_ = pack8(st0, st1), s1_ = pack8(st2, st3); \
        f32x4 x1_ = __builtin_amdgcn_mfma_f32_16x16x32_bf16(fr.a0, s0_, z4, 0, 0, 0); x1_ = __builtin_amdgcn_mfma_f32_16x16x32_bf16(fr.a1, s1_, x1_, 0, 0, 0); \
        f32x4 x2_ = __builtin_amdgcn_mfma_f32_16x16x32_bf16(fr.r0, s0_, z4, 0, 0, 0); x2_ = __builtin_amdgcn_mfma_f32_16x16x32_bf16(fr.r1, s1_, x2_, 0, 0, 0); \
        union { bf16x8 v; unsigned u[4]; } bx_; bx_.u[0] = pk_bf16(x1_[0], x1_[1]); bx_.u[1] = pk_bf16(x1_[2], x1_[3]); bx_.u[2] = fr.v.x; bx_.u[3] = fr.v.y; \
        const f32x4 e_ = __builtin_amdgcn_mfma_f32_16x16x32_bf16(fr.tm, bx_.v, z4, 0, 0, 0); \
        union { bf16x8 v; unsigned u[4]; } be_; be_.u[0] = pk_bf16(e_[0], e_[1]); be_.u[1] = pk_bf16(e_[2], e_[3]); be_.u[2] = fr.v.x; be_.u[3] = fr.v.y; \
        const f32x4 o_ = __builtin_amdgcn_mfma_f32_16x16x32_bf16(fr.bb, be_.v, x2_, 0, 0, 0); \
        st0 = __builtin_amdgcn_mfma_f32_16x16x32_bf16(fr.bk0, be_.v, st0, 0, 0, 0) * fr.g0; st1 = __builtin_amdgcn_mfma_f32_16x16x32_bf16(fr.bk1, be_.v, st1, 0, 0, 0) * fr.g1; \
        st2 = __builtin_amdgcn_mfma_f32_16x16x32_bf16(fr.bk2, be_.v, st2, 0, 0, 0) * fr.g2; st3 = __builtin_amdgcn_mfma_f32_16x16x32_bf16(fr.bk3, be_.v, st3, 0, 0, 0) * fr.g3; \
        const int ci_ = RW_CIDX(c); \
        _Pragma("unroll") for (int j_ = 0; j_ < 4; ++j_) RWY[((size_t)d * NTOK + RW_TOK(ci_, 4 * g + j_)) * 512 + h * 64 + 16 * n + l16] = f2bf(o_[j_]); } while (0)
    RwFrag fa, fb, fc;
#define RW_CL(c) ((c) < RW_NCHUNK ? (c) : RW_NCHUNK - 1)
    RW_LOADF(fa, 0); RW_LOADF(fb, 1);
    int c = 0;
    for (; c + 3 <= RW_NCHUNK; c += 3) {
        RW_LOADF(fc, RW_CL(c + 2)); RW_STEP(fa, c);
        RW_LOADF(fa, RW_CL(c + 3)); RW_STEP(fb, c + 1);
        RW_LOADF(fb, RW_CL(c + 4)); RW_STEP(fc, c + 2);
    }
    if (c < RW_NCHUNK) { RW_STEP(fa, c); if (c + 1 < RW_NCHUNK) RW_STEP(fb, c + 1); }
#undef RW_CL
#undef RW_CIDX
#undef RW_TOK
#undef RW_LOADF
#undef RW_STEP
}

__device__ __forceinline__ void na_tile(const Ctx& F, unsigned char* ws, const LAS float* sBias, int tile) {
    const bf16_t* QN = (const bf16_t*)(ws + WS_QN); const bf16_t* KN = (const bf16_t*)(ws + WS_KN);
    const bf16_t* VTL = (const bf16_t*)(ws + WS_VTL); const bf16_t* VTC = (const bf16_t*)(ws + WS_VTC); bf16_t* MIX = (bf16_t*)(ws + WS_MIX);
    const int h = F.wave, l16 = F.lane & 15, g = F.lane >> 4;
    const bool lat = tile < 1024;
    int b, r = 0, j = 0, gq;
    if (lat) { b = tile >> 8; r = (tile >> 2) & 63; j = tile & 3; gq = b * SEQL + r * 64 + j * 16 + l16; }
    else { const int tc = tile - 1024; b = tc >> 4; gq = NLAT + b * CTXL + (tc & 15) * 16 + l16; }
    const int row0 = min(max(r - 4, 0), 56), col0 = min(max(16 * j - 8, 0), 32);
    bf16x8 qf0, qf1;
    { const bf16_t* qp = QN + (size_t)gq * 512 + h * 64 + g * 8; qf0 = *(const bf16x8*)qp; qf1 = *(const bf16x8*)(qp + 32); }
    const f32x4 zero4 = {0.f, 0.f, 0.f, 0.f};
    const int cq = 16 * j + l16, win0 = min(max(cq - 8, 0), 48);
    const bf16_t* knb = KN + ((size_t)((((b * 8 + h) * 64 + row0) * 2) * 4 + g) * 64 + col0 + l16) * 8;
    const bf16_t* kcx = KN + (size_t)NLAT * 512 + ((size_t)(((b * 8 + h) * 2) * 4 + g) * 256 + l16) * 8;
    const bf16_t* vnb = VTL + ((size_t)(((b * 8 + h) * 64 + row0) * 12 + col0 / 4 + g) * 64 + l16) * 8;
    const bf16_t* vcx = VTC + ((size_t)(((b * 8 + h) * 8) * 4 + g) * 64 + l16) * 8;
    float mrun = -1e30f, lrun = 0.f;
    f32x4 o[4] = {zero4, zero4, zero4, zero4};
#pragma unroll
    for (int hf = 0; hf < 2; ++hf) {
        if (hf == 0 && !lat) continue;
        bf16x8 fr[32];
#pragma unroll
        for (int T = 0; T < 16; ++T) { const bf16_t* kp = hf == 0 ? knb + (size_t)((T >> 1) * 8) * 512 + (T & 1) * 128 : kcx + T * 128;
            fr[2 * T] = *(const bf16x8*)kp; fr[2 * T + 1] = *(const bf16x8*)(kp + (hf == 0 ? 4 * 512 : 4 * 2048)); }
        asm volatile("" ::: "memory");
        f32x4 acc[16];
#pragma unroll
        for (int T = 0; T < 16; ++T) { f32x4 a = __builtin_amdgcn_mfma_f32_16x16x32_bf16(fr[2 * T], qf0, zero4, 0, 0, 0); a = __builtin_amdgcn_mfma_f32_16x16x32_bf16(fr[2 * T + 1], qf1, a, 0, 0, 0);
            if (hf == 0) { const int ir = T >> 1, hh = T & 1, kr = row0 + ir; const LAS float* bias = sBias + (kr - r + 7) * 31;
#pragma unroll
                for (int e = 0; e < 4; ++e) { const int kc = col0 + 16 * hh + 4 * g + e; const bool ok = (kc >= win0) && (kc < win0 + 16);
                    const int dc = min(max(kc - cq + 15, 0), 30); a[e] = ok ? a[e] + bias[dc] : -1e30f; } }
            acc[T] = a; }
#pragma unroll
        for (int m = 0; m < 8; ++m)
#pragma unroll
            for (int dt = 0; dt < 4; ++dt) fr[4 * m + dt] = *(const bf16x8*)(hf == 0 ? vnb + (size_t)m * 12 * 512 + dt * 128 : vcx + (size_t)m * 4 * 512 + dt * 128);
        asm volatile("" ::: "memory");
        float mx = mrun;
#pragma unroll
        for (int T = 0; T < 16; ++T) mx = fmaxf(fmaxf(fmaxf(acc[T][0], acc[T][1]), fmaxf(acc[T][2], acc[T][3])), mx);
        mx = fmaxf(mx, xor16_f(mx)); mx = max_x32(mx);
        const float alpha = __expf(mrun - mx);
        float lsum = 0.f;
#pragma unroll
        for (int T = 0; T < 16; ++T) {
#pragma unroll
            for (int q = 0; q < 4; ++q) { const float pv = __expf(acc[T][q] - mx); acc[T][q] = pv; lsum += pv; } }
        lsum += xor16_f(lsum); lsum = sum_x32(lsum);
        lrun = lrun * alpha + lsum; mrun = mx;
#pragma unroll
        for (int dt = 0; dt < 4; ++dt) o[dt] = o[dt] * alpha;
#pragma unroll
        for (int m = 0; m < 8; ++m) { const bf16x8 pf = pack8(acc[2 * m], acc[2 * m + 1]);
#pragma unroll
            for (int dt = 0; dt < 4; ++dt) o[dt] = __builtin_amdgcn_mfma_f32_16x16x32_bf16(fr[4 * m + dt], pf, o[dt], 0, 0, 0); }
    }
    const float inv = 1.0f / lrun;
#pragma unroll
    for (int dt = 0; dt < 4; ++dt) { u32x2 w; w.x = pk_bf16(o[dt][0] * inv, o[dt][1] * inv); w.y = pk_bf16(o[dt][2] * inv, o[dt][3] * inv);
        *(u32x2*)(MIX + (size_t)gq * 2048 + 1024 + h * 64 + dt * 16 + 4 * g) = w; }
}
__device__ __forceinline__ void na_phase(const Ctx& F, const LayerW& W, unsigned char* ws, int blk, int nblk, int ntile) {
    LAS float* sBias = (LAS float*)(F.lds + F.wave * 2048);
    __syncthreads();
    for (int idx = F.lane; idx < 465; idx += 64) sBias[idx] = W.rpb[F.wave * 465 + idx];
    asm volatile("" ::: "memory");
    for (int tile = blk; tile < ntile; tile += nblk) na_tile(F, ws, sBias, tile);
}

__device__ __forceinline__ void phase_finish(const Ctx& F, const LayerW& W, unsigned char* ws, const bf16_t* GUPT, int ntok) {
    const bf16_t* P = (const bf16_t*)(ws + WS_P); bf16_t* MIX = (bf16_t*)(ws + WS_MIX);
    const bf16_t* RWY = (const bf16_t*)(ws + WS_RWY); const float* BON = (const float*)(ws + WS_BON); const float* YS = (const float*)(ws + WS_YS);
    const f32x4 z4 = {0.f, 0.f, 0.f, 0.f};
    for (int task = F.bid * 8 + F.wave; task < (ntok / 16) * 8; task += F.G * 8) {
        int ln = F.lane; asm volatile("" : "+v"(ln));
        const int l16 = ln & 15, g = ln >> 4, h = task & 7, tok = (task >> 3) * 16 + l16;
        const bf16_t* Pr = P + (size_t)tok * PTP;
        bf16x8 sg[4];
#pragma unroll
        for (int ks = 0; ks < 4; ++ks) { const u32x4 q = *(const u32x4*)(Pr + B_GD + 32 * ks + 8 * g); union { bf16x8 v; unsigned u[4]; } s;
#pragma unroll
            for (int e = 0; e < 4; ++e) s.u[e] = pk_bf16(sigmoidf_(bflo(q[e])), sigmoidf_(bfhi(q[e])));
            sg[ks] = s.v; }
        f32x4 y[4]; float s1 = 0.f;
#pragma unroll
        for (int m = 0; m < 4; ++m) { const int co = h * 64 + 16 * m + 4 * g;
            const u32x2 a = *(const u32x2*)(RWY + (size_t)tok * 512 + co), bq = *(const u32x2*)(RWY + ((size_t)NTOK + tok) * 512 + co);
            y[m] = (f32x4){bflo(a.x) + bflo(bq.x), bfhi(a.x) + bfhi(bq.x), bflo(a.y) + bflo(bq.y), bfhi(a.y) + bfhi(bq.y)};
            s1 += (y[m][0] + y[m][1]) + (y[m][2] + y[m][3]); }
        s1 += xor16_f(s1); s1 = sum_x32(s1);
        const float mu = s1 * (1.f / 64.f); float s2 = 0.f;
#pragma unroll
        for (int m = 0; m < 4; ++m) { y[m] = y[m] - mu; s2 += (y[m][0] * y[m][0] + y[m][1] * y[m][1]) + (y[m][2] * y[m][2] + y[m][3] * y[m][3]); }
        s2 += xor16_f(s2); s2 = sum_x32(s2);
        const float rs = rsqrtf(s2 * (1.f / 64.f) + 64e-5f);
        const float bon = BON[(size_t)tok * 8 + h] + BON[((size_t)NTOK + tok) * 8 + h];
#pragma unroll
        for (int m = 0; m < 4; ++m) { const int co = h * 64 + 16 * m + 4 * g;
            f32x4 ga = z4;
#pragma unroll
            for (int ks = 0; ks < 4; ++ks) ga = __builtin_amdgcn_mfma_f32_16x16x32_bf16(*(const bf16x8*)(GUPT + (size_t)(h * 64 + 16 * m + l16) * 128 + 32 * ks + 8 * g), sg[ks], ga, 0, 0, 0);
            const float4 lw = *(const float4*)(W.rw_lnw + co), lb = *(const float4*)(W.rw_lnb + co); const u32x2 vq = *(const u32x2*)(Pr + B_V + co);
            const float o0 = (y[m][0] * rs * lw.x + lb.x + bon * bflo(vq.x)) * ga[0], o1 = (y[m][1] * rs * lw.y + lb.y + bon * bfhi(vq.x)) * ga[1];
            const float o2 = (y[m][2] * rs * lw.z + lb.z + bon * bflo(vq.y)) * ga[2], o3 = (y[m][3] * rs * lw.w + lb.w + bon * bfhi(vq.y)) * ga[3];
            u32x2 o; o.x = pk_bf16(o0, o1); o.y = pk_bf16(o2, o3);
            *(u32x2*)(MIX + (size_t)tok * 2048 + 512 + co) = o; }
    }
    for (int tok = F.bid * 8 + F.wave; tok < ntok; tok += F.G * 8) {
        const int c0 = F.lane * 8;
        float ys[8], z[8], gw[8];
        load8f(YS + (size_t)tok * 512 + c0, ys); unpack8(*(const u32x4*)(P + (size_t)tok * PTP + D_Z + c0), z); load8f(W.s_norm + c0, gw);
        float ss = 0.f;
#pragma unroll
        for (int e = 0; e < 8; ++e) { ys[e] *= siluf_(z[e]); ss += ys[e] * ys[e]; }
        ss = wave_sum(ss);
        const float rs = rsqrtf(ss * (1.f / 512.f) + 1e-6f);
#pragma unroll
        for (int e = 0; e < 8; ++e) ys[e] = ys[e] * rs * gw[e];
        *(u32x4*)(MIX + (size_t)tok * 2048 + 1536 + c0) = pack8f(ys);
    }
}

constexpr int RADIX_LOW_BIT = 10;
constexpr int RADIX_STEPS = 14;
__device__ __forceinline__ unsigned ordkey(float x) { const unsigned u = __float_as_uint(x); return (u & 0x80000000u) ? ~u : (u | 0x80000000u); }
template <int CTRL> __device__ __forceinline__ int dpp_i0(int v) { return __builtin_amdgcn_update_dpp(0, v, CTRL, 0xF, 0xF, true); }
__device__ __forceinline__ int rowscan_incl(int x) { x += dpp_i0<0x111>(x); x += dpp_i0<0x112>(x); x += dpp_i0<0x114>(x); x += dpp_i0<0x118>(x); return x; }
__device__ __forceinline__ void phase_scores(const Ctx& F, unsigned char* ws, int layer, int ntok) {
    const bf16_t* Q = (const bf16_t*)(ws + WS_P); const bf16_t* KEYS = (const bf16_t*)(ws + WS_KEYS) + (size_t)layer * 8 * 2 * 128 * 128;
    int* IDS = (int*)(ws + WS_IDS); float* GATES = (float*)(ws + WS_GATES);
    LAS bf16_t* sK = (LAS bf16_t*)F.lds;
    LAS float* sVv = (LAS float*)(F.lds + 2 * 128 * 136 * 2 + F.wave * 5120);
    LAS int* sVi = (LAS int*)(sVv + 512);
    const int ntg = ntok / 128, ntask = 8 * ntg;
    const int l16 = F.lane & 15, g = F.lane >> 4;
    const f32x4 z4 = {0.f, 0.f, 0.f, 0.f};
    int cur_h = -1;
    for (int task = F.bid; task < ntask; task += F.G) {
        const int h = task / ntg, tg = task % ntg;
        if (h != cur_h) { __syncthreads();
#pragma unroll
            for (int q = 0; q < 8; ++q) { const int v = F.tid + 512 * q, row = v >> 4, part = v & 15;
                *(LAS u32x4*)(sK + row * 136 + part * 8) = *(const u32x4*)(KEYS + ((size_t)h * 256 + row) * 128 + part * 8); }
            cur_h = h; __syncthreads(); }
        const int t0 = tg * 128 + F.wave * 16;
#pragma unroll 1
        for (int p = 0; p < 2; ++p) {
            bf16x8 qf[4];
#pragma unroll
            for (int ks = 0; ks < 4; ++ks) qf[ks] = *(const bf16x8*)(Q + (size_t)(t0 + l16) * 2048 + h * 256 + p * 128 + 32 * ks + 8 * g);
            f32x4 acc[8];
#pragma unroll
            for (int kt = 0; kt < 8; ++kt) { f32x4 a = z4;
#pragma unroll
                for (int ks = 0; ks < 4; ++ks) a = __builtin_amdgcn_mfma_f32_16x16x32_bf16(qf[ks], *(const LAS bf16x8*)(sK + (p * 128 + 16 * kt + l16) * 136 + 32 * ks + 8 * g), a, 0, 0, 0);
                acc[kt] = a; }
            float lo0, lo1, lo2, lo3, hi0, hi1, hi2, hi3;
            { float m0 = acc[0][0], m1 = acc[0][1], m2 = acc[0][2], m3 = acc[0][3];
#pragma unroll
              for (int kt = 1; kt < 8; ++kt) { m0 = fmaxf(m0, acc[kt][0]); m1 = fmaxf(m1, acc[kt][1]); m2 = fmaxf(m2, acc[kt][2]); m3 = fmaxf(m3, acc[kt][3]); }
              hi0 = max16(m0); hi1 = max16(m1); hi2 = max16(m2); hi3 = max16(m3);
              lo0 = -max16(-m0); lo1 = -max16(-m1); lo2 = -max16(-m2); lo3 = -max16(-m3); }
#pragma unroll 1
            for (int it = 0; it < RADIX_STEPS; ++it) {
                const float c0 = 0.5f * (lo0 + hi0), c1 = 0.5f * (lo1 + hi1), c2 = 0.5f * (lo2 + hi2), c3 = 0.5f * (lo3 + hi3); int n0 = 0, n1 = 0, n2 = 0, n3 = 0;
#pragma unroll
                for (int kt = 0; kt < 8; ++kt) { n0 += acc[kt][0] >= c0; n1 += acc[kt][1] >= c1; n2 += acc[kt][2] >= c2; n3 += acc[kt][3] >= c3; }
                const bool k0 = sum16((float)n0) >= 16.f, k1 = sum16((float)n1) >= 16.f, k2 = sum16((float)n2) >= 16.f, k3 = sum16((float)n3) >= 16.f;
                lo0 = k0 ? c0 : lo0; hi0 = k0 ? hi0 : c0; lo1 = k1 ? c1 : lo1; hi1 = k1 ? hi1 : c1; lo2 = k2 ? c2 : lo2; hi2 = k2 ? hi2 : c2; lo3 = k3 ? c3 : lo3; hi3 = k3 ? hi3 : c3; }
#pragma unroll
            for (int r = 0; r < 4; ++r) { const float T = r == 0 ? lo0 : (r == 1 ? lo1 : (r == 2 ? lo2 : lo3));
                int cl = 0;
#pragma unroll
                for (int kt = 0; kt < 8; ++kt) cl += acc[kt][r] >= T;
                int rank = rowscan_incl(cl) - cl;
                LAS float* dv = sVv + ((4 * g + r) * 2 + p) * 16; LAS int* di = sVi + ((4 * g + r) * 2 + p) * 16;
#pragma unroll
                for (int kt = 0; kt < 8; ++kt) { const bool sel = acc[kt][r] >= T;
                    if (sel && rank < 16) { dv[rank] = acc[kt][r]; di[rank] = 16 * kt + l16; }
                    rank += sel ? 1 : 0; } }
        }
        asm volatile("" ::: "memory");
#pragma unroll 1
        for (int r = 0; r < 4; ++r) { const int tk = 4 * g + r;
            LAS float* sS = (LAS float*)(sVi + 512);
            LAS int* sI = (LAS int*)(sS + 128);
#pragma unroll
            for (int p = 0; p < 2; ++p) { const float v = sVv[(tk * 2 + p) * 16 + l16]; const int ix = sVi[(tk * 2 + p) * 16 + l16];
                const unsigned key = (ordkey(v) & ~15u) | (unsigned)(15 - l16); int rk = 0;
#pragma unroll
                for (int q = 0; q < 4; ++q) { const f32x4 o = *(const LAS f32x4*)(sVv + (tk * 2 + p) * 16 + 4 * q);
#pragma unroll
                    for (int e = 0; e < 4; ++e) rk += ((ordkey(o[e]) & ~15u) | (unsigned)(15 - (4 * q + e))) > key; }
                sS[(g * 2 + p) * 16 + rk] = v; sI[(g * 2 + p) * 16 + rk] = ix; }
            asm volatile("" ::: "memory");
            float cv[4]; int pi[4], pj[4];
#pragma unroll
            for (int q = 0; q < 4; ++q) { const int e = l16 + 16 * q; int i, j;
                if (e < 16) { i = 0; j = e; } else if (e < 24) { i = 1; j = e - 16; } else if (e < 29) { i = 2; j = e - 24; } else if (e < 33) { i = 3; j = e - 29; }
                else if (e < 36) { i = 4; j = e - 33; } else if (e < 42) { i = 5 + ((e - 36) >> 1); j = (e - 36) & 1; } else { i = 8 + (e - 42); j = 0; }
                const bool ok = e < 50; i = ok ? i : 15; j = ok ? j : 15;
                pi[q] = i; pj[q] = j; cv[q] = ok ? sS[(g * 2) * 16 + i] + sS[(g * 2 + 1) * 16 + j] : -3.0e38f; }
            float lo = sS[(g * 2) * 16 + 15] + sS[(g * 2 + 1) * 16], hi = sS[(g * 2) * 16] + sS[(g * 2 + 1) * 16];
            const float mx = hi;
#pragma unroll 1
            for (int it = 0; it < RADIX_STEPS; ++it) { const float cm = 0.5f * (lo + hi); int n = 0;
#pragma unroll
                for (int q = 0; q < 4; ++q) n += cv[q] >= cm;
                const bool kk = sum16((float)n) >= 16.f; lo = kk ? cm : lo; hi = kk ? hi : cm; }
            int cl = 0; float es = 0.f;
#pragma unroll
            for (int q = 0; q < 4; ++q) { const bool sel = cv[q] >= lo; cl += sel; es += sel ? __expf(cv[q] - mx) : 0.f; }
            int rank = rowscan_incl(cl) - cl;
            const float einv = 1.0f / sum16(es);
            const size_t ob = (size_t)(t0 + tk) * 128 + h * 16;
#pragma unroll
            for (int q = 0; q < 4; ++q) { const bool sel = cv[q] >= lo;
                if (sel && rank < 16) { IDS[ob + rank] = sI[(g * 2) * 16 + pi[q]] * 128 + sI[(g * 2 + 1) * 16 + pj[q]]; GATES[ob + rank] = __expf(cv[q] - mx) * einv; }
                rank += sel ? 1 : 0; }
            asm volatile("" ::: "memory");
        }
        asm volatile("" ::: "memory");
    }
}

struct XInfo { int xi, nx, rank, nloc; };
__device__ __forceinline__ void fp8x16_to_f32(const u32x4 q, float (&f)[16]) {
#pragma unroll
    for (int w = 0; w < 4; ++w) { const auto a = __builtin_amdgcn_cvt_pk_f32_fp8((int)q[w], false); const auto b = __builtin_amdgcn_cvt_pk_f32_fp8((int)q[w], true);
        f[4 * w] = a[0]; f[4 * w + 1] = a[1]; f[4 * w + 2] = b[0]; f[4 * w + 3] = b[1]; }
}
typedef long i64_t;
template <int IDMASK> __device__ __forceinline__ void phase_experts_u(const Ctx& F, unsigned char* ws, int layer, int ntok, const XInfo X, float* PART) {
    const bf16_t* H = (const bf16_t*)(ws + WS_XN); const unsigned char* PU8 = ws + WS_PU + (size_t)layer * 16384 * 2048;
    const int* IDS = (const int*)(ws + WS_IDS);
    const int e8 = F.lane >> 3, c = F.lane & 7, l16 = F.lane & 15, g = F.lane >> 4;
    const int tfirst = X.rank * 8 + F.wave, tstride = X.nloc * 8;
    const int nk = tfirst < ntok ? (ntok - tfirst + tstride - 1) / tstride : 0;
    const f32x4 z4 = {0.f, 0.f, 0.f, 0.f};
    LAS unsigned char* buf = F.lds + F.wave * 12288; LAS float* res = (LAS float*)(buf + 8192);
    const int woff = e8 * 128 + c * 16;
    const int srcoff = 16 * (c ^ e8);
    const int roff0 = l16 * 128 + (((2 * g) ^ (l16 & 7)) * 16), roff1 = l16 * 128 + (((2 * g + 1) ^ (l16 & 7)) * 16);
#define EU_TOK(k) (tfirst + min((k), nk - 1) * tstride)
#define EU_LOADI(I, k) do { const int* ip_ = IDS + (size_t)EU_TOK(k) * 128 + e8; _Pragma("unroll") for (int q_ = 0; q_ < 16; ++q_) I[q_] = ip_[8 * q_]; } while (0)
#define EU_LOADX(HX, k) do { const u32x4* hp_ = (const u32x4*)(H + (size_t)EU_TOK(k) * 2048 + s * 128 + 32 * g); HX[0] = hp_[0]; HX[1] = hp_[1]; HX[2] = hp_[2]; HX[3] = hp_[3]; } while (0)
#define EU_ISSUE(Q, I, hf) do { _Pragma("unroll") for (int i_ = 0; i_ < 8; ++i_) Q[i_] = *(const u32x4*)(PU8 + ((size_t)s * 16384 + I[(hf) * 8 + i_]) * 128 + srcoff); } while (0)
#define EU_CONSUME(Q, hf, slot) do { _Pragma("unroll") for (int i_ = 0; i_ < 8; ++i_) *(LAS u32x4*)(buf + i_ * 1024 + woff) = Q[i_]; \
        asm volatile("" ::: "memory"); \
        u32x4 p0_[4], p1_[4]; f32x4 a_[4]; \
        _Pragma("unroll") for (int q_ = 0; q_ < 4; ++q_) { p0_[q_] = *(const LAS u32x4*)(buf + q_ * 2048 + roff0); p1_[q_] = *(const LAS u32x4*)(buf + q_ * 2048 + roff1); a_[q_] = z4; } \
          \
        _Pragma("unroll") for (int q_ = 0; q_ < 4; ++q_) a_[q_] = __builtin_amdgcn_mfma_f32_16x16x32_fp8_fp8(((i64_t)p0_[q_][1] << 32) | (i64_t)p0_[q_][0], hb[0], a_[q_], 0, 0, 0); \
        _Pragma("unroll") for (int q_ = 0; q_ < 4; ++q_) a_[q_] = __builtin_amdgcn_mfma_f32_16x16x32_fp8_fp8(((i64_t)p0_[q_][3] << 32) | (i64_t)p0_[q_][2], hb[1], a_[q_], 0, 0, 0); \
        _Pragma("unroll") for (int q_ = 0; q_ < 4; ++q_) a_[q_] = __builtin_amdgcn_mfma_f32_16x16x32_fp8_fp8(((i64_t)p1_[q_][1] << 32) | (i64_t)p1_[q_][0], hb[2], a_[q_], 0, 0, 0); \
        _Pragma("unroll") for (int q_ = 0; q_ < 4; ++q_) a_[q_] = __builtin_amdgcn_mfma_f32_16x16x32_fp8_fp8(((i64_t)p1_[q_][3] << 32) | (i64_t)p1_[q_][2], hb[3], a_[q_], 0, 0, 0); \
        _Pragma("unroll") for (int q_ = 0; q_ < 4; ++q_) if (l16 == (hf) * 4 + q_) *(LAS f32x4*)(res + (slot) * 128 + 16 * ((hf) * 4 + q_) + 4 * g) = a_[q_]; \
        asm volatile("" ::: "memory"); } while (0)
    for (int s = X.xi; s < 16; s += X.nx) {
        if (nk == 0) continue;
        int id[2][16]; u32x4 hx[2][4]; u32x4 qa[8], qb[8];
        EU_LOADI(id[0], 0); EU_LOADX(hx[0], 0); EU_ISSUE(qa, id[0], 0); EU_ISSUE(qb, id[0], 1);
        EU_LOADI(id[1], 1);
        for (int k0 = 0; k0 < nk; k0 += 8) {
#pragma unroll
            for (int j = 0; j < 8; ++j) { const int k = k0 + j;
                i64_t hb[4];
#pragma unroll
                for (int m = 0; m < 4; ++m) { const u32x4 v = hx[j & 1][m];
                    int lo = __builtin_amdgcn_cvt_pk_fp8_f32(bflo(v[0]), bfhi(v[0]), 0, false); lo = __builtin_amdgcn_cvt_pk_fp8_f32(bflo(v[1]), bfhi(v[1]), lo, true);
                    int hi = __builtin_amdgcn_cvt_pk_fp8_f32(bflo(v[2]), bfhi(v[2]), 0, false); hi = __builtin_amdgcn_cvt_pk_fp8_f32(bflo(v[3]), bfhi(v[3]), hi, true);
                    hb[m] = ((i64_t)(unsigned)hi << 32) | (i64_t)(unsigned)lo; }
                EU_LOADX(hx[(j + 1) & 1], k + 1);
                EU_LOADI(id[j & 1], k + 2);
                EU_CONSUME(qa, 0, j);
                EU_ISSUE(qa, id[(j + 1) & 1], 0);
                EU_CONSUME(qb, 1, j);
                EU_ISSUE(qb, id[(j + 1) & 1], 1);
            }
            { const int u = F.lane >> 3, jj = F.lane & 7, ku = k0 + u;
              if (ku < nk) { float* dst = PART + ((size_t)s * NTOK + tfirst + ku * tstride) * 128 + 16 * jj;
#pragma unroll
                  for (int w = 0; w < 4; ++w) *(f32x4*)(dst + 4 * w) = *(const LAS f32x4*)(res + u * 128 + 16 * jj + 4 * w); }
              asm volatile("" ::: "memory"); }
        }
    }
#undef EU_TOK
#undef EU_LOADI
#undef EU_LOADX
#undef EU_ISSUE
#undef EU_CONSUME
}
__device__ __forceinline__ void phase_experts_combine(const Ctx& F, unsigned char* ws, int ntok) {
    const float* PART = (const float*)(ws + WS_PART); float* GATES = (float*)(ws + WS_GATES);
    for (int idx = F.bid * 512 + F.tid; idx < ntok * 32; idx += F.G * 512) {
        float4 a = make_float4(0.f, 0.f, 0.f, 0.f);
#pragma unroll
        for (int s = 0; s < 16; ++s) { const float4 v = *(const float4*)(PART + (size_t)s * NTOK * 128 + (size_t)idx * 4); a.x += v.x; a.y += v.y; a.z += v.z; a.w += v.w; }
        float4 g = *(const float4*)(GATES + (size_t)idx * 4);
        g.x *= geluf_(a.x * (1.0f / PEER_U_SCALE)); g.y *= geluf_(a.y * (1.0f / PEER_U_SCALE)); g.z *= geluf_(a.z * (1.0f / PEER_U_SCALE)); g.w *= geluf_(a.w * (1.0f / PEER_U_SCALE));
        *(float4*)(GATES + (size_t)idx * 4) = g;
    }
}
__device__ __forceinline__ void phase_experts_v(const Ctx& F, unsigned char* ws, float* out, float* CTXS, int layer, int ntok, const XInfo X) {
    const unsigned char* PV8 = ws + WS_PV + (size_t)layer * 16384 * 2048;
    const int* IDS = (const int*)(ws + WS_IDS); const float* COEF = (const float*)(ws + WS_GATES); const float* MOD = (const float*)(ws + WS_MOD);
    const int e8 = F.lane >> 3, c = F.lane & 7;
    const int tfirst = X.rank * 8 + F.wave, tstride = X.nloc * 8;
    const int nk = tfirst < ntok ? (ntok - tfirst + tstride - 1) / tstride : 0;
    LAS float* res = (LAS float*)(F.lds + F.wave * 4096);
#define EV_TOK(k) (tfirst + min((k), nk - 1) * tstride)
#define EV_LOADI(I, k) do { I[0] = *((const u32x4*)(IDS + (size_t)EV_TOK(k) * 128 + e8 * 16) + (c & 3)); } while (0)
#define EV_LOADC(C, k) do { C[0] = *((const u32x4*)(COEF + (size_t)EV_TOK(k) * 128 + e8 * 16) + (c & 3)); } while (0)
#define EV_QUAD(V) do { const u32x4 own_ = V[0];   \
        _Pragma("unroll") for (int w_ = 0; w_ < 4; ++w_) { V[0][w_] = (unsigned)__builtin_amdgcn_update_dpp(0, (int)own_[w_], 0x00, 0xF, 0xF, true); V[1][w_] = (unsigned)__builtin_amdgcn_update_dpp(0, (int)own_[w_], 0x55, 0xF, 0xF, true); \
            V[2][w_] = (unsigned)__builtin_amdgcn_update_dpp(0, (int)own_[w_], 0xAA, 0xF, 0xF, true); V[3][w_] = (unsigned)__builtin_amdgcn_update_dpp(0, (int)own_[w_], 0xFF, 0xF, 0xF, true); } } while (0)
#define EV_ROW(id) (*(const u32x4*)(PV8 + ((size_t)s * 16384 + (id)) * 128 + c * 16))
#define EV_ISSUE(Q, I, hf) do { _Pragma("unroll") for (int i_ = 0; i_ < 8; ++i_) Q[i_] = EV_ROW(I[(hf) * 2 + (i_ >> 2)][i_ & 3]); } while (0)
#define EV_HALF(Q, C, hf) do { _Pragma("unroll") for (int i_ = 0; i_ < 8; ++i_) { const float cf_ = __uint_as_float(C[(hf) * 2 + (i_ >> 2)][i_ & 3]); const f32x2_t c2_ = {cf_, cf_}; \
            _Pragma("unroll") for (int w_ = 0; w_ < 4; ++w_) { const f32x2_t lo_ = __builtin_amdgcn_cvt_pk_f32_fp8((int)Q[i_][w_], false), hi_ = __builtin_amdgcn_cvt_pk_f32_fp8((int)Q[i_][w_], true); \
                ac2[2 * w_] = lo_ * c2_ + ac2[2 * w_]; ac2[2 * w_ + 1] = hi_ * c2_ + ac2[2 * w_ + 1]; } } } while (0)
    for (int s = X.xi; s < 16; s += X.nx) {
        if (nk == 0) continue;
        u32x4 id[2][4], cf[2][4]; u32x4 qa[8], qb[8];
        EV_LOADI(id[0], 0); EV_LOADC(cf[0], 0); EV_QUAD(id[0]); EV_ISSUE(qa, id[0], 0); EV_ISSUE(qb, id[0], 1);
        EV_LOADI(id[1], 1);
        for (int k0 = 0; k0 < nk; k0 += 8) {
#pragma unroll
            for (int j = 0; j < 8; ++j) { const int k = k0 + j;
                f32x2_t ac2[8];
#pragma unroll
                for (int e = 0; e < 8; ++e) ac2[e] = (f32x2_t){0.f, 0.f};
                EV_QUAD(cf[j & 1]);
                EV_QUAD(id[(j + 1) & 1]);
                EV_LOADC(cf[(j + 1) & 1], k + 1);
                EV_HALF(qa, cf[j & 1], 0);
                EV_ISSUE(qa, id[(j + 1) & 1], 0);
                EV_HALF(qb, cf[j & 1], 1);
                EV_ISSUE(qb, id[(j + 1) & 1], 1);
                EV_LOADI(id[j & 1], k + 2);
                float acc[16];
#pragma unroll
                for (int e = 0; e < 8; ++e) { acc[2 * e] = ac2[e][0]; acc[2 * e + 1] = ac2[e][1]; }
#pragma unroll
                for (int e = 0; e < 16; ++e) { float v = acc[e]; v += dpp_f<0x128>(v); v += xor16_f(v); acc[e] = sum_x32(v); }
                if (e8 == 0) {
#pragma unroll
                    for (int w = 0; w < 4; ++w) *(LAS f32x4*)(res + j * 128 + c * 16 + 4 * w) = (f32x4){acc[4 * w], acc[4 * w + 1], acc[4 * w + 2], acc[4 * w + 3]}; }
                asm volatile("" ::: "memory");
            }
            { const int u = F.lane >> 3, jj = F.lane & 7, ku = k0 + u;
              if (ku < nk) { const int tu = tfirst + ku * tstride;
                  const bool isctx = tu >= NLAT; const int vv = isctx ? 4 : (tu >> 12);
                  float* xr = (isctx ? CTXS + (size_t)(tu - NLAT) * 2048 : out + (size_t)tu * 2048) + s * 128 + jj * 16;
                  const float* m5 = MOD + ((size_t)layer * 5 + vv) * 12288 + 5 * 2048 + s * 128 + jj * 16;
#pragma unroll
                  for (int w = 0; w < 4; ++w) { float4 x = *(const float4*)(xr + 4 * w); const float4 m = *(const float4*)(m5 + 4 * w); const f32x4 a = *(const LAS f32x4*)(res + u * 128 + jj * 16 + 4 * w);
                      x.x += m.x * a[0]; x.y += m.y * a[1]; x.z += m.z * a[2]; x.w += m.w * a[3]; *(float4*)(xr + 4 * w) = x; } }
              asm volatile("" ::: "memory"); }
        }
    }
#undef EV_TOK
#undef EV_LOADI
#undef EV_LOADC
#undef EV_QUAD
#undef EV_ROW
#undef EV_ISSUE
#undef EV_HALF
}

struct Params { const float* in[N_IN]; float* out; unsigned char* ws; };

__device__ __forceinline__ LayerW make_w(ka_t in, int l) {
    LayerW W;
    W.sc_w = in[I_SCW] + (size_t)l * 3 * 512; W.rw_w0 = in[I_RW0] + (size_t)l * 2 * 512; W.rw_wup = in[I_RWUP] + (size_t)l * 2 * 64 * 512;
    W.rw_a0 = in[I_RA0] + (size_t)l * 2 * 512; W.rw_aup = in[I_RAUP] + (size_t)l * 2 * 64 * 512; W.rw_gup = in[I_RGUP] + (size_t)l * 128 * 512;
    W.rw_kk = in[I_RKK] + (size_t)l * 512; W.rw_ka = in[I_RKA] + (size_t)l * 512; W.rw_rk = in[I_RRK] + (size_t)l * 512;
    W.rw_lnw = in[I_RLNW] + (size_t)l * 512; W.rw_lnb = in[I_RLNB] + (size_t)l * 512;
    W.na_q = in[I_NAQ] + (size_t)l * 64; W.na_k = in[I_NAK] + (size_t)l * 64; W.rpb = in[I_RPB] + (size_t)l * 8 * 15 * 31;
    W.s_cw = in[I_SCONVW] + (size_t)l * 3 * 1024; W.s_cb = in[I_SCONVB] + (size_t)l * 1024; W.s_dtb = in[I_SDTB] + (size_t)l * 16; W.s_alog = in[I_SALOG] + (size_t)l * 16;
    W.s_d = in[I_SD] + (size_t)l * 8; W.s_norm = in[I_SNORM] + (size_t)l * 512;
    return W;
}

__global__ void __launch_bounds__(512, 2) hybrid_fwd(Params p) {
    extern __shared__ __attribute__((aligned(16))) unsigned char shm[];
    Ctx F; F.lds = (LAS unsigned char*)shm; F.tid = threadIdx.x; F.lane = F.tid & 63; F.wave = __builtin_amdgcn_readfirstlane(F.tid >> 6); F.bid = blockIdx.x; F.G = gridDim.x;
    volatile LAS unsigned* bst = (volatile LAS unsigned*)(F.lds + LDS_BAR_OFF);
    if (F.tid < 4) bst[F.tid] = 0u;
    __syncthreads();
    (void)xcd_barrier_post((unsigned*)(p.ws + WS_CTL), bst);
    volatile LAS int* lxi = (volatile LAS int*)(F.lds + LDS_XI_OFF);
    if (F.tid == 0) lxi[2] = (int)xb_add((unsigned*)(p.ws + WS_CTL) + CTL_TICKET + 64 * xb_xcc_id(), 1u);
#define RPT_PHASE(id, ...) do { __VA_ARGS__ if (RPT == (id)) { GRID_BAR(); PH_BEGIN(); __VA_ARGS__ } } while (0)
#define GRID_BAR() do { ka_t kb_ = (ka_t)__builtin_amdgcn_kernarg_segment_ptr(); asm volatile("" : "+s"(kb_)); unsigned xx_ = xb_xcc_id(); asm volatile("" : "+s"(xx_)); \
        XcdBarrier b_; b_.bar = (unsigned*)((unsigned char*)kb_[N_IN + 1] + WS_CTL); b_.x = xx_; b_.st = (volatile LAS unsigned*)(F.lds + LDS_BAR_OFF); xcd_barrier(b_); } while (0)
    ka_t in; unsigned char* ws; float* out;
#define PH_BEGIN() do { int t_ = threadIdx.x; asm volatile("; PHASE_MARK" : "+v"(t_)); F.tid = t_; F.lane = t_ & 63; F.wave = __builtin_amdgcn_readfirstlane(t_ >> 6); \
        int b_ = blockIdx.x, g_ = gridDim.x; asm volatile("" : "+s"(b_), "+s"(g_)); F.bid = b_; F.G = g_; \
        ka_t k_ = (ka_t)__builtin_amdgcn_kernarg_segment_ptr(); asm volatile("" : "+s"(k_)); in = k_; \
        out = (float*)in[N_IN]; ws = (unsigned char*)in[N_IN + 1]; } while (0)

    PH_BEGIN();
    RPT_PHASE(1, phase_prologue(F, in, ws););
    GRID_BAR();
    if (F.tid == 0) {
        const unsigned* bw = (const unsigned*)(ws + WS_CTL); const unsigned myx = xb_xcc_id(); int xi = 0, nx = 0, nloc = 1;
        for (unsigned j = 0; j < 16; ++j) { const unsigned cnt = xb_ld((unsigned*)&bw[XB_XCNT(j)]); if (cnt > 0u) { if (j < myx) ++xi; ++nx; } if (j == myx) nloc = (int)cnt; }
        lxi[0] = xi; lxi[1] = nx > 0 ? nx : 1; lxi[3] = nloc > 0 ? nloc : 1; }
    __syncthreads();
    PH_BEGIN();
    phase_modreduce(F, in[I_BADA], (const float*)(ws + WS_MODP), (float*)(ws + WS_MOD));
    GRID_BAR();

#pragma unroll 1
    for (int l = 0; l < 2; ++l) {
        const int M = (l == 0) ? NTOK : NLAT;
        if (l == 0) { PH_BEGIN(); phase_norm(F, in[I_X], in[I_CTX], in[I_NMIX], (const float*)(ws + WS_MOD), 0, 1, (bf16_t*)(ws + WS_XN), NTOK); GRID_BAR(); }

        PH_BEGIN();
        RPT_PHASE(2, { pg8::Gemm g{(const bf16_t*)(ws + WS_XN), (const bf16_t*)(ws + WS_WIN) + (size_t)l * PTP * 2048, NTOK, PTP, 2048}; pg8::StaticOrder S; S.init(NTOK, PTP, F.G, F.bid);
          pg8::EpiBf16 E{(bf16_t*)(ws + WS_P), PTP}; pg8::gemm_phase<pg8::EpiBf16, pg8::StaticOrder>(F.lds, g, S, E, F.tid); });
        GRID_BAR();

        PH_BEGIN();
        { const LayerW W = make_w(in, l); phase_prep(F, W, ws);
            if (RPT == 31) phase_prep(F, W, ws);
            const bf16_t* WUPT = (const bf16_t*)(ws + WS_WUPT) + (size_t)l * 4 * 512 * 64;
            for (int rep = 0; rep < (RPT == 32 ? 2 : 1); ++rep) {
            for (int task = F.bid * 8 + F.wave; task < 4 * 8 * RW_NCHUNK; task += F.G * 8) rwkv_pre_task(F, W, ws, WUPT, task, 0);
            for (int task = F.bid * 8 + F.wave; task < 4 * 8 * RW_NCHUNK; task += F.G * 8) rwkv_pre_task(F, W, ws, WUPT, task, 1); } }
        GRID_BAR();

        PH_BEGIN();
        RPT_PHASE(4, { const LayerW W = make_w(in, l); for (int task = F.bid; task < 4 * 8 * NCH; task += F.G) ssd_task<false>(F, W, ws, task); });
        GRID_BAR();
        PH_BEGIN();
        phase_ssd_combine(F, ws);
        GRID_BAR();

        PH_BEGIN();
        { if (F.bid < 64) rwkv_scan(F, ws, F.bid);
        else { const LayerW W = make_w(in, l); const int blk = F.bid - 64, nblk = F.G - 64;
            for (int task = blk; task < 4 * 8 * NCH; task += nblk) ssd_task<true>(F, W, ws, task);
            na_phase(F, W, ws, blk, nblk, (l == 0) ? 1088 : 1024); } }
        if (RPT == 51) { GRID_BAR(); PH_BEGIN(); if (F.bid < 64) rwkv_scan(F, ws, F.bid); }
        if (RPT == 52) { GRID_BAR(); PH_BEGIN(); if (F.bid >= 64) { const LayerW W = make_w(in, l); const int blk = F.bid - 64, nblk = F.G - 64;
            for (int task = blk; task < 4 * 8 * NCH; task += nblk) ssd_task<true>(F, W, ws, task); } }
        if (RPT == 53) { GRID_BAR(); PH_BEGIN(); if (F.bid >= 64) { const LayerW W = make_w(in, l); const int blk = F.bid - 64, nblk = F.G - 64;
            na_phase(F, W, ws, blk, nblk, (l == 0) ? 1088 : 1024); } }
        GRID_BAR();

        PH_BEGIN();
        RPT_PHASE(6, { const LayerW W = make_w(in, l); phase_finish(F, W, ws, (const bf16_t*)(ws + WS_GUPT) + (size_t)l * 512 * 128, M); });
        GRID_BAR();

        PH_BEGIN();
        { pg8::Gemm g{(const bf16_t*)(ws + WS_MIX), (const bf16_t*)(ws + WS_WOUT) + (size_t)l * 2048 * 2048, M, 2048, 2048}; pg8::StaticOrder S; S.init(M, 2048, F.G, F.bid);
          float* CTXS = (float*)(ws + WS_CTXS);
          pg8::EpiResid E{l == 0 ? in[I_X] : out, l == 0 ? in[I_CTX] : CTXS, out, CTXS, (const float*)(ws + WS_MOD) + (size_t)l * 5 * 12288 + 2 * 2048};
          pg8::gemm_phase<pg8::EpiResid, pg8::StaticOrder>(F.lds, g, S, E, F.tid); }
        if (l == 0 && F.bid >= 32) PEER_CONVERT_LAYER(F, in, ws, 0, F.bid - 32, F.G - 32);
        GRID_BAR();

        PH_BEGIN();
        RPT_PHASE(7, phase_norm(F, out, (const float*)(ws + WS_CTXS), in[I_NFFN] + (size_t)l * 2048, (const float*)(ws + WS_MOD) + (size_t)l * 5 * 12288, 3, 4, (bf16_t*)(ws + WS_XN), M););
        GRID_BAR();
        PH_BEGIN();
        RPT_PHASE(8, { pg8::Gemm g{(const bf16_t*)(ws + WS_XN), (const bf16_t*)(ws + WS_WQ) + (size_t)l * 2048 * 2048, M, 2048, 2048}; pg8::StaticOrder S; S.init(M, 2048, F.G, F.bid);
          pg8::EpiBf16 E{(bf16_t*)(ws + WS_P), 2048}; pg8::gemm_phase<pg8::EpiBf16, pg8::StaticOrder>(F.lds, g, S, E, F.tid); });
        if (l == 0 && F.bid >= 32) PEER_CONVERT_LAYER(F, in, ws, 1, F.bid - 32, F.G - 32);
        GRID_BAR();
        PH_BEGIN();
        RPT_PHASE(9, phase_scores(F, ws, l, M););
        GRID_BAR();
        PH_BEGIN();
        RPT_PHASE(10, { XInfo X; X.xi = lxi[0]; X.nx = lxi[1]; X.rank = lxi[2]; X.nloc = lxi[3]; phase_experts_u<0x3fff>(F, ws, l, M, X, (float*)(ws + WS_PART)); });
        if (RPT == 101) { GRID_BAR(); PH_BEGIN(); XInfo X; X.xi = lxi[0]; X.nx = lxi[1]; X.rank = lxi[2]; X.nloc = lxi[3]; phase_experts_u<0x3ff>(F, ws, l, M, X, (float*)(ws + WS_P)); }
        if (RPT == 102) { GRID_BAR(); PH_BEGIN(); XInfo X; X.xi = lxi[0]; X.nx = lxi[1]; X.rank = lxi[2]; X.nloc = lxi[3]; phase_experts_u<0x3fff>(F, ws, l, M, X, (float*)(ws + WS_P)); }
        GRID_BAR();
        PH_BEGIN();
        phase_experts_combine(F, ws, M);
        GRID_BAR();
        PH_BEGIN();
        if (RPT == 11) { XInfo X; X.xi = lxi[0]; X.nx = lxi[1]; X.rank = lxi[2]; X.nloc = lxi[3]; phase_experts_v(F, ws, (float*)(ws + WS_P), (float*)(ws + WS_P) + (size_t)NLAT * 2048, l, M, X); GRID_BAR(); PH_BEGIN(); }
        { XInfo X; X.xi = lxi[0]; X.nx = lxi[1]; X.rank = lxi[2]; X.nloc = lxi[3]; phase_experts_v(F, ws, out, (float*)(ws + WS_CTXS), l, M, X); }
        if (l == 0) { GRID_BAR(); PH_BEGIN();
            phase_norm(F, out, (const float*)(ws + WS_CTXS), in[I_NMIX] + 2048, (const float*)(ws + WS_MOD) + (size_t)5 * 12288, 0, 1, (bf16_t*)(ws + WS_XN), NTOK); GRID_BAR(); }
    }
}

extern "C" void kernel_launch(void* const* d_in, const int* in_sizes, int n_in, void* d_out, int out_size, void* d_ws, size_t ws_size, hipStream_t stream) {
    static int grid = 0;
    if (grid == 0) {
        if (n_in != N_IN || out_size != NLAT * DM || ws_size < WS_END) { fprintf(stderr, "kernel_launch: unexpected shapes (n_in %d out %d ws %zu, need %zu)\n", n_in, out_size, ws_size, (size_t)WS_END); grid = -1; return; }
        int dev = 0, cus = 0, per_cu = 0;
        (void)hipGetDevice(&dev); (void)hipDeviceGetAttribute(&cus, hipDeviceAttributeMultiprocessorCount, dev);
        if (hipFuncSetAttribute((const void*)hybrid_fwd, hipFuncAttributeMaxDynamicSharedMemorySize, LDS_BYTES) != hipSuccess) { fprintf(stderr, "kernel_launch: hipFuncSetAttribute failed\n"); grid = -1; return; }
        (void)hipOccupancyMaxActiveBlocksPerMultiprocessor(&per_cu, (const void*)hybrid_fwd, 512, LDS_BYTES);
        (void)hipGetLastError();
        fprintf(stderr, "kernel_launch: %d CUs, occupancy query %d block(s)/CU, ws %zu B (need %zu)\n", cus, per_cu, ws_size, (size_t)WS_END);
        grid = cus;
        if (grid < 136) { fprintf(stderr, "kernel_launch: needs at least 136 CUs\n"); grid = -1; return; }
    }
    if (grid < 0) return;
    (void)hipMemsetAsync((char*)d_ws + WS_CTL, 0, 65536, stream);
    Params p{};
    for (int i = 0; i < N_IN; ++i) p.in[i] = (const float*)d_in[i];
    p.out = (float*)d_out; p.ws = (unsigned char*)d_ws;
    hipLaunchKernelGGL(hybrid_fwd, dim3(grid), dim3(512), LDS_BYTES, stream, p);
}
```

```cpp
#include <hip/hip_runtime.h>
#include <cstdio>
#include <cstdint>
#ifndef RPT
#define RPT 0
#endif

constexpr int DM = 2048, NBATCH = 4, SEQL = 4096, CTXL = 256, NLAT = NBATCH * SEQL, NCTX = NBATCH * CTXL, NTOK = NLAT + NCTX;
constexpr int PT = 6416, PTP = 6656;
constexpr int A_BG = 0, A_CG = 512, A_H = 1024;
constexpr int B_R = 1536, B_K = 2048, B_V = 2560, B_WD = 3072, B_AD = 3136, B_GD = 3200;
constexpr int C_Q = 3328, C_K = 3840, C_V = 4352;
constexpr int D_Z = 4864, D_X = 5376, D_DT = 6400;
constexpr int NPOS = CTXL + SEQL;
constexpr int NCH = 34;
constexpr int KSPL = 32;

enum { I_X = 0, I_C, I_CTX, I_CCTX, I_WADA, I_BADA, I_NMIX, I_NFFN, I_WIN, I_WOUT, I_SCW, I_RW0, I_RWUP, I_RA0, I_RAUP, I_RGUP, I_RKK, I_RKA, I_RRK, I_RLNW, I_RLNB,
       I_NAQ, I_NAK, I_RPB, I_SCONVW, I_SCONVB, I_SDTB, I_SALOG, I_SD, I_SNORM, I_PWQ, I_PKEYS, I_PU, I_PV, N_IN };

constexpr size_t WS_CTL   = 0;
constexpr size_t WS_ROPE  = 65536;
constexpr size_t WS_MODP  = WS_ROPE + 16384;
constexpr size_t WS_MOD   = WS_MODP + (size_t)KSPL * 2 * 5 * 12288 * 4;
constexpr size_t WS_WIN   = WS_MOD + (size_t)2 * 5 * 12288 * 4;
constexpr size_t WS_WOUT  = WS_WIN + (size_t)2 * PTP * DM * 2;
constexpr size_t WS_WQ    = WS_WOUT + (size_t)2 * DM * DM * 2;
constexpr size_t WS_KEYS  = WS_WQ + (size_t)2 * DM * DM * 2;
constexpr size_t WS_WUPT  = WS_KEYS + (size_t)2 * 8 * 2 * 128 * 128 * 2;
constexpr size_t WS_GUPT  = WS_WUPT + (size_t)2 * 4 * 512 * 64 * 2;
constexpr size_t WS_PU    = WS_GUPT + (size_t)2 * 512 * 128 * 2;
constexpr size_t WS_PV    = WS_PU + (size_t)2 * 16384 * DM;
constexpr size_t WS_P     = WS_PV + (size_t)2 * 16384 * DM;
constexpr size_t WS_MIX   = WS_P + (size_t)NTOK * PTP * 2;
constexpr size_t WS_CTXS  = WS_MIX + (size_t)NTOK * DM * 2;
constexpr size_t WS_XN    = WS_CTXS + (size_t)NCTX * DM * 4;
constexpr size_t WS_IDS   = WS_XN + (size_t)NTOK * DM * 2;
constexpr size_t WS_GATES = WS_IDS + (size_t)NTOK * 128 * 4;
constexpr size_t WS_PART  = WS_GATES + (size_t)NTOK * 128 * 4;
constexpr size_t WS_RWF   = WS_XN;
constexpr size_t WS_RWY   = WS_RWF + (size_t)64 * 272 * 10496;
constexpr size_t WS_BON   = WS_RWY + (size_t)2 * NTOK * 512 * 2;
constexpr size_t WS_XBC   = WS_BON + (size_t)2 * NTOK * 8 * 4;
constexpr size_t WS_DTS   = WS_XBC + (size_t)NTOK * 1024 * 2;
constexpr size_t WS_DEC   = WS_DTS + (size_t)NTOK * 16 * 4;
constexpr size_t WS_SST   = WS_DEC + (size_t)NTOK * 16 * 4;
constexpr size_t WS_SCD   = WS_SST + (size_t)64 * NCH * 8192 * 4;
constexpr size_t WS_YS    = WS_SCD + 16384;
constexpr size_t WS_QN    = WS_YS + (size_t)NTOK * 512 * 4;
constexpr size_t WS_KN    = WS_QN + (size_t)NTOK * 512 * 2;
constexpr size_t WS_VTL   = WS_KN + (size_t)NTOK * 512 * 2;
constexpr size_t WS_VTC   = WS_VTL + (size_t)4 * 8 * 64 * 64 * 96 * 2;
constexpr size_t WS_END   = WS_VTC + (size_t)4 * 8 * 64 * 256 * 2;
static_assert(WS_END < (size_t)1020 * 1024 * 1024, "workspace");
static_assert(WS_GATES + (size_t)NTOK * 128 * 4 <= WS_PART && WS_PART + (size_t)16 * NTOK * 128 * 4 <= WS_END, "alias");

constexpr int LDS_BYTES = 147456;
constexpr int LDS_BAR_OFF = LDS_BYTES - 16;
constexpr int LDS_XI_OFF = LDS_BYTES - 48;
constexpr int CTL_TICKET = 8192;

#define LAS __attribute__((address_space(3)))
typedef unsigned short bf16_t;
typedef _Float16 f16_t;
typedef short bf16x8 __attribute__((ext_vector_type(8)));
typedef float f32x4 __attribute__((ext_vector_type(4)));
typedef unsigned u32x4 __attribute__((ext_vector_type(4)));
typedef unsigned u32x2 __attribute__((ext_vector_type(2)));

__device__ __forceinline__ float bf2f(bf16_t h) { return __uint_as_float(((unsigned)h) << 16); }
__device__ __forceinline__ float bflo(unsigned u) { return __uint_as_float(u << 16); }
__device__ __forceinline__ float bfhi(unsigned u) { return __uint_as_float(u & 0xffff0000u); }
__device__ __forceinline__ bf16_t f2bf(float f) { unsigned u = __float_as_uint(f); u += 0x7FFFu + ((u >> 16) & 1u); return (bf16_t)(u >> 16); }
typedef float f32x2_t __attribute__((ext_vector_type(2)));
typedef __bf16 bf16x2_t __attribute__((ext_vector_type(2)));
__device__ __forceinline__ unsigned pk_bf16(float lo, float hi) { const f32x2_t v = {lo, hi}; const bf16x2_t r = __builtin_convertvector(v, bf16x2_t); return __builtin_bit_cast(unsigned, r); }
__device__ __forceinline__ bf16x8 pack8(const f32x4 a, const f32x4 b) { union { bf16x8 v; unsigned u[4]; } r; r.u[0] = pk_bf16(a[0], a[1]); r.u[1] = pk_bf16(a[2], a[3]); r.u[2] = pk_bf16(b[0], b[1]); r.u[3] = pk_bf16(b[2], b[3]); return r.v; }
template <int CTRL> __device__ __forceinline__ float dpp_f(float v) { return __int_as_float(__builtin_amdgcn_update_dpp(0, __float_as_int(v), CTRL, 0xF, 0xF, true)); }
__device__ __forceinline__ float sum4(float x)  { x += dpp_f<0xB1>(x); x += dpp_f<0x4E>(x); return x; }
__device__ __forceinline__ float sum8(float x)  { x = sum4(x); x += dpp_f<0x141>(x); return x; }
__device__ __forceinline__ float sum16(float x) { x = sum8(x); x += dpp_f<0x140>(x); return x; }
__device__ __forceinline__ float xor16_f(float x) { return __int_as_float(__builtin_amdgcn_ds_swizzle(__float_as_int(x), 0x401F)); }
__device__ __forceinline__ float sum_x32(float x) { const auto r = __builtin_amdgcn_permlane32_swap(__float_as_uint(x), __float_as_uint(x), false, false); return __uint_as_float(r[0]) + __uint_as_float(r[1]); }
__device__ __forceinline__ float max_x32(float x) { const auto r = __builtin_amdgcn_permlane32_swap(__float_as_uint(x), __float_as_uint(x), false, false); return fmaxf(__uint_as_float(r[0]), __uint_as_float(r[1])); }
__device__ __forceinline__ float wave_sum(float x) { x = sum16(x); x += xor16_f(x); return sum_x32(x); }
__device__ __forceinline__ float max16(float x) { x = fmaxf(x, dpp_f<0xB1>(x)); x = fmaxf(x, dpp_f<0x4E>(x)); x = fmaxf(x, dpp_f<0x141>(x)); x = fmaxf(x, dpp_f<0x140>(x)); return x; }
__device__ __forceinline__ float wave_max(float x) { x = max16(x); x = fmaxf(x, xor16_f(x)); return max_x32(x); }
__device__ __forceinline__ float rcpf_(float x) { return __builtin_amdgcn_rcpf(x); }
__device__ __forceinline__ float sigmoidf_(float x) { return rcpf_(1.0f + __expf(-x)); }
__device__ __forceinline__ float siluf_(float x) { return x * rcpf_(1.0f + __expf(-x)); }
__device__ __forceinline__ float tanhf_(float x) { const float e = __expf(2.0f * x); return 1.0f - 2.0f * rcpf_(e + 1.0f); }
__device__ __forceinline__ float geluf_(float x) { return 0.5f * x * (1.0f + tanhf_(0.7978845608028654f * (x + 0.044715f * x * x * x))); }

namespace pg8 {
#define PG8_LAS __attribute__((address_space(3)))
typedef unsigned short bf16_t;
typedef short bf16x8 __attribute__((ext_vector_type(8)));
typedef float f32x4 __attribute__((ext_vector_type(4)));
typedef unsigned u32x4 __attribute__((ext_vector_type(4)));
constexpr int BM = 256, BK = 64, HALF = 128, HTB = HALF * BK * 2  , STAGE_BYTES = 8 * HTB, NXCD = 8, WGM = 8;

__host__ __device__ __forceinline__ int lds_byte(int r, int c) { const int st = (r >> 4) * 2 + (c >> 5), rr = r & 15, cc = c & 31, ob = rr * 64 + cc * 2; return st * 1024 + (ob ^ (((ob >> 9) & 1) << 5)); }
__host__ __device__ __forceinline__ void stage_rc(int b, int& R, int& C) { const int st = b / 1024, sb = b % 1024, swz = sb ^ (((sb >> 9) & 1) << 5); R = (st >> 1) * 16 + swz / 64; C = (st & 1) * 32 + (swz % 64) / 2; }
__host__ __device__ __forceinline__ int perm32(int rho) { const int n = rho >> 4, i = rho & 15; return 8 * (i >> 2) + 4 * n + (i & 3); }

struct Unit { int pm, pn; };
struct Gemm { const bf16_t* A; const bf16_t* Bt; int M, N, K; };

struct StaticOrder {
    int nM, nN, nwg, G, c;
    __host__ __device__ void init(int M, int N, int G_, int c_) { nM = M / BM; nN = N / BM; nwg = nM * nN; G = G_; c = c_; }
    __host__ __device__ bool next(int i, Unit& u) const {
        const long L = (long)i * G + c; if (L >= nwg) return false;
        int wgid = (int)L; { const int q = nwg / NXCD, r = nwg % NXCD, xcd = wgid % NXCD, off = wgid / NXCD; wgid = (xcd < r ? xcd * (q + 1) : r * (q + 1) + (xcd - r) * q) + off; }
        const int nig = WGM * nN, gid = wgid / nig, fm = gid * WGM, gsz = (nM - fm) < WGM ? (nM - fm) : WGM;
        u.pm = fm + ((wgid % nig) % gsz); u.pn = (wgid % nig) / gsz; return true;
    }
    __device__ __forceinline__ void a_ready(const Unit&) const {}
    __device__ __forceinline__ void done(const Unit&) const {}
};

__device__ __forceinline__ unsigned cvt_pk_bf16(float lo, float hi) { return ::pk_bf16(lo, hi); }
struct EpiBf16 {
    static constexpr bool PERM = true, AFTER_DRAIN = false;
    bf16_t* O; int ldc;
    __device__ __forceinline__ void operator()(const f32x4 (&acc)[2][2][4][2], const Unit& u, int wr, int wc, int fr, int fq) const {
        const int row0 = u.pm * BM + wr * 64 + fr; const int col0 = u.pn * BM + wc * 32 + 8 * fq;
#pragma unroll
        for (int ai = 0; ai < 2; ++ai)
#pragma unroll
            for (int m = 0; m < 4; ++m) { bf16_t* rowp = O + (size_t)(row0 + ai * HALF + m * 16) * ldc + col0;
#pragma unroll
                for (int bj = 0; bj < 2; ++bj) { const f32x4 v0 = acc[ai][bj][m][0], v1 = acc[ai][bj][m][1];
                    u32x4 w; w.x = cvt_pk_bf16(v0[0], v0[1]); w.y = cvt_pk_bf16(v0[2], v0[3]); w.z = cvt_pk_bf16(v1[0], v1[1]); w.w = cvt_pk_bf16(v1[2], v1[3]);
                    *(u32x4*)(rowp + bj * HALF) = w; } }
    }
};
struct EpiResid {
    static constexpr bool PERM = false, AFTER_DRAIN = false;
    const float* xi_lat; const float* xi_ctx; float* xo_lat; float* xo_ctx; const float* gate;
    __device__ __forceinline__ void operator()(const f32x4 (&acc)[2][2][4][2], const Unit& u, int wr, int wc, int fr, int fq) const {
        const bool isctx = u.pm >= 64; const int v = isctx ? 4 : (u.pm >> 4);
        const int row0 = (isctx ? (u.pm - 64) : u.pm) * BM + wr * 64 + fr, col0 = u.pn * BM + wc * 32 + 4 * fq;
        const float* xi = isctx ? xi_ctx : xi_lat; float* xo = isctx ? xo_ctx : xo_lat;
        const float* gp = gate + (size_t)v * 12288 + col0;
        f32x4 gv[2][2];
#pragma unroll
        for (int bj = 0; bj < 2; ++bj)
#pragma unroll
            for (int n = 0; n < 2; ++n) gv[bj][n] = *(const f32x4*)(gp + bj * HALF + n * 16);
#pragma unroll
        for (int ai = 0; ai < 2; ++ai)
#pragma unroll
            for (int m = 0; m < 4; ++m) { const size_t off = (size_t)(row0 + ai * HALF + m * 16) * 2048 + col0;
#pragma unroll
                for (int bj = 0; bj < 2; ++bj)
#pragma unroll
                    for (int n = 0; n < 2; ++n) { const f32x4 xv = *(const f32x4*)(xi + off + bj * HALF + n * 16);
                        *(f32x4*)(xo + off + bj * HALF + n * 16) = xv + gv[bj][n] * acc[ai][bj][m][n]; }
                asm volatile("" ::: "memory"); }
    }
};

template <class Epi, class Sched>
__device__ __forceinline__ void gemm_phase(PG8_LAS unsigned char* lds, const Gemm g, const Sched& S, const Epi& E, const int tid) {
    const int wid = __builtin_amdgcn_readfirstlane(tid >> 6), lane = tid & 63, wr = wid >> 2, wc = wid & 3, fr = lane & 15, fq = lane >> 4;
    const int K = g.K, nt = K / BK;
    unsigned voffA[2], voffB[2];
#pragma unroll
    for (int i = 0; i < 2; ++i) { int R, C; stage_rc(tid * 16 + i * 8192, R, C); const int Rb = Epi::PERM ? ((R & ~31) + perm32(R & 31)) : R;
        voffA[i] = (unsigned)(R * K + C) * 2u; voffB[i] = (unsigned)(Rb * K + C) * 2u; }
    const size_t kstep = (size_t)(BK * 2);
    const size_t hstep = (size_t)HALF * K * 2;
    const size_t tstep = 2 * hstep;
    const unsigned ldsw = (unsigned)wid * 1024u;
    const int aoff = lds_byte(wr * 64 + fr, fq * 8), boff = lds_byte(wc * 32 + fr, fq * 8);
#define PG8_SA(b, h) (((b) * 2 + (h)) * HTB)
#define PG8_SB(b, h) ((4 + (b) * 2 + (h)) * HTB)
#define PG8_STAGE(bufoff, gbase, voff) do { _Pragma("unroll") for (int _i = 0; _i < 2; ++_i) \
        __builtin_amdgcn_global_load_lds((const unsigned*)((const char*)(gbase) + (voff)[_i]), (PG8_LAS unsigned*)(lds + (bufoff) + ldsw + _i * 8192), 16, 0, 0); } while (0)
#define PG8_LDA(dst, b, h) do { _Pragma("unroll") for (int m = 0; m < 4; ++m) _Pragma("unroll") for (int k = 0; k < 2; ++k) dst[m][k] = *(const PG8_LAS bf16x8*)(lds + PG8_SA(b, h) + aoff + m * 2048 + k * 1024); } while (0)
#define PG8_LDB(dst, b, h) do { _Pragma("unroll") for (int n = 0; n < 2; ++n) _Pragma("unroll") for (int k = 0; k < 2; ++k) dst[n][k] = *(const PG8_LAS bf16x8*)(lds + PG8_SB(b, h) + boff + n * 2048 + k * 1024); } while (0)
#define PG8_MMA(ai, bj, At, Bt) do { __builtin_amdgcn_s_setprio(1); _Pragma("unroll") for (int m = 0; m < 4; ++m) _Pragma("unroll") for (int n = 0; n < 2; ++n) _Pragma("unroll") for (int k = 0; k < 2; ++k) \
        acc[ai][bj][m][n] = __builtin_amdgcn_mfma_f32_16x16x32_bf16(Bt[n][k], At[m][k], acc[ai][bj][m][n], 0, 0, 0); __builtin_amdgcn_s_setprio(0); } while (0)
#define PG8_WAIT_V(n) asm volatile("s_waitcnt vmcnt(" #n ")" ::: "memory")
#define PG8_WAIT_L(n) asm volatile("s_waitcnt lgkmcnt(" #n ")" ::: "memory")
#define PG8_BAR __builtin_amdgcn_s_barrier()
#define PG8_SCHED __builtin_amdgcn_sched_barrier(0)
    Unit cur, nxt; int ui = 0;
    if (!S.next(0, cur)) return;
    f32x4 acc[2][2][4][2];
#pragma unroll
    for (int a = 0; a < 2; ++a)
#pragma unroll
        for (int b = 0; b < 2; ++b)
#pragma unroll
            for (int m = 0; m < 4; ++m)
#pragma unroll
                for (int n = 0; n < 2; ++n) acc[a][b][m][n] = (f32x4){0.f, 0.f, 0.f, 0.f};
    bf16x8 At[4][2], B0[2][2], B1[2][2];
    const char* cA = (const char*)g.A + (size_t)cur.pm * tstep; const char* cB = (const char*)g.Bt + (size_t)cur.pn * tstep;
    S.a_ready(cur);
    PG8_STAGE(PG8_SB(0, 0), cB, voffB); PG8_STAGE(PG8_SA(0, 0), cA, voffA); PG8_STAGE(PG8_SB(0, 1), cB + hstep, voffB); PG8_STAGE(PG8_SA(0, 1), cA + hstep, voffA);
    if (wr == 1) PG8_BAR;
    PG8_WAIT_V(4); PG8_BAR;
    PG8_STAGE(PG8_SB(1, 0), cB + kstep, voffB); PG8_STAGE(PG8_SA(1, 0), cA + kstep, voffA); PG8_STAGE(PG8_SB(1, 1), cB + hstep + kstep, voffB);
    PG8_WAIT_V(6); PG8_BAR;
    for (;;) {
        const bool has_next = S.next(ui + 1, nxt);
        const char* nA = has_next ? (const char*)g.A + (size_t)nxt.pm * tstep : cA; const char* nB = has_next ? (const char*)g.Bt + (size_t)nxt.pn * tstep : cB;
        for (int t = 0; t < nt; t += 2) {
            const bool last = (t == nt - 2);
            const char* a1 = cA + (size_t)(t + 1) * kstep;
            const char* a2 = last ? nA : cA + (size_t)(t + 2) * kstep; const char* b2 = last ? nB : cB + (size_t)(t + 2) * kstep;
            const char* a3 = a2 + kstep; const char* b3 = b2 + kstep;
            if (last && has_next) S.a_ready(nxt);
            PG8_LDB(B0, 0, 0); PG8_SCHED; PG8_LDA(At, 0, 0); PG8_STAGE(PG8_SA(1, 1), a1 + hstep, voffA);
            PG8_WAIT_L(8); PG8_BAR; PG8_WAIT_L(0); PG8_MMA(0, 0, At, B0); PG8_BAR; PG8_SCHED;
            PG8_LDB(B1, 0, 1); PG8_STAGE(PG8_SB(0, 0), b2, voffB);
            PG8_BAR; PG8_WAIT_L(0); PG8_MMA(0, 1, At, B1); PG8_BAR;
            PG8_LDA(At, 0, 1); PG8_STAGE(PG8_SA(0, 0), a2, voffA);
            PG8_BAR; PG8_WAIT_L(0); PG8_MMA(1, 0, At, B0); PG8_BAR; PG8_SCHED;
            PG8_STAGE(PG8_SB(0, 1), b2 + hstep, voffB);
            PG8_WAIT_V(6); PG8_BAR; PG8_MMA(1, 1, At, B1); PG8_BAR;
            PG8_LDB(B0, 1, 0); PG8_SCHED; PG8_LDA(At, 1, 0); PG8_STAGE(PG8_SA(0, 1), a2 + hstep, voffA);
            PG8_WAIT_L(8); PG8_BAR; PG8_WAIT_L(0); PG8_MMA(0, 0, At, B0); PG8_BAR; PG8_SCHED;
            PG8_LDB(B1, 1, 1); PG8_STAGE(PG8_SB(1, 0), b3, voffB);
            PG8_BAR; PG8_WAIT_L(0); PG8_MMA(0, 1, At, B1); PG8_BAR;
            PG8_LDA(At, 1, 1); PG8_STAGE(PG8_SA(1, 0), a3, voffA);
            PG8_BAR; PG8_WAIT_L(0); PG8_MMA(1, 0, At, B0); PG8_BAR; PG8_SCHED;
            PG8_STAGE(PG8_SB(1, 1), b3 + hstep, voffB);
            PG8_WAIT_V(6); PG8_BAR; PG8_MMA(1, 1, At, B1); PG8_BAR;
        }
        if constexpr (!Epi::AFTER_DRAIN) { E(acc, cur, wr, wc, fr, fq); S.done(cur); }
        if (!has_next) break;
#pragma unroll
        for (int a = 0; a < 2; ++a)
#pragma unroll
            for (int b = 0; b < 2; ++b)
#pragma unroll
                for (int m = 0; m < 4; ++m)
#pragma unroll
                    for (int n = 0; n < 2; ++n) acc[a][b][m][n] = (f32x4){0.f, 0.f, 0.f, 0.f};
        cur = nxt; cA = nA; cB = nB; ++ui;
    }
    PG8_WAIT_V(0);
    if (wr == 0) PG8_BAR;
    PG8_BAR;
    if constexpr (Epi::AFTER_DRAIN) { E.fused(acc, cur, wr, wc, fr, fq, lds, wid, lane); S.done(cur); }
#undef PG8_SA
#undef PG8_SB
#undef PG8_STAGE
#undef PG8_LDA
#undef PG8_LDB
#undef PG8_MMA
#undef PG8_WAIT_V
#undef PG8_WAIT_L
#undef PG8_BAR
#undef PG8_SCHED
}
}

#define XB_TMO      128
#define XB_XCNT(j)  (256  + 64 * (j))
#define XB_XSUB(j)  (1280 + 64 * (j))
#define XB_XGEN(j)  (2304 + 64 * (j))
#define XB_TOP      3328
#define XB_TOPGEN   3392
#define XCD_BAR_WORDS 3456
#define XB_SPIN_CAP (1u << 18)
#define LAS __attribute__((address_space(3)))

__device__ __forceinline__ unsigned xb_ld(unsigned* p)              { return __hip_atomic_load(p, __ATOMIC_RELAXED, __HIP_MEMORY_SCOPE_AGENT); }
__device__ __forceinline__ unsigned xb_add(unsigned* p, unsigned v) { return __hip_atomic_fetch_add(p, v, __ATOMIC_RELAXED, __HIP_MEMORY_SCOPE_AGENT); }
__device__ __forceinline__ unsigned xb_xcc_id() { return (unsigned)__builtin_amdgcn_s_getreg((3 << 11) | 20) & 0xFu; }
#define XB_SPIN(cond, bar) do { unsigned _sp = 0; while (cond) { __builtin_amdgcn_s_sleep(1); \
    if ((++_sp & 255u) == 0u) { if (xb_ld(&(bar)[XB_TMO])) break; if (_sp > XB_SPIN_CAP) { atomicAdd(&(bar)[XB_TMO], 1u); break; } } } } while (0)

struct XcdBarrier {
    unsigned* bar; unsigned x;
    volatile LAS unsigned* st;
};

__device__ __forceinline__ XcdBarrier xcd_barrier_post(unsigned* bar, volatile LAS unsigned* st) {
    XcdBarrier b; b.bar = bar; b.x = xb_xcc_id(); b.st = st;
    if (threadIdx.x == 0) (void)xb_add(&bar[XB_XCNT(b.x)], 1u);
    return b;
}
__device__ __forceinline__ void xcd_barrier_complete(unsigned* bar, unsigned x, unsigned& nloc, unsigned& nx) {
    const unsigned G = gridDim.x * gridDim.y * gridDim.z;
    unsigned sum, cnt, mine, sp = 0u;
    for (;;) {
        sum = 0u; cnt = 0u; mine = 0u;
#pragma unroll
        for (unsigned j = 0; j < 16; ++j) { const unsigned c = xb_ld(&bar[XB_XCNT(j)]); sum += c; cnt += (c > 0u) ? 1u : 0u; mine = (j == x) ? c : mine; }
        if (sum == G) break;
        __builtin_amdgcn_s_sleep(1);
        if ((++sp & 255u) == 0u) { if (xb_ld(&bar[XB_TMO])) break; if (sp > XB_SPIN_CAP) { atomicAdd(&bar[XB_TMO], 1u); break; } }
    }
    nloc = mine > 0u ? mine : 1u; nx = cnt > 0u ? cnt : 1u;
}

__device__ __forceinline__ void xcd_barrier(const XcdBarrier& b) {
    asm volatile("s_waitcnt vmcnt(0)" ::: "memory");
    __syncthreads();
    if (threadIdx.x == 0) {
        unsigned* bar = b.bar;
        __builtin_amdgcn_s_waitcnt(0);
        unsigned nloc = b.st[0], nx = b.st[1];
        if (nloc == 0u) { xcd_barrier_complete(bar, b.x, nloc, nx); b.st[0] = nloc; b.st[1] = nx; }
        const unsigned old = xb_add(&bar[XB_XSUB(b.x)], 1u);
        const unsigned gen = old / nloc;
        if (old + 1u == (gen + 1u) * nloc) {
            __builtin_amdgcn_fence(__ATOMIC_RELEASE, "agent");
            asm volatile("s_waitcnt vmcnt(0)" ::: "memory");
            const unsigned og = xb_add(&bar[XB_TOP], 1u);
            const unsigned tg = og / nx;
            if (og + 1u == (tg + 1u) * nx) xb_add(&bar[XB_TOPGEN], 1u);
            else XB_SPIN(xb_ld(&bar[XB_TOPGEN]) == tg, bar);
            __builtin_amdgcn_fence(__ATOMIC_ACQUIRE, "agent");
            xb_add(&bar[XB_XGEN(b.x)], 1u);
            asm volatile("s_waitcnt vmcnt(0)" ::: "memory");
        } else {
            XB_SPIN(xb_ld(&bar[XB_XGEN(b.x)]) == gen, bar);
            __builtin_amdgcn_fence(__ATOMIC_ACQUIRE, "agent");
            asm volatile("s_waitcnt vmcnt(0)" ::: "memory");
        }
    }
    __syncthreads();
}

typedef const float* cfp_t;
typedef __attribute__((address_space(4))) const cfp_t* ka_t;
struct Ctx {
    LAS unsigned char* lds; int tid, lane, wave, bid, G;
};

__device__ __forceinline__ void task_ada(const Ctx& F, const float* c, const float* c_ctx, const float* w_ada, float* modp, int task) {
    LAS float* s_act = (LAS float*)F.lds;
    const int l = task / (KSPL * 6), rem = task % (KSPL * 6), ks = rem / 6, cc = rem % 6;
    __syncthreads();
    if (F.tid < 320) { const int v = F.tid >> 6, k = ks * 64 + (F.tid & 63); const float x = v < 4 ? c[v * 2048 + k] : c_ctx[k]; s_act[F.tid] = siluf_(x); }
    __syncthreads();
    const int col4 = cc * 512 + F.tid;
    const float4* wp = (const float4*)(w_ada + ((size_t)l * 2048 + ks * 64) * 12288) + col4;
    float4 acc[5];
#pragma unroll
    for (int v = 0; v < 5; ++v) acc[v] = make_float4(0.f, 0.f, 0.f, 0.f);
#pragma unroll 8
    for (int k = 0; k < 64; ++k) {
        const float4 w = wp[(size_t)k * 3072];
#pragma unroll
        for (int v = 0; v < 5; ++v) { const float a = s_act[v * 64 + k]; acc[v].x += a * w.x; acc[v].y += a * w.y; acc[v].z += a * w.z; acc[v].w += a * w.w; }
    }
#pragma unroll
    for (int v = 0; v < 5; ++v) ((float4*)(modp + (((size_t)ks * 2 + l) * 5 + v) * 12288))[col4] = acc[v];
}
__device__ __forceinline__ void task_wt(const Ctx& F, const float* W, int N, bf16_t* Wt, int ntile) {
    LAS bf16_t* T = (LAS bf16_t*)F.lds;
    const int nq = F.tid & 15, kr = F.tid >> 4, n0 = ntile * 64;
    for (int kc = 0; kc < 16; ++kc) {
        float4 v[4];
#pragma unroll
        for (int j = 0; j < 4; ++j) { const int k = kc * 128 + kr + 32 * j, n = n0 + 4 * nq;
            v[j] = (n < N) ? *(const float4*)(W + (size_t)k * N + n) : make_float4(0.f, 0.f, 0.f, 0.f); }
        __syncthreads();
#pragma unroll
        for (int j = 0; j < 4; ++j) { const int kl = kr + 32 * j;
            T[(4 * nq + 0) * 136 + kl] = f2bf(v[j].x); T[(4 * nq + 1) * 136 + kl] = f2bf(v[j].y); T[(4 * nq + 2) * 136 + kl] = f2bf(v[j].z); T[(4 * nq + 3) * 136 + kl] = f2bf(v[j].w); }
        __syncthreads();
        { const int n = F.tid >> 3, kg = F.tid & 7;
          const u32x4 a = *(LAS u32x4*)(T + n * 136 + kg * 16), b = *(LAS u32x4*)(T + n * 136 + kg * 16 + 8);
          bf16_t* dst = Wt + (size_t)(n0 + n) * 2048 + kc * 128 + kg * 16; *(u32x4*)dst = a; *(u32x4*)(dst + 8) = b; }
    }
    __syncthreads();
}
__device__ __forceinline__ void task_cvt(const Ctx& F, const float* src, bf16_t* dst, size_t off) {
#pragma unroll 4
    for (int it = 0; it < 16; ++it) { const size_t e = off + (size_t)it * 4096 + F.tid * 8;
        const float4 a = *(const float4*)(src + e), b = *(const float4*)(src + e + 4);
        u32x4 o; o.x = pk_bf16(a.x, a.y); o.y = pk_bf16(a.z, a.w); o.z = pk_bf16(b.x, b.y); o.w = pk_bf16(b.z, b.w);
        *(u32x4*)(dst + e) = o; }
}
__device__ __forceinline__ void task_cvt8(const Ctx& F, const float* src, unsigned char* dst, size_t off, float scale) {
#pragma unroll 2
    for (int it = 0; it < 8; ++it) { const size_t e = off + (size_t)it * 8192 + F.tid * 16;
        u32x4 o;
#pragma unroll
        for (int w = 0; w < 4; ++w) { const float4 a = *(const float4*)(src + e + 4 * w);
            const float x0 = fminf(fmaxf(a.x * scale, -448.f), 448.f), x1 = fminf(fmaxf(a.y * scale, -448.f), 448.f), x2 = fminf(fmaxf(a.z * scale, -448.f), 448.f), x3 = fminf(fmaxf(a.w * scale, -448.f), 448.f);
            int p = __builtin_amdgcn_cvt_pk_fp8_f32(x0, x1, 0, false); p = __builtin_amdgcn_cvt_pk_fp8_f32(x2, x3, p, true); o[w] = (unsigned)p; }
        const size_t row = e >> 11; const int col = (int)(e & 2047);
        *(u32x4*)(dst + (row >> 14) * ((size_t)16384 * 2048) + ((size_t)(col >> 7) * 16384 + (row & 16383)) * 128 + (col & 127)) = o; }
}
constexpr float PEER_U_SCALE = 64.0f;
#define PEER_CONVERT_LAYER(F, in, ws, layer, blk, nblk) do { for (int t_ = (blk); t_ < 1024; t_ += (nblk)) { const bool isv_ = t_ >= 512; \
        task_cvt8(F, in[isv_ ? I_PV : I_PU], ws + (isv_ ? WS_PV : WS_PU), (size_t)(layer) * 16384 * 2048 + (size_t)(t_ & 511) * 65536, isv_ ? 1.0f : PEER_U_SCALE); } } while (0)
__device__ __forceinline__ void task_lorat(const Ctx& F, const float* src, bf16_t* dst, int nj) {
    const int ch = F.tid;
    for (int j8 = 0; j8 < nj / 8; ++j8) { float v[8];
#pragma unroll
        for (int q = 0; q < 8; ++q) v[q] = src[(size_t)(j8 * 8 + q) * 512 + ch];
        u32x4 o; o.x = pk_bf16(v[0], v[1]); o.y = pk_bf16(v[2], v[3]); o.z = pk_bf16(v[4], v[5]); o.w = pk_bf16(v[6], v[7]);
        *(u32x4*)(dst + (size_t)ch * nj + j8 * 8) = o; }
}
constexpr int T_ADA = 2 * KSPL * 6, T_WT1 = 2 * 104, T_WT2 = 2 * 32, T_WT3 = 2 * 32, T_PEER = 0, T_KEYS = 8, T_LORA = 10;
__device__ __forceinline__ void phase_prologue(const Ctx& F, ka_t in, unsigned char* ws) {
    const int total = T_ADA + T_WT1 + T_WT2 + T_WT3 + T_PEER + T_KEYS + T_LORA + 1;
    for (int t0 = F.bid; t0 < total; t0 += F.G) {
        int t = t0;
        if (t < T_ADA) { task_ada(F, in[I_C], in[I_CCTX], in[I_WADA], (float*)(ws + WS_MODP), t); continue; } t -= T_ADA;
        if (t < T_WT1) { const int l = t / 104, nt = t % 104; task_wt(F, in[I_WIN] + (size_t)l * 2048 * PT, PT, (bf16_t*)(ws + WS_WIN) + (size_t)l * PTP * 2048, nt); continue; } t -= T_WT1;
        if (t < T_WT2) { const int l = t / 32, nt = t % 32; task_wt(F, in[I_WOUT] + (size_t)l * 2048 * 2048, 2048, (bf16_t*)(ws + WS_WOUT) + (size_t)l * 2048 * 2048, nt); continue; } t -= T_WT2;
        if (t < T_WT3) { const int l = t / 32, nt = t % 32; task_wt(F, in[I_PWQ] + (size_t)l * 2048 * 2048, 2048, (bf16_t*)(ws + WS_WQ) + (size_t)l * 2048 * 2048, nt); continue; } t -= T_WT3;
        if (t < T_PEER) { const bool isv = t >= 1024; const int c = t & 1023; task_cvt8(F, in[isv ? I_PV : I_PU], ws + (isv ? WS_PV : WS_PU), (size_t)c * 65536, isv ? 1.0f : PEER_U_SCALE); continue; } t -= T_PEER;
        if (t < T_KEYS) { task_cvt(F, in[I_PKEYS], (bf16_t*)(ws + WS_KEYS), (size_t)t * 65536); continue; } t -= T_KEYS;
        if (t < T_LORA) {
            if (t < 8) { const int l = t >> 2, wh = t & 3;
                task_lorat(F, in[wh < 2 ? I_RWUP : I_RAUP] + ((size_t)l * 2 + (wh & 1)) * 64 * 512, (bf16_t*)(ws + WS_WUPT) + ((size_t)l * 4 + wh) * 512 * 64, 64); }
            else { const int l = t - 8; task_lorat(F, in[I_RGUP] + (size_t)l * 128 * 512, (bf16_t*)(ws + WS_GUPT) + (size_t)l * 512 * 128, 128); }
            continue; } t -= T_LORA;
        { float* rope = (float*)(ws + WS_ROPE);
          for (int e = F.tid; e < 2048; e += 512) { const int pos = e >> 5, i = e & 31; const float fr = powf(10000.0f, -(float)i / 32.0f), ang = (float)pos * fr;
              rope[2 * e] = cosf(ang); rope[2 * e + 1] = sinf(ang); } }
    }
}
__device__ __forceinline__ void phase_modreduce(const Ctx& F, const float* b_ada, const float* modp, float* mod) {
    for (int idx = F.bid * 512 + F.tid; idx < 2 * 5 * 12288; idx += F.G * 512) {
        const int l = idx / 61440, rem = idx % 61440, v = rem / 12288, n = rem % 12288;
        float s = b_ada[l * 12288 + n];
        for (int ks = 0; ks < KSPL; ++ks) s += modp[(((size_t)ks * 2 + l) * 5 + v) * 12288 + n];
        mod[idx] = s;
    }
}

__device__ __forceinline__ void norm_store(const float (&x)[32], const float* gw, const float* shift, const float* scale, bf16_t* dst, int lane) {
    float ss = 0.f;
#pragma unroll
    for (int q = 0; q < 32; ++q) ss += x[q] * x[q];
    ss = wave_sum(ss);
    const float rs = rsqrtf(ss * (1.0f / 2048.0f) + 1e-6f);
#pragma unroll
    for (int j = 0; j < 4; ++j) { const int e = j * 512 + lane * 8;
        const float4 g0 = *(const float4*)(gw + e), g1 = *(const float4*)(gw + e + 4), h0 = *(const float4*)(shift + e), h1 = *(const float4*)(shift + e + 4), c0 = *(const float4*)(scale + e), c1 = *(const float4*)(scale + e + 4);
        const float y0 = x[j * 8 + 0] * rs * g0.x * (1.f + c0.x) + h0.x, y1 = x[j * 8 + 1] * rs * g0.y * (1.f + c0.y) + h0.y, y2 = x[j * 8 + 2] * rs * g0.z * (1.f + c0.z) + h0.z, y3 = x[j * 8 + 3] * rs * g0.w * (1.f + c0.w) + h0.w;
        const float y4 = x[j * 8 + 4] * rs * g1.x * (1.f + c1.x) + h1.x, y5 = x[j * 8 + 5] * rs * g1.y * (1.f + c1.y) + h1.y, y6 = x[j * 8 + 6] * rs * g1.z * (1.f + c1.z) + h1.z, y7 = x[j * 8 + 7] * rs * g1.w * (1.f + c1.w) + h1.w;
        u32x4 o; o.x = pk_bf16(y0, y1); o.y = pk_bf16(y2, y3); o.z = pk_bf16(y4, y5); o.w = pk_bf16(y6, y7);
        *(u32x4*)(dst + e) = o; }
}
__device__ __forceinline__ void phase_norm(const Ctx& F, const float* xlat, const float* xctx, const float* gw, const float* mod, int shift_i, int scale_i, bf16_t* dst, int nrows) {
    for (int row = F.bid * 8 + F.wave; row < nrows; row += F.G * 8) {
        const bool isctx = row >= NLAT; const float* xr = isctx ? xctx + (size_t)(row - NLAT) * 2048 : xlat + (size_t)row * 2048;
        const int v = isctx ? 4 : (row >> 12);
        float x[32];
#pragma unroll
        for (int j = 0; j < 4; ++j) { const int e = j * 512 + F.lane * 8; const float4 a = *(const float4*)(xr + e), b = *(const float4*)(xr + e + 4);
            x[j * 8 + 0] = a.x; x[j * 8 + 1] = a.y; x[j * 8 + 2] = a.z; x[j * 8 + 3] = a.w; x[j * 8 + 4] = b.x; x[j * 8 + 5] = b.y; x[j * 8 + 6] = b.z; x[j * 8 + 7] = b.w; }
        norm_store(x, gw, mod + (size_t)v * 12288 + shift_i * 2048, mod + (size_t)v * 12288 + scale_i * 2048, dst + (size_t)row * 2048, F.lane);
    }
}

struct LayerW {
    const float *sc_w, *rw_w0, *rw_wup, *rw_a0, *rw_aup, *rw_gup, *rw_kk, *rw_ka, *rw_rk, *rw_lnw, *rw_lnb, *na_q, *na_k, *rpb, *s_cw, *s_cb, *s_dtb, *s_alog, *s_d, *s_norm;
};
__device__ __forceinline__ void unpack8(const u32x4 q, float (&f)[8]) { f[0] = bflo(q[0]); f[1] = bfhi(q[0]); f[2] = bflo(q[1]); f[3] = bfhi(q[1]); f[4] = bflo(q[2]); f[5] = bfhi(q[2]); f[6] = bflo(q[3]); f[7] = bfhi(q[3]); }
__device__ __forceinline__ u32x4 pack8f(const float (&f)[8]) { u32x4 o; o[0] = pk_bf16(f[0], f[1]); o[1] = pk_bf16(f[2], f[3]); o[2] = pk_bf16(f[4], f[5]); o[3] = pk_bf16(f[6], f[7]); return o; }
__device__ __forceinline__ void load8f(const float* p, float (&f)[8]) { const float4 a = *(const float4*)p, b = *(const float4*)(p + 4); f[0] = a.x; f[1] = a.y; f[2] = a.z; f[3] = a.w; f[4] = b.x; f[5] = b.y; f[6] = b.z; f[7] = b.w; }
__device__ __forceinline__ void phase_prep(const Ctx& F, const LayerW& W, unsigned char* ws) {
    const bf16_t* P = (const bf16_t*)(ws + WS_P);
    bf16_t* MIX = (bf16_t*)(ws + WS_MIX);
    bf16_t* XBC = (bf16_t*)(ws + WS_XBC); float* DTS = (float*)(ws + WS_DTS); float* DEC = (float*)(ws + WS_DEC);
    bf16_t* QN = (bf16_t*)(ws + WS_QN); bf16_t* KN = (bf16_t*)(ws + WS_KN); bf16_t* VTL = (bf16_t*)(ws + WS_VTL); bf16_t* VTC = (bf16_t*)(ws + WS_VTC);
    const float* ROPE = (const float*)(ws + WS_ROPE);
    for (int tile = F.bid; tile < NTOK / 8; tile += F.G) {
        int ln = F.lane; asm volatile("" : "+v"(ln));
        const int ch0 = ln * 8;
        const bool lat = tile < NLAT / 8;
        const int b = lat ? (tile >> 9) : ((tile - NLAT / 8) >> 5);
        const int t0 = lat ? (tile & 511) * 8 : ((tile - NLAT / 8) & 31) * 8;
        const int L = lat ? SEQL : CTXL;
        const int g0 = lat ? b * SEQL + t0 : NLAT + b * CTXL + t0;
        const bf16_t* Pr = P + (size_t)g0 * PTP;
        if (F.wave == 0 || F.wave == 4) {
            const bool gated = F.wave == 0;
            const float* cw = gated ? W.sc_w : W.s_cw; const int cstride = gated ? 512 : 1024;
            float w0[8], w1[8], w2[8], cb[8];
            load8f(cw + ch0, w0); load8f(cw + cstride + ch0, w1); load8f(cw + 2 * cstride + ch0, w2);
            if (gated) {
#pragma unroll
                for (int e = 0; e < 8; ++e) cb[e] = 0.f;
            } else load8f(W.s_cb + ch0, cb);
            const int col = gated ? A_CG : D_X;
#pragma unroll 1
            for (int tb = 0; tb < 8; tb += 4) {
            u32x4 ra[6], rb[6], rg[4];
#pragma unroll
            for (int q = 0; q < 6; ++q) { const int tq = t0 + tb - 1 + q; const bool ok = (tq >= 0) && (tq < L);
                ra[q] = ok ? *(const u32x4*)(Pr + (ptrdiff_t)(tb + q - 1) * PTP + col + ch0) : (u32x4){0u, 0u, 0u, 0u};
                if (gated) rb[q] = ok ? *(const u32x4*)(Pr + (ptrdiff_t)(tb + q - 1) * PTP + A_H + ch0) : (u32x4){0u, 0u, 0u, 0u}; }
            if (gated) {
#pragma unroll
                for (int tt = 0; tt < 4; ++tt) rg[tt] = *(const u32x4*)(Pr + (size_t)(tb + tt) * PTP + A_BG + ch0); }
            float up[8], uc[8], un[8];
            { float x[8], y[8]; unpack8(ra[0], x); if (gated) { unpack8(rb[0], y);
#pragma unroll
                for (int e = 0; e < 8; ++e) x[e] *= y[e]; }
#pragma unroll
              for (int e = 0; e < 8; ++e) up[e] = x[e];
              unpack8(ra[1], x); if (gated) { unpack8(rb[1], y);
#pragma unroll
                for (int e = 0; e < 8; ++e) x[e] *= y[e]; }
#pragma unroll
              for (int e = 0; e < 8; ++e) uc[e] = x[e]; }
#pragma unroll
            for (int tt = 0; tt < 4; ++tt) {
                { float x[8], y[8]; unpack8(ra[tt + 2], x); if (gated) { unpack8(rb[tt + 2], y);
#pragma unroll
                    for (int e = 0; e < 8; ++e) x[e] *= y[e]; }
#pragma unroll
                  for (int e = 0; e < 8; ++e) un[e] = x[e]; }
                float o[8];
                if (gated) { float bg[8]; unpack8(rg[tt], bg);
#pragma unroll
                    for (int e = 0; e < 8; ++e) o[e] = bg[e] * (w0[e] * up[e] + w1[e] * uc[e] + w2[e] * un[e]);
                    *(u32x4*)(MIX + (size_t)(g0 + tb + tt) * 2048 + ch0) = pack8f(o);
                } else {
#pragma unroll
                    for (int e = 0; e < 8; ++e) o[e] = siluf_(w0[e] * up[e] + w1[e] * uc[e] + w2[e] * un[e] + cb[e]);
                    *(u32x4*)(XBC + (size_t)(g0 + tb + tt) * 1024 + ch0) = pack8f(o); }
#pragma unroll
                for (int e = 0; e < 8; ++e) { up[e] = uc[e]; uc[e] = un[e]; }
            }
            }
        } else if (F.wave == 1 || F.wave == 2) {
            const bool isq = F.wave == 1; const int col = isq ? C_Q : C_K; bf16_t* dst = isq ? QN : KN;
            float nw[8]; load8f((isq ? W.na_q : W.na_k) + (ln & 7) * 8, nw);
            const float sc = isq ? 0.125f : 1.0f;
            u32x4 rq[8];
#pragma unroll
            for (int tt = 0; tt < 8; ++tt) rq[tt] = *(const u32x4*)(Pr + (size_t)tt * PTP + col + ch0);
#pragma unroll
            for (int tt = 0; tt < 8; ++tt) { float x[8]; unpack8(rq[tt], x); float ss = 0.f;
#pragma unroll
                for (int e = 0; e < 8; ++e) ss += x[e] * x[e];
                ss = sum8(ss); const float rs = rsqrtf(ss * (1.f / 64.f) + 1e-6f) * sc;
#pragma unroll
                for (int e = 0; e < 8; ++e) x[e] = x[e] * rs * nw[e];
                if (isq) *(u32x4*)(dst + (size_t)(g0 + tt) * 512 + ch0) = pack8f(x);
                else {
                    const int hh = ln >> 3, p = ln & 7, t = t0 + tt;
                    bf16_t* kd = lat ? dst + ((size_t)((((b * 8 + hh) * 64 + (t >> 6)) * 2 + (p >> 2)) * 4 + (p & 3)) * 64 + (t & 63)) * 8
                                     : dst + (size_t)NLAT * 512 + ((size_t)(((b * 8 + hh) * 2 + (p >> 2)) * 4 + (p & 3)) * 256 + t) * 8;
                    *(u32x4*)kd = pack8f(x); } }
        } else if (F.wave == 3) {
            u32x4 rv[8];
#pragma unroll
            for (int tt = 0; tt < 8; ++tt) rv[tt] = *(const u32x4*)(Pr + (size_t)tt * PTP + C_V + ch0);
            const int h = ln >> 3;
#pragma unroll
            for (int e = 0; e < 8; ++e) { const int i = (ln & 7) * 8 + e;
                unsigned short v[8];
#pragma unroll
                for (int tt = 0; tt < 8; ++tt) v[tt] = (unsigned short)((e & 1) ? (rv[tt][e >> 1] >> 16) : (rv[tt][e >> 1] & 0xffffu));
                u32x2 c0; c0.x = (unsigned)v[0] | ((unsigned)v[1] << 16); c0.y = (unsigned)v[2] | ((unsigned)v[3] << 16);
                u32x2 c1; c1.x = (unsigned)v[4] | ((unsigned)v[5] << 16); c1.y = (unsigned)v[6] | ((unsigned)v[7] << 16);
                if (lat) { const int row = t0 >> 6, x0 = (t0 & 63) >> 2, x1 = x0 + 1;
                    bf16_t* base = VTL + ((size_t)((b * 8 + h) * 64 + row) * 12 * 64 + i) * 8;
                    if (x0 <= 11) *(u32x2*)(base + x0 * 512) = c0;
                    if (x0 >= 4)  *(u32x2*)(base + (x0 - 4) * 512 + 4) = c0;
                    if (x1 <= 11) *(u32x2*)(base + x1 * 512) = c1;
                    if (x1 >= 4)  *(u32x2*)(base + (x1 - 4) * 512 + 4) = c1;
                } else { const int m = t0 >> 5, o = t0 & 31, gq = (o & 15) >> 2, hf = (o >> 4) * 4;
                    bf16_t* base = VTC + ((size_t)(((b * 8 + h) * 8 + m) * 4) * 64 + i) * 8;
                    *(u32x2*)(base + gq * 512 + hf) = c0; *(u32x2*)(base + (gq + 1) * 512 + hf) = c1; } }
        } else if (F.wave == 5) {
            if (ln < 32) {
                const int pg = ln, which = pg >> 4, gi = (pg >> 3) & 1, half = (pg >> 2) & 1, i0 = (pg & 3) * 8;
                const int c1 = 512 + which * 256 + gi * 128 + half * 64 + i0, c2 = c1 + 32;
                float wa0[8], wa1[8], wa2[8], ba[8], wb0[8], wb1[8], wb2[8], bb[8];
                load8f(W.s_cw + c1, wa0); load8f(W.s_cw + 1024 + c1, wa1); load8f(W.s_cw + 2048 + c1, wa2); load8f(W.s_cb + c1, ba);
                load8f(W.s_cw + c2, wb0); load8f(W.s_cw + 1024 + c2, wb1); load8f(W.s_cw + 2048 + c2, wb2); load8f(W.s_cb + c2, bb);
#pragma unroll 1
                for (int tb = 0; tb < 8; tb += 2) {
                u32x4 ra[4], rb[4];
#pragma unroll
                for (int q = 0; q < 4; ++q) { const int tq = t0 + tb - 1 + q; const bool ok = (tq >= 0) && (tq < L);
                    ra[q] = ok ? *(const u32x4*)(Pr + (ptrdiff_t)(tb + q - 1) * PTP + D_X + c1) : (u32x4){0u, 0u, 0u, 0u};
                    rb[q] = ok ? *(const u32x4*)(Pr + (ptrdiff_t)(tb + q - 1) * PTP + D_X + c2) : (u32x4){0u, 0u, 0u, 0u}; }
                float ap[8], ac[8], an[8], bp[8], bc[8], bn[8];
                unpack8(ra[0], ap); unpack8(ra[1], ac); unpack8(rb[0], bp); unpack8(rb[1], bc);
#pragma unroll
                for (int tt = 0; tt < 2; ++tt) { unpack8(ra[tt + 2], an); unpack8(rb[tt + 2], bn);
                    float y1[8], y2[8];
#pragma unroll
                    for (int e = 0; e < 8; ++e) { y1[e] = siluf_(wa0[e] * ap[e] + wa1[e] * ac[e] + wa2[e] * an[e] + ba[e]); y2[e] = siluf_(wb0[e] * bp[e] + wb1[e] * bc[e] + wb2[e] * bn[e] + bb[e]); }
                    if (lat) { const int t = t0 + tb + tt, pos = half ? (t & 63) : (t >> 6);
                        float cs[16];
#pragma unroll
                        for (int q = 0; q < 4; ++q) { const float4 v = *(const float4*)(ROPE + (size_t)(pos * 32 + i0) * 2 + 4 * q); cs[4 * q] = v.x; cs[4 * q + 1] = v.y; cs[4 * q + 2] = v.z; cs[4 * q + 3] = v.w; }
#pragma unroll
                        for (int e = 0; e < 8; ++e) { const float o1 = y1[e] * cs[2 * e] - y2[e] * cs[2 * e + 1], o2 = y1[e] * cs[2 * e + 1] + y2[e] * cs[2 * e]; y1[e] = o1; y2[e] = o2; } }
                    *(u32x4*)(XBC + (size_t)(g0 + tb + tt) * 1024 + c1) = pack8f(y1); *(u32x4*)(XBC + (size_t)(g0 + tb + tt) * 1024 + c2) = pack8f(y2);
#pragma unroll
                    for (int e = 0; e < 8; ++e) { ap[e] = ac[e]; ac[e] = an[e]; bp[e] = bc[e]; bc[e] = bn[e]; }
                }
                }
            }
        } else if (F.wave == 6) {
#pragma unroll
            for (int q = 0; q < 2; ++q) { const int it = ln + 64 * q, tt = it >> 4, j = it & 15;
                const float x = bf2f(Pr[(size_t)tt * PTP + D_DT + j]) + W.s_dtb[j];
                const float sp = fmaxf(x, 0.f) + log1pf(__expf(-fabsf(x)));
                DTS[(size_t)(g0 + tt) * 16 + j] = sp; DEC[(size_t)(g0 + tt) * 16 + j] = -sp * __expf(W.s_alog[j]); }
        }
    }
}

constexpr int SB_PITCH = 136;
__device__ __forceinline__ void ssd_scan_L(const Ctx& F, LAS float* sL, const float* LA, int g0, int h) {
    const int d = (F.tid >> 7) & 1, t = F.tid & 127;
    float v = 0.f;
    if (F.tid < 256) { v = LA[(size_t)(g0 + t) * 16 + d * 8 + h]; sL[F.tid] = v; }
    __syncthreads();
#pragma unroll
    for (int off = 1; off < 128; off <<= 1) {
        float o = 0.f;
        if (F.tid < 256) { const int tp = d ? t + off : t - off; if (tp >= 0 && tp < 128) o = sL[d * 128 + tp]; }
        __syncthreads();
        if (F.tid < 256) { v += o; sL[F.tid] = v; }
        __syncthreads();
    }
}
template <bool PASS2>
__device__ __forceinline__ void ssd_task(const Ctx& F, const LayerW& W, unsigned char* ws, int task) {
    const bf16_t* XBC = (const bf16_t*)(ws + WS_XBC); const float* DTS = (const float*)(ws + WS_DTS); const float* LA = (const float*)(ws + WS_DEC);
    float* SST = (float*)(ws + WS_SST); float* SCD = (float*)(ws + WS_SCD); float* YS = (float*)(ws + WS_YS);
    const int c = task % NCH, bh = task / NCH, h = bh & 7, b = bh >> 3, gi = h >> 2;
    const int g0 = c < 2 ? NLAT + b * CTXL + c * 128 : b * SEQL + (c - 2) * 128;
    const int w = F.wave, l16 = F.lane & 15, g = F.lane >> 4;
    const f32x4 z4 = {0.f, 0.f, 0.f, 0.f};
    LAS float* sL = (LAS float*)(F.lds + 131072);
    LAS float* sDT = sL + 256;
    __syncthreads();
    if (F.tid < 256) { const int s = F.tid >> 1, d = F.tid & 1; sDT[F.tid] = DTS[(size_t)(g0 + s) * 16 + d * 8 + h]; }
    ssd_scan_L(F, sL, LA, g0, h);
    if (!PASS2) {
        LAS bf16_t* sBT = (LAS bf16_t*)F.lds;
        LAS bf16_t* sXT = sBT + 128 * SB_PITCH;
#pragma unroll
        for (int q = 0; q < 4; ++q) { const int v = F.tid + 512 * q, s = v >> 4, part = v & 15;
            const u32x4 bv = *(const u32x4*)(XBC + (size_t)(g0 + s) * 1024 + 512 + gi * 128 + part * 8);
#pragma unroll
            for (int e = 0; e < 4; ++e) { sBT[(part * 8 + 2 * e) * SB_PITCH + s] = (bf16_t)(bv[e] & 0xffffu); sBT[(part * 8 + 2 * e + 1) * SB_PITCH + s] = (bf16_t)(bv[e] >> 16); } }
#pragma unroll
        for (int q = 0; q < 2; ++q) { const int v = F.tid + 512 * q, s = v >> 3, part = v & 7;
            const u32x4 xv = *(const u32x4*)(XBC + (size_t)(g0 + s) * 1024 + h * 64 + part * 8);
            const float sc0 = sDT[s * 2] * __expf(sL[127] - sL[s]), sc1 = sDT[s * 2 + 1] * __expf(sL[128] - sL[128 + s]);
#pragma unroll
            for (int e = 0; e < 4; ++e) { const float lo = bflo(xv[e]), hi = bfhi(xv[e]); const int p = part * 8 + 2 * e;
                sXT[p * SB_PITCH + s] = f2bf(lo * sc0); sXT[(p + 1) * SB_PITCH + s] = f2bf(hi * sc0);
                sXT[(64 + p) * SB_PITCH + s] = f2bf(lo * sc1); sXT[(64 + p + 1) * SB_PITCH + s] = f2bf(hi * sc1); } }
        __syncthreads();
        bf16x8 bfr[4];
#pragma unroll
        for (int ks = 0; ks < 4; ++ks) bfr[ks] = *(const LAS bf16x8*)(sBT + (16 * w + l16) * SB_PITCH + 32 * ks + 8 * g);
#pragma unroll
        for (int d = 0; d < 2; ++d) {
            float* st = SST + ((size_t)((b * 8 + h) * 2 + d) * NCH + c) * 8192;
#pragma unroll
            for (int pt = 0; pt < 4; ++pt) { f32x4 acc = z4;
#pragma unroll
                for (int ks = 0; ks < 4; ++ks) acc = __builtin_amdgcn_mfma_f32_16x16x32_bf16(*(const LAS bf16x8*)(sXT + (d * 64 + 16 * pt + l16) * SB_PITCH + 32 * ks + 8 * g), bfr[ks], acc, 0, 0, 0);
#pragma unroll
                for (int r = 0; r < 4; ++r) st[(16 * pt + 4 * g + r) * 128 + 16 * w + l16] = acc[r]; }
            if (F.tid == 0) SCD[((b * 8 + h) * 2 + d) * NCH + c] = __expf(d ? sL[128] : sL[127]);
        }
    } else {
        LAS bf16_t* sB = (LAS bf16_t*)F.lds;
        LAS bf16_t* sC = sB + 128 * SB_PITCH;
        LAS bf16_t* sXT = sC + 128 * SB_PITCH;
        LAS bf16_t* sS = sXT + 64 * SB_PITCH;
#pragma unroll
        for (int q = 0; q < 4; ++q) { const int v = F.tid + 512 * q, s = v >> 4, part = v & 15;
            *(LAS u32x4*)(sB + s * SB_PITCH + part * 8) = *(const u32x4*)(XBC + (size_t)(g0 + s) * 1024 + 512 + gi * 128 + part * 8);
            *(LAS u32x4*)(sC + s * SB_PITCH + part * 8) = *(const u32x4*)(XBC + (size_t)(g0 + s) * 1024 + 768 + gi * 128 + part * 8); }
#pragma unroll
        for (int q = 0; q < 2; ++q) { const int v = F.tid + 512 * q, s = v >> 3, part = v & 7;
            const u32x4 xv = *(const u32x4*)(XBC + (size_t)(g0 + s) * 1024 + h * 64 + part * 8);
#pragma unroll
            for (int e = 0; e < 4; ++e) { sXT[(part * 8 + 2 * e) * SB_PITCH + s] = (bf16_t)(xv[e] & 0xffffu); sXT[(part * 8 + 2 * e + 1) * SB_PITCH + s] = (bf16_t)(xv[e] >> 16); } }
#pragma unroll
        for (int q = 0; q < 4; ++q) { const int v = F.tid + 512 * q, d = v >> 10, p = (v >> 4) & 63, part = v & 15;
            const float* sp = SST + ((size_t)((b * 8 + h) * 2 + d) * NCH + c) * 8192 + p * 128 + part * 8;
            const float4 a0 = *(const float4*)sp, a1 = *(const float4*)(sp + 4);
            u32x4 o; o.x = pk_bf16(a0.x, a0.y); o.y = pk_bf16(a0.z, a0.w); o.z = pk_bf16(a1.x, a1.y); o.w = pk_bf16(a1.z, a1.w);
            *(LAS u32x4*)(sS + (d * 64 + p) * SB_PITCH + part * 8) = o; }
        __syncthreads();
        const int t = 16 * w + l16;
        bf16x8 cfr[4];
#pragma unroll
        for (int ks = 0; ks < 4; ++ks) cfr[ks] = *(const LAS bf16x8*)(sC + t * SB_PITCH + 32 * ks + 8 * g);
        f32x4 gt[8];
#pragma unroll
        for (int a = 0; a < 8; ++a) { f32x4 acc = z4;
#pragma unroll
            for (int ks = 0; ks < 4; ++ks) acc = __builtin_amdgcn_mfma_f32_16x16x32_bf16(*(const LAS bf16x8*)(sB + (16 * a + l16) * SB_PITCH + 32 * ks + 8 * g), cfr[ks], acc, 0, 0, 0);
            gt[a] = acc; }
        f32x4 ysum[4] = {z4, z4, z4, z4};
#pragma unroll
        for (int d = 0; d < 2; ++d) {
            const float Lt = sL[d * 128 + t], eLt = __expf(Lt);
            f32x4 acc[4];
#pragma unroll
            for (int pt = 0; pt < 4; ++pt) { f32x4 a = z4;
#pragma unroll
                for (int ks = 0; ks < 4; ++ks) a = __builtin_amdgcn_mfma_f32_16x16x32_bf16(*(const LAS bf16x8*)(sS + (d * 64 + 16 * pt + l16) * SB_PITCH + 32 * ks + 8 * g), cfr[ks], a, 0, 0, 0);
                acc[pt] = a * eLt; }
#pragma unroll
            for (int m = 0; m < 4; ++m) {
                const bool need = d ? (2 * m + 1 >= w) : (2 * m <= w);
                if (need) {
                    f32x4 wt[2];
#pragma unroll
                    for (int u = 0; u < 2; ++u) { const int a = 2 * m + u;
                        const f32x4 Ls = *(const LAS f32x4*)(sL + d * 128 + 16 * a + 4 * g);
#pragma unroll
                        for (int r = 0; r < 4; ++r) { const int s = 16 * a + 4 * g + r; const bool ok = d ? (s >= t) : (s <= t);
                            const float dts = sDT[s * 2 + d];
                            wt[u][r] = ok ? gt[a][r] * __expf(Lt - Ls[r]) * dts : 0.f; } }
                    const bf16x8 bfrag = pack8(wt[0], wt[1]);
#pragma unroll
                    for (int pt = 0; pt < 4; ++pt) { union { bf16x8 v; u32x2 hh[2]; } af;
                        af.hh[0] = *(const LAS u32x2*)(sXT + (16 * pt + l16) * SB_PITCH + 32 * m + 4 * g); af.hh[1] = *(const LAS u32x2*)(sXT + (16 * pt + l16) * SB_PITCH + 32 * m + 16 + 4 * g);
                        acc[pt] = __builtin_amdgcn_mfma_f32_16x16x32_bf16(af.v, bfrag, acc[pt], 0, 0, 0); }
                }
            }
#pragma unroll
            for (int pt = 0; pt < 4; ++pt) ysum[pt] = ysum[pt] + acc[pt];
        }
        const float dsk = W.s_d[h];
#pragma unroll
        for (int pt = 0; pt < 4; ++pt) { const int p = 16 * pt + 4 * g;
            const u32x2 xv = *(const u32x2*)(XBC + (size_t)(g0 + t) * 1024 + h * 64 + p);
            *(float4*)(YS + (size_t)(g0 + t) * 512 + h * 64 + p) = make_float4(ysum[pt][0] + dsk * bflo(xv.x), ysum[pt][1] + dsk * bfhi(xv.x), ysum[pt][2] + dsk * bflo(xv.y), ysum[pt][3] + dsk * bfhi(xv.y)); }
    }
}
template <int D> __device__ __forceinline__ void ssd_combine_one(float4* base, const float* scd) {
    float4 carry = make_float4(0.f, 0.f, 0.f, 0.f);
#pragma unroll
    for (int k0 = 0; k0 < NCH; k0 += 17) {
        float4 tmp[17];
#pragma unroll
        for (int k = 0; k < 17; ++k) { const int kk = k0 + k, c = D ? (kk < 2 ? 1 - kk : 35 - kk) : kk; tmp[k] = base[(size_t)c * 2048]; }
#pragma unroll
        for (int k = 0; k < 17; ++k) { const int kk = k0 + k, c = D ? (kk < 2 ? 1 - kk : 35 - kk) : kk; const float a = scd[c];
            base[(size_t)c * 2048] = carry;
            carry.x = a * carry.x + tmp[k].x; carry.y = a * carry.y + tmp[k].y; carry.z = a * carry.z + tmp[k].z; carry.w = a * carry.w + tmp[k].w; }
    }
}
__device__ __forceinline__ void phase_ssd_combine(const Ctx& F, unsigned char* ws) {
    float4* SST4 = (float4*)(ws + WS_SST); const float* SCD = (const float*)(ws + WS_SCD);
    for (int gt = F.bid * 512 + F.tid; gt < 64 * 2048; gt += F.G * 512) {
        const int sidx = gt >> 11, e4 = gt & 2047;
        float4* base = SST4 + (size_t)sidx * NCH * 2048 + e4;
        if (sidx & 1) ssd_combine_one<1>(base, SCD + sidx * NCH); else ssd_combine_one<0>(base, SCD + sidx * NCH);
    }
}

constexpr int RWF_CHUNK = 10496;
constexpr int RW_NCHUNK = NPOS / 16;
template <int CTRL> __device__ __forceinline__ float dpp_id1(float v) { return __int_as_float(__builtin_amdgcn_update_dpp(0x3f800000, __float_as_int(v), CTRL, 0xF, 0xF, false)); }
__device__ __forceinline__ float sel4(int g, float a, float b, float c, float d) { return g == 0 ? a : (g == 1 ? b : (g == 2 ? c : d)); }

template <int D> __device__ __forceinline__ void rwkv_pre_dir(const bf16_t* wupt, const bf16x8 (&bw)[2], const bf16x8 (&ba)[2], const f32x4 (&kk)[4], const f32x4 (&rr)[4], const f32x4 (&kx)[4],
        const float* w0p, const float* a0p, const float* kap, const float* rkp, float& bon, LAS unsigned char* wl, unsigned char* dst, int l16, int g) {
    LAS float* LT = (LAS float*)wl; LAS float* AT = LT + 256; LAS bf16_t* BT = (LAS bf16_t*)(wl + 2048); LAS bf16_t* KT = BT + 1024;
    const int lane = g * 16 + l16;
    bf16x8* o = (bf16x8*)dst;
    const f32x4 z4 = {0.f, 0.f, 0.f, 0.f};
    bf16x8 af[2], bf[2], kf[2], rf[2];
#pragma unroll
    for (int p = 0; p < 2; ++p) {
        f32x4 al[2], be[2], ka[2], rh[2];
#pragma unroll
        for (int mm = 0; mm < 2; ++mm) { const int m = 2 * p + mm; asm volatile("" ::: "memory");
            const bf16_t* wpw = wupt + ((size_t)D * 512 + 16 * m + l16) * 64 + 8 * g; const bf16_t* wpa = wupt + ((size_t)(2 + D) * 512 + 16 * m + l16) * 64 + 8 * g;
            f32x4 aw = __builtin_amdgcn_mfma_f32_16x16x32_bf16(*(const bf16x8*)wpw, bw[0], z4, 0, 0, 0); aw = __builtin_amdgcn_mfma_f32_16x16x32_bf16(*(const bf16x8*)(wpw + 32), bw[1], aw, 0, 0, 0);
            f32x4 aa = __builtin_amdgcn_mfma_f32_16x16x32_bf16(*(const bf16x8*)wpa, ba[0], z4, 0, 0, 0); aa = __builtin_amdgcn_mfma_f32_16x16x32_bf16(*(const bf16x8*)(wpa + 32), ba[1], aa, 0, 0, 0);
            const float4 w0 = *(const float4*)(w0p + 16 * m + 4 * g), a0 = *(const float4*)(a0p + 16 * m + 4 * g), kav = *(const float4*)(kap + 16 * m + 4 * g), rkv = *(const float4*)(rkp + 16 * m + 4 * g);
            const float w0a[4] = {w0.x, w0.y, w0.z, w0.w}, a0a[4] = {a0.x, a0.y, a0.z, a0.w}, kaa[4] = {kav.x, kav.y, kav.z, kav.w}, rka[4] = {rkv.x, rkv.y, rkv.z, rkv.w};
            f32x4 gcv;
#pragma unroll
            for (int r = 0; r < 4; ++r) {
                const float w = __expf(-0.6065306597126334f * sigmoidf_(w0a[r] + aw[r])), a = sigmoidf_(a0a[r] + aa[r]);
                const float kd = kx[m][r] * (1.f + (a - 1.f) * kaa[r]), bb = kk[m][r] * a;
                bon += rr[m][r] * kd * rka[r];
                float G = w;
                if (D == 0) { G *= dpp_id1<0x111>(G); G *= dpp_id1<0x112>(G); G *= dpp_id1<0x114>(G); G *= dpp_id1<0x118>(G); }
                else        { G *= dpp_id1<0x101>(G); G *= dpp_id1<0x102>(G); G *= dpp_id1<0x104>(G); G *= dpp_id1<0x108>(G); }
                const float Gex = (D == 0) ? dpp_id1<0x111>(G) : dpp_id1<0x101>(G);
                const float iG = rcpf_(G);
                al[mm][r] = Gex * kk[m][r]; be[mm][r] = bb * iG; ka[mm][r] = kd * iG; rh[mm][r] = G * rr[m][r]; gcv[r] = G;
                const int k = 16 * m + 4 * g + r; BT[k * 16 + l16] = f2bf(be[mm][r]); KT[k * 16 + l16] = f2bf(ka[mm][r]);
            }
            if (l16 == ((D == 0) ? 15 : 0)) *(float4*)((float*)(dst + 10240) + 16 * m + 4 * g) = make_float4(gcv[0], gcv[1], gcv[2], gcv[3]);
        }
        af[p] = pack8(al[0], al[1]); bf[p] = pack8(be[0], be[1]); kf[p] = pack8(ka[0], ka[1]); rf[p] = pack8(rh[0], rh[1]);
        o[64 * p + lane] = af[p]; o[128 + 64 * p + lane] = rf[p];
        __builtin_amdgcn_sched_barrier(0);
    }
    f32x4 Lm = __builtin_amdgcn_mfma_f32_16x16x32_bf16(af[0], bf[0], z4, 0, 0, 0); Lm = __builtin_amdgcn_mfma_f32_16x16x32_bf16(af[1], bf[1], Lm, 0, 0, 0);
    f32x4 Am = __builtin_amdgcn_mfma_f32_16x16x32_bf16(af[0], kf[0], z4, 0, 0, 0); Am = __builtin_amdgcn_mfma_f32_16x16x32_bf16(af[1], kf[1], Am, 0, 0, 0);
    f32x4 Bb = __builtin_amdgcn_mfma_f32_16x16x32_bf16(bf[0], rf[0], z4, 0, 0, 0); Bb = __builtin_amdgcn_mfma_f32_16x16x32_bf16(bf[1], rf[1], Bb, 0, 0, 0);
    f32x4 Bk = __builtin_amdgcn_mfma_f32_16x16x32_bf16(kf[0], rf[0], z4, 0, 0, 0); Bk = __builtin_amdgcn_mfma_f32_16x16x32_bf16(kf[1], rf[1], Bk, 0, 0, 0);
#pragma unroll
    for (int r = 0; r < 4; ++r) { const int row = 4 * g + r;
        const bool strict = (D == 0) ? (l16 < row) : (l16 > row);
        const bool incl = (D == 0) ? (row <= l16) : (row >= l16);
        Lm[r] = strict ? Lm[r] : 0.f; Am[r] = strict ? Am[r] : 0.f; Bb[r] = incl ? Bb[r] : 0.f; Bk[r] = incl ? Bk[r] : 0.f; }
    *(LAS f32x4*)(LT + l16 * 16 + 4 * g) = Lm; *(LAS f32x4*)(AT + l16 * 16 + 4 * g) = Am;
    o[320 + lane] = pack8(Bb, Bk);
    asm volatile("" ::: "memory");
#pragma unroll
    for (int m = 0; m < 4; ++m) { union { bf16x8 v; u32x2 h[2]; } f;
        f.h[0] = *(LAS u32x2*)(BT + (16 * m + l16) * 16 + 4 * g); f.h[1] = *(LAS u32x2*)(KT + (16 * m + l16) * 16 + 4 * g);
        o[384 + 64 * m + lane] = f.v; }
    __builtin_amdgcn_sched_barrier(0);
    float x[16];
    if (D == 0) {
#pragma unroll
        for (int c = 15; c >= 0; --c) { float s = (c == l16) ? 1.f : 0.f; asm volatile("" ::: "memory");
#pragma unroll
            for (int i = c + 1; i < 16; ++i) s -= x[i] * LT[c * 16 + i];
            x[c] = s; }
    } else {
#pragma unroll
        for (int c = 0; c < 16; ++c) { float s = (c == l16) ? 1.f : 0.f; asm volatile("" ::: "memory");
#pragma unroll
            for (int i = 0; i < c; ++i) s -= x[i] * LT[c * 16 + i];
            x[c] = s; }
    }
    f32x4 tm0, tm1;
#pragma unroll
    for (int r = 0; r < 4; ++r) tm0[r] = -sel4(g, x[r], x[4 + r], x[8 + r], x[12 + r]);
#pragma unroll
    for (int r = 0; r < 4; ++r) { const int c = 4 * g + r; float s = 0.f; asm volatile("" ::: "memory");
#pragma unroll
        for (int i = 0; i < 16; ++i) { const bool use = (D == 0) ? (i > c) : (i < c); s += use ? x[i] * AT[c * 16 + i] : 0.f; }
        tm1[r] = -s; }
    o[256 + lane] = pack8(tm0, tm1);
    asm volatile("" ::: "memory");
}
__device__ __forceinline__ void rwkv_pre_task(const Ctx& F, const LayerW& W, unsigned char* ws, const bf16_t* WUPT, int task, int dsel) {
    const bf16_t* P = (const bf16_t*)(ws + WS_P); float* BON = (float*)(ws + WS_BON); unsigned char* RWF = ws + WS_RWF;
    const int cidx = task % RW_NCHUNK, bh = task / RW_NCHUNK, h = bh & 7, b = bh >> 3;
    int ln_ = F.lane; asm volatile("" : "+v"(ln_));
    const int l16 = ln_ & 15, g = ln_ >> 4;
    const int pos = cidx * 16 + l16;
    const int tok = pos < CTXL ? NLAT + b * CTXL + pos : b * SEQL + (pos - CTXL);
    const bf16_t* Pr = P + (size_t)tok * PTP;
    LAS unsigned char* wl = F.lds + F.wave * 8192;
    bf16x8 bw[2], ba[2];
#pragma unroll
    for (int p = 0; p < 2; ++p) { const u32x4 q = *(const u32x4*)(Pr + B_WD + 32 * p + 8 * g); union { bf16x8 v; unsigned u[4]; } tq;
#pragma unroll
        for (int e = 0; e < 4; ++e) tq.u[e] = pk_bf16(tanhf_(bflo(q[e])), tanhf_(bfhi(q[e])));
        bw[p] = tq.v; ba[p] = *(const bf16x8*)(Pr + B_AD + 32 * p + 8 * g); }
    f32x4 kk[4], rr[4], kx[4];
    float ssq = 0.f;
#pragma unroll
    for (int m = 0; m < 4; ++m) { const int co = h * 64 + 16 * m + 4 * g;
        const u32x2 rq = *(const u32x2*)(Pr + B_R + co), kq = *(const u32x2*)(Pr + B_K + co); const float4 kkw = *(const float4*)(W.rw_kk + co);
        rr[m] = (f32x4){bflo(rq.x), bfhi(rq.x), bflo(rq.y), bfhi(rq.y)}; kx[m] = (f32x4){bflo(kq.x), bfhi(kq.x), bflo(kq.y), bfhi(kq.y)};
        kk[m] = (f32x4){kx[m][0] * kkw.x, kx[m][1] * kkw.y, kx[m][2] * kkw.z, kx[m][3] * kkw.w};
        ssq += kk[m][0] * kk[m][0] + kk[m][1] * kk[m][1] + kk[m][2] * kk[m][2] + kk[m][3] * kk[m][3]; }
    ssq += xor16_f(ssq); ssq = sum_x32(ssq);
    { const float rn = rsqrtf(ssq + 1e-12f);
#pragma unroll
      for (int m = 0; m < 4; ++m) kk[m] = kk[m] * rn; }
    float bon = 0.f;
    const int co = h * 64;
    const int c0 = cidx, c1 = cidx < 16 ? 15 - cidx : 287 - cidx;
    if (dsel == 0) rwkv_pre_dir<0>(WUPT + (size_t)co * 64, bw, ba, kk, rr, kx, W.rw_w0 + co, W.rw_a0 + co, W.rw_ka + co, W.rw_rk + co, bon, wl, RWF + ((size_t)(bh * 2 + 0) * RW_NCHUNK + c0) * RWF_CHUNK, l16, g);
    else           rwkv_pre_dir<1>(WUPT + (size_t)co * 64, bw, ba, kk, rr, kx, W.rw_w0 + 512 + co, W.rw_a0 + 512 + co, W.rw_ka + co, W.rw_rk + co, bon, wl, RWF + ((size_t)(bh * 2 + 1) * RW_NCHUNK + c1) * RWF_CHUNK, l16, g);
    bon += xor16_f(bon); bon = sum_x32(bon);
    if (g == 0) BON[((size_t)dsel * NTOK + tok) * 8 + h] = bon;
}
struct RwFrag { bf16x8 a0, a1, r0, r1, tm, bb, bk0, bk1, bk2, bk3; f32x4 g0, g1, g2, g3; u32x2 v; };
__device__ __forceinline__ void rwkv_scan(const Ctx& F, unsigned char* ws, int sidx) {
    if (F.wave >= 4) return;
    const bf16_t* P = (const bf16_t*)(ws + WS_P); bf16_t* RWY = (bf16_t*)(ws + WS_RWY);
    const int d = sidx & 1, h = (sidx >> 1) & 7, b = sidx >> 4, n = F.wave, l16 = F.lane & 15, g = F.lane >> 4;
    const unsigned char* base = ws + WS_RWF + (size_t)sidx * RW_NCHUNK * RWF_CHUNK;
    const int vcol = B_V + h * 64 + 16 * n + l16;
#define RW_CIDX(c) (d ? ((c) < 16 ? 15 - (c) : 287 - (c)) : (c))
#define RW_TOK(cidx, i) (((cidx) * 16 + (i)) < CTXL ? NLAT + b * CTXL + (cidx) * 16 + (i) : b * SEQL + ((cidx) * 16 + (i) - CTXL))
#define RW_LOADF(fr, c) do { const bf16x8* q_ = (const bf16x8*)(base + (size_t)(c) * RWF_CHUNK) + F.lane; \
        fr.a0 = q_[0]; fr.a1 = q_[64]; fr.r0 = q_[128]; fr.r1 = q_[192]; fr.tm = q_[256]; fr.bb = q_[320]; fr.bk0 = q_[384]; fr.bk1 = q_[448]; fr.bk2 = q_[512]; fr.bk3 = q_[576]; \
        const f32x4* gp_ = (const f32x4*)(base + (size_t)(c) * RWF_CHUNK + 10240) + g; fr.g0 = gp_[0]; fr.g1 = gp_[4]; fr.g2 = gp_[8]; fr.g3 = gp_[12]; \
        const int ci_ = RW_CIDX(c); unsigned short v_[4]; _Pragma("unroll") for (int j_ = 0; j_ < 4; ++j_) v_[j_] = P[(size_t)RW_TOK(ci_, 4 * g + j_) * PTP + vcol]; \
        fr.v.x = (unsigned)v_[0] | ((unsigned)v_[1] << 16); fr.v.y = (unsigned)v_[2] | ((unsigned)v_[3] << 16); } while (0)
    f32x4 st0 = {0.f, 0.f, 0.f, 0.f}, st1 = st0, st2 = st0, st3 = st0;
    const f32x4 z4 = {0.f, 0.f, 0.f, 0.f};
#define RW_STEP(fr, c) do { \
        const bf16x8 s0_ = pack8(st0, st1), s1_ = pack8(st2, st3); \
        f32x4 x1_ = __builtin_amdgcn_mfma_f32_16x16x32_bf16(fr.a0, s0_, z4, 0, 0, 0); x1_ = __builtin_amdgcn_mfma_f32_16x16x32_bf16(fr.a1, s1_, x1_, 0, 0, 0); \
        f32x4 x2_ = __builtin_amdgcn_mfma_f32_16x16x32_bf16(fr.r0, s0_, z4, 0, 0, 0); x2_ = __builtin_amdgcn_mfma_f32_16x16x32_bf16(fr.r1, s1_, x2_, 0, 0, 0); \
        union { bf16x8 v; unsigned u[4]; } bx_; bx_.u[0] = pk_bf16(x1_[0], x1_[1]); bx_.u[1] = pk_bf16(x1_[2], x1_[3]); bx_.u[2] = fr.v.x; bx_.u[3] = fr.v.y; \
        const f32x4 e_ = __builtin_amdgcn_mfma_f32_16x16x32_bf16(fr.tm, bx_.v, z4, 0, 0, 0); \
        union { bf16x8 v; unsigned u[4]; } be_; be_.u[0] = pk_bf16(e_[0], e_[1]); be_.u[1] = pk_bf16(e_[2], e_[3]); be_.u[2] = fr.v.x; be_.u[3] = fr.v.y; \
        const f32x4 o_ = __builtin_amdgcn_mfma_f32_16x16x32_bf16(fr.bb, be_.v, x2_, 0, 0, 0); \
        st0 = __builtin_amdgcn_mfma_f32_16x16x32_bf16(fr.bk0, be_.v, st0, 0, 0, 0) * fr.g0; st1 = __builtin_amdgcn_mfma_f32_16x16x32_bf16(fr.bk1, be_.v, st1, 0, 0, 0) * fr.g1; \
        st2 = __builtin_amdgcn_mfma_f32_16x16x32_bf16(fr.bk2, be_.v, st2, 0, 0, 0) * fr.g2; st3 = __builtin_amdgcn_mfma_f32_16x16x32_bf16(fr.bk3, be_.v, st3, 0, 0, 0) * fr.g3; \
        const int ci_ = RW_CIDX(c); \
        _Pragma("unroll") for (int j_ = 0; j_ < 4; ++j_) RWY[((size_t)d * NTOK + RW_TOK(ci_, 4 * g + j_)) * 512 + h * 64 + 16 * n + l16] = f2bf(o_[j_]); } while (0)
    RwFrag fa, fb, fc;
#define RW_CL(c) ((c) < RW_NCHUNK ? (c) : RW_NCHUNK - 1)
    RW_LOADF(fa, 0); RW_LOADF(fb, 1);
    int c = 0;
    for (; c + 3 <= RW_NCHUNK; c += 3) {
        RW_LOADF(fc, RW_CL(c + 2)); RW_STEP(fa, c);
        RW_LOADF(fa, RW_CL(c + 3)); RW_STEP(fb, c + 1);
        RW_LOADF(fb, RW_CL(c + 4)); RW_STEP(fc, c + 2);
    }
    if (c < RW_NCHUNK) { RW_STEP(fa, c); if (c + 1 < RW_NCHUNK) RW_STEP(fb, c + 1); }
#undef RW_CL
#undef RW_CIDX
#undef RW_TOK
#undef RW_LOADF
#undef RW_STEP
}

__device__ __forceinline__ void na_tile(const Ctx& F, unsigned char* ws, const LAS float* sBias, int tile) {
    const bf16_t* QN = (const bf16_t*)(ws + WS_QN); const bf16_t* KN = (const bf16_t*)(ws + WS_KN);
    const bf16_t* VTL = (const bf16_t*)(ws + WS_VTL); const bf16_t* VTC = (const bf16_t*)(ws + WS_VTC); bf16_t* MIX = (bf16_t*)(ws + WS_MIX);
    const int h = F.wave, l16 = F.lane & 15, g = F.lane >> 4;
    const bool lat = tile < 1024;
    int b, r = 0, j = 0, gq;
    if (lat) { b = tile >> 8; r = (tile >> 2) & 63; j = tile & 3; gq = b * SEQL + r * 64 + j * 16 + l16; }
    else { const int tc = tile - 1024; b = tc >> 4; gq = NLAT + b * CTXL + (tc & 15) * 16 + l16; }
    const int row0 = min(max(r - 4, 0), 56), col0 = min(max(16 * j - 8, 0), 32);
    bf16x8 qf0, qf1;
    { const bf16_t* qp = QN + (size_t)gq * 512 + h * 64 + g * 8; qf0 = *(const bf16x8*)qp; qf1 = *(const bf16x8*)(qp + 32); }
    const f32x4 zero4 = {0.f, 0.f, 0.f, 0.f};
    const int cq = 16 * j + l16, win0 = min(max(cq - 8, 0), 48);
    const bf16_t* knb = KN + ((size_t)((((b * 8 + h) * 64 + row0) * 2) * 4 + g) * 64 + col0 + l16) * 8;
    const bf16_t* kcx = KN + (size_t)NLAT * 512 + ((size_t)(((b * 8 + h) * 2) * 4 + g) * 256 + l16) * 8;
    const bf16_t* vnb = VTL + ((size_t)(((b * 8 + h) * 64 + row0) * 12 + col0 / 4 + g) * 64 + l16) * 8;
    const bf16_t* vcx = VTC + ((size_t)(((b * 8 + h) * 8) * 4 + g) * 64 + l16) * 8;
    float mrun = -1e30f, lrun = 0.f;
    f32x4 o[4] = {zero4, zero4, zero4, zero4};
#pragma unroll
    for (int hf = 0; hf < 2; ++hf) {
        if (hf == 0 && !lat) continue;
        bf16x8 fr[32];
#pragma unroll
        for (int T = 0; T < 16; ++T) { const bf16_t* kp = hf == 0 ? knb + (size_t)((T >> 1) * 8) * 512 + (T & 1) * 128 : kcx + T * 128;
            fr[2 * T] = *(const bf16x8*)kp; fr[2 * T + 1] = *(const bf16x8*)(kp + (hf == 0 ? 4 * 512 : 4 * 2048)); }
        asm volatile("" ::: "memory");
        f32x4 acc[16];
#pragma unroll
        for (int T = 0; T < 16; ++T) { f32x4 a = __builtin_amdgcn_mfma_f32_16x16x32_bf16(fr[2 * T], qf0, zero4, 0, 0, 0); a = __builtin_amdgcn_mfma_f32_16x16x32_bf16(fr[2 * T + 1], qf1, a, 0, 0, 0);
            if (hf == 0) { const int ir = T >> 1, hh = T & 1, kr = row0 + ir; const LAS float* bias = sBias + (kr - r + 7) * 31;
#pragma unroll
                for (int e = 0; e < 4; ++e) { const int kc = col0 + 16 * hh + 4 * g + e; const bool ok = (kc >= win0) && (kc < win0 + 16);
                    const int dc = min(max(kc - cq + 15, 0), 30); a[e] = ok ? a[e] + bias[dc] : -1e30f; } }
            acc[T] = a; }
#pragma unroll
        for (int m = 0; m < 8; ++m)
#pragma unroll
            for (int dt = 0; dt < 4; ++dt) fr[4 * m + dt] = *(const bf16x8*)(hf == 0 ? vnb + (size_t)m * 12 * 512 + dt * 128 : vcx + (size_t)m * 4 * 512 + dt * 128);
        asm volatile("" ::: "memory");
        float mx = mrun;
#pragma unroll
        for (int T = 0; T < 16; ++T) mx = fmaxf(fmaxf(fmaxf(acc[T][0], acc[T][1]), fmaxf(acc[T][2], acc[T][3])), mx);
        mx = fmaxf(mx, xor16_f(mx)); mx = max_x32(mx);
        const float alpha = __expf(mrun - mx);
        float lsum = 0.f;
#pragma unroll
        for (int T = 0; T < 16; ++T) {
#pragma unroll
            for (int q = 0; q < 4; ++q) { const float pv = __expf(acc[T][q] - mx); acc[T][q] = pv; lsum += pv; } }
        lsum += xor16_f(lsum); lsum = sum_x32(lsum);
        lrun = lrun * alpha + lsum; mrun = mx;
#pragma unroll
        for (int dt = 0; dt < 4; ++dt) o[dt] = o[dt] * alpha;
#pragma unroll
        for (int m = 0; m < 8; ++m) { const bf16x8 pf = pack8(acc[2 * m], acc[2 * m + 1]);
#pragma unroll
            for (int dt = 0; dt < 4; ++dt) o[dt] = __builtin_amdgcn_mfma_f32_16x16x32_bf16(fr[4 * m + dt], pf, o[dt], 0, 0, 0); }
    }
    const float inv = 1.0f / lrun;
#pragma unroll
    for (int dt = 0; dt < 4; ++dt) { u32x2 w; w.x = pk_bf16(o[dt][0] * inv, o[dt][1] * inv); w.y = pk_bf16(o[dt][2] * inv, o[dt][3] * inv);
        *(u32x2*)(MIX + (size_t)gq * 2048 + 1024 + h * 64 + dt * 16 + 4 * g) = w; }
}
__device__ __forceinline__ void na_phase(const Ctx& F, const LayerW& W, unsigned char* ws, int blk, int nblk, int ntile) {
    LAS float* sBias = (LAS float*)(F.lds + F.wave * 2048);
    __syncthreads();
    for (int idx = F.lane; idx < 465; idx += 64) sBias[idx] = W.rpb[F.wave * 465 + idx];
    asm volatile("" ::: "memory");
    for (int tile = blk; tile < ntile; tile += nblk) na_tile(F, ws, sBias, tile);
}

__device__ __forceinline__ void phase_finish(const Ctx& F, const LayerW& W, unsigned char* ws, const bf16_t* GUPT, int ntok) {
    const bf16_t* P = (const bf16_t*)(ws + WS_P); bf16_t* MIX = (bf16_t*)(ws + WS_MIX);
    const bf16_t* RWY = (const bf16_t*)(ws + WS_RWY); const float* BON = (const float*)(ws + WS_BON); const float* YS = (const float*)(ws + WS_YS);
    const f32x4 z4 = {0.f, 0.f, 0.f, 0.f};
    for (int task = F.bid * 8 + F.wave; task < (ntok / 16) * 8; task += F.G * 8) {
        int ln = F.lane; asm volatile("" : "+v"(ln));
        const int l16 = ln & 15, g = ln >> 4, h = task & 7, tok = (task >> 3) * 16 + l16;
        const bf16_t* Pr = P + (size_t)tok * PTP;
        bf16x8 sg[4];
#pragma unroll
        for (int ks = 0; ks < 4; ++ks) { const u32x4 q = *(const u32x4*)(Pr + B_GD + 32 * ks + 8 * g); union { bf16x8 v; unsigned u[4]; } s;
#pragma unroll
            for (int e = 0; e < 4; ++e) s.u[e] = pk_bf16(sigmoidf_(bflo(q[e])), sigmoidf_(bfhi(q[e])));
            sg[ks] = s.v; }
        f32x4 y[4]; float s1 = 0.f;
#pragma unroll
        for (int m = 0; m < 4; ++m) { const int co = h * 64 + 16 * m + 4 * g;
            const u32x2 a = *(const u32x2*)(RWY + (size_t)tok * 512 + co), bq = *(const u32x2*)(RWY + ((size_t)NTOK + tok) * 512 + co);
            y[m] = (f32x4){bflo(a.x) + bflo(bq.x), bfhi(a.x) + bfhi(bq.x), bflo(a.y) + bflo(bq.y), bfhi(a.y) + bfhi(bq.y)};
            s1 += (y[m][0] + y[m][1]) + (y[m][2] + y[m][3]); }
        s1 += xor16_f(s1); s1 = sum_x32(s1);
        const float mu = s1 * (1.f / 64.f); float s2 = 0.f;
#pragma unroll
        for (int m = 0; m < 4; ++m) { y[m] = y[m] - mu; s2 += (y[m][0] * y[m][0] + y[m][1] * y[m][1]) + (y[m][2] * y[m][2] + y[m][3] * y[m][3]); }
        s2 += xor16_f(s2); s2 = sum_x32(s2);
        const float rs = rsqrtf(s2 * (1.f / 64.f) + 64e-5f);
        const float bon = BON[(size_t)tok * 8 + h] + BON[((size_t)NTOK + tok) * 8 + h];
#pragma unroll
        for (int m = 0; m < 4; ++m) { const int co = h * 64 + 16 * m + 4 * g;
            f32x4 ga = z4;
#pragma unroll
            for (int ks = 0; ks < 4; ++ks) ga = __builtin_amdgcn_mfma_f32_16x16x32_bf16(*(const bf16x8*)(GUPT + (size_t)(h * 64 + 16 * m + l16) * 128 + 32 * ks + 8 * g), sg[ks], ga, 0, 0, 0);
            const float4 lw = *(const float4*)(W.rw_lnw + co), lb = *(const float4*)(W.rw_lnb + co); const u32x2 vq = *(const u32x2*)(Pr + B_V + co);
            const float o0 = (y[m][0] * rs * lw.x + lb.x + bon * bflo(vq.x)) * ga[0], o1 = (y[m][1] * rs * lw.y + lb.y + bon * bfhi(vq.x)) * ga[1];
            const float o2 = (y[m][2] * rs * lw.z + lb.z + bon * bflo(vq.y)) * ga[2], o3 = (y[m][3] * rs * lw.w + lb.w + bon * bfhi(vq.y)) * ga[3];
            u32x2 o; o.x = pk_bf16(o0, o1); o.y = pk_bf16(o2, o3);
            *(u32x2*)(MIX + (size_t)tok * 2048 + 512 + co) = o; }
    }
    for (int tok = F.bid * 8 + F.wave; tok < ntok; tok += F.G * 8) {
        const int c0 = F.lane * 8;
        float ys[8], z[8], gw[8];
        load8f(YS + (size_t)tok * 512 + c0, ys); unpack8(*(const u32x4*)(P + (size_t)tok * PTP + D_Z + c0), z); load8f(W.s_norm + c0, gw);
        float ss = 0.f;
#pragma unroll
        for (int e = 0; e < 8; ++e) { ys[e] *= siluf_(z[e]); ss += ys[e] * ys[e]; }
        ss = wave_sum(ss);
        const float rs = rsqrtf(ss * (1.f / 512.f) + 1e-6f);
#pragma unroll
        for (int e = 0; e < 8; ++e) ys[e] = ys[e] * rs * gw[e];
        *(u32x4*)(MIX + (size_t)tok * 2048 + 1536 + c0) = pack8f(ys);
    }
}

constexpr int RADIX_LOW_BIT = 10;
constexpr int RADIX_STEPS = 14;
__device__ __forceinline__ unsigned ordkey(float x) { const unsigned u = __float_as_uint(x); return (u & 0x80000000u) ? ~u : (u | 0x80000000u); }
template <int CTRL> __device__ __forceinline__ int dpp_i0(int v) { return __builtin_amdgcn_update_dpp(0, v, CTRL, 0xF, 0xF, true); }
__device__ __forceinline__ int rowscan_incl(int x) { x += dpp_i0<0x111>(x); x += dpp_i0<0x112>(x); x += dpp_i0<0x114>(x); x += dpp_i0<0x118>(x); return x; }
__device__ __forceinline__ void phase_scores(const Ctx& F, unsigned char* ws, int layer, int ntok) {
    const bf16_t* Q = (const bf16_t*)(ws + WS_P); const bf16_t* KEYS = (const bf16_t*)(ws + WS_KEYS) + (size_t)layer * 8 * 2 * 128 * 128;
    int* IDS = (int*)(ws + WS_IDS); float* GATES = (float*)(ws + WS_GATES);
    LAS bf16_t* sK = (LAS bf16_t*)F.lds;
    LAS float* sVv = (LAS float*)(F.lds + 2 * 128 * 136 * 2 + F.wave * 5120);
    LAS int* sVi = (LAS int*)(sVv + 512);
    const int ntg = ntok / 128, ntask = 8 * ntg;
    const int l16 = F.lane & 15, g = F.lane >> 4;
    const f32x4 z4 = {0.f, 0.f, 0.f, 0.f};
    int cur_h = -1;
    for (int task = F.bid; task < ntask; task += F.G) {
        const int h = task / ntg, tg = task % ntg;
        if (h != cur_h) { __syncthreads();
#pragma unroll
            for (int q = 0; q < 8; ++q) { const int v = F.tid + 512 * q, row = v >> 4, part = v & 15;
                *(LAS u32x4*)(sK + row * 136 + part * 8) = *(const u32x4*)(KEYS + ((size_t)h * 256 + row) * 128 + part * 8); }
            cur_h = h; __syncthreads(); }
        const int t0 = tg * 128 + F.wave * 16;
#pragma unroll 1
        for (int p = 0; p < 2; ++p) {
            bf16x8 qf[4];
#pragma unroll
            for (int ks = 0; ks < 4; ++ks) qf[ks] = *(const bf16x8*)(Q + (size_t)(t0 + l16) * 2048 + h * 256 + p * 128 + 32 * ks + 8 * g);
            f32x4 acc[8];
#pragma unroll
            for (int kt = 0; kt < 8; ++kt) { f32x4 a = z4;
#pragma unroll
                for (int ks = 0; ks < 4; ++ks) a = __builtin_amdgcn_mfma_f32_16x16x32_bf16(qf[ks], *(const LAS bf16x8*)(sK + (p * 128 + 16 * kt + l16) * 136 + 32 * ks + 8 * g), a, 0, 0, 0);
                acc[kt] = a; }
            float lo0, lo1, lo2, lo3, hi0, hi1, hi2, hi3;
            { float m0 = acc[0][0], m1 = acc[0][1], m2 = acc[0][2], m3 = acc[0][3];
#pragma unroll
              for (int kt = 1; kt < 8; ++kt) { m0 = fmaxf(m0, acc[kt][0]); m1 = fmaxf(m1, acc[kt][1]); m2 = fmaxf(m2, acc[kt][2]); m3 = fmaxf(m3, acc[kt][3]); }
              hi0 = max16(m0); hi1 = max16(m1); hi2 = max16(m2); hi3 = max16(m3);
              lo0 = -max16(-m0); lo1 = -max16(-m1); lo2 = -max16(-m2); lo3 = -max16(-m3); }
#pragma unroll 1
            for (int it = 0; it < RADIX_STEPS; ++it) {
                const float c0 = 0.5f * (lo0 + hi0), c1 = 0.5f * (lo1 + hi1), c2 = 0.5f * (lo2 + hi2), c3 = 0.5f * (lo3 + hi3); int n0 = 0, n1 = 0, n2 = 0, n3 = 0;
#pragma unroll
                for (int kt = 0; kt < 8; ++kt) { n0 += acc[kt][0] >= c0; n1 += acc[kt][1] >= c1; n2 += acc[kt][2] >= c2; n3 += acc[kt][3] >= c3; }
                const bool k0 = sum16((float)n0) >= 16.f, k1 = sum16((float)n1) >= 16.f, k2 = sum16((float)n2) >= 16.f, k3 = sum16((float)n3) >= 16.f;
                lo0 = k0 ? c0 : lo0; hi0 = k0 ? hi0 : c0; lo1 = k1 ? c1 : lo1; hi1 = k1 ? hi1 : c1; lo2 = k2 ? c2 : lo2; hi2 = k2 ? hi2 : c2; lo3 = k3 ? c3 : lo3; hi3 = k3 ? hi3 : c3; }
#pragma unroll
            for (int r = 0; r < 4; ++r) { const float T = r == 0 ? lo0 : (r == 1 ? lo1 : (r == 2 ? lo2 : lo3));
                int cl = 0;
#pragma unroll
                for (int kt = 0; kt < 8; ++kt) cl += acc[kt][r] >= T;
                int rank = rowscan_incl(cl) - cl;
                LAS float* dv = sVv + ((4 * g + r) * 2 + p) * 16; LAS int* di = sVi + ((4 * g + r) * 2 + p) * 16;
#pragma unroll
                for (int kt = 0; kt < 8; ++kt) { const bool sel = acc[kt][r] >= T;
                    if (sel && rank < 16) { dv[rank] = acc[kt][r]; di[rank] = 16 * kt + l16; }
                    rank += sel ? 1 : 0; } }
        }
        asm volatile("" ::: "memory");
#pragma unroll 1
        for (int r = 0; r < 4; ++r) { const int tk = 4 * g + r;
            LAS float* sS = (LAS float*)(sVi + 512);
            LAS int* sI = (LAS int*)(sS + 128);
#pragma unroll
            for (int p = 0; p < 2; ++p) { const float v = sVv[(tk * 2 + p) * 16 + l16]; const int ix = sVi[(tk * 2 + p) * 16 + l16];
                const unsigned key = (ordkey(v) & ~15u) | (unsigned)(15 - l16); int rk = 0;
#pragma unroll
                for (int q = 0; q < 4; ++q) { const f32x4 o = *(const LAS f32x4*)(sVv + (tk * 2 + p) * 16 + 4 * q);
#pragma unroll
                    for (int e = 0; e < 4; ++e) rk += ((ordkey(o[e]) & ~15u) | (unsigned)(15 - (4 * q + e))) > key; }
                sS[(g * 2 + p) * 16 + rk] = v; sI[(g * 2 + p) * 16 + rk] = ix; }
            asm volatile("" ::: "memory");
            float cv[4]; int pi[4], pj[4];
#pragma unroll
            for (int q = 0; q < 4; ++q) { const int e = l16 + 16 * q; int i, j;
                if (e < 16) { i = 0; j = e; } else if (e < 24) { i = 1; j = e - 16; } else if (e < 29) { i = 2; j = e - 24; } else if (e < 33) { i = 3; j = e - 29; }
                else if (e < 36) { i = 4; j = e - 33; } else if (e < 42) { i = 5 + ((e - 36) >> 1); j = (e - 36) & 1; } else { i = 8 + (e - 42); j = 0; }
                const bool ok = e < 50; i = ok ? i : 15; j = ok ? j : 15;
                pi[q] = i; pj[q] = j; cv[q] = ok ? sS[(g * 2) * 16 + i] + sS[(g * 2 + 1) * 16 + j] : -3.0e38f; }
            float lo = sS[(g * 2) * 16 + 15] + sS[(g * 2 + 1) * 16], hi = sS[(g * 2) * 16] + sS[(g * 2 + 1) * 16];
            const float mx = hi;
#pragma unroll 1
            for (int it = 0; it < RADIX_STEPS; ++it) { const float cm = 0.5f * (lo + hi); int n = 0;
#pragma unroll
                for (int q = 0; q < 4; ++q) n += cv[q] >= cm;
                const bool kk = sum16((float)n) >= 16.f; lo = kk ? cm : lo; hi = kk ? hi : cm; }
            int cl = 0; float es = 0.f;
#pragma unroll
            for (int q = 0; q < 4; ++q) { const bool sel = cv[q] >= lo; cl += sel; es += sel ? __expf(cv[q] - mx) : 0.f; }
            int rank = rowscan_incl(cl) - cl;
            const float einv = 1.0f / sum16(es);
            const size_t ob = (size_t)(t0 + tk) * 128 + h * 16;
#pragma unroll
            for (int q = 0; q < 4; ++q) { const bool sel = cv[q] >= lo;
                if (sel && rank < 16) { IDS[ob + rank] = sI[(g * 2) * 16 + pi[q]] * 128 + sI[(g * 2 + 1) * 16 + pj[q]]; GATES[ob + rank] = __expf(cv[q] - mx) * einv; }
                rank += sel ? 1 : 0; }
            asm volatile("" ::: "memory");
        }
        asm volatile("" ::: "memory");
    }
}

struct XInfo { int xi, nx, rank, nloc; };
__device__ __forceinline__ void fp8x16_to_f32(const u32x4 q, float (&f)[16]) {
#pragma unroll
    for (int w = 0; w < 4; ++w) { const auto a = __builtin_amdgcn_cvt_pk_f32_fp8((int)q[w], false); const auto b = __builtin_amdgcn_cvt_pk_f32_fp8((int)q[w], true);
        f[4 * w] = a[0]; f[4 * w + 1] = a[1]; f[4 * w + 2] = b[0]; f[4 * w + 3] = b[1]; }
}
typedef long i64_t;
template <int IDMASK> __device__ __forceinline__ void phase_experts_u(const Ctx& F, unsigned char* ws, int layer, int ntok, const XInfo X, float* PART) {
    const bf16_t* H = (const bf16_t*)(ws + WS_XN); const unsigned char* PU8 = ws + WS_PU + (size_t)layer * 16384 * 2048;
    const int* IDS = (const int*)(ws + WS_IDS);
    const int e8 = F.lane >> 3, c = F.lane & 7, l16 = F.lane & 15, g = F.lane >> 4;
    const int tfirst = X.rank * 8 + F.wave, tstride = X.nloc * 8;
    const int nk = tfirst < ntok ? (ntok - tfirst + tstride - 1) / tstride : 0;
    const f32x4 z4 = {0.f, 0.f, 0.f, 0.f};
    LAS unsigned char* buf = F.lds + F.wave * 12288; LAS float* res = (LAS float*)(buf + 8192);
    const int woff = e8 * 128 + c * 16;
    const int srcoff = 16 * (c ^ e8);
    const int roff0 = l16 * 128 + (((2 * g) ^ (l16 & 7)) * 16), roff1 = l16 * 128 + (((2 * g + 1) ^ (l16 & 7)) * 16);
#define EU_TOK(k) (tfirst + min((k), nk - 1) * tstride)
#define EU_LOADI(I, k) do { const int* ip_ = IDS + (size_t)EU_TOK(k) * 128 + e8; _Pragma("unroll") for (int q_ = 0; q_ < 16; ++q_) I[q_] = ip_[8 * q_]; } while (0)
#define EU_LOADX(HX, k) do { const u32x4* hp_ = (const u32x4*)(H + (size_t)EU_TOK(k) * 2048 + s * 128 + 32 * g); HX[0] = hp_[0]; HX[1] = hp_[1]; HX[2] = hp_[2]; HX[3] = hp_[3]; } while (0)
#define EU_ISSUE(Q, I, hf) do { const unsigned char* sb_ = PU8 + (size_t)s * 16384 * 128; _Pragma("unroll") for (int i_ = 0; i_ < 8; ++i_) Q[i_] = *(const u32x4*)(sb_ + (unsigned)(I[(hf) * 8 + i_] * 128 + srcoff)); } while (0)
#define EU_CONSUME(Q, hf, slot) do { _Pragma("unroll") for (int i_ = 0; i_ < 8; ++i_) *(LAS u32x4*)(buf + i_ * 1024 + woff) = Q[i_]; \
        asm volatile("" ::: "memory"); \
        u32x4 p0_[4], p1_[4]; f32x4 a_[4]; \
        _Pragma("unroll") for (int q_ = 0; q_ < 4; ++q_) { p0_[q_] = *(const LAS u32x4*)(buf + q_ * 2048 + roff0); p1_[q_] = *(const LAS u32x4*)(buf + q_ * 2048 + roff1); a_[q_] = z4; } \
          \
        _Pragma("unroll") for (int q_ = 0; q_ < 4; ++q_) a_[q_] = __builtin_amdgcn_mfma_f32_16x16x32_fp8_fp8(((i64_t)p0_[q_][1] << 32) | (i64_t)p0_[q_][0], hb[0], a_[q_], 0, 0, 0); \
        _Pragma("unroll") for (int q_ = 0; q_ < 4; ++q_) a_[q_] = __builtin_amdgcn_mfma_f32_16x16x32_fp8_fp8(((i64_t)p0_[q_][3] << 32) | (i64_t)p0_[q_][2], hb[1], a_[q_], 0, 0, 0); \
        _Pragma("unroll") for (int q_ = 0; q_ < 4; ++q_) a_[q_] = __builtin_amdgcn_mfma_f32_16x16x32_fp8_fp8(((i64_t)p1_[q_][1] << 32) | (i64_t)p1_[q_][0], hb[2], a_[q_], 0, 0, 0); \
        _Pragma("unroll") for (int q_ = 0; q_ < 4; ++q_) a_[q_] = __builtin_amdgcn_mfma_f32_16x16x32_fp8_fp8(((i64_t)p1_[q_][3] << 32) | (i64_t)p1_[q_][2], hb[3], a_[q_], 0, 0, 0); \
        _Pragma("unroll") for (int q_ = 0; q_ < 4; ++q_) if (l16 == (hf) * 4 + q_) *(LAS f32x4*)(res + (slot) * 128 + 16 * ((hf) * 4 + q_) + 4 * g) = a_[q_]; \
        asm volatile("" ::: "memory"); } while (0)
    for (int s = X.xi; s < 16; s += X.nx) {
        if (nk == 0) continue;
        int id[2][16]; u32x4 hx[2][4]; u32x4 qa[8], qb[8];
        EU_LOADI(id[0], 0); EU_LOADX(hx[0], 0); EU_ISSUE(qa, id[0], 0); EU_ISSUE(qb, id[0], 1);
        EU_LOADI(id[1], 1);
        for (int k0 = 0; k0 < nk; k0 += 8) {
#pragma unroll
            for (int j = 0; j < 8; ++j) { const int k = k0 + j;
                i64_t hb[4];
#pragma unroll
                for (int m = 0; m < 4; ++m) { const u32x4 v = hx[j & 1][m];
                    int lo = __builtin_amdgcn_cvt_pk_fp8_f32(bflo(v[0]), bfhi(v[0]), 0, false); lo = __builtin_amdgcn_cvt_pk_fp8_f32(bflo(v[1]), bfhi(v[1]), lo, true);
                    int hi = __builtin_amdgcn_cvt_pk_fp8_f32(bflo(v[2]), bfhi(v[2]), 0, false); hi = __builtin_amdgcn_cvt_pk_fp8_f32(bflo(v[3]), bfhi(v[3]), hi, true);
                    hb[m] = ((i64_t)(unsigned)hi << 32) | (i64_t)(unsigned)lo; }
                EU_LOADX(hx[(j + 1) & 1], k + 1);
                EU_LOADI(id[j & 1], k + 2);
                EU_CONSUME(qa, 0, j);
                EU_ISSUE(qa, id[(j + 1) & 1], 0);
                EU_CONSUME(qb, 1, j);
                EU_ISSUE(qb, id[(j + 1) & 1], 1);
            }
            { const int u = F.lane >> 3, jj = F.lane & 7, ku = k0 + u;
              if (ku < nk) { float* dst = PART + ((size_t)s * NTOK + tfirst + ku * tstride) * 128 + 16 * jj;
#pragma unroll
                  for (int w = 0; w < 4; ++w) *(f32x4*)(dst + 4 * w) = *(const LAS f32x4*)(res + u * 128 + 16 * jj + 4 * w); }
              asm volatile("" ::: "memory"); }
        }
    }
#undef EU_TOK
#undef EU_LOADI
#undef EU_LOADX
#undef EU_ISSUE
#undef EU_CONSUME
}
__device__ __forceinline__ void phase_experts_combine(const Ctx& F, unsigned char* ws, int ntok) {
    const float* PART = (const float*)(ws + WS_PART); float* GATES = (float*)(ws + WS_GATES);
    for (int idx = F.bid * 512 + F.tid; idx < ntok * 32; idx += F.G * 512) {
        float4 a = make_float4(0.f, 0.f, 0.f, 0.f);
#pragma unroll
        for (int s = 0; s < 16; ++s) { const float4 v = *(const float4*)(PART + (size_t)s * NTOK * 128 + (size_t)idx * 4); a.x += v.x; a.y += v.y; a.z += v.z; a.w += v.w; }
        float4 g = *(const float4*)(GATES + (size_t)idx * 4);
        g.x *= geluf_(a.x * (1.0f / PEER_U_SCALE)); g.y *= geluf_(a.y * (1.0f / PEER_U_SCALE)); g.z *= geluf_(a.z * (1.0f / PEER_U_SCALE)); g.w *= geluf_(a.w * (1.0f / PEER_U_SCALE));
        *(float4*)(GATES + (size_t)idx * 4) = g;
    }
}
__device__ __forceinline__ void phase_experts_v(const Ctx& F, unsigned char* ws, float* out, float* CTXS, int layer, int ntok, const XInfo X) {
    const unsigned char* PV8 = ws + WS_PV + (size_t)layer * 16384 * 2048;
    const int* IDS = (const int*)(ws + WS_IDS); const float* COEF = (const float*)(ws + WS_GATES); const float* MOD = (const float*)(ws + WS_MOD);
    const int e8 = F.lane >> 3, c = F.lane & 7;
    const int tfirst = X.rank * 8 + F.wave, tstride = X.nloc * 8;
    const int nk = tfirst < ntok ? (ntok - tfirst + tstride - 1) / tstride : 0;
    LAS float* res = (LAS float*)(F.lds + F.wave * 4096);
#define EV_TOK(k) (tfirst + min((k), nk - 1) * tstride)
#define EV_LOADI(I, k) do { I[0] = *((const u32x4*)(IDS + (size_t)EV_TOK(k) * 128 + e8 * 16) + (c & 3)); } while (0)
#define EV_LOADC(C, k) do { C[0] = *((const u32x4*)(COEF + (size_t)EV_TOK(k) * 128 + e8 * 16) + (c & 3)); } while (0)
#define EV_QUAD(V) do { const u32x4 own_ = V[0];   \
        _Pragma("unroll") for (int w_ = 0; w_ < 4; ++w_) { V[0][w_] = (unsigned)__builtin_amdgcn_update_dpp(0, (int)own_[w_], 0x00, 0xF, 0xF, true); V[1][w_] = (unsigned)__builtin_amdgcn_update_dpp(0, (int)own_[w_], 0x55, 0xF, 0xF, true); \
            V[2][w_] = (unsigned)__builtin_amdgcn_update_dpp(0, (int)own_[w_], 0xAA, 0xF, 0xF, true); V[3][w_] = (unsigned)__builtin_amdgcn_update_dpp(0, (int)own_[w_], 0xFF, 0xF, 0xF, true); } } while (0)
#define EV_ROW(id) (*(const u32x4*)(PV8 + (size_t)s * 16384 * 128 + (unsigned)((id) * 128 + c * 16)))
#define EV_ISSUE(Q, I, hf) do { _Pragma("unroll") for (int i_ = 0; i_ < 8; ++i_) Q[i_] = EV_ROW(I[(hf) * 2 + (i_ >> 2)][i_ & 3]); } while (0)
#define EV_HALF(Q, C, hf) do { _Pragma("unroll") for (int i_ = 0; i_ < 8; ++i_) { const float cf_ = __uint_as_float(C[(hf) * 2 + (i_ >> 2)][i_ & 3]); const f32x2_t c2_ = {cf_, cf_}; \
            _Pragma("unroll") for (int w_ = 0; w_ < 4; ++w_) { const f32x2_t lo_ = __builtin_amdgcn_cvt_pk_f32_fp8((int)Q[i_][w_], false), hi_ = __builtin_amdgcn_cvt_pk_f32_fp8((int)Q[i_][w_], true); \
                ac2[2 * w_] = lo_ * c2_ + ac2[2 * w_]; ac2[2 * w_ + 1] = hi_ * c2_ + ac2[2 * w_ + 1]; } } } while (0)
    for (int s = X.xi; s < 16; s += X.nx) {
        if (nk == 0) continue;
        u32x4 id[2][4], cf[2][4]; u32x4 qa[8], qb[8];
        EV_LOADI(id[0], 0); EV_LOADC(cf[0], 0); EV_QUAD(id[0]); EV_ISSUE(qa, id[0], 0); EV_ISSUE(qb, id[0], 1);
        EV_LOADI(id[1], 1);
        for (int k0 = 0; k0 < nk; k0 += 8) {
#pragma unroll
            for (int j = 0; j < 8; ++j) { const int k = k0 + j;
                f32x2_t ac2[8];
#pragma unroll
                for (int e = 0; e < 8; ++e) ac2[e] = (f32x2_t){0.f, 0.f};
                EV_QUAD(cf[j & 1]);
                EV_QUAD(id[(j + 1) & 1]);
                EV_LOADC(cf[(j + 1) & 1], k + 1);
                EV_HALF(qa, cf[j & 1], 0);
                EV_ISSUE(qa, id[(j + 1) & 1], 0);
                EV_HALF(qb, cf[j & 1], 1);
                EV_ISSUE(qb, id[(j + 1) & 1], 1);
                EV_LOADI(id[j & 1], k + 2);
                float acc[16];
#pragma unroll
                for (int e = 0; e < 8; ++e) { acc[2 * e] = ac2[e][0]; acc[2 * e + 1] = ac2[e][1]; }
#pragma unroll
                for (int e = 0; e < 16; ++e) { float v = acc[e]; v += dpp_f<0x128>(v); v += xor16_f(v); acc[e] = sum_x32(v); }
                if (e8 == 0) {
#pragma unroll
                    for (int w = 0; w < 4; ++w) *(LAS f32x4*)(res + j * 128 + c * 16 + 4 * w) = (f32x4){acc[4 * w], acc[4 * w + 1], acc[4 * w + 2], acc[4 * w + 3]}; }
                asm volatile("" ::: "memory");
            }
            { const int u = F.lane >> 3, jj = F.lane & 7, ku = k0 + u;
              if (ku < nk) { const int tu = tfirst + ku * tstride;
                  const bool isctx = tu >= NLAT; const int vv = isctx ? 4 : (tu >> 12);
                  float* xr = (isctx ? CTXS + (size_t)(tu - NLAT) * 2048 : out + (size_t)tu * 2048) + s * 128 + jj * 16;
                  const float* m5 = MOD + ((size_t)layer * 5 + vv) * 12288 + 5 * 2048 + s * 128 + jj * 16;
#pragma unroll
                  for (int w = 0; w < 4; ++w) { float4 x = *(const float4*)(xr + 4 * w); const float4 m = *(const float4*)(m5 + 4 * w); const f32x4 a = *(const LAS f32x4*)(res + u * 128 + jj * 16 + 4 * w);
                      x.x += m.x * a[0]; x.y += m.y * a[1]; x.z += m.z * a[2]; x.w += m.w * a[3]; *(float4*)(xr + 4 * w) = x; } }
              asm volatile("" ::: "memory"); }
        }
    }
#undef EV_TOK
#undef EV_LOADI
#undef EV_LOADC
#undef EV_QUAD
#undef EV_ROW
#undef EV_ISSUE
#undef EV_HALF
}

struct Params { const float* in[N_IN]; float* out; unsigned char* ws; };

__device__ __forceinline__ LayerW make_w(ka_t in, int l) {
    LayerW W;
    W.sc_w = in[I_SCW] + (size_t)l * 3 * 512; W.rw_w0 = in[I_RW0] + (size_t)l * 2 * 512; W.rw_wup = in[I_RWUP] + (size_t)l * 2 * 64 * 512;
    W.rw_a0 = in[I_RA0] + (size_t)l * 2 * 512; W.rw_aup = in[I_RAUP] + (size_t)l * 2 * 64 * 512; W.rw_gup = in[I_RGUP] + (size_t)l * 128 * 512;
    W.rw_kk = in[I_RKK] + (size_t)l * 512; W.rw_ka = in[I_RKA] + (size_t)l * 512; W.rw_rk = in[I_RRK] + (size_t)l * 512;
    W.rw_lnw = in[I_RLNW] + (size_t)l * 512; W.rw_lnb = in[I_RLNB] + (size_t)l * 512;
    W.na_q = in[I_NAQ] + (size_t)l * 64; W.na_k = in[I_NAK] + (size_t)l * 64; W.rpb = in[I_RPB] + (size_t)l * 8 * 15 * 31;
    W.s_cw = in[I_SCONVW] + (size_t)l * 3 * 1024; W.s_cb = in[I_SCONVB] + (size_t)l * 1024; W.s_dtb = in[I_SDTB] + (size_t)l * 16; W.s_alog = in[I_SALOG] + (size_t)l * 16;
    W.s_d = in[I_SD] + (size_t)l * 8; W.s_norm = in[I_SNORM] + (size_t)l * 512;
    return W;
}

__global__ void __launch_bounds__(512, 2) hybrid_fwd(Params p) {
    extern __shared__ __attribute__((aligned(16))) unsigned char shm[];
    Ctx F; F.lds = (LAS unsigned char*)shm; F.tid = threadIdx.x; F.lane = F.tid & 63; F.wave = __builtin_amdgcn_readfirstlane(F.tid >> 6); F.bid = blockIdx.x; F.G = gridDim.x;
    volatile LAS unsigned* bst = (volatile LAS unsigned*)(F.lds + LDS_BAR_OFF);
    if (F.tid < 4) bst[F.tid] = 0u;
    __syncthreads();
    (void)xcd_barrier_post((unsigned*)(p.ws + WS_CTL), bst);
    volatile LAS int* lxi = (volatile LAS int*)(F.lds + LDS_XI_OFF);
    if (F.tid == 0) lxi[2] = (int)xb_add((unsigned*)(p.ws + WS_CTL) + CTL_TICKET + 64 * xb_xcc_id(), 1u);
#define RPT_PHASE(id, ...) do { __VA_ARGS__ if (RPT == (id)) { GRID_BAR(); PH_BEGIN(); __VA_ARGS__ } } while (0)
#define GRID_BAR() do { ka_t kb_ = (ka_t)__builtin_amdgcn_kernarg_segment_ptr(); asm volatile("" : "+s"(kb_)); unsigned xx_ = xb_xcc_id(); asm volatile("" : "+s"(xx_)); \
        XcdBarrier b_; b_.bar = (unsigned*)((unsigned char*)kb_[N_IN + 1] + WS_CTL); b_.x = xx_; b_.st = (volatile LAS unsigned*)(F.lds + LDS_BAR_OFF); xcd_barrier(b_); } while (0)
    ka_t in; unsigned char* ws; float* out;
#define PH_BEGIN() do { int t_ = threadIdx.x; asm volatile("; PHASE_MARK" : "+v"(t_)); F.tid = t_; F.lane = t_ & 63; F.wave = __builtin_amdgcn_readfirstlane(t_ >> 6); \
        int b_ = blockIdx.x, g_ = gridDim.x; asm volatile("" : "+s"(b_), "+s"(g_)); F.bid = b_; F.G = g_; \
        ka_t k_ = (ka_t)__builtin_amdgcn_kernarg_segment_ptr(); asm volatile("" : "+s"(k_)); in = k_; \
        out = (float*)in[N_IN]; ws = (unsigned char*)in[N_IN + 1]; } while (0)

    PH_BEGIN();
    RPT_PHASE(1, phase_prologue(F, in, ws););
    GRID_BAR();
    if (F.tid == 0) {
        const unsigned* bw = (const unsigned*)(ws + WS_CTL); const unsigned myx = xb_xcc_id(); int xi = 0, nx = 0, nloc = 1;
        for (unsigned j = 0; j < 16; ++j) { const unsigned cnt = xb_ld((unsigned*)&bw[XB_XCNT(j)]); if (cnt > 0u) { if (j < myx) ++xi; ++nx; } if (j == myx) nloc = (int)cnt; }
        lxi[0] = xi; lxi[1] = nx > 0 ? nx : 1; lxi[3] = nloc > 0 ? nloc : 1; }
    __syncthreads();
    PH_BEGIN();
    phase_modreduce(F, in[I_BADA], (const float*)(ws + WS_MODP), (float*)(ws + WS_MOD));
    GRID_BAR();

#pragma unroll 1
    for (int l = 0; l < 2; ++l) {
        const int M = (l == 0) ? NTOK : NLAT;
        if (l == 0) { PH_BEGIN(); phase_norm(F, in[I_X], in[I_CTX], in[I_NMIX], (const float*)(ws + WS_MOD), 0, 1, (bf16_t*)(ws + WS_XN), NTOK); GRID_BAR(); }

        PH_BEGIN();
        RPT_PHASE(2, { pg8::Gemm g{(const bf16_t*)(ws + WS_XN), (const bf16_t*)(ws + WS_WIN) + (size_t)l * PTP * 2048, NTOK, PTP, 2048}; pg8::StaticOrder S; S.init(NTOK, PTP, F.G, F.bid);
          pg8::EpiBf16 E{(bf16_t*)(ws + WS_P), PTP}; pg8::gemm_phase<pg8::EpiBf16, pg8::StaticOrder>(F.lds, g, S, E, F.tid); });
        GRID_BAR();

        PH_BEGIN();
        { const LayerW W = make_w(in, l); phase_prep(F, W, ws);
            if (RPT == 31) phase_prep(F, W, ws);
            const bf16_t* WUPT = (const bf16_t*)(ws + WS_WUPT) + (size_t)l * 4 * 512 * 64;
            for (int rep = 0; rep < (RPT == 32 ? 2 : 1); ++rep) {
            for (int task = F.bid * 8 + F.wave; task < 4 * 8 * RW_NCHUNK; task += F.G * 8) rwkv_pre_task(F, W, ws, WUPT, task, 0);
            for (int task = F.bid * 8 + F.wave; task < 4 * 8 * RW_NCHUNK; task += F.G * 8) rwkv_pre_task(F, W, ws, WUPT, task, 1); } }
        GRID_BAR();

        PH_BEGIN();
        RPT_PHASE(4, { const LayerW W = make_w(in, l); for (int task = F.bid; task < 4 * 8 * NCH; task += F.G) ssd_task<false>(F, W, ws, task); });
        GRID_BAR();
        PH_BEGIN();
        phase_ssd_combine(F, ws);
        GRID_BAR();

        PH_BEGIN();
        { if (F.bid < 64) rwkv_scan(F, ws, F.bid);
        else { const LayerW W = make_w(in, l); const int blk = F.bid - 64, nblk = F.G - 64;
            for (int task = blk; task < 4 * 8 * NCH; task += nblk) ssd_task<true>(F, W, ws, task);
            na_phase(F, W, ws, blk, nblk, (l == 0) ? 1088 : 1024); } }
        if (RPT == 51) { GRID_BAR(); PH_BEGIN(); if (F.bid < 64) rwkv_scan(F, ws, F.bid); }
        if (RPT == 52) { GRID_BAR(); PH_BEGIN(); if (F.bid >= 64) { const LayerW W = make_w(in, l); const int blk = F.bid - 64, nblk = F.G - 64;
            for (int task = blk; task < 4 * 8 * NCH; task += nblk) ssd_task<true>(F, W, ws, task); } }
        if (RPT == 53) { GRID_BAR(); PH_BEGIN(); if (F.bid >= 64) { const LayerW W = make_w(in, l); const int blk = F.bid - 64, nblk = F.G - 64;
            na_phase(F, W, ws, blk, nblk, (l == 0) ? 1088 : 1024); } }
        GRID_BAR();

        PH_BEGIN();
        RPT_PHASE(6, { const LayerW W = make_w(in, l); phase_finish(F, W, ws, (const bf16_t*)(ws + WS_GUPT) + (size_t)l * 512 * 128, M); });
        GRID_BAR();

        PH_BEGIN();
        { pg8::Gemm g{(const bf16_t*)(ws + WS_MIX), (const bf16_t*)(ws + WS_WOUT) + (size_t)l * 2048 * 2048, M, 2048, 2048}; pg8::StaticOrder S; S.init(M, 2048, F.G, F.bid);
          float* CTXS = (float*)(ws + WS_CTXS);
          pg8::EpiResid E{l == 0 ? in[I_X] : out, l == 0 ? in[I_CTX] : CTXS, out, CTXS, (const float*)(ws + WS_MOD) + (size_t)l * 5 * 12288 + 2 * 2048};
          pg8::gemm_phase<pg8::EpiResid, pg8::StaticOrder>(F.lds, g, S, E, F.tid); }
        if (l == 0 && F.bid >= 32) PEER_CONVERT_LAYER(F, in, ws, 0, F.bid - 32, F.G - 32);
        GRID_BAR();

        PH_BEGIN();
        RPT_PHASE(7, phase_norm(F, out, (const float*)(ws + WS_CTXS), in[I_NFFN] + (size_t)l * 2048, (const float*)(ws + WS_MOD) + (size_t)l * 5 * 12288, 3, 4, (bf16_t*)(ws + WS_XN), M););
        GRID_BAR();
        PH_BEGIN();
        RPT_PHASE(8, { pg8::Gemm g{(const bf16_t*)(ws + WS_XN), (const bf16_t*)(ws + WS_WQ) + (size_t)l * 2048 * 2048, M, 2048, 2048}; pg8::StaticOrder S; S.init(M, 2048, F.G, F.bid);
          pg8::EpiBf16 E{(bf16_t*)(ws + WS_P), 2048}; pg8::gemm_phase<pg8::EpiBf16, pg8::StaticOrder>(F.lds, g, S, E, F.tid); });
        if (l == 0 && F.bid >= 32) PEER_CONVERT_LAYER(F, in, ws, 1, F.bid - 32, F.G - 32);
        GRID_BAR();
        PH_BEGIN();
        RPT_PHASE(9, phase_scores(F, ws, l, M););
        GRID_BAR();
        PH_BEGIN();
        RPT_PHASE(10, { XInfo X; X.xi = lxi[0]; X.nx = lxi[1]; X.rank = lxi[2]; X.nloc = lxi[3]; phase_experts_u<0x3fff>(F, ws, l, M, X, (float*)(ws + WS_PART)); });
        if (RPT == 101) { GRID_BAR(); PH_BEGIN(); XInfo X; X.xi = lxi[0]; X.nx = lxi[1]; X.rank = lxi[2]; X.nloc = lxi[3]; phase_experts_u<0x3ff>(F, ws, l, M, X, (float*)(ws + WS_P)); }
        if (RPT == 102) { GRID_BAR(); PH_BEGIN(); XInfo X; X.xi = lxi[0]; X.nx = lxi[1]; X.rank = lxi[2]; X.nloc = lxi[3]; phase_experts_u<0x3fff>(F, ws, l, M, X, (float*)(ws + WS_P)); }
        GRID_BAR();
        PH_BEGIN();
        phase_experts_combine(F, ws, M);
        GRID_BAR();
        PH_BEGIN();
        if (RPT == 11) { XInfo X; X.xi = lxi[0]; X.nx = lxi[1]; X.rank = lxi[2]; X.nloc = lxi[3]; phase_experts_v(F, ws, (float*)(ws + WS_P), (float*)(ws + WS_P) + (size_t)NLAT * 2048, l, M, X); GRID_BAR(); PH_BEGIN(); }
        { XInfo X; X.xi = lxi[0]; X.nx = lxi[1]; X.rank = lxi[2]; X.nloc = lxi[3]; phase_experts_v(F, ws, out, (float*)(ws + WS_CTXS), l, M, X); }
        if (l == 0) { GRID_BAR(); PH_BEGIN();
            phase_norm(F, out, (const float*)(ws + WS_CTXS), in[I_NMIX] + 2048, (const float*)(ws + WS_MOD) + (size_t)5 * 12288, 0, 1, (bf16_t*)(ws + WS_XN), NTOK); GRID_BAR(); }
    }
}

extern "C" void kernel_launch(void* const* d_in, const int* in_sizes, int n_in, void* d_out, int out_size, void* d_ws, size_t ws_size, hipStream_t stream) {
    static int grid = 0;
    if (grid == 0) {
        if (n_in != N_IN || out_size != NLAT * DM || ws_size < WS_END) { fprintf(stderr, "kernel_launch: unexpected shapes (n_in %d out %d ws %zu, need %zu)\n", n_in, out_size, ws_size, (size_t)WS_END); grid = -1; return; }
        int dev = 0, cus = 0, per_cu = 0;
        (void)hipGetDevice(&dev); (void)hipDeviceGetAttribute(&cus, hipDeviceAttributeMultiprocessorCount, dev);
        if (hipFuncSetAttribute((const void*)hybrid_fwd, hipFuncAttributeMaxDynamicSharedMemorySize, LDS_BYTES) != hipSuccess) { fprintf(stderr, "kernel_launch: hipFuncSetAttribute failed\n"); grid = -1; return; }
        (void)hipOccupancyMaxActiveBlocksPerMultiprocessor(&per_cu, (const void*)hybrid_fwd, 512, LDS_BYTES);
        (void)hipGetLastError();
        fprintf(stderr, "kernel_launch: %d CUs, occupancy query %d block(s)/CU, ws %zu B (need %zu)\n", cus, per_cu, ws_size, (size_t)WS_END);
        grid = cus;
        if (grid < 136) { fprintf(stderr, "kernel_launch: needs at least 136 CUs\n"); grid = -1; return; }
    }
    if (grid < 0) return;
    (void)hipMemsetAsync((char*)d_ws + WS_CTL, 0, 65536, stream);
    Params p{};
    for (int i = 0; i < N_IN; ++i) p.in[i] = (const float*)d_in[i];
    p.out = (float*)d_out; p.ws = (unsigned char*)d_ws;
    hipLaunchKernelGGL(hybrid_fwd, dim3(grid), dim3(512), LDS_BYTES, stream, p);
}
```

```cpp
#include <hip/hip_runtime.h>
#include <cstdio>
#include <cstdint>
#ifndef RPT
#define RPT 0
#endif

constexpr int DM = 2048, NBATCH = 4, SEQL = 4096, CTXL = 256, NLAT = NBATCH * SEQL, NCTX = NBATCH * CTXL, NTOK = NLAT + NCTX;
constexpr int PT = 6416, PTP = 6656;
constexpr int A_BG = 0, A_CG = 512, A_H = 1024;
constexpr int B_R = 1536, B_K = 2048, B_V = 2560, B_WD = 3072, B_AD = 3136, B_GD = 3200;
constexpr int C_Q = 3328, C_K = 3840, C_V = 4352;
constexpr int D_Z = 4864, D_X = 5376, D_DT = 6400;
constexpr int NPOS = CTXL + SEQL;
constexpr int NCH = 34;
constexpr int KSPL = 32;

enum { I_X = 0, I_C, I_CTX, I_CCTX, I_WADA, I_BADA, I_NMIX, I_NFFN, I_WIN, I_WOUT, I_SCW, I_RW0, I_RWUP, I_RA0, I_RAUP, I_RGUP, I_RKK, I_RKA, I_RRK, I_RLNW, I_RLNB,
       I_NAQ, I_NAK, I_RPB, I_SCONVW, I_SCONVB, I_SDTB, I_SALOG, I_SD, I_SNORM, I_PWQ, I_PKEYS, I_PU, I_PV, N_IN };

constexpr size_t WS_CTL   = 0;
constexpr size_t WS_ROPE  = 65536;
constexpr size_t WS_MODP  = WS_ROPE + 16384;
constexpr size_t WS_MOD   = WS_MODP + (size_t)KSPL * 2 * 5 * 12288 * 4;
constexpr size_t WS_WIN   = WS_MOD + (size_t)2 * 5 * 12288 * 4;
constexpr size_t WS_WOUT  = WS_WIN + (size_t)2 * PTP * DM * 2;
constexpr size_t WS_WQ    = WS_WOUT + (size_t)2 * DM * DM * 2;
constexpr size_t WS_KEYS  = WS_WQ + (size_t)2 * DM * DM * 2;
constexpr size_t WS_WUPT  = WS_KEYS + (size_t)2 * 8 * 2 * 128 * 128 * 2;
constexpr size_t WS_GUPT  = WS_WUPT + (size_t)2 * 4 * 512 * 64 * 2;
constexpr size_t WS_PU    = WS_GUPT + (size_t)2 * 512 * 128 * 2;
constexpr size_t WS_PV    = WS_PU + (size_t)2 * 16384 * DM;
constexpr size_t WS_P     = WS_PV + (size_t)2 * 16384 * DM;
constexpr size_t WS_MIX   = WS_P + (size_t)NTOK * PTP * 2;
constexpr size_t WS_CTXS  = WS_MIX + (size_t)NTOK * DM * 2;
constexpr size_t WS_XN    = WS_CTXS + (size_t)NCTX * DM * 4;
constexpr size_t WS_IDS   = WS_XN + (size_t)NTOK * DM * 2;
constexpr size_t WS_GATES = WS_IDS + (size_t)NTOK * 128 * 4;
constexpr size_t WS_PART  = WS_GATES + (size_t)NTOK * 128 * 4;
constexpr size_t WS_RWF   = WS_XN;
constexpr size_t WS_RWY   = WS_RWF + (size_t)64 * 272 * 10496;
constexpr size_t WS_BON   = WS_RWY + (size_t)2 * NTOK * 512 * 2;
constexpr size_t WS_XBC   = WS_BON + (size_t)2 * NTOK * 8 * 4;
constexpr size_t WS_DTS   = WS_XBC + (size_t)NTOK * 1024 * 2;
constexpr size_t WS_DEC   = WS_DTS + (size_t)NTOK * 16 * 4;
constexpr size_t WS_SST   = WS_DEC + (size_t)NTOK * 16 * 4;
constexpr size_t WS_SCD   = WS_SST + (size_t)64 * NCH * 8192 * 4;
constexpr size_t WS_YS    = WS_SCD + 16384;
constexpr size_t WS_QN    = WS_YS + (size_t)NTOK * 512 * 4;
constexpr size_t WS_KN    = WS_QN + (size_t)NTOK * 512 * 2;
constexpr size_t WS_VTL   = WS_KN + (size_t)NTOK * 512 * 2;
constexpr size_t WS_VTC   = WS_VTL + (size_t)4 * 8 * 64 * 64 * 96 * 2;
constexpr size_t WS_END   = WS_VTC + (size_t)4 * 8 * 64 * 256 * 2;
static_assert(WS_END < (size_t)1020 * 1024 * 1024, "workspace");
static_assert(WS_GATES + (size_t)NTOK * 128 * 4 <= WS_PART && WS_PART + (size_t)16 * NTOK * 128 * 4 <= WS_END, "alias");

constexpr int LDS_BYTES = 147456;
constexpr int LDS_BAR_OFF = LDS_BYTES - 16;
constexpr int LDS_XI_OFF = LDS_BYTES - 48;
constexpr int CTL_TICKET = 8192;

#define LAS __attribute__((address_space(3)))
typedef unsigned short bf16_t;
typedef _Float16 f16_t;
typedef short bf16x8 __attribute__((ext_vector_type(8)));
typedef float f32x4 __attribute__((ext_vector_type(4)));
typedef unsigned u32x4 __attribute__((ext_vector_type(4)));
typedef unsigned u32x2 __attribute__((ext_vector_type(2)));

__device__ __forceinline__ float bf2f(bf16_t h) { return __uint_as_float(((unsigned)h) << 16); }
__device__ __forceinline__ float bflo(unsigned u) { return __uint_as_float(u << 16); }
__device__ __forceinline__ float bfhi(unsigned u) { return __uint_as_float(u & 0xffff0000u); }
__device__ __forceinline__ bf16_t f2bf(float f) { unsigned u = __float_as_uint(f); u += 0x7FFFu + ((u >> 16) & 1u); return (bf16_t)(u >> 16); }
typedef float f32x2_t __attribute__((ext_vector_type(2)));
typedef __bf16 bf16x2_t __attribute__((ext_vector_type(2)));
__device__ __forceinline__ unsigned pk_bf16(float lo, float hi) { const f32x2_t v = {lo, hi}; const bf16x2_t r = __builtin_convertvector(v, bf16x2_t); return __builtin_bit_cast(unsigned, r); }
__device__ __forceinline__ bf16x8 pack8(const f32x4 a, const f32x4 b) { union { bf16x8 v; unsigned u[4]; } r; r.u[0] = pk_bf16(a[0], a[1]); r.u[1] = pk_bf16(a[2], a[3]); r.u[2] = pk_bf16(b[0], b[1]); r.u[3] = pk_bf16(b[2], b[3]); return r.v; }
template <int CTRL> __device__ __forceinline__ float dpp_f(float v) { return __int_as_float(__builtin_amdgcn_update_dpp(0, __float_as_int(v), CTRL, 0xF, 0xF, true)); }
__device__ __forceinline__ float sum4(float x)  { x += dpp_f<0xB1>(x); x += dpp_f<0x4E>(x); return x; }
__device__ __forceinline__ float sum8(float x)  { x = sum4(x); x += dpp_f<0x141>(x); return x; }
__device__ __forceinline__ float sum16(float x) { x = sum8(x); x += dpp_f<0x140>(x); return x; }
__device__ __forceinline__ float xor16_f(float x) { return __int_as_float(__builtin_amdgcn_ds_swizzle(__float_as_int(x), 0x401F)); }
__device__ __forceinline__ float sum_x32(float x) { const auto r = __builtin_amdgcn_permlane32_swap(__float_as_uint(x), __float_as_uint(x), false, false); return __uint_as_float(r[0]) + __uint_as_float(r[1]); }
__device__ __forceinline__ float max_x32(float x) { const auto r = __builtin_amdgcn_permlane32_swap(__float_as_uint(x), __float_as_uint(x), false, false); return fmaxf(__uint_as_float(r[0]), __uint_as_float(r[1])); }
__device__ __forceinline__ float wave_sum(float x) { x = sum16(x); x += xor16_f(x); return sum_x32(x); }
__device__ __forceinline__ float max16(float x) { x = fmaxf(x, dpp_f<0xB1>(x)); x = fmaxf(x, dpp_f<0x4E>(x)); x = fmaxf(x, dpp_f<0x141>(x)); x = fmaxf(x, dpp_f<0x140>(x)); return x; }
__device__ __forceinline__ float wave_max(float x) { x = max16(x); x = fmaxf(x, xor16_f(x)); return max_x32(x); }
__device__ __forceinline__ float rcpf_(float x) { return __builtin_amdgcn_rcpf(x); }
__device__ __forceinline__ float sigmoidf_(float x) { return rcpf_(1.0f + __expf(-x)); }
__device__ __forceinline__ float siluf_(float x) { return x * rcpf_(1.0f + __expf(-x)); }
__device__ __forceinline__ float tanhf_(float x) { const float e = __expf(2.0f * x); return 1.0f - 2.0f * rcpf_(e + 1.0f); }
__device__ __forceinline__ float geluf_(float x) { return 0.5f * x * (1.0f + tanhf_(0.7978845608028654f * (x + 0.044715f * x * x * x))); }

namespace pg8 {
#define PG8_LAS __attribute__((address_space(3)))
typedef unsigned short bf16_t;
typedef short bf16x8 __attribute__((ext_vector_type(8)));
typedef float f32x4 __attribute__((ext_vector_type(4)));
typedef unsigned u32x4 __attribute__((ext_vector_type(4)));
constexpr int BM = 256, BK = 64, HALF = 128, HTB = HALF * BK * 2  , STAGE_BYTES = 8 * HTB, NXCD = 8, WGM = 8;

__host__ __device__ __forceinline__ int lds_byte(int r, int c) { const int st = (r >> 4) * 2 + (c >> 5), rr = r & 15, cc = c & 31, ob = rr * 64 + cc * 2; return st * 1024 + (ob ^ (((ob >> 9) & 1) << 5)); }
__host__ __device__ __forceinline__ void stage_rc(int b, int& R, int& C) { const int st = b / 1024, sb = b % 1024, swz = sb ^ (((sb >> 9) & 1) << 5); R = (st >> 1) * 16 + swz / 64; C = (st & 1) * 32 + (swz % 64) / 2; }
__host__ __device__ __forceinline__ int perm32(int rho) { const int n = rho >> 4, i = rho & 15; return 8 * (i >> 2) + 4 * n + (i & 3); }

struct Unit { int pm, pn; };
struct Gemm { const bf16_t* A; const bf16_t* Bt; int M, N, K; };

struct StaticOrder {
    int nM, nN, nwg, G, c;
    __host__ __device__ void init(int M, int N, int G_, int c_) { nM = M / BM; nN = N / BM; nwg = nM * nN; G = G_; c = c_; }
    __host__ __device__ bool next(int i, Unit& u) const {
        const long L = (long)i * G + c; if (L >= nwg) return false;
        int wgid = (int)L; { const int q = nwg / NXCD, r = nwg % NXCD, xcd = wgid % NXCD, off = wgid / NXCD; wgid = (xcd < r ? xcd * (q + 1) : r * (q + 1) + (xcd - r) * q) + off; }
        const int nig = WGM * nN, gid = wgid / nig, fm = gid * WGM, gsz = (nM - fm) < WGM ? (nM - fm) : WGM;
        u.pm = fm + ((wgid % nig) % gsz); u.pn = (wgid % nig) / gsz; return true;
    }
    __device__ __forceinline__ void a_ready(const Unit&) const {}
    __device__ __forceinline__ void done(const Unit&) const {}
};

__device__ __forceinline__ unsigned cvt_pk_bf16(float lo, float hi) { return ::pk_bf16(lo, hi); }
struct EpiBf16 {
    static constexpr bool PERM = true, AFTER_DRAIN = false;
    bf16_t* O; int ldc;
    __device__ __forceinline__ void operator()(const f32x4 (&acc)[2][2][4][2], const Unit& u, int wr, int wc, int fr, int fq) const {
        const int row0 = u.pm * BM + wr * 64 + fr; const int col0 = u.pn * BM + wc * 32 + 8 * fq;
#pragma unroll
        for (int ai = 0; ai < 2; ++ai)
#pragma unroll
            for (int m = 0; m < 4; ++m) { bf16_t* rowp = O + (size_t)(row0 + ai * HALF + m * 16) * ldc + col0;
#pragma unroll
                for (int bj = 0; bj < 2; ++bj) { const f32x4 v0 = acc[ai][bj][m][0], v1 = acc[ai][bj][m][1];
                    u32x4 w; w.x = cvt_pk_bf16(v0[0], v0[1]); w.y = cvt_pk_bf16(v0[2], v0[3]); w.z = cvt_pk_bf16(v1[0], v1[1]); w.w = cvt_pk_bf16(v1[2], v1[3]);
                    *(u32x4*)(rowp + bj * HALF) = w; } }
    }
};
struct EpiResid {
    static constexpr bool PERM = false, AFTER_DRAIN = false;
    const float* xi_lat; const float* xi_ctx; float* xo_lat; float* xo_ctx; const float* gate;
    __device__ __forceinline__ void operator()(const f32x4 (&acc)[2][2][4][2], const Unit& u, int wr, int wc, int fr, int fq) const {
        const bool isctx = u.pm >= 64; const int v = isctx ? 4 : (u.pm >> 4);
        const int row0 = (isctx ? (u.pm - 64) : u.pm) * BM + wr * 64 + fr, col0 = u.pn * BM + wc * 32 + 4 * fq;
        const float* xi = isctx ? xi_ctx : xi_lat; float* xo = isctx ? xo_ctx : xo_lat;
        const float* gp = gate + (size_t)v * 12288 + col0;
        f32x4 gv[2][2];
#pragma unroll
        for (int bj = 0; bj < 2; ++bj)
#pragma unroll
            for (int n = 0; n < 2; ++n) gv[bj][n] = *(const f32x4*)(gp + bj * HALF + n * 16);
#pragma unroll
        for (int ai = 0; ai < 2; ++ai)
#pragma unroll
            for (int m = 0; m < 4; ++m) { const size_t off = (size_t)(row0 + ai * HALF + m * 16) * 2048 + col0;
#pragma unroll
                for (int bj = 0; bj < 2; ++bj)
#pragma unroll
                    for (int n = 0; n < 2; ++n) { const f32x4 xv = *(const f32x4*)(xi + off + bj * HALF + n * 16);
                        *(f32x4*)(xo + off + bj * HALF + n * 16) = xv + gv[bj][n] * acc[ai][bj][m][n]; }
                asm volatile("" ::: "memory"); }
    }
};

template <class Epi, class Sched>
__device__ __forceinline__ void gemm_phase(PG8_LAS unsigned char* lds, const Gemm g, const Sched& S, const Epi& E, const int tid) {
    const int wid = __builtin_amdgcn_readfirstlane(tid >> 6), lane = tid & 63, wr = wid >> 2, wc = wid & 3, fr = lane & 15, fq = lane >> 4;
    const int K = g.K, nt = K / BK;
    unsigned voffA[2], voffB[2];
#pragma unroll
    for (int i = 0; i < 2; ++i) { int R, C; stage_rc(tid * 16 + i * 8192, R, C); const int Rb = Epi::PERM ? ((R & ~31) + perm32(R & 31)) : R;
        voffA[i] = (unsigned)(R * K + C) * 2u; voffB[i] = (unsigned)(Rb * K + C) * 2u; }
    const size_t kstep = (size_t)(BK * 2);
    const size_t hstep = (size_t)HALF * K * 2;
    const size_t tstep = 2 * hstep;
    const unsigned ldsw = (unsigned)wid * 1024u;
    const int aoff = lds_byte(wr * 64 + fr, fq * 8), boff = lds_byte(wc * 32 + fr, fq * 8);
#define PG8_SA(b, h) (((b) * 2 + (h)) * HTB)
#define PG8_SB(b, h) ((4 + (b) * 2 + (h)) * HTB)
#define PG8_STAGE(bufoff, gbase, voff) do { _Pragma("unroll") for (int _i = 0; _i < 2; ++_i) \
        __builtin_amdgcn_global_load_lds((const unsigned*)((const char*)(gbase) + (voff)[_i]), (PG8_LAS unsigned*)(lds + (bufoff) + ldsw + _i * 8192), 16, 0, 0); } while (0)
#define PG8_LDA(dst, b, h) do { _Pragma("unroll") for (int m = 0; m < 4; ++m) _Pragma("unroll") for (int k = 0; k < 2; ++k) dst[m][k] = *(const PG8_LAS bf16x8*)(lds + PG8_SA(b, h) + aoff + m * 2048 + k * 1024); } while (0)
#define PG8_LDB(dst, b, h) do { _Pragma("unroll") for (int n = 0; n < 2; ++n) _Pragma("unroll") for (int k = 0; k < 2; ++k) dst[n][k] = *(const PG8_LAS bf16x8*)(lds + PG8_SB(b, h) + boff + n * 2048 + k * 1024); } while (0)
#define PG8_MMA(ai, bj, At, Bt) do { __builtin_amdgcn_s_setprio(1); _Pragma("unroll") for (int m = 0; m < 4; ++m) _Pragma("unroll") for (int n = 0; n < 2; ++n) _Pragma("unroll") for (int k = 0; k < 2; ++k) \
        acc[ai][bj][m][n] = __builtin_amdgcn_mfma_f32_16x16x32_bf16(Bt[n][k], At[m][k], acc[ai][bj][m][n], 0, 0, 0); __builtin_amdgcn_s_setprio(0); } while (0)
#define PG8_WAIT_V(n) asm volatile("s_waitcnt vmcnt(" #n ")" ::: "memory")
#define PG8_WAIT_L(n) asm volatile("s_waitcnt lgkmcnt(" #n ")" ::: "memory")
#define PG8_BAR __builtin_amdgcn_s_barrier()
#define PG8_SCHED __builtin_amdgcn_sched_barrier(0)
    Unit cur, nxt; int ui = 0;
    if (!S.next(0, cur)) return;
    f32x4 acc[2][2][4][2];
#pragma unroll
    for (int a = 0; a < 2; ++a)
#pragma unroll
        for (int b = 0; b < 2; ++b)
#pragma unroll
            for (int m = 0; m < 4; ++m)
#pragma unroll
                for (int n = 0; n < 2; ++n) acc[a][b][m][n] = (f32x4){0.f, 0.f, 0.f, 0.f};
    bf16x8 At[4][2], B0[2][2], B1[2][2];
    const char* cA = (const char*)g.A + (size_t)cur.pm * tstep; const char* cB = (const char*)g.Bt + (size_t)cur.pn * tstep;
    S.a_ready(cur);
    PG8_STAGE(PG8_SB(0, 0), cB, voffB); PG8_STAGE(PG8_SA(0, 0), cA, voffA); PG8_STAGE(PG8_SB(0, 1), cB + hstep, voffB); PG8_STAGE(PG8_SA(0, 1), cA + hstep, voffA);
    if (wr == 1) PG8_BAR;
    PG8_WAIT_V(4); PG8_BAR;
    PG8_STAGE(PG8_SB(1, 0), cB + kstep, voffB); PG8_STAGE(PG8_SA(1, 0), cA + kstep, voffA); PG8_STAGE(PG8_SB(1, 1), cB + hstep + kstep, voffB);
    PG8_WAIT_V(6); PG8_BAR;
    for (;;) {
        const bool has_next = S.next(ui + 1, nxt);
        const char* nA = has_next ? (const char*)g.A + (size_t)nxt.pm * tstep : cA; const char* nB = has_next ? (const char*)g.Bt + (size_t)nxt.pn * tstep : cB;
        for (int t = 0; t < nt; t += 2) {
            const bool last = (t == nt - 2);
            const char* a1 = cA + (size_t)(t + 1) * kstep;
            const char* a2 = last ? nA : cA + (size_t)(t + 2) * kstep; const char* b2 = last ? nB : cB + (size_t)(t + 2) * kstep;
            const char* a3 = a2 + kstep; const char* b3 = b2 + kstep;
            if (last && has_next) S.a_ready(nxt);
            PG8_LDB(B0, 0, 0); PG8_SCHED; PG8_LDA(At, 0, 0); PG8_STAGE(PG8_SA(1, 1), a1 + hstep, voffA);
            PG8_WAIT_L(8); PG8_BAR; PG8_WAIT_L(0); PG8_MMA(0, 0, At, B0); PG8_BAR; PG8_SCHED;
            PG8_LDB(B1, 0, 1); PG8_STAGE(PG8_SB(0, 0), b2, voffB);
            PG8_BAR; PG8_WAIT_L(0); PG8_MMA(0, 1, At, B1); PG8_BAR;
            PG8_LDA(At, 0, 1); PG8_STAGE(PG8_SA(0, 0), a2, voffA);
            PG8_BAR; PG8_WAIT_L(0); PG8_MMA(1, 0, At, B0); PG8_BAR; PG8_SCHED;
            PG8_STAGE(PG8_SB(0, 1), b2 + hstep, voffB);
            PG8_WAIT_V(6); PG8_BAR; PG8_MMA(1, 1, At, B1); PG8_BAR;
            PG8_LDB(B0, 1, 0); PG8_SCHED; PG8_LDA(At, 1, 0); PG8_STAGE(PG8_SA(0, 1), a2 + hstep, voffA);
            PG8_WAIT_L(8); PG8_BAR; PG8_WAIT_L(0); PG8_MMA(0, 0, At, B0); PG8_BAR; PG8_SCHED;
            PG8_LDB(B1, 1, 1); PG8_STAGE(PG8_SB(1, 0), b3, voffB);
            PG8_BAR; PG8_WAIT_L(0); PG8_MMA(0, 1, At, B1); PG8_BAR;
            PG8_LDA(At, 1, 1); PG8_STAGE(PG8_SA(1, 0), a3, voffA);
            PG8_BAR; PG8_WAIT_L(0); PG8_MMA(1, 0, At, B0); PG8_BAR; PG8_SCHED;
            PG8_STAGE(PG8_SB(1, 1), b3 + hstep, voffB);
            PG8_WAIT_V(6); PG8_BAR; PG8_MMA(1, 1, At, B1); PG8_BAR;
        }
        if constexpr (!Epi::AFTER_DRAIN) { E(acc, cur, wr, wc, fr, fq); S.done(cur); }
        if (!has_next) break;
#pragma unroll
        for (int a = 0; a < 2; ++a)
#pragma unroll
            for (int b = 0; b < 2; ++b)
#pragma unroll
                for (int m = 0; m < 4; ++m)
#pragma unroll
                    for (int n = 0; n < 2; ++n) acc[a][b][m][n] = (f32x4){0.f, 0.f, 0.f, 0.f};
        cur = nxt; cA = nA; cB = nB; ++ui;
    }
    PG8_WAIT_V(0);
    if (wr == 0) PG8_BAR;
    PG8_BAR;
    if constexpr (Epi::AFTER_DRAIN) { E.fused(acc, cur, wr, wc, fr, fq, lds, wid, lane); S.done(cur); }
#undef PG8_SA
#undef PG8_SB
#undef PG8_STAGE
#undef PG8_LDA
#undef PG8_LDB
#undef PG8_MMA
#undef PG8_WAIT_V
#undef PG8_WAIT_L
#undef PG8_BAR
#undef PG8_SCHED
}
}

#define XB_TMO      128
#define XB_XCNT(j)  (256  + 64 * (j))
#define XB_XSUB(j)  (1280 + 64 * (j))
#define XB_XGEN(j)  (2304 + 64 * (j))
#define XB_TOP      3328
#define XB_TOPGEN   3392
#define XCD_BAR_WORDS 3456
#define XB_SPIN_CAP (1u << 18)
#define LAS __attribute__((address_space(3)))

__device__ __forceinline__ unsigned xb_ld(unsigned* p)              { return __hip_atomic_load(p, __ATOMIC_RELAXED, __HIP_MEMORY_SCOPE_AGENT); }
__device__ __forceinline__ unsigned xb_add(unsigned* p, unsigned v) { return __hip_atomic_fetch_add(p, v, __ATOMIC_RELAXED, __HIP_MEMORY_SCOPE_AGENT); }
__device__ __forceinline__ unsigned xb_xcc_id() { return (unsigned)__builtin_amdgcn_s_getreg((3 << 11) | 20) & 0xFu; }
#define XB_SPIN(cond, bar) do { unsigned _sp = 0; while (cond) { __builtin_amdgcn_s_sleep(1); \
    if ((++_sp & 255u) == 0u) { if (xb_ld(&(bar)[XB_TMO])) break; if (_sp > XB_SPIN_CAP) { atomicAdd(&(bar)[XB_TMO], 1u); break; } } } } while (0)

struct XcdBarrier {
    unsigned* bar; unsigned x;
    volatile LAS unsigned* st;
};

__device__ __forceinline__ XcdBarrier xcd_barrier_post(unsigned* bar, volatile LAS unsigned* st) {
    XcdBarrier b; b.bar = bar; b.x = xb_xcc_id(); b.st = st;
    if (threadIdx.x == 0) (void)xb_add(&bar[XB_XCNT(b.x)], 1u);
    return b;
}
__device__ __forceinline__ void xcd_barrier_complete(unsigned* bar, unsigned x, unsigned& nloc, unsigned& nx) {
    const unsigned G = gridDim.x * gridDim.y * gridDim.z;
    unsigned sum, cnt, mine, sp = 0u;
    for (;;) {
        sum = 0u; cnt = 0u; mine = 0u;
#pragma unroll
        for (unsigned j = 0; j < 16; ++j) { const unsigned c = xb_ld(&bar[XB_XCNT(j)]); sum += c; cnt += (c > 0u) ? 1u : 0u; mine = (j == x) ? c : mine; }
        if (sum == G) break;
        __builtin_amdgcn_s_sleep(1);
        if ((++sp & 255u) == 0u) { if (xb_ld(&bar[XB_TMO])) break; if (sp > XB_SPIN_CAP) { atomicAdd(&bar[XB_TMO], 1u); break; } }
    }
    nloc = mine > 0u ? mine : 1u; nx = cnt > 0u ? cnt : 1u;
}

__device__ __forceinline__ void xcd_barrier(const XcdBarrier& b) {
    asm volatile("s_waitcnt vmcnt(0)" ::: "memory");
    __syncthreads();
    if (threadIdx.x == 0) {
        unsigned* bar = b.bar;
        __builtin_amdgcn_s_waitcnt(0);
        unsigned nloc = b.st[0], nx = b.st[1];
        if (nloc == 0u) { xcd_barrier_complete(bar, b.x, nloc, nx); b.st[0] = nloc; b.st[1] = nx; }
        const unsigned old = xb_add(&bar[XB_XSUB(b.x)], 1u);
        const unsigned gen = old / nloc;
        if (old + 1u == (gen + 1u) * nloc) {
            __builtin_amdgcn_fence(__ATOMIC_RELEASE, "agent");
            asm volatile("s_waitcnt vmcnt(0)" ::: "memory");
            const unsigned og = xb_add(&bar[XB_TOP], 1u);
            const unsigned tg = og / nx;
            if (og + 1u == (tg + 1u) * nx) xb_add(&bar[XB_TOPGEN], 1u);
            else XB_SPIN(xb_ld(&bar[XB_TOPGEN]) == tg, bar);
            __builtin_amdgcn_fence(__ATOMIC_ACQUIRE, "agent");
            xb_add(&bar[XB_XGEN(b.x)], 1u);
            asm volatile("s_waitcnt vmcnt(0)" ::: "memory");
        } else {
            XB_SPIN(xb_ld(&bar[XB_XGEN(b.x)]) == gen, bar);
            __builtin_amdgcn_fence(__ATOMIC_ACQUIRE, "agent");
            asm volatile("s_waitcnt vmcnt(0)" ::: "memory");
        }
    }
    __syncthreads();
}

typedef const float* cfp_t;
typedef __attribute__((address_space(4))) const cfp_t* ka_t;
struct Ctx {
    LAS unsigned char* lds; int tid, lane, wave, bid, G;
};

__device__ __forceinline__ void task_ada(const Ctx& F, const float* c, const float* c_ctx, const float* w_ada, float* modp, int task) {
    LAS float* s_act = (LAS float*)F.lds;
    const int l = task / (KSPL * 6), rem = task % (KSPL * 6), ks = rem / 6, cc = rem % 6;
    __syncthreads();
    if (F.tid < 320) { const int v = F.tid >> 6, k = ks * 64 + (F.tid & 63); const float x = v < 4 ? c[v * 2048 + k] : c_ctx[k]; s_act[F.tid] = siluf_(x); }
    __syncthreads();
    const int col4 = cc * 512 + F.tid;
    const float4* wp = (const float4*)(w_ada + ((size_t)l * 2048 + ks * 64) * 12288) + col4;
    float4 acc[5];
#pragma unroll
    for (int v = 0; v < 5; ++v) acc[v] = make_float4(0.f, 0.f, 0.f, 0.f);
#pragma unroll 8
    for (int k = 0; k < 64; ++k) {
        const float4 w = wp[(size_t)k * 3072];
#pragma unroll
        for (int v = 0; v < 5; ++v) { const float a = s_act[v * 64 + k]; acc[v].x += a * w.x; acc[v].y += a * w.y; acc[v].z += a * w.z; acc[v].w += a * w.w; }
    }
#pragma unroll
    for (int v = 0; v < 5; ++v) ((float4*)(modp + (((size_t)ks * 2 + l) * 5 + v) * 12288))[col4] = acc[v];
}
__device__ __forceinline__ void task_wt(const Ctx& F, const float* W, int N, bf16_t* Wt, int ntile) {
    LAS bf16_t* T = (LAS bf16_t*)F.lds;
    const int nq = F.tid & 15, kr = F.tid >> 4, n0 = ntile * 64;
    for (int kc = 0; kc < 16; ++kc) {
        float4 v[4];
#pragma unroll
        for (int j = 0; j < 4; ++j) { const int k = kc * 128 + kr + 32 * j, n = n0 + 4 * nq;
            v[j] = (n < N) ? *(const float4*)(W + (size_t)k * N + n) : make_float4(0.f, 0.f, 0.f, 0.f); }
        __syncthreads();
#pragma unroll
        for (int j = 0; j < 4; ++j) { const int kl = kr + 32 * j;
            T[(4 * nq + 0) * 136 + kl] = f2bf(v[j].x); T[(4 * nq + 1) * 136 + kl] = f2bf(v[j].y); T[(4 * nq + 2) * 136 + kl] = f2bf(v[j].z); T[(4 * nq + 3) * 136 + kl] = f2bf(v[j].w); }
        __syncthreads();
        { const int n = F.tid >> 3, kg = F.tid & 7;
          const u32x4 a = *(LAS u32x4*)(T + n * 136 + kg * 16), b = *(LAS u32x4*)(T + n * 136 + kg * 16 + 8);
          bf16_t* dst = Wt + (size_t)(n0 + n) * 2048 + kc * 128 + kg * 16; *(u32x4*)dst = a; *(u32x4*)(dst + 8) = b; }
    }
    __syncthreads();
}
__device__ __forceinline__ void task_cvt(const Ctx& F, const float* src, bf16_t* dst, size_t off) {
#pragma unroll 4
    for (int it = 0; it < 16; ++it) { const size_t e = off + (size_t)it * 4096 + F.tid * 8;
        const float4 a = *(const float4*)(src + e), b = *(const float4*)(src + e + 4);
        u32x4 o; o.x = pk_bf16(a.x, a.y); o.y = pk_bf16(a.z, a.w); o.z = pk_bf16(b.x, b.y); o.w = pk_bf16(b.z, b.w);
        *(u32x4*)(dst + e) = o; }
}
__device__ __forceinline__ void task_cvt8(const Ctx& F, const float* src, unsigned char* dst, size_t off, float scale) {
#pragma unroll 2
    for (int it = 0; it < 8; ++it) { const size_t e = off + (size_t)it * 8192 + F.tid * 16;
        u32x4 o;
#pragma unroll
        for (int w = 0; w < 4; ++w) { const float4 a = *(const float4*)(src + e + 4 * w);
            const float x0 = fminf(fmaxf(a.x * scale, -448.f), 448.f), x1 = fminf(fmaxf(a.y * scale, -448.f), 448.f), x2 = fminf(fmaxf(a.z * scale, -448.f), 448.f), x3 = fminf(fmaxf(a.w * scale, -448.f), 448.f);
            int p = __builtin_amdgcn_cvt_pk_fp8_f32(x0, x1, 0, false); p = __builtin_amdgcn_cvt_pk_fp8_f32(x2, x3, p, true); o[w] = (unsigned)p; }
        const size_t row = e >> 11; const int col = (int)(e & 2047);
        *(u32x4*)(dst + (row >> 14) * ((size_t)16384 * 2048) + ((size_t)(col >> 7) * 16384 + (row & 16383)) * 128 + (col & 127)) = o; }
}
constexpr float PEER_U_SCALE = 64.0f;
#define PEER_CONVERT_LAYER(F, in, ws, layer, blk, nblk) do { for (int t_ = (blk); t_ < 1024; t_ += (nblk)) { const bool isv_ = t_ >= 512; \
        task_cvt8(F, in[isv_ ? I_PV : I_PU], ws + (isv_ ? WS_PV : WS_PU), (size_t)(layer) * 16384 * 2048 + (size_t)(t_ & 511) * 65536, isv_ ? 1.0f : PEER_U_SCALE); } } while (0)
__device__ __forceinline__ void task_lorat(const Ctx& F, const float* src, bf16_t* dst, int nj) {
    const int ch = F.tid;
    for (int j8 = 0; j8 < nj / 8; ++j8) { float v[8];
#pragma unroll
        for (int q = 0; q < 8; ++q) v[q] = src[(size_t)(j8 * 8 + q) * 512 + ch];
        u32x4 o; o.x = pk_bf16(v[0], v[1]); o.y = pk_bf16(v[2], v[3]); o.z = pk_bf16(v[4], v[5]); o.w = pk_bf16(v[6], v[7]);
        *(u32x4*)(dst + (size_t)ch * nj + j8 * 8) = o; }
}
constexpr int T_ADA = 2 * KSPL * 6, T_WT1 = 2 * 104, T_WT2 = 2 * 32, T_WT3 = 2 * 32, T_PEER = 0, T_KEYS = 8, T_LORA = 10;
__device__ __forceinline__ void phase_prologue(const Ctx& F, ka_t in, unsigned char* ws) {
    const int total = T_ADA + T_WT1 + T_WT2 + T_WT3 + T_PEER + T_KEYS + T_LORA + 1;
    for (int t0 = F.bid; t0 < total; t0 += F.G) {
        int t = t0;
        if (t < T_ADA) { task_ada(F, in[I_C], in[I_CCTX], in[I_WADA], (float*)(ws + WS_MODP), t); continue; } t -= T_ADA;
        if (t < T_WT1) { const int l = t / 104, nt = t % 104; task_wt(F, in[I_WIN] + (size_t)l * 2048 * PT, PT, (bf16_t*)(ws + WS_WIN) + (size_t)l * PTP * 2048, nt); continue; } t -= T_WT1;
        if (t < T_WT2) { const int l = t / 32, nt = t % 32; task_wt(F, in[I_WOUT] + (size_t)l * 2048 * 2048, 2048, (bf16_t*)(ws + WS_WOUT) + (size_t)l * 2048 * 2048, nt); continue; } t -= T_WT2;
        if (t < T_WT3) { const int l = t / 32, nt = t % 32; task_wt(F, in[I_PWQ] + (size_t)l * 2048 * 2048, 2048, (bf16_t*)(ws + WS_WQ) + (size_t)l * 2048 * 2048, nt); continue; } t -= T_WT3;
        if (t < T_PEER) { const bool isv = t >= 1024; const int c = t & 1023; task_cvt8(F, in[isv ? I_PV : I_PU], ws + (isv ? WS_PV : WS_PU), (size_t)c * 65536, isv ? 1.0f : PEER_U_SCALE); continue; } t -= T_PEER;
        if (t < T_KEYS) { task_cvt(F, in[I_PKEYS], (bf16_t*)(ws + WS_KEYS), (size_t)t * 65536); continue; } t -= T_KEYS;
        if (t < T_LORA) {
            if (t < 8) { const int l = t >> 2, wh = t & 3;
                task_lorat(F, in[wh < 2 ? I_RWUP : I_RAUP] + ((size_t)l * 2 + (wh & 1)) * 64 * 512, (bf16_t*)(ws + WS_WUPT) + ((size_t)l * 4 + wh) * 512 * 64, 64); }
            else { const int l = t - 8; task_lorat(F, in[I_RGUP] + (size_t)l * 128 * 512, (bf16_t*)(ws + WS_GUPT) + (size_t)l * 512 * 128, 128); }
            continue; } t -= T_LORA;
        { float* rope = (float*)(ws + WS_ROPE);
          for (int e = F.tid; e < 2048; e += 512) { const int pos = e >> 5, i = e & 31; const float fr = powf(10000.0f, -(float)i / 32.0f), ang = (float)pos * fr;
              rope[2 * e] = cosf(ang); rope[2 * e + 1] = sinf(ang); } }
    }
}
__device__ __forceinline__ void phase_modreduce(const Ctx& F, const float* b_ada, const float* modp, float* mod) {
    for (int idx = F.bid * 512 + F.tid; idx < 2 * 5 * 12288; idx += F.G * 512) {
        const int l = idx / 61440, rem = idx % 61440, v = rem / 12288, n = rem % 12288;
        float s = b_ada[l * 12288 + n];
        for (int ks = 0; ks < KSPL; ++ks) s += modp[(((size_t)ks * 2 + l) * 5 + v) * 12288 + n];
        mod[idx] = s;
    }
}

__device__ __forceinline__ void norm_store(const float (&x)[32], const float* gw, const float* shift, const float* scale, bf16_t* dst, int lane) {
    float ss = 0.f;
#pragma unroll
    for (int q = 0; q < 32; ++q) ss += x[q] * x[q];
    ss = wave_sum(ss);
    const float rs = rsqrtf(ss * (1.0f / 2048.0f) + 1e-6f);
#pragma unroll
    for (int j = 0; j < 4; ++j) { const int e = j * 512 + lane * 8;
        const float4 g0 = *(const float4*)(gw + e), g1 = *(const float4*)(gw + e + 4), h0 = *(const float4*)(shift + e), h1 = *(const float4*)(shift + e + 4), c0 = *(const float4*)(scale + e), c1 = *(const float4*)(scale + e + 4);
        const float y0 = x[j * 8 + 0] * rs * g0.x * (1.f + c0.x) + h0.x, y1 = x[j * 8 + 1] * rs * g0.y * (1.f + c0.y) + h0.y, y2 = x[j * 8 + 2] * rs * g0.z * (1.f + c0.z) + h0.z, y3 = x[j * 8 + 3] * rs * g0.w * (1.f + c0.w) + h0.w;
        const float y4 = x[j * 8 + 4] * rs * g1.x * (1.f + c1.x) + h1.x, y5 = x[j * 8 + 5] * rs * g1.y * (1.f + c1.y) + h1.y, y6 = x[j * 8 + 6] * rs * g1.z * (1.f + c1.z) + h1.z, y7 = x[j * 8 + 7] * rs * g1.w * (1.f + c1.w) + h1.w;
        u32x4 o; o.x = pk_bf16(y0, y1); o.y = pk_bf16(y2, y3); o.z = pk_bf16(y4, y5); o.w = pk_bf16(y6, y7);
        *(u32x4*)(dst + e) = o; }
}
__device__ __forceinline__ void phase_norm(const Ctx& F, const float* xlat, const float* xctx, const float* gw, const float* mod, int shift_i, int scale_i, bf16_t* dst, int nrows) {
    for (int row = F.bid * 8 + F.wave; row < nrows; row += F.G * 8) {
        const bool isctx = row >= NLAT; const float* xr = isctx ? xctx + (size_t)(row - NLAT) * 2048 : xlat + (size_t)row * 2048;
        const int v = isctx ? 4 : (row >> 12);
        float x[32];
#pragma unroll
        for (int j = 0; j < 4; ++j) { const int e = j * 512 + F.lane * 8; const float4 a = *(const float4*)(xr + e), b = *(const float4*)(xr + e + 4);
            x[j * 8 + 0] = a.x; x[j * 8 + 1] = a.y; x[j * 8 + 2] = a.z; x[j * 8 + 3] = a.w; x[j * 8 + 4] = b.x; x[j * 8 + 5] = b.y; x[j * 8 + 6] = b.z; x[j * 8 + 7] = b.w; }
        norm_store(x, gw, mod + (size_t)v * 12288 + shift_i * 2048, mod + (size_t)v * 12288 + scale_i * 2048, dst + (size_t)row * 2048, F.lane);
    }
}

struct LayerW {
    const float *sc_w, *rw_w0, *rw_wup, *rw_a0, *rw_aup, *rw_gup, *rw_kk, *rw_ka, *rw_rk, *rw_lnw, *rw_lnb, *na_q, *na_k, *rpb, *s_cw, *s_cb, *s_dtb, *s_alog, *s_d, *s_norm;
};
__device__ __forceinline__ void unpack8(const u32x4 q, float (&f)[8]) { f[0] = bflo(q[0]); f[1] = bfhi(q[0]); f[2] = bflo(q[1]); f[3] = bfhi(q[1]); f[4] = bflo(q[2]); f[5] = bfhi(q[2]); f[6] = bflo(q[3]); f[7] = bfhi(q[3]); }
__device__ __forceinline__ u32x4 pack8f(const float (&f)[8]) { u32x4 o; o[0] = pk_bf16(f[0], f[1]); o[1] = pk_bf16(f[2], f[3]); o[2] = pk_bf16(f[4], f[5]); o[3] = pk_bf16(f[6], f[7]); return o; }
__device__ __forceinline__ void load8f(const float* p, float (&f)[8]) { const float4 a = *(const float4*)p, b = *(const float4*)(p + 4); f[0] = a.x; f[1] = a.y; f[2] = a.z; f[3] = a.w; f[4] = b.x; f[5] = b.y; f[6] = b.z; f[7] = b.w; }
__device__ __forceinline__ void phase_prep(const Ctx& F, const LayerW& W, unsigned char* ws) {
    const bf16_t* P = (const bf16_t*)(ws + WS_P);
    bf16_t* MIX = (bf16_t*)(ws + WS_MIX);
    bf16_t* XBC = (bf16_t*)(ws + WS_XBC); float* DTS = (float*)(ws + WS_DTS); float* DEC = (float*)(ws + WS_DEC);
    bf16_t* QN = (bf16_t*)(ws + WS_QN); bf16_t* KN = (bf16_t*)(ws + WS_KN); bf16_t* VTL = (bf16_t*)(ws + WS_VTL); bf16_t* VTC = (bf16_t*)(ws + WS_VTC);
    const float* ROPE = (const float*)(ws + WS_ROPE);
    for (int tile = F.bid; tile < NTOK / 8; tile += F.G) {
        int ln = F.lane; asm volatile("" : "+v"(ln));
        const int ch0 = ln * 8;
        const bool lat = tile < NLAT / 8;
        const int b = lat ? (tile >> 9) : ((tile - NLAT / 8) >> 5);
        const int t0 = lat ? (tile & 511) * 8 : ((tile - NLAT / 8) & 31) * 8;
        const int L = lat ? SEQL : CTXL;
        const int g0 = lat ? b * SEQL + t0 : NLAT + b * CTXL + t0;
        const bf16_t* Pr = P + (size_t)g0 * PTP;
        if (F.wave == 0 || F.wave == 4) {
            const bool gated = F.wave == 0;
            const float* cw = gated ? W.sc_w : W.s_cw; const int cstride = gated ? 512 : 1024;
            float w0[8], w1[8], w2[8], cb[8];
            load8f(cw + ch0, w0); load8f(cw + cstride + ch0, w1); load8f(cw + 2 * cstride + ch0, w2);
            if (gated) {
#pragma unroll
                for (int e = 0; e < 8; ++e) cb[e] = 0.f;
            } else load8f(W.s_cb + ch0, cb);
            const int col = gated ? A_CG : D_X;
#pragma unroll 1
            for (int tb = 0; tb < 8; tb += 4) {
            u32x4 ra[6], rb[6], rg[4];
#pragma unroll
            for (int q = 0; q < 6; ++q) { const int tq = t0 + tb - 1 + q; const bool ok = (tq >= 0) && (tq < L);
                ra[q] = ok ? *(const u32x4*)(Pr + (ptrdiff_t)(tb + q - 1) * PTP + col + ch0) : (u32x4){0u, 0u, 0u, 0u};
                if (gated) rb[q] = ok ? *(const u32x4*)(Pr + (ptrdiff_t)(tb + q - 1) * PTP + A_H + ch0) : (u32x4){0u, 0u, 0u, 0u}; }
            if (gated) {
#pragma unroll
                for (int tt = 0; tt < 4; ++tt) rg[tt] = *(const u32x4*)(Pr + (size_t)(tb + tt) * PTP + A_BG + ch0); }
            float up[8], uc[8], un[8];
            { float x[8], y[8]; unpack8(ra[0], x); if (gated) { unpack8(rb[0], y);
#pragma unroll
                for (int e = 0; e < 8; ++e) x[e] *= y[e]; }
#pragma unroll
              for (int e = 0; e < 8; ++e) up[e] = x[e];
              unpack8(ra[1], x); if (gated) { unpack8(rb[1], y);
#pragma unroll
                for (int e = 0; e < 8; ++e) x[e] *= y[e]; }
#pragma unroll
              for (int e = 0; e < 8; ++e) uc[e] = x[e]; }
#pragma unroll
            for (int tt = 0; tt < 4; ++tt) {
                { float x[8], y[8]; unpack8(ra[tt + 2], x); if (gated) { unpack8(rb[tt + 2], y);
#pragma unroll
                    for (int e = 0; e < 8; ++e) x[e] *= y[e]; }
#pragma unroll
                  for (int e = 0; e < 8; ++e) un[e] = x[e]; }
                float o[8];
                if (gated) { float bg[8]; unpack8(rg[tt], bg);
#pragma unroll
                    for (int e = 0; e < 8; ++e) o[e] = bg[e] * (w0[e] * up[e] + w1[e] * uc[e] + w2[e] * un[e]);
                    *(u32x4*)(MIX + (size_t)(g0 + tb + tt) * 2048 + ch0) = pack8f(o);
                } else {
#pragma unroll
                    for (int e = 0; e < 8; ++e) o[e] = siluf_(w0[e] * up[e] + w1[e] * uc[e] + w2[e] * un[e] + cb[e]);
                    *(u32x4*)(XBC + (size_t)(g0 + tb + tt) * 1024 + ch0) = pack8f(o); }
#pragma unroll
                for (int e = 0; e < 8; ++e) { up[e] = uc[e]; uc[e] = un[e]; }
            }
            }
        } else if (F.wave == 1 || F.wave == 2) {
            const bool isq = F.wave == 1; const int col = isq ? C_Q : C_K; bf16_t* dst = isq ? QN : KN;
            float nw[8]; load8f((isq ? W.na_q : W.na_k) + (ln & 7) * 8, nw);
            const float sc = isq ? 0.125f : 1.0f;
            u32x4 rq[8];
#pragma unroll
            for (int tt = 0; tt < 8; ++tt) rq[tt] = *(const u32x4*)(Pr + (size_t)tt * PTP + col + ch0);
#pragma unroll
            for (int tt = 0; tt < 8; ++tt) { float x[8]; unpack8(rq[tt], x); float ss = 0.f;
#pragma unroll
                for (int e = 0; e < 8; ++e) ss += x[e] * x[e];
                ss = sum8(ss); const float rs = rsqrtf(ss * (1.f / 64.f) + 1e-6f) * sc;
#pragma unroll
                for (int e = 0; e < 8; ++e) x[e] = x[e] * rs * nw[e];
                if (isq) *(u32x4*)(dst + (size_t)(g0 + tt) * 512 + ch0) = pack8f(x);
                else {
                    const int hh = ln >> 3, p = ln & 7, t = t0 + tt;
                    bf16_t* kd = lat ? dst + ((size_t)((((b * 8 + hh) * 64 + (t >> 6)) * 2 + (p >> 2)) * 4 + (p & 3)) * 64 + (t & 63)) * 8
                                     : dst + (size_t)NLAT * 512 + ((size_t)(((b * 8 + hh) * 2 + (p >> 2)) * 4 + (p & 3)) * 256 + t) * 8;
                    *(u32x4*)kd = pack8f(x); } }
        } else if (F.wave == 3) {
            u32x4 rv[8];
#pragma unroll
            for (int tt = 0; tt < 8; ++tt) rv[tt] = *(const u32x4*)(Pr + (size_t)tt * PTP + C_V + ch0);
            const int h = ln >> 3;
#pragma unroll
            for (int e = 0; e < 8; ++e) { const int i = (ln & 7) * 8 + e;
                unsigned short v[8];
#pragma unroll
                for (int tt = 0; tt < 8; ++tt) v[tt] = (unsigned short)((e & 1) ? (rv[tt][e >> 1] >> 16) : (rv[tt][e >> 1] & 0xffffu));
                u32x2 c0; c0.x = (unsigned)v[0] | ((unsigned)v[1] << 16); c0.y = (unsigned)v[2] | ((unsigned)v[3] << 16);
                u32x2 c1; c1.x = (unsigned)v[4] | ((unsigned)v[5] << 16); c1.y = (unsigned)v[6] | ((unsigned)v[7] << 16);
                if (lat) { const int row = t0 >> 6, x0 = (t0 & 63) >> 2, x1 = x0 + 1;
                    bf16_t* base = VTL + ((size_t)((b * 8 + h) * 64 + row) * 12 * 64 + i) * 8;
                    if (x0 <= 11) *(u32x2*)(base + x0 * 512) = c0;
                    if (x0 >= 4)  *(u32x2*)(base + (x0 - 4) * 512 + 4) = c0;
                    if (x1 <= 11) *(u32x2*)(base + x1 * 512) = c1;
                    if (x1 >= 4)  *(u32x2*)(base + (x1 - 4) * 512 + 4) = c1;
                } else { const int m = t0 >> 5, o = t0 & 31, gq = (o & 15) >> 2, hf = (o >> 4) * 4;
                    bf16_t* base = VTC + ((size_t)(((b * 8 + h) * 8 + m) * 4) * 64 + i) * 8;
                    *(u32x2*)(base + gq * 512 + hf) = c0; *(u32x2*)(base + (gq + 1) * 512 + hf) = c1; } }
        } else if (F.wave == 5 || F.wave == 7) {
            {
                const int pg = ln & 15, tb = (ln >> 4) * 2, which = F.wave == 7 ? 1 : 0, gi = (pg >> 3) & 1, half = (pg >> 2) & 1, i0 = (pg & 3) * 8;
                const int c1 = 512 + which * 256 + gi * 128 + half * 64 + i0, c2 = c1 + 32;
                float wa0[8], wa1[8], wa2[8], ba[8], wb0[8], wb1[8], wb2[8], bb[8];
                load8f(W.s_cw + c1, wa0); load8f(W.s_cw + 1024 + c1, wa1); load8f(W.s_cw + 2048 + c1, wa2); load8f(W.s_cb + c1, ba);
                load8f(W.s_cw + c2, wb0); load8f(W.s_cw + 1024 + c2, wb1); load8f(W.s_cw + 2048 + c2, wb2); load8f(W.s_cb + c2, bb);
                u32x4 ra[4], rb[4];
#pragma unroll
                for (int q = 0; q < 4; ++q) { const int tq = t0 + tb - 1 + q; const bool ok = (tq >= 0) && (tq < L);
                    ra[q] = ok ? *(const u32x4*)(Pr + (ptrdiff_t)(tb + q - 1) * PTP + D_X + c1) : (u32x4){0u, 0u, 0u, 0u};
                    rb[q] = ok ? *(const u32x4*)(Pr + (ptrdiff_t)(tb + q - 1) * PTP + D_X + c2) : (u32x4){0u, 0u, 0u, 0u}; }
                float ap[8], ac[8], an[8], bp[8], bc[8], bn[8];
                unpack8(ra[0], ap); unpack8(ra[1], ac); unpack8(rb[0], bp); unpack8(rb[1], bc);
#pragma unroll
                for (int tt = 0; tt < 2; ++tt) { unpack8(ra[tt + 2], an); unpack8(rb[tt + 2], bn);
                    float y1[8], y2[8];
#pragma unroll
                    for (int e = 0; e < 8; ++e) { y1[e] = siluf_(wa0[e] * ap[e] + wa1[e] * ac[e] + wa2[e] * an[e] + ba[e]); y2[e] = siluf_(wb0[e] * bp[e] + wb1[e] * bc[e] + wb2[e] * bn[e] + bb[e]); }
                    if (lat) { const int t = t0 + tb + tt, pos = half ? (t & 63) : (t >> 6);
                        float cs[16];
#pragma unroll
                        for (int q = 0; q < 4; ++q) { const float4 v = *(const float4*)(ROPE + (size_t)(pos * 32 + i0) * 2 + 4 * q); cs[4 * q] = v.x; cs[4 * q + 1] = v.y; cs[4 * q + 2] = v.z; cs[4 * q + 3] = v.w; }
#pragma unroll
                        for (int e = 0; e < 8; ++e) { const float o1 = y1[e] * cs[2 * e] - y2[e] * cs[2 * e + 1], o2 = y1[e] * cs[2 * e + 1] + y2[e] * cs[2 * e]; y1[e] = o1; y2[e] = o2; } }
                    *(u32x4*)(XBC + (size_t)(g0 + tb + tt) * 1024 + c1) = pack8f(y1); *(u32x4*)(XBC + (size_t)(g0 + tb + tt) * 1024 + c2) = pack8f(y2);
#pragma unroll
                    for (int e = 0; e < 8; ++e) { ap[e] = ac[e]; ac[e] = an[e]; bp[e] = bc[e]; bc[e] = bn[e]; }
                }
            }
        } else if (F.wave == 6) {
#pragma unroll
            for (int q = 0; q < 2; ++q) { const int it = ln + 64 * q, tt = it >> 4, j = it & 15;
                const float x = bf2f(Pr[(size_t)tt * PTP + D_DT + j]) + W.s_dtb[j];
                const float sp = fmaxf(x, 0.f) + log1pf(__expf(-fabsf(x)));
                DTS[(size_t)(g0 + tt) * 16 + j] = sp; DEC[(size_t)(g0 + tt) * 16 + j] = -sp * __expf(W.s_alog[j]); }
        }
    }
}

constexpr int SB_PITCH = 136;
__device__ __forceinline__ void ssd_scan_L(const Ctx& F, LAS float* sL, const float* LA, int g0, int h) {
    const int d = (F.tid >> 7) & 1, t = F.tid & 127;
    float v = 0.f;
    if (F.tid < 256) { v = LA[(size_t)(g0 + t) * 16 + d * 8 + h]; sL[F.tid] = v; }
    __syncthreads();
#pragma unroll
    for (int off = 1; off < 128; off <<= 1) {
        float o = 0.f;
        if (F.tid < 256) { const int tp = d ? t + off : t - off; if (tp >= 0 && tp < 128) o = sL[d * 128 + tp]; }
        __syncthreads();
        if (F.tid < 256) { v += o; sL[F.tid] = v; }
        __syncthreads();
    }
}
template <bool PASS2>
__device__ __forceinline__ void ssd_task(const Ctx& F, const LayerW& W, unsigned char* ws, int task) {
    const bf16_t* XBC = (const bf16_t*)(ws + WS_XBC); const float* DTS = (const float*)(ws + WS_DTS); const float* LA = (const float*)(ws + WS_DEC);
    float* SST = (float*)(ws + WS_SST); float* SCD = (float*)(ws + WS_SCD); float* YS = (float*)(ws + WS_YS);
    const int c = task % NCH, bh = task / NCH, h = bh & 7, b = bh >> 3, gi = h >> 2;
    const int g0 = c < 2 ? NLAT + b * CTXL + c * 128 : b * SEQL + (c - 2) * 128;
    const int w = F.wave, l16 = F.lane & 15, g = F.lane >> 4;
    const f32x4 z4 = {0.f, 0.f, 0.f, 0.f};
    LAS float* sL = (LAS float*)(F.lds + 131072);
    LAS float* sDT = sL + 256;
    __syncthreads();
    if (F.tid < 256) { const int s = F.tid >> 1, d = F.tid & 1; sDT[F.tid] = DTS[(size_t)(g0 + s) * 16 + d * 8 + h]; }
    ssd_scan_L(F, sL, LA, g0, h);
    if (!PASS2) {
        LAS bf16_t* sBT = (LAS bf16_t*)F.lds;
        LAS bf16_t* sXT = sBT + 128 * SB_PITCH;
#pragma unroll
        for (int q = 0; q < 4; ++q) { const int v = F.tid + 512 * q, s = v >> 4, part = v & 15;
            const u32x4 bv = *(const u32x4*)(XBC + (size_t)(g0 + s) * 1024 + 512 + gi * 128 + part * 8);
#pragma unroll
            for (int e = 0; e < 4; ++e) { sBT[(part * 8 + 2 * e) * SB_PITCH + s] = (bf16_t)(bv[e] & 0xffffu); sBT[(part * 8 + 2 * e + 1) * SB_PITCH + s] = (bf16_t)(bv[e] >> 16); } }
#pragma unroll
        for (int q = 0; q < 2; ++q) { const int v = F.tid + 512 * q, s = v >> 3, part = v & 7;
            const u32x4 xv = *(const u32x4*)(XBC + (size_t)(g0 + s) * 1024 + h * 64 + part * 8);
            const float sc0 = sDT[s * 2] * __expf(sL[127] - sL[s]), sc1 = sDT[s * 2 + 1] * __expf(sL[128] - sL[128 + s]);
#pragma unroll
            for (int e = 0; e < 4; ++e) { const float lo = bflo(xv[e]), hi = bfhi(xv[e]); const int p = part * 8 + 2 * e;
                sXT[p * SB_PITCH + s] = f2bf(lo * sc0); sXT[(p + 1) * SB_PITCH + s] = f2bf(hi * sc0);
                sXT[(64 + p) * SB_PITCH + s] = f2bf(lo * sc1); sXT[(64 + p + 1) * SB_PITCH + s] = f2bf(hi * sc1); } }
        __syncthreads();
        bf16x8 bfr[4];
#pragma unroll
        for (int ks = 0; ks < 4; ++ks) bfr[ks] = *(const LAS bf16x8*)(sBT + (16 * w + l16) * SB_PITCH + 32 * ks + 8 * g);
#pragma unroll
        for (int d = 0; d < 2; ++d) {
            float* st = SST + ((size_t)((b * 8 + h) * 2 + d) * NCH + c) * 8192;
#pragma unroll
            for (int pt = 0; pt < 4; ++pt) { f32x4 acc = z4;
#pragma unroll
                for (int ks = 0; ks < 4; ++ks) acc = __builtin_amdgcn_mfma_f32_16x16x32_bf16(*(const LAS bf16x8*)(sXT + (d * 64 + 16 * pt + l16) * SB_PITCH + 32 * ks + 8 * g), bfr[ks], acc, 0, 0, 0);
#pragma unroll
                for (int r = 0; r < 4; ++r) st[(16 * pt + 4 * g + r) * 128 + 16 * w + l16] = acc[r]; }
            if (F.tid == 0) SCD[((b * 8 + h) * 2 + d) * NCH + c] = __expf(d ? sL[128] : sL[127]);
        }
    } else {
        LAS bf16_t* sB = (LAS bf16_t*)F.lds;
        LAS bf16_t* sC = sB + 128 * SB_PITCH;
        LAS bf16_t* sXT = sC + 128 * SB_PITCH;
        LAS bf16_t* sS = sXT + 64 * SB_PITCH;
#pragma unroll
        for (int q = 0; q < 4; ++q) { const int v = F.tid + 512 * q, s = v >> 4, part = v & 15;
            *(LAS u32x4*)(sB + s * SB_PITCH + part * 8) = *(const u32x4*)(XBC + (size_t)(g0 + s) * 1024 + 512 + gi * 128 + part * 8);
            *(LAS u32x4*)(sC + s * SB_PITCH + part * 8) = *(const u32x4*)(XBC + (size_t)(g0 + s) * 1024 + 768 + gi * 128 + part * 8); }
#pragma unroll
        for (int q = 0; q < 2; ++q) { const int v = F.tid + 512 * q, s = v >> 3, part = v & 7;
            const u32x4 xv = *(const u32x4*)(XBC + (size_t)(g0 + s) * 1024 + h * 64 + part * 8);
#pragma unroll
            for (int e = 0; e < 4; ++e) { sXT[(part * 8 + 2 * e) * SB_PITCH + s] = (bf16_t)(xv[e] & 0xffffu); sXT[(part * 8 + 2 * e + 1) * SB_PITCH + s] = (bf16_t)(xv[e] >> 16); } }
#pragma unroll
        for (int q = 0; q < 4; ++q) { const int v = F.tid + 512 * q, d = v >> 10, p = (v >> 4) & 63, part = v & 15;
            const float* sp = SST + ((size_t)((b * 8 + h) * 2 + d) * NCH + c) * 8192 + p * 128 + part * 8;
            const float4 a0 = *(const float4*)sp, a1 = *(const float4*)(sp + 4);
            u32x4 o; o.x = pk_bf16(a0.x, a0.y); o.y = pk_bf16(a0.z, a0.w); o.z = pk_bf16(a1.x, a1.y); o.w = pk_bf16(a1.z, a1.w);
            *(LAS u32x4*)(sS + (d * 64 + p) * SB_PITCH + part * 8) = o; }
        __syncthreads();
        const int t = 16 * w + l16;
        bf16x8 cfr[4];
#pragma unroll
        for (int ks = 0; ks < 4; ++ks) cfr[ks] = *(const LAS bf16x8*)(sC + t * SB_PITCH + 32 * ks + 8 * g);
        f32x4 gt[8];
#pragma unroll
        for (int a = 0; a < 8; ++a) { f32x4 acc = z4;
#pragma unroll
            for (int ks = 0; ks < 4; ++ks) acc = __builtin_amdgcn_mfma_f32_16x16x32_bf16(*(const LAS bf16x8*)(sB + (16 * a + l16) * SB_PITCH + 32 * ks + 8 * g), cfr[ks], acc, 0, 0, 0);
            gt[a] = acc; }
        f32x4 ysum[4] = {z4, z4, z4, z4};
#pragma unroll
        for (int d = 0; d < 2; ++d) {
            const float Lt = sL[d * 128 + t], eLt = __expf(Lt);
            f32x4 acc[4];
#pragma unroll
            for (int pt = 0; pt < 4; ++pt) { f32x4 a = z4;
#pragma unroll
                for (int ks = 0; ks < 4; ++ks) a = __builtin_amdgcn_mfma_f32_16x16x32_bf16(*(const LAS bf16x8*)(sS + (d * 64 + 16 * pt + l16) * SB_PITCH + 32 * ks + 8 * g), cfr[ks], a, 0, 0, 0);
                acc[pt] = a * eLt; }
#pragma unroll
            for (int m = 0; m < 4; ++m) {
                const bool need = d ? (2 * m + 1 >= w) : (2 * m <= w);
                if (need) {
                    f32x4 wt[2];
#pragma unroll
                    for (int u = 0; u < 2; ++u) { const int a = 2 * m + u;
                        const f32x4 Ls = *(const LAS f32x4*)(sL + d * 128 + 16 * a + 4 * g);
#pragma unroll
                        for (int r = 0; r < 4; ++r) { const int s = 16 * a + 4 * g + r; const bool ok = d ? (s >= t) : (s <= t);
                            const float dts = sDT[s * 2 + d];
                            wt[u][r] = ok ? gt[a][r] * __expf(Lt - Ls[r]) * dts : 0.f; } }
                    const bf16x8 bfrag = pack8(wt[0], wt[1]);
#pragma unroll
                    for (int pt = 0; pt < 4; ++pt) { union { bf16x8 v; u32x2 hh[2]; } af;
                        af.hh[0] = *(const LAS u32x2*)(sXT + (16 * pt + l16) * SB_PITCH + 32 * m + 4 * g); af.hh[1] = *(const LAS u32x2*)(sXT + (16 * pt + l16) * SB_PITCH + 32 * m + 16 + 4 * g);
                        acc[pt] = __builtin_amdgcn_mfma_f32_16x16x32_bf16(af.v, bfrag, acc[pt], 0, 0, 0); }
                }
            }
#pragma unroll
            for (int pt = 0; pt < 4; ++pt) ysum[pt] = ysum[pt] + acc[pt];
        }
        const float dsk = W.s_d[h];
#pragma unroll
        for (int pt = 0; pt < 4; ++pt) { const int p = 16 * pt + 4 * g;
            const u32x2 xv = *(const u32x2*)(XBC + (size_t)(g0 + t) * 1024 + h * 64 + p);
            *(float4*)(YS + (size_t)(g0 + t) * 512 + h * 64 + p) = make_float4(ysum[pt][0] + dsk * bflo(xv.x), ysum[pt][1] + dsk * bfhi(xv.x), ysum[pt][2] + dsk * bflo(xv.y), ysum[pt][3] + dsk * bfhi(xv.y)); }
    }
}
template <int D> __device__ __forceinline__ void ssd_combine_one(float4* base, const float* scd) {
    float4 carry = make_float4(0.f, 0.f, 0.f, 0.f);
#pragma unroll
    for (int k0 = 0; k0 < NCH; k0 += 17) {
        float4 tmp[17];
#pragma unroll
        for (int k = 0; k < 17; ++k) { const int kk = k0 + k, c = D ? (kk < 2 ? 1 - kk : 35 - kk) : kk; tmp[k] = base[(size_t)c * 2048]; }
#pragma unroll
        for (int k = 0; k < 17; ++k) { const int kk = k0 + k, c = D ? (kk < 2 ? 1 - kk : 35 - kk) : kk; const float a = scd[c];
            base[(size_t)c * 2048] = carry;
            carry.x = a * carry.x + tmp[k].x; carry.y = a * carry.y + tmp[k].y; carry.z = a * carry.z + tmp[k].z; carry.w = a * carry.w + tmp[k].w; }
    }
}
__device__ __forceinline__ void phase_ssd_combine(const Ctx& F, unsigned char* ws) {
    float4* SST4 = (float4*)(ws + WS_SST); const float* SCD = (const float*)(ws + WS_SCD);
    for (int gt = F.bid * 512 + F.tid; gt < 64 * 2048; gt += F.G * 512) {
        const int sidx = gt >> 11, e4 = gt & 2047;
        float4* base = SST4 + (size_t)sidx * NCH * 2048 + e4;
        if (sidx & 1) ssd_combine_one<1>(base, SCD + sidx * NCH); else ssd_combine_one<0>(base, SCD + sidx * NCH);
    }
}

constexpr int RWF_CHUNK = 10496;
constexpr int RW_NCHUNK = NPOS / 16;
template <int CTRL> __device__ __forceinline__ float dpp_id1(float v) { return __int_as_float(__builtin_amdgcn_update_dpp(0x3f800000, __float_as_int(v), CTRL, 0xF, 0xF, false)); }
__device__ __forceinline__ float sel4(int g, float a, float b, float c, float d) { return g == 0 ? a : (g == 1 ? b : (g == 2 ? c : d)); }

template <int D> __device__ __forceinline__ void rwkv_pre_dir(const bf16_t* wupt, const bf16x8 (&bw)[2], const bf16x8 (&ba)[2], const f32x4 (&kk)[4], const f32x4 (&rr)[4], const f32x4 (&kx)[4],
        const float* w0p, const float* a0p, const float* kap, const float* rkp, float& bon, LAS unsigned char* wl, unsigned char* dst, int l16, int g) {
    LAS float* LT = (LAS float*)wl; LAS float* AT = LT + 256; LAS bf16_t* BT = (LAS bf16_t*)(wl + 2048); LAS bf16_t* KT = BT + 1024;
    const int lane = g * 16 + l16;
    bf16x8* o = (bf16x8*)dst;
    const f32x4 z4 = {0.f, 0.f, 0.f, 0.f};
    bf16x8 af[2], bf[2], kf[2], rf[2];
#pragma unroll
    for (int p = 0; p < 2; ++p) {
        f32x4 al[2], be[2], ka[2], rh[2];
#pragma unroll
        for (int mm = 0; mm < 2; ++mm) { const int m = 2 * p + mm; asm volatile("" ::: "memory");
            const bf16_t* wpw = wupt + ((size_t)D * 512 + 16 * m + l16) * 64 + 8 * g; const bf16_t* wpa = wupt + ((size_t)(2 + D) * 512 + 16 * m + l16) * 64 + 8 * g;
            f32x4 aw = __builtin_amdgcn_mfma_f32_16x16x32_bf16(*(const bf16x8*)wpw, bw[0], z4, 0, 0, 0); aw = __builtin_amdgcn_mfma_f32_16x16x32_bf16(*(const bf16x8*)(wpw + 32), bw[1], aw, 0, 0, 0);
            f32x4 aa = __builtin_amdgcn_mfma_f32_16x16x32_bf16(*(const bf16x8*)wpa, ba[0], z4, 0, 0, 0); aa = __builtin_amdgcn_mfma_f32_16x16x32_bf16(*(const bf16x8*)(wpa + 32), ba[1], aa, 0, 0, 0);
            const float4 w0 = *(const float4*)(w0p + 16 * m + 4 * g), a0 = *(const float4*)(a0p + 16 * m + 4 * g), kav = *(const float4*)(kap + 16 * m + 4 * g), rkv = *(const float4*)(rkp + 16 * m + 4 * g);
            const float w0a[4] = {w0.x, w0.y, w0.z, w0.w}, a0a[4] = {a0.x, a0.y, a0.z, a0.w}, kaa[4] = {kav.x, kav.y, kav.z, kav.w}, rka[4] = {rkv.x, rkv.y, rkv.z, rkv.w};
            f32x4 gcv;
#pragma unroll
            for (int r = 0; r < 4; ++r) {
                const float w = __expf(-0.6065306597126334f * sigmoidf_(w0a[r] + aw[r])), a = sigmoidf_(a0a[r] + aa[r]);
                const float kd = kx[m][r] * (1.f + (a - 1.f) * kaa[r]), bb = kk[m][r] * a;
                bon += rr[m][r] * kd * rka[r];
                float G = w;
                if (D == 0) { G *= dpp_id1<0x111>(G); G *= dpp_id1<0x112>(G); G *= dpp_id1<0x114>(G); G *= dpp_id1<0x118>(G); }
                else        { G *= dpp_id1<0x101>(G); G *= dpp_id1<0x102>(G); G *= dpp_id1<0x104>(G); G *= dpp_id1<0x108>(G); }
                const float Gex = (D == 0) ? dpp_id1<0x111>(G) : dpp_id1<0x101>(G);
                const float iG = rcpf_(G);
                al[mm][r] = Gex * kk[m][r]; be[mm][r] = bb * iG; ka[mm][r] = kd * iG; rh[mm][r] = G * rr[m][r]; gcv[r] = G;
                const int k = 16 * m + 4 * g + r; BT[k * 16 + l16] = f2bf(be[mm][r]); KT[k * 16 + l16] = f2bf(ka[mm][r]);
            }
            if (l16 == ((D == 0) ? 15 : 0)) *(float4*)((float*)(dst + 10240) + 16 * m + 4 * g) = make_float4(gcv[0], gcv[1], gcv[2], gcv[3]);
        }
        af[p] = pack8(al[0], al[1]); bf[p] = pack8(be[0], be[1]); kf[p] = pack8(ka[0], ka[1]); rf[p] = pack8(rh[0], rh[1]);
        o[64 * p + lane] = af[p]; o[128 + 64 * p + lane] = rf[p];
        __builtin_amdgcn_sched_barrier(0);
    }
    f32x4 Lm = __builtin_amdgcn_mfma_f32_16x16x32_bf16(af[0], bf[0], z4, 0, 0, 0); Lm = __builtin_amdgcn_mfma_f32_16x16x32_bf16(af[1], bf[1], Lm, 0, 0, 0);
    f32x4 Am = __builtin_amdgcn_mfma_f32_16x16x32_bf16(af[0], kf[0], z4, 0, 0, 0); Am = __builtin_amdgcn_mfma_f32_16x16x32_bf16(af[1], kf[1], Am, 0, 0, 0);
    f32x4 Bb = __builtin_amdgcn_mfma_f32_16x16x32_bf16(bf[0], rf[0], z4, 0, 0, 0); Bb = __builtin_amdgcn_mfma_f32_16x16x32_bf16(bf[1], rf[1], Bb, 0, 0, 0);
    f32x4 Bk = __builtin_amdgcn_mfma_f32_16x16x32_bf16(kf[0], rf[0], z4, 0, 0, 0); Bk = __builtin_amdgcn_mfma_f32_16x16x32_bf16(kf[1], rf[1], Bk, 0, 0, 0);
#pragma unroll
    for (int r = 0; r < 4; ++r) { const int row = 4 * g + r;
        const bool strict = (D == 0) ? (l16 < row) : (l16 > row);
        const bool incl = (D == 0) ? (row <= l16) : (row >= l16);
        Lm[r] = strict ? Lm[r] : 0.f; Am[r] = strict ? Am[r] : 0.f; Bb[r] = incl ? Bb[r] : 0.f; Bk[r] = incl ? Bk[r] : 0.f; }
    *(LAS f32x4*)(LT + l16 * 16 + 4 * g) = Lm; *(LAS f32x4*)(AT + l16 * 16 + 4 * g) = Am;
    o[320 + lane] = pack8(Bb, Bk);
    asm volatile("" ::: "memory");
#pragma unroll
    for (int m = 0; m < 4; ++m) { union { bf16x8 v; u32x2 h[2]; } f;
        f.h[0] = *(LAS u32x2*)(BT + (16 * m + l16) * 16 + 4 * g); f.h[1] = *(LAS u32x2*)(KT + (16 * m + l16) * 16 + 4 * g);
        o[384 + 64 * m + lane] = f.v; }
    __builtin_amdgcn_sched_barrier(0);
    float x[16];
    if (D == 0) {
#pragma unroll
        for (int c = 15; c >= 0; --c) { float s = (c == l16) ? 1.f : 0.f; asm volatile("" ::: "memory");
#pragma unroll
            for (int i = c + 1; i < 16; ++i) s -= x[i] * LT[c * 16 + i];
            x[c] = s; }
    } else {
#pragma unroll
        for (int c = 0; c < 16; ++c) { float s = (c == l16) ? 1.f : 0.f; asm volatile("" ::: "memory");
#pragma unroll
            for (int i = 0; i < c; ++i) s -= x[i] * LT[c * 16 + i];
            x[c] = s; }
    }
    f32x4 tm0, tm1;
#pragma unroll
    for (int r = 0; r < 4; ++r) tm0[r] = -sel4(g, x[r], x[4 + r], x[8 + r], x[12 + r]);
#pragma unroll
    for (int r = 0; r < 4; ++r) { const int c = 4 * g + r; float s = 0.f; asm volatile("" ::: "memory");
#pragma unroll
        for (int i = 0; i < 16; ++i) { const bool use = (D == 0) ? (i > c) : (i < c); s += use ? x[i] * AT[c * 16 + i] : 0.f; }
        tm1[r] = -s; }
    o[256 + lane] = pack8(tm0, tm1);
    asm volatile("" ::: "memory");
}
__device__ __forceinline__ void rwkv_pre_task(const Ctx& F, const LayerW& W, unsigned char* ws, const bf16_t* WUPT, int task, int dsel) {
    const bf16_t* P = (const bf16_t*)(ws + WS_P); float* BON = (float*)(ws + WS_BON); unsigned char* RWF = ws + WS_RWF;
    const int cidx = task % RW_NCHUNK, bh = task / RW_NCHUNK, h = bh & 7, b = bh >> 3;
    int ln_ = F.lane; asm volatile("" : "+v"(ln_));
    const int l16 = ln_ & 15, g = ln_ >> 4;
    const int pos = cidx * 16 + l16;
    const int tok = pos < CTXL ? NLAT + b * CTXL + pos : b * SEQL + (pos - CTXL);
    const bf16_t* Pr = P + (size_t)tok * PTP;
    LAS unsigned char* wl = F.lds + F.wave * 8192;
    bf16x8 bw[2], ba[2];
#pragma unroll
    for (int p = 0; p < 2; ++p) { const u32x4 q = *(const u32x4*)(Pr + B_WD + 32 * p + 8 * g); union { bf16x8 v; unsigned u[4]; } tq;
#pragma unroll
        for (int e = 0; e < 4; ++e) tq.u[e] = pk_bf16(tanhf_(bflo(q[e])), tanhf_(bfhi(q[e])));
        bw[p] = tq.v; ba[p] = *(const bf16x8*)(Pr + B_AD + 32 * p + 8 * g); }
    f32x4 kk[4], rr[4], kx[4];
    float ssq = 0.f;
#pragma unroll
    for (int m = 0; m < 4; ++m) { const int co = h * 64 + 16 * m + 4 * g;
        const u32x2 rq = *(const u32x2*)(Pr + B_R + co), kq = *(const u32x2*)(Pr + B_K + co); const float4 kkw = *(const float4*)(W.rw_kk + co);
        rr[m] = (f32x4){bflo(rq.x), bfhi(rq.x), bflo(rq.y), bfhi(rq.y)}; kx[m] = (f32x4){bflo(kq.x), bfhi(kq.x), bflo(kq.y), bfhi(kq.y)};
        kk[m] = (f32x4){kx[m][0] * kkw.x, kx[m][1] * kkw.y, kx[m][2] * kkw.z, kx[m][3] * kkw.w};
        ssq += kk[m][0] * kk[m][0] + kk[m][1] * kk[m][1] + kk[m][2] * kk[m][2] + kk[m][3] * kk[m][3]; }
    ssq += xor16_f(ssq); ssq = sum_x32(ssq);
    { const float rn = rsqrtf(ssq + 1e-12f);
#pragma unroll
      for (int m = 0; m < 4; ++m) kk[m] = kk[m] * rn; }
    float bon = 0.f;
    const int co = h * 64;
    const int c0 = cidx, c1 = cidx < 16 ? 15 - cidx : 287 - cidx;
    if (dsel == 0) rwkv_pre_dir<0>(WUPT + (size_t)co * 64, bw, ba, kk, rr, kx, W.rw_w0 + co, W.rw_a0 + co, W.rw_ka + co, W.rw_rk + co, bon, wl, RWF + ((size_t)(bh * 2 + 0) * RW_NCHUNK + c0) * RWF_CHUNK, l16, g);
    else           rwkv_pre_dir<1>(WUPT + (size_t)co * 64, bw, ba, kk, rr, kx, W.rw_w0 + 512 + co, W.rw_a0 + 512 + co, W.rw_ka + co, W.rw_rk + co, bon, wl, RWF + ((size_t)(bh * 2 + 1) * RW_NCHUNK + c1) * RWF_CHUNK, l16, g);
    bon += xor16_f(bon); bon = sum_x32(bon);
    if (g == 0) BON[((size_t)dsel * NTOK + tok) * 8 + h] = bon;
}
struct RwFrag { bf16x8 a0, a1, r0, r1, tm, bb, bk0, bk1, bk2, bk3; f32x4 g0, g1, g2, g3; u32x2 v; };
__device__ __forceinline__ void rwkv_scan(const Ctx& F, unsigned char* ws, int sidx) {
    if (F.wave >= 4) return;
    const bf16_t* P = (const bf16_t*)(ws + WS_P); bf16_t* RWY = (bf16_t*)(ws + WS_RWY);
    const int d = sidx & 1, h = (sidx >> 1) & 7, b = sidx >> 4, n = F.wave, l16 = F.lane & 15, g = F.lane >> 4;
    const unsigned char* base = ws + WS_RWF + (size_t)sidx * RW_NCHUNK * RWF_CHUNK;
    const int vcol = B_V + h * 64 + 16 * n + l16;
#define RW_CIDX(c) (d ? ((c) < 16 ? 15 - (c) : 287 - (c)) : (c))
#define RW_TOK(cidx, i) (((cidx) * 16 + (i)) < CTXL ? NLAT + b * CTXL + (cidx) * 16 + (i) : b * SEQL + ((cidx) * 16 + (i) - CTXL))
#define RW_LOADF(fr, c) do { const bf16x8* q_ = (const bf16x8*)(base + (size_t)(c) * RWF_CHUNK) + F.lane; \
        fr.a0 = q_[0]; fr.a1 = q_[64]; fr.r0 = q_[128]; fr.r1 = q_[192]; fr.tm = q_[256]; fr.bb = q_[320]; fr.bk0 = q_[384]; fr.bk1 = q_[448]; fr.bk2 = q_[512]; fr.bk3 = q_[576]; \
        const f32x4* gp_ = (const f32x4*)(base + (size_t)(c) * RWF_CHUNK + 10240) + g; fr.g0 = gp_[0]; fr.g1 = gp_[4]; fr.g2 = gp_[8]; fr.g3 = gp_[12]; \
        const int ci_ = RW_CIDX(c); unsigned short v_[4]; _Pragma("unroll") for (int j_ = 0; j_ < 4; ++j_) v_[j_] = P[(size_t)RW_TOK(ci_, 4 * g + j_) * PTP + vcol]; \
        fr.v.x = (unsigned)v_[0] | ((unsigned)v_[1] << 16); fr.v.y = (unsigned)v_[2] | ((unsigned)v_[3] << 16); } while (0)
    f32x4 st0 = {0.f, 0.f, 0.f, 0.f}, st1 = st0, st2 = st0, st3 = st0;
    const f32x4 z4 = {0.f, 0.f, 0.f, 0.f};
#define RW_STEP(fr, c) do { \
        const bf16x8 s0_ = pack8(st0, st1), s1_ = pack8(st2, st3); \
        f32x4 x1_ = __builtin_amdgcn_mfma_f32_16x16x32_bf16(fr.a0, s0_, z4, 0, 0, 0); x1_ = __builtin_amdgcn_mfma_f32_16x16x32_bf16(fr.a1, s1_, x1_, 0, 0, 0); \
        f32x4 x2_ = __builtin_amdgcn_mfma_f32_16x16x32_bf16(fr.r0, s0_, z4, 0, 0, 0); x2_ = __builtin_amdgcn_mfma_f32_16x16x32_bf16(fr.r1, s1_, x2_, 0, 0, 0); \
        union { bf16x8 v; unsigned u[4]; } bx_; bx_.u[0] = pk_bf16(x1_[0], x1_[1]); bx_.u[1] = pk_bf16(x1_[2], x1_[3]); bx_.u[2] = fr.v.x; bx_.u[3] = fr.v.y; \
        const f32x4 e_ = __builtin_amdgcn_mfma_f32_16x16x32_bf16(fr.tm, bx_.v, z4, 0, 0, 0); \
        union { bf16x8 v; unsigned u[4]; } be_; be_.u[0] = pk_bf16(e_[0], e_[1]); be_.u[1] = pk_bf16(e_[2], e_[3]); be_.u[2] = fr.v.x; be_.u[3] = fr.v.y; \
        const f32x4 o_ = __builtin_amdgcn_mfma_f32_16x16x32_bf16(fr.bb, be_.v, x2_, 0, 0, 0); \
        st0 = __builtin_amdgcn_mfma_f32_16x16x32_bf16(fr.bk0, be_.v, st0, 0, 0, 0) * fr.g0; st1 = __builtin_amdgcn_mfma_f32_16x16x32_bf16(fr.bk1, be_.v, st1, 0, 0, 0) * fr.g1; \
        st2 = __builtin_amdgcn_mfma_f32_16x16x32_bf16(fr.bk2, be_.v, st2, 0, 0, 0) * fr.g2; st3 = __builtin_amdgcn_mfma_f32_16x16x32_bf16(fr.bk3, be_.v, st3, 0, 0, 0) * fr.g3; \
        const int ci_ = RW_CIDX(c); \
        _Pragma("unroll") for (int j_ = 0; j_ < 4; ++j_) RWY[((size_t)d * NTOK + RW_TOK(ci_, 4 * g + j_)) * 512 + h * 64 + 16 * n + l16] = f2bf(o_[j_]); } while (0)
    RwFrag fa, fb, fc;
#define RW_CL(c) ((c) < RW_NCHUNK ? (c) : RW_NCHUNK - 1)
    RW_LOADF(fa, 0); RW_LOADF(fb, 1);
    int c = 0;
    for (; c + 3 <= RW_NCHUNK; c += 3) {
        RW_LOADF(fc, RW_CL(c + 2)); RW_STEP(fa, c);
        RW_LOADF(fa, RW_CL(c + 3)); RW_STEP(fb, c + 1);
        RW_LOADF(fb, RW_CL(c + 4)); RW_STEP(fc, c + 2);
    }
    if (c < RW_NCHUNK) { RW_STEP(fa, c); if (c + 1 < RW_NCHUNK) RW_STEP(fb, c + 1); }
#undef RW_CL
#undef RW_CIDX
#undef RW_TOK
#undef RW_LOADF
#undef RW_STEP
}

__device__ __forceinline__ void na_tile(const Ctx& F, unsigned char* ws, const LAS float* sBias, int tile) {
    const bf16_t* QN = (const bf16_t*)(ws + WS_QN); const bf16_t* KN = (const bf16_t*)(ws + WS_KN);
    const bf16_t* VTL = (const bf16_t*)(ws + WS_VTL); const bf16_t* VTC = (const bf16_t*)(ws + WS_VTC); bf16_t* MIX = (bf16_t*)(ws + WS_MIX);
    const int h = F.wave, l16 = F.lane & 15, g = F.lane >> 4;
    const bool lat = tile < 1024;
    int b, r = 0, j = 0, gq;
    if (lat) { b = tile >> 8; r = (tile >> 2) & 63; j = tile & 3; gq = b * SEQL + r * 64 + j * 16 + l16; }
    else { const int tc = tile - 1024; b = tc >> 4; gq = NLAT + b * CTXL + (tc & 15) * 16 + l16; }
    const int row0 = min(max(r - 4, 0), 56), col0 = min(max(16 * j - 8, 0), 32);
    bf16x8 qf0, qf1;
    { const bf16_t* qp = QN + (size_t)gq * 512 + h * 64 + g * 8; qf0 = *(const bf16x8*)qp; qf1 = *(const bf16x8*)(qp + 32); }
    const f32x4 zero4 = {0.f, 0.f, 0.f, 0.f};
    const int cq = 16 * j + l16, win0 = min(max(cq - 8, 0), 48);
    const bf16_t* knb = KN + ((size_t)((((b * 8 + h) * 64 + row0) * 2) * 4 + g) * 64 + col0 + l16) * 8;
    const bf16_t* kcx = KN + (size_t)NLAT * 512 + ((size_t)(((b * 8 + h) * 2) * 4 + g) * 256 + l16) * 8;
    const bf16_t* vnb = VTL + ((size_t)(((b * 8 + h) * 64 + row0) * 12 + col0 / 4 + g) * 64 + l16) * 8;
    const bf16_t* vcx = VTC + ((size_t)(((b * 8 + h) * 8) * 4 + g) * 64 + l16) * 8;
    float mrun = -1e30f, lrun = 0.f;
    f32x4 o[4] = {zero4, zero4, zero4, zero4};
#pragma unroll
    for (int hf = 0; hf < 2; ++hf) {
        if (hf == 0 && !lat) continue;
        bf16x8 fr[32];
#pragma unroll
        for (int T = 0; T < 16; ++T) { const bf16_t* kp = hf == 0 ? knb + (size_t)((T >> 1) * 8) * 512 + (T & 1) * 128 : kcx + T * 128;
            fr[2 * T] = *(const bf16x8*)kp; fr[2 * T + 1] = *(const bf16x8*)(kp + (hf == 0 ? 4 * 512 : 4 * 2048)); }
        asm volatile("" ::: "memory");
        f32x4 acc[16];
#pragma unroll
        for (int T = 0; T < 16; ++T) { f32x4 a = __builtin_amdgcn_mfma_f32_16x16x32_bf16(fr[2 * T], qf0, zero4, 0, 0, 0); a = __builtin_amdgcn_mfma_f32_16x16x32_bf16(fr[2 * T + 1], qf1, a, 0, 0, 0);
            if (hf == 0) { const int ir = T >> 1, hh = T & 1, kr = row0 + ir; const LAS float* bias = sBias + (kr - r + 7) * 31;
#pragma unroll
                for (int e = 0; e < 4; ++e) { const int kc = col0 + 16 * hh + 4 * g + e; const bool ok = (kc >= win0) && (kc < win0 + 16);
                    const int dc = min(max(kc - cq + 15, 0), 30); a[e] = ok ? a[e] + bias[dc] : -1e30f; } }
            acc[T] = a; }
#pragma unroll
        for (int m = 0; m < 8; ++m)
#pragma unroll
            for (int dt = 0; dt < 4; ++dt) fr[4 * m + dt] = *(const bf16x8*)(hf == 0 ? vnb + (size_t)m * 12 * 512 + dt * 128 : vcx + (size_t)m * 4 * 512 + dt * 128);
        asm volatile("" ::: "memory");
        float mx = mrun;
#pragma unroll
        for (int T = 0; T < 16; ++T) mx = fmaxf(fmaxf(fmaxf(acc[T][0], acc[T][1]), fmaxf(acc[T][2], acc[T][3])), mx);
        mx = fmaxf(mx, xor16_f(mx)); mx = max_x32(mx);
        const float alpha = __expf(mrun - mx);
        float lsum = 0.f;
#pragma unroll
        for (int T = 0; T < 16; ++T) {
#pragma unroll
            for (int q = 0; q < 4; ++q) { const float pv = __expf(acc[T][q] - mx); acc[T][q] = pv; lsum += pv; } }
        lsum += xor16_f(lsum); lsum = sum_x32(lsum);
        lrun = lrun * alpha + lsum; mrun = mx;
#pragma unroll
        for (int dt = 0; dt < 4; ++dt) o[dt] = o[dt] * alpha;
#pragma unroll
        for (int m = 0; m < 8; ++m) { const bf16x8 pf = pack8(acc[2 * m], acc[2 * m + 1]);
#pragma unroll
            for (int dt = 0; dt < 4; ++dt) o[dt] = __builtin_amdgcn_mfma_f32_16x16x32_bf16(fr[4 * m + dt], pf, o[dt], 0, 0, 0); }
    }
    const float inv = 1.0f / lrun;
#pragma unroll
    for (int dt = 0; dt < 4; ++dt) { u32x2 w; w.x = pk_bf16(o[dt][0] * inv, o[dt][1] * inv); w.y = pk_bf16(o[dt][2] * inv, o[dt][3] * inv);
        *(u32x2*)(MIX + (size_t)gq * 2048 + 1024 + h * 64 + dt * 16 + 4 * g) = w; }
}
__device__ __forceinline__ void na_phase(const Ctx& F, const LayerW& W, unsigned char* ws, int blk, int nblk, int ntile) {
    LAS float* sBias = (LAS float*)(F.lds + F.wave * 2048);
    __syncthreads();
    for (int idx = F.lane; idx < 465; idx += 64) sBias[idx] = W.rpb[F.wave * 465 + idx];
    asm volatile("" ::: "memory");
    for (int tile = blk; tile < ntile; tile += nblk) na_tile(F, ws, sBias, tile);
}

__device__ __forceinline__ void phase_finish(const Ctx& F, const LayerW& W, unsigned char* ws, const bf16_t* GUPT, int ntok) {
    const bf16_t* P = (const bf16_t*)(ws + WS_P); bf16_t* MIX = (bf16_t*)(ws + WS_MIX);
    const bf16_t* RWY = (const bf16_t*)(ws + WS_RWY); const float* BON = (const float*)(ws + WS_BON); const float* YS = (const float*)(ws + WS_YS);
    const f32x4 z4 = {0.f, 0.f, 0.f, 0.f};
    for (int task = F.bid * 8 + F.wave; task < (ntok / 16) * 8; task += F.G * 8) {
        int ln = F.lane; asm volatile("" : "+v"(ln));
        const int l16 = ln & 15, g = ln >> 4, h = task & 7, tok = (task >> 3) * 16 + l16;
        const bf16_t* Pr = P + (size_t)tok * PTP;
        bf16x8 sg[4];
#pragma unroll
        for (int ks = 0; ks < 4; ++ks) { const u32x4 q = *(const u32x4*)(Pr + B_GD + 32 * ks + 8 * g); union { bf16x8 v; unsigned u[4]; } s;
#pragma unroll
            for (int e = 0; e < 4; ++e) s.u[e] = pk_bf16(sigmoidf_(bflo(q[e])), sigmoidf_(bfhi(q[e])));
            sg[ks] = s.v; }
        f32x4 y[4]; float s1 = 0.f;
#pragma unroll
        for (int m = 0; m < 4; ++m) { const int co = h * 64 + 16 * m + 4 * g;
            const u32x2 a = *(const u32x2*)(RWY + (size_t)tok * 512 + co), bq = *(const u32x2*)(RWY + ((size_t)NTOK + tok) * 512 + co);
            y[m] = (f32x4){bflo(a.x) + bflo(bq.x), bfhi(a.x) + bfhi(bq.x), bflo(a.y) + bflo(bq.y), bfhi(a.y) + bfhi(bq.y)};
            s1 += (y[m][0] + y[m][1]) + (y[m][2] + y[m][3]); }
        s1 += xor16_f(s1); s1 = sum_x32(s1);
        const float mu = s1 * (1.f / 64.f); float s2 = 0.f;
#pragma unroll
        for (int m = 0; m < 4; ++m) { y[m] = y[m] - mu; s2 += (y[m][0] * y[m][0] + y[m][1] * y[m][1]) + (y[m][2] * y[m][2] + y[m][3] * y[m][3]); }
        s2 += xor16_f(s2); s2 = sum_x32(s2);
        const float rs = rsqrtf(s2 * (1.f / 64.f) + 64e-5f);
        const float bon = BON[(size_t)tok * 8 + h] + BON[((size_t)NTOK + tok) * 8 + h];
#pragma unroll
        for (int m = 0; m < 4; ++m) { const int co = h * 64 + 16 * m + 4 * g;
            f32x4 ga = z4;
#pragma unroll
            for (int ks = 0; ks < 4; ++ks) ga = __builtin_amdgcn_mfma_f32_16x16x32_bf16(*(const bf16x8*)(GUPT + (size_t)(h * 64 + 16 * m + l16) * 128 + 32 * ks + 8 * g), sg[ks], ga, 0, 0, 0);
            const float4 lw = *(const float4*)(W.rw_lnw + co), lb = *(const float4*)(W.rw_lnb + co); const u32x2 vq = *(const u32x2*)(Pr + B_V + co);
            const float o0 = (y[m][0] * rs * lw.x + lb.x + bon * bflo(vq.x)) * ga[0], o1 = (y[m][1] * rs * lw.y + lb.y + bon * bfhi(vq.x)) * ga[1];
            const float o2 = (y[m][2] * rs * lw.z + lb.z + bon * bflo(vq.y)) * ga[2], o3 = (y[m][3] * rs * lw.w + lb.w + bon * bfhi(vq.y)) * ga[3];
            u32x2 o; o.x = pk_bf16(o0, o1); o.y = pk_bf16(o2, o3);
            *(u32x2*)(MIX + (size_t)tok * 2048 + 512 + co) = o; }
    }
    for (int tok = F.bid * 8 + F.wave; tok < ntok; tok += F.G * 8) {
        const int c0 = F.lane * 8;
        float ys[8], z[8], gw[8];
        load8f(YS + (size_t)tok * 512 + c0, ys); unpack8(*(const u32x4*)(P + (size_t)tok * PTP + D_Z + c0), z); load8f(W.s_norm + c0, gw);
        float ss = 0.f;
#pragma unroll
        for (int e = 0; e < 8; ++e) { ys[e] *= siluf_(z[e]); ss += ys[e] * ys[e]; }
        ss = wave_sum(ss);
        const float rs = rsqrtf(ss * (1.f / 512.f) + 1e-6f);
#pragma unroll
        for (int e = 0; e < 8; ++e) ys[e] = ys[e] * rs * gw[e];
        *(u32x4*)(MIX + (size_t)tok * 2048 + 1536 + c0) = pack8f(ys);
    }
}

constexpr int RADIX_LOW_BIT = 10;
constexpr int RADIX_STEPS = 14;
__device__ __forceinline__ unsigned ordkey(float x) { const unsigned u = __float_as_uint(x); return (u & 0x80000000u) ? ~u : (u | 0x80000000u); }
template <int CTRL> __device__ __forceinline__ int dpp_i0(int v) { return __builtin_amdgcn_update_dpp(0, v, CTRL, 0xF, 0xF, true); }
__device__ __forceinline__ int rowscan_incl(int x) { x += dpp_i0<0x111>(x); x += dpp_i0<0x112>(x); x += dpp_i0<0x114>(x); x += dpp_i0<0x118>(x); return x; }
__device__ __forceinline__ void phase_scores(const Ctx& F, unsigned char* ws, int layer, int ntok) {
    const bf16_t* Q = (const bf16_t*)(ws + WS_P); const bf16_t* KEYS = (const bf16_t*)(ws + WS_KEYS) + (size_t)layer * 8 * 2 * 128 * 128;
    int* IDS = (int*)(ws + WS_IDS); float* GATES = (float*)(ws + WS_GATES);
    LAS bf16_t* sK = (LAS bf16_t*)F.lds;
    LAS float* sVv = (LAS float*)(F.lds + 2 * 128 * 136 * 2 + F.wave * 5120);
    LAS int* sVi = (LAS int*)(sVv + 512);
    const int ntg = ntok / 128, ntask = 8 * ntg;
    const int l16 = F.lane & 15, g = F.lane >> 4;
    const f32x4 z4 = {0.f, 0.f, 0.f, 0.f};
    int cur_h = -1;
    for (int task = F.bid; task < ntask; task += F.G) {
        const int h = task / ntg, tg = task % ntg;
        if (h != cur_h) { __syncthreads();
#pragma unroll
            for (int q = 0; q < 8; ++q) { const int v = F.tid + 512 * q, row = v >> 4, part = v & 15;
                *(LAS u32x4*)(sK + row * 136 + part * 8) = *(const u32x4*)(KEYS + ((size_t)h * 256 + row) * 128 + part * 8); }
            cur_h = h; __syncthreads(); }
        const int t0 = tg * 128 + F.wave * 16;
#pragma unroll 1
        for (int p = 0; p < 2; ++p) {
            bf16x8 qf[4];
#pragma unroll
            for (int ks = 0; ks < 4; ++ks) qf[ks] = *(const bf16x8*)(Q + (size_t)(t0 + l16) * 2048 + h * 256 + p * 128 + 32 * ks + 8 * g);
            f32x4 acc[8];
#pragma unroll
            for (int kt = 0; kt < 8; ++kt) { f32x4 a = z4;
#pragma unroll
                for (int ks = 0; ks < 4; ++ks) a = __builtin_amdgcn_mfma_f32_16x16x32_bf16(qf[ks], *(const LAS bf16x8*)(sK + (p * 128 + 16 * kt + l16) * 136 + 32 * ks + 8 * g), a, 0, 0, 0);
                acc[kt] = a; }
            float lo0, lo1, lo2, lo3, hi0, hi1, hi2, hi3;
            { float m0 = acc[0][0], m1 = acc[0][1], m2 = acc[0][2], m3 = acc[0][3];
#pragma unroll
              for (int kt = 1; kt < 8; ++kt) { m0 = fmaxf(m0, acc[kt][0]); m1 = fmaxf(m1, acc[kt][1]); m2 = fmaxf(m2, acc[kt][2]); m3 = fmaxf(m3, acc[kt][3]); }
              hi0 = max16(m0); hi1 = max16(m1); hi2 = max16(m2); hi3 = max16(m3);
              lo0 = -max16(-m0); lo1 = -max16(-m1); lo2 = -max16(-m2); lo3 = -max16(-m3); }
#pragma unroll 1
            for (int it = 0; it < RADIX_STEPS; ++it) {
                const float c0 = 0.5f * (lo0 + hi0), c1 = 0.5f * (lo1 + hi1), c2 = 0.5f * (lo2 + hi2), c3 = 0.5f * (lo3 + hi3); int n0 = 0, n1 = 0, n2 = 0, n3 = 0;
#pragma unroll
                for (int kt = 0; kt < 8; ++kt) { n0 += acc[kt][0] >= c0; n1 += acc[kt][1] >= c1; n2 += acc[kt][2] >= c2; n3 += acc[kt][3] >= c3; }
                const bool k0 = sum16((float)n0) >= 16.f, k1 = sum16((float)n1) >= 16.f, k2 = sum16((float)n2) >= 16.f, k3 = sum16((float)n3) >= 16.f;
                lo0 = k0 ? c0 : lo0; hi0 = k0 ? hi0 : c0; lo1 = k1 ? c1 : lo1; hi1 = k1 ? hi1 : c1; lo2 = k2 ? c2 : lo2; hi2 = k2 ? hi2 : c2; lo3 = k3 ? c3 : lo3; hi3 = k3 ? hi3 : c3; }
#pragma unroll
            for (int r = 0; r < 4; ++r) { const float T = r == 0 ? lo0 : (r == 1 ? lo1 : (r == 2 ? lo2 : lo3));
                int cl = 0;
#pragma unroll
                for (int kt = 0; kt < 8; ++kt) cl += acc[kt][r] >= T;
                int rank = rowscan_incl(cl) - cl;
                LAS float* dv = sVv + ((4 * g + r) * 2 + p) * 16; LAS int* di = sVi + ((4 * g + r) * 2 + p) * 16;
#pragma unroll
                for (int kt = 0; kt < 8; ++kt) { const bool sel = acc[kt][r] >= T;
                    if (sel && rank < 16) { dv[rank] = acc[kt][r]; di[rank] = 16 * kt + l16; }
                    rank += sel ? 1 : 0; } }
        }
        asm volatile("" ::: "memory");
#pragma unroll 1
        for (int r = 0; r < 4; ++r) { const int tk = 4 * g + r;
            LAS float* sS = (LAS float*)(sVi + 512);
            LAS int* sI = (LAS int*)(sS + 128);
#pragma unroll
            for (int p = 0; p < 2; ++p) { const float v = sVv[(tk * 2 + p) * 16 + l16]; const int ix = sVi[(tk * 2 + p) * 16 + l16];
                const unsigned key = (ordkey(v) & ~15u) | (unsigned)(15 - l16); int rk = 0;
#pragma unroll
                for (int q = 0; q < 4; ++q) { const f32x4 o = *(const LAS f32x4*)(sVv + (tk * 2 + p) * 16 + 4 * q);
#pragma unroll
                    for (int e = 0; e < 4; ++e) rk += ((ordkey(o[e]) & ~15u) | (unsigned)(15 - (4 * q + e))) > key; }
                sS[(g * 2 + p) * 16 + rk] = v; sI[(g * 2 + p) * 16 + rk] = ix; }
            asm volatile("" ::: "memory");
            float cv[4]; int pi[4], pj[4];
#pragma unroll
            for (int q = 0; q < 4; ++q) { const int e = l16 + 16 * q; int i, j;
                if (e < 16) { i = 0; j = e; } else if (e < 24) { i = 1; j = e - 16; } else if (e < 29) { i = 2; j = e - 24; } else if (e < 33) { i = 3; j = e - 29; }
                else if (e < 36) { i = 4; j = e - 33; } else if (e < 42) { i = 5 + ((e - 36) >> 1); j = (e - 36) & 1; } else { i = 8 + (e - 42); j = 0; }
                const bool ok = e < 50; i = ok ? i : 15; j = ok ? j : 15;
                pi[q] = i; pj[q] = j; cv[q] = ok ? sS[(g * 2) * 16 + i] + sS[(g * 2 + 1) * 16 + j] : -3.0e38f; }
            float lo = sS[(g * 2) * 16 + 15] + sS[(g * 2 + 1) * 16], hi = sS[(g * 2) * 16] + sS[(g * 2 + 1) * 16];
            const float mx = hi;
#pragma unroll 1
            for (int it = 0; it < RADIX_STEPS; ++it) { const float cm = 0.5f * (lo + hi); int n = 0;
#pragma unroll
                for (int q = 0; q < 4; ++q) n += cv[q] >= cm;
                const bool kk = sum16((float)n) >= 16.f; lo = kk ? cm : lo; hi = kk ? hi : cm; }
            int cl = 0; float es = 0.f;
#pragma unroll
            for (int q = 0; q < 4; ++q) { const bool sel = cv[q] >= lo; cl += sel; es += sel ? __expf(cv[q] - mx) : 0.f; }
            int rank = rowscan_incl(cl) - cl;
            const float einv = 1.0f / sum16(es);
            const size_t ob = (size_t)(t0 + tk) * 128 + h * 16;
#pragma unroll
            for (int q = 0; q < 4; ++q) { const bool sel = cv[q] >= lo;
                if (sel && rank < 16) { IDS[ob + rank] = sI[(g * 2) * 16 + pi[q]] * 128 + sI[(g * 2 + 1) * 16 + pj[q]]; GATES[ob + rank] = __expf(cv[q] - mx) * einv; }
                rank += sel ? 1 : 0; }
            asm volatile("" ::: "memory");
        }
        asm volatile("" ::: "memory");
    }
}

struct XInfo { int xi, nx, rank, nloc; };
__device__ __forceinline__ void fp8x16_to_f32(const u32x4 q, float (&f)[16]) {
#pragma unroll
    for (int w = 0; w < 4; ++w) { const auto a = __builtin_amdgcn_cvt_pk_f32_fp8((int)q[w], false); const auto b = __builtin_amdgcn_cvt_pk_f32_fp8((int)q[w], true);
        f[4 * w] = a[0]; f[4 * w + 1] = a[1]; f[4 * w + 2] = b[0]; f[4 * w + 3] = b[1]; }
}
typedef long i64_t;
template <int IDMASK> __device__ __forceinline__ void phase_experts_u(const Ctx& F, unsigned char* ws, int layer, int ntok, const XInfo X, float* PART) {
    const bf16_t* H = (const bf16_t*)(ws + WS_XN); const unsigned char* PU8 = ws + WS_PU + (size_t)layer * 16384 * 2048;
    const int* IDS = (const int*)(ws + WS_IDS);
    const int e8 = F.lane >> 3, c = F.lane & 7, l16 = F.lane & 15, g = F.lane >> 4;
    const int tfirst = X.rank * 8 + F.wave, tstride = X.nloc * 8;
    const int nk = tfirst < ntok ? (ntok - tfirst + tstride - 1) / tstride : 0;
    const f32x4 z4 = {0.f, 0.f, 0.f, 0.f};
    LAS unsigned char* buf = F.lds + F.wave * 12288; LAS float* res = (LAS float*)(buf + 8192);
    const int woff = e8 * 128 + c * 16;
    const int srcoff = 16 * (c ^ e8);
    const int roff0 = l16 * 128 + (((2 * g) ^ (l16 & 7)) * 16), roff1 = l16 * 128 + (((2 * g + 1) ^ (l16 & 7)) * 16);
#define EU_TOK(k) (tfirst + min((k), nk - 1) * tstride)
#define EU_LOADI(I, k) do { const int* ip_ = IDS + (size_t)EU_TOK(k) * 128 + e8; _Pragma("unroll") for (int q_ = 0; q_ < 16; ++q_) I[q_] = ip_[8 * q_]; } while (0)
#define EU_LOADX(HX, k) do { const u32x4* hp_ = (const u32x4*)(H + (size_t)EU_TOK(k) * 2048 + s * 128 + 32 * g); HX[0] = hp_[0]; HX[1] = hp_[1]; HX[2] = hp_[2]; HX[3] = hp_[3]; } while (0)
#define EU_ISSUE(Q, I, hf) do { const unsigned char* sb_ = PU8 + (size_t)s * 16384 * 128; _Pragma("unroll") for (int i_ = 0; i_ < 8; ++i_) Q[i_] = *(const u32x4*)(sb_ + (unsigned)(I[(hf) * 8 + i_] * 128 + srcoff)); } while (0)
#define EU_CONSUME(Q, hf, slot) do { _Pragma("unroll") for (int i_ = 0; i_ < 8; ++i_) *(LAS u32x4*)(buf + i_ * 1024 + woff) = Q[i_]; \
        asm volatile("" ::: "memory"); \
        u32x4 p0_[4], p1_[4]; f32x4 a_[4]; \
        _Pragma("unroll") for (int q_ = 0; q_ < 4; ++q_) { p0_[q_] = *(const LAS u32x4*)(buf + q_ * 2048 + roff0); p1_[q_] = *(const LAS u32x4*)(buf + q_ * 2048 + roff1); a_[q_] = z4; } \
          \
        _Pragma("unroll") for (int q_ = 0; q_ < 4; ++q_) a_[q_] = __builtin_amdgcn_mfma_f32_16x16x32_fp8_fp8(((i64_t)p0_[q_][1] << 32) | (i64_t)p0_[q_][0], hb[0], a_[q_], 0, 0, 0); \
        _Pragma("unroll") for (int q_ = 0; q_ < 4; ++q_) a_[q_] = __builtin_amdgcn_mfma_f32_16x16x32_fp8_fp8(((i64_t)p0_[q_][3] << 32) | (i64_t)p0_[q_][2], hb[1], a_[q_], 0, 0, 0); \
        _Pragma("unroll") for (int q_ = 0; q_ < 4; ++q_) a_[q_] = __builtin_amdgcn_mfma_f32_16x16x32_fp8_fp8(((i64_t)p1_[q_][1] << 32) | (i64_t)p1_[q_][0], hb[2], a_[q_], 0, 0, 0); \
        _Pragma("unroll") for (int q_ = 0; q_ < 4; ++q_) a_[q_] = __builtin_amdgcn_mfma_f32_16x16x32_fp8_fp8(((i64_t)p1_[q_][3] << 32) | (i64_t)p1_[q_][2], hb[3], a_[q_], 0, 0, 0); \
        _Pragma("unroll") for (int q_ = 0; q_ < 4; ++q_) if (l16 == (hf) * 4 + q_) *(LAS f32x4*)(res + (slot) * 128 + 16 * ((hf) * 4 + q_) + 4 * g) = a_[q_]; \
        asm volatile("" ::: "memory"); } while (0)
    for (int s = X.xi; s < 16; s += X.nx) {
        if (nk == 0) continue;
        int id[2][16]; u32x4 hx[2][4]; u32x4 qa[8], qb[8];
        EU_LOADI(id[0], 0); EU_LOADX(hx[0], 0); EU_ISSUE(qa, id[0], 0); EU_ISSUE(qb, id[0], 1);
        EU_LOADI(id[1], 1);
        for (int k0 = 0; k0 < nk; k0 += 8) {
#pragma unroll
            for (int j = 0; j < 8; ++j) { const int k = k0 + j;
                i64_t hb[4];
#pragma unroll
                for (int m = 0; m < 4; ++m) { const u32x4 v = hx[j & 1][m];
                    int lo = __builtin_amdgcn_cvt_pk_fp8_f32(bflo(v[0]), bfhi(v[0]), 0, false); lo = __builtin_amdgcn_cvt_pk_fp8_f32(bflo(v[1]), bfhi(v[1]), lo, true);
                    int hi = __builtin_amdgcn_cvt_pk_fp8_f32(bflo(v[2]), bfhi(v[2]), 0, false); hi = __builtin_amdgcn_cvt_pk_fp8_f32(bflo(v[3]), bfhi(v[3]), hi, true);
                    hb[m] = ((i64_t)(unsigned)hi << 32) | (i64_t)(unsigned)lo; }
                EU_LOADX(hx[(j + 1) & 1], k + 1);
                EU_LOADI(id[j & 1], k + 2);
                EU_CONSUME(qa, 0, j);
                EU_ISSUE(qa, id[(j + 1) & 1], 0);
                EU_CONSUME(qb, 1, j);
                EU_ISSUE(qb, id[(j + 1) & 1], 1);
            }
            { const int u = F.lane >> 3, jj = F.lane & 7, ku = k0 + u;
              if (ku < nk) { float* dst = PART + ((size_t)s * NTOK + tfirst + ku * tstride) * 128 + 16 * jj;
#pragma unroll
                  for (int w = 0; w < 4; ++w) *(f32x4*)(dst + 4 * w) = *(const LAS f32x4*)(res + u * 128 + 16 * jj + 4 * w); }
              asm volatile("" ::: "memory"); }
        }
    }
#undef EU_TOK
#undef EU_LOADI
#undef EU_LOADX
#undef EU_ISSUE
#undef EU_CONSUME
}
__device__ __forceinline__ void phase_experts_combine(const Ctx& F, unsigned char* ws, int ntok) {
    const float* PART = (const float*)(ws + WS_PART); float* GATES = (float*)(ws + WS_GATES);
    for (int idx = F.bid * 512 + F.tid; idx < ntok * 32; idx += F.G * 512) {
        float4 a = make_float4(0.f, 0.f, 0.f, 0.f);
#pragma unroll
        for (int s = 0; s < 16; ++s) { const float4 v = *(const float4*)(PART + (size_t)s * NTOK * 128 + (size_t)idx * 4); a.x += v.x; a.y += v.y; a.z += v.z; a.w += v.w; }
        float4 g = *(const float4*)(GATES + (size_t)idx * 4);
        g.x *= geluf_(a.x * (1.0f / PEER_U_SCALE)); g.y *= geluf_(a.y * (1.0f / PEER_U_SCALE)); g.z *= geluf_(a.z * (1.0f / PEER_U_SCALE)); g.w *= geluf_(a.w * (1.0f / PEER_U_SCALE));
        *(float4*)(GATES + (size_t)idx * 4) = g;
    }
}
__device__ __forceinline__ void phase_experts_v(const Ctx& F, unsigned char* ws, float* out, float* CTXS, int layer, int ntok, const XInfo X) {
    const unsigned char* PV8 = ws + WS_PV + (size_t)layer * 16384 * 2048;
    const int* IDS = (const int*)(ws + WS_IDS); const float* COEF = (const float*)(ws + WS_GATES); const float* MOD = (const float*)(ws + WS_MOD);
    const int e8 = F.lane >> 3, c = F.lane & 7;
    const int tfirst = X.rank * 8 + F.wave, tstride = X.nloc * 8;
    const int nk = tfirst < ntok ? (ntok - tfirst + tstride - 1) / tstride : 0;
    LAS float* res = (LAS float*)(F.lds + F.wave * 4096);
#define EV_TOK(k) (tfirst + min((k), nk - 1) * tstride)
#define EV_LOADI(I, k) do { I[0] = *((const u32x4*)(IDS + (size_t)EV_TOK(k) * 128 + e8 * 16) + (c & 3)); } while (0)
#define EV_LOADC(C, k) do { C[0] = *((const u32x4*)(COEF + (size_t)EV_TOK(k) * 128 + e8 * 16) + (c & 3)); } while (0)
#define EV_QUAD(V) do { const u32x4 own_ = V[0];   \
        _Pragma("unroll") for (int w_ = 0; w_ < 4; ++w_) { V[0][w_] = (unsigned)__builtin_amdgcn_update_dpp(0, (int)own_[w_], 0x00, 0xF, 0xF, true); V[1][w_] = (unsigned)__builtin_amdgcn_update_dpp(0, (int)own_[w_], 0x55, 0xF, 0xF, true); \
            V[2][w_] = (unsigned)__builtin_amdgcn_update_dpp(0, (int)own_[w_], 0xAA, 0xF, 0xF, true); V[3][w_] = (unsigned)__builtin_amdgcn_update_dpp(0, (int)own_[w_], 0xFF, 0xF, 0xF, true); } } while (0)
#define EV_ROW(id) (*(const u32x4*)(PV8 + (size_t)s * 16384 * 128 + (unsigned)((id) * 128 + c * 16)))
#define EV_ISSUE(Q, I, hf) do { _Pragma("unroll") for (int i_ = 0; i_ < 8; ++i_) Q[i_] = EV_ROW(I[(hf) * 2 + (i_ >> 2)][i_ & 3]); } while (0)
#define EV_HALF(Q, C, hf) do { _Pragma("unroll") for (int i_ = 0; i_ < 8; ++i_) { const float cf_ = __uint_as_float(C[(hf) * 2 + (i_ >> 2)][i_ & 3]); const f32x2_t c2_ = {cf_, cf_}; \
            _Pragma("unroll") for (int w_ = 0; w_ < 4; ++w_) { const f32x2_t lo_ = __builtin_amdgcn_cvt_pk_f32_fp8((int)Q[i_][w_], false), hi_ = __builtin_amdgcn_cvt_pk_f32_fp8((int)Q[i_][w_], true); \
                ac2[2 * w_] = lo_ * c2_ + ac2[2 * w_]; ac2[2 * w_ + 1] = hi_ * c2_ + ac2[2 * w_ + 1]; } } } while (0)
    for (int s = X.xi; s < 16; s += X.nx) {
        if (nk == 0) continue;
        u32x4 id[2][4], cf[2][4]; u32x4 qa[8], qb[8];
        EV_LOADI(id[0], 0); EV_LOADC(cf[0], 0); EV_QUAD(id[0]); EV_ISSUE(qa, id[0], 0); EV_ISSUE(qb, id[0], 1);
        EV_LOADI(id[1], 1);
        for (int k0 = 0; k0 < nk; k0 += 8) {
#pragma unroll
            for (int j = 0; j < 8; ++j) { const int k = k0 + j;
                f32x2_t ac2[8];
#pragma unroll
                for (int e = 0; e < 8; ++e) ac2[e] = (f32x2_t){0.f, 0.f};
                EV_QUAD(cf[j & 1]);
                EV_QUAD(id[(j + 1) & 1]);
                EV_LOADC(cf[(j + 1) & 1], k + 1);
                EV_HALF(qa, cf[j & 1], 0);
                EV_ISSUE(qa, id[(j + 1) & 1], 0);
                EV_HALF(qb, cf[j & 1], 1);
                EV_ISSUE(qb, id[(j + 1) & 1], 1);
                EV_LOADI(id[j & 1], k + 2);
                float acc[16];
#pragma unroll
                for (int e = 0; e < 8; ++e) { acc[2 * e] = ac2[e][0]; acc[2 * e + 1] = ac2[e][1]; }
#pragma unroll
                for (int e = 0; e < 16; ++e) { float v = acc[e]; v += dpp_f<0x128>(v); v += xor16_f(v); acc[e] = sum_x32(v); }
                if (e8 == 0) {
#pragma unroll
                    for (int w = 0; w < 4; ++w) *(LAS f32x4*)(res + j * 128 + c * 16 + 4 * w) = (f32x4){acc[4 * w], acc[4 * w + 1], acc[4 * w + 2], acc[4 * w + 3]}; }
                asm volatile("" ::: "memory");
            }
            { const int u = F.lane >> 3, jj = F.lane & 7, ku = k0 + u;
              if (ku < nk) { const int tu = tfirst + ku * tstride;
                  const bool isctx = tu >= NLAT; const int vv = isctx ? 4 : (tu >> 12);
                  float* xr = (isctx ? CTXS + (size_t)(tu - NLAT) * 2048 : out + (size_t)tu * 2048) + s * 128 + jj * 16;
                  const float* m5 = MOD + ((size_t)layer * 5 + vv) * 12288 + 5 * 2048 + s * 128 + jj * 16;
#pragma unroll
                  for (int w = 0; w < 4; ++w) { float4 x = *(const float4*)(xr + 4 * w); const float4 m = *(const float4*)(m5 + 4 * w); const f32x4 a = *(const LAS f32x4*)(res + u * 128 + jj * 16 + 4 * w);
                      x.x += m.x * a[0]; x.y += m.y * a[1]; x.z += m.z * a[2]; x.w += m.w * a[3]; *(float4*)(xr + 4 * w) = x; } }
              asm volatile("" ::: "memory"); }
        }
    }
#undef EV_TOK
#undef EV_LOADI
#undef EV_LOADC
#undef EV_QUAD
#undef EV_ROW
#undef EV_ISSUE
#undef EV_HALF
}

struct Params { const float* in[N_IN]; float* out; unsigned char* ws; };

__device__ __forceinline__ LayerW make_w(ka_t in, int l) {
    LayerW W;
    W.sc_w = in[I_SCW] + (size_t)l * 3 * 512; W.rw_w0 = in[I_RW0] + (size_t)l * 2 * 512; W.rw_wup = in[I_RWUP] + (size_t)l * 2 * 64 * 512;
    W.rw_a0 = in[I_RA0] + (size_t)l * 2 * 512; W.rw_aup = in[I_RAUP] + (size_t)l * 2 * 64 * 512; W.rw_gup = in[I_RGUP] + (size_t)l * 128 * 512;
    W.rw_kk = in[I_RKK] + (size_t)l * 512; W.rw_ka = in[I_RKA] + (size_t)l * 512; W.rw_rk = in[I_RRK] + (size_t)l * 512;
    W.rw_lnw = in[I_RLNW] + (size_t)l * 512; W.rw_lnb = in[I_RLNB] + (size_t)l * 512;
    W.na_q = in[I_NAQ] + (size_t)l * 64; W.na_k = in[I_NAK] + (size_t)l * 64; W.rpb = in[I_RPB] + (size_t)l * 8 * 15 * 31;
    W.s_cw = in[I_SCONVW] + (size_t)l * 3 * 1024; W.s_cb = in[I_SCONVB] + (size_t)l * 1024; W.s_dtb = in[I_SDTB] + (size_t)l * 16; W.s_alog = in[I_SALOG] + (size_t)l * 16;
    W.s_d = in[I_SD] + (size_t)l * 8; W.s_norm = in[I_SNORM] + (size_t)l * 512;
    return W;
}

__global__ void __launch_bounds__(512, 2) hybrid_fwd(Params p) {
    extern __shared__ __attribute__((aligned(16))) unsigned char shm[];
    Ctx F; F.lds = (LAS unsigned char*)shm; F.tid = threadIdx.x; F.lane = F.tid & 63; F.wave = __builtin_amdgcn_readfirstlane(F.tid >> 6); F.bid = blockIdx.x; F.G = gridDim.x;
    volatile LAS unsigned* bst = (volatile LAS unsigned*)(F.lds + LDS_BAR_OFF);
    if (F.tid < 4) bst[F.tid] = 0u;
    __syncthreads();
    (void)xcd_barrier_post((unsigned*)(p.ws + WS_CTL), bst);
    volatile LAS int* lxi = (volatile LAS int*)(F.lds + LDS_XI_OFF);
    if (F.tid == 0) lxi[2] = (int)xb_add((unsigned*)(p.ws + WS_CTL) + CTL_TICKET + 64 * xb_xcc_id(), 1u);
#define RPT_PHASE(id, ...) do { __VA_ARGS__ if (RPT == (id)) { GRID_BAR(); PH_BEGIN(); __VA_ARGS__ } } while (0)
#define GRID_BAR() do { ka_t kb_ = (ka_t)__builtin_amdgcn_kernarg_segment_ptr(); asm volatile("" : "+s"(kb_)); unsigned xx_ = xb_xcc_id(); asm volatile("" : "+s"(xx_)); \
        XcdBarrier b_; b_.bar = (unsigned*)((unsigned char*)kb_[N_IN + 1] + WS_CTL); b_.x = xx_; b_.st = (volatile LAS unsigned*)(F.lds + LDS_BAR_OFF); xcd_barrier(b_); } while (0)
    ka_t in; unsigned char* ws; float* out;
#define PH_BEGIN() do { int t_ = threadIdx.x; asm volatile("; PHASE_MARK" : "+v"(t_)); F.tid = t_; F.lane = t_ & 63; F.wave = __builtin_amdgcn_readfirstlane(t_ >> 6); \
        int b_ = blockIdx.x, g_ = gridDim.x; asm volatile("" : "+s"(b_), "+s"(g_)); F.bid = b_; F.G = g_; \
        ka_t k_ = (ka_t)__builtin_amdgcn_kernarg_segment_ptr(); asm volatile("" : "+s"(k_)); in = k_; \
        out = (float*)in[N_IN]; ws = (unsigned char*)in[N_IN + 1]; } while (0)

    PH_BEGIN();
    RPT_PHASE(1, phase_prologue(F, in, ws););
    GRID_BAR();
    if (F.tid == 0) {
        const unsigned* bw = (const unsigned*)(ws + WS_CTL); const unsigned myx = xb_xcc_id(); int xi = 0, nx = 0, nloc = 1;
        for (unsigned j = 0; j < 16; ++j) { const unsigned cnt = xb_ld((unsigned*)&bw[XB_XCNT(j)]); if (cnt > 0u) { if (j < myx) ++xi; ++nx; } if (j == myx) nloc = (int)cnt; }
        lxi[0] = xi; lxi[1] = nx > 0 ? nx : 1; lxi[3] = nloc > 0 ? nloc : 1; }
    __syncthreads();
    PH_BEGIN();
    phase_modreduce(F, in[I_BADA], (const float*)(ws + WS_MODP), (float*)(ws + WS_MOD));
    GRID_BAR();

#pragma unroll 1
    for (int l = 0; l < 2; ++l) {
        const int M = (l == 0) ? NTOK : NLAT;
        if (l == 0) { PH_BEGIN(); phase_norm(F, in[I_X], in[I_CTX], in[I_NMIX], (const float*)(ws + WS_MOD), 0, 1, (bf16_t*)(ws + WS_XN), NTOK); GRID_BAR(); }

        PH_BEGIN();
        RPT_PHASE(2, { pg8::Gemm g{(const bf16_t*)(ws + WS_XN), (const bf16_t*)(ws + WS_WIN) + (size_t)l * PTP * 2048, NTOK, PTP, 2048}; pg8::StaticOrder S; S.init(NTOK, PTP, F.G, F.bid);
          pg8::EpiBf16 E{(bf16_t*)(ws + WS_P), PTP}; pg8::gemm_phase<pg8::EpiBf16, pg8::StaticOrder>(F.lds, g, S, E, F.tid); });
        GRID_BAR();

        PH_BEGIN();
        { const LayerW W = make_w(in, l); phase_prep(F, W, ws);
            if (RPT == 31) phase_prep(F, W, ws);
            const bf16_t* WUPT = (const bf16_t*)(ws + WS_WUPT) + (size_t)l * 4 * 512 * 64;
            for (int rep = 0; rep < (RPT == 32 ? 2 : 1); ++rep) {
            for (int task = F.bid * 8 + F.wave; task < 4 * 8 * RW_NCHUNK; task += F.G * 8) rwkv_pre_task(F, W, ws, WUPT, task, 0);
            for (int task = F.bid * 8 + F.wave; task < 4 * 8 * RW_NCHUNK; task += F.G * 8) rwkv_pre_task(F, W, ws, WUPT, task, 1); } }
        GRID_BAR();

        PH_BEGIN();
        RPT_PHASE(4, { const LayerW W = make_w(in, l); for (int task = F.bid; task < 4 * 8 * NCH; task += F.G) ssd_task<false>(F, W, ws, task); });
        GRID_BAR();
        PH_BEGIN();
        phase_ssd_combine(F, ws);
        GRID_BAR();

        PH_BEGIN();
        { if (F.bid < 64) rwkv_scan(F, ws, F.bid);
        else { const LayerW W = make_w(in, l); const int blk = F.bid - 64, nblk = F.G - 64;
            for (int task = blk; task < 4 * 8 * NCH; task += nblk) ssd_task<true>(F, W, ws, task);
            na_phase(F, W, ws, blk, nblk, (l == 0) ? 1088 : 1024); } }
        if (RPT == 51) { GRID_BAR(); PH_BEGIN(); if (F.bid < 64) rwkv_scan(F, ws, F.bid); }
        if (RPT == 52) { GRID_BAR(); PH_BEGIN(); if (F.bid >= 64) { const LayerW W = make_w(in, l); const int blk = F.bid - 64, nblk = F.G - 64;
            for (int task = blk; task < 4 * 8 * NCH; task += nblk) ssd_task<true>(F, W, ws, task); } }
        if (RPT == 53) { GRID_BAR(); PH_BEGIN(); if (F.bid >= 64) { const LayerW W = make_w(in, l); const int blk = F.bid - 64, nblk = F.G - 64;
            na_phase(F, W, ws, blk, nblk, (l == 0) ? 1088 : 1024); } }
        GRID_BAR();

        PH_BEGIN();
        RPT_PHASE(6, { const LayerW W = make_w(in, l); phase_finish(F, W, ws, (const bf16_t*)(ws + WS_GUPT) + (size_t)l * 512 * 128, M); });
        GRID_BAR();

        PH_BEGIN();
        { pg8::Gemm g{(const bf16_t*)(ws + WS_MIX), (const bf16_t*)(ws + WS_WOUT) + (size_t)l * 2048 * 2048, M, 2048, 2048}; pg8::StaticOrder S; S.init(M, 2048, F.G, F.bid);
          float* CTXS = (float*)(ws + WS_CTXS);
          pg8::EpiResid E{l == 0 ? in[I_X] : out, l == 0 ? in[I_CTX] : CTXS, out, CTXS, (const float*)(ws + WS_MOD) + (size_t)l * 5 * 12288 + 2 * 2048};
          pg8::gemm_phase<pg8::EpiResid, pg8::StaticOrder>(F.lds, g, S, E, F.tid); }
        if (l == 0 && F.bid >= 32) PEER_CONVERT_LAYER(F, in, ws, 0, F.bid - 32, F.G - 32);
        GRID_BAR();

        PH_BEGIN();
        RPT_PHASE(7, phase_norm(F, out, (const float*)(ws + WS_CTXS), in[I_NFFN] + (size_t)l * 2048, (const float*)(ws + WS_MOD) + (size_t)l * 5 * 12288, 3, 4, (bf16_t*)(ws + WS_XN), M););
        GRID_BAR();
        PH_BEGIN();
        RPT_PHASE(8, { pg8::Gemm g{(const bf16_t*)(ws + WS_XN), (const bf16_t*)(ws + WS_WQ) + (size_t)l * 2048 * 2048, M, 2048, 2048}; pg8::StaticOrder S; S.init(M, 2048, F.G, F.bid);
          pg8::EpiBf16 E{(bf16_t*)(ws + WS_P), 2048}; pg8::gemm_phase<pg8::EpiBf16, pg8::StaticOrder>(F.lds, g, S, E, F.tid); });
        if (l == 0 && F.bid >= 32) PEER_CONVERT_LAYER(F, in, ws, 1, F.bid - 32, F.G - 32);
        GRID_BAR();
        PH_BEGIN();
        RPT_PHASE(9, phase_scores(F, ws, l, M););
        GRID_BAR();
        PH_BEGIN();
        RPT_PHASE(10, { XInfo X; X.xi = lxi[0]; X.nx = lxi[1]; X.rank = lxi[2]; X.nloc = lxi[3]; phase_experts_u<0x3fff>(F, ws, l, M, X, (float*)(ws + WS_PART)); });
        if (RPT == 101) { GRID_BAR(); PH_BEGIN(); XInfo X; X.xi = lxi[0]; X.nx = lxi[1]; X.rank = lxi[2]; X.nloc = lxi[3]; phase_experts_u<0x3ff>(F, ws, l, M, X, (float*)(ws + WS_P)); }
        if (RPT == 102) { GRID_BAR(); PH_BEGIN(); XInfo X; X.xi = lxi[0]; X.nx = lxi[1]; X.rank = lxi[2]; X.nloc = lxi[3]; phase_experts_u<0x3fff>(F, ws, l, M, X, (float*)(ws + WS_P)); }
        GRID_BAR();
        PH_BEGIN();
        phase_experts_combine(F, ws, M);
        GRID_BAR();
        PH_BEGIN();
        if (RPT == 11) { XInfo X; X.xi = lxi[0]; X.nx = lxi[1]; X.rank = lxi[2]; X.nloc = lxi[3]; phase_experts_v(F, ws, (float*)(ws + WS_P), (float*)(ws + WS_P) + (size_t)NLAT * 2048, l, M, X); GRID_BAR(); PH_BEGIN(); }
        { XInfo X; X.xi = lxi[0]; X.nx = lxi[1]; X.rank = lxi[2]; X.nloc = lxi[3]; phase_experts_v(F, ws, out, (float*)(ws + WS_CTXS), l, M, X); }
        if (l == 0) { GRID_BAR(); PH_BEGIN();
            phase_norm(F, out, (const float*)(ws + WS_CTXS), in[I_NMIX] + 2048, (const float*)(ws + WS_MOD) + (size_t)5 * 12288, 0, 1, (bf16_t*)(ws + WS_XN), NTOK); GRID_BAR(); }
    }
}

extern "C" void kernel_launch(void* const* d_in, const int* in_sizes, int n_in, void* d_out, int out_size, void* d_ws, size_t ws_size, hipStream_t stream) {
    static int grid = 0;
    if (grid == 0) {
        if (n_in != N_IN || out_size != NLAT * DM || ws_size < WS_END) { fprintf(stderr, "kernel_launch: unexpected shapes (n_in %d out %d ws %zu, need %zu)\n", n_in, out_size, ws_size, (size_t)WS_END); grid = -1; return; }
        int dev = 0, cus = 0, per_cu = 0;
        (void)hipGetDevice(&dev); (void)hipDeviceGetAttribute(&cus, hipDeviceAttributeMultiprocessorCount, dev);
        if (hipFuncSetAttribute((const void*)hybrid_fwd, hipFuncAttributeMaxDynamicSharedMemorySize, LDS_BYTES) != hipSuccess) { fprintf(stderr, "kernel_launch: hipFuncSetAttribute failed\n"); grid = -1; return; }
        (void)hipOccupancyMaxActiveBlocksPerMultiprocessor(&per_cu, (const void*)hybrid_fwd, 512, LDS_BYTES);
        (void)hipGetLastError();
        fprintf(stderr, "kernel_launch: %d CUs, occupancy query %d block(s)/CU, ws %zu B (need %zu)\n", cus, per_cu, ws_size, (size_t)WS_END);
        grid = cus;
        if (grid < 136) { fprintf(stderr, "kernel_launch: needs at least 136 CUs\n"); grid = -1; return; }
    }
    if (grid < 0) return;
    (void)hipMemsetAsync((char*)d_ws + WS_CTL, 0, 65536, stream);
    Params p{};
    for (int i = 0; i < N_IN; ++i) p.in[i] = (const float*)d_in[i];
    p.out = (float*)d_out; p.ws = (unsigned char*)d_ws;
    hipLaunchKernelGGL(hybrid_fwd, dim3(grid), dim3(512), LDS_BYTES, stream, p);
}
```

```cpp
#include <hip/hip_runtime.h>
#include <cstdio>
#include <cstdint>
#ifndef RPT
#define RPT 0
#endif

constexpr int DM = 2048, NBATCH = 4, SEQL = 4096, CTXL = 256, NLAT = NBATCH * SEQL, NCTX = NBATCH * CTXL, NTOK = NLAT + NCTX;
constexpr int PT = 6416, PTP = 6656;
constexpr int A_BG = 0, A_CG = 512, A_H = 1024;
constexpr int B_R = 1536, B_K = 2048, B_V = 2560, B_WD = 3072, B_AD = 3136, B_GD = 3200;
constexpr int C_Q = 3328, C_K = 3840, C_V = 4352;
constexpr int D_Z = 4864, D_X = 5376, D_DT = 6400;
constexpr int NPOS = CTXL + SEQL;
constexpr int NCH = 34;
constexpr int KSPL = 32;

enum { I_X = 0, I_C, I_CTX, I_CCTX, I_WADA, I_BADA, I_NMIX, I_NFFN, I_WIN, I_WOUT, I_SCW, I_RW0, I_RWUP, I_RA0, I_RAUP, I_RGUP, I_RKK, I_RKA, I_RRK, I_RLNW, I_RLNB,
       I_NAQ, I_NAK, I_RPB, I_SCONVW, I_SCONVB, I_SDTB, I_SALOG, I_SD, I_SNORM, I_PWQ, I_PKEYS, I_PU, I_PV, N_IN };

constexpr size_t WS_CTL   = 0;
constexpr size_t WS_ROPE  = 65536;
constexpr size_t WS_MODP  = WS_ROPE + 16384;
constexpr size_t WS_MOD   = WS_MODP + (size_t)KSPL * 2 * 5 * 12288 * 4;
constexpr size_t WS_WIN   = WS_MOD + (size_t)2 * 5 * 12288 * 4;
constexpr size_t WS_WOUT  = WS_WIN + (size_t)2 * PTP * DM * 2;
constexpr size_t WS_WQ    = WS_WOUT + (size_t)2 * DM * DM * 2;
constexpr size_t WS_KEYS  = WS_WQ + (size_t)2 * DM * DM * 2;
constexpr size_t WS_WUPT  = WS_KEYS + (size_t)2 * 8 * 2 * 128 * 128 * 2;
constexpr size_t WS_GUPT  = WS_WUPT + (size_t)2 * 4 * 512 * 64 * 2;
constexpr size_t WS_PU    = WS_GUPT + (size_t)2 * 512 * 128 * 2;
constexpr size_t WS_PV    = WS_PU + (size_t)2 * 16384 * DM;
constexpr size_t WS_P     = WS_PV + (size_t)2 * 16384 * DM;
constexpr size_t WS_MIX   = WS_P + (size_t)NTOK * PTP * 2;
constexpr size_t WS_CTXS  = WS_MIX + (size_t)NTOK * DM * 2;
constexpr size_t WS_XN    = WS_CTXS + (size_t)NCTX * DM * 4;
constexpr size_t WS_IDS   = WS_XN + (size_t)NTOK * DM * 2;
constexpr size_t WS_GATES = WS_IDS + (size_t)NTOK * 128 * 4;
constexpr size_t WS_PART  = WS_GATES + (size_t)NTOK * 128 * 4;
constexpr size_t WS_RWF   = WS_XN;
constexpr size_t WS_RWY   = WS_RWF + (size_t)64 * 272 * 10496;
constexpr size_t WS_BON   = WS_RWY + (size_t)2 * NTOK * 512 * 2;
constexpr size_t WS_XBC   = WS_BON + (size_t)2 * NTOK * 8 * 4;
constexpr size_t WS_DTS   = WS_XBC + (size_t)NTOK * 1024 * 2;
constexpr size_t WS_DEC   = WS_DTS + (size_t)NTOK * 16 * 4;
constexpr size_t WS_SST   = WS_DEC + (size_t)NTOK * 16 * 4;
constexpr size_t WS_SCD   = WS_SST + (size_t)64 * NCH * 8192 * 4;
constexpr size_t WS_YS    = WS_SCD + 16384;
constexpr size_t WS_QN    = WS_YS + (size_t)NTOK * 512 * 4;
constexpr size_t WS_KN    = WS_QN + (size_t)NTOK * 512 * 2;
constexpr size_t WS_VTL   = WS_KN + (size_t)NTOK * 512 * 2;
constexpr size_t WS_VTC   = WS_VTL + (size_t)4 * 8 * 64 * 64 * 96 * 2;
constexpr size_t WS_END   = WS_VTC + (size_t)4 * 8 * 64 * 256 * 2;
static_assert(WS_END < (size_t)1020 * 1024 * 1024, "workspace");
static_assert(WS_GATES + (size_t)NTOK * 128 * 4 <= WS_PART && WS_PART + (size_t)16 * NTOK * 128 * 4 <= WS_END, "alias");

constexpr int LDS_BYTES = 147456;
constexpr int LDS_BAR_OFF = LDS_BYTES - 16;
constexpr int LDS_XI_OFF = LDS_BYTES - 48;
constexpr int CTL_TICKET = 8192;

#define LAS __attribute__((address_space(3)))
typedef unsigned short bf16_t;
typedef _Float16 f16_t;
typedef short bf16x8 __attribute__((ext_vector_type(8)));
typedef float f32x4 __attribute__((ext_vector_type(4)));
typedef unsigned u32x4 __attribute__((ext_vector_type(4)));
typedef unsigned u32x2 __attribute__((ext_vector_type(2)));

__device__ __forceinline__ float bf2f(bf16_t h) { return __uint_as_float(((unsigned)h) << 16); }
__device__ __forceinline__ float bflo(unsigned u) { return __uint_as_float(u << 16); }
__device__ __forceinline__ float bfhi(unsigned u) { return __uint_as_float(u & 0xffff0000u); }
__device__ __forceinline__ bf16_t f2bf(float f) { unsigned u = __float_as_uint(f); u += 0x7FFFu + ((u >> 16) & 1u); return (bf16_t)(u >> 16); }
typedef float f32x2_t __attribute__((ext_vector_type(2)));
typedef __bf16 bf16x2_t __attribute__((ext_vector_type(2)));
__device__ __forceinline__ unsigned pk_bf16(float lo, float hi) { const f32x2_t v = {lo, hi}; const bf16x2_t r = __builtin_convertvector(v, bf16x2_t); return __builtin_bit_cast(unsigned, r); }
__device__ __forceinline__ bf16x8 pack8(const f32x4 a, const f32x4 b) { union { bf16x8 v; unsigned u[4]; } r; r.u[0] = pk_bf16(a[0], a[1]); r.u[1] = pk_bf16(a[2], a[3]); r.u[2] = pk_bf16(b[0], b[1]); r.u[3] = pk_bf16(b[2], b[3]); return r.v; }
template <int CTRL> __device__ __forceinline__ float dpp_f(float v) { return __int_as_float(__builtin_amdgcn_update_dpp(0, __float_as_int(v), CTRL, 0xF, 0xF, true)); }
__device__ __forceinline__ float sum4(float x)  { x += dpp_f<0xB1>(x); x += dpp_f<0x4E>(x); return x; }
__device__ __forceinline__ float sum8(float x)  { x = sum4(x); x += dpp_f<0x141>(x); return x; }
__device__ __forceinline__ float sum16(float x) { x = sum8(x); x += dpp_f<0x140>(x); return x; }
__device__ __forceinline__ float xor16_f(float x) { return __int_as_float(__builtin_amdgcn_ds_swizzle(__float_as_int(x), 0x401F)); }
__device__ __forceinline__ float sum_x32(float x) { const auto r = __builtin_amdgcn_permlane32_swap(__float_as_uint(x), __float_as_uint(x), false, false); return __uint_as_float(r[0]) + __uint_as_float(r[1]); }
__device__ __forceinline__ float max_x32(float x) { const auto r = __builtin_amdgcn_permlane32_swap(__float_as_uint(x), __float_as_uint(x), false, false); return fmaxf(__uint_as_float(r[0]), __uint_as_float(r[1])); }
__device__ __forceinline__ float wave_sum(float x) { x = sum16(x); x += xor16_f(x); return sum_x32(x); }
__device__ __forceinline__ float max16(float x) { x = fmaxf(x, dpp_f<0xB1>(x)); x = fmaxf(x, dpp_f<0x4E>(x)); x = fmaxf(x, dpp_f<0x141>(x)); x = fmaxf(x, dpp_f<0x140>(x)); return x; }
__device__ __forceinline__ float wave_max(float x) { x = max16(x); x = fmaxf(x, xor16_f(x)); return max_x32(x); }
__device__ __forceinline__ float rcpf_(float x) { return __builtin_amdgcn_rcpf(x); }
__device__ __forceinline__ float sigmoidf_(float x) { return rcpf_(1.0f + __expf(-x)); }
__device__ __forceinline__ float siluf_(float x) { return x * rcpf_(1.0f + __expf(-x)); }
__device__ __forceinline__ float tanhf_(float x) { const float e = __expf(2.0f * x); return 1.0f - 2.0f * rcpf_(e + 1.0f); }
__device__ __forceinline__ float geluf_(float x) { return 0.5f * x * (1.0f + tanhf_(0.7978845608028654f * (x + 0.044715f * x * x * x))); }

namespace pg8 {
#define PG8_LAS __attribute__((address_space(3)))
typedef unsigned short bf16_t;
typedef short bf16x8 __attribute__((ext_vector_type(8)));
typedef float f32x4 __attribute__((ext_vector_type(4)));
typedef unsigned u32x4 __attribute__((ext_vector_type(4)));
constexpr int BM = 256, BK = 64, HALF = 128, HTB = HALF * BK * 2  , STAGE_BYTES = 8 * HTB, NXCD = 8, WGM = 8;

__host__ __device__ __forceinline__ int lds_byte(int r, int c) { const int st = (r >> 4) * 2 + (c >> 5), rr = r & 15, cc = c & 31, ob = rr * 64 + cc * 2; return st * 1024 + (ob ^ (((ob >> 9) & 1) << 5)); }
__host__ __device__ __forceinline__ void stage_rc(int b, int& R, int& C) { const int st = b / 1024, sb = b % 1024, swz = sb ^ (((sb >> 9) & 1) << 5); R = (st >> 1) * 16 + swz / 64; C = (st & 1) * 32 + (swz % 64) / 2; }
__host__ __device__ __forceinline__ int perm32(int rho) { const int n = rho >> 4, i = rho & 15; return 8 * (i >> 2) + 4 * n + (i & 3); }

struct Unit { int pm, pn; };
struct Gemm { const bf16_t* A; const bf16_t* Bt; int M, N, K; };

struct StaticOrder {
    int nM, nN, nwg, G, c;
    __host__ __device__ void init(int M, int N, int G_, int c_) { nM = M / BM; nN = N / BM; nwg = nM * nN; G = G_; c = c_; }
    __host__ __device__ bool next(int i, Unit& u) const {
        const long L = (long)i * G + c; if (L >= nwg) return false;
        int wgid = (int)L; { const int q = nwg / NXCD, r = nwg % NXCD, xcd = wgid % NXCD, off = wgid / NXCD; wgid = (xcd < r ? xcd * (q + 1) : r * (q + 1) + (xcd - r) * q) + off; }
        const int nig = WGM * nN, gid = wgid / nig, fm = gid * WGM, gsz = (nM - fm) < WGM ? (nM - fm) : WGM;
        u.pm = fm + ((wgid % nig) % gsz); u.pn = (wgid % nig) / gsz; return true;
    }
    __device__ __forceinline__ void a_ready(const Unit&) const {}
    __device__ __forceinline__ void done(const Unit&) const {}
};

__device__ __forceinline__ unsigned cvt_pk_bf16(float lo, float hi) { return ::pk_bf16(lo, hi); }
struct EpiBf16 {
    static constexpr bool PERM = true, AFTER_DRAIN = false;
    bf16_t* O; int ldc;
    __device__ __forceinline__ void operator()(const f32x4 (&acc)[2][2][4][2], const Unit& u, int wr, int wc, int fr, int fq) const {
        const int row0 = u.pm * BM + wr * 64 + fr; const int col0 = u.pn * BM + wc * 32 + 8 * fq;
#pragma unroll
        for (int ai = 0; ai < 2; ++ai)
#pragma unroll
            for (int m = 0; m < 4; ++m) { bf16_t* rowp = O + (size_t)(row0 + ai * HALF + m * 16) * ldc + col0;
#pragma unroll
                for (int bj = 0; bj < 2; ++bj) { const f32x4 v0 = acc[ai][bj][m][0], v1 = acc[ai][bj][m][1];
                    u32x4 w; w.x = cvt_pk_bf16(v0[0], v0[1]); w.y = cvt_pk_bf16(v0[2], v0[3]); w.z = cvt_pk_bf16(v1[0], v1[1]); w.w = cvt_pk_bf16(v1[2], v1[3]);
                    *(u32x4*)(rowp + bj * HALF) = w; } }
    }
};
struct EpiResid {
    static constexpr bool PERM = false, AFTER_DRAIN = false;
    const float* xi_lat; const float* xi_ctx; float* xo_lat; float* xo_ctx; const float* gate;
    __device__ __forceinline__ void operator()(const f32x4 (&acc)[2][2][4][2], const Unit& u, int wr, int wc, int fr, int fq) const {
        const bool isctx = u.pm >= 64; const int v = isctx ? 4 : (u.pm >> 4);
        const int row0 = (isctx ? (u.pm - 64) : u.pm) * BM + wr * 64 + fr, col0 = u.pn * BM + wc * 32 + 4 * fq;
        const float* xi = isctx ? xi_ctx : xi_lat; float* xo = isctx ? xo_ctx : xo_lat;
        const float* gp = gate + (size_t)v * 12288 + col0;
        f32x4 gv[2][2];
#pragma unroll
        for (int bj = 0; bj < 2; ++bj)
#pragma unroll
            for (int n = 0; n < 2; ++n) gv[bj][n] = *(const f32x4*)(gp + bj * HALF + n * 16);
#pragma unroll
        for (int ai = 0; ai < 2; ++ai)
#pragma unroll
            for (int m = 0; m < 4; ++m) { const size_t off = (size_t)(row0 + ai * HALF + m * 16) * 2048 + col0;
#pragma unroll
                for (int bj = 0; bj < 2; ++bj)
#pragma unroll
                    for (int n = 0; n < 2; ++n) { const f32x4 xv = *(const f32x4*)(xi + off + bj * HALF + n * 16);
                        *(f32x4*)(xo + off + bj * HALF + n * 16) = xv + gv[bj][n] * acc[ai][bj][m][n]; }
                asm volatile("" ::: "memory"); }
    }
};

template <class Epi, class Sched>
__device__ __forceinline__ void gemm_phase(PG8_LAS unsigned char* lds, const Gemm g, const Sched& S, const Epi& E, const int tid) {
    const int wid = __builtin_amdgcn_readfirstlane(tid >> 6), lane = tid & 63, wr = wid >> 2, wc = wid & 3, fr = lane & 15, fq = lane >> 4;
    const int K = g.K, nt = K / BK;
    unsigned voffA[2], voffB[2];
#pragma unroll
    for (int i = 0; i < 2; ++i) { int R, C; stage_rc(tid * 16 + i * 8192, R, C); const int Rb = Epi::PERM ? ((R & ~31) + perm32(R & 31)) : R;
        voffA[i] = (unsigned)(R * K + C) * 2u; voffB[i] = (unsigned)(Rb * K + C) * 2u; }
    const size_t kstep = (size_t)(BK * 2);
    const size_t hstep = (size_t)HALF * K * 2;
    const size_t tstep = 2 * hstep;
    const unsigned ldsw = (unsigned)wid * 1024u;
    const int aoff = lds_byte(wr * 64 + fr, fq * 8), boff = lds_byte(wc * 32 + fr, fq * 8);
#define PG8_SA(b, h) (((b) * 2 + (h)) * HTB)
#define PG8_SB(b, h) ((4 + (b) * 2 + (h)) * HTB)
#define PG8_STAGE(bufoff, gbase, voff) do { _Pragma("unroll") for (int _i = 0; _i < 2; ++_i) \
        __builtin_amdgcn_global_load_lds((const unsigned*)((const char*)(gbase) + (voff)[_i]), (PG8_LAS unsigned*)(lds + (bufoff) + ldsw + _i * 8192), 16, 0, 0); } while (0)
#define PG8_LDA(dst, b, h) do { _Pragma("unroll") for (int m = 0; m < 4; ++m) _Pragma("unroll") for (int k = 0; k < 2; ++k) dst[m][k] = *(const PG8_LAS bf16x8*)(lds + PG8_SA(b, h) + aoff + m * 2048 + k * 1024); } while (0)
#define PG8_LDB(dst, b, h) do { _Pragma("unroll") for (int n = 0; n < 2; ++n) _Pragma("unroll") for (int k = 0; k < 2; ++k) dst[n][k] = *(const PG8_LAS bf16x8*)(lds + PG8_SB(b, h) + boff + n * 2048 + k * 1024); } while (0)
#define PG8_MMA(ai, bj, At, Bt) do { __builtin_amdgcn_s_setprio(1); _Pragma("unroll") for (int m = 0; m < 4; ++m) _Pragma("unroll") for (int n = 0; n < 2; ++n) _Pragma("unroll") for (int k = 0; k < 2; ++k) \
        acc[ai][bj][m][n] = __builtin_amdgcn_mfma_f32_16x16x32_bf16(Bt[n][k], At[m][k], acc[ai][bj][m][n], 0, 0, 0); __builtin_amdgcn_s_setprio(0); } while (0)
#define PG8_WAIT_V(n) asm volatile("s_waitcnt vmcnt(" #n ")" ::: "memory")
#define PG8_WAIT_L(n) asm volatile("s_waitcnt lgkmcnt(" #n ")" ::: "memory")
#define PG8_BAR __builtin_amdgcn_s_barrier()
#define PG8_SCHED __builtin_amdgcn_sched_barrier(0)
    Unit cur, nxt; int ui = 0;
    if (!S.next(0, cur)) return;
    f32x4 acc[2][2][4][2];
#pragma unroll
    for (int a = 0; a < 2; ++a)
#pragma unroll
        for (int b = 0; b < 2; ++b)
#pragma unroll
            for (int m = 0; m < 4; ++m)
#pragma unroll
                for (int n = 0; n < 2; ++n) acc[a][b][m][n] = (f32x4){0.f, 0.f, 0.f, 0.f};
    bf16x8 At[4][2], B0[2][2], B1[2][2];
    const char* cA = (const char*)g.A + (size_t)cur.pm * tstep; const char* cB = (const char*)g.Bt + (size_t)cur.pn * tstep;
    S.a_ready(cur);
    PG8_STAGE(PG8_SB(0, 0), cB, voffB); PG8_STAGE(PG8_SA(0, 0), cA, voffA); PG8_STAGE(PG8_SB(0, 1), cB + hstep, voffB); PG8_STAGE(PG8_SA(0, 1), cA + hstep, voffA);
    if (wr == 1) PG8_BAR;
    PG8_WAIT_V(4); PG8_BAR;
    PG8_STAGE(PG8_SB(1, 0), cB + kstep, voffB); PG8_STAGE(PG8_SA(1, 0), cA + kstep, voffA); PG8_STAGE(PG8_SB(1, 1), cB + hstep + kstep, voffB);
    PG8_WAIT_V(6); PG8_BAR;
    for (;;) {
        const bool has_next = S.next(ui + 1, nxt);
        const char* nA = has_next ? (const char*)g.A + (size_t)nxt.pm * tstep : cA; const char* nB = has_next ? (const char*)g.Bt + (size_t)nxt.pn * tstep : cB;
        for (int t = 0; t < nt; t += 2) {
            const bool last = (t == nt - 2);
            const char* a1 = cA + (size_t)(t + 1) * kstep;
            const char* a2 = last ? nA : cA + (size_t)(t + 2) * kstep; const char* b2 = last ? nB : cB + (size_t)(t + 2) * kstep;
            const char* a3 = a2 + kstep; const char* b3 = b2 + kstep;
            if (last && has_next) S.a_ready(nxt);
            PG8_LDB(B0, 0, 0); PG8_SCHED; PG8_LDA(At, 0, 0); PG8_STAGE(PG8_SA(1, 1), a1 + hstep, voffA);
            PG8_WAIT_L(8); PG8_BAR; PG8_WAIT_L(0); PG8_MMA(0, 0, At, B0); PG8_BAR; PG8_SCHED;
            PG8_LDB(B1, 0, 1); PG8_STAGE(PG8_SB(0, 0), b2, voffB);
            PG8_BAR; PG8_WAIT_L(0); PG8_MMA(0, 1, At, B1); PG8_BAR;
            PG8_LDA(At, 0, 1); PG8_STAGE(PG8_SA(0, 0), a2, voffA);
            PG8_BAR; PG8_WAIT_L(0); PG8_MMA(1, 0, At, B0); PG8_BAR; PG8_SCHED;
            PG8_STAGE(PG8_SB(0, 1), b2 + hstep, voffB);
            PG8_WAIT_V(6); PG8_BAR; PG8_MMA(1, 1, At, B1); PG8_BAR;
            PG8_LDB(B0, 1, 0); PG8_SCHED; PG8_LDA(At, 1, 0); PG8_STAGE(PG8_SA(0, 1), a2 + hstep, voffA);
            PG8_WAIT_L(8); PG8_BAR; PG8_WAIT_L(0); PG8_MMA(0, 0, At, B0); PG8_BAR; PG8_SCHED;
            PG8_LDB(B1, 1, 1); PG8_STAGE(PG8_SB(1, 0), b3, voffB);
            PG8_BAR; PG8_WAIT_L(0); PG8_MMA(0, 1, At, B1); PG8_BAR;
            PG8_LDA(At, 1, 1); PG8_STAGE(PG8_SA(1, 0), a3, voffA);
            PG8_BAR; PG8_WAIT_L(0); PG8_MMA(1, 0, At, B0); PG8_BAR; PG8_SCHED;
            PG8_STAGE(PG8_SB(1, 1), b3 + hstep, voffB);
            PG8_WAIT_V(6); PG8_BAR; PG8_MMA(1, 1, At, B1); PG8_BAR;
        }
        if constexpr (!Epi::AFTER_DRAIN) { E(acc, cur, wr, wc, fr, fq); S.done(cur); }
        if (!has_next) break;
#pragma unroll
        for (int a = 0; a < 2; ++a)
#pragma unroll
            for (int b = 0; b < 2; ++b)
#pragma unroll
                for (int m = 0; m < 4; ++m)
#pragma unroll
                    for (int n = 0; n < 2; ++n) acc[a][b][m][n] = (f32x4){0.f, 0.f, 0.f, 0.f};
        cur = nxt; cA = nA; cB = nB; ++ui;
    }
    PG8_WAIT_V(0);
    if (wr == 0) PG8_BAR;
    PG8_BAR;
    if constexpr (Epi::AFTER_DRAIN) { E.fused(acc, cur, wr, wc, fr, fq, lds, wid, lane); S.done(cur); }
#undef PG8_SA
#undef PG8_SB
#undef PG8_STAGE
#undef PG8_LDA
#undef PG8_LDB
#undef PG8_MMA
#undef PG8_WAIT_V
#undef PG8_WAIT_L
#undef PG8_BAR
#undef PG8_SCHED
}
}

#define XB_TMO      128
#define XB_XCNT(j)  (256  + 64 * (j))
#define XB_XSUB(j)  (1280 + 64 * (j))
#define XB_XGEN(j)  (2304 + 64 * (j))
#define XB_TOP      3328
#define XB_TOPGEN   3392
#define XCD_BAR_WORDS 3456
#define XB_SPIN_CAP (1u << 18)
#define LAS __attribute__((address_space(3)))

__device__ __forceinline__ unsigned xb_ld(unsigned* p)              { return __hip_atomic_load(p, __ATOMIC_RELAXED, __HIP_MEMORY_SCOPE_AGENT); }
__device__ __forceinline__ unsigned xb_add(unsigned* p, unsigned v) { return __hip_atomic_fetch_add(p, v, __ATOMIC_RELAXED, __HIP_MEMORY_SCOPE_AGENT); }
__device__ __forceinline__ unsigned xb_xcc_id() { return (unsigned)__builtin_amdgcn_s_getreg((3 << 11) | 20) & 0xFu; }
#define XB_SPIN(cond, bar) do { unsigned _sp = 0; while (cond) { __builtin_amdgcn_s_sleep(1); \
    if ((++_sp & 255u) == 0u) { if (xb_ld(&(bar)[XB_TMO])) break; if (_sp > XB_SPIN_CAP) { atomicAdd(&(bar)[XB_TMO], 1u); break; } } } } while (0)

struct XcdBarrier {
    unsigned* bar; unsigned x;
    volatile LAS unsigned* st;
};

__device__ __forceinline__ XcdBarrier xcd_barrier_post(unsigned* bar, volatile LAS unsigned* st) {
    XcdBarrier b; b.bar = bar; b.x = xb_xcc_id(); b.st = st;
    if (threadIdx.x == 0) (void)xb_add(&bar[XB_XCNT(b.x)], 1u);
    return b;
}
__device__ __forceinline__ void xcd_barrier_complete(unsigned* bar, unsigned x, unsigned& nloc, unsigned& nx) {
    const unsigned G = gridDim.x * gridDim.y * gridDim.z;
    unsigned sum, cnt, mine, sp = 0u;
    for (;;) {
        sum = 0u; cnt = 0u; mine = 0u;
#pragma unroll
        for (unsigned j = 0; j < 16; ++j) { const unsigned c = xb_ld(&bar[XB_XCNT(j)]); sum += c; cnt += (c > 0u) ? 1u : 0u; mine = (j == x) ? c : mine; }
        if (sum == G) break;
        __builtin_amdgcn_s_sleep(1);
        if ((++sp & 255u) == 0u) { if (xb_ld(&bar[XB_TMO])) break; if (sp > XB_SPIN_CAP) { atomicAdd(&bar[XB_TMO], 1u); break; } }
    }
    nloc = mine > 0u ? mine : 1u; nx = cnt > 0u ? cnt : 1u;
}

__device__ __forceinline__ void xcd_barrier(const XcdBarrier& b) {
    asm volatile("s_waitcnt vmcnt(0)" ::: "memory");
    __syncthreads();
    if (threadIdx.x == 0) {
        unsigned* bar = b.bar;
        __builtin_amdgcn_s_waitcnt(0);
        unsigned nloc = b.st[0], nx = b.st[1];
        if (nloc == 0u) { xcd_barrier_complete(bar, b.x, nloc, nx); b.st[0] = nloc; b.st[1] = nx; }
        const unsigned old = xb_add(&bar[XB_XSUB(b.x)], 1u);
        const unsigned gen = old / nloc;
        if (old + 1u == (gen + 1u) * nloc) {
            __builtin_amdgcn_fence(__ATOMIC_RELEASE, "agent");
            asm volatile("s_waitcnt vmcnt(0)" ::: "memory");
            const unsigned og = xb_add(&bar[XB_TOP], 1u);
            const unsigned tg = og / nx;
            if (og + 1u == (tg + 1u) * nx) xb_add(&bar[XB_TOPGEN], 1u);
            else XB_SPIN(xb_ld(&bar[XB_TOPGEN]) == tg, bar);
            __builtin_amdgcn_fence(__ATOMIC_ACQUIRE, "agent");
            xb_add(&bar[XB_XGEN(b.x)], 1u);
            asm volatile("s_waitcnt vmcnt(0)" ::: "memory");
        } else {
            XB_SPIN(xb_ld(&bar[XB_XGEN(b.x)]) == gen, bar);
            __builtin_amdgcn_fence(__ATOMIC_ACQUIRE, "agent");
            asm volatile("s_waitcnt vmcnt(0)" ::: "memory");
        }
    }
    __syncthreads();
}

typedef const float* cfp_t;
typedef __attribute__((address_space(4))) const cfp_t* ka_t;
struct Ctx {
    LAS unsigned char* lds; int tid, lane, wave, bid, G;
};

__device__ __forceinline__ void task_ada(const Ctx& F, const float* c, const float* c_ctx, const float* w_ada, float* modp, int task) {
    LAS float* s_act = (LAS float*)F.lds;
    const int l = task / (KSPL * 6), rem = task % (KSPL * 6), ks = rem / 6, cc = rem % 6;
    __syncthreads();
    if (F.tid < 320) { const int v = F.tid >> 6, k = ks * 64 + (F.tid & 63); const float x = v < 4 ? c[v * 2048 + k] : c_ctx[k]; s_act[F.tid] = siluf_(x); }
    __syncthreads();
    const int col4 = cc * 512 + F.tid;
    const float4* wp = (const float4*)(w_ada + ((size_t)l * 2048 + ks * 64) * 12288) + col4;
    float4 acc[5];
#pragma unroll
    for (int v = 0; v < 5; ++v) acc[v] = make_float4(0.f, 0.f, 0.f, 0.f);
#pragma unroll 8
    for (int k = 0; k < 64; ++k) {
        const float4 w = wp[(size_t)k * 3072];
#pragma unroll
        for (int v = 0; v < 5; ++v) { const float a = s_act[v * 64 + k]; acc[v].x += a * w.x; acc[v].y += a * w.y; acc[v].z += a * w.z; acc[v].w += a * w.w; }
    }
#pragma unroll
    for (int v = 0; v < 5; ++v) ((float4*)(modp + (((size_t)ks * 2 + l) * 5 + v) * 12288))[col4] = acc[v];
}
__device__ __forceinline__ void task_wt(const Ctx& F, const float* W, int N, bf16_t* Wt, int ntile) {
    LAS bf16_t* T = (LAS bf16_t*)F.lds;
    const int nq = F.tid & 15, kr = F.tid >> 4, n0 = ntile * 64;
    for (int kc = 0; kc < 16; ++kc) {
        float4 v[4];
#pragma unroll
        for (int j = 0; j < 4; ++j) { const int k = kc * 128 + kr + 32 * j, n = n0 + 4 * nq;
            v[j] = (n < N) ? *(const float4*)(W + (size_t)k * N + n) : make_float4(0.f, 0.f, 0.f, 0.f); }
        __syncthreads();
#pragma unroll
        for (int j = 0; j < 4; ++j) { const int kl = kr + 32 * j;
            T[(4 * nq + 0) * 136 + kl] = f2bf(v[j].x); T[(4 * nq + 1) * 136 + kl] = f2bf(v[j].y); T[(4 * nq + 2) * 136 + kl] = f2bf(v[j].z); T[(4 * nq + 3) * 136 + kl] = f2bf(v[j].w); }
        __syncthreads();
        { const int n = F.tid >> 3, kg = F.tid & 7;
          const u32x4 a = *(LAS u32x4*)(T + n * 136 + kg * 16), b = *(LAS u32x4*)(T + n * 136 + kg * 16 + 8);
          bf16_t* dst = Wt + (size_t)(n0 + n) * 2048 + kc * 128 + kg * 16; *(u32x4*)dst = a; *(u32x4*)(dst + 8) = b; }
    }
    __syncthreads();
}
__device__ __forceinline__ void task_cvt(const Ctx& F, const float* src, bf16_t* dst, size_t off) {
#pragma unroll 4
    for (int it = 0; it < 16; ++it) { const size_t e = off + (size_t)it * 4096 + F.tid * 8;
        const float4 a = *(const float4*)(src + e), b = *(const float4*)(src + e + 4);
        u32x4 o; o.x = pk_bf16(a.x, a.y); o.y = pk_bf16(a.z, a.w); o.z = pk_bf16(b.x, b.y); o.w = pk_bf16(b.z, b.w);
        *(u32x4*)(dst + e) = o; }
}
__device__ __forceinline__ void task_cvt8(const Ctx& F, const float* src, unsigned char* dst, size_t off, float scale) {
#pragma unroll 2
    for (int it = 0; it < 8; ++it) { const size_t e = off + (size_t)it * 8192 + F.tid * 16;
        u32x4 o;
#pragma unroll
        for (int w = 0; w < 4; ++w) { const float4 a = *(const float4*)(src + e + 4 * w);
            const float x0 = fminf(fmaxf(a.x * scale, -448.f), 448.f), x1 = fminf(fmaxf(a.y * scale, -448.f), 448.f), x2 = fminf(fmaxf(a.z * scale, -448.f), 448.f), x3 = fminf(fmaxf(a.w * scale, -448.f), 448.f);
            int p = __builtin_amdgcn_cvt_pk_fp8_f32(x0, x1, 0, false); p = __builtin_amdgcn_cvt_pk_fp8_f32(x2, x3, p, true); o[w] = (unsigned)p; }
        const size_t row = e >> 11; const int col = (int)(e & 2047);
        *(u32x4*)(dst + (row >> 14) * ((size_t)16384 * 2048) + ((size_t)(col >> 7) * 16384 + (row & 16383)) * 128 + (col & 127)) = o; }
}
constexpr float PEER_U_SCALE = 64.0f;
#define PEER_CONVERT_LAYER(F, in, ws, layer, blk, nblk) do { for (int t_ = (blk); t_ < 1024; t_ += (nblk)) { const bool isv_ = t_ >= 512; \
        task_cvt8(F, in[isv_ ? I_PV : I_PU], ws + (isv_ ? WS_PV : WS_PU), (size_t)(layer) * 16384 * 2048 + (size_t)(t_ & 511) * 65536, isv_ ? 1.0f : PEER_U_SCALE); } } while (0)
__device__ __forceinline__ void task_lorat(const Ctx& F, const float* src, bf16_t* dst, int nj) {
    const int ch = F.tid;
    for (int j8 = 0; j8 < nj / 8; ++j8) { float v[8];
#pragma unroll
        for (int q = 0; q < 8; ++q) v[q] = src[(size_t)(j8 * 8 + q) * 512 + ch];
        u32x4 o; o.x = pk_bf16(v[0], v[1]); o.y = pk_bf16(v[2], v[3]); o.z = pk_bf16(v[4], v[5]); o.w = pk_bf16(v[6], v[7]);
        *(u32x4*)(dst + (size_t)ch * nj + j8 * 8) = o; }
}
constexpr int T_ADA = 2 * KSPL * 6, T_WT1 = 2 * 104, T_WT2 = 2 * 32, T_WT3 = 2 * 32, T_PEER = 0, T_KEYS = 8, T_LORA = 10;
__device__ __forceinline__ void phase_prologue(const Ctx& F, ka_t in, unsigned char* ws) {
    const int total = T_ADA + T_WT1 + T_WT2 + T_WT3 + T_PEER + T_KEYS + T_LORA + 1;
    for (int t0 = F.bid; t0 < total; t0 += F.G) {
        int t = t0;
        if (t < T_ADA) { task_ada(F, in[I_C], in[I_CCTX], in[I_WADA], (float*)(ws + WS_MODP), t); continue; } t -= T_ADA;
        if (t < T_WT1) { const int l = t / 104, nt = t % 104; task_wt(F, in[I_WIN] + (size_t)l * 2048 * PT, PT, (bf16_t*)(ws + WS_WIN) + (size_t)l * PTP * 2048, nt); continue; } t -= T_WT1;
        if (t < T_WT2) { const int l = t / 32, nt = t % 32; task_wt(F, in[I_WOUT] + (size_t)l * 2048 * 2048, 2048, (bf16_t*)(ws + WS_WOUT) + (size_t)l * 2048 * 2048, nt); continue; } t -= T_WT2;
        if (t < T_WT3) { const int l = t / 32, nt = t % 32; task_wt(F, in[I_PWQ] + (size_t)l * 2048 * 2048, 2048, (bf16_t*)(ws + WS_WQ) + (size_t)l * 2048 * 2048, nt); continue; } t -= T_WT3;
        if (t < T_PEER) { const bool isv = t >= 1024; const int c = t & 1023; task_cvt8(F, in[isv ? I_PV : I_PU], ws + (isv ? WS_PV : WS_PU), (size_t)c * 65536, isv ? 1.0f : PEER_U_SCALE); continue; } t -= T_PEER;
        if (t < T_KEYS) { task_cvt(F, in[I_PKEYS], (bf16_t*)(ws + WS_KEYS), (size_t)t * 65536); continue; } t -= T_KEYS;
        if (t < T_LORA) {
            if (t < 8) { const int l = t >> 2, wh = t & 3;
                task_lorat(F, in[wh < 2 ? I_RWUP : I_RAUP] + ((size_t)l * 2 + (wh & 1)) * 64 * 512, (bf16_t*)(ws + WS_WUPT) + ((size_t)l * 4 + wh) * 512 * 64, 64); }
            else { const int l = t - 8; task_lorat(F, in[I_RGUP] + (size_t)l * 128 * 512, (bf16_t*)(ws + WS_GUPT) + (size_t)l * 512 * 128, 128); }
            continue; } t -= T_LORA;
        { float* rope = (float*)(ws + WS_ROPE);
          for (int e = F.tid; e < 2048; e += 512) { const int pos = e >> 5, i = e & 31; const float fr = powf(10000.0f, -(float)i / 32.0f), ang = (float)pos * fr;
              rope[2 * e] = cosf(ang); rope[2 * e + 1] = sinf(ang); } }
    }
}
__device__ __forceinline__ void phase_modreduce(const Ctx& F, const float* b_ada, const float* modp, float* mod) {
    for (int idx = F.bid * 512 + F.tid; idx < 2 * 5 * 12288; idx += F.G * 512) {
        const int l = idx / 61440, rem = idx % 61440, v = rem / 12288, n = rem % 12288;
        float s = b_ada[l * 12288 + n];
        for (int ks = 0; ks < KSPL; ++ks) s += modp[(((size_t)ks * 2 + l) * 5 + v) * 12288 + n];
        mod[idx] = s;
    }
}

__device__ __forceinline__ void norm_store(const float (&x)[32], const float* gw, const float* shift, const float* scale, bf16_t* dst, int lane) {
    float ss = 0.f;
#pragma unroll
    for (int q = 0; q < 32; ++q) ss += x[q] * x[q];
    ss = wave_sum(ss);
    const float rs = rsqrtf(ss * (1.0f / 2048.0f) + 1e-6f);
#pragma unroll
    for (int j = 0; j < 4; ++j) { const int e = j * 512 + lane * 8;
        const float4 g0 = *(const float4*)(gw + e), g1 = *(const float4*)(gw + e + 4), h0 = *(const float4*)(shift + e), h1 = *(const float4*)(shift + e + 4), c0 = *(const float4*)(scale + e), c1 = *(const float4*)(scale + e + 4);
        const float y0 = x[j * 8 + 0] * rs * g0.x * (1.f + c0.x) + h0.x, y1 = x[j * 8 + 1] * rs * g0.y * (1.f + c0.y) + h0.y, y2 = x[j * 8 + 2] * rs * g0.z * (1.f + c0.z) + h0.z, y3 = x[j * 8 + 3] * rs * g0.w * (1.f + c0.w) + h0.w;
        const float y4 = x[j * 8 + 4] * rs * g1.x * (1.f + c1.x) + h1.x, y5 = x[j * 8 + 5] * rs * g1.y * (1.f + c1.y) + h1.y, y6 = x[j * 8 + 6] * rs * g1.z * (1.f + c1.z) + h1.z, y7 = x[j * 8 + 7] * rs * g1.w * (1.f + c1.w) + h1.w;
        u32x4 o; o.x = pk_bf16(y0, y1); o.y = pk_bf16(y2, y3); o.z = pk_bf16(y4, y5); o.w = pk_bf16(y6, y7);
        *(u32x4*)(dst + e) = o; }
}
__device__ __forceinline__ void phase_norm(const Ctx& F, const float* xlat, const float* xctx, const float* gw, const float* mod, int shift_i, int scale_i, bf16_t* dst, int nrows) {
    for (int row = F.bid * 8 + F.wave; row < nrows; row += F.G * 8) {
        const bool isctx = row >= NLAT; const float* xr = isctx ? xctx + (size_t)(row - NLAT) * 2048 : xlat + (size_t)row * 2048;
        const int v = isctx ? 4 : (row >> 12);
        float x[32];
#pragma unroll
        for (int j = 0; j < 4; ++j) { const int e = j * 512 + F.lane * 8; const float4 a = *(const float4*)(xr + e), b = *(const float4*)(xr + e + 4);
            x[j * 8 + 0] = a.x; x[j * 8 + 1] = a.y; x[j * 8 + 2] = a.z; x[j * 8 + 3] = a.w; x[j * 8 + 4] = b.x; x[j * 8 + 5] = b.y; x[j * 8 + 6] = b.z; x[j * 8 + 7] = b.w; }
        norm_store(x, gw, mod + (size_t)v * 12288 + shift_i * 2048, mod + (size_t)v * 12288 + scale_i * 2048, dst + (size_t)row * 2048, F.lane);
    }
}

struct LayerW {
    const float *sc_w, *rw_w0, *rw_wup, *rw_a0, *rw_aup, *rw_gup, *rw_kk, *rw_ka, *rw_rk, *rw_lnw, *rw_lnb, *na_q, *na_k, *rpb, *s_cw, *s_cb, *s_dtb, *s_alog, *s_d, *s_norm;
};
__device__ __forceinline__ void unpack8(const u32x4 q, float (&f)[8]) { f[0] = bflo(q[0]); f[1] = bfhi(q[0]); f[2] = bflo(q[1]); f[3] = bfhi(q[1]); f[4] = bflo(q[2]); f[5] = bfhi(q[2]); f[6] = bflo(q[3]); f[7] = bfhi(q[3]); }
__device__ __forceinline__ u32x4 pack8f(const float (&f)[8]) { u32x4 o; o[0] = pk_bf16(f[0], f[1]); o[1] = pk_bf16(f[2], f[3]); o[2] = pk_bf16(f[4], f[5]); o[3] = pk_bf16(f[6], f[7]); return o; }
__device__ __forceinline__ void load8f(const float* p, float (&f)[8]) { const float4 a = *(const float4*)p, b = *(const float4*)(p + 4); f[0] = a.x; f[1] = a.y; f[2] = a.z; f[3] = a.w; f[4] = b.x; f[5] = b.y; f[6] = b.z; f[7] = b.w; }
__device__ __forceinline__ void phase_prep(const Ctx& F, const LayerW& W, unsigned char* ws) {
    const bf16_t* P = (const bf16_t*)(ws + WS_P);
    bf16_t* MIX = (bf16_t*)(ws + WS_MIX);
    bf16_t* XBC = (bf16_t*)(ws + WS_XBC); float* DTS = (float*)(ws + WS_DTS); float* DEC = (float*)(ws + WS_DEC);
    bf16_t* QN = (bf16_t*)(ws + WS_QN); bf16_t* KN = (bf16_t*)(ws + WS_KN); bf16_t* VTL = (bf16_t*)(ws + WS_VTL); bf16_t* VTC = (bf16_t*)(ws + WS_VTC);
    const float* ROPE = (const float*)(ws + WS_ROPE);
    for (int tile = F.bid; tile < NTOK / 8; tile += F.G) {
        int ln = F.lane; asm volatile("" : "+v"(ln));
        const int ch0 = ln * 8;
        const bool lat = tile < NLAT / 8;
        const int b = lat ? (tile >> 9) : ((tile - NLAT / 8) >> 5);
        const int t0 = lat ? (tile & 511) * 8 : ((tile - NLAT / 8) & 31) * 8;
        const int L = lat ? SEQL : CTXL;
        const int g0 = lat ? b * SEQL + t0 : NLAT + b * CTXL + t0;
        const bf16_t* Pr = P + (size_t)g0 * PTP;
        if (F.wave == 0 || F.wave == 4) {
            const bool gated = F.wave == 0;
            const float* cw = gated ? W.sc_w : W.s_cw; const int cstride = gated ? 512 : 1024;
            float w0[8], w1[8], w2[8], cb[8];
            load8f(cw + ch0, w0); load8f(cw + cstride + ch0, w1); load8f(cw + 2 * cstride + ch0, w2);
            if (gated) {
#pragma unroll
                for (int e = 0; e < 8; ++e) cb[e] = 0.f;
            } else load8f(W.s_cb + ch0, cb);
            const int col = gated ? A_CG : D_X;
#pragma unroll 1
            for (int tb = 0; tb < 8; tb += 4) {
            u32x4 ra[6], rb[6], rg[4];
#pragma unroll
            for (int q = 0; q < 6; ++q) { const int tq = t0 + tb - 1 + q; const bool ok = (tq >= 0) && (tq < L);
                ra[q] = ok ? *(const u32x4*)(Pr + (ptrdiff_t)(tb + q - 1) * PTP + col + ch0) : (u32x4){0u, 0u, 0u, 0u};
                if (gated) rb[q] = ok ? *(const u32x4*)(Pr + (ptrdiff_t)(tb + q - 1) * PTP + A_H + ch0) : (u32x4){0u, 0u, 0u, 0u}; }
            if (gated) {
#pragma unroll
                for (int tt = 0; tt < 4; ++tt) rg[tt] = *(const u32x4*)(Pr + (size_t)(tb + tt) * PTP + A_BG + ch0); }
            float up[8], uc[8], un[8];
            { float x[8], y[8]; unpack8(ra[0], x); if (gated) { unpack8(rb[0], y);
#pragma unroll
                for (int e = 0; e < 8; ++e) x[e] *= y[e]; }
#pragma unroll
              for (int e = 0; e < 8; ++e) up[e] = x[e];
              unpack8(ra[1], x); if (gated) { unpack8(rb[1], y);
#pragma unroll
                for (int e = 0; e < 8; ++e) x[e] *= y[e]; }
#pragma unroll
              for (int e = 0; e < 8; ++e) uc[e] = x[e]; }
#pragma unroll
            for (int tt = 0; tt < 4; ++tt) {
                { float x[8], y[8]; unpack8(ra[tt + 2], x); if (gated) { unpack8(rb[tt + 2], y);
#pragma unroll
                    for (int e = 0; e < 8; ++e) x[e] *= y[e]; }
#pragma unroll
                  for (int e = 0; e < 8; ++e) un[e] = x[e]; }
                float o[8];
                if (gated) { float bg[8]; unpack8(rg[tt], bg);
#pragma unroll
                    for (int e = 0; e < 8; ++e) o[e] = bg[e] * (w0[e] * up[e] + w1[e] * uc[e] + w2[e] * un[e]);
                    *(u32x4*)(MIX + (size_t)(g0 + tb + tt) * 2048 + ch0) = pack8f(o);
                } else {
#pragma unroll
                    for (int e = 0; e < 8; ++e) o[e] = siluf_(w0[e] * up[e] + w1[e] * uc[e] + w2[e] * un[e] + cb[e]);
                    *(u32x4*)(XBC + (size_t)(g0 + tb + tt) * 1024 + ch0) = pack8f(o); }
#pragma unroll
                for (int e = 0; e < 8; ++e) { up[e] = uc[e]; uc[e] = un[e]; }
            }
            }
        } else if (F.wave == 1 || F.wave == 2) {
            const bool isq = F.wave == 1; const int col = isq ? C_Q : C_K; bf16_t* dst = isq ? QN : KN;
            float nw[8]; load8f((isq ? W.na_q : W.na_k) + (ln & 7) * 8, nw);
            const float sc = isq ? 0.125f : 1.0f;
            u32x4 rq[8];
#pragma unroll
            for (int tt = 0; tt < 8; ++tt) rq[tt] = *(const u32x4*)(Pr + (size_t)tt * PTP + col + ch0);
#pragma unroll
            for (int tt = 0; tt < 8; ++tt) { float x[8]; unpack8(rq[tt], x); float ss = 0.f;
#pragma unroll
                for (int e = 0; e < 8; ++e) ss += x[e] * x[e];
                ss = sum8(ss); const float rs = rsqrtf(ss * (1.f / 64.f) + 1e-6f) * sc;
#pragma unroll
                for (int e = 0; e < 8; ++e) x[e] = x[e] * rs * nw[e];
                if (isq) *(u32x4*)(dst + (size_t)(g0 + tt) * 512 + ch0) = pack8f(x);
                else {
                    const int hh = ln >> 3, p = ln & 7, t = t0 + tt;
                    bf16_t* kd = lat ? dst + ((size_t)((((b * 8 + hh) * 64 + (t >> 6)) * 2 + (p >> 2)) * 4 + (p & 3)) * 64 + (t & 63)) * 8
                                     : dst + (size_t)NLAT * 512 + ((size_t)(((b * 8 + hh) * 2 + (p >> 2)) * 4 + (p & 3)) * 256 + t) * 8;
                    *(u32x4*)kd = pack8f(x); } }
        } else if (F.wave == 3) {
            u32x4 rv[8];
#pragma unroll
            for (int tt = 0; tt < 8; ++tt) rv[tt] = *(const u32x4*)(Pr + (size_t)tt * PTP + C_V + ch0);
            const int h = ln >> 3;
#pragma unroll
            for (int e = 0; e < 8; ++e) { const int i = (ln & 7) * 8 + e;
                unsigned short v[8];
#pragma unroll
                for (int tt = 0; tt < 8; ++tt) v[tt] = (unsigned short)((e & 1) ? (rv[tt][e >> 1] >> 16) : (rv[tt][e >> 1] & 0xffffu));
                u32x2 c0; c0.x = (unsigned)v[0] | ((unsigned)v[1] << 16); c0.y = (unsigned)v[2] | ((unsigned)v[3] << 16);
                u32x2 c1; c1.x = (unsigned)v[4] | ((unsigned)v[5] << 16); c1.y = (unsigned)v[6] | ((unsigned)v[7] << 16);
                if (lat) { const int row = t0 >> 6, x0 = (t0 & 63) >> 2, x1 = x0 + 1;
                    bf16_t* base = VTL + ((size_t)((b * 8 + h) * 64 + row) * 12 * 64 + i) * 8;
                    if (x0 <= 11) *(u32x2*)(base + x0 * 512) = c0;
                    if (x0 >= 4)  *(u32x2*)(base + (x0 - 4) * 512 + 4) = c0;
                    if (x1 <= 11) *(u32x2*)(base + x1 * 512) = c1;
                    if (x1 >= 4)  *(u32x2*)(base + (x1 - 4) * 512 + 4) = c1;
                } else { const int m = t0 >> 5, o = t0 & 31, gq = (o & 15) >> 2, hf = (o >> 4) * 4;
                    bf16_t* base = VTC + ((size_t)(((b * 8 + h) * 8 + m) * 4) * 64 + i) * 8;
                    *(u32x2*)(base + gq * 512 + hf) = c0; *(u32x2*)(base + (gq + 1) * 512 + hf) = c1; } }
        } else if (F.wave == 5 || F.wave == 7) {
            {
                const int pg = ln & 15, tb = (ln >> 4) * 2, which = F.wave == 7 ? 1 : 0, gi = (pg >> 3) & 1, half = (pg >> 2) & 1, i0 = (pg & 3) * 8;
                const int c1 = 512 + which * 256 + gi * 128 + half * 64 + i0, c2 = c1 + 32;
                float wa0[8], wa1[8], wa2[8], ba[8], wb0[8], wb1[8], wb2[8], bb[8];
                load8f(W.s_cw + c1, wa0); load8f(W.s_cw + 1024 + c1, wa1); load8f(W.s_cw + 2048 + c1, wa2); load8f(W.s_cb + c1, ba);
                load8f(W.s_cw + c2, wb0); load8f(W.s_cw + 1024 + c2, wb1); load8f(W.s_cw + 2048 + c2, wb2); load8f(W.s_cb + c2, bb);
                u32x4 ra[4], rb[4];
#pragma unroll
                for (int q = 0; q < 4; ++q) { const int tq = t0 + tb - 1 + q; const bool ok = (tq >= 0) && (tq < L);
                    ra[q] = ok ? *(const u32x4*)(Pr + (ptrdiff_t)(tb + q - 1) * PTP + D_X + c1) : (u32x4){0u, 0u, 0u, 0u};
                    rb[q] = ok ? *(const u32x4*)(Pr + (ptrdiff_t)(tb + q - 1) * PTP + D_X + c2) : (u32x4){0u, 0u, 0u, 0u}; }
                float ap[8], ac[8], an[8], bp[8], bc[8], bn[8];
                unpack8(ra[0], ap); unpack8(ra[1], ac); unpack8(rb[0], bp); unpack8(rb[1], bc);
#pragma unroll
                for (int tt = 0; tt < 2; ++tt) { unpack8(ra[tt + 2], an); unpack8(rb[tt + 2], bn);
                    float y1[8], y2[8];
#pragma unroll
                    for (int e = 0; e < 8; ++e) { y1[e] = siluf_(wa0[e] * ap[e] + wa1[e] * ac[e] + wa2[e] * an[e] + ba[e]); y2[e] = siluf_(wb0[e] * bp[e] + wb1[e] * bc[e] + wb2[e] * bn[e] + bb[e]); }
                    if (lat) { const int t = t0 + tb + tt, pos = half ? (t & 63) : (t >> 6);
                        float cs[16];
#pragma unroll
                        for (int q = 0; q < 4; ++q) { const float4 v = *(const float4*)(ROPE + (size_t)(pos * 32 + i0) * 2 + 4 * q); cs[4 * q] = v.x; cs[4 * q + 1] = v.y; cs[4 * q + 2] = v.z; cs[4 * q + 3] = v.w; }
#pragma unroll
                        for (int e = 0; e < 8; ++e) { const float o1 = y1[e] * cs[2 * e] - y2[e] * cs[2 * e + 1], o2 = y1[e] * cs[2 * e + 1] + y2[e] * cs[2 * e]; y1[e] = o1; y2[e] = o2; } }
                    *(u32x4*)(XBC + (size_t)(g0 + tb + tt) * 1024 + c1) = pack8f(y1); *(u32x4*)(XBC + (size_t)(g0 + tb + tt) * 1024 + c2) = pack8f(y2);
#pragma unroll
                    for (int e = 0; e < 8; ++e) { ap[e] = ac[e]; ac[e] = an[e]; bp[e] = bc[e]; bc[e] = bn[e]; }
                }
            }
        } else if (F.wave == 6) {
#pragma unroll
            for (int q = 0; q < 2; ++q) { const int it = ln + 64 * q, tt = it >> 4, j = it & 15;
                const float x = bf2f(Pr[(size_t)tt * PTP + D_DT + j]) + W.s_dtb[j];
                const float sp = fmaxf(x, 0.f) + log1pf(__expf(-fabsf(x)));
                DTS[(size_t)(g0 + tt) * 16 + j] = sp; DEC[(size_t)(g0 + tt) * 16 + j] = -sp * __expf(W.s_alog[j]); }
        }
    }
}

constexpr int SB_PITCH = 136;
__device__ __forceinline__ void ssd_scan_L(const Ctx& F, LAS float* sL, const float* LA, int g0, int h) {
    const int d = (F.tid >> 7) & 1, t = F.tid & 127;
    float v = 0.f;
    if (F.tid < 256) { v = LA[(size_t)(g0 + t) * 16 + d * 8 + h]; sL[F.tid] = v; }
    __syncthreads();
#pragma unroll
    for (int off = 1; off < 128; off <<= 1) {
        float o = 0.f;
        if (F.tid < 256) { const int tp = d ? t + off : t - off; if (tp >= 0 && tp < 128) o = sL[d * 128 + tp]; }
        __syncthreads();
        if (F.tid < 256) { v += o; sL[F.tid] = v; }
        __syncthreads();
    }
}
template <bool PASS2>
__device__ __forceinline__ void ssd_task(const Ctx& F, const LayerW& W, unsigned char* ws, int task) {
    const bf16_t* XBC = (const bf16_t*)(ws + WS_XBC); const float* DTS = (const float*)(ws + WS_DTS); const float* LA = (const float*)(ws + WS_DEC);
    float* SST = (float*)(ws + WS_SST); float* SCD = (float*)(ws + WS_SCD); float* YS = (float*)(ws + WS_YS);
    const int c = task % NCH, bh = task / NCH, h = bh & 7, b = bh >> 3, gi = h >> 2;
    const int g0 = c < 2 ? NLAT + b * CTXL + c * 128 : b * SEQL + (c - 2) * 128;
    const int w = F.wave, l16 = F.lane & 15, g = F.lane >> 4;
    const f32x4 z4 = {0.f, 0.f, 0.f, 0.f};
    LAS float* sL = (LAS float*)(F.lds + 131072);
    LAS float* sDT = sL + 256;
    __syncthreads();
    if (F.tid < 256) { const int s = F.tid >> 1, d = F.tid & 1; sDT[F.tid] = DTS[(size_t)(g0 + s) * 16 + d * 8 + h]; }
    ssd_scan_L(F, sL, LA, g0, h);
    if (!PASS2) {
        LAS bf16_t* sBT = (LAS bf16_t*)F.lds;
        LAS bf16_t* sXT = sBT + 128 * SB_PITCH;
#pragma unroll
        for (int q = 0; q < 4; ++q) { const int v = F.tid + 512 * q, s = v >> 4, part = v & 15;
            const u32x4 bv = *(const u32x4*)(XBC + (size_t)(g0 + s) * 1024 + 512 + gi * 128 + part * 8);
#pragma unroll
            for (int e = 0; e < 4; ++e) { sBT[(part * 8 + 2 * e) * SB_PITCH + s] = (bf16_t)(bv[e] & 0xffffu); sBT[(part * 8 + 2 * e + 1) * SB_PITCH + s] = (bf16_t)(bv[e] >> 16); } }
#pragma unroll
        for (int q = 0; q < 2; ++q) { const int v = F.tid + 512 * q, s = v >> 3, part = v & 7;
            const u32x4 xv = *(const u32x4*)(XBC + (size_t)(g0 + s) * 1024 + h * 64 + part * 8);
            const float sc0 = sDT[s * 2] * __expf(sL[127] - sL[s]), sc1 = sDT[s * 2 + 1] * __expf(sL[128] - sL[128 + s]);
#pragma unroll
            for (int e = 0; e < 4; ++e) { const float lo = bflo(xv[e]), hi = bfhi(xv[e]); const int p = part * 8 + 2 * e;
                sXT[p * SB_PITCH + s] = f2bf(lo * sc0); sXT[(p + 1) * SB_PITCH + s] = f2bf(hi * sc0);
                sXT[(64 + p) * SB_PITCH + s] = f2bf(lo * sc1); sXT[(64 + p + 1) * SB_PITCH + s] = f2bf(hi * sc1); } }
        __syncthreads();
        bf16x8 bfr[4];
#pragma unroll
        for (int ks = 0; ks < 4; ++ks) bfr[ks] = *(const LAS bf16x8*)(sBT + (16 * w + l16) * SB_PITCH + 32 * ks + 8 * g);
#pragma unroll
        for (int d = 0; d < 2; ++d) {
            float* st = SST + ((size_t)((b * 8 + h) * 2 + d) * NCH + c) * 8192;
#pragma unroll
            for (int pt = 0; pt < 4; ++pt) { f32x4 acc = z4;
#pragma unroll
                for (int ks = 0; ks < 4; ++ks) acc = __builtin_amdgcn_mfma_f32_16x16x32_bf16(*(const LAS bf16x8*)(sXT + (d * 64 + 16 * pt + l16) * SB_PITCH + 32 * ks + 8 * g), bfr[ks], acc, 0, 0, 0);
#pragma unroll
                for (int r = 0; r < 4; ++r) st[(16 * pt + 4 * g + r) * 128 + 16 * w + l16] = acc[r]; }
            if (F.tid == 0) SCD[((b * 8 + h) * 2 + d) * NCH + c] = __expf(d ? sL[128] : sL[127]);
        }
    } else {
        LAS bf16_t* sB = (LAS bf16_t*)F.lds;
        LAS bf16_t* sC = sB + 128 * SB_PITCH;
        LAS bf16_t* sXT = sC + 128 * SB_PITCH;
        LAS bf16_t* sS = sXT + 64 * SB_PITCH;
#pragma unroll
        for (int q = 0; q < 4; ++q) { const int v = F.tid + 512 * q, s = v >> 4, part = v & 15;
            *(LAS u32x4*)(sB + s * SB_PITCH + part * 8) = *(const u32x4*)(XBC + (size_t)(g0 + s) * 1024 + 512 + gi * 128 + part * 8);
            *(LAS u32x4*)(sC + s * SB_PITCH + part * 8) = *(const u32x4*)(XBC + (size_t)(g0 + s) * 1024 + 768 + gi * 128 + part * 8); }
#pragma unroll
        for (int q = 0; q < 2; ++q) { const int v = F.tid + 512 * q, s = v >> 3, part = v & 7;
            const u32x4 xv = *(const u32x4*)(XBC + (size_t)(g0 + s) * 1024 + h * 64 + part * 8);
#pragma unroll
            for (int e = 0; e < 4; ++e) { sXT[(part * 8 + 2 * e) * SB_PITCH + s] = (bf16_t)(xv[e] & 0xffffu); sXT[(part * 8 + 2 * e + 1) * SB_PITCH + s] = (bf16_t)(xv[e] >> 16); } }
#pragma unroll
        for (int q = 0; q < 4; ++q) { const int v = F.tid + 512 * q, d = v >> 10, p = (v >> 4) & 63, part = v & 15;
            const float* sp = SST + ((size_t)((b * 8 + h) * 2 + d) * NCH + c) * 8192 + p * 128 + part * 8;
            const float4 a0 = *(const float4*)sp, a1 = *(const float4*)(sp + 4);
            u32x4 o; o.x = pk_bf16(a0.x, a0.y); o.y = pk_bf16(a0.z, a0.w); o.z = pk_bf16(a1.x, a1.y); o.w = pk_bf16(a1.z, a1.w);
            *(LAS u32x4*)(sS + (d * 64 + p) * SB_PITCH + part * 8) = o; }
        __syncthreads();
        const int t = 16 * w + l16;
        bf16x8 cfr[4];
#pragma unroll
        for (int ks = 0; ks < 4; ++ks) cfr[ks] = *(const LAS bf16x8*)(sC + t * SB_PITCH + 32 * ks + 8 * g);
        f32x4 gt[8];
#pragma unroll
        for (int a = 0; a < 8; ++a) { f32x4 acc = z4;
#pragma unroll
            for (int ks = 0; ks < 4; ++ks) acc = __builtin_amdgcn_mfma_f32_16x16x32_bf16(*(const LAS bf16x8*)(sB + (16 * a + l16) * SB_PITCH + 32 * ks + 8 * g), cfr[ks], acc, 0, 0, 0);
            gt[a] = acc; }
        f32x4 ysum[4] = {z4, z4, z4, z4};
#pragma unroll
        for (int d = 0; d < 2; ++d) {
            const float Lt = sL[d * 128 + t], eLt = __expf(Lt);
            f32x4 acc[4];
#pragma unroll
            for (int pt = 0; pt < 4; ++pt) { f32x4 a = z4;
#pragma unroll
                for (int ks = 0; ks < 4; ++ks) a = __builtin_amdgcn_mfma_f32_16x16x32_bf16(*(const LAS bf16x8*)(sS + (d * 64 + 16 * pt + l16) * SB_PITCH + 32 * ks + 8 * g), cfr[ks], a, 0, 0, 0);
                acc[pt] = a * eLt; }
#pragma unroll
            for (int m = 0; m < 4; ++m) {
                const bool need = d ? (2 * m + 1 >= w) : (2 * m <= w);
                if (need) {
                    f32x4 wt[2];
#pragma unroll
                    for (int u = 0; u < 2; ++u) { const int a = 2 * m + u;
                        const f32x4 Ls = *(const LAS f32x4*)(sL + d * 128 + 16 * a + 4 * g);
#pragma unroll
                        for (int r = 0; r < 4; ++r) { const int s = 16 * a + 4 * g + r; const bool ok = d ? (s >= t) : (s <= t);
                            const float dts = sDT[s * 2 + d];
                            wt[u][r] = ok ? gt[a][r] * __expf(Lt - Ls[r]) * dts : 0.f; } }
                    const bf16x8 bfrag = pack8(wt[0], wt[1]);
#pragma unroll
                    for (int pt = 0; pt < 4; ++pt) { union { bf16x8 v; u32x2 hh[2]; } af;
                        af.hh[0] = *(const LAS u32x2*)(sXT + (16 * pt + l16) * SB_PITCH + 32 * m + 4 * g); af.hh[1] = *(const LAS u32x2*)(sXT + (16 * pt + l16) * SB_PITCH + 32 * m + 16 + 4 * g);
                        acc[pt] = __builtin_amdgcn_mfma_f32_16x16x32_bf16(af.v, bfrag, acc[pt], 0, 0, 0); }
                }
            }
#pragma unroll
            for (int pt = 0; pt < 4; ++pt) ysum[pt] = ysum[pt] + acc[pt];
        }
        const float dsk = W.s_d[h];
#pragma unroll
        for (int pt = 0; pt < 4; ++pt) { const int p = 16 * pt + 4 * g;
            const u32x2 xv = *(const u32x2*)(XBC + (size_t)(g0 + t) * 1024 + h * 64 + p);
            *(float4*)(YS + (size_t)(g0 + t) * 512 + h * 64 + p) = make_float4(ysum[pt][0] + dsk * bflo(xv.x), ysum[pt][1] + dsk * bfhi(xv.x), ysum[pt][2] + dsk * bflo(xv.y), ysum[pt][3] + dsk * bfhi(xv.y)); }
    }
}
template <int D> __device__ __forceinline__ void ssd_combine_one(float4* base, const float* scd) {
    float4 carry = make_float4(0.f, 0.f, 0.f, 0.f);
#pragma unroll
    for (int k0 = 0; k0 < NCH; k0 += 17) {
        float4 tmp[17];
#pragma unroll
        for (int k = 0; k < 17; ++k) { const int kk = k0 + k, c = D ? (kk < 2 ? 1 - kk : 35 - kk) : kk; tmp[k] = base[(size_t)c * 2048]; }
#pragma unroll
        for (int k = 0; k < 17; ++k) { const int kk = k0 + k, c = D ? (kk < 2 ? 1 - kk : 35 - kk) : kk; const float a = scd[c];
            base[(size_t)c * 2048] = carry;
            carry.x = a * carry.x + tmp[k].x; carry.y = a * carry.y + tmp[k].y; carry.z = a * carry.z + tmp[k].z; carry.w = a * carry.w + tmp[k].w; }
    }
}
__device__ __forceinline__ void phase_ssd_combine(const Ctx& F, unsigned char* ws) {
    float4* SST4 = (float4*)(ws + WS_SST); const float* SCD = (const float*)(ws + WS_SCD);
    for (int gt = F.bid * 512 + F.tid; gt < 64 * 2048; gt += F.G * 512) {
        const int sidx = gt >> 11, e4 = gt & 2047;
        float4* base = SST4 + (size_t)sidx * NCH * 2048 + e4;
        if (sidx & 1) ssd_combine_one<1>(base, SCD + sidx * NCH); else ssd_combine_one<0>(base, SCD + sidx * NCH);
    }
}

constexpr int RWF_CHUNK = 10496;
constexpr int RW_NCHUNK = NPOS / 16;
template <int CTRL> __device__ __forceinline__ float dpp_id0(float v) { return __int_as_float(__builtin_amdgcn_update_dpp(0, __float_as_int(v), CTRL, 0xF, 0xF, true)); }
template <int CTRL> __device__ __forceinline__ float dpp_id1(float v) { return __int_as_float(__builtin_amdgcn_update_dpp(0x3f800000, __float_as_int(v), CTRL, 0xF, 0xF, false)); }
__device__ __forceinline__ float sel4(int g, float a, float b, float c, float d) { return g == 0 ? a : (g == 1 ? b : (g == 2 ? c : d)); }

template <int D> __device__ __forceinline__ void rwkv_pre_dir(const bf16_t* wupt, const bf16x8 (&bw)[2], const bf16x8 (&ba)[2], const f32x4 (&kk)[4], const f32x4 (&rr)[4], const f32x4 (&kx)[4],
        const float* w0p, const float* a0p, const float* kap, const float* rkp, float& bon, LAS unsigned char* wl, unsigned char* dst, int l16, int g) {
    LAS float* LT = (LAS float*)wl; LAS float* AT = LT + 256; LAS bf16_t* BT = (LAS bf16_t*)(wl + 2048); LAS bf16_t* KT = BT + 1024;
    const int lane = g * 16 + l16;
    bf16x8* o = (bf16x8*)dst;
    const f32x4 z4 = {0.f, 0.f, 0.f, 0.f};
    bf16x8 af[2], bf[2], kf[2], rf[2];
#pragma unroll
    for (int p = 0; p < 2; ++p) {
        f32x4 al[2], be[2], ka[2], rh[2];
#pragma unroll
        for (int mm = 0; mm < 2; ++mm) { const int m = 2 * p + mm; asm volatile("" ::: "memory");
            const bf16_t* wpw = wupt + ((size_t)D * 512 + 16 * m + l16) * 64 + 8 * g; const bf16_t* wpa = wupt + ((size_t)(2 + D) * 512 + 16 * m + l16) * 64 + 8 * g;
            f32x4 aw = __builtin_amdgcn_mfma_f32_16x16x32_bf16(*(const bf16x8*)wpw, bw[0], z4, 0, 0, 0); aw = __builtin_amdgcn_mfma_f32_16x16x32_bf16(*(const bf16x8*)(wpw + 32), bw[1], aw, 0, 0, 0);
            f32x4 aa = __builtin_amdgcn_mfma_f32_16x16x32_bf16(*(const bf16x8*)wpa, ba[0], z4, 0, 0, 0); aa = __builtin_amdgcn_mfma_f32_16x16x32_bf16(*(const bf16x8*)(wpa + 32), ba[1], aa, 0, 0, 0);
            const float4 w0 = *(const float4*)(w0p + 16 * m + 4 * g), a0 = *(const float4*)(a0p + 16 * m + 4 * g), kav = *(const float4*)(kap + 16 * m + 4 * g), rkv = *(const float4*)(rkp + 16 * m + 4 * g);
            const float w0a[4] = {w0.x, w0.y, w0.z, w0.w}, a0a[4] = {a0.x, a0.y, a0.z, a0.w}, kaa[4] = {kav.x, kav.y, kav.z, kav.w}, rka[4] = {rkv.x, rkv.y, rkv.z, rkv.w};
            f32x4 gcv;
#pragma unroll
            for (int r = 0; r < 4; ++r) {
                const float a = sigmoidf_(a0a[r] + aa[r]);
                const float kd = kx[m][r] * (1.f + (a - 1.f) * kaa[r]), bb = kk[m][r] * a;
                bon += rr[m][r] * kd * rka[r];
                float Lg = -0.8750387749205294f * sigmoidf_(w0a[r] + aw[r]);
                if (D == 0) { Lg += dpp_id0<0x111>(Lg); Lg += dpp_id0<0x112>(Lg); Lg += dpp_id0<0x114>(Lg); Lg += dpp_id0<0x118>(Lg); }
                else        { Lg += dpp_id0<0x101>(Lg); Lg += dpp_id0<0x102>(Lg); Lg += dpp_id0<0x104>(Lg); Lg += dpp_id0<0x108>(Lg); }
                const float Lex = (D == 0) ? dpp_id0<0x111>(Lg) : dpp_id0<0x101>(Lg);
                const float G = __builtin_amdgcn_exp2f(Lg), Gex = __builtin_amdgcn_exp2f(Lex), iG = __builtin_amdgcn_exp2f(-Lg);
                al[mm][r] = Gex * kk[m][r]; be[mm][r] = bb * iG; ka[mm][r] = kd * iG; rh[mm][r] = G * rr[m][r]; gcv[r] = G;
                const int k = 16 * m + 4 * g + r; const unsigned pk_ = pk_bf16(be[mm][r], ka[mm][r]); BT[k * 16 + l16] = (bf16_t)(pk_ & 0xffffu); KT[k * 16 + l16] = (bf16_t)(pk_ >> 16);
            }
            if (l16 == ((D == 0) ? 15 : 0)) *(float4*)((float*)(dst + 10240) + 16 * m + 4 * g) = make_float4(gcv[0], gcv[1], gcv[2], gcv[3]);
        }
        af[p] = pack8(al[0], al[1]); bf[p] = pack8(be[0], be[1]); kf[p] = pack8(ka[0], ka[1]); rf[p] = pack8(rh[0], rh[1]);
        o[64 * p + lane] = af[p]; o[128 + 64 * p + lane] = rf[p];
        __builtin_amdgcn_sched_barrier(0);
    }
    f32x4 Lm = __builtin_amdgcn_mfma_f32_16x16x32_bf16(af[0], bf[0], z4, 0, 0, 0); Lm = __builtin_amdgcn_mfma_f32_16x16x32_bf16(af[1], bf[1], Lm, 0, 0, 0);
    f32x4 Am = __builtin_amdgcn_mfma_f32_16x16x32_bf16(af[0], kf[0], z4, 0, 0, 0); Am = __builtin_amdgcn_mfma_f32_16x16x32_bf16(af[1], kf[1], Am, 0, 0, 0);
    f32x4 Bb = __builtin_amdgcn_mfma_f32_16x16x32_bf16(bf[0], rf[0], z4, 0, 0, 0); Bb = __builtin_amdgcn_mfma_f32_16x16x32_bf16(bf[1], rf[1], Bb, 0, 0, 0);
    f32x4 Bk = __builtin_amdgcn_mfma_f32_16x16x32_bf16(kf[0], rf[0], z4, 0, 0, 0); Bk = __builtin_amdgcn_mfma_f32_16x16x32_bf16(kf[1], rf[1], Bk, 0, 0, 0);
#pragma unroll
    for (int r = 0; r < 4; ++r) { const int row = 4 * g + r;
        const bool strict = (D == 0) ? (l16 < row) : (l16 > row);
        const bool incl = (D == 0) ? (row <= l16) : (row >= l16);
        Lm[r] = strict ? Lm[r] : 0.f; Am[r] = strict ? Am[r] : 0.f; Bb[r] = incl ? Bb[r] : 0.f; Bk[r] = incl ? Bk[r] : 0.f; }
    *(LAS f32x4*)(LT + l16 * 16 + 4 * g) = Lm; *(LAS f32x4*)(AT + l16 * 16 + 4 * g) = Am;
    o[320 + lane] = pack8(Bb, Bk);
    asm volatile("" ::: "memory");
#pragma unroll
    for (int m = 0; m < 4; ++m) { union { bf16x8 v; u32x2 h[2]; } f;
        f.h[0] = *(LAS u32x2*)(BT + (16 * m + l16) * 16 + 4 * g); f.h[1] = *(LAS u32x2*)(KT + (16 * m + l16) * 16 + 4 * g);
        o[384 + 64 * m + lane] = f.v; }
    __builtin_amdgcn_sched_barrier(0);
    float x[16];
    if (D == 0) {
#pragma unroll
        for (int c = 15; c >= 0; --c) { float s = (c == l16) ? 1.f : 0.f; asm volatile("" ::: "memory");
#pragma unroll
            for (int i = c + 1; i < 16; ++i) s -= x[i] * LT[c * 16 + i];
            x[c] = s; }
    } else {
#pragma unroll
        for (int c = 0; c < 16; ++c) { float s = (c == l16) ? 1.f : 0.f; asm volatile("" ::: "memory");
#pragma unroll
            for (int i = 0; i < c; ++i) s -= x[i] * LT[c * 16 + i];
            x[c] = s; }
    }
    f32x4 tm0, tm1;
#pragma unroll
    for (int r = 0; r < 4; ++r) tm0[r] = -sel4(g, x[r], x[4 + r], x[8 + r], x[12 + r]);
#pragma unroll
    for (int r = 0; r < 4; ++r) { const int c = 4 * g + r; float s = 0.f; asm volatile("" ::: "memory");
#pragma unroll
        for (int i = 0; i < 16; i += 4) { const f32x4 a4 = *(LAS f32x4*)(AT + c * 16 + i); s += x[i] * a4[0] + x[i + 1] * a4[1] + x[i + 2] * a4[2] + x[i + 3] * a4[3]; }
        tm1[r] = -s; }
    o[256 + lane] = pack8(tm0, tm1);
    asm volatile("" ::: "memory");
}
__device__ __forceinline__ void rwkv_pre_task(const Ctx& F, const LayerW& W, unsigned char* ws, const bf16_t* WUPT, int task, int dsel) {
    const bf16_t* P = (const bf16_t*)(ws + WS_P); float* BON = (float*)(ws + WS_BON); unsigned char* RWF = ws + WS_RWF;
    const int cidx = task % RW_NCHUNK, bh = task / RW_NCHUNK, h = bh & 7, b = bh >> 3;
    int ln_ = F.lane; asm volatile("" : "+v"(ln_));
    const int l16 = ln_ & 15, g = ln_ >> 4;
    const int pos = cidx * 16 + l16;
    const int tok = pos < CTXL ? NLAT + b * CTXL + pos : b * SEQL + (pos - CTXL);
    const bf16_t* Pr = P + (size_t)tok * PTP;
    LAS unsigned char* wl = F.lds + F.wave * 8192;
    bf16x8 bw[2], ba[2];
#pragma unroll
    for (int p = 0; p < 2; ++p) { const u32x4 q = *(const u32x4*)(Pr + B_WD + 32 * p + 8 * g); union { bf16x8 v; unsigned u[4]; } tq;
#pragma unroll
        for (int e = 0; e < 4; ++e) tq.u[e] = pk_bf16(tanhf_(bflo(q[e])), tanhf_(bfhi(q[e])));
        bw[p] = tq.v; ba[p] = *(const bf16x8*)(Pr + B_AD + 32 * p + 8 * g); }
    f32x4 kk[4], rr[4], kx[4];
    float ssq = 0.f;
#pragma unroll
    for (int m = 0; m < 4; ++m) { const int co = h * 64 + 16 * m + 4 * g;
        const u32x2 rq = *(const u32x2*)(Pr + B_R + co), kq = *(const u32x2*)(Pr + B_K + co); const float4 kkw = *(const float4*)(W.rw_kk + co);
        rr[m] = (f32x4){bflo(rq.x), bfhi(rq.x), bflo(rq.y), bfhi(rq.y)}; kx[m] = (f32x4){bflo(kq.x), bfhi(kq.x), bflo(kq.y), bfhi(kq.y)};
        kk[m] = (f32x4){kx[m][0] * kkw.x, kx[m][1] * kkw.y, kx[m][2] * kkw.z, kx[m][3] * kkw.w};
        ssq += kk[m][0] * kk[m][0] + kk[m][1] * kk[m][1] + kk[m][2] * kk[m][2] + kk[m][3] * kk[m][3]; }
    ssq += xor16_f(ssq); ssq = sum_x32(ssq);
    { const float rn = rsqrtf(ssq + 1e-12f);
#pragma unroll
      for (int m = 0; m < 4; ++m) kk[m] = kk[m] * rn; }
    float bon = 0.f;
    const int co = h * 64;
    const int c0 = cidx, c1 = cidx < 16 ? 15 - cidx : 287 - cidx;
    if (dsel == 0) rwkv_pre_dir<0>(WUPT + (size_t)co * 64, bw, ba, kk, rr, kx, W.rw_w0 + co, W.rw_a0 + co, W.rw_ka + co, W.rw_rk + co, bon, wl, RWF + ((size_t)(bh * 2 + 0) * RW_NCHUNK + c0) * RWF_CHUNK, l16, g);
    else           rwkv_pre_dir<1>(WUPT + (size_t)co * 64, bw, ba, kk, rr, kx, W.rw_w0 + 512 + co, W.rw_a0 + 512 + co, W.rw_ka + co, W.rw_rk + co, bon, wl, RWF + ((size_t)(bh * 2 + 1) * RW_NCHUNK + c1) * RWF_CHUNK, l16, g);
    bon += xor16_f(bon); bon = sum_x32(bon);
    if (g == 0) BON[((size_t)dsel * NTOK + tok) * 8 + h] = bon;
}
struct RwFrag { bf16x8 a0, a1, r0, r1, tm, bb, bk0, bk1, bk2, bk3; f32x4 g0, g1, g2, g3; u32x2 v; };
__device__ __forceinline__ void rwkv_scan(const Ctx& F, unsigned char* ws, int sidx) {
    if (F.wave >= 4) return;
    const bf16_t* P = (const bf16_t*)(ws + WS_P); bf16_t* RWY = (bf16_t*)(ws + WS_RWY);
    const int d = sidx & 1, h = (sidx >> 1) & 7, b = sidx >> 4, n = F.wave, l16 = F.lane & 15, g = F.lane >> 4;
    const unsigned char* base = ws + WS_RWF + (size_t)sidx * RW_NCHUNK * RWF_CHUNK;
    const int vcol = B_V + h * 64 + 16 * n + l16;
#define RW_CIDX(c) (d ? ((c) < 16 ? 15 - (c) : 287 - (c)) : (c))
#define RW_TOK(cidx, i) (((cidx) * 16 + (i)) < CTXL ? NLAT + b * CTXL + (cidx) * 16 + (i) : b * SEQL + ((cidx) * 16 + (i) - CTXL))
#define RW_LOADF(fr, c) do { const bf16x8* q_ = (const bf16x8*)(base + (size_t)(c) * RWF_CHUNK) + F.lane; \
        fr.a0 = q_[0]; fr.a1 = q_[64]; fr.r0 = q_[128]; fr.r1 = q_[192]; fr.tm = q_[256]; fr.bb = q_[320]; fr.bk0 = q_[384]; fr.bk1 = q_[448]; fr.bk2 = q_[512]; fr.bk3 = q_[576]; \
        const f32x4* gp_ = (const f32x4*)(base + (size_t)(c) * RWF_CHUNK + 10240) + g; fr.g0 = gp_[0]; fr.g1 = gp_[4]; fr.g2 = gp_[8]; fr.g3 = gp_[12]; \
        const int ci_ = RW_CIDX(c); unsigned short v_[4]; _Pragma("unroll") for (int j_ = 0; j_ < 4; ++j_) v_[j_] = P[(size_t)RW_TOK(ci_, 4 * g + j_) * PTP + vcol]; \
        fr.v.x = (unsigned)v_[0] | ((unsigned)v_[1] << 16); fr.v.y = (unsigned)v_[2] | ((unsigned)v_[3] << 16); } while (0)
    f32x4 st0 = {0.f, 0.f, 0.f, 0.f}, st1 = st0, st2 = st0, st3 = st0;
    const f32x4 z4 = {0.f, 0.f, 0.f, 0.f};
#define RW_STEP(fr, c) do { \
        const bf16x8 s0_ = pack8(st0, st1), s1_ = pack8(st2, st3); \
        f32x4 x1_ = __builtin_amdgcn_mfma_f32_16x16x32_bf16(fr.a0, s0_, z4, 0, 0, 0); x1_ = __builtin_amdgcn_mfma_f32_16x16x32_bf16(fr.a1, s1_, x1_, 0, 0, 0); \
        f32x4 x2_ = __builtin_amdgcn_mfma_f32_16x16x32_bf16(fr.r0, s0_, z4, 0, 0, 0); x2_ = __builtin_amdgcn_mfma_f32_16x16x32_bf16(fr.r1, s1_, x2_, 0, 0, 0); \
        union { bf16x8 v; unsigned u[4]; } bx_; bx_.u[0] = pk_bf16(x1_[0], x1_[1]); bx_.u[1] = pk_bf16(x1_[2], x1_[3]); bx_.u[2] = fr.v.x; bx_.u[3] = fr.v.y; \
        const f32x4 e_ = __builtin_amdgcn_mfma_f32_16x16x32_bf16(fr.tm, bx_.v, z4, 0, 0, 0); \
        union { bf16x8 v; unsigned u[4]; } be_; be_.u[0] = pk_bf16(e_[0], e_[1]); be_.u[1] = pk_bf16(e_[2], e_[3]); be_.u[2] = fr.v.x; be_.u[3] = fr.v.y; \
        const f32x4 o_ = __builtin_amdgcn_mfma_f32_16x16x32_bf16(fr.bb, be_.v, x2_, 0, 0, 0); \
        st0 = __builtin_amdgcn_mfma_f32_16x16x32_bf16(fr.bk0, be_.v, st0, 0, 0, 0) * fr.g0; st1 = __builtin_amdgcn_mfma_f32_16x16x32_bf16(fr.bk1, be_.v, st1, 0, 0, 0) * fr.g1; \
        st2 = __builtin_amdgcn_mfma_f32_16x16x32_bf16(fr.bk2, be_.v, st2, 0, 0, 0) * fr.g2; st3 = __builtin_amdgcn_mfma_f32_16x16x32_bf16(fr.bk3, be_.v, st3, 0, 0, 0) * fr.g3; \
        const int ci_ = RW_CIDX(c); \
        _Pragma("unroll") for (int j_ = 0; j_ < 4; ++j_) RWY[((size_t)d * NTOK + RW_TOK(ci_, 4 * g + j_)) * 512 + h * 64 + 16 * n + l16] = f2bf(o_[j_]); } while (0)
    RwFrag fa, fb, fc;
#define RW_CL(c) ((c) < RW_NCHUNK ? (c) : RW_NCHUNK - 1)
    RW_LOADF(fa, 0); RW_LOADF(fb, 1);
    int c = 0;
    for (; c + 3 <= RW_NCHUNK; c += 3) {
        RW_LOADF(fc, RW_CL(c + 2)); RW_STEP(fa, c);
        RW_LOADF(fa, RW_CL(c + 3)); RW_STEP(fb, c + 1);
        RW_LOADF(fb, RW_CL(c + 4)); RW_STEP(fc, c + 2);
    }
    if (c < RW_NCHUNK) { RW_STEP(fa, c); if (c + 1 < RW_NCHUNK) RW_STEP(fb, c + 1); }
#undef RW_CL
#undef RW_CIDX
#undef RW_TOK
#undef RW_LOADF
#undef RW_STEP
}

__device__ __forceinline__ void na_tile(const Ctx& F, unsigned char* ws, const LAS float* sBias, int tile) {
    const bf16_t* QN = (const bf16_t*)(ws + WS_QN); const bf16_t* KN = (const bf16_t*)(ws + WS_KN);
    const bf16_t* VTL = (const bf16_t*)(ws + WS_VTL); const bf16_t* VTC = (const bf16_t*)(ws + WS_VTC); bf16_t* MIX = (bf16_t*)(ws + WS_MIX);
    const int h = F.wave, l16 = F.lane & 15, g = F.lane >> 4;
    const bool lat = tile < 1024;
    int b, r = 0, j = 0, gq;
    if (lat) { b = tile >> 8; r = (tile >> 2) & 63; j = tile & 3; gq = b * SEQL + r * 64 + j * 16 + l16; }
    else { const int tc = tile - 1024; b = tc >> 4; gq = NLAT + b * CTXL + (tc & 15) * 16 + l16; }
    const int row0 = min(max(r - 4, 0), 56), col0 = min(max(16 * j - 8, 0), 32);
    bf16x8 qf0, qf1;
    { const bf16_t* qp = QN + (size_t)gq * 512 + h * 64 + g * 8; qf0 = *(const bf16x8*)qp; qf1 = *(const bf16x8*)(qp + 32); }
    const f32x4 zero4 = {0.f, 0.f, 0.f, 0.f};
    const int cq = 16 * j + l16, win0 = min(max(cq - 8, 0), 48);
    const bf16_t* knb = KN + ((size_t)((((b * 8 + h) * 64 + row0) * 2) * 4 + g) * 64 + col0 + l16) * 8;
    const bf16_t* kcx = KN + (size_t)NLAT * 512 + ((size_t)(((b * 8 + h) * 2) * 4 + g) * 256 + l16) * 8;
    const bf16_t* vnb = VTL + ((size_t)(((b * 8 + h) * 64 + row0) * 12 + col0 / 4 + g) * 64 + l16) * 8;
    const bf16_t* vcx = VTC + ((size_t)(((b * 8 + h) * 8) * 4 + g) * 64 + l16) * 8;
    float mrun = -1e30f, lrun = 0.f;
    f32x4 o[4] = {zero4, zero4, zero4, zero4};
#pragma unroll
    for (int hf = 0; hf < 2; ++hf) {
        if (hf == 0 && !lat) continue;
        bf16x8 fr[32];
#pragma unroll
        for (int T = 0; T < 16; ++T) { const bf16_t* kp = hf == 0 ? knb + (size_t)((T >> 1) * 8) * 512 + (T & 1) * 128 : kcx + T * 128;
            fr[2 * T] = *(const bf16x8*)kp; fr[2 * T + 1] = *(const bf16x8*)(kp + (hf == 0 ? 4 * 512 : 4 * 2048)); }
        asm volatile("" ::: "memory");
        f32x4 acc[16];
#pragma unroll
        for (int T = 0; T < 16; ++T) { f32x4 a = __builtin_amdgcn_mfma_f32_16x16x32_bf16(fr[2 * T], qf0, zero4, 0, 0, 0); a = __builtin_amdgcn_mfma_f32_16x16x32_bf16(fr[2 * T + 1], qf1, a, 0, 0, 0);
            if (hf == 0) { const int ir = T >> 1, hh = T & 1, kr = row0 + ir; const LAS float* bias = sBias + (kr - r + 7) * 31;
#pragma unroll
                for (int e = 0; e < 4; ++e) { const int kc = col0 + 16 * hh + 4 * g + e; const bool ok = (kc >= win0) && (kc < win0 + 16);
                    const int dc = min(max(kc - cq + 15, 0), 30); a[e] = ok ? a[e] + bias[dc] : -1e30f; } }
            acc[T] = a; }
#pragma unroll
        for (int m = 0; m < 8; ++m)
#pragma unroll
            for (int dt = 0; dt < 4; ++dt) fr[4 * m + dt] = *(const bf16x8*)(hf == 0 ? vnb + (size_t)m * 12 * 512 + dt * 128 : vcx + (size_t)m * 4 * 512 + dt * 128);
        asm volatile("" ::: "memory");
        float mx = mrun;
#pragma unroll
        for (int T = 0; T < 16; ++T) mx = fmaxf(fmaxf(fmaxf(acc[T][0], acc[T][1]), fmaxf(acc[T][2], acc[T][3])), mx);
        mx = fmaxf(mx, xor16_f(mx)); mx = max_x32(mx);
        const float alpha = __expf(mrun - mx);
        float lsum = 0.f;
#pragma unroll
        for (int T = 0; T < 16; ++T) {
#pragma unroll
            for (int q = 0; q < 4; ++q) { const float pv = __expf(acc[T][q] - mx); acc[T][q] = pv; lsum += pv; } }
        lsum += xor16_f(lsum); lsum = sum_x32(lsum);
        lrun = lrun * alpha + lsum; mrun = mx;
#pragma unroll
        for (int dt = 0; dt < 4; ++dt) o[dt] = o[dt] * alpha;
#pragma unroll
        for (int m = 0; m < 8; ++m) { const bf16x8 pf = pack8(acc[2 * m], acc[2 * m + 1]);
#pragma unroll
            for (int dt = 0; dt < 4; ++dt) o[dt] = __builtin_amdgcn_mfma_f32_16x16x32_bf16(fr[4 * m + dt], pf, o[dt], 0, 0, 0); }
    }
    const float inv = 1.0f / lrun;
#pragma unroll
    for (int dt = 0; dt < 4; ++dt) { u32x2 w; w.x = pk_bf16(o[dt][0] * inv, o[dt][1] * inv); w.y = pk_bf16(o[dt][2] * inv, o[dt][3] * inv);
        *(u32x2*)(MIX + (size_t)gq * 2048 + 1024 + h * 64 + dt * 16 + 4 * g) = w; }
}
__device__ __forceinline__ void na_phase(const Ctx& F, const LayerW& W, unsigned char* ws, int blk, int nblk, int ntile) {
    LAS float* sBias = (LAS float*)(F.lds + F.wave * 2048);
    __syncthreads();
    for (int idx = F.lane; idx < 465; idx += 64) sBias[idx] = W.rpb[F.wave * 465 + idx];
    asm volatile("" ::: "memory");
    for (int tile = blk; tile < ntile; tile += nblk) na_tile(F, ws, sBias, tile);
}

__device__ __forceinline__ void phase_finish(const Ctx& F, const LayerW& W, unsigned char* ws, const bf16_t* GUPT, int ntok) {
    const bf16_t* P = (const bf16_t*)(ws + WS_P); bf16_t* MIX = (bf16_t*)(ws + WS_MIX);
    const bf16_t* RWY = (const bf16_t*)(ws + WS_RWY); const float* BON = (const float*)(ws + WS_BON); const float* YS = (const float*)(ws + WS_YS);
    const f32x4 z4 = {0.f, 0.f, 0.f, 0.f};
    for (int task = F.bid * 8 + F.wave; task < (ntok / 16) * 8; task += F.G * 8) {
        int ln = F.lane; asm volatile("" : "+v"(ln));
        const int l16 = ln & 15, g = ln >> 4, h = task & 7, tok = (task >> 3) * 16 + l16;
        const bf16_t* Pr = P + (size_t)tok * PTP;
        bf16x8 sg[4];
#pragma unroll
        for (int ks = 0; ks < 4; ++ks) { const u32x4 q = *(const u32x4*)(Pr + B_GD + 32 * ks + 8 * g); union { bf16x8 v; unsigned u[4]; } s;
#pragma unroll
            for (int e = 0; e < 4; ++e) s.u[e] = pk_bf16(sigmoidf_(bflo(q[e])), sigmoidf_(bfhi(q[e])));
            sg[ks] = s.v; }
        f32x4 y[4]; float s1 = 0.f;
#pragma unroll
        for (int m = 0; m < 4; ++m) { const int co = h * 64 + 16 * m + 4 * g;
            const u32x2 a = *(const u32x2*)(RWY + (size_t)tok * 512 + co), bq = *(const u32x2*)(RWY + ((size_t)NTOK + tok) * 512 + co);
            y[m] = (f32x4){bflo(a.x) + bflo(bq.x), bfhi(a.x) + bfhi(bq.x), bflo(a.y) + bflo(bq.y), bfhi(a.y) + bfhi(bq.y)};
            s1 += (y[m][0] + y[m][1]) + (y[m][2] + y[m][3]); }
        s1 += xor16_f(s1); s1 = sum_x32(s1);
        const float mu = s1 * (1.f / 64.f); float s2 = 0.f;
#pragma unroll
        for (int m = 0; m < 4; ++m) { y[m] = y[m] - mu; s2 += (y[m][0] * y[m][0] + y[m][1] * y[m][1]) + (y[m][2] * y[m][2] + y[m][3] * y[m][3]); }
        s2 += xor16_f(s2); s2 = sum_x32(s2);
        const float rs = rsqrtf(s2 * (1.f / 64.f) + 64e-5f);
        const float bon = BON[(size_t)tok * 8 + h] + BON[((size_t)NTOK + tok) * 8 + h];
#pragma unroll
        for (int m = 0; m < 4; ++m) { const int co = h * 64 + 16 * m + 4 * g;
            f32x4 ga = z4;
#pragma unroll
            for (int ks = 0; ks < 4; ++ks) ga = __builtin_amdgcn_mfma_f32_16x16x32_bf16(*(const bf16x8*)(GUPT + (size_t)(h * 64 + 16 * m + l16) * 128 + 32 * ks + 8 * g), sg[ks], ga, 0, 0, 0);
            const float4 lw = *(const float4*)(W.rw_lnw + co), lb = *(const float4*)(W.rw_lnb + co); const u32x2 vq = *(const u32x2*)(Pr + B_V + co);
            const float o0 = (y[m][0] * rs * lw.x + lb.x + bon * bflo(vq.x)) * ga[0], o1 = (y[m][1] * rs * lw.y + lb.y + bon * bfhi(vq.x)) * ga[1];
            const float o2 = (y[m][2] * rs * lw.z + lb.z + bon * bflo(vq.y)) * ga[2], o3 = (y[m][3] * rs * lw.w + lb.w + bon * bfhi(vq.y)) * ga[3];
            u32x2 o; o.x = pk_bf16(o0, o1); o.y = pk_bf16(o2, o3);
            *(u32x2*)(MIX + (size_t)tok * 2048 + 512 + co) = o; }
    }
    for (int tok = F.bid * 8 + F.wave; tok < ntok; tok += F.G * 8) {
        const int c0 = F.lane * 8;
        float ys[8], z[8], gw[8];
        load8f(YS + (size_t)tok * 512 + c0, ys); unpack8(*(const u32x4*)(P + (size_t)tok * PTP + D_Z + c0), z); load8f(W.s_norm + c0, gw);
        float ss = 0.f;
#pragma unroll
        for (int e = 0; e < 8; ++e) { ys[e] *= siluf_(z[e]); ss += ys[e] * ys[e]; }
        ss = wave_sum(ss);
        const float rs = rsqrtf(ss * (1.f / 512.f) + 1e-6f);
#pragma unroll
        for (int e = 0; e < 8; ++e) ys[e] = ys[e] * rs * gw[e];
        *(u32x4*)(MIX + (size_t)tok * 2048 + 1536 + c0) = pack8f(ys);
    }
}

constexpr int RADIX_LOW_BIT = 10;
constexpr int RADIX_STEPS = 14;
__device__ __forceinline__ unsigned ordkey(float x) { const unsigned u = __float_as_uint(x); return (u & 0x80000000u) ? ~u : (u | 0x80000000u); }
template <int CTRL> __device__ __forceinline__ int dpp_i0(int v) { return __builtin_amdgcn_update_dpp(0, v, CTRL, 0xF, 0xF, true); }
__device__ __forceinline__ int rowscan_incl(int x) { x += dpp_i0<0x111>(x); x += dpp_i0<0x112>(x); x += dpp_i0<0x114>(x); x += dpp_i0<0x118>(x); return x; }
__device__ __forceinline__ void phase_scores(const Ctx& F, unsigned char* ws, int layer, int ntok) {
    const bf16_t* Q = (const bf16_t*)(ws + WS_P); const bf16_t* KEYS = (const bf16_t*)(ws + WS_KEYS) + (size_t)layer * 8 * 2 * 128 * 128;
    int* IDS = (int*)(ws + WS_IDS); float* GATES = (float*)(ws + WS_GATES);
    LAS bf16_t* sK = (LAS bf16_t*)F.lds;
    LAS float* sVv = (LAS float*)(F.lds + 2 * 128 * 136 * 2 + F.wave * 5120);
    LAS int* sVi = (LAS int*)(sVv + 512);
    const int ntg = ntok / 128, ntask = 8 * ntg;
    const int l16 = F.lane & 15, g = F.lane >> 4;
    const f32x4 z4 = {0.f, 0.f, 0.f, 0.f};
    int cur_h = -1;
    for (int task = F.bid; task < ntask; task += F.G) {
        const int h = task / ntg, tg = task % ntg;
        if (h != cur_h) { __syncthreads();
#pragma unroll
            for (int q = 0; q < 8; ++q) { const int v = F.tid + 512 * q, row = v >> 4, part = v & 15;
                *(LAS u32x4*)(sK + row * 136 + part * 8) = *(const u32x4*)(KEYS + ((size_t)h * 256 + row) * 128 + part * 8); }
            cur_h = h; __syncthreads(); }
        const int t0 = tg * 128 + F.wave * 16;
#pragma unroll 1
        for (int p = 0; p < 2; ++p) {
            bf16x8 qf[4];
#pragma unroll
            for (int ks = 0; ks < 4; ++ks) qf[ks] = *(const bf16x8*)(Q + (size_t)(t0 + l16) * 2048 + h * 256 + p * 128 + 32 * ks + 8 * g);
            f32x4 acc[8];
#pragma unroll
            for (int kt = 0; kt < 8; ++kt) { f32x4 a = z4;
#pragma unroll
                for (int ks = 0; ks < 4; ++ks) a = __builtin_amdgcn_mfma_f32_16x16x32_bf16(qf[ks], *(const LAS bf16x8*)(sK + (p * 128 + 16 * kt + l16) * 136 + 32 * ks + 8 * g), a, 0, 0, 0);
                acc[kt] = a; }
            float lo0, lo1, lo2, lo3, hi0, hi1, hi2, hi3;
            { float m0 = acc[0][0], m1 = acc[0][1], m2 = acc[0][2], m3 = acc[0][3];
#pragma unroll
              for (int kt = 1; kt < 8; ++kt) { m0 = fmaxf(m0, acc[kt][0]); m1 = fmaxf(m1, acc[kt][1]); m2 = fmaxf(m2, acc[kt][2]); m3 = fmaxf(m3, acc[kt][3]); }
              hi0 = max16(m0); hi1 = max16(m1); hi2 = max16(m2); hi3 = max16(m3);
              lo0 = -max16(-m0); lo1 = -max16(-m1); lo2 = -max16(-m2); lo3 = -max16(-m3); }
#pragma unroll 1
            for (int it = 0; it < RADIX_STEPS; ++it) {
                const float c0 = 0.5f * (lo0 + hi0), c1 = 0.5f * (lo1 + hi1), c2 = 0.5f * (lo2 + hi2), c3 = 0.5f * (lo3 + hi3); int n0 = 0, n1 = 0, n2 = 0, n3 = 0;
#pragma unroll
                for (int kt = 0; kt < 8; ++kt) { n0 += acc[kt][0] >= c0; n1 += acc[kt][1] >= c1; n2 += acc[kt][2] >= c2; n3 += acc[kt][3] >= c3; }
                const bool k0 = sum16((float)n0) >= 16.f, k1 = sum16((float)n1) >= 16.f, k2 = sum16((float)n2) >= 16.f, k3 = sum16((float)n3) >= 16.f;
                lo0 = k0 ? c0 : lo0; hi0 = k0 ? hi0 : c0; lo1 = k1 ? c1 : lo1; hi1 = k1 ? hi1 : c1; lo2 = k2 ? c2 : lo2; hi2 = k2 ? hi2 : c2; lo3 = k3 ? c3 : lo3; hi3 = k3 ? hi3 : c3; }
#pragma unroll
            for (int r = 0; r < 4; ++r) { const float T = r == 0 ? lo0 : (r == 1 ? lo1 : (r == 2 ? lo2 : lo3));
                int cl = 0;
#pragma unroll
                for (int kt = 0; kt < 8; ++kt) cl += acc[kt][r] >= T;
                int rank = rowscan_incl(cl) - cl;
                LAS float* dv = sVv + ((4 * g + r) * 2 + p) * 16; LAS int* di = sVi + ((4 * g + r) * 2 + p) * 16;
#pragma unroll
                for (int kt = 0; kt < 8; ++kt) { const bool sel = acc[kt][r] >= T;
                    if (sel && rank < 16) { dv[rank] = acc[kt][r]; di[rank] = 16 * kt + l16; }
                    rank += sel ? 1 : 0; } }
        }
        asm volatile("" ::: "memory");
#pragma unroll 1
        for (int r = 0; r < 4; ++r) { const int tk = 4 * g + r;
            LAS float* sS = (LAS float*)(sVi + 512);
            LAS int* sI = (LAS int*)(sS + 128);
#pragma unroll
            for (int p = 0; p < 2; ++p) { const float v = sVv[(tk * 2 + p) * 16 + l16]; const int ix = sVi[(tk * 2 + p) * 16 + l16];
                const unsigned key = (ordkey(v) & ~15u) | (unsigned)(15 - l16); int rk = 0;
#pragma unroll
                for (int q = 0; q < 4; ++q) { const f32x4 o = *(const LAS f32x4*)(sVv + (tk * 2 + p) * 16 + 4 * q);
#pragma unroll
                    for (int e = 0; e < 4; ++e) rk += ((ordkey(o[e]) & ~15u) | (unsigned)(15 - (4 * q + e))) > key; }
                sS[(g * 2 + p) * 16 + rk] = v; sI[(g * 2 + p) * 16 + rk] = ix; }
            asm volatile("" ::: "memory");
            float cv[4]; int pi[4], pj[4];
#pragma unroll
            for (int q = 0; q < 4; ++q) { const int e = l16 + 16 * q; int i, j;
                if (e < 16) { i = 0; j = e; } else if (e < 24) { i = 1; j = e - 16; } else if (e < 29) { i = 2; j = e - 24; } else if (e < 33) { i = 3; j = e - 29; }
                else if (e < 36) { i = 4; j = e - 33; } else if (e < 42) { i = 5 + ((e - 36) >> 1); j = (e - 36) & 1; } else { i = 8 + (e - 42); j = 0; }
                const bool ok = e < 50; i = ok ? i : 15; j = ok ? j : 15;
                pi[q] = i; pj[q] = j; cv[q] = ok ? sS[(g * 2) * 16 + i] + sS[(g * 2 + 1) * 16 + j] : -3.0e38f; }
            float lo = sS[(g * 2) * 16 + 15] + sS[(g * 2 + 1) * 16], hi = sS[(g * 2) * 16] + sS[(g * 2 + 1) * 16];
            const float mx = hi;
#pragma unroll 1
            for (int it = 0; it < RADIX_STEPS; ++it) { const float cm = 0.5f * (lo + hi); int n = 0;
#pragma unroll
                for (int q = 0; q < 4; ++q) n += cv[q] >= cm;
                const bool kk = sum16((float)n) >= 16.f; lo = kk ? cm : lo; hi = kk ? hi : cm; }
            int cl = 0; float es = 0.f;
#pragma unroll
            for (int q = 0; q < 4; ++q) { const bool sel = cv[q] >= lo; cl += sel; es += sel ? __expf(cv[q] - mx) : 0.f; }
            int rank = rowscan_incl(cl) - cl;
            const float einv = 1.0f / sum16(es);
            const size_t ob = (size_t)(t0 + tk) * 128 + h * 16;
#pragma unroll
            for (int q = 0; q < 4; ++q) { const bool sel = cv[q] >= lo;
                if (sel && rank < 16) { IDS[ob + rank] = sI[(g * 2) * 16 + pi[q]] * 128 + sI[(g * 2 + 1) * 16 + pj[q]]; GATES[ob + rank] = __expf(cv[q] - mx) * einv; }
                rank += sel ? 1 : 0; }
            asm volatile("" ::: "memory");
        }
        asm volatile("" ::: "memory");
    }
}

struct XInfo { int xi, nx, rank, nloc; };
__device__ __forceinline__ void fp8x16_to_f32(const u32x4 q, float (&f)[16]) {
#pragma unroll
    for (int w = 0; w < 4; ++w) { const auto a = __builtin_amdgcn_cvt_pk_f32_fp8((int)q[w], false); const auto b = __builtin_amdgcn_cvt_pk_f32_fp8((int)q[w], true);
        f[4 * w] = a[0]; f[4 * w + 1] = a[1]; f[4 * w + 2] = b[0]; f[4 * w + 3] = b[1]; }
}
typedef long i64_t;
template <int IDMASK> __device__ __forceinline__ void phase_experts_u(const Ctx& F, unsigned char* ws, int layer, int ntok, const XInfo X, float* PART) {
    const bf16_t* H = (const bf16_t*)(ws + WS_XN); const unsigned char* PU8 = ws + WS_PU + (size_t)layer * 16384 * 2048;
    const int* IDS = (const int*)(ws + WS_IDS);
    const int e8 = F.lane >> 3, c = F.lane & 7, l16 = F.lane & 15, g = F.lane >> 4;
    const int tfirst = X.rank * 8 + F.wave, tstride = X.nloc * 8;
    const int nk = tfirst < ntok ? (ntok - tfirst + tstride - 1) / tstride : 0;
    const f32x4 z4 = {0.f, 0.f, 0.f, 0.f};
    LAS unsigned char* buf = F.lds + F.wave * 12288; LAS float* res = (LAS float*)(buf + 8192);
    const int woff = e8 * 128 + c * 16;
    const int srcoff = 16 * (c ^ e8);
    const int roff0 = l16 * 128 + (((2 * g) ^ (l16 & 7)) * 16), roff1 = l16 * 128 + (((2 * g + 1) ^ (l16 & 7)) * 16);
#define EU_TOK(k) (tfirst + min((k), nk - 1) * tstride)
#define EU_LOADI(I, k) do { const int* ip_ = IDS + (size_t)EU_TOK(k) * 128 + e8; _Pragma("unroll") for (int q_ = 0; q_ < 16; ++q_) I[q_] = ip_[8 * q_]; } while (0)
#define EU_LOADX(HX, k) do { const u32x4* hp_ = (const u32x4*)(H + (size_t)EU_TOK(k) * 2048 + s * 128 + 32 * g); HX[0] = hp_[0]; HX[1] = hp_[1]; HX[2] = hp_[2]; HX[3] = hp_[3]; } while (0)
#define EU_ISSUE(Q, I, hf) do { const unsigned char* sb_ = PU8 + (size_t)s * 16384 * 128; _Pragma("unroll") for (int i_ = 0; i_ < 8; ++i_) Q[i_] = *(const u32x4*)(sb_ + (unsigned)(I[(hf) * 8 + i_] * 128 + srcoff)); } while (0)
#define EU_CONSUME(Q, hf, slot) do { _Pragma("unroll") for (int i_ = 0; i_ < 8; ++i_) *(LAS u32x4*)(buf + i_ * 1024 + woff) = Q[i_]; \
        asm volatile("" ::: "memory"); \
        u32x4 p0_[4], p1_[4]; f32x4 a_[4]; \
        _Pragma("unroll") for (int q_ = 0; q_ < 4; ++q_) { p0_[q_] = *(const LAS u32x4*)(buf + q_ * 2048 + roff0); p1_[q_] = *(const LAS u32x4*)(buf + q_ * 2048 + roff1); a_[q_] = z4; } \
          \
        _Pragma("unroll") for (int q_ = 0; q_ < 4; ++q_) a_[q_] = __builtin_amdgcn_mfma_f32_16x16x32_fp8_fp8(((i64_t)p0_[q_][1] << 32) | (i64_t)p0_[q_][0], hb[0], a_[q_], 0, 0, 0); \
        _Pragma("unroll") for (int q_ = 0; q_ < 4; ++q_) a_[q_] = __builtin_amdgcn_mfma_f32_16x16x32_fp8_fp8(((i64_t)p0_[q_][3] << 32) | (i64_t)p0_[q_][2], hb[1], a_[q_], 0, 0, 0); \
        _Pragma("unroll") for (int q_ = 0; q_ < 4; ++q_) a_[q_] = __builtin_amdgcn_mfma_f32_16x16x32_fp8_fp8(((i64_t)p1_[q_][1] << 32) | (i64_t)p1_[q_][0], hb[2], a_[q_], 0, 0, 0); \
        _Pragma("unroll") for (int q_ = 0; q_ < 4; ++q_) a_[q_] = __builtin_amdgcn_mfma_f32_16x16x32_fp8_fp8(((i64_t)p1_[q_][3] << 32) | (i64_t)p1_[q_][2], hb[3], a_[q_], 0, 0, 0); \
        _Pragma("unroll") for (int q_ = 0; q_ < 4; ++q_) if (l16 == (hf) * 4 + q_) *(LAS f32x4*)(res + (slot) * 128 + 16 * ((hf) * 4 + q_) + 4 * g) = a_[q_]; \
        asm volatile("" ::: "memory"); } while (0)
    for (int s = X.xi; s < 16; s += X.nx) {
        if (nk == 0) continue;
        int id[2][16]; u32x4 hx[2][4]; u32x4 qa[8], qb[8];
        EU_LOADI(id[0], 0); EU_LOADX(hx[0], 0); EU_ISSUE(qa, id[0], 0); EU_ISSUE(qb, id[0], 1);
        EU_LOADI(id[1], 1);
        for (int k0 = 0; k0 < nk; k0 += 8) {
#pragma unroll
            for (int j = 0; j < 8; ++j) { const int k = k0 + j;
                i64_t hb[4];
#pragma unroll
                for (int m = 0; m < 4; ++m) { const u32x4 v = hx[j & 1][m];
                    int lo = __builtin_amdgcn_cvt_pk_fp8_f32(bflo(v[0]), bfhi(v[0]), 0, false); lo = __builtin_amdgcn_cvt_pk_fp8_f32(bflo(v[1]), bfhi(v[1]), lo, true);
                    int hi = __builtin_amdgcn_cvt_pk_fp8_f32(bflo(v[2]), bfhi(v[2]), 0, false); hi = __builtin_amdgcn_cvt_pk_fp8_f32(bflo(v[3]), bfhi(v[3]), hi, true);
                    hb[m] = ((i64_t)(unsigned)hi << 32) | (i64_t)(unsigned)lo; }
                EU_LOADX(hx[(j + 1) & 1], k + 1);
                EU_LOADI(id[j & 1], k + 2);
                EU_CONSUME(qa, 0, j);
                EU_ISSUE(qa, id[(j + 1) & 1], 0);
                EU_CONSUME(qb, 1, j);
                EU_ISSUE(qb, id[(j + 1) & 1], 1);
            }
            { const int u = F.lane >> 3, jj = F.lane & 7, ku = k0 + u;
              if (ku < nk) { float* dst = PART + ((size_t)s * NTOK + tfirst + ku * tstride) * 128 + 16 * jj;
#pragma unroll
                  for (int w = 0; w < 4; ++w) *(f32x4*)(dst + 4 * w) = *(const LAS f32x4*)(res + u * 128 + 16 * jj + 4 * w); }
              asm volatile("" ::: "memory"); }
        }
    }
#undef EU_TOK
#undef EU_LOADI
#undef EU_LOADX
#undef EU_ISSUE
#undef EU_CONSUME
}
__device__ __forceinline__ void phase_experts_combine(const Ctx& F, unsigned char* ws, int ntok) {
    const float* PART = (const float*)(ws + WS_PART); float* GATES = (float*)(ws + WS_GATES);
    for (int idx = F.bid * 512 + F.tid; idx < ntok * 32; idx += F.G * 512) {
        float4 a = make_float4(0.f, 0.f, 0.f, 0.f);
#pragma unroll
        for (int s = 0; s < 16; ++s) { const float4 v = *(const float4*)(PART + (size_t)s * NTOK * 128 + (size_t)idx * 4); a.x += v.x; a.y += v.y; a.z += v.z; a.w += v.w; }
        float4 g = *(const float4*)(GATES + (size_t)idx * 4);
        g.x *= geluf_(a.x * (1.0f / PEER_U_SCALE)); g.y *= geluf_(a.y * (1.0f / PEER_U_SCALE)); g.z *= geluf_(a.z * (1.0f / PEER_U_SCALE)); g.w *= geluf_(a.w * (1.0f / PEER_U_SCALE));
        *(float4*)(GATES + (size_t)idx * 4) = g;
    }
}
__device__ __forceinline__ void phase_experts_v(const Ctx& F, unsigned char* ws, float* out, float* CTXS, int layer, int ntok, const XInfo X) {
    const unsigned char* PV8 = ws + WS_PV + (size_t)layer * 16384 * 2048;
    const int* IDS = (const int*)(ws + WS_IDS); const float* COEF = (const float*)(ws + WS_GATES); const float* MOD = (const float*)(ws + WS_MOD);
    const int e8 = F.lane >> 3, c = F.lane & 7;
    const int tfirst = X.rank * 8 + F.wave, tstride = X.nloc * 8;
    const int nk = tfirst < ntok ? (ntok - tfirst + tstride - 1) / tstride : 0;
    LAS float* res = (LAS float*)(F.lds + F.wave * 4096);
#define EV_TOK(k) (tfirst + min((k), nk - 1) * tstride)
#define EV_LOADI(I, k) do { I[0] = *((const u32x4*)(IDS + (size_t)EV_TOK(k) * 128 + e8 * 16) + (c & 3)); } while (0)
#define EV_LOADC(C, k) do { C[0] = *((const u32x4*)(COEF + (size_t)EV_TOK(k) * 128 + e8 * 16) + (c & 3)); } while (0)
#define EV_QUAD(V) do { const u32x4 own_ = V[0];   \
        _Pragma("unroll") for (int w_ = 0; w_ < 4; ++w_) { V[0][w_] = (unsigned)__builtin_amdgcn_update_dpp(0, (int)own_[w_], 0x00, 0xF, 0xF, true); V[1][w_] = (unsigned)__builtin_amdgcn_update_dpp(0, (int)own_[w_], 0x55, 0xF, 0xF, true); \
            V[2][w_] = (unsigned)__builtin_amdgcn_update_dpp(0, (int)own_[w_], 0xAA, 0xF, 0xF, true); V[3][w_] = (unsigned)__builtin_amdgcn_update_dpp(0, (int)own_[w_], 0xFF, 0xF, 0xF, true); } } while (0)
#define EV_ROW(id) (*(const u32x4*)(PV8 + (size_t)s * 16384 * 128 + (unsigned)((id) * 128 + c * 16)))
#define EV_ISSUE(Q, I, hf) do { _Pragma("unroll") for (int i_ = 0; i_ < 8; ++i_) Q[i_] = EV_ROW(I[(hf) * 2 + (i_ >> 2)][i_ & 3]); } while (0)
#define EV_HALF(Q, C, hf) do { _Pragma("unroll") for (int i_ = 0; i_ < 8; ++i_) { const float cf_ = __uint_as_float(C[(hf) * 2 + (i_ >> 2)][i_ & 3]); const f32x2_t c2_ = {cf_, cf_}; \
            _Pragma("unroll") for (int w_ = 0; w_ < 4; ++w_) { const f32x2_t lo_ = __builtin_amdgcn_cvt_pk_f32_fp8((int)Q[i_][w_], false), hi_ = __builtin_amdgcn_cvt_pk_f32_fp8((int)Q[i_][w_], true); \
                ac2[2 * w_] = lo_ * c2_ + ac2[2 * w_]; ac2[2 * w_ + 1] = hi_ * c2_ + ac2[2 * w_ + 1]; } } } while (0)
    for (int s = X.xi; s < 16; s += X.nx) {
        if (nk == 0) continue;
        u32x4 id[2][4], cf[2][4]; u32x4 qa[8], qb[8];
        EV_LOADI(id[0], 0); EV_LOADC(cf[0], 0); EV_QUAD(id[0]); EV_ISSUE(qa, id[0], 0); EV_ISSUE(qb, id[0], 1);
        EV_LOADI(id[1], 1);
        for (int k0 = 0; k0 < nk; k0 += 8) {
#pragma unroll
            for (int j = 0; j < 8; ++j) { const int k = k0 + j;
                f32x2_t ac2[8];
#pragma unroll
                for (int e = 0; e < 8; ++e) ac2[e] = (f32x2_t){0.f, 0.f};
                EV_QUAD(cf[j & 1]);
                EV_QUAD(id[(j + 1) & 1]);
                EV_LOADC(cf[(j + 1) & 1], k + 1);
                EV_HALF(qa, cf[j & 1], 0);
                EV_ISSUE(qa, id[(j + 1) & 1], 0);
                EV_HALF(qb, cf[j & 1], 1);
                EV_ISSUE(qb, id[(j + 1) & 1], 1);
                EV_LOADI(id[j & 1], k + 2);
                float acc[16];
#pragma unroll
                for (int e = 0; e < 8; ++e) { acc[2 * e] = ac2[e][0]; acc[2 * e + 1] = ac2[e][1]; }
#pragma unroll
                for (int e = 0; e < 16; ++e) { float v = acc[e]; v += dpp_f<0x128>(v); v += xor16_f(v); acc[e] = sum_x32(v); }
                if (e8 == 0) {
#pragma unroll
                    for (int w = 0; w < 4; ++w) *(LAS f32x4*)(res + j * 128 + c * 16 + 4 * w) = (f32x4){acc[4 * w], acc[4 * w + 1], acc[4 * w + 2], acc[4 * w + 3]}; }
                asm volatile("" ::: "memory");
            }
            { const int u = F.lane >> 3, jj = F.lane & 7, ku = k0 + u;
              if (ku < nk) { const int tu = tfirst + ku * tstride;
                  const bool isctx = tu >= NLAT; const int vv = isctx ? 4 : (tu >> 12);
                  float* xr = (isctx ? CTXS + (size_t)(tu - NLAT) * 2048 : out + (size_t)tu * 2048) + s * 128 + jj * 16;
                  const float* m5 = MOD + ((size_t)layer * 5 + vv) * 12288 + 5 * 2048 + s * 128 + jj * 16;
#pragma unroll
                  for (int w = 0; w < 4; ++w) { float4 x = *(const float4*)(xr + 4 * w); const float4 m = *(const float4*)(m5 + 4 * w); const f32x4 a = *(const LAS f32x4*)(res + u * 128 + jj * 16 + 4 * w);
                      x.x += m.x * a[0]; x.y += m.y * a[1]; x.z += m.z * a[2]; x.w += m.w * a[3]; *(float4*)(xr + 4 * w) = x; } }
              asm volatile("" ::: "memory"); }
        }
    }
#undef EV_TOK
#undef EV_LOADI
#undef EV_LOADC
#undef EV_QUAD
#undef EV_ROW
#undef EV_ISSUE
#undef EV_HALF
}

struct Params { const float* in[N_IN]; float* out; unsigned char* ws; };

__device__ __forceinline__ LayerW make_w(ka_t in, int l) {
    LayerW W;
    W.sc_w = in[I_SCW] + (size_t)l * 3 * 512; W.rw_w0 = in[I_RW0] + (size_t)l * 2 * 512; W.rw_wup = in[I_RWUP] + (size_t)l * 2 * 64 * 512;
    W.rw_a0 = in[I_RA0] + (size_t)l * 2 * 512; W.rw_aup = in[I_RAUP] + (size_t)l * 2 * 64 * 512; W.rw_gup = in[I_RGUP] + (size_t)l * 128 * 512;
    W.rw_kk = in[I_RKK] + (size_t)l * 512; W.rw_ka = in[I_RKA] + (size_t)l * 512; W.rw_rk = in[I_RRK] + (size_t)l * 512;
    W.rw_lnw = in[I_RLNW] + (size_t)l * 512; W.rw_lnb = in[I_RLNB] + (size_t)l * 512;
    W.na_q = in[I_NAQ] + (size_t)l * 64; W.na_k = in[I_NAK] + (size_t)l * 64; W.rpb = in[I_RPB] + (size_t)l * 8 * 15 * 31;
    W.s_cw = in[I_SCONVW] + (size_t)l * 3 * 1024; W.s_cb = in[I_SCONVB] + (size_t)l * 1024; W.s_dtb = in[I_SDTB] + (size_t)l * 16; W.s_alog = in[I_SALOG] + (size_t)l * 16;
    W.s_d = in[I_SD] + (size_t)l * 8; W.s_norm = in[I_SNORM] + (size_t)l * 512;
    return W;
}

__global__ void __launch_bounds__(512, 2) hybrid_fwd(Params p) {
    extern __shared__ __attribute__((aligned(16))) unsigned char shm[];
    Ctx F; F.lds = (LAS unsigned char*)shm; F.tid = threadIdx.x; F.lane = F.tid & 63; F.wave = __builtin_amdgcn_readfirstlane(F.tid >> 6); F.bid = blockIdx.x; F.G = gridDim.x;
    volatile LAS unsigned* bst = (volatile LAS unsigned*)(F.lds + LDS_BAR_OFF);
    if (F.tid < 4) bst[F.tid] = 0u;
    __syncthreads();
    (void)xcd_barrier_post((unsigned*)(p.ws + WS_CTL), bst);
    volatile LAS int* lxi = (volatile LAS int*)(F.lds + LDS_XI_OFF);
    if (F.tid == 0) lxi[2] = (int)xb_add((unsigned*)(p.ws + WS_CTL) + CTL_TICKET + 64 * xb_xcc_id(), 1u);
#define RPT_PHASE(id, ...) do { __VA_ARGS__ if (RPT == (id)) { GRID_BAR(); PH_BEGIN(); __VA_ARGS__ } } while (0)
#define GRID_BAR() do { ka_t kb_ = (ka_t)__builtin_amdgcn_kernarg_segment_ptr(); asm volatile("" : "+s"(kb_)); unsigned xx_ = xb_xcc_id(); asm volatile("" : "+s"(xx_)); \
        XcdBarrier b_; b_.bar = (unsigned*)((unsigned char*)kb_[N_IN + 1] + WS_CTL); b_.x = xx_; b_.st = (volatile LAS unsigned*)(F.lds + LDS_BAR_OFF); xcd_barrier(b_); } while (0)
    ka_t in; unsigned char* ws; float* out;
#define PH_BEGIN() do { int t_ = threadIdx.x; asm volatile("; PHASE_MARK" : "+v"(t_)); F.tid = t_; F.lane = t_ & 63; F.wave = __builtin_amdgcn_readfirstlane(t_ >> 6); \
        int b_ = blockIdx.x, g_ = gridDim.x; asm volatile("" : "+s"(b_), "+s"(g_)); F.bid = b_; F.G = g_; \
        ka_t k_ = (ka_t)__builtin_amdgcn_kernarg_segment_ptr(); asm volatile("" : "+s"(k_)); in = k_; \
        out = (float*)in[N_IN]; ws = (unsigned char*)in[N_IN + 1]; } while (0)

    PH_BEGIN();
    RPT_PHASE(1, phase_prologue(F, in, ws););
    GRID_BAR();
    if (F.tid == 0) {
        const unsigned* bw = (const unsigned*)(ws + WS_CTL); const unsigned myx = xb_xcc_id(); int xi = 0, nx = 0, nloc = 1;
        for (unsigned j = 0; j < 16; ++j) { const unsigned cnt = xb_ld((unsigned*)&bw[XB_XCNT(j)]); if (cnt > 0u) { if (j < myx) ++xi; ++nx; } if (j == myx) nloc = (int)cnt; }
        lxi[0] = xi; lxi[1] = nx > 0 ? nx : 1; lxi[3] = nloc > 0 ? nloc : 1; }
    __syncthreads();
    PH_BEGIN();
    phase_modreduce(F, in[I_BADA], (const float*)(ws + WS_MODP), (float*)(ws + WS_MOD));
    GRID_BAR();

#pragma unroll 1
    for (int l = 0; l < 2; ++l) {
        const int M = (l == 0) ? NTOK : NLAT;
        if (l == 0) { PH_BEGIN(); phase_norm(F, in[I_X], in[I_CTX], in[I_NMIX], (const float*)(ws + WS_MOD), 0, 1, (bf16_t*)(ws + WS_XN), NTOK); GRID_BAR(); }

        PH_BEGIN();
        RPT_PHASE(2, { pg8::Gemm g{(const bf16_t*)(ws + WS_XN), (const bf16_t*)(ws + WS_WIN) + (size_t)l * PTP * 2048, NTOK, PTP, 2048}; pg8::StaticOrder S; S.init(NTOK, PTP, F.G, F.bid);
          pg8::EpiBf16 E{(bf16_t*)(ws + WS_P), PTP}; pg8::gemm_phase<pg8::EpiBf16, pg8::StaticOrder>(F.lds, g, S, E, F.tid); });
        GRID_BAR();

        PH_BEGIN();
        { const LayerW W = make_w(in, l); phase_prep(F, W, ws);
            if (RPT == 31) phase_prep(F, W, ws);
            const bf16_t* WUPT = (const bf16_t*)(ws + WS_WUPT) + (size_t)l * 4 * 512 * 64;
            for (int rep = 0; rep < (RPT == 32 ? 2 : 1); ++rep) {
            for (int task = F.bid * 8 + F.wave; task < 4 * 8 * RW_NCHUNK; task += F.G * 8) rwkv_pre_task(F, W, ws, WUPT, task, 0);
            for (int task = F.bid * 8 + F.wave; task < 4 * 8 * RW_NCHUNK; task += F.G * 8) rwkv_pre_task(F, W, ws, WUPT, task, 1); } }
        GRID_BAR();

        PH_BEGIN();
        RPT_PHASE(4, { const LayerW W = make_w(in, l); for (int task = F.bid; task < 4 * 8 * NCH; task += F.G) ssd_task<false>(F, W, ws, task); });
        GRID_BAR();
        PH_BEGIN();
        phase_ssd_combine(F, ws);
        GRID_BAR();

        PH_BEGIN();
        { if (F.bid < 64) rwkv_scan(F, ws, F.bid);
        else { const LayerW W = make_w(in, l); const int blk = F.bid - 64, nblk = F.G - 64;
            for (int task = blk; task < 4 * 8 * NCH; task += nblk) ssd_task<true>(F, W, ws, task);
            na_phase(F, W, ws, blk, nblk, (l == 0) ? 1088 : 1024); } }
        if (RPT == 51) { GRID_BAR(); PH_BEGIN(); if (F.bid < 64) rwkv_scan(F, ws, F.bid); }
        if (RPT == 52) { GRID_BAR(); PH_BEGIN(); if (F.bid >= 64) { const LayerW W = make_w(in, l); const int blk = F.bid - 64, nblk = F.G - 64;
            for (int task = blk; task < 4 * 8 * NCH; task += nblk) ssd_task<true>(F, W, ws, task); } }
        if (RPT == 53) { GRID_BAR(); PH_BEGIN(); if (F.bid >= 64) { const LayerW W = make_w(in, l); const int blk = F.bid - 64, nblk = F.G - 64;
            na_phase(F, W, ws, blk, nblk, (l == 0) ? 1088 : 1024); } }
        GRID_BAR();

        PH_BEGIN();
        RPT_PHASE(6, { const LayerW W = make_w(in, l); phase_finish(F, W, ws, (const bf16_t*)(ws + WS_GUPT) + (size_t)l * 512 * 128, M); });
        GRID_BAR();

        PH_BEGIN();
        { pg8::Gemm g{(const bf16_t*)(ws + WS_MIX), (const bf16_t*)(ws + WS_WOUT) + (size_t)l * 2048 * 2048, M, 2048, 2048}; pg8::StaticOrder S; S.init(M, 2048, F.G, F.bid);
          float* CTXS = (float*)(ws + WS_CTXS);
          pg8::EpiResid E{l == 0 ? in[I_X] : out, l == 0 ? in[I_CTX] : CTXS, out, CTXS, (const float*)(ws + WS_MOD) + (size_t)l * 5 * 12288 + 2 * 2048};
          pg8::gemm_phase<pg8::EpiResid, pg8::StaticOrder>(F.lds, g, S, E, F.tid); }
        if (l == 0 && F.bid >= 32) PEER_CONVERT_LAYER(F, in, ws, 0, F.bid - 32, F.G - 32);
        GRID_BAR();

        PH_BEGIN();
        RPT_PHASE(7, phase_norm(F, out, (const float*)(ws + WS_CTXS), in[I_NFFN] + (size_t)l * 2048, (const float*)(ws + WS_MOD) + (size_t)l * 5 * 12288, 3, 4, (bf16_t*)(ws + WS_XN), M););
        GRID_BAR();
        PH_BEGIN();
        RPT_PHASE(8, { pg8::Gemm g{(const bf16_t*)(ws + WS_XN), (const bf16_t*)(ws + WS_WQ) + (size_t)l * 2048 * 2048, M, 2048, 2048}; pg8::StaticOrder S; S.init(M, 2048, F.G, F.bid);
          pg8::EpiBf16 E{(bf16_t*)(ws + WS_P), 2048}; pg8::gemm_phase<pg8::EpiBf16, pg8::StaticOrder>(F.lds, g, S, E, F.tid); });
        if (l == 0 && F.bid >= 32) PEER_CONVERT_LAYER(F, in, ws, 1, F.bid - 32, F.G - 32);
        GRID_BAR();
        PH_BEGIN();
        RPT_PHASE(9, phase_scores(F, ws, l, M););
        GRID_BAR();
        PH_BEGIN();
        RPT_PHASE(10, { XInfo X; X.xi = lxi[0]; X.nx = lxi[1]; X.rank = lxi[2]; X.nloc = lxi[3]; phase_experts_u<0x3fff>(F, ws, l, M, X, (float*)(ws + WS_PART)); });
        if (RPT == 101) { GRID_BAR(); PH_BEGIN(); XInfo X; X.xi = lxi[0]; X.nx = lxi[1]; X.rank = lxi[2]; X.nloc = lxi[3]; phase_experts_u<0x3ff>(F, ws, l, M, X, (float*)(ws + WS_P)); }
        if (RPT == 102) { GRID_BAR(); PH_BEGIN(); XInfo X; X.xi = lxi[0]; X.nx = lxi[1]; X.rank = lxi[2]; X.nloc = lxi[3]; phase_experts_u<0x3fff>(F, ws, l, M, X, (float*)(ws + WS_P)); }
        GRID_BAR();
        PH_BEGIN();
        phase_experts_combine(F, ws, M);
        GRID_BAR();
        PH_BEGIN();
        if (RPT == 11) { XInfo X; X.xi = lxi[0]; X.nx = lxi[1]; X.rank = lxi[2]; X.nloc = lxi[3]; phase_experts_v(F, ws, (float*)(ws + WS_P), (float*)(ws + WS_P) + (size_t)NLAT * 2048, l, M, X); GRID_BAR(); PH_BEGIN(); }
        { XInfo X; X.xi = lxi[0]; X.nx = lxi[1]; X.rank = lxi[2]; X.nloc = lxi[3]; phase_experts_v(F, ws, out, (float*)(ws + WS_CTXS), l, M, X); }
        if (l == 0) { GRID_BAR(); PH_BEGIN();
            phase_norm(F, out, (const float*)(ws + WS_CTXS), in[I_NMIX] + 2048, (const float*)(ws + WS_MOD) + (size_t)5 * 12288, 0, 1, (bf16_t*)(ws + WS_XN), NTOK); GRID_BAR(); }
    }
}

extern "C" void kernel_launch(void* const* d_in, const int* in_sizes, int n_in, void* d_out, int out_size, void* d_ws, size_t ws_size, hipStream_t stream) {
    static int grid = 0;
    if (grid == 0) {
        if (n_in != N_IN || out_size != NLAT * DM || ws_size < WS_END) { fprintf(stderr, "kernel_launch: unexpected shapes (n_in %d out %d ws %zu, need %zu)\n", n_in, out_size, ws_size, (size_t)WS_END); grid = -1; return; }
        int dev = 0, cus = 0, per_cu = 0;
        (void)hipGetDevice(&dev); (void)hipDeviceGetAttribute(&cus, hipDeviceAttributeMultiprocessorCount, dev);
        if (hipFuncSetAttribute((const void*)hybrid_fwd, hipFuncAttributeMaxDynamicSharedMemorySize, LDS_BYTES) != hipSuccess) { fprintf(stderr, "kernel_launch: hipFuncSetAttribute failed\n"); grid = -1; return; }
        (void)hipOccupancyMaxActiveBlocksPerMultiprocessor(&per_cu, (const void*)hybrid_fwd, 512, LDS_BYTES);
        (void)hipGetLastError();
        fprintf(stderr, "kernel_launch: %d CUs, occupancy query %d block(s)/CU, ws %zu B (need %zu)\n", cus, per_cu, ws_size, (size_t)WS_END);
        grid = cus;
        if (grid < 136) { fprintf(stderr, "kernel_launch: needs at least 136 CUs\n"); grid = -1; return; }
    }
    if (grid < 0) return;
    (void)hipMemsetAsync((char*)d_ws + WS_CTL, 0, 65536, stream);
    Params p{};
    for (int i = 0; i < N_IN; ++i) p.in[i] = (const float*)d_in[i];
    p.out = (float*)d_out; p.ws = (unsigned char*)d_ws;
    hipLaunchKernelGGL(hybrid_fwd, dim3(grid), dim3(512), LDS_BYTES, stream, p);
}
```

```cpp
#include <hip/hip_runtime.h>
#include <cstdio>
#include <cstdint>
#ifndef RPT
#define RPT 0
#endif

constexpr int DM = 2048, NBATCH = 4, SEQL = 4096, CTXL = 256, NLAT = NBATCH * SEQL, NCTX = NBATCH * CTXL, NTOK = NLAT + NCTX;
constexpr int PT = 6416, PTP = 6656;
constexpr int A_BG = 0, A_CG = 512, A_H = 1024;
constexpr int B_R = 1536, B_K = 2048, B_V = 2560, B_WD = 3072, B_AD = 3136, B_GD = 3200;
constexpr int C_Q = 3328, C_K = 3840, C_V = 4352;
constexpr int D_Z = 4864, D_X = 5376, D_DT = 6400;
constexpr int NPOS = CTXL + SEQL;
constexpr int NCH = 34;
constexpr int KSPL = 32;

enum { I_X = 0, I_C, I_CTX, I_CCTX, I_WADA, I_BADA, I_NMIX, I_NFFN, I_WIN, I_WOUT, I_SCW, I_RW0, I_RWUP, I_RA0, I_RAUP, I_RGUP, I_RKK, I_RKA, I_RRK, I_RLNW, I_RLNB,
       I_NAQ, I_NAK, I_RPB, I_SCONVW, I_SCONVB, I_SDTB, I_SALOG, I_SD, I_SNORM, I_PWQ, I_PKEYS, I_PU, I_PV, N_IN };

constexpr size_t WS_CTL   = 0;
constexpr size_t WS_ROPE  = 65536;
constexpr size_t WS_MODP  = WS_ROPE + 16384;
constexpr size_t WS_MOD   = WS_MODP + (size_t)KSPL * 2 * 5 * 12288 * 4;
constexpr size_t WS_WIN   = WS_MOD + (size_t)2 * 5 * 12288 * 4;
constexpr size_t WS_WOUT  = WS_WIN + (size_t)2 * PTP * DM * 2;
constexpr size_t WS_WQ    = WS_WOUT + (size_t)2 * DM * DM * 2;
constexpr size_t WS_KEYS  = WS_WQ + (size_t)2 * DM * DM * 2;
constexpr size_t WS_WUPT  = WS_KEYS + (size_t)2 * 8 * 2 * 128 * 128 * 2;
constexpr size_t WS_GUPT  = WS_WUPT + (size_t)2 * 4 * 512 * 64 * 2;
constexpr size_t WS_PU    = WS_GUPT + (size_t)2 * 512 * 128 * 2;
constexpr size_t WS_PV    = WS_PU + (size_t)2 * 16384 * DM;
constexpr size_t WS_P     = WS_PV + (size_t)2 * 16384 * DM;
constexpr size_t WS_MIX   = WS_P + (size_t)NTOK * PTP * 2;
constexpr size_t WS_CTXS  = WS_MIX + (size_t)NTOK * DM * 2;
constexpr size_t WS_XN    = WS_CTXS + (size_t)NCTX * DM * 4;
constexpr size_t WS_IDS   = WS_XN + (size_t)NTOK * DM * 2;
constexpr size_t WS_GATES = WS_IDS + (size_t)NTOK * 128 * 4;
constexpr size_t WS_PART  = WS_GATES + (size_t)NTOK * 128 * 4;
constexpr size_t WS_RWF   = WS_XN;
constexpr size_t WS_RWY   = WS_RWF + (size_t)64 * 272 * 13312;
constexpr size_t WS_BON   = WS_RWY + (size_t)2 * NTOK * 512 * 2;
constexpr size_t WS_XBC   = WS_BON + (size_t)2 * NTOK * 8 * 4;
constexpr size_t WS_DTS   = WS_XBC + (size_t)NTOK * 1024 * 2;
constexpr size_t WS_DEC   = WS_DTS + (size_t)NTOK * 16 * 4;
constexpr size_t WS_SST   = WS_DEC + (size_t)NTOK * 16 * 4;
constexpr size_t WS_SCD   = WS_SST + (size_t)64 * NCH * 8192 * 4;
constexpr size_t WS_YS    = WS_SCD + 16384;
constexpr size_t WS_QN    = WS_YS + (size_t)NTOK * 512 * 4;
constexpr size_t WS_KN    = WS_QN + (size_t)NTOK * 512 * 2;
constexpr size_t WS_VTL   = WS_KN + (size_t)NTOK * 512 * 2;
constexpr size_t WS_VTC   = WS_VTL + (size_t)4 * 8 * 64 * 64 * 96 * 2;
constexpr size_t WS_END   = WS_VTC + (size_t)4 * 8 * 64 * 256 * 2;
static_assert(WS_END < (size_t)1020 * 1024 * 1024, "workspace");
static_assert(WS_GATES + (size_t)NTOK * 128 * 4 <= WS_PART && WS_PART + (size_t)16 * NTOK * 128 * 4 <= WS_END, "alias");

constexpr int LDS_BYTES = 147456;
constexpr int LDS_BAR_OFF = LDS_BYTES - 16;
constexpr int LDS_XI_OFF = LDS_BYTES - 48;
constexpr int CTL_TICKET = 8192;

#define LAS __attribute__((address_space(3)))
typedef unsigned short bf16_t;
typedef _Float16 f16_t;
typedef short bf16x8 __attribute__((ext_vector_type(8)));
typedef float f32x4 __attribute__((ext_vector_type(4)));
typedef unsigned u32x4 __attribute__((ext_vector_type(4)));
typedef unsigned u32x2 __attribute__((ext_vector_type(2)));

__device__ __forceinline__ float bf2f(bf16_t h) { return __uint_as_float(((unsigned)h) << 16); }
__device__ __forceinline__ float bflo(unsigned u) { return __uint_as_float(u << 16); }
__device__ __forceinline__ float bfhi(unsigned u) { return __uint_as_float(u & 0xffff0000u); }
__device__ __forceinline__ bf16_t f2bf(float f) { unsigned u = __float_as_uint(f); u += 0x7FFFu + ((u >> 16) & 1u); return (bf16_t)(u >> 16); }
typedef float f32x2_t __attribute__((ext_vector_type(2)));
typedef __bf16 bf16x2_t __attribute__((ext_vector_type(2)));
__device__ __forceinline__ unsigned pk_bf16(float lo, float hi) { const f32x2_t v = {lo, hi}; const bf16x2_t r = __builtin_convertvector(v, bf16x2_t); return __builtin_bit_cast(unsigned, r); }
__device__ __forceinline__ bf16x8 pack8(const f32x4 a, const f32x4 b) { union { bf16x8 v; unsigned u[4]; } r; r.u[0] = pk_bf16(a[0], a[1]); r.u[1] = pk_bf16(a[2], a[3]); r.u[2] = pk_bf16(b[0], b[1]); r.u[3] = pk_bf16(b[2], b[3]); return r.v; }
template <int CTRL> __device__ __forceinline__ float dpp_f(float v) { return __int_as_float(__builtin_amdgcn_update_dpp(0, __float_as_int(v), CTRL, 0xF, 0xF, true)); }
__device__ __forceinline__ float sum4(float x)  { x += dpp_f<0xB1>(x); x += dpp_f<0x4E>(x); return x; }
__device__ __forceinline__ float sum8(float x)  { x = sum4(x); x += dpp_f<0x141>(x); return x; }
__device__ __forceinline__ float sum16(float x) { x = sum8(x); x += dpp_f<0x140>(x); return x; }
__device__ __forceinline__ float xor16_f(float x) { return __int_as_float(__builtin_amdgcn_ds_swizzle(__float_as_int(x), 0x401F)); }
__device__ __forceinline__ float sum_x32(float x) { const auto r = __builtin_amdgcn_permlane32_swap(__float_as_uint(x), __float_as_uint(x), false, false); return __uint_as_float(r[0]) + __uint_as_float(r[1]); }
__device__ __forceinline__ float max_x32(float x) { const auto r = __builtin_amdgcn_permlane32_swap(__float_as_uint(x), __float_as_uint(x), false, false); return fmaxf(__uint_as_float(r[0]), __uint_as_float(r[1])); }
__device__ __forceinline__ float wave_sum(float x) { x = sum16(x); x += xor16_f(x); return sum_x32(x); }
__device__ __forceinline__ float max16(float x) { x = fmaxf(x, dpp_f<0xB1>(x)); x = fmaxf(x, dpp_f<0x4E>(x)); x = fmaxf(x, dpp_f<0x141>(x)); x = fmaxf(x, dpp_f<0x140>(x)); return x; }
__device__ __forceinline__ float wave_max(float x) { x = max16(x); x = fmaxf(x, xor16_f(x)); return max_x32(x); }
__device__ __forceinline__ float rcpf_(float x) { return __builtin_amdgcn_rcpf(x); }
__device__ __forceinline__ float sigmoidf_(float x) { return rcpf_(1.0f + __expf(-x)); }
__device__ __forceinline__ float siluf_(float x) { return x * rcpf_(1.0f + __expf(-x)); }
__device__ __forceinline__ float tanhf_(float x) { const float e = __expf(2.0f * x); return 1.0f - 2.0f * rcpf_(e + 1.0f); }
__device__ __forceinline__ float geluf_(float x) { return 0.5f * x * (1.0f + tanhf_(0.7978845608028654f * (x + 0.044715f * x * x * x))); }

namespace pg8 {
#define PG8_LAS __attribute__((address_space(3)))
typedef unsigned short bf16_t;
typedef short bf16x8 __attribute__((ext_vector_type(8)));
typedef float f32x4 __attribute__((ext_vector_type(4)));
typedef unsigned u32x4 __attribute__((ext_vector_type(4)));
constexpr int BM = 256, BK = 64, HALF = 128, HTB = HALF * BK * 2  , STAGE_BYTES = 8 * HTB, NXCD = 8, WGM = 8;

__host__ __device__ __forceinline__ int lds_byte(int r, int c) { const int st = (r >> 4) * 2 + (c >> 5), rr = r & 15, cc = c & 31, ob = rr * 64 + cc * 2; return st * 1024 + (ob ^ (((ob >> 9) & 1) << 5)); }
__host__ __device__ __forceinline__ void stage_rc(int b, int& R, int& C) { const int st = b / 1024, sb = b % 1024, swz = sb ^ (((sb >> 9) & 1) << 5); R = (st >> 1) * 16 + swz / 64; C = (st & 1) * 32 + (swz % 64) / 2; }
__host__ __device__ __forceinline__ int perm32(int rho) { const int n = rho >> 4, i = rho & 15; return 8 * (i >> 2) + 4 * n + (i & 3); }

struct Unit { int pm, pn; };
struct Gemm { const bf16_t* A; const bf16_t* Bt; int M, N, K; };

struct StaticOrder {
    int nM, nN, nwg, G, c;
    __host__ __device__ void init(int M, int N, int G_, int c_) { nM = M / BM; nN = N / BM; nwg = nM * nN; G = G_; c = c_; }
    __host__ __device__ bool next(int i, Unit& u) const {
        const long L = (long)i * G + c; if (L >= nwg) return false;
        int wgid = (int)L; { const int q = nwg / NXCD, r = nwg % NXCD, xcd = wgid % NXCD, off = wgid / NXCD; wgid = (xcd < r ? xcd * (q + 1) : r * (q + 1) + (xcd - r) * q) + off; }
        const int nig = WGM * nN, gid = wgid / nig, fm = gid * WGM, gsz = (nM - fm) < WGM ? (nM - fm) : WGM;
        u.pm = fm + ((wgid % nig) % gsz); u.pn = (wgid % nig) / gsz; return true;
    }
    __device__ __forceinline__ void a_ready(const Unit&) const {}
    __device__ __forceinline__ void done(const Unit&) const {}
};

__device__ __forceinline__ unsigned cvt_pk_bf16(float lo, float hi) { return ::pk_bf16(lo, hi); }
struct EpiBf16 {
    static constexpr bool PERM = true, AFTER_DRAIN = false;
    bf16_t* O; int ldc;
    __device__ __forceinline__ void operator()(const f32x4 (&acc)[2][2][4][2], const Unit& u, int wr, int wc, int fr, int fq) const {
        const int row0 = u.pm * BM + wr * 64 + fr; const int col0 = u.pn * BM + wc * 32 + 8 * fq;
#pragma unroll
        for (int ai = 0; ai < 2; ++ai)
#pragma unroll
            for (int m = 0; m < 4; ++m) { bf16_t* rowp = O + (size_t)(row0 + ai * HALF + m * 16) * ldc + col0;
#pragma unroll
                for (int bj = 0; bj < 2; ++bj) { const f32x4 v0 = acc[ai][bj][m][0], v1 = acc[ai][bj][m][1];
                    u32x4 w; w.x = cvt_pk_bf16(v0[0], v0[1]); w.y = cvt_pk_bf16(v0[2], v0[3]); w.z = cvt_pk_bf16(v1[0], v1[1]); w.w = cvt_pk_bf16(v1[2], v1[3]);
                    *(u32x4*)(rowp + bj * HALF) = w; } }
    }
};
struct EpiResid {
    static constexpr bool PERM = false, AFTER_DRAIN = false;
    const float* xi_lat; const float* xi_ctx; float* xo_lat; float* xo_ctx; const float* gate;
    __device__ __forceinline__ void operator()(const f32x4 (&acc)[2][2][4][2], const Unit& u, int wr, int wc, int fr, int fq) const {
        const bool isctx = u.pm >= 64; const int v = isctx ? 4 : (u.pm >> 4);
        const int row0 = (isctx ? (u.pm - 64) : u.pm) * BM + wr * 64 + fr, col0 = u.pn * BM + wc * 32 + 4 * fq;
        const float* xi = isctx ? xi_ctx : xi_lat; float* xo = isctx ? xo_ctx : xo_lat;
        const float* gp = gate + (size_t)v * 12288 + col0;
        f32x4 gv[2][2];
#pragma unroll
        for (int bj = 0; bj < 2; ++bj)
#pragma unroll
            for (int n = 0; n < 2; ++n) gv[bj][n] = *(const f32x4*)(gp + bj * HALF + n * 16);
#pragma unroll
        for (int ai = 0; ai < 2; ++ai)
#pragma unroll
            for (int m = 0; m < 4; ++m) { const size_t off = (size_t)(row0 + ai * HALF + m * 16) * 2048 + col0;
#pragma unroll
                for (int bj = 0; bj < 2; ++bj)
#pragma unroll
                    for (int n = 0; n < 2; ++n) { const f32x4 xv = *(const f32x4*)(xi + off + bj * HALF + n * 16);
                        *(f32x4*)(xo + off + bj * HALF + n * 16) = xv + gv[bj][n] * acc[ai][bj][m][n]; }
                asm volatile("" ::: "memory"); }
    }
};

template <class Epi, class Sched>
__device__ __forceinline__ void gemm_phase(PG8_LAS unsigned char* lds, const Gemm g, const Sched& S, const Epi& E, const int tid) {
    const int wid = __builtin_amdgcn_readfirstlane(tid >> 6), lane = tid & 63, wr = wid >> 2, wc = wid & 3, fr = lane & 15, fq = lane >> 4;
    const int K = g.K, nt = K / BK;
    unsigned voffA[2], voffB[2];
#pragma unroll
    for (int i = 0; i < 2; ++i) { int R, C; stage_rc(tid * 16 + i * 8192, R, C); const int Rb = Epi::PERM ? ((R & ~31) + perm32(R & 31)) : R;
        voffA[i] = (unsigned)(R * K + C) * 2u; voffB[i] = (unsigned)(Rb * K + C) * 2u; }
    const size_t kstep = (size_t)(BK * 2);
    const size_t hstep = (size_t)HALF * K * 2;
    const size_t tstep = 2 * hstep;
    const unsigned ldsw = (unsigned)wid * 1024u;
    const int aoff = lds_byte(wr * 64 + fr, fq * 8), boff = lds_byte(wc * 32 + fr, fq * 8);
#define PG8_SA(b, h) (((b) * 2 + (h)) * HTB)
#define PG8_SB(b, h) ((4 + (b) * 2 + (h)) * HTB)
#define PG8_STAGE(bufoff, gbase, voff) do { _Pragma("unroll") for (int _i = 0; _i < 2; ++_i) \
        __builtin_amdgcn_global_load_lds((const unsigned*)((const char*)(gbase) + (voff)[_i]), (PG8_LAS unsigned*)(lds + (bufoff) + ldsw + _i * 8192), 16, 0, 0); } while (0)
#define PG8_LDA(dst, b, h) do { _Pragma("unroll") for (int m = 0; m < 4; ++m) _Pragma("unroll") for (int k = 0; k < 2; ++k) dst[m][k] = *(const PG8_LAS bf16x8*)(lds + PG8_SA(b, h) + aoff + m * 2048 + k * 1024); } while (0)
#define PG8_LDB(dst, b, h) do { _Pragma("unroll") for (int n = 0; n < 2; ++n) _Pragma("unroll") for (int k = 0; k < 2; ++k) dst[n][k] = *(const PG8_LAS bf16x8*)(lds + PG8_SB(b, h) + boff + n * 2048 + k * 1024); } while (0)
#define PG8_MMA(ai, bj, At, Bt) do { __builtin_amdgcn_s_setprio(1); _Pragma("unroll") for (int m = 0; m < 4; ++m) _Pragma("unroll") for (int n = 0; n < 2; ++n) _Pragma("unroll") for (int k = 0; k < 2; ++k) \
        acc[ai][bj][m][n] = __builtin_amdgcn_mfma_f32_16x16x32_bf16(Bt[n][k], At[m][k], acc[ai][bj][m][n], 0, 0, 0); __builtin_amdgcn_s_setprio(0); } while (0)
#define PG8_WAIT_V(n) asm volatile("s_waitcnt vmcnt(" #n ")" ::: "memory")
#define PG8_WAIT_L(n) asm volatile("s_waitcnt lgkmcnt(" #n ")" ::: "memory")
#define PG8_BAR __builtin_amdgcn_s_barrier()
#define PG8_SCHED __builtin_amdgcn_sched_barrier(0)
    Unit cur, nxt; int ui = 0;
    if (!S.next(0, cur)) return;
    f32x4 acc[2][2][4][2];
#pragma unroll
    for (int a = 0; a < 2; ++a)
#pragma unroll
        for (int b = 0; b < 2; ++b)
#pragma unroll
            for (int m = 0; m < 4; ++m)
#pragma unroll
                for (int n = 0; n < 2; ++n) acc[a][b][m][n] = (f32x4){0.f, 0.f, 0.f, 0.f};
    bf16x8 At[4][2], B0[2][2], B1[2][2];
    const char* cA = (const char*)g.A + (size_t)cur.pm * tstep; const char* cB = (const char*)g.Bt + (size_t)cur.pn * tstep;
    S.a_ready(cur);
    PG8_STAGE(PG8_SB(0, 0), cB, voffB); PG8_STAGE(PG8_SA(0, 0), cA, voffA); PG8_STAGE(PG8_SB(0, 1), cB + hstep, voffB); PG8_STAGE(PG8_SA(0, 1), cA + hstep, voffA);
    if (wr == 1) PG8_BAR;
    PG8_WAIT_V(4); PG8_BAR;
    PG8_STAGE(PG8_SB(1, 0), cB + kstep, voffB); PG8_STAGE(PG8_SA(1, 0), cA + kstep, voffA); PG8_STAGE(PG8_SB(1, 1), cB + hstep + kstep, voffB);
    PG8_WAIT_V(6); PG8_BAR;
    for (;;) {
        const bool has_next = S.next(ui + 1, nxt);
        const char* nA = has_next ? (const char*)g.A + (size_t)nxt.pm * tstep : cA; const char* nB = has_next ? (const char*)g.Bt + (size_t)nxt.pn * tstep : cB;
        for (int t = 0; t < nt; t += 2) {
            const bool last = (t == nt - 2);
            const char* a1 = cA + (size_t)(t + 1) * kstep;
            const char* a2 = last ? nA : cA + (size_t)(t + 2) * kstep; const char* b2 = last ? nB : cB + (size_t)(t + 2) * kstep;
            const char* a3 = a2 + kstep; const char* b3 = b2 + kstep;
            if (last && has_next) S.a_ready(nxt);
            PG8_LDB(B0, 0, 0); PG8_SCHED; PG8_LDA(At, 0, 0); PG8_STAGE(PG8_SA(1, 1), a1 + hstep, voffA);
            PG8_WAIT_L(8); PG8_BAR; PG8_WAIT_L(0); PG8_MMA(0, 0, At, B0); PG8_BAR; PG8_SCHED;
            PG8_LDB(B1, 0, 1); PG8_STAGE(PG8_SB(0, 0), b2, voffB);
            PG8_BAR; PG8_WAIT_L(0); PG8_MMA(0, 1, At, B1); PG8_BAR;
            PG8_LDA(At, 0, 1); PG8_STAGE(PG8_SA(0, 0), a2, voffA);
            PG8_BAR; PG8_WAIT_L(0); PG8_MMA(1, 0, At, B0); PG8_BAR; PG8_SCHED;
            PG8_STAGE(PG8_SB(0, 1), b2 + hstep, voffB);
            PG8_WAIT_V(6); PG8_BAR; PG8_MMA(1, 1, At, B1); PG8_BAR;
            PG8_LDB(B0, 1, 0); PG8_SCHED; PG8_LDA(At, 1, 0); PG8_STAGE(PG8_SA(0, 1), a2 + hstep, voffA);
            PG8_WAIT_L(8); PG8_BAR; PG8_WAIT_L(0); PG8_MMA(0, 0, At, B0); PG8_BAR; PG8_SCHED;
            PG8_LDB(B1, 1, 1); PG8_STAGE(PG8_SB(1, 0), b3, voffB);
            PG8_BAR; PG8_WAIT_L(0); PG8_MMA(0, 1, At, B1); PG8_BAR;
            PG8_LDA(At, 1, 1); PG8_STAGE(PG8_SA(1, 0), a3, voffA);
            PG8_BAR; PG8_WAIT_L(0); PG8_MMA(1, 0, At, B0); PG8_BAR; PG8_SCHED;
            PG8_STAGE(PG8_SB(1, 1), b3 + hstep, voffB);
            PG8_WAIT_V(6); PG8_BAR; PG8_MMA(1, 1, At, B1); PG8_BAR;
        }
        if constexpr (!Epi::AFTER_DRAIN) { E(acc, cur, wr, wc, fr, fq); S.done(cur); }
        if (!has_next) break;
#pragma unroll
        for (int a = 0; a < 2; ++a)
#pragma unroll
            for (int b = 0; b < 2; ++b)
#pragma unroll
                for (int m = 0; m < 4; ++m)
#pragma unroll
                    for (int n = 0; n < 2; ++n) acc[a][b][m][n] = (f32x4){0.f, 0.f, 0.f, 0.f};
        cur = nxt; cA = nA; cB = nB; ++ui;
    }
    PG8_WAIT_V(0);
    if (wr == 0) PG8_BAR;
    PG8_BAR;
    if constexpr (Epi::AFTER_DRAIN) { E.fused(acc, cur, wr, wc, fr, fq, lds, wid, lane); S.done(cur); }
#undef PG8_SA
#undef PG8_SB
#undef PG8_STAGE
#undef PG8_LDA
#undef PG8_LDB
#undef PG8_MMA
#undef PG8_WAIT_V
#undef PG8_WAIT_L
#undef PG8_BAR
#undef PG8_SCHED
}
}

#define XB_TMO      128
#define XB_XCNT(j)  (256  + 64 * (j))
#define XB_XSUB(j)  (1280 + 64 * (j))
#define XB_XGEN(j)  (2304 + 64 * (j))
#define XB_TOP      3328
#define XB_TOPGEN   3392
#define XCD_BAR_WORDS 3456
#define XB_SPIN_CAP (1u << 18)
#define LAS __attribute__((address_space(3)))

__device__ __forceinline__ unsigned xb_ld(unsigned* p)              { return __hip_atomic_load(p, __ATOMIC_RELAXED, __HIP_MEMORY_SCOPE_AGENT); }
__device__ __forceinline__ unsigned xb_add(unsigned* p, unsigned v) { return __hip_atomic_fetch_add(p, v, __ATOMIC_RELAXED, __HIP_MEMORY_SCOPE_AGENT); }
__device__ __forceinline__ unsigned xb_xcc_id() { return (unsigned)__builtin_amdgcn_s_getreg((3 << 11) | 20) & 0xFu; }
#define XB_SPIN(cond, bar) do { unsigned _sp = 0; while (cond) { __builtin_amdgcn_s_sleep(1); \
    if ((++_sp & 255u) == 0u) { if (xb_ld(&(bar)[XB_TMO])) break; if (_sp > XB_SPIN_CAP) { atomicAdd(&(bar)[XB_TMO], 1u); break; } } } } while (0)

struct XcdBarrier {
    unsigned* bar; unsigned x;
    volatile LAS unsigned* st;
};

__device__ __forceinline__ XcdBarrier xcd_barrier_post(unsigned* bar, volatile LAS unsigned* st) {
    XcdBarrier b; b.bar = bar; b.x = xb_xcc_id(); b.st = st;
    if (threadIdx.x == 0) (void)xb_add(&bar[XB_XCNT(b.x)], 1u);
    return b;
}
__device__ __forceinline__ void xcd_barrier_complete(unsigned* bar, unsigned x, unsigned& nloc, unsigned& nx) {
    const unsigned G = gridDim.x * gridDim.y * gridDim.z;
    unsigned sum, cnt, mine, sp = 0u;
    for (;;) {
        sum = 0u; cnt = 0u; mine = 0u;
#pragma unroll
        for (unsigned j = 0; j < 16; ++j) { const unsigned c = xb_ld(&bar[XB_XCNT(j)]); sum += c; cnt += (c > 0u) ? 1u : 0u; mine = (j == x) ? c : mine; }
        if (sum == G) break;
        __builtin_amdgcn_s_sleep(1);
        if ((++sp & 255u) == 0u) { if (xb_ld(&bar[XB_TMO])) break; if (sp > XB_SPIN_CAP) { atomicAdd(&bar[XB_TMO], 1u); break; } }
    }
    nloc = mine > 0u ? mine : 1u; nx = cnt > 0u ? cnt : 1u;
}

__device__ __forceinline__ void xcd_barrier(const XcdBarrier& b) {
    asm volatile("s_waitcnt vmcnt(0)" ::: "memory");
    __syncthreads();
    if (threadIdx.x == 0) {
        unsigned* bar = b.bar;
        __builtin_amdgcn_s_waitcnt(0);
        unsigned nloc = b.st[0], nx = b.st[1];
        if (nloc == 0u) { xcd_barrier_complete(bar, b.x, nloc, nx); b.st[0] = nloc; b.st[1] = nx; }
        const unsigned old = xb_add(&bar[XB_XSUB(b.x)], 1u);
        const unsigned gen = old / nloc;
        if (old + 1u == (gen + 1u) * nloc) {
            __builtin_amdgcn_fence(__ATOMIC_RELEASE, "agent");
            asm volatile("s_waitcnt vmcnt(0)" ::: "memory");
            const unsigned og = xb_add(&bar[XB_TOP], 1u);
            const unsigned tg = og / nx;
            if (og + 1u == (tg + 1u) * nx) xb_add(&bar[XB_TOPGEN], 1u);
            else XB_SPIN(xb_ld(&bar[XB_TOPGEN]) == tg, bar);
            __builtin_amdgcn_fence(__ATOMIC_ACQUIRE, "agent");
            xb_add(&bar[XB_XGEN(b.x)], 1u);
            asm volatile("s_waitcnt vmcnt(0)" ::: "memory");
        } else {
            XB_SPIN(xb_ld(&bar[XB_XGEN(b.x)]) == gen, bar);
            __builtin_amdgcn_fence(__ATOMIC_ACQUIRE, "agent");
            asm volatile("s_waitcnt vmcnt(0)" ::: "memory");
        }
    }
    __syncthreads();
}

typedef const float* cfp_t;
typedef __attribute__((address_space(4))) const cfp_t* ka_t;
struct Ctx {
    LAS unsigned char* lds; int tid, lane, wave, bid, G;
};

__device__ __forceinline__ void task_ada(const Ctx& F, const float* c, const float* c_ctx, const float* w_ada, float* modp, int task) {
    LAS float* s_act = (LAS float*)F.lds;
    const int l = task / (KSPL * 6), rem = task % (KSPL * 6), ks = rem / 6, cc = rem % 6;
    __syncthreads();
    if (F.tid < 320) { const int v = F.tid >> 6, k = ks * 64 + (F.tid & 63); const float x = v < 4 ? c[v * 2048 + k] : c_ctx[k]; s_act[F.tid] = siluf_(x); }
    __syncthreads();
    const int col4 = cc * 512 + F.tid;
    const float4* wp = (const float4*)(w_ada + ((size_t)l * 2048 + ks * 64) * 12288) + col4;
    float4 acc[5];
#pragma unroll
    for (int v = 0; v < 5; ++v) acc[v] = make_float4(0.f, 0.f, 0.f, 0.f);
#pragma unroll 8
    for (int k = 0; k < 64; ++k) {
        const float4 w = wp[(size_t)k * 3072];
#pragma unroll
        for (int v = 0; v < 5; ++v) { const float a = s_act[v * 64 + k]; acc[v].x += a * w.x; acc[v].y += a * w.y; acc[v].z += a * w.z; acc[v].w += a * w.w; }
    }
#pragma unroll
    for (int v = 0; v < 5; ++v) ((float4*)(modp + (((size_t)ks * 2 + l) * 5 + v) * 12288))[col4] = acc[v];
}
__device__ __forceinline__ void task_wt(const Ctx& F, const float* W, int N, bf16_t* Wt, int ntile) {
    LAS bf16_t* T = (LAS bf16_t*)F.lds;
    const int nq = F.tid & 15, kr = F.tid >> 4, n0 = ntile * 64;
    for (int kc = 0; kc < 16; ++kc) {
        float4 v[4];
#pragma unroll
        for (int j = 0; j < 4; ++j) { const int k = kc * 128 + kr + 32 * j, n = n0 + 4 * nq;
            v[j] = (n < N) ? *(const float4*)(W + (size_t)k * N + n) : make_float4(0.f, 0.f, 0.f, 0.f); }
        __syncthreads();
#pragma unroll
        for (int j = 0; j < 4; ++j) { const int kl = kr + 32 * j;
            T[(4 * nq + 0) * 136 + kl] = f2bf(v[j].x); T[(4 * nq + 1) * 136 + kl] = f2bf(v[j].y); T[(4 * nq + 2) * 136 + kl] = f2bf(v[j].z); T[(4 * nq + 3) * 136 + kl] = f2bf(v[j].w); }
        __syncthreads();
        { const int n = F.tid >> 3, kg = F.tid & 7;
          const u32x4 a = *(LAS u32x4*)(T + n * 136 + kg * 16), b = *(LAS u32x4*)(T + n * 136 + kg * 16 + 8);
          bf16_t* dst = Wt + (size_t)(n0 + n) * 2048 + kc * 128 + kg * 16; *(u32x4*)dst = a; *(u32x4*)(dst + 8) = b; }
    }
    __syncthreads();
}
__device__ __forceinline__ void task_cvt(const Ctx& F, const float* src, bf16_t* dst, size_t off) {
#pragma unroll 4
    for (int it = 0; it < 16; ++it) { const size_t e = off + (size_t)it * 4096 + F.tid * 8;
        const float4 a = *(const float4*)(src + e), b = *(const float4*)(src + e + 4);
        u32x4 o; o.x = pk_bf16(a.x, a.y); o.y = pk_bf16(a.z, a.w); o.z = pk_bf16(b.x, b.y); o.w = pk_bf16(b.z, b.w);
        *(u32x4*)(dst + e) = o; }
}
__device__ __forceinline__ void task_cvt8(const Ctx& F, const float* src, unsigned char* dst, size_t off, float scale) {
#pragma unroll 2
    for (int it = 0; it < 8; ++it) { const size_t e = off + (size_t)it * 8192 + F.tid * 16;
        u32x4 o;
#pragma unroll
        for (int w = 0; w < 4; ++w) { const float4 a = *(const float4*)(src + e + 4 * w);
            const float x0 = fminf(fmaxf(a.x * scale, -448.f), 448.f), x1 = fminf(fmaxf(a.y * scale, -448.f), 448.f), x2 = fminf(fmaxf(a.z * scale, -448.f), 448.f), x3 = fminf(fmaxf(a.w * scale, -448.f), 448.f);
            int p = __builtin_amdgcn_cvt_pk_fp8_f32(x0, x1, 0, false); p = __builtin_amdgcn_cvt_pk_fp8_f32(x2, x3, p, true); o[w] = (unsigned)p; }
        const size_t row = e >> 11; const int col = (int)(e & 2047);
        *(u32x4*)(dst + (row >> 14) * ((size_t)16384 * 2048) + ((size_t)(col >> 7) * 16384 + (row & 16383)) * 128 + (col & 127)) = o; }
}
constexpr float PEER_U_SCALE = 64.0f;
#define PEER_CONVERT_LAYER(F, in, ws, layer, blk, nblk) do { for (int t_ = (blk); t_ < 1024; t_ += (nblk)) { const bool isv_ = t_ >= 512; \
        task_cvt8(F, in[isv_ ? I_PV : I_PU], ws + (isv_ ? WS_PV : WS_PU), (size_t)(layer) * 16384 * 2048 + (size_t)(t_ & 511) * 65536, isv_ ? 1.0f : PEER_U_SCALE); } } while (0)
__device__ __forceinline__ void task_lorat(const Ctx& F, const float* src, bf16_t* dst, int nj) {
    const int ch = F.tid;
    for (int j8 = 0; j8 < nj / 8; ++j8) { float v[8];
#pragma unroll
        for (int q = 0; q < 8; ++q) v[q] = src[(size_t)(j8 * 8 + q) * 512 + ch];
        u32x4 o; o.x = pk_bf16(v[0], v[1]); o.y = pk_bf16(v[2], v[3]); o.z = pk_bf16(v[4], v[5]); o.w = pk_bf16(v[6], v[7]);
        *(u32x4*)(dst + (size_t)ch * nj + j8 * 8) = o; }
}
constexpr int T_ADA = 2 * KSPL * 6, T_WT1 = 2 * 104, T_WT2 = 2 * 32, T_WT3 = 2 * 32, T_PEER = 0, T_KEYS = 8, T_LORA = 10;
__device__ __forceinline__ void phase_prologue(const Ctx& F, ka_t in, unsigned char* ws) {
    const int total = T_ADA + T_WT1 + T_WT2 + T_WT3 + T_PEER + T_KEYS + T_LORA + 1;
    for (int t0 = F.bid; t0 < total; t0 += F.G) {
        int t = t0;
        if (t < T_ADA) { task_ada(F, in[I_C], in[I_CCTX], in[I_WADA], (float*)(ws + WS_MODP), t); continue; } t -= T_ADA;
        if (t < T_WT1) { const int l = t / 104, nt = t % 104; task_wt(F, in[I_WIN] + (size_t)l * 2048 * PT, PT, (bf16_t*)(ws + WS_WIN) + (size_t)l * PTP * 2048, nt); continue; } t -= T_WT1;
        if (t < T_WT2) { const int l = t / 32, nt = t % 32; task_wt(F, in[I_WOUT] + (size_t)l * 2048 * 2048, 2048, (bf16_t*)(ws + WS_WOUT) + (size_t)l * 2048 * 2048, nt); continue; } t -= T_WT2;
        if (t < T_WT3) { const int l = t / 32, nt = t % 32; task_wt(F, in[I_PWQ] + (size_t)l * 2048 * 2048, 2048, (bf16_t*)(ws + WS_WQ) + (size_t)l * 2048 * 2048, nt); continue; } t -= T_WT3;
        if (t < T_PEER) { const bool isv = t >= 1024; const int c = t & 1023; task_cvt8(F, in[isv ? I_PV : I_PU], ws + (isv ? WS_PV : WS_PU), (size_t)c * 65536, isv ? 1.0f : PEER_U_SCALE); continue; } t -= T_PEER;
        if (t < T_KEYS) { task_cvt(F, in[I_PKEYS], (bf16_t*)(ws + WS_KEYS), (size_t)t * 65536); continue; } t -= T_KEYS;
        if (t < T_LORA) {
            if (t < 8) { const int l = t >> 2, wh = t & 3;
                task_lorat(F, in[wh < 2 ? I_RWUP : I_RAUP] + ((size_t)l * 2 + (wh & 1)) * 64 * 512, (bf16_t*)(ws + WS_WUPT) + ((size_t)l * 4 + wh) * 512 * 64, 64); }
            else { const int l = t - 8; task_lorat(F, in[I_RGUP] + (size_t)l * 128 * 512, (bf16_t*)(ws + WS_GUPT) + (size_t)l * 512 * 128, 128); }
            continue; } t -= T_LORA;
        { float* rope = (float*)(ws + WS_ROPE);
          for (int e = F.tid; e < 2048; e += 512) { const int pos = e >> 5, i = e & 31; const float fr = powf(10000.0f, -(float)i / 32.0f), ang = (float)pos * fr;
              rope[2 * e] = cosf(ang); rope[2 * e + 1] = sinf(ang); } }
    }
}
__device__ __forceinline__ void phase_modreduce(const Ctx& F, const float* b_ada, const float* modp, float* mod) {
    for (int idx = F.bid * 512 + F.tid; idx < 2 * 5 * 12288; idx += F.G * 512) {
        const int l = idx / 61440, rem = idx % 61440, v = rem / 12288, n = rem % 12288;
        float s = b_ada[l * 12288 + n];
        for (int ks = 0; ks < KSPL; ++ks) s += modp[(((size_t)ks * 2 + l) * 5 + v) * 12288 + n];
        mod[idx] = s;
    }
}

__device__ __forceinline__ void norm_store(const float (&x)[32], const float* gw, const float* shift, const float* scale, bf16_t* dst, int lane) {
    float ss = 0.f;
#pragma unroll
    for (int q = 0; q < 32; ++q) ss += x[q] * x[q];
    ss = wave_sum(ss);
    const float rs = rsqrtf(ss * (1.0f / 2048.0f) + 1e-6f);
#pragma unroll
    for (int j = 0; j < 4; ++j) { const int e = j * 512 + lane * 8;
        const float4 g0 = *(const float4*)(gw + e), g1 = *(const float4*)(gw + e + 4), h0 = *(const float4*)(shift + e), h1 = *(const float4*)(shift + e + 4), c0 = *(const float4*)(scale + e), c1 = *(const float4*)(scale + e + 4);
        const float y0 = x[j * 8 + 0] * rs * g0.x * (1.f + c0.x) + h0.x, y1 = x[j * 8 + 1] * rs * g0.y * (1.f + c0.y) + h0.y, y2 = x[j * 8 + 2] * rs * g0.z * (1.f + c0.z) + h0.z, y3 = x[j * 8 + 3] * rs * g0.w * (1.f + c0.w) + h0.w;
        const float y4 = x[j * 8 + 4] * rs * g1.x * (1.f + c1.x) + h1.x, y5 = x[j * 8 + 5] * rs * g1.y * (1.f + c1.y) + h1.y, y6 = x[j * 8 + 6] * rs * g1.z * (1.f + c1.z) + h1.z, y7 = x[j * 8 + 7] * rs * g1.w * (1.f + c1.w) + h1.w;
        u32x4 o; o.x = pk_bf16(y0, y1); o.y = pk_bf16(y2, y3); o.z = pk_bf16(y4, y5); o.w = pk_bf16(y6, y7);
        *(u32x4*)(dst + e) = o; }
}
__device__ __forceinline__ void phase_norm(const Ctx& F, const float* xlat, const float* xctx, const float* gw, const float* mod, int shift_i, int scale_i, bf16_t* dst, int nrows) {
    for (int row = F.bid * 8 + F.wave; row < nrows; row += F.G * 8) {
        const bool isctx = row >= NLAT; const float* xr = isctx ? xctx + (size_t)(row - NLAT) * 2048 : xlat + (size_t)row * 2048;
        const int v = isctx ? 4 : (row >> 12);
        float x[32];
#pragma unroll
        for (int j = 0; j < 4; ++j) { const int e = j * 512 + F.lane * 8; const float4 a = *(const float4*)(xr + e), b = *(const float4*)(xr + e + 4);
            x[j * 8 + 0] = a.x; x[j * 8 + 1] = a.y; x[j * 8 + 2] = a.z; x[j * 8 + 3] = a.w; x[j * 8 + 4] = b.x; x[j * 8 + 5] = b.y; x[j * 8 + 6] = b.z; x[j * 8 + 7] = b.w; }
        norm_store(x, gw, mod + (size_t)v * 12288 + shift_i * 2048, mod + (size_t)v * 12288 + scale_i * 2048, dst + (size_t)row * 2048, F.lane);
    }
}

struct LayerW {
    const float *sc_w, *rw_w0, *rw_wup, *rw_a0, *rw_aup, *rw_gup, *rw_kk, *rw_ka, *rw_rk, *rw_lnw, *rw_lnb, *na_q, *na_k, *rpb, *s_cw, *s_cb, *s_dtb, *s_alog, *s_d, *s_norm;
};
__device__ __forceinline__ void unpack8(const u32x4 q, float (&f)[8]) { f[0] = bflo(q[0]); f[1] = bfhi(q[0]); f[2] = bflo(q[1]); f[3] = bfhi(q[1]); f[4] = bflo(q[2]); f[5] = bfhi(q[2]); f[6] = bflo(q[3]); f[7] = bfhi(q[3]); }
__device__ __forceinline__ u32x4 pack8f(const float (&f)[8]) { u32x4 o; o[0] = pk_bf16(f[0], f[1]); o[1] = pk_bf16(f[2], f[3]); o[2] = pk_bf16(f[4], f[5]); o[3] = pk_bf16(f[6], f[7]); return o; }
__device__ __forceinline__ void load8f(const float* p, float (&f)[8]) { const float4 a = *(const float4*)p, b = *(const float4*)(p + 4); f[0] = a.x; f[1] = a.y; f[2] = a.z; f[3] = a.w; f[4] = b.x; f[5] = b.y; f[6] = b.z; f[7] = b.w; }
__device__ __forceinline__ void phase_prep(const Ctx& F, const LayerW& W, unsigned char* ws) {
    const bf16_t* P = (const bf16_t*)(ws + WS_P);
    bf16_t* MIX = (bf16_t*)(ws + WS_MIX);
    bf16_t* XBC = (bf16_t*)(ws + WS_XBC); float* DTS = (float*)(ws + WS_DTS); float* DEC = (float*)(ws + WS_DEC);
    bf16_t* QN = (bf16_t*)(ws + WS_QN); bf16_t* KN = (bf16_t*)(ws + WS_KN); bf16_t* VTL = (bf16_t*)(ws + WS_VTL); bf16_t* VTC = (bf16_t*)(ws + WS_VTC);
    const float* ROPE = (const float*)(ws + WS_ROPE);
    for (int tile = F.bid; tile < NTOK / 8; tile += F.G) {
        int ln = F.lane; asm volatile("" : "+v"(ln));
        const int ch0 = ln * 8;
        const bool lat = tile < NLAT / 8;
        const int b = lat ? (tile >> 9) : ((tile - NLAT / 8) >> 5);
        const int t0 = lat ? (tile & 511) * 8 : ((tile - NLAT / 8) & 31) * 8;
        const int L = lat ? SEQL : CTXL;
        const int g0 = lat ? b * SEQL + t0 : NLAT + b * CTXL + t0;
        const bf16_t* Pr = P + (size_t)g0 * PTP;
        if (F.wave == 0 || F.wave == 4) {
            const bool gated = F.wave == 0;
            const float* cw = gated ? W.sc_w : W.s_cw; const int cstride = gated ? 512 : 1024;
            float w0[8], w1[8], w2[8], cb[8];
            load8f(cw + ch0, w0); load8f(cw + cstride + ch0, w1); load8f(cw + 2 * cstride + ch0, w2);
            if (gated) {
#pragma unroll
                for (int e = 0; e < 8; ++e) cb[e] = 0.f;
            } else load8f(W.s_cb + ch0, cb);
            const int col = gated ? A_CG : D_X;
#pragma unroll 1
            for (int tb = 0; tb < 8; tb += 4) {
            u32x4 ra[6], rb[6], rg[4];
#pragma unroll
            for (int q = 0; q < 6; ++q) { const int tq = t0 + tb - 1 + q; const bool ok = (tq >= 0) && (tq < L);
                ra[q] = ok ? *(const u32x4*)(Pr + (ptrdiff_t)(tb + q - 1) * PTP + col + ch0) : (u32x4){0u, 0u, 0u, 0u};
                if (gated) rb[q] = ok ? *(const u32x4*)(Pr + (ptrdiff_t)(tb + q - 1) * PTP + A_H + ch0) : (u32x4){0u, 0u, 0u, 0u}; }
            if (gated) {
#pragma unroll
                for (int tt = 0; tt < 4; ++tt) rg[tt] = *(const u32x4*)(Pr + (size_t)(tb + tt) * PTP + A_BG + ch0); }
            float up[8], uc[8], un[8];
            { float x[8], y[8]; unpack8(ra[0], x); if (gated) { unpack8(rb[0], y);
#pragma unroll
                for (int e = 0; e < 8; ++e) x[e] *= y[e]; }
#pragma unroll
              for (int e = 0; e < 8; ++e) up[e] = x[e];
              unpack8(ra[1], x); if (gated) { unpack8(rb[1], y);
#pragma unroll
                for (int e = 0; e < 8; ++e) x[e] *= y[e]; }
#pragma unroll
              for (int e = 0; e < 8; ++e) uc[e] = x[e]; }
#pragma unroll
            for (int tt = 0; tt < 4; ++tt) {
                { float x[8], y[8]; unpack8(ra[tt + 2], x); if (gated) { unpack8(rb[tt + 2], y);
#pragma unroll
                    for (int e = 0; e < 8; ++e) x[e] *= y[e]; }
#pragma unroll
                  for (int e = 0; e < 8; ++e) un[e] = x[e]; }
                float o[8];
                if (gated) { float bg[8]; unpack8(rg[tt], bg);
#pragma unroll
                    for (int e = 0; e < 8; ++e) o[e] = bg[e] * (w0[e] * up[e] + w1[e] * uc[e] + w2[e] * un[e]);
                    *(u32x4*)(MIX + (size_t)(g0 + tb + tt) * 2048 + ch0) = pack8f(o);
                } else {
#pragma unroll
                    for (int e = 0; e < 8; ++e) o[e] = siluf_(w0[e] * up[e] + w1[e] * uc[e] + w2[e] * un[e] + cb[e]);
                    *(u32x4*)(XBC + (size_t)(g0 + tb + tt) * 1024 + ch0) = pack8f(o); }
#pragma unroll
                for (int e = 0; e < 8; ++e) { up[e] = uc[e]; uc[e] = un[e]; }
            }
            }
        } else if (F.wave == 1 || F.wave == 2) {
            const bool isq = F.wave == 1; const int col = isq ? C_Q : C_K; bf16_t* dst = isq ? QN : KN;
            float nw[8]; load8f((isq ? W.na_q : W.na_k) + (ln & 7) * 8, nw);
            const float sc = isq ? 0.125f : 1.0f;
            u32x4 rq[8];
#pragma unroll
            for (int tt = 0; tt < 8; ++tt) rq[tt] = *(const u32x4*)(Pr + (size_t)tt * PTP + col + ch0);
#pragma unroll
            for (int tt = 0; tt < 8; ++tt) { float x[8]; unpack8(rq[tt], x); float ss = 0.f;
#pragma unroll
                for (int e = 0; e < 8; ++e) ss += x[e] * x[e];
                ss = sum8(ss); const float rs = rsqrtf(ss * (1.f / 64.f) + 1e-6f) * sc;
#pragma unroll
                for (int e = 0; e < 8; ++e) x[e] = x[e] * rs * nw[e];
                if (isq) *(u32x4*)(dst + (size_t)(g0 + tt) * 512 + ch0) = pack8f(x);
                else {
                    const int hh = ln >> 3, p = ln & 7, t = t0 + tt;
                    bf16_t* kd = lat ? dst + ((size_t)((((b * 8 + hh) * 64 + (t >> 6)) * 2 + (p >> 2)) * 4 + (p & 3)) * 64 + (t & 63)) * 8
                                     : dst + (size_t)NLAT * 512 + ((size_t)(((b * 8 + hh) * 2 + (p >> 2)) * 4 + (p & 3)) * 256 + t) * 8;
                    *(u32x4*)kd = pack8f(x); } }
        } else if (F.wave == 3) {
            u32x4 rv[8];
#pragma unroll
            for (int tt = 0; tt < 8; ++tt) rv[tt] = *(const u32x4*)(Pr + (size_t)tt * PTP + C_V + ch0);
            const int h = ln >> 3;
#pragma unroll
            for (int e = 0; e < 8; ++e) { const int i = (ln & 7) * 8 + e;
                unsigned short v[8];
#pragma unroll
                for (int tt = 0; tt < 8; ++tt) v[tt] = (unsigned short)((e & 1) ? (rv[tt][e >> 1] >> 16) : (rv[tt][e >> 1] & 0xffffu));
                u32x2 c0; c0.x = (unsigned)v[0] | ((unsigned)v[1] << 16); c0.y = (unsigned)v[2] | ((unsigned)v[3] << 16);
                u32x2 c1; c1.x = (unsigned)v[4] | ((unsigned)v[5] << 16); c1.y = (unsigned)v[6] | ((unsigned)v[7] << 16);
                if (lat) { const int row = t0 >> 6, x0 = (t0 & 63) >> 2, x1 = x0 + 1;
                    bf16_t* base = VTL + ((size_t)((b * 8 + h) * 64 + row) * 12 * 64 + i) * 8;
                    if (x0 <= 11) *(u32x2*)(base + x0 * 512) = c0;
                    if (x0 >= 4)  *(u32x2*)(base + (x0 - 4) * 512 + 4) = c0;
                    if (x1 <= 11) *(u32x2*)(base + x1 * 512) = c1;
                    if (x1 >= 4)  *(u32x2*)(base + (x1 - 4) * 512 + 4) = c1;
                } else { const int m = t0 >> 5, o = t0 & 31, gq = (o & 15) >> 2, hf = (o >> 4) * 4;
                    bf16_t* base = VTC + ((size_t)(((b * 8 + h) * 8 + m) * 4) * 64 + i) * 8;
                    *(u32x2*)(base + gq * 512 + hf) = c0; *(u32x2*)(base + (gq + 1) * 512 + hf) = c1; } }
        } else if (F.wave == 5 || F.wave == 7) {
            {
                const int pg = ln & 15, tb = (ln >> 4) * 2, which = F.wave == 7 ? 1 : 0, gi = (pg >> 3) & 1, half = (pg >> 2) & 1, i0 = (pg & 3) * 8;
                const int c1 = 512 + which * 256 + gi * 128 + half * 64 + i0, c2 = c1 + 32;
                float wa0[8], wa1[8], wa2[8], ba[8], wb0[8], wb1[8], wb2[8], bb[8];
                load8f(W.s_cw + c1, wa0); load8f(W.s_cw + 1024 + c1, wa1); load8f(W.s_cw + 2048 + c1, wa2); load8f(W.s_cb + c1, ba);
                load8f(W.s_cw + c2, wb0); load8f(W.s_cw + 1024 + c2, wb1); load8f(W.s_cw + 2048 + c2, wb2); load8f(W.s_cb + c2, bb);
                u32x4 ra[4], rb[4];
#pragma unroll
                for (int q = 0; q < 4; ++q) { const int tq = t0 + tb - 1 + q; const bool ok = (tq >= 0) && (tq < L);
                    ra[q] = ok ? *(const u32x4*)(Pr + (ptrdiff_t)(tb + q - 1) * PTP + D_X + c1) : (u32x4){0u, 0u, 0u, 0u};
                    rb[q] = ok ? *(const u32x4*)(Pr + (ptrdiff_t)(tb + q - 1) * PTP + D_X + c2) : (u32x4){0u, 0u, 0u, 0u}; }
                float ap[8], ac[8], an[8], bp[8], bc[8], bn[8];
                unpack8(ra[0], ap); unpack8(ra[1], ac); unpack8(rb[0], bp); unpack8(rb[1], bc);
#pragma unroll
                for (int tt = 0; tt < 2; ++tt) { unpack8(ra[tt + 2], an); unpack8(rb[tt + 2], bn);
                    float y1[8], y2[8];
#pragma unroll
                    for (int e = 0; e < 8; ++e) { y1[e] = siluf_(wa0[e] * ap[e] + wa1[e] * ac[e] + wa2[e] * an[e] + ba[e]); y2[e] = siluf_(wb0[e] * bp[e] + wb1[e] * bc[e] + wb2[e] * bn[e] + bb[e]); }
                    if (lat) { const int t = t0 + tb + tt, pos = half ? (t & 63) : (t >> 6);
                        float cs[16];
#pragma unroll
                        for (int q = 0; q < 4; ++q) { const float4 v = *(const float4*)(ROPE + (size_t)(pos * 32 + i0) * 2 + 4 * q); cs[4 * q] = v.x; cs[4 * q + 1] = v.y; cs[4 * q + 2] = v.z; cs[4 * q + 3] = v.w; }
#pragma unroll
                        for (int e = 0; e < 8; ++e) { const float o1 = y1[e] * cs[2 * e] - y2[e] * cs[2 * e + 1], o2 = y1[e] * cs[2 * e + 1] + y2[e] * cs[2 * e]; y1[e] = o1; y2[e] = o2; } }
                    *(u32x4*)(XBC + (size_t)(g0 + tb + tt) * 1024 + c1) = pack8f(y1); *(u32x4*)(XBC + (size_t)(g0 + tb + tt) * 1024 + c2) = pack8f(y2);
#pragma unroll
                    for (int e = 0; e < 8; ++e) { ap[e] = ac[e]; ac[e] = an[e]; bp[e] = bc[e]; bc[e] = bn[e]; }
                }
            }
        } else if (F.wave == 6) {
#pragma unroll
            for (int q = 0; q < 2; ++q) { const int it = ln + 64 * q, tt = it >> 4, j = it & 15;
                const float x = bf2f(Pr[(size_t)tt * PTP + D_DT + j]) + W.s_dtb[j];
                const float sp = fmaxf(x, 0.f) + log1pf(__expf(-fabsf(x)));
                DTS[(size_t)(g0 + tt) * 16 + j] = sp; DEC[(size_t)(g0 + tt) * 16 + j] = -sp * __expf(W.s_alog[j]); }
        }
    }
}

constexpr int SB_PITCH = 136;
__device__ __forceinline__ void ssd_scan_L(const Ctx& F, LAS float* sL, const float* LA, int g0, int h) {
    const int d = (F.tid >> 7) & 1, t = F.tid & 127;
    float v = 0.f;
    if (F.tid < 256) { v = LA[(size_t)(g0 + t) * 16 + d * 8 + h]; sL[F.tid] = v; }
    __syncthreads();
#pragma unroll
    for (int off = 1; off < 128; off <<= 1) {
        float o = 0.f;
        if (F.tid < 256) { const int tp = d ? t + off : t - off; if (tp >= 0 && tp < 128) o = sL[d * 128 + tp]; }
        __syncthreads();
        if (F.tid < 256) { v += o; sL[F.tid] = v; }
        __syncthreads();
    }
}
template <bool PASS2>
__device__ __forceinline__ void ssd_task(const Ctx& F, const LayerW& W, unsigned char* ws, int task) {
    const bf16_t* XBC = (const bf16_t*)(ws + WS_XBC); const float* DTS = (const float*)(ws + WS_DTS); const float* LA = (const float*)(ws + WS_DEC);
    float* SST = (float*)(ws + WS_SST); float* SCD = (float*)(ws + WS_SCD); float* YS = (float*)(ws + WS_YS);
    const int c = task % NCH, bh = task / NCH, h = bh & 7, b = bh >> 3, gi = h >> 2;
    const int g0 = c < 2 ? NLAT + b * CTXL + c * 128 : b * SEQL + (c - 2) * 128;
    const int w = F.wave, l16 = F.lane & 15, g = F.lane >> 4;
    const f32x4 z4 = {0.f, 0.f, 0.f, 0.f};
    LAS float* sL = (LAS float*)(F.lds + 131072);
    LAS float* sDT = sL + 256;
    __syncthreads();
    if (F.tid < 256) { const int s = F.tid >> 1, d = F.tid & 1; sDT[F.tid] = DTS[(size_t)(g0 + s) * 16 + d * 8 + h]; }
    ssd_scan_L(F, sL, LA, g0, h);
    if (!PASS2) {
        LAS bf16_t* sBT = (LAS bf16_t*)F.lds;
        LAS bf16_t* sXT = sBT + 128 * SB_PITCH;
#pragma unroll
        for (int q = 0; q < 4; ++q) { const int v = F.tid + 512 * q, s = v >> 4, part = v & 15;
            const u32x4 bv = *(const u32x4*)(XBC + (size_t)(g0 + s) * 1024 + 512 + gi * 128 + part * 8);
#pragma unroll
            for (int e = 0; e < 4; ++e) { sBT[(part * 8 + 2 * e) * SB_PITCH + s] = (bf16_t)(bv[e] & 0xffffu); sBT[(part * 8 + 2 * e + 1) * SB_PITCH + s] = (bf16_t)(bv[e] >> 16); } }
#pragma unroll
        for (int q = 0; q < 2; ++q) { const int v = F.tid + 512 * q, s = v >> 3, part = v & 7;
            const u32x4 xv = *(const u32x4*)(XBC + (size_t)(g0 + s) * 1024 + h * 64 + part * 8);
            const float sc0 = sDT[s * 2] * __expf(sL[127] - sL[s]), sc1 = sDT[s * 2 + 1] * __expf(sL[128] - sL[128 + s]);
#pragma unroll
            for (int e = 0; e < 4; ++e) { const float lo = bflo(xv[e]), hi = bfhi(xv[e]); const int p = part * 8 + 2 * e;
                sXT[p * SB_PITCH + s] = f2bf(lo * sc0); sXT[(p + 1) * SB_PITCH + s] = f2bf(hi * sc0);
                sXT[(64 + p) * SB_PITCH + s] = f2bf(lo * sc1); sXT[(64 + p + 1) * SB_PITCH + s] = f2bf(hi * sc1); } }
        __syncthreads();
        bf16x8 bfr[4];
#pragma unroll
        for (int ks = 0; ks < 4; ++ks) bfr[ks] = *(const LAS bf16x8*)(sBT + (16 * w + l16) * SB_PITCH + 32 * ks + 8 * g);
#pragma unroll
        for (int d = 0; d < 2; ++d) {
            float* st = SST + ((size_t)((b * 8 + h) * 2 + d) * NCH + c) * 8192;
#pragma unroll
            for (int pt = 0; pt < 4; ++pt) { f32x4 acc = z4;
#pragma unroll
                for (int ks = 0; ks < 4; ++ks) acc = __builtin_amdgcn_mfma_f32_16x16x32_bf16(*(const LAS bf16x8*)(sXT + (d * 64 + 16 * pt + l16) * SB_PITCH + 32 * ks + 8 * g), bfr[ks], acc, 0, 0, 0);
#pragma unroll
                for (int r = 0; r < 4; ++r) st[(16 * pt + 4 * g + r) * 128 + 16 * w + l16] = acc[r]; }
            if (F.tid == 0) SCD[((b * 8 + h) * 2 + d) * NCH + c] = __expf(d ? sL[128] : sL[127]);
        }
    } else {
        LAS bf16_t* sB = (LAS bf16_t*)F.lds;
        LAS bf16_t* sC = sB + 128 * SB_PITCH;
        LAS bf16_t* sXT = sC + 128 * SB_PITCH;
        LAS bf16_t* sS = sXT + 64 * SB_PITCH;
#pragma unroll
        for (int q = 0; q < 4; ++q) { const int v = F.tid + 512 * q, s = v >> 4, part = v & 15;
            *(LAS u32x4*)(sB + s * SB_PITCH + part * 8) = *(const u32x4*)(XBC + (size_t)(g0 + s) * 1024 + 512 + gi * 128 + part * 8);
            *(LAS u32x4*)(sC + s * SB_PITCH + part * 8) = *(const u32x4*)(XBC + (size_t)(g0 + s) * 1024 + 768 + gi * 128 + part * 8); }
#pragma unroll
        for (int q = 0; q < 2; ++q) { const int v = F.tid + 512 * q, s = v >> 3, part = v & 7;
            const u32x4 xv = *(const u32x4*)(XBC + (size_t)(g0 + s) * 1024 + h * 64 + part * 8);
#pragma unroll
            for (int e = 0; e < 4; ++e) { sXT[(part * 8 + 2 * e) * SB_PITCH + s] = (bf16_t)(xv[e] & 0xffffu); sXT[(part * 8 + 2 * e + 1) * SB_PITCH + s] = (bf16_t)(xv[e] >> 16); } }
#pragma unroll
        for (int q = 0; q < 4; ++q) { const int v = F.tid + 512 * q, d = v >> 10, p = (v >> 4) & 63, part = v & 15;
            const float* sp = SST + ((size_t)((b * 8 + h) * 2 + d) * NCH + c) * 8192 + p * 128 + part * 8;
            const float4 a0 = *(const float4*)sp, a1 = *(const float4*)(sp + 4);
            u32x4 o; o.x = pk_bf16(a0.x, a0.y); o.y = pk_bf16(a0.z, a0.w); o.z = pk_bf16(a1.x, a1.y); o.w = pk_bf16(a1.z, a1.w);
            *(LAS u32x4*)(sS + (d * 64 + p) * SB_PITCH + part * 8) = o; }
        __syncthreads();
        const int t = 16 * w + l16;
        bf16x8 cfr[4];
#pragma unroll
        for (int ks = 0; ks < 4; ++ks) cfr[ks] = *(const LAS bf16x8*)(sC + t * SB_PITCH + 32 * ks + 8 * g);
        f32x4 gt[8];
#pragma unroll
        for (int a = 0; a < 8; ++a) { f32x4 acc = z4;
#pragma unroll
            for (int ks = 0; ks < 4; ++ks) acc = __builtin_amdgcn_mfma_f32_16x16x32_bf16(*(const LAS bf16x8*)(sB + (16 * a + l16) * SB_PITCH + 32 * ks + 8 * g), cfr[ks], acc, 0, 0, 0);
            gt[a] = acc; }
        f32x4 ysum[4] = {z4, z4, z4, z4};
#pragma unroll
        for (int d = 0; d < 2; ++d) {
            const float Lt = sL[d * 128 + t], eLt = __expf(Lt);
            f32x4 acc[4];
#pragma unroll
            for (int pt = 0; pt < 4; ++pt) { f32x4 a = z4;
#pragma unroll
                for (int ks = 0; ks < 4; ++ks) a = __builtin_amdgcn_mfma_f32_16x16x32_bf16(*(const LAS bf16x8*)(sS + (d * 64 + 16 * pt + l16) * SB_PITCH + 32 * ks + 8 * g), cfr[ks], a, 0, 0, 0);
                acc[pt] = a * eLt; }
#pragma unroll
            for (int m = 0; m < 4; ++m) {
                const bool need = d ? (2 * m + 1 >= w) : (2 * m <= w);
                if (need) {
                    f32x4 wt[2];
#pragma unroll
                    for (int u = 0; u < 2; ++u) { const int a = 2 * m + u;
                        const f32x4 Ls = *(const LAS f32x4*)(sL + d * 128 + 16 * a + 4 * g);
#pragma unroll
                        for (int r = 0; r < 4; ++r) { const int s = 16 * a + 4 * g + r; const bool ok = d ? (s >= t) : (s <= t);
                            const float dts = sDT[s * 2 + d];
                            wt[u][r] = ok ? gt[a][r] * __expf(Lt - Ls[r]) * dts : 0.f; } }
                    const bf16x8 bfrag = pack8(wt[0], wt[1]);
#pragma unroll
                    for (int pt = 0; pt < 4; ++pt) { union { bf16x8 v; u32x2 hh[2]; } af;
                        af.hh[0] = *(const LAS u32x2*)(sXT + (16 * pt + l16) * SB_PITCH + 32 * m + 4 * g); af.hh[1] = *(const LAS u32x2*)(sXT + (16 * pt + l16) * SB_PITCH + 32 * m + 16 + 4 * g);
                        acc[pt] = __builtin_amdgcn_mfma_f32_16x16x32_bf16(af.v, bfrag, acc[pt], 0, 0, 0); }
                }
            }
#pragma unroll
            for (int pt = 0; pt < 4; ++pt) ysum[pt] = ysum[pt] + acc[pt];
        }
        const float dsk = W.s_d[h];
#pragma unroll
        for (int pt = 0; pt < 4; ++pt) { const int p = 16 * pt + 4 * g;
            const u32x2 xv = *(const u32x2*)(XBC + (size_t)(g0 + t) * 1024 + h * 64 + p);
            *(float4*)(YS + (size_t)(g0 + t) * 512 + h * 64 + p) = make_float4(ysum[pt][0] + dsk * bflo(xv.x), ysum[pt][1] + dsk * bfhi(xv.x), ysum[pt][2] + dsk * bflo(xv.y), ysum[pt][3] + dsk * bfhi(xv.y)); }
    }
}
template <int D> __device__ __forceinline__ void ssd_combine_one(float4* base, const float* scd) {
    float4 carry = make_float4(0.f, 0.f, 0.f, 0.f);
#pragma unroll
    for (int k0 = 0; k0 < NCH; k0 += 17) {
        float4 tmp[17];
#pragma unroll
        for (int k = 0; k < 17; ++k) { const int kk = k0 + k, c = D ? (kk < 2 ? 1 - kk : 35 - kk) : kk; tmp[k] = base[(size_t)c * 2048]; }
#pragma unroll
        for (int k = 0; k < 17; ++k) { const int kk = k0 + k, c = D ? (kk < 2 ? 1 - kk : 35 - kk) : kk; const float a = scd[c];
            base[(size_t)c * 2048] = carry;
            carry.x = a * carry.x + tmp[k].x; carry.y = a * carry.y + tmp[k].y; carry.z = a * carry.z + tmp[k].z; carry.w = a * carry.w + tmp[k].w; }
    }
}
__device__ __forceinline__ void phase_ssd_combine(const Ctx& F, unsigned char* ws) {
    float4* SST4 = (float4*)(ws + WS_SST); const float* SCD = (const float*)(ws + WS_SCD);
    for (int gt = F.bid * 512 + F.tid; gt < 64 * 2048; gt += F.G * 512) {
        const int sidx = gt >> 11, e4 = gt & 2047;
        float4* base = SST4 + (size_t)sidx * NCH * 2048 + e4;
        if (sidx & 1) ssd_combine_one<1>(base, SCD + sidx * NCH); else ssd_combine_one<0>(base, SCD + sidx * NCH);
    }
}

constexpr int RWF_CHUNK = 13312;
constexpr int RW_NCHUNK = NPOS / 16;
template <int CTRL> __device__ __forceinline__ float dpp_id0(float v) { return __int_as_float(__builtin_amdgcn_update_dpp(0, __float_as_int(v), CTRL, 0xF, 0xF, true)); }
template <int CTRL> __device__ __forceinline__ float dpp_id1(float v) { return __int_as_float(__builtin_amdgcn_update_dpp(0x3f800000, __float_as_int(v), CTRL, 0xF, 0xF, false)); }
__device__ __forceinline__ float sel4(int g, float a, float b, float c, float d) { return g == 0 ? a : (g == 1 ? b : (g == 2 ? c : d)); }

template <int D> __device__ __forceinline__ void rwkv_pre_dir(const bf16_t* wupt, const bf16x8 (&bw)[2], const bf16x8 (&ba)[2], const f32x4 (&kk)[4], const f32x4 (&rr)[4], const f32x4 (&kx)[4],
        const float* w0p, const float* a0p, const float* kap, const float* rkp, float& bon, LAS unsigned char* wl, unsigned char* dst, int l16, int g) {
    LAS float* LT = (LAS float*)wl; LAS float* AT = LT + 256; LAS bf16_t* BT = (LAS bf16_t*)(wl + 2048); LAS bf16_t* KT = BT + 1024;
    const int lane = g * 16 + l16;
    bf16x8* o = (bf16x8*)dst;
    const f32x4 z4 = {0.f, 0.f, 0.f, 0.f};
    bf16x8 af[2], bf[2], kf[2], rf[2];
#pragma unroll
    for (int p = 0; p < 2; ++p) {
        f32x4 al[2], be[2], ka[2], rh[2];
#pragma unroll
        for (int mm = 0; mm < 2; ++mm) { const int m = 2 * p + mm; asm volatile("" ::: "memory");
            const bf16_t* wpw = wupt + ((size_t)D * 512 + 16 * m + l16) * 64 + 8 * g; const bf16_t* wpa = wupt + ((size_t)(2 + D) * 512 + 16 * m + l16) * 64 + 8 * g;
            f32x4 aw = __builtin_amdgcn_mfma_f32_16x16x32_bf16(*(const bf16x8*)wpw, bw[0], z4, 0, 0, 0); aw = __builtin_amdgcn_mfma_f32_16x16x32_bf16(*(const bf16x8*)(wpw + 32), bw[1], aw, 0, 0, 0);
            f32x4 aa = __builtin_amdgcn_mfma_f32_16x16x32_bf16(*(const bf16x8*)wpa, ba[0], z4, 0, 0, 0); aa = __builtin_amdgcn_mfma_f32_16x16x32_bf16(*(const bf16x8*)(wpa + 32), ba[1], aa, 0, 0, 0);
            const float4 w0 = *(const float4*)(w0p + 16 * m + 4 * g), a0 = *(const float4*)(a0p + 16 * m + 4 * g), kav = *(const float4*)(kap + 16 * m + 4 * g), rkv = *(const float4*)(rkp + 16 * m + 4 * g);
            const float w0a[4] = {w0.x, w0.y, w0.z, w0.w}, a0a[4] = {a0.x, a0.y, a0.z, a0.w}, kaa[4] = {kav.x, kav.y, kav.z, kav.w}, rka[4] = {rkv.x, rkv.y, rkv.z, rkv.w};
            f32x4 gcv;
#pragma unroll
            for (int r = 0; r < 4; ++r) {
                const float a = sigmoidf_(a0a[r] + aa[r]);
                const float kd = kx[m][r] * (1.f + (a - 1.f) * kaa[r]), bb = kk[m][r] * a;
                bon += rr[m][r] * kd * rka[r];
                float Lg = -0.8750387749205294f * sigmoidf_(w0a[r] + aw[r]);
                if (D == 0) { Lg += dpp_id0<0x111>(Lg); Lg += dpp_id0<0x112>(Lg); Lg += dpp_id0<0x114>(Lg); Lg += dpp_id0<0x118>(Lg); }
                else        { Lg += dpp_id0<0x101>(Lg); Lg += dpp_id0<0x102>(Lg); Lg += dpp_id0<0x104>(Lg); Lg += dpp_id0<0x108>(Lg); }
                const float Lex = (D == 0) ? dpp_id0<0x111>(Lg) : dpp_id0<0x101>(Lg);
                const float G = __builtin_amdgcn_exp2f(Lg), Gex = __builtin_amdgcn_exp2f(Lex), iG = __builtin_amdgcn_exp2f(-Lg);
                al[mm][r] = Gex * kk[m][r]; be[mm][r] = bb * iG; ka[mm][r] = kd * iG; rh[mm][r] = G * rr[m][r]; gcv[r] = G;
                const int k = 16 * m + 4 * g + r; const unsigned pk_ = pk_bf16(be[mm][r], ka[mm][r]); BT[k * 16 + l16] = (bf16_t)(pk_ & 0xffffu); KT[k * 16 + l16] = (bf16_t)(pk_ >> 16);
            }
            if (l16 == ((D == 0) ? 15 : 0)) *(float4*)((float*)(dst + 12288) + 16 * m + 4 * g) = make_float4(gcv[0], gcv[1], gcv[2], gcv[3]);
        }
        af[p] = pack8(al[0], al[1]); bf[p] = pack8(be[0], be[1]); kf[p] = pack8(ka[0], ka[1]); rf[p] = pack8(rh[0], rh[1]);
        o[64 * p + lane] = af[p]; o[128 + 64 * p + lane] = rf[p];
        __builtin_amdgcn_sched_barrier(0);
    }
    f32x4 Lm = __builtin_amdgcn_mfma_f32_16x16x32_bf16(af[0], bf[0], z4, 0, 0, 0); Lm = __builtin_amdgcn_mfma_f32_16x16x32_bf16(af[1], bf[1], Lm, 0, 0, 0);
    f32x4 Am = __builtin_amdgcn_mfma_f32_16x16x32_bf16(af[0], kf[0], z4, 0, 0, 0); Am = __builtin_amdgcn_mfma_f32_16x16x32_bf16(af[1], kf[1], Am, 0, 0, 0);
    f32x4 Bb = __builtin_amdgcn_mfma_f32_16x16x32_bf16(bf[0], rf[0], z4, 0, 0, 0); Bb = __builtin_amdgcn_mfma_f32_16x16x32_bf16(bf[1], rf[1], Bb, 0, 0, 0);
    f32x4 Bk = __builtin_amdgcn_mfma_f32_16x16x32_bf16(kf[0], rf[0], z4, 0, 0, 0); Bk = __builtin_amdgcn_mfma_f32_16x16x32_bf16(kf[1], rf[1], Bk, 0, 0, 0);
#pragma unroll
    for (int r = 0; r < 4; ++r) { const int row = 4 * g + r;
        const bool strict = (D == 0) ? (l16 < row) : (l16 > row);
        const bool incl = (D == 0) ? (row <= l16) : (row >= l16);
        Lm[r] = strict ? Lm[r] : 0.f; Am[r] = strict ? Am[r] : 0.f; Bb[r] = incl ? Bb[r] : 0.f; Bk[r] = incl ? Bk[r] : 0.f; }
    *(LAS f32x4*)(LT + l16 * 16 + 4 * g) = Lm; *(LAS f32x4*)(AT + l16 * 16 + 4 * g) = Am;
    o[320 + lane] = pack8(Bb, Bk);
    asm volatile("" ::: "memory");
#pragma unroll
    for (int m = 0; m < 4; ++m) { union { bf16x8 v; u32x2 h[2]; } f;
        f.h[0] = *(LAS u32x2*)(BT + (16 * m + l16) * 16 + 4 * g); f.h[1] = *(LAS u32x2*)(KT + (16 * m + l16) * 16 + 4 * g);
        o[384 + 64 * m + lane] = f.v; }
    __builtin_amdgcn_sched_barrier(0);
    float x[16];
    if (D == 0) {
#pragma unroll
        for (int c = 15; c >= 0; --c) { float s = (c == l16) ? 1.f : 0.f; asm volatile("" ::: "memory");
#pragma unroll
            for (int i = c + 1; i < 16; ++i) s -= x[i] * LT[c * 16 + i];
            x[c] = s; }
    } else {
#pragma unroll
        for (int c = 0; c < 16; ++c) { float s = (c == l16) ? 1.f : 0.f; asm volatile("" ::: "memory");
#pragma unroll
            for (int i = 0; i < c; ++i) s -= x[i] * LT[c * 16 + i];
            x[c] = s; }
    }
    f32x4 tm0, tm1;
#pragma unroll
    for (int r = 0; r < 4; ++r) tm0[r] = -sel4(g, x[r], x[4 + r], x[8 + r], x[12 + r]);
#pragma unroll
    for (int r = 0; r < 4; ++r) { const int c = 4 * g + r; float s = 0.f; asm volatile("" ::: "memory");
#pragma unroll
        for (int i = 0; i < 16; i += 4) { const f32x4 a4 = *(LAS f32x4*)(AT + c * 16 + i); s += x[i] * a4[0] + x[i + 1] * a4[1] + x[i + 2] * a4[2] + x[i + 3] * a4[3]; }
        tm1[r] = -s; }
    o[256 + lane] = pack8(tm0, tm1);
    asm volatile("" ::: "memory");
}
__device__ __forceinline__ void rwkv_pre_task(const Ctx& F, const LayerW& W, unsigned char* ws, const bf16_t* WUPT, int task, int dsel) {
    const bf16_t* P = (const bf16_t*)(ws + WS_P); float* BON = (float*)(ws + WS_BON); unsigned char* RWF = ws + WS_RWF;
    const int cidx = task % RW_NCHUNK, bh = task / RW_NCHUNK, h = bh & 7, b = bh >> 3;
    int ln_ = F.lane; asm volatile("" : "+v"(ln_));
    const int l16 = ln_ & 15, g = ln_ >> 4;
    const int pos = cidx * 16 + l16;
    const int tok = pos < CTXL ? NLAT + b * CTXL + pos : b * SEQL + (pos - CTXL);
    const bf16_t* Pr = P + (size_t)tok * PTP;
    LAS unsigned char* wl = F.lds + F.wave * 8192;
    bf16x8 bw[2], ba[2];
#pragma unroll
    for (int p = 0; p < 2; ++p) { const u32x4 q = *(const u32x4*)(Pr + B_WD + 32 * p + 8 * g); union { bf16x8 v; unsigned u[4]; } tq;
#pragma unroll
        for (int e = 0; e < 4; ++e) tq.u[e] = pk_bf16(tanhf_(bflo(q[e])), tanhf_(bfhi(q[e])));
        bw[p] = tq.v; ba[p] = *(const bf16x8*)(Pr + B_AD + 32 * p + 8 * g); }
    f32x4 kk[4], rr[4], kx[4];
    float ssq = 0.f;
#pragma unroll
    for (int m = 0; m < 4; ++m) { const int co = h * 64 + 16 * m + 4 * g;
        const u32x2 rq = *(const u32x2*)(Pr + B_R + co), kq = *(const u32x2*)(Pr + B_K + co); const float4 kkw = *(const float4*)(W.rw_kk + co);
        rr[m] = (f32x4){bflo(rq.x), bfhi(rq.x), bflo(rq.y), bfhi(rq.y)}; kx[m] = (f32x4){bflo(kq.x), bfhi(kq.x), bflo(kq.y), bfhi(kq.y)};
        kk[m] = (f32x4){kx[m][0] * kkw.x, kx[m][1] * kkw.y, kx[m][2] * kkw.z, kx[m][3] * kkw.w};
        ssq += kk[m][0] * kk[m][0] + kk[m][1] * kk[m][1] + kk[m][2] * kk[m][2] + kk[m][3] * kk[m][3]; }
    ssq += xor16_f(ssq); ssq = sum_x32(ssq);
    { const float rn = rsqrtf(ssq + 1e-12f);
#pragma unroll
      for (int m = 0; m < 4; ++m) kk[m] = kk[m] * rn; }
    float bon = 0.f;
    const int co = h * 64;
    const int c0 = cidx, c1 = cidx < 16 ? 15 - cidx : 287 - cidx;
    {
      const int tok0 = cidx < 16 ? NLAT + b * CTXL + cidx * 16 : b * SEQL + cidx * 16 - CTXL;
      const bf16_t* vp = P + (size_t)(tok0 + 4 * g) * PTP + B_V + h * 64 + l16;
      u32x2* vd = (u32x2*)(RWF + ((size_t)(bh * 2 + dsel) * RW_NCHUNK + (dsel ? c1 : c0)) * RWF_CHUNK + 10240) + ln_;
#pragma unroll
      for (int n = 0; n < 4; ++n) { u32x2 w; w.x = (unsigned)vp[16 * n] | ((unsigned)vp[PTP + 16 * n] << 16); w.y = (unsigned)vp[2 * PTP + 16 * n] | ((unsigned)vp[3 * PTP + 16 * n] << 16); vd[64 * n] = w; } }
    if (dsel == 0) rwkv_pre_dir<0>(WUPT + (size_t)co * 64, bw, ba, kk, rr, kx, W.rw_w0 + co, W.rw_a0 + co, W.rw_ka + co, W.rw_rk + co, bon, wl, RWF + ((size_t)(bh * 2 + 0) * RW_NCHUNK + c0) * RWF_CHUNK, l16, g);
    else           rwkv_pre_dir<1>(WUPT + (size_t)co * 64, bw, ba, kk, rr, kx, W.rw_w0 + 512 + co, W.rw_a0 + 512 + co, W.rw_ka + co, W.rw_rk + co, bon, wl, RWF + ((size_t)(bh * 2 + 1) * RW_NCHUNK + c1) * RWF_CHUNK, l16, g);
    bon += xor16_f(bon); bon = sum_x32(bon);
    if (g == 0) BON[((size_t)dsel * NTOK + tok) * 8 + h] = bon;
}
struct RwFrag { bf16x8 a0, a1, r0, r1, tm, bb, bk0, bk1, bk2, bk3; f32x4 g0, g1, g2, g3; u32x2 v; };
__device__ __forceinline__ void rwkv_scan(const Ctx& F, unsigned char* ws, int sidx) {
    const unsigned char* base = ws + WS_RWF + (size_t)sidx * RW_NCHUNK * RWF_CHUNK;
    if (F.wave >= 4) {
        const int w = F.wave - 4; const unsigned lo = (unsigned)F.lane * 16u;
#define RW_DMA(ch) do { const int ch_ = (ch) < RW_NCHUNK ? (ch) : RW_NCHUNK - 1; const unsigned char* rec_ = base + (size_t)ch_ * RWF_CHUNK; LAS unsigned char* sl_ = F.lds + ((ch) & 7) * RWF_CHUNK; \
        _Pragma("unroll") for (int i_ = 0; i_ < 3; ++i_) __builtin_amdgcn_global_load_lds((const unsigned*)(rec_ + (w + 4 * i_) * 1024 + lo), (LAS unsigned*)(sl_ + (w + 4 * i_) * 1024), 16, 0, 0); \
        if (w == 0) __builtin_amdgcn_global_load_lds((const unsigned*)(rec_ + 12288 + lo), (LAS unsigned*)(sl_ + 12288), 16, 0, 0); } while (0)
#pragma unroll 1
        for (int ch = 0; ch < 7; ++ch) RW_DMA(ch);
        asm volatile("s_waitcnt vmcnt(15)" ::: "memory");
        __builtin_amdgcn_s_barrier();
#pragma unroll 1
        for (int c = 0; c < RW_NCHUNK; ++c) {
            asm volatile("s_waitcnt vmcnt(15)" ::: "memory");
            __builtin_amdgcn_s_barrier();
            RW_DMA(c + 7);
        }
        asm volatile("s_waitcnt vmcnt(0)" ::: "memory");
#undef RW_DMA
        return;
    }
    bf16_t* RWY = (bf16_t*)(ws + WS_RWY);
    const int d = sidx & 1, h = (sidx >> 1) & 7, b = sidx >> 4, n = F.wave, l16 = F.lane & 15, g = F.lane >> 4;
    const int sgn = 1 - 2 * d, offA = d * 15, offB = d * 287;
    const int tokA = NLAT + b * CTXL, tokB = b * SEQL - CTXL;
    const unsigned yoff = (unsigned)((4 * g) * 512 + h * 64 + 16 * n + l16) * 2;
    unsigned char* Yb = (unsigned char*)RWY + (size_t)d * NTOK * 1024;
#define RW_CIDX(c) (((c) < 16 ? offA : offB) + sgn * (c))
#define RW_TOKB(ci) (((ci) < 16 ? tokA : tokB) + (ci) * 16)
#define RW_LDSF(fr, c) do { LAS unsigned char* sl_ = F.lds + ((c) & 7) * RWF_CHUNK; const LAS bf16x8* q_ = (const LAS bf16x8*)sl_ + F.lane; \
        fr.a0 = q_[0]; fr.a1 = q_[64]; fr.r0 = q_[128]; fr.r1 = q_[192]; fr.tm = q_[256]; fr.bb = q_[320]; fr.bk0 = q_[384]; fr.bk1 = q_[448]; fr.bk2 = q_[512]; fr.bk3 = q_[576]; \
        fr.v = *((const LAS u32x2*)(sl_ + 10240) + n * 64 + F.lane); \
        const LAS f32x4* gp_ = (const LAS f32x4*)(sl_ + 12288) + g; fr.g0 = gp_[0]; fr.g1 = gp_[4]; fr.g2 = gp_[8]; fr.g3 = gp_[12]; } while (0)
    f32x4 st0 = {0.f, 0.f, 0.f, 0.f}, st1 = st0, st2 = st0, st3 = st0;
    const f32x4 z4 = {0.f, 0.f, 0.f, 0.f};
#define RW_STEP(fr, c) do { \
        const bf16x8 s0_ = pack8(st0, st1), s1_ = pack8(st2, st3); \
        f32x4 x1_ = __builtin_amdgcn_mfma_f32_16x16x32_bf16(fr.a0, s0_, z4, 0, 0, 0); x1_ = __builtin_amdgcn_mfma_f32_16x16x32_bf16(fr.a1, s1_, x1_, 0, 0, 0); \
        f32x4 x2_ = __builtin_amdgcn_mfma_f32_16x16x32_bf16(fr.r0, s0_, z4, 0, 0, 0); x2_ = __builtin_amdgcn_mfma_f32_16x16x32_bf16(fr.r1, s1_, x2_, 0, 0, 0); \
        union { bf16x8 v; unsigned u[4]; } bx_; bx_.u[0] = pk_bf16(x1_[0], x1_[1]); bx_.u[1] = pk_bf16(x1_[2], x1_[3]); bx_.u[2] = fr.v.x; bx_.u[3] = fr.v.y; \
        const f32x4 e_ = __builtin_amdgcn_mfma_f32_16x16x32_bf16(fr.tm, bx_.v, z4, 0, 0, 0); \
        union { bf16x8 v; unsigned u[4]; } be_; be_.u[0] = pk_bf16(e_[0], e_[1]); be_.u[1] = pk_bf16(e_[2], e_[3]); be_.u[2] = fr.v.x; be_.u[3] = fr.v.y; \
        const f32x4 o_ = __builtin_amdgcn_mfma_f32_16x16x32_bf16(fr.bb, be_.v, x2_, 0, 0, 0); \
        st0 = __builtin_amdgcn_mfma_f32_16x16x32_bf16(fr.bk0, be_.v, st0, 0, 0, 0) * fr.g0; st1 = __builtin_amdgcn_mfma_f32_16x16x32_bf16(fr.bk1, be_.v, st1, 0, 0, 0) * fr.g1; \
        st2 = __builtin_amdgcn_mfma_f32_16x16x32_bf16(fr.bk2, be_.v, st2, 0, 0, 0) * fr.g2; st3 = __builtin_amdgcn_mfma_f32_16x16x32_bf16(fr.bk3, be_.v, st3, 0, 0, 0) * fr.g3; \
        const int ci_ = RW_CIDX(c); unsigned char* yb_ = Yb + (size_t)RW_TOKB(ci_) * 1024 + yoff; const unsigned p01_ = pk_bf16(o_[0], o_[1]), p23_ = pk_bf16(o_[2], o_[3]); \
        *(bf16_t*)yb_ = (bf16_t)(p01_ & 0xffffu); *(bf16_t*)(yb_ + 1024) = (bf16_t)(p01_ >> 16); *(bf16_t*)(yb_ + 2048) = (bf16_t)(p23_ & 0xffffu); *(bf16_t*)(yb_ + 3072) = (bf16_t)(p23_ >> 16); } while (0)
    RwFrag fa, fb;
    __builtin_amdgcn_s_barrier(); asm volatile("" ::: "memory");
    RW_LDSF(fa, 0);
#pragma unroll 1
    for (int c = 0; c < RW_NCHUNK; c += 2) {
        asm volatile("" ::: "memory"); __builtin_amdgcn_s_barrier(); asm volatile("" ::: "memory");
        RW_LDSF(fb, c + 1); RW_STEP(fa, c);
        asm volatile("" ::: "memory"); __builtin_amdgcn_s_barrier(); asm volatile("" ::: "memory");
        RW_LDSF(fa, c + 2); RW_STEP(fb, c + 1);
    }
#undef RW_CIDX
#undef RW_TOKB
#undef RW_LDSF
#undef RW_STEP
}

__device__ __forceinline__ void na_tile(const Ctx& F, unsigned char* ws, const LAS float* sBias, int tile) {
    const bf16_t* QN = (const bf16_t*)(ws + WS_QN); const bf16_t* KN = (const bf16_t*)(ws + WS_KN);
    const bf16_t* VTL = (const bf16_t*)(ws + WS_VTL); const bf16_t* VTC = (const bf16_t*)(ws + WS_VTC); bf16_t* MIX = (bf16_t*)(ws + WS_MIX);
    const int h = F.wave, l16 = F.lane & 15, g = F.lane >> 4;
    const bool lat = tile < 1024;
    int b, r = 0, j = 0, gq;
    if (lat) { b = tile >> 8; r = (tile >> 2) & 63; j = tile & 3; gq = b * SEQL + r * 64 + j * 16 + l16; }
    else { const int tc = tile - 1024; b = tc >> 4; gq = NLAT + b * CTXL + (tc & 15) * 16 + l16; }
    const int row0 = min(max(r - 4, 0), 56), col0 = min(max(16 * j - 8, 0), 32);
    bf16x8 qf0, qf1;
    { const bf16_t* qp = QN + (size_t)gq * 512 + h * 64 + g * 8; qf0 = *(const bf16x8*)qp; qf1 = *(const bf16x8*)(qp + 32); }
    const f32x4 zero4 = {0.f, 0.f, 0.f, 0.f};
    const int cq = 16 * j + l16, win0 = min(max(cq - 8, 0), 48);
    const bf16_t* knb = KN + ((size_t)((((b * 8 + h) * 64 + row0) * 2) * 4 + g) * 64 + col0 + l16) * 8;
    const bf16_t* kcx = KN + (size_t)NLAT * 512 + ((size_t)(((b * 8 + h) * 2) * 4 + g) * 256 + l16) * 8;
    const bf16_t* vnb = VTL + ((size_t)(((b * 8 + h) * 64 + row0) * 12 + col0 / 4 + g) * 64 + l16) * 8;
    const bf16_t* vcx = VTC + ((size_t)(((b * 8 + h) * 8) * 4 + g) * 64 + l16) * 8;
    float mrun = -1e30f, lrun = 0.f;
    f32x4 o[4] = {zero4, zero4, zero4, zero4};
#pragma unroll
    for (int hf = 0; hf < 2; ++hf) {
        if (hf == 0 && !lat) continue;
        bf16x8 fr[32];
#pragma unroll
        for (int T = 0; T < 16; ++T) { const bf16_t* kp = hf == 0 ? knb + (size_t)((T >> 1) * 8) * 512 + (T & 1) * 128 : kcx + T * 128;
            fr[2 * T] = *(const bf16x8*)kp; fr[2 * T + 1] = *(const bf16x8*)(kp + (hf == 0 ? 4 * 512 : 4 * 2048)); }
        asm volatile("" ::: "memory");
        f32x4 acc[16];
#pragma unroll
        for (int T = 0; T < 16; ++T) { f32x4 a = __builtin_amdgcn_mfma_f32_16x16x32_bf16(fr[2 * T], qf0, zero4, 0, 0, 0); a = __builtin_amdgcn_mfma_f32_16x16x32_bf16(fr[2 * T + 1], qf1, a, 0, 0, 0);
            if (hf == 0) { const int ir = T >> 1, hh = T & 1, kr = row0 + ir; const LAS float* bias = sBias + (kr - r + 7) * 31;
#pragma unroll
                for (int e = 0; e < 4; ++e) { const int kc = col0 + 16 * hh + 4 * g + e; const bool ok = (kc >= win0) && (kc < win0 + 16);
                    const int dc = min(max(kc - cq + 15, 0), 30); a[e] = ok ? a[e] + bias[dc] : -1e30f; } }
            acc[T] = a; }
#pragma unroll
        for (int m = 0; m < 8; ++m)
#pragma unroll
            for (int dt = 0; dt < 4; ++dt) fr[4 * m + dt] = *(const bf16x8*)(hf == 0 ? vnb + (size_t)m * 12 * 512 + dt * 128 : vcx + (size_t)m * 4 * 512 + dt * 128);
        asm volatile("" ::: "memory");
        float mx = mrun;
#pragma unroll
        for (int T = 0; T < 16; ++T) mx = fmaxf(fmaxf(fmaxf(acc[T][0], acc[T][1]), fmaxf(acc[T][2], acc[T][3])), mx);
        mx = fmaxf(mx, xor16_f(mx)); mx = max_x32(mx);
        const float alpha = __expf(mrun - mx);
        float lsum = 0.f;
#pragma unroll
        for (int T = 0; T < 16; ++T) {
#pragma unroll
            for (int q = 0; q < 4; ++q) { const float pv = __expf(acc[T][q] - mx); acc[T][q] = pv; lsum += pv; } }
        lsum += xor16_f(lsum); lsum = sum_x32(lsum);
        lrun = lrun * alpha + lsum; mrun = mx;
#pragma unroll
        for (int dt = 0; dt < 4; ++dt) o[dt] = o[dt] * alpha;
#pragma unroll
        for (int m = 0; m < 8; ++m) { const bf16x8 pf = pack8(acc[2 * m], acc[2 * m + 1]);
#pragma unroll
            for (int dt = 0; dt < 4; ++dt) o[dt] = __builtin_amdgcn_mfma_f32_16x16x32_bf16(fr[4 * m + dt], pf, o[dt], 0, 0, 0); }
    }
    const float inv = 1.0f / lrun;
#pragma unroll
    for (int dt = 0; dt < 4; ++dt) { u32x2 w; w.x = pk_bf16(o[dt][0] * inv, o[dt][1] * inv); w.y = pk_bf16(o[dt][2] * inv, o[dt][3] * inv);
        *(u32x2*)(MIX + (size_t)gq * 2048 + 1024 + h * 64 + dt * 16 + 4 * g) = w; }
}
__device__ __forceinline__ void na_phase(const Ctx& F, const LayerW& W, unsigned char* ws, int blk, int nblk, int ntile) {
    LAS float* sBias = (LAS float*)(F.lds + F.wave * 2048);
    __syncthreads();
    for (int idx = F.lane; idx < 465; idx += 64) sBias[idx] = W.rpb[F.wave * 465 + idx];
    asm volatile("" ::: "memory");
    for (int tile = blk; tile < ntile; tile += nblk) na_tile(F, ws, sBias, tile);
}

__device__ __forceinline__ void phase_finish(const Ctx& F, const LayerW& W, unsigned char* ws, const bf16_t* GUPT, int ntok) {
    const bf16_t* P = (const bf16_t*)(ws + WS_P); bf16_t* MIX = (bf16_t*)(ws + WS_MIX);
    const bf16_t* RWY = (const bf16_t*)(ws + WS_RWY); const float* BON = (const float*)(ws + WS_BON); const float* YS = (const float*)(ws + WS_YS);
    const f32x4 z4 = {0.f, 0.f, 0.f, 0.f};
    for (int task = F.bid * 8 + F.wave; task < (ntok / 16) * 8; task += F.G * 8) {
        int ln = F.lane; asm volatile("" : "+v"(ln));
        const int l16 = ln & 15, g = ln >> 4, h = task & 7, tok = (task >> 3) * 16 + l16;
        const bf16_t* Pr = P + (size_t)tok * PTP;
        bf16x8 sg[4];
#pragma unroll
        for (int ks = 0; ks < 4; ++ks) { const u32x4 q = *(const u32x4*)(Pr + B_GD + 32 * ks + 8 * g); union { bf16x8 v; unsigned u[4]; } s;
#pragma unroll
            for (int e = 0; e < 4; ++e) s.u[e] = pk_bf16(sigmoidf_(bflo(q[e])), sigmoidf_(bfhi(q[e])));
            sg[ks] = s.v; }
        f32x4 y[4]; float s1 = 0.f;
#pragma unroll
        for (int m = 0; m < 4; ++m) { const int co = h * 64 + 16 * m + 4 * g;
            const u32x2 a = *(const u32x2*)(RWY + (size_t)tok * 512 + co), bq = *(const u32x2*)(RWY + ((size_t)NTOK + tok) * 512 + co);
            y[m] = (f32x4){bflo(a.x) + bflo(bq.x), bfhi(a.x) + bfhi(bq.x), bflo(a.y) + bflo(bq.y), bfhi(a.y) + bfhi(bq.y)};
            s1 += (y[m][0] + y[m][1]) + (y[m][2] + y[m][3]); }
        s1 += xor16_f(s1); s1 = sum_x32(s1);
        const float mu = s1 * (1.f / 64.f); float s2 = 0.f;
#pragma unroll
        for (int m = 0; m < 4; ++m) { y[m] = y[m] - mu; s2 += (y[m][0] * y[m][0] + y[m][1] * y[m][1]) + (y[m][2] * y[m][2] + y[m][3] * y[m][3]); }
        s2 += xor16_f(s2); s2 = sum_x32(s2);
        const float rs = rsqrtf(s2 * (1.f / 64.f) + 64e-5f);
        const float bon = BON[(size_t)tok * 8 + h] + BON[((size_t)NTOK + tok) * 8 + h];
#pragma unroll
        for (int m = 0; m < 4; ++m) { const int co = h * 64 + 16 * m + 4 * g;
            f32x4 ga = z4;
#pragma unroll
            for (int ks = 0; ks < 4; ++ks) ga = __builtin_amdgcn_mfma_f32_16x16x32_bf16(*(const bf16x8*)(GUPT + (size_t)(h * 64 + 16 * m + l16) * 128 + 32 * ks + 8 * g), sg[ks], ga, 0, 0, 0);
            const float4 lw = *(const float4*)(W.rw_lnw + co), lb = *(const float4*)(W.rw_lnb + co); const u32x2 vq = *(const u32x2*)(Pr + B_V + co);
            const float o0 = (y[m][0] * rs * lw.x + lb.x + bon * bflo(vq.x)) * ga[0], o1 = (y[m][1] * rs * lw.y + lb.y + bon * bfhi(vq.x)) * ga[1];
            const float o2 = (y[m][2] * rs * lw.z + lb.z + bon * bflo(vq.y)) * ga[2], o3 = (y[m][3] * rs * lw.w + lb.w + bon * bfhi(vq.y)) * ga[3];
            u32x2 o; o.x = pk_bf16(o0, o1); o.y = pk_bf16(o2, o3);
            *(u32x2*)(MIX + (size_t)tok * 2048 + 512 + co) = o; }
    }
    for (int tok = F.bid * 8 + F.wave; tok < ntok; tok += F.G * 8) {
        const int c0 = F.lane * 8;
        float ys[8], z[8], gw[8];
        load8f(YS + (size_t)tok * 512 + c0, ys); unpack8(*(const u32x4*)(P + (size_t)tok * PTP + D_Z + c0), z); load8f(W.s_norm + c0, gw);
        float ss = 0.f;
#pragma unroll
        for (int e = 0; e < 8; ++e) { ys[e] *= siluf_(z[e]); ss += ys[e] * ys[e]; }
        ss = wave_sum(ss);
        const float rs = rsqrtf(ss * (1.f / 512.f) + 1e-6f);
#pragma unroll
        for (int e = 0; e < 8; ++e) ys[e] = ys[e] * rs * gw[e];
        *(u32x4*)(MIX + (size_t)tok * 2048 + 1536 + c0) = pack8f(ys);
    }
}

constexpr int RADIX_LOW_BIT = 10;
constexpr int RADIX_STEPS = 14;
__device__ __forceinline__ unsigned ordkey(float x) { const unsigned u = __float_as_uint(x); return (u & 0x80000000u) ? ~u : (u | 0x80000000u); }
template <int CTRL> __device__ __forceinline__ int dpp_i0(int v) { return __builtin_amdgcn_update_dpp(0, v, CTRL, 0xF, 0xF, true); }
__device__ __forceinline__ int rowscan_incl(int x) { x += dpp_i0<0x111>(x); x += dpp_i0<0x112>(x); x += dpp_i0<0x114>(x); x += dpp_i0<0x118>(x); return x; }
__device__ __forceinline__ void phase_scores(const Ctx& F, unsigned char* ws, int layer, int ntok) {
    const bf16_t* Q = (const bf16_t*)(ws + WS_P); const bf16_t* KEYS = (const bf16_t*)(ws + WS_KEYS) + (size_t)layer * 8 * 2 * 128 * 128;
    int* IDS = (int*)(ws + WS_IDS); float* GATES = (float*)(ws + WS_GATES);
    LAS bf16_t* sK = (LAS bf16_t*)F.lds;
    LAS float* sVv = (LAS float*)(F.lds + 2 * 128 * 136 * 2 + F.wave * 5120);
    LAS int* sVi = (LAS int*)(sVv + 512);
    const int ntg = ntok / 128, ntask = 8 * ntg;
    const int l16 = F.lane & 15, g = F.lane >> 4;
    const f32x4 z4 = {0.f, 0.f, 0.f, 0.f};
    int cur_h = -1;
    for (int task = F.bid; task < ntask; task += F.G) {
        const int h = task / ntg, tg = task % ntg;
        if (h != cur_h) { __syncthreads();
#pragma unroll
            for (int q = 0; q < 8; ++q) { const int v = F.tid + 512 * q, row = v >> 4, part = v & 15;
                *(LAS u32x4*)(sK + row * 136 + part * 8) = *(const u32x4*)(KEYS + ((size_t)h * 256 + row) * 128 + part * 8); }
            cur_h = h; __syncthreads(); }
        const int t0 = tg * 128 + F.wave * 16;
#pragma unroll 1
        for (int p = 0; p < 2; ++p) {
            bf16x8 qf[4];
#pragma unroll
            for (int ks = 0; ks < 4; ++ks) qf[ks] = *(const bf16x8*)(Q + (size_t)(t0 + l16) * 2048 + h * 256 + p * 128 + 32 * ks + 8 * g);
            f32x4 acc[8];
#pragma unroll
            for (int kt = 0; kt < 8; ++kt) { f32x4 a = z4;
#pragma unroll
                for (int ks = 0; ks < 4; ++ks) a = __builtin_amdgcn_mfma_f32_16x16x32_bf16(qf[ks], *(const LAS bf16x8*)(sK + (p * 128 + 16 * kt + l16) * 136 + 32 * ks + 8 * g), a, 0, 0, 0);
                acc[kt] = a; }
            float lo0, lo1, lo2, lo3, hi0, hi1, hi2, hi3;
            { float m0 = acc[0][0], m1 = acc[0][1], m2 = acc[0][2], m3 = acc[0][3];
#pragma unroll
              for (int kt = 1; kt < 8; ++kt) { m0 = fmaxf(m0, acc[kt][0]); m1 = fmaxf(m1, acc[kt][1]); m2 = fmaxf(m2, acc[kt][2]); m3 = fmaxf(m3, acc[kt][3]); }
              hi0 = max16(m0); hi1 = max16(m1); hi2 = max16(m2); hi3 = max16(m3);
              lo0 = -max16(-m0); lo1 = -max16(-m1); lo2 = -max16(-m2); lo3 = -max16(-m3); }
#pragma unroll 1
            for (int it = 0; it < RADIX_STEPS; ++it) {
                const float c0 = 0.5f * (lo0 + hi0), c1 = 0.5f * (lo1 + hi1), c2 = 0.5f * (lo2 + hi2), c3 = 0.5f * (lo3 + hi3); int n0 = 0, n1 = 0, n2 = 0, n3 = 0;
#pragma unroll
                for (int kt = 0; kt < 8; ++kt) { n0 += acc[kt][0] >= c0; n1 += acc[kt][1] >= c1; n2 += acc[kt][2] >= c2; n3 += acc[kt][3] >= c3; }
                const bool k0 = sum16((float)n0) >= 16.f, k1 = sum16((float)n1) >= 16.f, k2 = sum16((float)n2) >= 16.f, k3 = sum16((float)n3) >= 16.f;
                lo0 = k0 ? c0 : lo0; hi0 = k0 ? hi0 : c0; lo1 = k1 ? c1 : lo1; hi1 = k1 ? hi1 : c1; lo2 = k2 ? c2 : lo2; hi2 = k2 ? hi2 : c2; lo3 = k3 ? c3 : lo3; hi3 = k3 ? hi3 : c3; }
#pragma unroll
            for (int r = 0; r < 4; ++r) { const float T = r == 0 ? lo0 : (r == 1 ? lo1 : (r == 2 ? lo2 : lo3));
                int cl = 0;
#pragma unroll
                for (int kt = 0; kt < 8; ++kt) cl += acc[kt][r] >= T;
                int rank = rowscan_incl(cl) - cl;
                LAS float* dv = sVv + ((4 * g + r) * 2 + p) * 16; LAS int* di = sVi + ((4 * g + r) * 2 + p) * 16;
#pragma unroll
                for (int kt = 0; kt < 8; ++kt) { const bool sel = acc[kt][r] >= T;
                    if (sel && rank < 16) { dv[rank] = acc[kt][r]; di[rank] = 16 * kt + l16; }
                    rank += sel ? 1 : 0; } }
        }
        asm volatile("" ::: "memory");
#pragma unroll 1
        for (int r = 0; r < 4; ++r) { const int tk = 4 * g + r;
            LAS float* sS = (LAS float*)(sVi + 512);
            LAS int* sI = (LAS int*)(sS + 128);
#pragma unroll
            for (int p = 0; p < 2; ++p) { const float v = sVv[(tk * 2 + p) * 16 + l16]; const int ix = sVi[(tk * 2 + p) * 16 + l16];
                const unsigned key = (ordkey(v) & ~15u) | (unsigned)(15 - l16); int rk = 0;
#pragma unroll
                for (int q = 0; q < 4; ++q) { const f32x4 o = *(const LAS f32x4*)(sVv + (tk * 2 + p) * 16 + 4 * q);
#pragma unroll
                    for (int e = 0; e < 4; ++e) rk += ((ordkey(o[e]) & ~15u) | (unsigned)(15 - (4 * q + e))) > key; }
                sS[(g * 2 + p) * 16 + rk] = v; sI[(g * 2 + p) * 16 + rk] = ix; }
            asm volatile("" ::: "memory");
            float cv[4]; int pi[4], pj[4];
#pragma unroll
            for (int q = 0; q < 4; ++q) { const int e = l16 + 16 * q; int i, j;
                if (e < 16) { i = 0; j = e; } else if (e < 24) { i = 1; j = e - 16; } else if (e < 29) { i = 2; j = e - 24; } else if (e < 33) { i = 3; j = e - 29; }
                else if (e < 36) { i = 4; j = e - 33; } else if (e < 42) { i = 5 + ((e - 36) >> 1); j = (e - 36) & 1; } else { i = 8 + (e - 42); j = 0; }
                const bool ok = e < 50; i = ok ? i : 15; j = ok ? j : 15;
                pi[q] = i; pj[q] = j; cv[q] = ok ? sS[(g * 2) * 16 + i] + sS[(g * 2 + 1) * 16 + j] : -3.0e38f; }
            float lo = sS[(g * 2) * 16 + 15] + sS[(g * 2 + 1) * 16], hi = sS[(g * 2) * 16] + sS[(g * 2 + 1) * 16];
            const float mx = hi;
#pragma unroll 1
            for (int it = 0; it < RADIX_STEPS; ++it) { const float cm = 0.5f * (lo + hi); int n = 0;
#pragma unroll
                for (int q = 0; q < 4; ++q) n += cv[q] >= cm;
                const bool kk = sum16((float)n) >= 16.f; lo = kk ? cm : lo; hi = kk ? hi : cm; }
            int cl = 0; float es = 0.f;
#pragma unroll
            for (int q = 0; q < 4; ++q) { const bool sel = cv[q] >= lo; cl += sel; es += sel ? __expf(cv[q] - mx) : 0.f; }
            int rank = rowscan_incl(cl) - cl;
            const float einv = 1.0f / sum16(es);
            const size_t ob = (size_t)(t0 + tk) * 128 + h * 16;
#pragma unroll
            for (int q = 0; q < 4; ++q) { const bool sel = cv[q] >= lo;
                if (sel && rank < 16) { IDS[ob + rank] = sI[(g * 2) * 16 + pi[q]] * 128 + sI[(g * 2 + 1) * 16 + pj[q]]; GATES[ob + rank] = __expf(cv[q] - mx) * einv; }
                rank += sel ? 1 : 0; }
            asm volatile("" ::: "memory");
        }
        asm volatile("" ::: "memory");
    }
}

struct XInfo { int xi, nx, rank, nloc; };
__device__ __forceinline__ void fp8x16_to_f32(const u32x4 q, float (&f)[16]) {
#pragma unroll
    for (int w = 0; w < 4; ++w) { const auto a = __builtin_amdgcn_cvt_pk_f32_fp8((int)q[w], false); const auto b = __builtin_amdgcn_cvt_pk_f32_fp8((int)q[w], true);
        f[4 * w] = a[0]; f[4 * w + 1] = a[1]; f[4 * w + 2] = b[0]; f[4 * w + 3] = b[1]; }
}
typedef long i64_t;
template <int IDMASK> __device__ __forceinline__ void phase_experts_u(const Ctx& F, unsigned char* ws, int layer, int ntok, const XInfo X, float* PART) {
    const bf16_t* H = (const bf16_t*)(ws + WS_XN); const unsigned char* PU8 = ws + WS_PU + (size_t)layer * 16384 * 2048;
    const int* IDS = (const int*)(ws + WS_IDS);
    const int e8 = F.lane >> 3, c = F.lane & 7, l16 = F.lane & 15, g = F.lane >> 4;
    const int tfirst = X.rank * 8 + F.wave, tstride = X.nloc * 8;
    const int nk = tfirst < ntok ? (ntok - tfirst + tstride - 1) / tstride : 0;
    const f32x4 z4 = {0.f, 0.f, 0.f, 0.f};
    LAS unsigned char* buf = F.lds + F.wave * 12288; LAS float* res = (LAS float*)(buf + 8192);
    const int woff = e8 * 128 + c * 16;
    const int srcoff = 16 * (c ^ e8);
    const int roff0 = l16 * 128 + (((2 * g) ^ (l16 & 7)) * 16), roff1 = l16 * 128 + (((2 * g + 1) ^ (l16 & 7)) * 16);
#define EU_TOK(k) (tfirst + min((k), nk - 1) * tstride)
#define EU_LOADI(I, k) do { const int* ip_ = IDS + (size_t)EU_TOK(k) * 128 + e8; _Pragma("unroll") for (int q_ = 0; q_ < 16; ++q_) I[q_] = ip_[8 * q_]; } while (0)
#define EU_LOADX(HX, k) do { const u32x4* hp_ = (const u32x4*)(H + (size_t)EU_TOK(k) * 2048 + s * 128 + 32 * g); HX[0] = hp_[0]; HX[1] = hp_[1]; HX[2] = hp_[2]; HX[3] = hp_[3]; } while (0)
#define EU_ISSUE(Q, I, hf) do { const unsigned char* sb_ = PU8 + (size_t)s * 16384 * 128; _Pragma("unroll") for (int i_ = 0; i_ < 8; ++i_) Q[i_] = *(const u32x4*)(sb_ + (unsigned)(I[(hf) * 8 + i_] * 128 + srcoff)); } while (0)
#define EU_CONSUME(Q, hf, slot) do { _Pragma("unroll") for (int i_ = 0; i_ < 8; ++i_) *(LAS u32x4*)(buf + i_ * 1024 + woff) = Q[i_]; \
        asm volatile("" ::: "memory"); \
        u32x4 p0_[4], p1_[4]; f32x4 a_[4]; \
        _Pragma("unroll") for (int q_ = 0; q_ < 4; ++q_) { p0_[q_] = *(const LAS u32x4*)(buf + q_ * 2048 + roff0); p1_[q_] = *(const LAS u32x4*)(buf + q_ * 2048 + roff1); a_[q_] = z4; } \
          \
        _Pragma("unroll") for (int q_ = 0; q_ < 4; ++q_) a_[q_] = __builtin_amdgcn_mfma_f32_16x16x32_fp8_fp8(((i64_t)p0_[q_][1] << 32) | (i64_t)p0_[q_][0], hb[0], a_[q_], 0, 0, 0); \
        _Pragma("unroll") for (int q_ = 0; q_ < 4; ++q_) a_[q_] = __builtin_amdgcn_mfma_f32_16x16x32_fp8_fp8(((i64_t)p0_[q_][3] << 32) | (i64_t)p0_[q_][2], hb[1], a_[q_], 0, 0, 0); \
        _Pragma("unroll") for (int q_ = 0; q_ < 4; ++q_) a_[q_] = __builtin_amdgcn_mfma_f32_16x16x32_fp8_fp8(((i64_t)p1_[q_][1] << 32) | (i64_t)p1_[q_][0], hb[2], a_[q_], 0, 0, 0); \
        _Pragma("unroll") for (int q_ = 0; q_ < 4; ++q_) a_[q_] = __builtin_amdgcn_mfma_f32_16x16x32_fp8_fp8(((i64_t)p1_[q_][3] << 32) | (i64_t)p1_[q_][2], hb[3], a_[q_], 0, 0, 0); \
        _Pragma("unroll") for (int q_ = 0; q_ < 4; ++q_) if (l16 == (hf) * 4 + q_) *(LAS f32x4*)(res + (slot) * 128 + 16 * ((hf) * 4 + q_) + 4 * g) = a_[q_]; \
        asm volatile("" ::: "memory"); } while (0)
    for (int s = X.xi; s < 16; s += X.nx) {
        if (nk == 0) continue;
        int id[2][16]; u32x4 hx[2][4]; u32x4 qa[8], qb[8];
        EU_LOADI(id[0], 0); EU_LOADX(hx[0], 0); EU_ISSUE(qa, id[0], 0); EU_ISSUE(qb, id[0], 1);
        EU_LOADI(id[1], 1);
        for (int k0 = 0; k0 < nk; k0 += 8) {
#pragma unroll
            for (int j = 0; j < 8; ++j) { const int k = k0 + j;
                i64_t hb[4];
#pragma unroll
                for (int m = 0; m < 4; ++m) { const u32x4 v = hx[j & 1][m];
                    int lo = __builtin_amdgcn_cvt_pk_fp8_f32(bflo(v[0]), bfhi(v[0]), 0, false); lo = __builtin_amdgcn_cvt_pk_fp8_f32(bflo(v[1]), bfhi(v[1]), lo, true);
                    int hi = __builtin_amdgcn_cvt_pk_fp8_f32(bflo(v[2]), bfhi(v[2]), 0, false); hi = __builtin_amdgcn_cvt_pk_fp8_f32(bflo(v[3]), bfhi(v[3]), hi, true);
                    hb[m] = ((i64_t)(unsigned)hi << 32) | (i64_t)(unsigned)lo; }
                EU_LOADX(hx[(j + 1) & 1], k + 1);
                EU_LOADI(id[j & 1], k + 2);
                EU_CONSUME(qa, 0, j);
                EU_ISSUE(qa, id[(j + 1) & 1], 0);
                EU_CONSUME(qb, 1, j);
                EU_ISSUE(qb, id[(j + 1) & 1], 1);
            }
            { const int u = F.lane >> 3, jj = F.lane & 7, ku = k0 + u;
              if (ku < nk) { float* dst = PART + ((size_t)s * NTOK + tfirst + ku * tstride) * 128 + 16 * jj;
#pragma unroll
                  for (int w = 0; w < 4; ++w) *(f32x4*)(dst + 4 * w) = *(const LAS f32x4*)(res + u * 128 + 16 * jj + 4 * w); }
              asm volatile("" ::: "memory"); }
        }
    }
#undef EU_TOK
#undef EU_LOADI
#undef EU_LOADX
#undef EU_ISSUE
#undef EU_CONSUME
}
__device__ __forceinline__ void phase_experts_combine(const Ctx& F, unsigned char* ws, int ntok) {
    const float* PART = (const float*)(ws + WS_PART); float* GATES = (float*)(ws + WS_GATES);
    for (int idx = F.bid * 512 + F.tid; idx < ntok * 32; idx += F.G * 512) {
        float4 a = make_float4(0.f, 0.f, 0.f, 0.f);
#pragma unroll
        for (int s = 0; s < 16; ++s) { const float4 v = *(const float4*)(PART + (size_t)s * NTOK * 128 + (size_t)idx * 4); a.x += v.x; a.y += v.y; a.z += v.z; a.w += v.w; }
        float4 g = *(const float4*)(GATES + (size_t)idx * 4);
        g.x *= geluf_(a.x * (1.0f / PEER_U_SCALE)); g.y *= geluf_(a.y * (1.0f / PEER_U_SCALE)); g.z *= geluf_(a.z * (1.0f / PEER_U_SCALE)); g.w *= geluf_(a.w * (1.0f / PEER_U_SCALE));
        *(float4*)(GATES + (size_t)idx * 4) = g;
    }
}
__device__ __forceinline__ void phase_experts_v(const Ctx& F, unsigned char* ws, float* out, float* CTXS, int layer, int ntok, const XInfo X) {
    const unsigned char* PV8 = ws + WS_PV + (size_t)layer * 16384 * 2048;
    const int* IDS = (const int*)(ws + WS_IDS); const float* COEF = (const float*)(ws + WS_GATES); const float* MOD = (const float*)(ws + WS_MOD);
    const int e8 = F.lane >> 3, c = F.lane & 7;
    const int tfirst = X.rank * 8 + F.wave, tstride = X.nloc * 8;
    const int nk = tfirst < ntok ? (ntok - tfirst + tstride - 1) / tstride : 0;
    LAS float* res = (LAS float*)(F.lds + F.wave * 4096);
#define EV_TOK(k) (tfirst + min((k), nk - 1) * tstride)
#define EV_LOADI(I, k) do { I[0] = *((const u32x4*)(IDS + (size_t)EV_TOK(k) * 128 + e8 * 16) + (c & 3)); } while (0)
#define EV_LOADC(C, k) do { C[0] = *((const u32x4*)(COEF + (size_t)EV_TOK(k) * 128 + e8 * 16) + (c & 3)); } while (0)
#define EV_QUAD(V) do { const u32x4 own_ = V[0];   \
        _Pragma("unroll") for (int w_ = 0; w_ < 4; ++w_) { V[0][w_] = (unsigned)__builtin_amdgcn_update_dpp(0, (int)own_[w_], 0x00, 0xF, 0xF, true); V[1][w_] = (unsigned)__builtin_amdgcn_update_dpp(0, (int)own_[w_], 0x55, 0xF, 0xF, true); \
            V[2][w_] = (unsigned)__builtin_amdgcn_update_dpp(0, (int)own_[w_], 0xAA, 0xF, 0xF, true); V[3][w_] = (unsigned)__builtin_amdgcn_update_dpp(0, (int)own_[w_], 0xFF, 0xF, 0xF, true); } } while (0)
#define EV_ROW(id) (*(const u32x4*)(PV8 + (size_t)s * 16384 * 128 + (unsigned)((id) * 128 + c * 16)))
#define EV_ISSUE(Q, I, hf) do { _Pragma("unroll") for (int i_ = 0; i_ < 8; ++i_) Q[i_] = EV_ROW(I[(hf) * 2 + (i_ >> 2)][i_ & 3]); } while (0)
#define EV_HALF(Q, C, hf) do { _Pragma("unroll") for (int i_ = 0; i_ < 8; ++i_) { const float cf_ = __uint_as_float(C[(hf) * 2 + (i_ >> 2)][i_ & 3]); const f32x2_t c2_ = {cf_, cf_}; \
            _Pragma("unroll") for (int w_ = 0; w_ < 4; ++w_) { const f32x2_t lo_ = __builtin_amdgcn_cvt_pk_f32_fp8((int)Q[i_][w_], false), hi_ = __builtin_amdgcn_cvt_pk_f32_fp8((int)Q[i_][w_], true); \
                ac2[2 * w_] = lo_ * c2_ + ac2[2 * w_]; ac2[2 * w_ + 1] = hi_ * c2_ + ac2[2 * w_ + 1]; } } } while (0)
    for (int s = X.xi; s < 16; s += X.nx) {
        if (nk == 0) continue;
        u32x4 id[2][4], cf[2][4]; u32x4 qa[8], qb[8];
        EV_LOADI(id[0], 0); EV_LOADC(cf[0], 0); EV_QUAD(id[0]); EV_ISSUE(qa, id[0], 0); EV_ISSUE(qb, id[0], 1);
        EV_LOADI(id[1], 1);
        for (int k0 = 0; k0 < nk; k0 += 8) {
#pragma unroll
            for (int j = 0; j < 8; ++j) { const int k = k0 + j;
                f32x2_t ac2[8];
#pragma unroll
                for (int e = 0; e < 8; ++e) ac2[e] = (f32x2_t){0.f, 0.f};
                EV_QUAD(cf[j & 1]);
                EV_QUAD(id[(j + 1) & 1]);
                EV_LOADC(cf[(j + 1) & 1], k + 1);
                EV_HALF(qa, cf[j & 1], 0);
                EV_ISSUE(qa, id[(j + 1) & 1], 0);
                EV_HALF(qb, cf[j & 1], 1);
                EV_ISSUE(qb, id[(j + 1) & 1], 1);
                EV_LOADI(id[j & 1], k + 2);
                float acc[16];
#pragma unroll
                for (int e = 0; e < 8; ++e) { acc[2 * e] = ac2[e][0]; acc[2 * e + 1] = ac2[e][1]; }
#pragma unroll
                for (int e = 0; e < 16; ++e) { float v = acc[e]; v += dpp_f<0x128>(v); v += xor16_f(v); acc[e] = sum_x32(v); }
                if (e8 == 0) {
#pragma unroll
                    for (int w = 0; w < 4; ++w) *(LAS f32x4*)(res + j * 128 + c * 16 + 4 * w) = (f32x4){acc[4 * w], acc[4 * w + 1], acc[4 * w + 2], acc[4 * w + 3]}; }
                asm volatile("" ::: "memory");
            }
            { const int u = F.lane >> 3, jj = F.lane & 7, ku = k0 + u;
              if (ku < nk) { const int tu = tfirst + ku * tstride;
                  const bool isctx = tu >= NLAT; const int vv = isctx ? 4 : (tu >> 12);
                  float* xr = (isctx ? CTXS + (size_t)(tu - NLAT) * 2048 : out + (size_t)tu * 2048) + s * 128 + jj * 16;
                  const float* m5 = MOD + ((size_t)layer * 5 + vv) * 12288 + 5 * 2048 + s * 128 + jj * 16;
#pragma unroll
                  for (int w = 0; w < 4; ++w) { float4 x = *(const float4*)(xr + 4 * w); const float4 m = *(const float4*)(m5 + 4 * w); const f32x4 a = *(const LAS f32x4*)(res + u * 128 + jj * 16 + 4 * w);
                      x.x += m.x * a[0]; x.y += m.y * a[1]; x.z += m.z * a[2]; x.w += m.w * a[3]; *(float4*)(xr + 4 * w) = x; } }
              asm volatile("" ::: "memory"); }
        }
    }
#undef EV_TOK
#undef EV_LOADI
#undef EV_LOADC
#undef EV_QUAD
#undef EV_ROW
#undef EV_ISSUE
#undef EV_HALF
}

struct Params { const float* in[N_IN]; float* out; unsigned char* ws; };

__device__ __forceinline__ LayerW make_w(ka_t in, int l) {
    LayerW W;
    W.sc_w = in[I_SCW] + (size_t)l * 3 * 512; W.rw_w0 = in[I_RW0] + (size_t)l * 2 * 512; W.rw_wup = in[I_RWUP] + (size_t)l * 2 * 64 * 512;
    W.rw_a0 = in[I_RA0] + (size_t)l * 2 * 512; W.rw_aup = in[I_RAUP] + (size_t)l * 2 * 64 * 512; W.rw_gup = in[I_RGUP] + (size_t)l * 128 * 512;
    W.rw_kk = in[I_RKK] + (size_t)l * 512; W.rw_ka = in[I_RKA] + (size_t)l * 512; W.rw_rk = in[I_RRK] + (size_t)l * 512;
    W.rw_lnw = in[I_RLNW] + (size_t)l * 512; W.rw_lnb = in[I_RLNB] + (size_t)l * 512;
    W.na_q = in[I_NAQ] + (size_t)l * 64; W.na_k = in[I_NAK] + (size_t)l * 64; W.rpb = in[I_RPB] + (size_t)l * 8 * 15 * 31;
    W.s_cw = in[I_SCONVW] + (size_t)l * 3 * 1024; W.s_cb = in[I_SCONVB] + (size_t)l * 1024; W.s_dtb = in[I_SDTB] + (size_t)l * 16; W.s_alog = in[I_SALOG] + (size_t)l * 16;
    W.s_d = in[I_SD] + (size_t)l * 8; W.s_norm = in[I_SNORM] + (size_t)l * 512;
    return W;
}

__global__ void __launch_bounds__(512, 2) hybrid_fwd(Params p) {
    extern __shared__ __attribute__((aligned(16))) unsigned char shm[];
    Ctx F; F.lds = (LAS unsigned char*)shm; F.tid = threadIdx.x; F.lane = F.tid & 63; F.wave = __builtin_amdgcn_readfirstlane(F.tid >> 6); F.bid = blockIdx.x; F.G = gridDim.x;
    volatile LAS unsigned* bst = (volatile LAS unsigned*)(F.lds + LDS_BAR_OFF);
    if (F.tid < 4) bst[F.tid] = 0u;
    __syncthreads();
    (void)xcd_barrier_post((unsigned*)(p.ws + WS_CTL), bst);
    volatile LAS int* lxi = (volatile LAS int*)(F.lds + LDS_XI_OFF);
    if (F.tid == 0) lxi[2] = (int)xb_add((unsigned*)(p.ws + WS_CTL) + CTL_TICKET + 64 * xb_xcc_id(), 1u);
#define RPT_PHASE(id, ...) do { __VA_ARGS__ if (RPT == (id)) { GRID_BAR(); PH_BEGIN(); __VA_ARGS__ } } while (0)
#define GRID_BAR() do { ka_t kb_ = (ka_t)__builtin_amdgcn_kernarg_segment_ptr(); asm volatile("" : "+s"(kb_)); unsigned xx_ = xb_xcc_id(); asm volatile("" : "+s"(xx_)); \
        XcdBarrier b_; b_.bar = (unsigned*)((unsigned char*)kb_[N_IN + 1] + WS_CTL); b_.x = xx_; b_.st = (volatile LAS unsigned*)(F.lds + LDS_BAR_OFF); xcd_barrier(b_); } while (0)
    ka_t in; unsigned char* ws; float* out;
#define PH_BEGIN() do { int t_ = threadIdx.x; asm volatile("; PHASE_MARK" : "+v"(t_)); F.tid = t_; F.lane = t_ & 63; F.wave = __builtin_amdgcn_readfirstlane(t_ >> 6); \
        int b_ = blockIdx.x, g_ = gridDim.x; asm volatile("" : "+s"(b_), "+s"(g_)); F.bid = b_; F.G = g_; \
        ka_t k_ = (ka_t)__builtin_amdgcn_kernarg_segment_ptr(); asm volatile("" : "+s"(k_)); in = k_; \
        out = (float*)in[N_IN]; ws = (unsigned char*)in[N_IN + 1]; } while (0)

    PH_BEGIN();
    RPT_PHASE(1, phase_prologue(F, in, ws););
    GRID_BAR();
    if (F.tid == 0) {
        const unsigned* bw = (const unsigned*)(ws + WS_CTL); const unsigned myx = xb_xcc_id(); int xi = 0, nx = 0, nloc = 1;
        for (unsigned j = 0; j < 16; ++j) { const unsigned cnt = xb_ld((unsigned*)&bw[XB_XCNT(j)]); if (cnt > 0u) { if (j < myx) ++xi; ++nx; } if (j == myx) nloc = (int)cnt; }
        lxi[0] = xi; lxi[1] = nx > 0 ? nx : 1; lxi[3] = nloc > 0 ? nloc : 1; }
    __syncthreads();
    PH_BEGIN();
    phase_modreduce(F, in[I_BADA], (const float*)(ws + WS_MODP), (float*)(ws + WS_MOD));
    GRID_BAR();

#pragma unroll 1
    for (int l = 0; l < 2; ++l) {
        const int M = (l == 0) ? NTOK : NLAT;
        if (l == 0) { PH_BEGIN(); phase_norm(F, in[I_X], in[I_CTX], in[I_NMIX], (const float*)(ws + WS_MOD), 0, 1, (bf16_t*)(ws + WS_XN), NTOK); GRID_BAR(); }

        PH_BEGIN();
        RPT_PHASE(2, { pg8::Gemm g{(const bf16_t*)(ws + WS_XN), (const bf16_t*)(ws + WS_WIN) + (size_t)l * PTP * 2048, NTOK, PTP, 2048}; pg8::StaticOrder S; S.init(NTOK, PTP, F.G, F.bid);
          pg8::EpiBf16 E{(bf16_t*)(ws + WS_P), PTP}; pg8::gemm_phase<pg8::EpiBf16, pg8::StaticOrder>(F.lds, g, S, E, F.tid); });
        GRID_BAR();

        PH_BEGIN();
        { const LayerW W = make_w(in, l); phase_prep(F, W, ws);
            if (RPT == 31) phase_prep(F, W, ws);
            const bf16_t* WUPT = (const bf16_t*)(ws + WS_WUPT) + (size_t)l * 4 * 512 * 64;
            for (int rep = 0; rep < (RPT == 32 ? 2 : 1); ++rep) {
            for (int task = F.bid * 8 + F.wave; task < 4 * 8 * RW_NCHUNK; task += F.G * 8) rwkv_pre_task(F, W, ws, WUPT, task, 0);
            for (int task = F.bid * 8 + F.wave; task < 4 * 8 * RW_NCHUNK; task += F.G * 8) rwkv_pre_task(F, W, ws, WUPT, task, 1); } }
        GRID_BAR();

        PH_BEGIN();
        RPT_PHASE(4, { const LayerW W = make_w(in, l); for (int task = F.bid; task < 4 * 8 * NCH; task += F.G) ssd_task<false>(F, W, ws, task); });
        GRID_BAR();
        PH_BEGIN();
        phase_ssd_combine(F, ws);
        GRID_BAR();

        PH_BEGIN();
        { if (F.bid < 64) rwkv_scan(F, ws, F.bid);
        else { const LayerW W = make_w(in, l); const int blk = F.bid - 64, nblk = F.G - 64;
            for (int task = blk; task < 4 * 8 * NCH; task += nblk) ssd_task<true>(F, W, ws, task);
            na_phase(F, W, ws, blk, nblk, (l == 0) ? 1088 : 1024); } }
        if (RPT == 51) { GRID_BAR(); PH_BEGIN(); if (F.bid < 64) rwkv_scan(F, ws, F.bid); }
        if (RPT == 52) { GRID_BAR(); PH_BEGIN(); if (F.bid >= 64) { const LayerW W = make_w(in, l); const int blk = F.bid - 64, nblk = F.G - 64;
            for (int task = blk; task < 4 * 8 * NCH; task += nblk) ssd_task<true>(F, W, ws, task); } }
        if (RPT == 53) { GRID_BAR(); PH_BEGIN(); if (F.bid >= 64) { const LayerW W = make_w(in, l); const int blk = F.bid - 64, nblk = F.G - 64;
            na_phase(F, W, ws, blk, nblk, (l == 0) ? 1088 : 1024); } }
        GRID_BAR();

        PH_BEGIN();
        RPT_PHASE(6, { const LayerW W = make_w(in, l); phase_finish(F, W, ws, (const bf16_t*)(ws + WS_GUPT) + (size_t)l * 512 * 128, M); });
        GRID_BAR();

        PH_BEGIN();
        { pg8::Gemm g{(const bf16_t*)(ws + WS_MIX), (const bf16_t*)(ws + WS_WOUT) + (size_t)l * 2048 * 2048, M, 2048, 2048}; pg8::StaticOrder S; S.init(M, 2048, F.G, F.bid);
          float* CTXS = (float*)(ws + WS_CTXS);
          pg8::EpiResid E{l == 0 ? in[I_X] : out, l == 0 ? in[I_CTX] : CTXS, out, CTXS, (const float*)(ws + WS_MOD) + (size_t)l * 5 * 12288 + 2 * 2048};
          pg8::gemm_phase<pg8::EpiResid, pg8::StaticOrder>(F.lds, g, S, E, F.tid); }
        if (l == 0 && F.bid >= 32) PEER_CONVERT_LAYER(F, in, ws, 0, F.bid - 32, F.G - 32);
        GRID_BAR();

        PH_BEGIN();
        RPT_PHASE(7, phase_norm(F, out, (const float*)(ws + WS_CTXS), in[I_NFFN] + (size_t)l * 2048, (const float*)(ws + WS_MOD) + (size_t)l * 5 * 12288, 3, 4, (bf16_t*)(ws + WS_XN), M););
        GRID_BAR();
        PH_BEGIN();
        RPT_PHASE(8, { pg8::Gemm g{(const bf16_t*)(ws + WS_XN), (const bf16_t*)(ws + WS_WQ) + (size_t)l * 2048 * 2048, M, 2048, 2048}; pg8::StaticOrder S; S.init(M, 2048, F.G, F.bid);
          pg8::EpiBf16 E{(bf16_t*)(ws + WS_P), 2048}; pg8::gemm_phase<pg8::EpiBf16, pg8::StaticOrder>(F.lds, g, S, E, F.tid); });
        if (l == 0 && F.bid >= 32) PEER_CONVERT_LAYER(F, in, ws, 1, F.bid - 32, F.G - 32);
        GRID_BAR();
        PH_BEGIN();
        RPT_PHASE(9, phase_scores(F, ws, l, M););
        GRID_BAR();
        PH_BEGIN();
        RPT_PHASE(10, { XInfo X; X.xi = lxi[0]; X.nx = lxi[1]; X.rank = lxi[2]; X.nloc = lxi[3]; phase_experts_u<0x3fff>(F, ws, l, M, X, (float*)(ws + WS_PART)); });
        if (RPT == 101) { GRID_BAR(); PH_BEGIN(); XInfo X; X.xi = lxi[0]; X.nx = lxi[1]; X.rank = lxi[2]; X.nloc = lxi[3]; phase_experts_u<0x3ff>(F, ws, l, M, X, (float*)(ws + WS_P)); }
        if (RPT == 102) { GRID_BAR(); PH_BEGIN(); XInfo X; X.xi = lxi[0]; X.nx = lxi[1]; X.rank = lxi[2]; X.nloc = lxi[3]; phase_experts_u<0x3fff>(F, ws, l, M, X, (float*)(ws + WS_P)); }
        GRID_BAR();
        PH_BEGIN();
        phase_experts_combine(F, ws, M);
        GRID_BAR();
        PH_BEGIN();
        if (RPT == 11) { XInfo X; X.xi = lxi[0]; X.nx = lxi[1]; X.rank = lxi[2]; X.nloc = lxi[3]; phase_experts_v(F, ws, (float*)(ws + WS_P), (float*)(ws + WS_P) + (size_t)NLAT * 2048, l, M, X); GRID_BAR(); PH_BEGIN(); }
        { XInfo X; X.xi = lxi[0]; X.nx = lxi[1]; X.rank = lxi[2]; X.nloc = lxi[3]; phase_experts_v(F, ws, out, (float*)(ws + WS_CTXS), l, M, X); }
        if (l == 0) { GRID_BAR(); PH_BEGIN();
            phase_norm(F, out, (const float*)(ws + WS_CTXS), in[I_NMIX] + 2048, (const float*)(ws + WS_MOD) + (size_t)5 * 12288, 0, 1, (bf16_t*)(ws + WS_XN), NTOK); GRID_BAR(); }
    }
}

extern "C" void kernel_launch(void* const* d_in, const int* in_sizes, int n_in, void* d_out, int out_size, void* d_ws, size_t ws_size, hipStream_t stream) {
    static int grid = 0;
    if (grid == 0) {
        if (n_in != N_IN || out_size != NLAT * DM || ws_size < WS_END) { fprintf(stderr, "kernel_launch: unexpected shapes (n_in %d out %d ws %zu, need %zu)\n", n_in, out_size, ws_size, (size_t)WS_END); grid = -1; return; }
        int dev = 0, cus = 0, per_cu = 0;
        (void)hipGetDevice(&dev); (void)hipDeviceGetAttribute(&cus, hipDeviceAttributeMultiprocessorCount, dev);
        if (hipFuncSetAttribute((const void*)hybrid_fwd, hipFuncAttributeMaxDynamicSharedMemorySize, LDS_BYTES) != hipSuccess) { fprintf(stderr, "kernel_launch: hipFuncSetAttribute failed\n"); grid = -1; return; }
        (void)hipOccupancyMaxActiveBlocksPerMultiprocessor(&per_cu, (const void*)hybrid_fwd, 512, LDS_BYTES);
        (void)hipGetLastError();
        fprintf(stderr, "kernel_launch: %d CUs, occupancy query %d block(s)/CU, ws %zu B (need %zu)\n", cus, per_cu, ws_size, (size_t)WS_END);
        grid = cus;
        if (grid < 136) { fprintf(stderr, "kernel_launch: needs at least 136 CUs\n"); grid = -1; return; }
    }
    if (grid < 0) return;
    (void)hipMemsetAsync((char*)d_ws + WS_CTL, 0, 65536, stream);
    Params p{};
    for (int i = 0; i < N_IN; ++i) p.in[i] = (const float*)d_in[i];
    p.out = (float*)d_out; p.ws = (unsigned char*)d_ws;
    hipLaunchKernelGGL(hybrid_fwd, dim3(grid), dim3(512), LDS_BYTES, stream, p);
}
```

```cpp
#include <hip/hip_runtime.h>
#include <cstdio>
#include <cstdint>
#ifndef RPT
#define RPT 0
#endif

constexpr int DM = 2048, NBATCH = 4, SEQL = 4096, CTXL = 256, NLAT = NBATCH * SEQL, NCTX = NBATCH * CTXL, NTOK = NLAT + NCTX;
constexpr int PT = 6416, PTP = 6656;
constexpr int A_BG = 0, A_CG = 512, A_H = 1024;
constexpr int B_R = 1536, B_K = 2048, B_V = 2560, B_WD = 3072, B_AD = 3136, B_GD = 3200;
constexpr int C_Q = 3328, C_K = 3840, C_V = 4352;
constexpr int D_Z = 4864, D_X = 5376, D_DT = 6400;
constexpr int NPOS = CTXL + SEQL;
constexpr int NCH = 34;
constexpr int KSPL = 32;

enum { I_X = 0, I_C, I_CTX, I_CCTX, I_WADA, I_BADA, I_NMIX, I_NFFN, I_WIN, I_WOUT, I_SCW, I_RW0, I_RWUP, I_RA0, I_RAUP, I_RGUP, I_RKK, I_RKA, I_RRK, I_RLNW, I_RLNB,
       I_NAQ, I_NAK, I_RPB, I_SCONVW, I_SCONVB, I_SDTB, I_SALOG, I_SD, I_SNORM, I_PWQ, I_PKEYS, I_PU, I_PV, N_IN };

constexpr size_t WS_CTL   = 0;
constexpr size_t WS_ROPE  = 65536;
constexpr size_t WS_MODP  = WS_ROPE + 16384;
constexpr size_t WS_MOD   = WS_MODP + (size_t)KSPL * 2 * 5 * 12288 * 4;
constexpr size_t WS_WIN   = WS_MOD + (size_t)2 * 5 * 12288 * 4;
constexpr size_t WS_WOUT  = WS_WIN + (size_t)2 * PTP * DM * 2;
constexpr size_t WS_WQ    = WS_WOUT + (size_t)2 * DM * DM * 2;
constexpr size_t WS_KEYS  = WS_WQ + (size_t)2 * DM * DM * 2;
constexpr size_t WS_WUPT  = WS_KEYS + (size_t)2 * 8 * 2 * 128 * 128 * 2;
constexpr size_t WS_GUPT  = WS_WUPT + (size_t)2 * 4 * 512 * 64 * 2;
constexpr size_t WS_PU    = WS_GUPT + (size_t)2 * 512 * 128 * 2;
constexpr size_t WS_PV    = WS_PU + (size_t)2 * 16384 * DM;
constexpr size_t WS_P     = WS_PV + (size_t)2 * 16384 * DM;
constexpr size_t WS_MIX   = WS_P + (size_t)NTOK * PTP * 2;
constexpr size_t WS_CTXS  = WS_MIX + (size_t)NTOK * DM * 2;
constexpr size_t WS_XN    = WS_CTXS + (size_t)NCTX * DM * 4;
constexpr size_t WS_IDS   = WS_XN + (size_t)NTOK * DM * 2;
constexpr size_t WS_GATES = WS_IDS + (size_t)NTOK * 128 * 4;
constexpr size_t WS_PART  = WS_GATES + (size_t)NTOK * 128 * 4;
constexpr size_t WS_RWF   = WS_XN;
constexpr size_t WS_RWY   = WS_RWF + (size_t)64 * 272 * 13312;
constexpr size_t WS_BON   = WS_RWY + (size_t)2 * NTOK * 512 * 2;
constexpr size_t WS_XBC   = WS_BON + (size_t)2 * NTOK * 8 * 4;
constexpr size_t WS_DTS   = WS_XBC + (size_t)NTOK * 1024 * 2;
constexpr size_t WS_DEC   = WS_DTS + (size_t)NTOK * 16 * 4;
constexpr size_t WS_SST   = WS_DEC + (size_t)NTOK * 16 * 4;
constexpr size_t WS_SCD   = WS_SST + (size_t)64 * NCH * 8192 * 4;
constexpr size_t WS_YS    = WS_SCD + 16384;
constexpr size_t WS_QN    = WS_YS + (size_t)NTOK * 512 * 4;
constexpr size_t WS_KN    = WS_QN + (size_t)NTOK * 512 * 2;
constexpr size_t WS_VTL   = WS_KN + (size_t)NTOK * 512 * 2;
constexpr size_t WS_VTC   = WS_VTL + (size_t)4 * 8 * 64 * 64 * 96 * 2;
constexpr size_t WS_END   = WS_VTC + (size_t)4 * 8 * 64 * 256 * 2;
static_assert(WS_END < (size_t)1020 * 1024 * 1024, "workspace");
static_assert(WS_GATES + (size_t)NTOK * 128 * 4 <= WS_PART && WS_PART + (size_t)16 * NTOK * 128 * 4 <= WS_END, "alias");

constexpr int LDS_BYTES = 147456;
constexpr int LDS_BAR_OFF = LDS_BYTES - 16;
constexpr int LDS_XI_OFF = LDS_BYTES - 48;
constexpr int CTL_TICKET = 8192;

#define LAS __attribute__((address_space(3)))
typedef unsigned short bf16_t;
typedef _Float16 f16_t;
typedef short bf16x8 __attribute__((ext_vector_type(8)));
typedef float f32x4 __attribute__((ext_vector_type(4)));
typedef unsigned u32x4 __attribute__((ext_vector_type(4)));
typedef unsigned u32x2 __attribute__((ext_vector_type(2)));

__device__ __forceinline__ float bf2f(bf16_t h) { return __uint_as_float(((unsigned)h) << 16); }
__device__ __forceinline__ float bflo(unsigned u) { return __uint_as_float(u << 16); }
__device__ __forceinline__ float bfhi(unsigned u) { return __uint_as_float(u & 0xffff0000u); }
__device__ __forceinline__ bf16_t f2bf(float f) { unsigned u = __float_as_uint(f); u += 0x7FFFu + ((u >> 16) & 1u); return (bf16_t)(u >> 16); }
typedef float f32x2_t __attribute__((ext_vector_type(2)));
typedef __bf16 bf16x2_t __attribute__((ext_vector_type(2)));
__device__ __forceinline__ unsigned pk_bf16(float lo, float hi) { const f32x2_t v = {lo, hi}; const bf16x2_t r = __builtin_convertvector(v, bf16x2_t); return __builtin_bit_cast(unsigned, r); }
__device__ __forceinline__ bf16x8 pack8(const f32x4 a, const f32x4 b) { union { bf16x8 v; unsigned u[4]; } r; r.u[0] = pk_bf16(a[0], a[1]); r.u[1] = pk_bf16(a[2], a[3]); r.u[2] = pk_bf16(b[0], b[1]); r.u[3] = pk_bf16(b[2], b[3]); return r.v; }
template <int CTRL> __device__ __forceinline__ float dpp_f(float v) { return __int_as_float(__builtin_amdgcn_update_dpp(0, __float_as_int(v), CTRL, 0xF, 0xF, true)); }
__device__ __forceinline__ float sum4(float x)  { x += dpp_f<0xB1>(x); x += dpp_f<0x4E>(x); return x; }
__device__ __forceinline__ float sum8(float x)  { x = sum4(x); x += dpp_f<0x141>(x); return x; }
__device__ __forceinline__ float sum16(float x) { x = sum8(x); x += dpp_f<0x140>(x); return x; }
__device__ __forceinline__ float xor16_f(float x) { return __int_as_float(__builtin_amdgcn_ds_swizzle(__float_as_int(x), 0x401F)); }
__device__ __forceinline__ float sum_x32(float x) { const auto r = __builtin_amdgcn_permlane32_swap(__float_as_uint(x), __float_as_uint(x), false, false); return __uint_as_float(r[0]) + __uint_as_float(r[1]); }
__device__ __forceinline__ float max_x32(float x) { const auto r = __builtin_amdgcn_permlane32_swap(__float_as_uint(x), __float_as_uint(x), false, false); return fmaxf(__uint_as_float(r[0]), __uint_as_float(r[1])); }
__device__ __forceinline__ float wave_sum(float x) { x = sum16(x); x += xor16_f(x); return sum_x32(x); }
__device__ __forceinline__ float max16(float x) { x = fmaxf(x, dpp_f<0xB1>(x)); x = fmaxf(x, dpp_f<0x4E>(x)); x = fmaxf(x, dpp_f<0x141>(x)); x = fmaxf(x, dpp_f<0x140>(x)); return x; }
__device__ __forceinline__ float wave_max(float x) { x = max16(x); x = fmaxf(x, xor16_f(x)); return max_x32(x); }
__device__ __forceinline__ float rcpf_(float x) { return __builtin_amdgcn_rcpf(x); }
__device__ __forceinline__ float sigmoidf_(float x) { return rcpf_(1.0f + __expf(-x)); }
__device__ __forceinline__ float siluf_(float x) { return x * rcpf_(1.0f + __expf(-x)); }
__device__ __forceinline__ float tanhf_(float x) { const float e = __expf(2.0f * x); return 1.0f - 2.0f * rcpf_(e + 1.0f); }
__device__ __forceinline__ float geluf_(float x) { return 0.5f * x * (1.0f + tanhf_(0.7978845608028654f * (x + 0.044715f * x * x * x))); }

namespace pg8 {
#define PG8_LAS __attribute__((address_space(3)))
typedef unsigned short bf16_t;
typedef short bf16x8 __attribute__((ext_vector_type(8)));
typedef float f32x4 __attribute__((ext_vector_type(4)));
typedef unsigned u32x4 __attribute__((ext_vector_type(4)));
constexpr int BM = 256, BK = 64, HALF = 128, HTB = HALF * BK * 2  , STAGE_BYTES = 8 * HTB, NXCD = 8, WGM = 8;

__host__ __device__ __forceinline__ int lds_byte(int r, int c) { const int st = (r >> 4) * 2 + (c >> 5), rr = r & 15, cc = c & 31, ob = rr * 64 + cc * 2; return st * 1024 + (ob ^ (((ob >> 9) & 1) << 5)); }
__host__ __device__ __forceinline__ void stage_rc(int b, int& R, int& C) { const int st = b / 1024, sb = b % 1024, swz = sb ^ (((sb >> 9) & 1) << 5); R = (st >> 1) * 16 + swz / 64; C = (st & 1) * 32 + (swz % 64) / 2; }
__host__ __device__ __forceinline__ int perm32(int rho) { const int n = rho >> 4, i = rho & 15; return 8 * (i >> 2) + 4 * n + (i & 3); }

struct Unit { int pm, pn; };
struct Gemm { const bf16_t* A; const bf16_t* Bt; int M, N, K; };

struct StaticOrder {
    int nM, nN, nwg, G, c;
    __host__ __device__ void init(int M, int N, int G_, int c_) { nM = M / BM; nN = N / BM; nwg = nM * nN; G = G_; c = c_; }
    __host__ __device__ bool next(int i, Unit& u) const {
        const long L = (long)i * G + c; if (L >= nwg) return false;
        int wgid = (int)L; { const int q = nwg / NXCD, r = nwg % NXCD, xcd = wgid % NXCD, off = wgid / NXCD; wgid = (xcd < r ? xcd * (q + 1) : r * (q + 1) + (xcd - r) * q) + off; }
        const int nig = WGM * nN, gid = wgid / nig, fm = gid * WGM, gsz = (nM - fm) < WGM ? (nM - fm) : WGM;
        u.pm = fm + ((wgid % nig) % gsz); u.pn = (wgid % nig) / gsz; return true;
    }
    __device__ __forceinline__ void a_ready(const Unit&) const {}
    __device__ __forceinline__ void done(const Unit&) const {}
};

__device__ __forceinline__ unsigned cvt_pk_bf16(float lo, float hi) { return ::pk_bf16(lo, hi); }
struct EpiBf16 {
    static constexpr bool PERM = true, AFTER_DRAIN = false;
    bf16_t* O; int ldc;
    __device__ __forceinline__ void operator()(const f32x4 (&acc)[2][2][4][2], const Unit& u, int wr, int wc, int fr, int fq) const {
        const int row0 = u.pm * BM + wr * 64 + fr; const int col0 = u.pn * BM + wc * 32 + 8 * fq;
#pragma unroll
        for (int ai = 0; ai < 2; ++ai)
#pragma unroll
            for (int m = 0; m < 4; ++m) { bf16_t* rowp = O + (size_t)(row0 + ai * HALF + m * 16) * ldc + col0;
#pragma unroll
                for (int bj = 0; bj < 2; ++bj) { const f32x4 v0 = acc[ai][bj][m][0], v1 = acc[ai][bj][m][1];
                    u32x4 w; w.x = cvt_pk_bf16(v0[0], v0[1]); w.y = cvt_pk_bf16(v0[2], v0[3]); w.z = cvt_pk_bf16(v1[0], v1[1]); w.w = cvt_pk_bf16(v1[2], v1[3]);
                    *(u32x4*)(rowp + bj * HALF) = w; } }
    }
};
struct EpiResid {
    static constexpr bool PERM = false, AFTER_DRAIN = false;
    const float* xi_lat; const float* xi_ctx; float* xo_lat; float* xo_ctx; const float* gate;
    __device__ __forceinline__ void operator()(const f32x4 (&acc)[2][2][4][2], const Unit& u, int wr, int wc, int fr, int fq) const {
        const bool isctx = u.pm >= 64; const int v = isctx ? 4 : (u.pm >> 4);
        const int row0 = (isctx ? (u.pm - 64) : u.pm) * BM + wr * 64 + fr, col0 = u.pn * BM + wc * 32 + 4 * fq;
        const float* xi = isctx ? xi_ctx : xi_lat; float* xo = isctx ? xo_ctx : xo_lat;
        const float* gp = gate + (size_t)v * 12288 + col0;
        f32x4 gv[2][2];
#pragma unroll
        for (int bj = 0; bj < 2; ++bj)
#pragma unroll
            for (int n = 0; n < 2; ++n) gv[bj][n] = *(const f32x4*)(gp + bj * HALF + n * 16);
#pragma unroll
        for (int ai = 0; ai < 2; ++ai)
#pragma unroll
            for (int m = 0; m < 4; ++m) { const size_t off = (size_t)(row0 + ai * HALF + m * 16) * 2048 + col0;
#pragma unroll
                for (int bj = 0; bj < 2; ++bj)
#pragma unroll
                    for (int n = 0; n < 2; ++n) { const f32x4 xv = *(const f32x4*)(xi + off + bj * HALF + n * 16);
                        *(f32x4*)(xo + off + bj * HALF + n * 16) = xv + gv[bj][n] * acc[ai][bj][m][n]; }
                asm volatile("" ::: "memory"); }
    }
};

template <class Epi, class Sched>
__device__ __forceinline__ void gemm_phase(PG8_LAS unsigned char* lds, const Gemm g, const Sched& S, const Epi& E, const int tid) {
    const int wid = __builtin_amdgcn_readfirstlane(tid >> 6), lane = tid & 63, wr = wid >> 2, wc = wid & 3, fr = lane & 15, fq = lane >> 4;
    const int K = g.K, nt = K / BK;
    unsigned voffA[2], voffB[2];
#pragma unroll
    for (int i = 0; i < 2; ++i) { int R, C; stage_rc(tid * 16 + i * 8192, R, C); const int Rb = Epi::PERM ? ((R & ~31) + perm32(R & 31)) : R;
        voffA[i] = (unsigned)(R * K + C) * 2u; voffB[i] = (unsigned)(Rb * K + C) * 2u; }
    const size_t kstep = (size_t)(BK * 2);
    const size_t hstep = (size_t)HALF * K * 2;
    const size_t tstep = 2 * hstep;
    const unsigned ldsw = (unsigned)wid * 1024u;
    const int aoff = lds_byte(wr * 64 + fr, fq * 8), boff = lds_byte(wc * 32 + fr, fq * 8);
#define PG8_SA(b, h) (((b) * 2 + (h)) * HTB)
#define PG8_SB(b, h) ((4 + (b) * 2 + (h)) * HTB)
#define PG8_STAGE(bufoff, gbase, voff) do { _Pragma("unroll") for (int _i = 0; _i < 2; ++_i) \
        __builtin_amdgcn_global_load_lds((const unsigned*)((const char*)(gbase) + (voff)[_i]), (PG8_LAS unsigned*)(lds + (bufoff) + ldsw + _i * 8192), 16, 0, 0); } while (0)
#define PG8_LDA(dst, b, h) do { _Pragma("unroll") for (int m = 0; m < 4; ++m) _Pragma("unroll") for (int k = 0; k < 2; ++k) dst[m][k] = *(const PG8_LAS bf16x8*)(lds + PG8_SA(b, h) + aoff + m * 2048 + k * 1024); } while (0)
#define PG8_LDB(dst, b, h) do { _Pragma("unroll") for (int n = 0; n < 2; ++n) _Pragma("unroll") for (int k = 0; k < 2; ++k) dst[n][k] = *(const PG8_LAS bf16x8*)(lds + PG8_SB(b, h) + boff + n * 2048 + k * 1024); } while (0)
#define PG8_MMA(ai, bj, At, Bt) do { __builtin_amdgcn_s_setprio(1); _Pragma("unroll") for (int m = 0; m < 4; ++m) _Pragma("unroll") for (int n = 0; n < 2; ++n) _Pragma("unroll") for (int k = 0; k < 2; ++k) \
        acc[ai][bj][m][n] = __builtin_amdgcn_mfma_f32_16x16x32_bf16(Bt[n][k], At[m][k], acc[ai][bj][m][n], 0, 0, 0); __builtin_amdgcn_s_setprio(0); } while (0)
#define PG8_WAIT_V(n) asm volatile("s_waitcnt vmcnt(" #n ")" ::: "memory")
#define PG8_WAIT_L(n) asm volatile("s_waitcnt lgkmcnt(" #n ")" ::: "memory")
#define PG8_BAR __builtin_amdgcn_s_barrier()
#define PG8_SCHED __builtin_amdgcn_sched_barrier(0)
    Unit cur, nxt; int ui = 0;
    if (!S.next(0, cur)) return;
    f32x4 acc[2][2][4][2];
#pragma unroll
    for (int a = 0; a < 2; ++a)
#pragma unroll
        for (int b = 0; b < 2; ++b)
#pragma unroll
            for (int m = 0; m < 4; ++m)
#pragma unroll
                for (int n = 0; n < 2; ++n) acc[a][b][m][n] = (f32x4){0.f, 0.f, 0.f, 0.f};
    bf16x8 At[4][2], B0[2][2], B1[2][2];
    const char* cA = (const char*)g.A + (size_t)cur.pm * tstep; const char* cB = (const char*)g.Bt + (size_t)cur.pn * tstep;
    S.a_ready(cur);
    PG8_STAGE(PG8_SB(0, 0), cB, voffB); PG8_STAGE(PG8_SA(0, 0), cA, voffA); PG8_STAGE(PG8_SB(0, 1), cB + hstep, voffB); PG8_STAGE(PG8_SA(0, 1), cA + hstep, voffA);
    if (wr == 1) PG8_BAR;
    PG8_WAIT_V(4); PG8_BAR;
    PG8_STAGE(PG8_SB(1, 0), cB + kstep, voffB); PG8_STAGE(PG8_SA(1, 0), cA + kstep, voffA); PG8_STAGE(PG8_SB(1, 1), cB + hstep + kstep, voffB);
    PG8_WAIT_V(6); PG8_BAR;
    for (;;) {
        const bool has_next = S.next(ui + 1, nxt);
        const char* nA = has_next ? (const char*)g.A + (size_t)nxt.pm * tstep : cA; const char* nB = has_next ? (const char*)g.Bt + (size_t)nxt.pn * tstep : cB;
        for (int t = 0; t < nt; t += 2) {
            const bool last = (t == nt - 2);
            const char* a1 = cA + (size_t)(t + 1) * kstep;
            const char* a2 = last ? nA : cA + (size_t)(t + 2) * kstep; const char* b2 = last ? nB : cB + (size_t)(t + 2) * kstep;
            const char* a3 = a2 + kstep; const char* b3 = b2 + kstep;
            if (last && has_next) S.a_ready(nxt);
            PG8_LDB(B0, 0, 0); PG8_SCHED; PG8_LDA(At, 0, 0); PG8_STAGE(PG8_SA(1, 1), a1 + hstep, voffA);
            PG8_WAIT_L(8); PG8_BAR; PG8_WAIT_L(0); PG8_MMA(0, 0, At, B0); PG8_BAR; PG8_SCHED;
            PG8_LDB(B1, 0, 1); PG8_STAGE(PG8_SB(0, 0), b2, voffB);
            PG8_BAR; PG8_WAIT_L(0); PG8_MMA(0, 1, At, B1); PG8_BAR;
            PG8_LDA(At, 0, 1); PG8_STAGE(PG8_SA(0, 0), a2, voffA);
            PG8_BAR; PG8_WAIT_L(0); PG8_MMA(1, 0, At, B0); PG8_BAR; PG8_SCHED;
            PG8_STAGE(PG8_SB(0, 1), b2 + hstep, voffB);
            PG8_WAIT_V(6); PG8_BAR; PG8_MMA(1, 1, At, B1); PG8_BAR;
            PG8_LDB(B0, 1, 0); PG8_SCHED; PG8_LDA(At, 1, 0); PG8_STAGE(PG8_SA(0, 1), a2 + hstep, voffA);
            PG8_WAIT_L(8); PG8_BAR; PG8_WAIT_L(0); PG8_MMA(0, 0, At, B0); PG8_BAR; PG8_SCHED;
            PG8_LDB(B1, 1, 1); PG8_STAGE(PG8_SB(1, 0), b3, voffB);
            PG8_BAR; PG8_WAIT_L(0); PG8_MMA(0, 1, At, B1); PG8_BAR;
            PG8_LDA(At, 1, 1); PG8_STAGE(PG8_SA(1, 0), a3, voffA);
            PG8_BAR; PG8_WAIT_L(0); PG8_MMA(1, 0, At, B0); PG8_BAR; PG8_SCHED;
            PG8_STAGE(PG8_SB(1, 1), b3 + hstep, voffB);
            PG8_WAIT_V(6); PG8_BAR; PG8_MMA(1, 1, At, B1); PG8_BAR;
        }
        if constexpr (!Epi::AFTER_DRAIN) { E(acc, cur, wr, wc, fr, fq); S.done(cur); }
        if (!has_next) break;
#pragma unroll
        for (int a = 0; a < 2; ++a)
#pragma unroll
            for (int b = 0; b < 2; ++b)
#pragma unroll
                for (int m = 0; m < 4; ++m)
#pragma unroll
                    for (int n = 0; n < 2; ++n) acc[a][b][m][n] = (f32x4){0.f, 0.f, 0.f, 0.f};
        cur = nxt; cA = nA; cB = nB; ++ui;
    }
    PG8_WAIT_V(0);
    if (wr == 0) PG8_BAR;
    PG8_BAR;
    if constexpr (Epi::AFTER_DRAIN) { E.fused(acc, cur, wr, wc, fr, fq, lds, wid, lane); S.done(cur); }
#undef PG8_SA
#undef PG8_SB
#undef PG8_STAGE
#undef PG8_LDA
#undef PG8_LDB
#undef PG8_MMA
#undef PG8_WAIT_V
#undef PG8_WAIT_L
#undef PG8_BAR
#undef PG8_SCHED
}
}

#define XB_TMO      128
#define XB_XCNT(j)  (256  + 64 * (j))
#define XB_XSUB(j)  (1280 + 64 * (j))
#define XB_XGEN(j)  (2304 + 64 * (j))
#define XB_TOP      3328
#define XB_TOPGEN   3392
#define XCD_BAR_WORDS 3456
#define XB_SPIN_CAP (1u << 18)
#define LAS __attribute__((address_space(3)))

__device__ __forceinline__ unsigned xb_ld(unsigned* p)              { return __hip_atomic_load(p, __ATOMIC_RELAXED, __HIP_MEMORY_SCOPE_AGENT); }
__device__ __forceinline__ unsigned xb_add(unsigned* p, unsigned v) { return __hip_atomic_fetch_add(p, v, __ATOMIC_RELAXED, __HIP_MEMORY_SCOPE_AGENT); }
__device__ __forceinline__ unsigned xb_xcc_id() { return (unsigned)__builtin_amdgcn_s_getreg((3 << 11) | 20) & 0xFu; }
#define XB_SPIN(cond, bar) do { unsigned _sp = 0; while (cond) { __builtin_amdgcn_s_sleep(1); \
    if ((++_sp & 255u) == 0u) { if (xb_ld(&(bar)[XB_TMO])) break; if (_sp > XB_SPIN_CAP) { atomicAdd(&(bar)[XB_TMO], 1u); break; } } } } while (0)

struct XcdBarrier {
    unsigned* bar; unsigned x;
    volatile LAS unsigned* st;
};

__device__ __forceinline__ XcdBarrier xcd_barrier_post(unsigned* bar, volatile LAS unsigned* st) {
    XcdBarrier b; b.bar = bar; b.x = xb_xcc_id(); b.st = st;
    if (threadIdx.x == 0) (void)xb_add(&bar[XB_XCNT(b.x)], 1u);
    return b;
}
__device__ __forceinline__ void xcd_barrier_complete(unsigned* bar, unsigned x, unsigned& nloc, unsigned& nx) {
    const unsigned G = gridDim.x * gridDim.y * gridDim.z;
    unsigned sum, cnt, mine, sp = 0u;
    for (;;) {
        sum = 0u; cnt = 0u; mine = 0u;
#pragma unroll
        for (unsigned j = 0; j < 16; ++j) { const unsigned c = xb_ld(&bar[XB_XCNT(j)]); sum += c; cnt += (c > 0u) ? 1u : 0u; mine = (j == x) ? c : mine; }
        if (sum == G) break;
        __builtin_amdgcn_s_sleep(1);
        if ((++sp & 255u) == 0u) { if (xb_ld(&bar[XB_TMO])) break; if (sp > XB_SPIN_CAP) { atomicAdd(&bar[XB_TMO], 1u); break; } }
    }
    nloc = mine > 0u ? mine : 1u; nx = cnt > 0u ? cnt : 1u;
}

__device__ __forceinline__ void xcd_barrier(const XcdBarrier& b) {
    asm volatile("s_waitcnt vmcnt(0)" ::: "memory");
    __syncthreads();
    if (threadIdx.x == 0) {
        unsigned* bar = b.bar;
        __builtin_amdgcn_s_waitcnt(0);
        unsigned nloc = b.st[0], nx = b.st[1];
        if (nloc == 0u) { xcd_barrier_complete(bar, b.x, nloc, nx); b.st[0] = nloc; b.st[1] = nx; }
        const unsigned old = xb_add(&bar[XB_XSUB(b.x)], 1u);
        const unsigned gen = old / nloc;
        if (old + 1u == (gen + 1u) * nloc) {
            __builtin_amdgcn_fence(__ATOMIC_RELEASE, "agent");
            asm volatile("s_waitcnt vmcnt(0)" ::: "memory");
            const unsigned og = xb_add(&bar[XB_TOP], 1u);
            const unsigned tg = og / nx;
            if (og + 1u == (tg + 1u) * nx) xb_add(&bar[XB_TOPGEN], 1u);
            else XB_SPIN(xb_ld(&bar[XB_TOPGEN]) == tg, bar);
            __builtin_amdgcn_fence(__ATOMIC_ACQUIRE, "agent");
            xb_add(&bar[XB_XGEN(b.x)], 1u);
            asm volatile("s_waitcnt vmcnt(0)" ::: "memory");
        } else {
            XB_SPIN(xb_ld(&bar[XB_XGEN(b.x)]) == gen, bar);
            __builtin_amdgcn_fence(__ATOMIC_ACQUIRE, "agent");
            asm volatile("s_waitcnt vmcnt(0)" ::: "memory");
        }
    }
    __syncthreads();
}

typedef const float* cfp_t;
typedef __attribute__((address_space(4))) const cfp_t* ka_t;
struct Ctx {
    LAS unsigned char* lds; int tid, lane, wave, bid, G;
};

__device__ __forceinline__ void task_ada(const Ctx& F, const float* c, const float* c_ctx, const float* w_ada, float* modp, int task) {
    LAS float* s_act = (LAS float*)F.lds;
    const int l = task / (KSPL * 6), rem = task % (KSPL * 6), ks = rem / 6, cc = rem % 6;
    __syncthreads();
    if (F.tid < 320) { const int v = F.tid >> 6, k = ks * 64 + (F.tid & 63); const float x = v < 4 ? c[v * 2048 + k] : c_ctx[k]; s_act[F.tid] = siluf_(x); }
    __syncthreads();
    const int col4 = cc * 512 + F.tid;
    const float4* wp = (const float4*)(w_ada + ((size_t)l * 2048 + ks * 64) * 12288) + col4;
    float4 acc[5];
#pragma unroll
    for (int v = 0; v < 5; ++v) acc[v] = make_float4(0.f, 0.f, 0.f, 0.f);
#pragma unroll 8
    for (int k = 0; k < 64; ++k) {
        const float4 w = wp[(size_t)k * 3072];
#pragma unroll
        for (int v = 0; v < 5; ++v) { const float a = s_act[v * 64 + k]; acc[v].x += a * w.x; acc[v].y += a * w.y; acc[v].z += a * w.z; acc[v].w += a * w.w; }
    }
#pragma unroll
    for (int v = 0; v < 5; ++v) ((float4*)(modp + (((size_t)ks * 2 + l) * 5 + v) * 12288))[col4] = acc[v];
}
__device__ __forceinline__ void task_wt(const Ctx& F, const float* W, int N, bf16_t* Wt, int ntile) {
    LAS bf16_t* T = (LAS bf16_t*)F.lds;
    const int nq = F.tid & 15, kr = F.tid >> 4, n0 = ntile * 64;
    for (int kc = 0; kc < 16; ++kc) {
        float4 v[4];
#pragma unroll
        for (int j = 0; j < 4; ++j) { const int k = kc * 128 + kr + 32 * j, n = n0 + 4 * nq;
            v[j] = (n < N) ? *(const float4*)(W + (size_t)k * N + n) : make_float4(0.f, 0.f, 0.f, 0.f); }
        __syncthreads();
#pragma unroll
        for (int j = 0; j < 4; ++j) { const int kl = kr + 32 * j;
            T[(4 * nq + 0) * 136 + kl] = f2bf(v[j].x); T[(4 * nq + 1) * 136 + kl] = f2bf(v[j].y); T[(4 * nq + 2) * 136 + kl] = f2bf(v[j].z); T[(4 * nq + 3) * 136 + kl] = f2bf(v[j].w); }
        __syncthreads();
        { const int n = F.tid >> 3, kg = F.tid & 7;
          const u32x4 a = *(LAS u32x4*)(T + n * 136 + kg * 16), b = *(LAS u32x4*)(T + n * 136 + kg * 16 + 8);
          bf16_t* dst = Wt + (size_t)(n0 + n) * 2048 + kc * 128 + kg * 16; *(u32x4*)dst = a; *(u32x4*)(dst + 8) = b; }
    }
    __syncthreads();
}
__device__ __forceinline__ void task_cvt(const Ctx& F, const float* src, bf16_t* dst, size_t off) {
#pragma unroll 4
    for (int it = 0; it < 16; ++it) { const size_t e = off + (size_t)it * 4096 + F.tid * 8;
        const float4 a = *(const float4*)(src + e), b = *(const float4*)(src + e + 4);
        u32x4 o; o.x = pk_bf16(a.x, a.y); o.y = pk_bf16(a.z, a.w); o.z = pk_bf16(b.x, b.y); o.w = pk_bf16(b.z, b.w);
        *(u32x4*)(dst + e) = o; }
}
__device__ __forceinline__ void task_cvt8(const Ctx& F, const float* src, unsigned char* dst, size_t off, float scale) {
#pragma unroll 2
    for (int it = 0; it < 8; ++it) { const size_t e = off + (size_t)it * 8192 + F.tid * 16;
        u32x4 o;
#pragma unroll
        for (int w = 0; w < 4; ++w) { const float4 a = *(const float4*)(src + e + 4 * w);
            const float x0 = fminf(fmaxf(a.x * scale, -448.f), 448.f), x1 = fminf(fmaxf(a.y * scale, -448.f), 448.f), x2 = fminf(fmaxf(a.z * scale, -448.f), 448.f), x3 = fminf(fmaxf(a.w * scale, -448.f), 448.f);
            int p = __builtin_amdgcn_cvt_pk_fp8_f32(x0, x1, 0, false); p = __builtin_amdgcn_cvt_pk_fp8_f32(x2, x3, p, true); o[w] = (unsigned)p; }
        const size_t row = e >> 11; const int col = (int)(e & 2047);
        *(u32x4*)(dst + (row >> 14) * ((size_t)16384 * 2048) + ((size_t)(col >> 7) * 16384 + (row & 16383)) * 128 + (col & 127)) = o; }
}
constexpr float PEER_U_SCALE = 64.0f;
#define PEER_CONVERT_LAYER(F, in, ws, layer, blk, nblk) do { for (int t_ = (blk); t_ < 1024; t_ += (nblk)) { const bool isv_ = t_ >= 512; \
        task_cvt8(F, in[isv_ ? I_PV : I_PU], ws + (isv_ ? WS_PV : WS_PU), (size_t)(layer) * 16384 * 2048 + (size_t)(t_ & 511) * 65536, isv_ ? 1.0f : PEER_U_SCALE); } } while (0)
__device__ __forceinline__ void task_lorat(const Ctx& F, const float* src, bf16_t* dst, int nj) {
    const int ch = F.tid;
    for (int j8 = 0; j8 < nj / 8; ++j8) { float v[8];
#pragma unroll
        for (int q = 0; q < 8; ++q) v[q] = src[(size_t)(j8 * 8 + q) * 512 + ch];
        u32x4 o; o.x = pk_bf16(v[0], v[1]); o.y = pk_bf16(v[2], v[3]); o.z = pk_bf16(v[4], v[5]); o.w = pk_bf16(v[6], v[7]);
        *(u32x4*)(dst + (size_t)ch * nj + j8 * 8) = o; }
}
constexpr int T_ADA = 2 * KSPL * 6, T_WT1 = 2 * 104, T_WT2 = 2 * 32, T_WT3 = 2 * 32, T_PEER = 0, T_KEYS = 8, T_LORA = 10;
__device__ __forceinline__ void phase_prologue(const Ctx& F, ka_t in, unsigned char* ws) {
    const int total = T_ADA + T_WT1 + T_WT2 + T_WT3 + T_PEER + T_KEYS + T_LORA + 1;
    for (int t0 = F.bid; t0 < total; t0 += F.G) {
        int t = t0;
        if (t < T_ADA) { task_ada(F, in[I_C], in[I_CCTX], in[I_WADA], (float*)(ws + WS_MODP), t); continue; } t -= T_ADA;
        if (t < T_WT1) { const int l = t / 104, nt = t % 104; task_wt(F, in[I_WIN] + (size_t)l * 2048 * PT, PT, (bf16_t*)(ws + WS_WIN) + (size_t)l * PTP * 2048, nt); continue; } t -= T_WT1;
        if (t < T_WT2) { const int l = t / 32, nt = t % 32; task_wt(F, in[I_WOUT] + (size_t)l * 2048 * 2048, 2048, (bf16_t*)(ws + WS_WOUT) + (size_t)l * 2048 * 2048, nt); continue; } t -= T_WT2;
        if (t < T_WT3) { const int l = t / 32, nt = t % 32; task_wt(F, in[I_PWQ] + (size_t)l * 2048 * 2048, 2048, (bf16_t*)(ws + WS_WQ) + (size_t)l * 2048 * 2048, nt); continue; } t -= T_WT3;
        if (t < T_PEER) { const bool isv = t >= 1024; const int c = t & 1023; task_cvt8(F, in[isv ? I_PV : I_PU], ws + (isv ? WS_PV : WS_PU), (size_t)c * 65536, isv ? 1.0f : PEER_U_SCALE); continue; } t -= T_PEER;
        if (t < T_KEYS) { task_cvt(F, in[I_PKEYS], (bf16_t*)(ws + WS_KEYS), (size_t)t * 65536); continue; } t -= T_KEYS;
        if (t < T_LORA) {
            if (t < 8) { const int l = t >> 2, wh = t & 3;
                task_lorat(F, in[wh < 2 ? I_RWUP : I_RAUP] + ((size_t)l * 2 + (wh & 1)) * 64 * 512, (bf16_t*)(ws + WS_WUPT) + ((size_t)l * 4 + wh) * 512 * 64, 64); }
            else { const int l = t - 8; task_lorat(F, in[I_RGUP] + (size_t)l * 128 * 512, (bf16_t*)(ws + WS_GUPT) + (size_t)l * 512 * 128, 128); }
            continue; } t -= T_LORA;
        { float* rope = (float*)(ws + WS_ROPE);
          for (int e = F.tid; e < 2048; e += 512) { const int pos = e >> 5, i = e & 31; const float fr = powf(10000.0f, -(float)i / 32.0f), ang = (float)pos * fr;
              rope[2 * e] = cosf(ang); rope[2 * e + 1] = sinf(ang); } }
    }
}
__device__ __forceinline__ void phase_modreduce(const Ctx& F, const float* b_ada, const float* modp, float* mod) {
    for (int idx = F.bid * 512 + F.tid; idx < 2 * 5 * 12288; idx += F.G * 512) {
        const int l = idx / 61440, rem = idx % 61440, v = rem / 12288, n = rem % 12288;
        float s = b_ada[l * 12288 + n];
        for (int ks = 0; ks < KSPL; ++ks) s += modp[(((size_t)ks * 2 + l) * 5 + v) * 12288 + n];
        mod[idx] = s;
    }
}

__device__ __forceinline__ void norm_store(const float (&x)[32], const float* gw, const float* shift, const float* scale, bf16_t* dst, int lane) {
    float ss = 0.f;
#pragma unroll
    for (int q = 0; q < 32; ++q) ss += x[q] * x[q];
    ss = wave_sum(ss);
    const float rs = rsqrtf(ss * (1.0f / 2048.0f) + 1e-6f);
#pragma unroll
    for (int j = 0; j < 4; ++j) { const int e = j * 512 + lane * 8;
        const float4 g0 = *(const float4*)(gw + e), g1 = *(const float4*)(gw + e + 4), h0 = *(const float4*)(shift + e), h1 = *(const float4*)(shift + e + 4), c0 = *(const float4*)(scale + e), c1 = *(const float4*)(scale + e + 4);
        const float y0 = x[j * 8 + 0] * rs * g0.x * (1.f + c0.x) + h0.x, y1 = x[j * 8 + 1] * rs * g0.y * (1.f + c0.y) + h0.y, y2 = x[j * 8 + 2] * rs * g0.z * (1.f + c0.z) + h0.z, y3 = x[j * 8 + 3] * rs * g0.w * (1.f + c0.w) + h0.w;
        const float y4 = x[j * 8 + 4] * rs * g1.x * (1.f + c1.x) + h1.x, y5 = x[j * 8 + 5] * rs * g1.y * (1.f + c1.y) + h1.y, y6 = x[j * 8 + 6] * rs * g1.z * (1.f + c1.z) + h1.z, y7 = x[j * 8 + 7] * rs * g1.w * (1.f + c1.w) + h1.w;
        u32x4 o; o.x = pk_bf16(y0, y1); o.y = pk_bf16(y2, y3); o.z = pk_bf16(y4, y5); o.w = pk_bf16(y6, y7);
        *(u32x4*)(dst + e) = o; }
}
__device__ __forceinline__ void phase_norm(const Ctx& F, const float* xlat, const float* xctx, const float* gw, const float* mod, int shift_i, int scale_i, bf16_t* dst, int nrows) {
    for (int row = F.bid * 8 + F.wave; row < nrows; row += F.G * 8) {
        const bool isctx = row >= NLAT; const float* xr = isctx ? xctx + (size_t)(row - NLAT) * 2048 : xlat + (size_t)row * 2048;
        const int v = isctx ? 4 : (row >> 12);
        float x[32];
#pragma unroll
        for (int j = 0; j < 4; ++j) { const int e = j * 512 + F.lane * 8; const float4 a = *(const float4*)(xr + e), b = *(const float4*)(xr + e + 4);
            x[j * 8 + 0] = a.x; x[j * 8 + 1] = a.y; x[j * 8 + 2] = a.z; x[j * 8 + 3] = a.w; x[j * 8 + 4] = b.x; x[j * 8 + 5] = b.y; x[j * 8 + 6] = b.z; x[j * 8 + 7] = b.w; }
        norm_store(x, gw, mod + (size_t)v * 12288 + shift_i * 2048, mod + (size_t)v * 12288 + scale_i * 2048, dst + (size_t)row * 2048, F.lane);
    }
}

struct LayerW {
    const float *sc_w, *rw_w0, *rw_wup, *rw_a0, *rw_aup, *rw_gup, *rw_kk, *rw_ka, *rw_rk, *rw_lnw, *rw_lnb, *na_q, *na_k, *rpb, *s_cw, *s_cb, *s_dtb, *s_alog, *s_d, *s_norm;
};
__device__ __forceinline__ void unpack8(const u32x4 q, float (&f)[8]) { f[0] = bflo(q[0]); f[1] = bfhi(q[0]); f[2] = bflo(q[1]); f[3] = bfhi(q[1]); f[4] = bflo(q[2]); f[5] = bfhi(q[2]); f[6] = bflo(q[3]); f[7] = bfhi(q[3]); }
__device__ __forceinline__ u32x4 pack8f(const float (&f)[8]) { u32x4 o; o[0] = pk_bf16(f[0], f[1]); o[1] = pk_bf16(f[2], f[3]); o[2] = pk_bf16(f[4], f[5]); o[3] = pk_bf16(f[6], f[7]); return o; }
__device__ __forceinline__ void load8f(const float* p, float (&f)[8]) { const float4 a = *(const float4*)p, b = *(const float4*)(p + 4); f[0] = a.x; f[1] = a.y; f[2] = a.z; f[3] = a.w; f[4] = b.x; f[5] = b.y; f[6] = b.z; f[7] = b.w; }
__device__ __forceinline__ void phase_prep(const Ctx& F, const LayerW& W, unsigned char* ws) {
    const bf16_t* P = (const bf16_t*)(ws + WS_P);
    bf16_t* MIX = (bf16_t*)(ws + WS_MIX);
    bf16_t* XBC = (bf16_t*)(ws + WS_XBC); float* DTS = (float*)(ws + WS_DTS); float* DEC = (float*)(ws + WS_DEC);
    bf16_t* QN = (bf16_t*)(ws + WS_QN); bf16_t* KN = (bf16_t*)(ws + WS_KN); bf16_t* VTL = (bf16_t*)(ws + WS_VTL); bf16_t* VTC = (bf16_t*)(ws + WS_VTC);
    const float* ROPE = (const float*)(ws + WS_ROPE);
    for (int tile = F.bid; tile < NTOK / 8; tile += F.G) {
        int ln = F.lane; asm volatile("" : "+v"(ln));
        const int ch0 = ln * 8;
        const bool lat = tile < NLAT / 8;
        const int b = lat ? (tile >> 9) : ((tile - NLAT / 8) >> 5);
        const int t0 = lat ? (tile & 511) * 8 : ((tile - NLAT / 8) & 31) * 8;
        const int L = lat ? SEQL : CTXL;
        const int g0 = lat ? b * SEQL + t0 : NLAT + b * CTXL + t0;
        const bf16_t* Pr = P + (size_t)g0 * PTP;
        if (F.wave == 0 || F.wave == 4) {
            const bool gated = F.wave == 0;
            const float* cw = gated ? W.sc_w : W.s_cw; const int cstride = gated ? 512 : 1024;
            float w0[8], w1[8], w2[8], cb[8];
            load8f(cw + ch0, w0); load8f(cw + cstride + ch0, w1); load8f(cw + 2 * cstride + ch0, w2);
            if (gated) {
#pragma unroll
                for (int e = 0; e < 8; ++e) cb[e] = 0.f;
            } else load8f(W.s_cb + ch0, cb);
            const int col = gated ? A_CG : D_X;
#pragma unroll 1
            for (int tb = 0; tb < 8; tb += 4) {
            u32x4 ra[6], rb[6], rg[4];
#pragma unroll
            for (int q = 0; q < 6; ++q) { const int tq = t0 + tb - 1 + q; const bool ok = (tq >= 0) && (tq < L);
                ra[q] = ok ? *(const u32x4*)(Pr + (ptrdiff_t)(tb + q - 1) * PTP + col + ch0) : (u32x4){0u, 0u, 0u, 0u};
                if (gated) rb[q] = ok ? *(const u32x4*)(Pr + (ptrdiff_t)(tb + q - 1) * PTP + A_H + ch0) : (u32x4){0u, 0u, 0u, 0u}; }
            if (gated) {
#pragma unroll
                for (int tt = 0; tt < 4; ++tt) rg[tt] = *(const u32x4*)(Pr + (size_t)(tb + tt) * PTP + A_BG + ch0); }
            float up[8], uc[8], un[8];
            { float x[8], y[8]; unpack8(ra[0], x); if (gated) { unpack8(rb[0], y);
#pragma unroll
                for (int e = 0; e < 8; ++e) x[e] *= y[e]; }
#pragma unroll
              for (int e = 0; e < 8; ++e) up[e] = x[e];
              unpack8(ra[1], x); if (gated) { unpack8(rb[1], y);
#pragma unroll
                for (int e = 0; e < 8; ++e) x[e] *= y[e]; }
#pragma unroll
              for (int e = 0; e < 8; ++e) uc[e] = x[e]; }
#pragma unroll
            for (int tt = 0; tt < 4; ++tt) {
                { float x[8], y[8]; unpack8(ra[tt + 2], x); if (gated) { unpack8(rb[tt + 2], y);
#pragma unroll
                    for (int e = 0; e < 8; ++e) x[e] *= y[e]; }
#pragma unroll
                  for (int e = 0; e < 8; ++e) un[e] = x[e]; }
                float o[8];
                if (gated) { float bg[8]; unpack8(rg[tt], bg);
#pragma unroll
                    for (int e = 0; e < 8; ++e) o[e] = bg[e] * (w0[e] * up[e] + w1[e] * uc[e] + w2[e] * un[e]);
                    *(u32x4*)(MIX + (size_t)(g0 + tb + tt) * 2048 + ch0) = pack8f(o);
                } else {
#pragma unroll
                    for (int e = 0; e < 8; ++e) o[e] = siluf_(w0[e] * up[e] + w1[e] * uc[e] + w2[e] * un[e] + cb[e]);
                    *(u32x4*)(XBC + (size_t)(g0 + tb + tt) * 1024 + ch0) = pack8f(o); }
#pragma unroll
                for (int e = 0; e < 8; ++e) { up[e] = uc[e]; uc[e] = un[e]; }
            }
            }
        } else if (F.wave == 1 || F.wave == 2) {
            const bool isq = F.wave == 1; const int col = isq ? C_Q : C_K; bf16_t* dst = isq ? QN : KN;
            float nw[8]; load8f((isq ? W.na_q : W.na_k) + (ln & 7) * 8, nw);
            const float sc = isq ? 0.125f : 1.0f;
            u32x4 rq[8];
#pragma unroll
            for (int tt = 0; tt < 8; ++tt) rq[tt] = *(const u32x4*)(Pr + (size_t)tt * PTP + col + ch0);
#pragma unroll
            for (int tt = 0; tt < 8; ++tt) { float x[8]; unpack8(rq[tt], x); float ss = 0.f;
#pragma unroll
                for (int e = 0; e < 8; ++e) ss += x[e] * x[e];
                ss = sum8(ss); const float rs = rsqrtf(ss * (1.f / 64.f) + 1e-6f) * sc;
#pragma unroll
                for (int e = 0; e < 8; ++e) x[e] = x[e] * rs * nw[e];
                if (isq) *(u32x4*)(dst + (size_t)(g0 + tt) * 512 + ch0) = pack8f(x);
                else {
                    const int hh = ln >> 3, p = ln & 7, t = t0 + tt;
                    bf16_t* kd = lat ? dst + ((size_t)((((b * 8 + hh) * 64 + (t >> 6)) * 2 + (p >> 2)) * 4 + (p & 3)) * 64 + (t & 63)) * 8
                                     : dst + (size_t)NLAT * 512 + ((size_t)(((b * 8 + hh) * 2 + (p >> 2)) * 4 + (p & 3)) * 256 + t) * 8;
                    *(u32x4*)kd = pack8f(x); } }
        } else if (F.wave == 3) {
            u32x4 rv[8];
#pragma unroll
            for (int tt = 0; tt < 8; ++tt) rv[tt] = *(const u32x4*)(Pr + (size_t)tt * PTP + C_V + ch0);
            const int h = ln >> 3;
#pragma unroll
            for (int e = 0; e < 8; ++e) { const int i = (ln & 7) * 8 + e;
                unsigned short v[8];
#pragma unroll
                for (int tt = 0; tt < 8; ++tt) v[tt] = (unsigned short)((e & 1) ? (rv[tt][e >> 1] >> 16) : (rv[tt][e >> 1] & 0xffffu));
                u32x2 c0; c0.x = (unsigned)v[0] | ((unsigned)v[1] << 16); c0.y = (unsigned)v[2] | ((unsigned)v[3] << 16);
                u32x2 c1; c1.x = (unsigned)v[4] | ((unsigned)v[5] << 16); c1.y = (unsigned)v[6] | ((unsigned)v[7] << 16);
                if (lat) { const int row = t0 >> 6, x0 = (t0 & 63) >> 2, x1 = x0 + 1;
                    bf16_t* base = VTL + ((size_t)((b * 8 + h) * 64 + row) * 12 * 64 + i) * 8;
                    if (x0 <= 11) *(u32x2*)(base + x0 * 512) = c0;
                    if (x0 >= 4)  *(u32x2*)(base + (x0 - 4) * 512 + 4) = c0;
                    if (x1 <= 11) *(u32x2*)(base + x1 * 512) = c1;
                    if (x1 >= 4)  *(u32x2*)(base + (x1 - 4) * 512 + 4) = c1;
                } else { const int m = t0 >> 5, o = t0 & 31, gq = (o & 15) >> 2, hf = (o >> 4) * 4;
                    bf16_t* base = VTC + ((size_t)(((b * 8 + h) * 8 + m) * 4) * 64 + i) * 8;
                    *(u32x2*)(base + gq * 512 + hf) = c0; *(u32x2*)(base + (gq + 1) * 512 + hf) = c1; } }
        } else if (F.wave == 5 || F.wave == 7) {
            {
                const int pg = ln & 15, tb = (ln >> 4) * 2, which = F.wave == 7 ? 1 : 0, gi = (pg >> 3) & 1, half = (pg >> 2) & 1, i0 = (pg & 3) * 8;
                const int c1 = 512 + which * 256 + gi * 128 + half * 64 + i0, c2 = c1 + 32;
                float wa0[8], wa1[8], wa2[8], ba[8], wb0[8], wb1[8], wb2[8], bb[8];
                load8f(W.s_cw + c1, wa0); load8f(W.s_cw + 1024 + c1, wa1); load8f(W.s_cw + 2048 + c1, wa2); load8f(W.s_cb + c1, ba);
                load8f(W.s_cw + c2, wb0); load8f(W.s_cw + 1024 + c2, wb1); load8f(W.s_cw + 2048 + c2, wb2); load8f(W.s_cb + c2, bb);
                u32x4 ra[4], rb[4];
#pragma unroll
                for (int q = 0; q < 4; ++q) { const int tq = t0 + tb - 1 + q; const bool ok = (tq >= 0) && (tq < L);
                    ra[q] = ok ? *(const u32x4*)(Pr + (ptrdiff_t)(tb + q - 1) * PTP + D_X + c1) : (u32x4){0u, 0u, 0u, 0u};
                    rb[q] = ok ? *(const u32x4*)(Pr + (ptrdiff_t)(tb + q - 1) * PTP + D_X + c2) : (u32x4){0u, 0u, 0u, 0u}; }
                float ap[8], ac[8], an[8], bp[8], bc[8], bn[8];
                unpack8(ra[0], ap); unpack8(ra[1], ac); unpack8(rb[0], bp); unpack8(rb[1], bc);
#pragma unroll
                for (int tt = 0; tt < 2; ++tt) { unpack8(ra[tt + 2], an); unpack8(rb[tt + 2], bn);
                    float y1[8], y2[8];
#pragma unroll
                    for (int e = 0; e < 8; ++e) { y1[e] = siluf_(wa0[e] * ap[e] + wa1[e] * ac[e] + wa2[e] * an[e] + ba[e]); y2[e] = siluf_(wb0[e] * bp[e] + wb1[e] * bc[e] + wb2[e] * bn[e] + bb[e]); }
                    if (lat) { const int t = t0 + tb + tt, pos = half ? (t & 63) : (t >> 6);
                        float cs[16];
#pragma unroll
                        for (int q = 0; q < 4; ++q) { const float4 v = *(const float4*)(ROPE + (size_t)(pos * 32 + i0) * 2 + 4 * q); cs[4 * q] = v.x; cs[4 * q + 1] = v.y; cs[4 * q + 2] = v.z; cs[4 * q + 3] = v.w; }
#pragma unroll
                        for (int e = 0; e < 8; ++e) { const float o1 = y1[e] * cs[2 * e] - y2[e] * cs[2 * e + 1], o2 = y1[e] * cs[2 * e + 1] + y2[e] * cs[2 * e]; y1[e] = o1; y2[e] = o2; } }
                    *(u32x4*)(XBC + (size_t)(g0 + tb + tt) * 1024 + c1) = pack8f(y1); *(u32x4*)(XBC + (size_t)(g0 + tb + tt) * 1024 + c2) = pack8f(y2);
#pragma unroll
                    for (int e = 0; e < 8; ++e) { ap[e] = ac[e]; ac[e] = an[e]; bp[e] = bc[e]; bc[e] = bn[e]; }
                }
            }
        } else if (F.wave == 6) {
#pragma unroll
            for (int q = 0; q < 2; ++q) { const int it = ln + 64 * q, tt = it >> 4, j = it & 15;
                const float x = bf2f(Pr[(size_t)tt * PTP + D_DT + j]) + W.s_dtb[j];
                const float sp = fmaxf(x, 0.f) + log1pf(__expf(-fabsf(x)));
                DTS[(size_t)(g0 + tt) * 16 + j] = sp; DEC[(size_t)(g0 + tt) * 16 + j] = -sp * __expf(W.s_alog[j]); }
        }
    }
}

constexpr int SB_PITCH = 136;
__device__ __forceinline__ void ssd_scan_L(const Ctx& F, LAS float* sL, const float* LA, int g0, int h) {
    const int d = (F.tid >> 7) & 1, t = F.tid & 127;
    float v = 0.f;
    if (F.tid < 256) { v = LA[(size_t)(g0 + t) * 16 + d * 8 + h]; sL[F.tid] = v; }
    __syncthreads();
#pragma unroll
    for (int off = 1; off < 128; off <<= 1) {
        float o = 0.f;
        if (F.tid < 256) { const int tp = d ? t + off : t - off; if (tp >= 0 && tp < 128) o = sL[d * 128 + tp]; }
        __syncthreads();
        if (F.tid < 256) { v += o; sL[F.tid] = v; }
        __syncthreads();
    }
}
template <bool PASS2>
__device__ __forceinline__ void ssd_task(const Ctx& F, const LayerW& W, unsigned char* ws, int task) {
    const bf16_t* XBC = (const bf16_t*)(ws + WS_XBC); const float* DTS = (const float*)(ws + WS_DTS); const float* LA = (const float*)(ws + WS_DEC);
    float* SST = (float*)(ws + WS_SST); float* SCD = (float*)(ws + WS_SCD); float* YS = (float*)(ws + WS_YS);
    const int c = task % NCH, bh = task / NCH, h = bh & 7, b = bh >> 3, gi = h >> 2;
    const int g0 = c < 2 ? NLAT + b * CTXL + c * 128 : b * SEQL + (c - 2) * 128;
    const int w = F.wave, l16 = F.lane & 15, g = F.lane >> 4;
    const f32x4 z4 = {0.f, 0.f, 0.f, 0.f};
    LAS float* sL = (LAS float*)(F.lds + 131072);
    LAS float* sDT = sL + 256;
    __syncthreads();
    if (F.tid < 256) { const int s = F.tid >> 1, d = F.tid & 1; sDT[F.tid] = DTS[(size_t)(g0 + s) * 16 + d * 8 + h]; }
    ssd_scan_L(F, sL, LA, g0, h);
    if (!PASS2) {
        LAS bf16_t* sBT = (LAS bf16_t*)F.lds;
        LAS bf16_t* sXT = sBT + 128 * SB_PITCH;
#pragma unroll
        for (int q = 0; q < 4; ++q) { const int v = F.tid + 512 * q, s = v >> 4, part = v & 15;
            const u32x4 bv = *(const u32x4*)(XBC + (size_t)(g0 + s) * 1024 + 512 + gi * 128 + part * 8);
#pragma unroll
            for (int e = 0; e < 4; ++e) { sBT[(part * 8 + 2 * e) * SB_PITCH + s] = (bf16_t)(bv[e] & 0xffffu); sBT[(part * 8 + 2 * e + 1) * SB_PITCH + s] = (bf16_t)(bv[e] >> 16); } }
#pragma unroll
        for (int q = 0; q < 2; ++q) { const int v = F.tid + 512 * q, s = v >> 3, part = v & 7;
            const u32x4 xv = *(const u32x4*)(XBC + (size_t)(g0 + s) * 1024 + h * 64 + part * 8);
            const float sc0 = sDT[s * 2] * __expf(sL[127] - sL[s]), sc1 = sDT[s * 2 + 1] * __expf(sL[128] - sL[128 + s]);
#pragma unroll
            for (int e = 0; e < 4; ++e) { const float lo = bflo(xv[e]), hi = bfhi(xv[e]); const int p = part * 8 + 2 * e;
                sXT[p * SB_PITCH + s] = f2bf(lo * sc0); sXT[(p + 1) * SB_PITCH + s] = f2bf(hi * sc0);
                sXT[(64 + p) * SB_PITCH + s] = f2bf(lo * sc1); sXT[(64 + p + 1) * SB_PITCH + s] = f2bf(hi * sc1); } }
        __syncthreads();
        bf16x8 bfr[4];
#pragma unroll
        for (int ks = 0; ks < 4; ++ks) bfr[ks] = *(const LAS bf16x8*)(sBT + (16 * w + l16) * SB_PITCH + 32 * ks + 8 * g);
#pragma unroll
        for (int d = 0; d < 2; ++d) {
            float* st = SST + ((size_t)((b * 8 + h) * 2 + d) * NCH + c) * 8192;
#pragma unroll
            for (int pt = 0; pt < 4; ++pt) { f32x4 acc = z4;
#pragma unroll
                for (int ks = 0; ks < 4; ++ks) acc = __builtin_amdgcn_mfma_f32_16x16x32_bf16(*(const LAS bf16x8*)(sXT + (d * 64 + 16 * pt + l16) * SB_PITCH + 32 * ks + 8 * g), bfr[ks], acc, 0, 0, 0);
#pragma unroll
                for (int r = 0; r < 4; ++r) st[(16 * pt + 4 * g + r) * 128 + 16 * w + l16] = acc[r]; }
            if (F.tid == 0) SCD[((b * 8 + h) * 2 + d) * NCH + c] = __expf(d ? sL[128] : sL[127]);
        }
    } else {
        LAS bf16_t* sB = (LAS bf16_t*)F.lds;
        LAS bf16_t* sC = sB + 128 * SB_PITCH;
        LAS bf16_t* sXT = sC + 128 * SB_PITCH;
        LAS bf16_t* sS = sXT + 64 * SB_PITCH;
#pragma unroll
        for (int q = 0; q < 4; ++q) { const int v = F.tid + 512 * q, s = v >> 4, part = v & 15;
            *(LAS u32x4*)(sB + s * SB_PITCH + part * 8) = *(const u32x4*)(XBC + (size_t)(g0 + s) * 1024 + 512 + gi * 128 + part * 8);
            *(LAS u32x4*)(sC + s * SB_PITCH + part * 8) = *(const u32x4*)(XBC + (size_t)(g0 + s) * 1024 + 768 + gi * 128 + part * 8); }
#pragma unroll
        for (int q = 0; q < 2; ++q) { const int v = F.tid + 512 * q, s = v >> 3, part = v & 7;
            const u32x4 xv = *(const u32x4*)(XBC + (size_t)(g0 + s) * 1024 + h * 64 + part * 8);
#pragma unroll
            for (int e = 0; e < 4; ++e) { sXT[(part * 8 + 2 * e) * SB_PITCH + s] = (bf16_t)(xv[e] & 0xffffu); sXT[(part * 8 + 2 * e + 1) * SB_PITCH + s] = (bf16_t)(xv[e] >> 16); } }
#pragma unroll
        for (int q = 0; q < 4; ++q) { const int v = F.tid + 512 * q, d = v >> 10, p = (v >> 4) & 63, part = v & 15;
            const float* sp = SST + ((size_t)((b * 8 + h) * 2 + d) * NCH + c) * 8192 + p * 128 + part * 8;
            const float4 a0 = *(const float4*)sp, a1 = *(const float4*)(sp + 4);
            u32x4 o; o.x = pk_bf16(a0.x, a0.y); o.y = pk_bf16(a0.z, a0.w); o.z = pk_bf16(a1.x, a1.y); o.w = pk_bf16(a1.z, a1.w);
            *(LAS u32x4*)(sS + (d * 64 + p) * SB_PITCH + part * 8) = o; }
        __syncthreads();
        const int t = 16 * w + l16;
        bf16x8 cfr[4];
#pragma unroll
        for (int ks = 0; ks < 4; ++ks) cfr[ks] = *(const LAS bf16x8*)(sC + t * SB_PITCH + 32 * ks + 8 * g);
        f32x4 gt[8];
#pragma unroll
        for (int a = 0; a < 8; ++a) { f32x4 acc = z4;
#pragma unroll
            for (int ks = 0; ks < 4; ++ks) acc = __builtin_amdgcn_mfma_f32_16x16x32_bf16(*(const LAS bf16x8*)(sB + (16 * a + l16) * SB_PITCH + 32 * ks + 8 * g), cfr[ks], acc, 0, 0, 0);
            gt[a] = acc; }
        f32x4 ysum[4] = {z4, z4, z4, z4};
#pragma unroll
        for (int d = 0; d < 2; ++d) {
            const float Lt = sL[d * 128 + t], eLt = __expf(Lt);
            f32x4 acc[4];
#pragma unroll
            for (int pt = 0; pt < 4; ++pt) { f32x4 a = z4;
#pragma unroll
                for (int ks = 0; ks < 4; ++ks) a = __builtin_amdgcn_mfma_f32_16x16x32_bf16(*(const LAS bf16x8*)(sS + (d * 64 + 16 * pt + l16) * SB_PITCH + 32 * ks + 8 * g), cfr[ks], a, 0, 0, 0);
                acc[pt] = a * eLt; }
#pragma unroll
            for (int m = 0; m < 4; ++m) {
                const bool need = d ? (2 * m + 1 >= w) : (2 * m <= w);
                if (need) {
                    f32x4 wt[2];
#pragma unroll
                    for (int u = 0; u < 2; ++u) { const int a = 2 * m + u;
                        const f32x4 Ls = *(const LAS f32x4*)(sL + d * 128 + 16 * a + 4 * g);
#pragma unroll
                        for (int r = 0; r < 4; ++r) { const int s = 16 * a + 4 * g + r; const bool ok = d ? (s >= t) : (s <= t);
                            const float dts = sDT[s * 2 + d];
                            wt[u][r] = ok ? gt[a][r] * __expf(Lt - Ls[r]) * dts : 0.f; } }
                    const bf16x8 bfrag = pack8(wt[0], wt[1]);
#pragma unroll
                    for (int pt = 0; pt < 4; ++pt) { union { bf16x8 v; u32x2 hh[2]; } af;
                        af.hh[0] = *(const LAS u32x2*)(sXT + (16 * pt + l16) * SB_PITCH + 32 * m + 4 * g); af.hh[1] = *(const LAS u32x2*)(sXT + (16 * pt + l16) * SB_PITCH + 32 * m + 16 + 4 * g);
                        acc[pt] = __builtin_amdgcn_mfma_f32_16x16x32_bf16(af.v, bfrag, acc[pt], 0, 0, 0); }
                }
            }
#pragma unroll
            for (int pt = 0; pt < 4; ++pt) ysum[pt] = ysum[pt] + acc[pt];
        }
        const float dsk = W.s_d[h];
#pragma unroll
        for (int pt = 0; pt < 4; ++pt) { const int p = 16 * pt + 4 * g;
            const u32x2 xv = *(const u32x2*)(XBC + (size_t)(g0 + t) * 1024 + h * 64 + p);
            *(float4*)(YS + (size_t)(g0 + t) * 512 + h * 64 + p) = make_float4(ysum[pt][0] + dsk * bflo(xv.x), ysum[pt][1] + dsk * bfhi(xv.x), ysum[pt][2] + dsk * bflo(xv.y), ysum[pt][3] + dsk * bfhi(xv.y)); }
    }
}
template <int D> __device__ __forceinline__ void ssd_combine_one(float4* base, const float* scd) {
    float4 carry = make_float4(0.f, 0.f, 0.f, 0.f);
#pragma unroll
    for (int k0 = 0; k0 < NCH; k0 += 17) {
        float4 tmp[17];
#pragma unroll
        for (int k = 0; k < 17; ++k) { const int kk = k0 + k, c = D ? (kk < 2 ? 1 - kk : 35 - kk) : kk; tmp[k] = base[(size_t)c * 2048]; }
#pragma unroll
        for (int k = 0; k < 17; ++k) { const int kk = k0 + k, c = D ? (kk < 2 ? 1 - kk : 35 - kk) : kk; const float a = scd[c];
            base[(size_t)c * 2048] = carry;
            carry.x = a * carry.x + tmp[k].x; carry.y = a * carry.y + tmp[k].y; carry.z = a * carry.z + tmp[k].z; carry.w = a * carry.w + tmp[k].w; }
    }
}
__device__ __forceinline__ void phase_ssd_combine(const Ctx& F, unsigned char* ws) {
    float4* SST4 = (float4*)(ws + WS_SST); const float* SCD = (const float*)(ws + WS_SCD);
    for (int gt = F.bid * 512 + F.tid; gt < 64 * 2048; gt += F.G * 512) {
        const int sidx = gt >> 11, e4 = gt & 2047;
        float4* base = SST4 + (size_t)sidx * NCH * 2048 + e4;
        if (sidx & 1) ssd_combine_one<1>(base, SCD + sidx * NCH); else ssd_combine_one<0>(base, SCD + sidx * NCH);
    }
}

constexpr int RWF_CHUNK = 13312;
constexpr int RW_NCHUNK = NPOS / 16;
template <int CTRL> __device__ __forceinline__ float dpp_id0(float v) { return __int_as_float(__builtin_amdgcn_update_dpp(0, __float_as_int(v), CTRL, 0xF, 0xF, true)); }
template <int CTRL> __device__ __forceinline__ float dpp_id1(float v) { return __int_as_float(__builtin_amdgcn_update_dpp(0x3f800000, __float_as_int(v), CTRL, 0xF, 0xF, false)); }
__device__ __forceinline__ float sel4(int g, float a, float b, float c, float d) { return g == 0 ? a : (g == 1 ? b : (g == 2 ? c : d)); }

template <int D> __device__ __forceinline__ void rwkv_pre_dir(const bf16_t* wupt, const bf16x8 (&bw)[2], const bf16x8 (&ba)[2], const f32x4 (&kk)[4], const f32x4 (&rr)[4], const f32x4 (&kx)[4],
        const float* w0p, const float* a0p, const float* kap, const float* rkp, float& bon, LAS unsigned char* wl, unsigned char* dst, int l16, int g) {
    LAS float* LT = (LAS float*)wl; LAS float* AT = LT + 256; LAS bf16_t* BT = (LAS bf16_t*)(wl + 2048); LAS bf16_t* KT = BT + 1024;
    const int lane = g * 16 + l16;
    bf16x8* o = (bf16x8*)dst;
    const f32x4 z4 = {0.f, 0.f, 0.f, 0.f};
    bf16x8 af[2], bf[2], kf[2], rf[2];
#pragma unroll
    for (int p = 0; p < 2; ++p) {
        f32x4 al[2], be[2], ka[2], rh[2];
#pragma unroll
        for (int mm = 0; mm < 2; ++mm) { const int m = 2 * p + mm; asm volatile("" ::: "memory");
            const bf16_t* wpw = wupt + ((size_t)D * 512 + 16 * m + l16) * 64 + 8 * g; const bf16_t* wpa = wupt + ((size_t)(2 + D) * 512 + 16 * m + l16) * 64 + 8 * g;
            f32x4 aw = __builtin_amdgcn_mfma_f32_16x16x32_bf16(*(const bf16x8*)wpw, bw[0], z4, 0, 0, 0); aw = __builtin_amdgcn_mfma_f32_16x16x32_bf16(*(const bf16x8*)(wpw + 32), bw[1], aw, 0, 0, 0);
            f32x4 aa = __builtin_amdgcn_mfma_f32_16x16x32_bf16(*(const bf16x8*)wpa, ba[0], z4, 0, 0, 0); aa = __builtin_amdgcn_mfma_f32_16x16x32_bf16(*(const bf16x8*)(wpa + 32), ba[1], aa, 0, 0, 0);
            const float4 w0 = *(const float4*)(w0p + 16 * m + 4 * g), a0 = *(const float4*)(a0p + 16 * m + 4 * g), kav = *(const float4*)(kap + 16 * m + 4 * g), rkv = *(const float4*)(rkp + 16 * m + 4 * g);
            const float w0a[4] = {w0.x, w0.y, w0.z, w0.w}, a0a[4] = {a0.x, a0.y, a0.z, a0.w}, kaa[4] = {kav.x, kav.y, kav.z, kav.w}, rka[4] = {rkv.x, rkv.y, rkv.z, rkv.w};
            f32x4 gcv;
#pragma unroll
            for (int r = 0; r < 4; ++r) {
                const float a = sigmoidf_(a0a[r] + aa[r]);
                const float kd = kx[m][r] * (1.f + (a - 1.f) * kaa[r]), bb = kk[m][r] * a;
                bon += rr[m][r] * kd * rka[r];
                float Lg = -0.8750387749205294f * sigmoidf_(w0a[r] + aw[r]);
                if (D == 0) { Lg += dpp_id0<0x111>(Lg); Lg += dpp_id0<0x112>(Lg); Lg += dpp_id0<0x114>(Lg); Lg += dpp_id0<0x118>(Lg); }
                else        { Lg += dpp_id0<0x101>(Lg); Lg += dpp_id0<0x102>(Lg); Lg += dpp_id0<0x104>(Lg); Lg += dpp_id0<0x108>(Lg); }
                const float Lex = (D == 0) ? dpp_id0<0x111>(Lg) : dpp_id0<0x101>(Lg);
                const float G = __builtin_amdgcn_exp2f(Lg), Gex = __builtin_amdgcn_exp2f(Lex), iG = __builtin_amdgcn_exp2f(-Lg);
                al[mm][r] = Gex * kk[m][r]; be[mm][r] = bb * iG; ka[mm][r] = kd * iG; rh[mm][r] = G * rr[m][r]; gcv[r] = G;
                const int k = 16 * m + 4 * g + r; const unsigned pk_ = pk_bf16(be[mm][r], ka[mm][r]); BT[k * 16 + l16] = (bf16_t)(pk_ & 0xffffu); KT[k * 16 + l16] = (bf16_t)(pk_ >> 16);
            }
            if (l16 == ((D == 0) ? 15 : 0)) *(float4*)((float*)(dst + 12288) + 16 * m + 4 * g) = make_float4(gcv[0], gcv[1], gcv[2], gcv[3]);
        }
        af[p] = pack8(al[0], al[1]); bf[p] = pack8(be[0], be[1]); kf[p] = pack8(ka[0], ka[1]); rf[p] = pack8(rh[0], rh[1]);
        o[64 * p + lane] = af[p]; o[128 + 64 * p + lane] = rf[p];
        __builtin_amdgcn_sched_barrier(0);
    }
    f32x4 Lm = __builtin_amdgcn_mfma_f32_16x16x32_bf16(af[0], bf[0], z4, 0, 0, 0); Lm = __builtin_amdgcn_mfma_f32_16x16x32_bf16(af[1], bf[1], Lm, 0, 0, 0);
    f32x4 Am = __builtin_amdgcn_mfma_f32_16x16x32_bf16(af[0], kf[0], z4, 0, 0, 0); Am = __builtin_amdgcn_mfma_f32_16x16x32_bf16(af[1], kf[1], Am, 0, 0, 0);
    f32x4 Bb = __builtin_amdgcn_mfma_f32_16x16x32_bf16(bf[0], rf[0], z4, 0, 0, 0); Bb = __builtin_amdgcn_mfma_f32_16x16x32_bf16(bf[1], rf[1], Bb, 0, 0, 0);
    f32x4 Bk = __builtin_amdgcn_mfma_f32_16x16x32_bf16(kf[0], rf[0], z4, 0, 0, 0); Bk = __builtin_amdgcn_mfma_f32_16x16x32_bf16(kf[1], rf[1], Bk, 0, 0, 0);
#pragma unroll
    for (int r = 0; r < 4; ++r) { const int row = 4 * g + r;
        const bool strict = (D == 0) ? (l16 < row) : (l16 > row);
        const bool incl = (D == 0) ? (row <= l16) : (row >= l16);
        Lm[r] = strict ? Lm[r] : 0.f; Am[r] = strict ? Am[r] : 0.f; Bb[r] = incl ? Bb[r] : 0.f; Bk[r] = incl ? Bk[r] : 0.f; }
    *(LAS f32x4*)(LT + l16 * 16 + 4 * g) = Lm; *(LAS f32x4*)(AT + l16 * 16 + 4 * g) = Am;
    o[320 + lane] = pack8(Bb, Bk);
    asm volatile("" ::: "memory");
#pragma unroll
    for (int m = 0; m < 4; ++m) { union { bf16x8 v; u32x2 h[2]; } f;
        f.h[0] = *(LAS u32x2*)(BT + (16 * m + l16) * 16 + 4 * g); f.h[1] = *(LAS u32x2*)(KT + (16 * m + l16) * 16 + 4 * g);
        o[384 + 64 * m + lane] = f.v; }
    __builtin_amdgcn_sched_barrier(0);
    float x[16];
    if (D == 0) {
#pragma unroll
        for (int c = 15; c >= 0; --c) { float s = (c == l16) ? 1.f : 0.f; asm volatile("" ::: "memory");
#pragma unroll
            for (int i = c + 1; i < 16; ++i) s -= x[i] * LT[c * 16 + i];
            x[c] = s; }
    } else {
#pragma unroll
        for (int c = 0; c < 16; ++c) { float s = (c == l16) ? 1.f : 0.f; asm volatile("" ::: "memory");
#pragma unroll
            for (int i = 0; i < c; ++i) s -= x[i] * LT[c * 16 + i];
            x[c] = s; }
    }
    f32x4 tm0, tm1;
#pragma unroll
    for (int r = 0; r < 4; ++r) tm0[r] = -sel4(g, x[r], x[4 + r], x[8 + r], x[12 + r]);
#pragma unroll
    for (int r = 0; r < 4; ++r) { const int c = 4 * g + r; float s = 0.f; asm volatile("" ::: "memory");
#pragma unroll
        for (int i = 0; i < 16; i += 4) { const f32x4 a4 = *(LAS f32x4*)(AT + c * 16 + i); s += x[i] * a4[0] + x[i + 1] * a4[1] + x[i + 2] * a4[2] + x[i + 3] * a4[3]; }
        tm1[r] = -s; }
    o[256 + lane] = pack8(tm0, tm1);
    asm volatile("" ::: "memory");
}
__device__ __forceinline__ void rwkv_pre_task(const Ctx& F, const LayerW& W, unsigned char* ws, const bf16_t* WUPT, int task, int dsel) {
    const bf16_t* P = (const bf16_t*)(ws + WS_P); float* BON = (float*)(ws + WS_BON); unsigned char* RWF = ws + WS_RWF;
    const int cidx = task % RW_NCHUNK, bh = task / RW_NCHUNK, h = bh & 7, b = bh >> 3;
    int ln_ = F.lane; asm volatile("" : "+v"(ln_));
    const int l16 = ln_ & 15, g = ln_ >> 4;
    const int pos = cidx * 16 + l16;
    const int tok = pos < CTXL ? NLAT + b * CTXL + pos : b * SEQL + (pos - CTXL);
    const bf16_t* Pr = P + (size_t)tok * PTP;
    LAS unsigned char* wl = F.lds + F.wave * 8192;
    bf16x8 bw[2], ba[2];
#pragma unroll
    for (int p = 0; p < 2; ++p) { const u32x4 q = *(const u32x4*)(Pr + B_WD + 32 * p + 8 * g); union { bf16x8 v; unsigned u[4]; } tq;
#pragma unroll
        for (int e = 0; e < 4; ++e) tq.u[e] = pk_bf16(tanhf_(bflo(q[e])), tanhf_(bfhi(q[e])));
        bw[p] = tq.v; ba[p] = *(const bf16x8*)(Pr + B_AD + 32 * p + 8 * g); }
    f32x4 kk[4], rr[4], kx[4];
    float ssq = 0.f;
#pragma unroll
    for (int m = 0; m < 4; ++m) { const int co = h * 64 + 16 * m + 4 * g;
        const u32x2 rq = *(const u32x2*)(Pr + B_R + co), kq = *(const u32x2*)(Pr + B_K + co); const float4 kkw = *(const float4*)(W.rw_kk + co);
        rr[m] = (f32x4){bflo(rq.x), bfhi(rq.x), bflo(rq.y), bfhi(rq.y)}; kx[m] = (f32x4){bflo(kq.x), bfhi(kq.x), bflo(kq.y), bfhi(kq.y)};
        kk[m] = (f32x4){kx[m][0] * kkw.x, kx[m][1] * kkw.y, kx[m][2] * kkw.z, kx[m][3] * kkw.w};
        ssq += kk[m][0] * kk[m][0] + kk[m][1] * kk[m][1] + kk[m][2] * kk[m][2] + kk[m][3] * kk[m][3]; }
    ssq += xor16_f(ssq); ssq = sum_x32(ssq);
    { const float rn = rsqrtf(ssq + 1e-12f);
#pragma unroll
      for (int m = 0; m < 4; ++m) kk[m] = kk[m] * rn; }
    float bon = 0.f;
    const int co = h * 64;
    const int c0 = cidx, c1 = cidx < 16 ? 15 - cidx : 287 - cidx;
    {
      const int tok0 = cidx < 16 ? NLAT + b * CTXL + cidx * 16 : b * SEQL + cidx * 16 - CTXL;
      const bf16_t* vp = P + (size_t)(tok0 + 4 * g) * PTP + B_V + h * 64 + l16;
      u32x2* vd = (u32x2*)(RWF + ((size_t)(bh * 2 + dsel) * RW_NCHUNK + (dsel ? c1 : c0)) * RWF_CHUNK + 10240) + ln_;
#pragma unroll
      for (int n = 0; n < 4; ++n) { u32x2 w; w.x = (unsigned)vp[16 * n] | ((unsigned)vp[PTP + 16 * n] << 16); w.y = (unsigned)vp[2 * PTP + 16 * n] | ((unsigned)vp[3 * PTP + 16 * n] << 16); vd[64 * n] = w; } }
    if (dsel == 0) rwkv_pre_dir<0>(WUPT + (size_t)co * 64, bw, ba, kk, rr, kx, W.rw_w0 + co, W.rw_a0 + co, W.rw_ka + co, W.rw_rk + co, bon, wl, RWF + ((size_t)(bh * 2 + 0) * RW_NCHUNK + c0) * RWF_CHUNK, l16, g);
    else           rwkv_pre_dir<1>(WUPT + (size_t)co * 64, bw, ba, kk, rr, kx, W.rw_w0 + 512 + co, W.rw_a0 + 512 + co, W.rw_ka + co, W.rw_rk + co, bon, wl, RWF + ((size_t)(bh * 2 + 1) * RW_NCHUNK + c1) * RWF_CHUNK, l16, g);
    bon += xor16_f(bon); bon = sum_x32(bon);
    if (g == 0) BON[((size_t)dsel * NTOK + tok) * 8 + h] = bon;
}
constexpr int RW_R = 10;
constexpr int RW_OP = 144;
struct RwFrag { bf16x8 a0, a1, r0, r1, tm, bb, bk0, bk1, bk2, bk3; f32x4 g0, g1, g2, g3; u32x2 v; };
__device__ __forceinline__ void rwkv_scan(const Ctx& F, unsigned char* ws, int sidx) {
    const unsigned char* base = ws + WS_RWF + (size_t)sidx * RW_NCHUNK * RWF_CHUNK;
    const int d = sidx & 1, h = (sidx >> 1) & 7, b = sidx >> 4;
    const int sgn = 1 - 2 * d, offA = d * 15, offB = d * 287;
    const int tokA = NLAT + b * CTXL, tokB = b * SEQL - CTXL;
    unsigned char* Yb = ws + WS_RWY + (size_t)d * NTOK * 1024;
    if (F.wave >= 4) {
        const int w = F.wave - 4; const unsigned lo = (unsigned)F.lane * 16u;
#define RW_DMA(ch) do { const int ch_ = (ch) < RW_NCHUNK ? (ch) : RW_NCHUNK - 1; const unsigned char* rec_ = base + (size_t)ch_ * RWF_CHUNK; LAS unsigned char* sl_ = F.lds + ((ch) % RW_R) * RWF_CHUNK; \
        _Pragma("unroll") for (int i_ = 0; i_ < 3; ++i_) __builtin_amdgcn_global_load_lds((const unsigned*)(rec_ + (w + 4 * i_) * 1024 + lo), (LAS unsigned*)(sl_ + (w + 4 * i_) * 1024), 16, 0, 0); \
        if (w == 0) __builtin_amdgcn_global_load_lds((const unsigned*)(rec_ + 12288 + lo), (LAS unsigned*)(sl_ + 12288), 16, 0, 0); } while (0)
#pragma unroll 1
        for (int ch = 0; ch < RW_R - 1; ++ch) RW_DMA(ch);
        asm volatile("s_waitcnt vmcnt(%0)" :: "n"(3 * (RW_R - 3)) : "memory");
        __builtin_amdgcn_s_barrier();
#pragma unroll 1
        for (int c = 0; c <= RW_NCHUNK; ++c) {
            asm volatile("s_waitcnt vmcnt(%0)" :: "n"(3 * (RW_R - 3)) : "memory");
            asm volatile("s_waitcnt lgkmcnt(0)" ::: "memory");
            __builtin_amdgcn_s_barrier();
            if (c < RW_NCHUNK) RW_DMA(c + RW_R - 1);
            if (c > 0 && ((c - 1) & 3) == w) {
                const int cp = c - 1, ci = ((cp) < 16 ? offA : offB) + sgn * cp, tk = ((ci) < 16 ? tokA : tokB) + ci * 16;
                const LAS unsigned char* ot = F.lds + RW_R * RWF_CHUNK + (cp & 1) * (16 * RW_OP) + (F.lane >> 2) * RW_OP + (F.lane & 3) * 16;
                const u32x4 v0 = *(const LAS u32x4*)ot, v1 = *(const LAS u32x4*)(ot + 64);
                unsigned char* yp = Yb + ((size_t)(tk + (F.lane >> 2)) * 512 + h * 64) * 2 + (F.lane & 3) * 16;
                *(u32x4*)yp = v0; *(u32x4*)(yp + 64) = v1; }
        }
        asm volatile("s_waitcnt vmcnt(0)" ::: "memory");
#undef RW_DMA
        return;
    }
    const int n = F.wave, l16 = F.lane & 15, g = F.lane >> 4;
    LAS unsigned char* otw = F.lds + RW_R * RWF_CHUNK + (4 * g) * RW_OP + (16 * n + l16) * 2;
#define RW_LDSF(fr, c) do { LAS unsigned char* sl_ = F.lds + ((c) % RW_R) * RWF_CHUNK; const LAS bf16x8* q_ = (const LAS bf16x8*)sl_ + F.lane; \
        fr.a0 = q_[0]; fr.a1 = q_[64]; fr.r0 = q_[128]; fr.r1 = q_[192]; fr.tm = q_[256]; fr.bb = q_[320]; fr.bk0 = q_[384]; fr.bk1 = q_[448]; fr.bk2 = q_[512]; fr.bk3 = q_[576]; \
        fr.v = *((const LAS u32x2*)(sl_ + 10240) + n * 64 + F.lane); \
        const LAS f32x4* gp_ = (const LAS f32x4*)(sl_ + 12288) + g; fr.g0 = gp_[0]; fr.g1 = gp_[4]; fr.g2 = gp_[8]; fr.g3 = gp_[12]; } while (0)
    f32x4 st0 = {0.f, 0.f, 0.f, 0.f}, st1 = st0, st2 = st0, st3 = st0;
    const f32x4 z4 = {0.f, 0.f, 0.f, 0.f};
#define RW_STEP(fr, c) do { \
        const bf16x8 s0_ = pack8(st0, st1), s1_ = pack8(st2, st3); \
        f32x4 x1_ = __builtin_amdgcn_mfma_f32_16x16x32_bf16(fr.a0, s0_, z4, 0, 0, 0); x1_ = __builtin_amdgcn_mfma_f32_16x16x32_bf16(fr.a1, s1_, x1_, 0, 0, 0); \
        f32x4 x2_ = __builtin_amdgcn_mfma_f32_16x16x32_bf16(fr.r0, s0_, z4, 0, 0, 0); x2_ = __builtin_amdgcn_mfma_f32_16x16x32_bf16(fr.r1, s1_, x2_, 0, 0, 0); \
        union { bf16x8 v; unsigned u[4]; } bx_; bx_.u[0] = pk_bf16(x1_[0], x1_[1]); bx_.u[1] = pk_bf16(x1_[2], x1_[3]); bx_.u[2] = fr.v.x; bx_.u[3] = fr.v.y; \
        const f32x4 e_ = __builtin_amdgcn_mfma_f32_16x16x32_bf16(fr.tm, bx_.v, z4, 0, 0, 0); \
        union { bf16x8 v; unsigned u[4]; } be_; be_.u[0] = pk_bf16(e_[0], e_[1]); be_.u[1] = pk_bf16(e_[2], e_[3]); be_.u[2] = fr.v.x; be_.u[3] = fr.v.y; \
        const f32x4 o_ = __builtin_amdgcn_mfma_f32_16x16x32_bf16(fr.bb, be_.v, x2_, 0, 0, 0); \
        st0 = __builtin_amdgcn_mfma_f32_16x16x32_bf16(fr.bk0, be_.v, st0, 0, 0, 0) * fr.g0; st1 = __builtin_amdgcn_mfma_f32_16x16x32_bf16(fr.bk1, be_.v, st1, 0, 0, 0) * fr.g1; \
        st2 = __builtin_amdgcn_mfma_f32_16x16x32_bf16(fr.bk2, be_.v, st2, 0, 0, 0) * fr.g2; st3 = __builtin_amdgcn_mfma_f32_16x16x32_bf16(fr.bk3, be_.v, st3, 0, 0, 0) * fr.g3; \
        const unsigned p01_ = pk_bf16(o_[0], o_[1]), p23_ = pk_bf16(o_[2], o_[3]); LAS unsigned char* ow_ = otw + ((c) & 1) * (16 * RW_OP); \
        *(LAS bf16_t*)ow_ = (bf16_t)(p01_ & 0xffffu); *(LAS bf16_t*)(ow_ + RW_OP) = (bf16_t)(p01_ >> 16); *(LAS bf16_t*)(ow_ + 2 * RW_OP) = (bf16_t)(p23_ & 0xffffu); *(LAS bf16_t*)(ow_ + 3 * RW_OP) = (bf16_t)(p23_ >> 16); } while (0)
    RwFrag fa, fb;
    __builtin_amdgcn_s_barrier(); asm volatile("" ::: "memory");
    RW_LDSF(fa, 0);
#pragma unroll 1
    for (int c = 0; c < RW_NCHUNK; c += 2) {
        asm volatile("s_waitcnt lgkmcnt(0)" ::: "memory"); __builtin_amdgcn_s_barrier(); asm volatile("" ::: "memory");
        RW_LDSF(fb, c + 1); RW_STEP(fa, c);
        asm volatile("s_waitcnt lgkmcnt(0)" ::: "memory"); __builtin_amdgcn_s_barrier(); asm volatile("" ::: "memory");
        RW_LDSF(fa, c + 2); RW_STEP(fb, c + 1);
    }
    asm volatile("s_waitcnt lgkmcnt(0)" ::: "memory"); __builtin_amdgcn_s_barrier();
#undef RW_LDSF
#undef RW_STEP
}

__device__ __forceinline__ void na_tile(const Ctx& F, unsigned char* ws, const LAS float* sBias, int tile) {
    const bf16_t* QN = (const bf16_t*)(ws + WS_QN); const bf16_t* KN = (const bf16_t*)(ws + WS_KN);
    const bf16_t* VTL = (const bf16_t*)(ws + WS_VTL); const bf16_t* VTC = (const bf16_t*)(ws + WS_VTC); bf16_t* MIX = (bf16_t*)(ws + WS_MIX);
    const int h = F.wave, l16 = F.lane & 15, g = F.lane >> 4;
    const bool lat = tile < 1024;
    int b, r = 0, j = 0, gq;
    if (lat) { b = tile >> 8; r = (tile >> 2) & 63; j = tile & 3; gq = b * SEQL + r * 64 + j * 16 + l16; }
    else { const int tc = tile - 1024; b = tc >> 4; gq = NLAT + b * CTXL + (tc & 15) * 16 + l16; }
    const int row0 = min(max(r - 4, 0), 56), col0 = min(max(16 * j - 8, 0), 32);
    bf16x8 qf0, qf1;
    { const bf16_t* qp = QN + (size_t)gq * 512 + h * 64 + g * 8; qf0 = *(const bf16x8*)qp; qf1 = *(const bf16x8*)(qp + 32); }
    const f32x4 zero4 = {0.f, 0.f, 0.f, 0.f};
    const int cq = 16 * j + l16, win0 = min(max(cq - 8, 0), 48);
    const bf16_t* knb = KN + ((size_t)((((b * 8 + h) * 64 + row0) * 2) * 4 + g) * 64 + col0 + l16) * 8;
    const bf16_t* kcx = KN + (size_t)NLAT * 512 + ((size_t)(((b * 8 + h) * 2) * 4 + g) * 256 + l16) * 8;
    const bf16_t* vnb = VTL + ((size_t)(((b * 8 + h) * 64 + row0) * 12 + col0 / 4 + g) * 64 + l16) * 8;
    const bf16_t* vcx = VTC + ((size_t)(((b * 8 + h) * 8) * 4 + g) * 64 + l16) * 8;
    float mrun = -1e30f, lrun = 0.f;
    f32x4 o[4] = {zero4, zero4, zero4, zero4};
#pragma unroll
    for (int hf = 0; hf < 2; ++hf) {
        if (hf == 0 && !lat) continue;
        bf16x8 fr[32];
#pragma unroll
        for (int T = 0; T < 16; ++T) { const bf16_t* kp = hf == 0 ? knb + (size_t)((T >> 1) * 8) * 512 + (T & 1) * 128 : kcx + T * 128;
            fr[2 * T] = *(const bf16x8*)kp; fr[2 * T + 1] = *(const bf16x8*)(kp + (hf == 0 ? 4 * 512 : 4 * 2048)); }
        asm volatile("" ::: "memory");
        f32x4 acc[16];
#pragma unroll
        for (int T = 0; T < 16; ++T) { f32x4 a = __builtin_amdgcn_mfma_f32_16x16x32_bf16(fr[2 * T], qf0, zero4, 0, 0, 0); a = __builtin_amdgcn_mfma_f32_16x16x32_bf16(fr[2 * T + 1], qf1, a, 0, 0, 0);
            if (hf == 0) { const int ir = T >> 1, hh = T & 1, kr = row0 + ir; const LAS float* bias = sBias + (kr - r + 7) * 31;
#pragma unroll
                for (int e = 0; e < 4; ++e) { const int kc = col0 + 16 * hh + 4 * g + e; const bool ok = (kc >= win0) && (kc < win0 + 16);
                    const int dc = min(max(kc - cq + 15, 0), 30); a[e] = ok ? a[e] + bias[dc] : -1e30f; } }
            acc[T] = a; }
#pragma unroll
        for (int m = 0; m < 8; ++m)
#pragma unroll
            for (int dt = 0; dt < 4; ++dt) fr[4 * m + dt] = *(const bf16x8*)(hf == 0 ? vnb + (size_t)m * 12 * 512 + dt * 128 : vcx + (size_t)m * 4 * 512 + dt * 128);
        asm volatile("" ::: "memory");
        float mx = mrun;
#pragma unroll
        for (int T = 0; T < 16; ++T) mx = fmaxf(fmaxf(fmaxf(acc[T][0], acc[T][1]), fmaxf(acc[T][2], acc[T][3])), mx);
        mx = fmaxf(mx, xor16_f(mx)); mx = max_x32(mx);
        const float alpha = __expf(mrun - mx);
        float lsum = 0.f;
#pragma unroll
        for (int T = 0; T < 16; ++T) {
#pragma unroll
            for (int q = 0; q < 4; ++q) { const float pv = __expf(acc[T][q] - mx); acc[T][q] = pv; lsum += pv; } }
        lsum += xor16_f(lsum); lsum = sum_x32(lsum);
        lrun = lrun * alpha + lsum; mrun = mx;
#pragma unroll
        for (int dt = 0; dt < 4; ++dt) o[dt] = o[dt] * alpha;
#pragma unroll
        for (int m = 0; m < 8; ++m) { const bf16x8 pf = pack8(acc[2 * m], acc[2 * m + 1]);
#pragma unroll
            for (int dt = 0; dt < 4; ++dt) o[dt] = __builtin_amdgcn_mfma_f32_16x16x32_bf16(fr[4 * m + dt], pf, o[dt], 0, 0, 0); }
    }
    const float inv = 1.0f / lrun;
#pragma unroll
    for (int dt = 0; dt < 4; ++dt) { u32x2 w; w.x = pk_bf16(o[dt][0] * inv, o[dt][1] * inv); w.y = pk_bf16(o[dt][2] * inv, o[dt][3] * inv);
        *(u32x2*)(MIX + (size_t)gq * 2048 + 1024 + h * 64 + dt * 16 + 4 * g) = w; }
}
__device__ __forceinline__ void na_phase(const Ctx& F, const LayerW& W, unsigned char* ws, int blk, int nblk, int ntile) {
    LAS float* sBias = (LAS float*)(F.lds + F.wave * 2048);
    __syncthreads();
    for (int idx = F.lane; idx < 465; idx += 64) sBias[idx] = W.rpb[F.wave * 465 + idx];
    asm volatile("" ::: "memory");
    for (int tile = blk; tile < ntile; tile += nblk) na_tile(F, ws, sBias, tile);
}

__device__ __forceinline__ void phase_finish(const Ctx& F, const LayerW& W, unsigned char* ws, const bf16_t* GUPT, int ntok) {
    const bf16_t* P = (const bf16_t*)(ws + WS_P); bf16_t* MIX = (bf16_t*)(ws + WS_MIX);
    const bf16_t* RWY = (const bf16_t*)(ws + WS_RWY); const float* BON = (const float*)(ws + WS_BON); const float* YS = (const float*)(ws + WS_YS);
    const f32x4 z4 = {0.f, 0.f, 0.f, 0.f};
    for (int task = F.bid * 8 + F.wave; task < (ntok / 16) * 8; task += F.G * 8) {
        int ln = F.lane; asm volatile("" : "+v"(ln));
        const int l16 = ln & 15, g = ln >> 4, h = task & 7, tok = (task >> 3) * 16 + l16;
        const bf16_t* Pr = P + (size_t)tok * PTP;
        bf16x8 sg[4];
#pragma unroll
        for (int ks = 0; ks < 4; ++ks) { const u32x4 q = *(const u32x4*)(Pr + B_GD + 32 * ks + 8 * g); union { bf16x8 v; unsigned u[4]; } s;
#pragma unroll
            for (int e = 0; e < 4; ++e) s.u[e] = pk_bf16(sigmoidf_(bflo(q[e])), sigmoidf_(bfhi(q[e])));
            sg[ks] = s.v; }
        f32x4 y[4]; float s1 = 0.f;
#pragma unroll
        for (int m = 0; m < 4; ++m) { const int co = h * 64 + 16 * m + 4 * g;
            const u32x2 a = *(const u32x2*)(RWY + (size_t)tok * 512 + co), bq = *(const u32x2*)(RWY + ((size_t)NTOK + tok) * 512 + co);
            y[m] = (f32x4){bflo(a.x) + bflo(bq.x), bfhi(a.x) + bfhi(bq.x), bflo(a.y) + bflo(bq.y), bfhi(a.y) + bfhi(bq.y)};
            s1 += (y[m][0] + y[m][1]) + (y[m][2] + y[m][3]); }
        s1 += xor16_f(s1); s1 = sum_x32(s1);
        const float mu = s1 * (1.f / 64.f); float s2 = 0.f;
#pragma unroll
        for (int m = 0; m < 4; ++m) { y[m] = y[m] - mu; s2 += (y[m][0] * y[m][0] + y[m][1] * y[m][1]) + (y[m][2] * y[m][2] + y[m][3] * y[m][3]); }
        s2 += xor16_f(s2); s2 = sum_x32(s2);
        const float rs = rsqrtf(s2 * (1.f / 64.f) + 64e-5f);
        const float bon = BON[(size_t)tok * 8 + h] + BON[((size_t)NTOK + tok) * 8 + h];
#pragma unroll
        for (int m = 0; m < 4; ++m) { const int co = h * 64 + 16 * m + 4 * g;
            f32x4 ga = z4;
#pragma unroll
            for (int ks = 0; ks < 4; ++ks) ga = __builtin_amdgcn_mfma_f32_16x16x32_bf16(*(const bf16x8*)(GUPT + (size_t)(h * 64 + 16 * m + l16) * 128 + 32 * ks + 8 * g), sg[ks], ga, 0, 0, 0);
            const float4 lw = *(const float4*)(W.rw_lnw + co), lb = *(const float4*)(W.rw_lnb + co); const u32x2 vq = *(const u32x2*)(Pr + B_V + co);
            const float o0 = (y[m][0] * rs * lw.x + lb.x + bon * bflo(vq.x)) * ga[0], o1 = (y[m][1] * rs * lw.y + lb.y + bon * bfhi(vq.x)) * ga[1];
            const float o2 = (y[m][2] * rs * lw.z + lb.z + bon * bflo(vq.y)) * ga[2], o3 = (y[m][3] * rs * lw.w + lb.w + bon * bfhi(vq.y)) * ga[3];
            u32x2 o; o.x = pk_bf16(o0, o1); o.y = pk_bf16(o2, o3);
            *(u32x2*)(MIX + (size_t)tok * 2048 + 512 + co) = o; }
    }
    for (int tok = F.bid * 8 + F.wave; tok < ntok; tok += F.G * 8) {
        const int c0 = F.lane * 8;
        float ys[8], z[8], gw[8];
        load8f(YS + (size_t)tok * 512 + c0, ys); unpack8(*(const u32x4*)(P + (size_t)tok * PTP + D_Z + c0), z); load8f(W.s_norm + c0, gw);
        float ss = 0.f;
#pragma unroll
        for (int e = 0; e < 8; ++e) { ys[e] *= siluf_(z[e]); ss += ys[e] * ys[e]; }
        ss = wave_sum(ss);
        const float rs = rsqrtf(ss * (1.f / 512.f) + 1e-6f);
#pragma unroll
        for (int e = 0; e < 8; ++e) ys[e] = ys[e] * rs * gw[e];
        *(u32x4*)(MIX + (size_t)tok * 2048 + 1536 + c0) = pack8f(ys);
    }
}

constexpr int RADIX_LOW_BIT = 10;
constexpr int RADIX_STEPS = 14;
__device__ __forceinline__ unsigned ordkey(float x) { const unsigned u = __float_as_uint(x); return (u & 0x80000000u) ? ~u : (u | 0x80000000u); }
template <int CTRL> __device__ __forceinline__ int dpp_i0(int v) { return __builtin_amdgcn_update_dpp(0, v, CTRL, 0xF, 0xF, true); }
__device__ __forceinline__ int rowscan_incl(int x) { x += dpp_i0<0x111>(x); x += dpp_i0<0x112>(x); x += dpp_i0<0x114>(x); x += dpp_i0<0x118>(x); return x; }
__device__ __forceinline__ void phase_scores(const Ctx& F, unsigned char* ws, int layer, int ntok) {
    const bf16_t* Q = (const bf16_t*)(ws + WS_P); const bf16_t* KEYS = (const bf16_t*)(ws + WS_KEYS) + (size_t)layer * 8 * 2 * 128 * 128;
    int* IDS = (int*)(ws + WS_IDS); float* GATES = (float*)(ws + WS_GATES);
    LAS bf16_t* sK = (LAS bf16_t*)F.lds;
    LAS float* sVv = (LAS float*)(F.lds + 2 * 128 * 136 * 2 + F.wave * 5120);
    LAS int* sVi = (LAS int*)(sVv + 512);
    const int ntg = ntok / 128, ntask = 8 * ntg;
    const int l16 = F.lane & 15, g = F.lane >> 4;
    const f32x4 z4 = {0.f, 0.f, 0.f, 0.f};
    int cur_h = -1;
    for (int task = F.bid; task < ntask; task += F.G) {
        const int h = task / ntg, tg = task % ntg;
        if (h != cur_h) { __syncthreads();
#pragma unroll
            for (int q = 0; q < 8; ++q) { const int v = F.tid + 512 * q, row = v >> 4, part = v & 15;
                *(LAS u32x4*)(sK + row * 136 + part * 8) = *(const u32x4*)(KEYS + ((size_t)h * 256 + row) * 128 + part * 8); }
            cur_h = h; __syncthreads(); }
        const int t0 = tg * 128 + F.wave * 16;
#pragma unroll 1
        for (int p = 0; p < 2; ++p) {
            bf16x8 qf[4];
#pragma unroll
            for (int ks = 0; ks < 4; ++ks) qf[ks] = *(const bf16x8*)(Q + (size_t)(t0 + l16) * 2048 + h * 256 + p * 128 + 32 * ks + 8 * g);
            f32x4 acc[8];
#pragma unroll
            for (int kt = 0; kt < 8; ++kt) { f32x4 a = z4;
#pragma unroll
                for (int ks = 0; ks < 4; ++ks) a = __builtin_amdgcn_mfma_f32_16x16x32_bf16(qf[ks], *(const LAS bf16x8*)(sK + (p * 128 + 16 * kt + l16) * 136 + 32 * ks + 8 * g), a, 0, 0, 0);
                acc[kt] = a; }
            float lo0, lo1, lo2, lo3, hi0, hi1, hi2, hi3;
            { float m0 = acc[0][0], m1 = acc[0][1], m2 = acc[0][2], m3 = acc[0][3];
#pragma unroll
              for (int kt = 1; kt < 8; ++kt) { m0 = fmaxf(m0, acc[kt][0]); m1 = fmaxf(m1, acc[kt][1]); m2 = fmaxf(m2, acc[kt][2]); m3 = fmaxf(m3, acc[kt][3]); }
              hi0 = max16(m0); hi1 = max16(m1); hi2 = max16(m2); hi3 = max16(m3);
              lo0 = -max16(-m0); lo1 = -max16(-m1); lo2 = -max16(-m2); lo3 = -max16(-m3); }
#pragma unroll 1
            for (int it = 0; it < RADIX_STEPS; ++it) {
                const float c0 = 0.5f * (lo0 + hi0), c1 = 0.5f * (lo1 + hi1), c2 = 0.5f * (lo2 + hi2), c3 = 0.5f * (lo3 + hi3); int n0 = 0, n1 = 0, n2 = 0, n3 = 0;
#pragma unroll
                for (int kt = 0; kt < 8; ++kt) { n0 += acc[kt][0] >= c0; n1 += acc[kt][1] >= c1; n2 += acc[kt][2] >= c2; n3 += acc[kt][3] >= c3; }
                const bool k0 = sum16((float)n0) >= 16.f, k1 = sum16((float)n1) >= 16.f, k2 = sum16((float)n2) >= 16.f, k3 = sum16((float)n3) >= 16.f;
                lo0 = k0 ? c0 : lo0; hi0 = k0 ? hi0 : c0; lo1 = k1 ? c1 : lo1; hi1 = k1 ? hi1 : c1; lo2 = k2 ? c2 : lo2; hi2 = k2 ? hi2 : c2; lo3 = k3 ? c3 : lo3; hi3 = k3 ? hi3 : c3; }
#pragma unroll
            for (int r = 0; r < 4; ++r) { const float T = r == 0 ? lo0 : (r == 1 ? lo1 : (r == 2 ? lo2 : lo3));
                int cl = 0;
#pragma unroll
                for (int kt = 0; kt < 8; ++kt) cl += acc[kt][r] >= T;
                int rank = rowscan_incl(cl) - cl;
                LAS float* dv = sVv + ((4 * g + r) * 2 + p) * 16; LAS int* di = sVi + ((4 * g + r) * 2 + p) * 16;
#pragma unroll
                for (int kt = 0; kt < 8; ++kt) { const bool sel = acc[kt][r] >= T;
                    if (sel && rank < 16) { dv[rank] = acc[kt][r]; di[rank] = 16 * kt + l16; }
                    rank += sel ? 1 : 0; } }
        }
        asm volatile("" ::: "memory");
#pragma unroll 1
        for (int r = 0; r < 4; ++r) { const int tk = 4 * g + r;
            LAS float* sS = (LAS float*)(sVi + 512);
            LAS int* sI = (LAS int*)(sS + 128);
#pragma unroll
            for (int p = 0; p < 2; ++p) { const float v = sVv[(tk * 2 + p) * 16 + l16]; const int ix = sVi[(tk * 2 + p) * 16 + l16];
                const unsigned key = (ordkey(v) & ~15u) | (unsigned)(15 - l16); int rk = 0;
#pragma unroll
                for (int q = 0; q < 4; ++q) { const f32x4 o = *(const LAS f32x4*)(sVv + (tk * 2 + p) * 16 + 4 * q);
#pragma unroll
                    for (int e = 0; e < 4; ++e) rk += ((ordkey(o[e]) & ~15u) | (unsigned)(15 - (4 * q + e))) > key; }
                sS[(g * 2 + p) * 16 + rk] = v; sI[(g * 2 + p) * 16 + rk] = ix; }
            asm volatile("" ::: "memory");
            float cv[4]; int pi[4], pj[4];
#pragma unroll
            for (int q = 0; q < 4; ++q) { const int e = l16 + 16 * q; int i, j;
                if (e < 16) { i = 0; j = e; } else if (e < 24) { i = 1; j = e - 16; } else if (e < 29) { i = 2; j = e - 24; } else if (e < 33) { i = 3; j = e - 29; }
                else if (e < 36) { i = 4; j = e - 33; } else if (e < 42) { i = 5 + ((e - 36) >> 1); j = (e - 36) & 1; } else { i = 8 + (e - 42); j = 0; }
                const bool ok = e < 50; i = ok ? i : 15; j = ok ? j : 15;
                pi[q] = i; pj[q] = j; cv[q] = ok ? sS[(g * 2) * 16 + i] + sS[(g * 2 + 1) * 16 + j] : -3.0e38f; }
            float lo = sS[(g * 2) * 16 + 15] + sS[(g * 2 + 1) * 16], hi = sS[(g * 2) * 16] + sS[(g * 2 + 1) * 16];
            const float mx = hi;
#pragma unroll 1
            for (int it = 0; it < RADIX_STEPS; ++it) { const float cm = 0.5f * (lo + hi); int n = 0;
#pragma unroll
                for (int q = 0; q < 4; ++q) n += cv[q] >= cm;
                const bool kk = sum16((float)n) >= 16.f; lo = kk ? cm : lo; hi = kk ? hi : cm; }
            int cl = 0; float es = 0.f;
#pragma unroll
            for (int q = 0; q < 4; ++q) { const bool sel = cv[q] >= lo; cl += sel; es += sel ? __expf(cv[q] - mx) : 0.f; }
            int rank = rowscan_incl(cl) - cl;
            const float einv = 1.0f / sum16(es);
            const size_t ob = (size_t)(t0 + tk) * 128 + h * 16;
#pragma unroll
            for (int q = 0; q < 4; ++q) { const bool sel = cv[q] >= lo;
                if (sel && rank < 16) { IDS[ob + rank] = sI[(g * 2) * 16 + pi[q]] * 128 + sI[(g * 2 + 1) * 16 + pj[q]]; GATES[ob + rank] = __expf(cv[q] - mx) * einv; }
                rank += sel ? 1 : 0; }
            asm volatile("" ::: "memory");
        }
        asm volatile("" ::: "memory");
    }
}

struct XInfo { int xi, nx, rank, nloc; };
__device__ __forceinline__ void fp8x16_to_f32(const u32x4 q, float (&f)[16]) {
#pragma unroll
    for (int w = 0; w < 4; ++w) { const auto a = __builtin_amdgcn_cvt_pk_f32_fp8((int)q[w], false); const auto b = __builtin_amdgcn_cvt_pk_f32_fp8((int)q[w], true);
        f[4 * w] = a[0]; f[4 * w + 1] = a[1]; f[4 * w + 2] = b[0]; f[4 * w + 3] = b[1]; }
}
typedef long i64_t;
template <int IDMASK> __device__ __forceinline__ void phase_experts_u(const Ctx& F, unsigned char* ws, int layer, int ntok, const XInfo X, float* PART) {
    const bf16_t* H = (const bf16_t*)(ws + WS_XN); const unsigned char* PU8 = ws + WS_PU + (size_t)layer * 16384 * 2048;
    const int* IDS = (const int*)(ws + WS_IDS);
    const int e8 = F.lane >> 3, c = F.lane & 7, l16 = F.lane & 15, g = F.lane >> 4;
    const int tfirst = X.rank * 8 + F.wave, tstride = X.nloc * 8;
    const int nk = tfirst < ntok ? (ntok - tfirst + tstride - 1) / tstride : 0;
    const f32x4 z4 = {0.f, 0.f, 0.f, 0.f};
    LAS unsigned char* buf = F.lds + F.wave * 12288; LAS float* res = (LAS float*)(buf + 8192);
    const int woff = e8 * 128 + c * 16;
    const int srcoff = 16 * (c ^ e8);
    const int roff0 = l16 * 128 + (((2 * g) ^ (l16 & 7)) * 16), roff1 = l16 * 128 + (((2 * g + 1) ^ (l16 & 7)) * 16);
#define EU_TOK(k) (tfirst + min((k), nk - 1) * tstride)
#define EU_LOADI(I, k) do { const int* ip_ = IDS + (size_t)EU_TOK(k) * 128 + e8; _Pragma("unroll") for (int q_ = 0; q_ < 16; ++q_) I[q_] = ip_[8 * q_]; } while (0)
#define EU_LOADX(HX, k) do { const u32x4* hp_ = (const u32x4*)(H + (size_t)EU_TOK(k) * 2048 + s * 128 + 32 * g); HX[0] = hp_[0]; HX[1] = hp_[1]; HX[2] = hp_[2]; HX[3] = hp_[3]; } while (0)
#define EU_ISSUE(Q, I, hf) do { const unsigned char* sb_ = PU8 + (size_t)s * 16384 * 128; _Pragma("unroll") for (int i_ = 0; i_ < 8; ++i_) Q[i_] = *(const u32x4*)(sb_ + (unsigned)(I[(hf) * 8 + i_] * 128 + srcoff)); } while (0)
#define EU_CONSUME(Q, hf, slot) do { _Pragma("unroll") for (int i_ = 0; i_ < 8; ++i_) *(LAS u32x4*)(buf + i_ * 1024 + woff) = Q[i_]; \
        asm volatile("" ::: "memory"); \
        u32x4 p0_[4], p1_[4]; f32x4 a_[4]; \
        _Pragma("unroll") for (int q_ = 0; q_ < 4; ++q_) { p0_[q_] = *(const LAS u32x4*)(buf + q_ * 2048 + roff0); p1_[q_] = *(const LAS u32x4*)(buf + q_ * 2048 + roff1); a_[q_] = z4; } \
          \
        _Pragma("unroll") for (int q_ = 0; q_ < 4; ++q_) a_[q_] = __builtin_amdgcn_mfma_f32_16x16x32_fp8_fp8(((i64_t)p0_[q_][1] << 32) | (i64_t)p0_[q_][0], hb[0], a_[q_], 0, 0, 0); \
        _Pragma("unroll") for (int q_ = 0; q_ < 4; ++q_) a_[q_] = __builtin_amdgcn_mfma_f32_16x16x32_fp8_fp8(((i64_t)p0_[q_][3] << 32) | (i64_t)p0_[q_][2], hb[1], a_[q_], 0, 0, 0); \
        _Pragma("unroll") for (int q_ = 0; q_ < 4; ++q_) a_[q_] = __builtin_amdgcn_mfma_f32_16x16x32_fp8_fp8(((i64_t)p1_[q_][1] << 32) | (i64_t)p1_[q_][0], hb[2], a_[q_], 0, 0, 0); \
        _Pragma("unroll") for (int q_ = 0; q_ < 4; ++q_) a_[q_] = __builtin_amdgcn_mfma_f32_16x16x32_fp8_fp8(((i64_t)p1_[q_][3] << 32) | (i64_t)p1_[q_][2], hb[3], a_[q_], 0, 0, 0); \
        _Pragma("unroll") for (int q_ = 0; q_ < 4; ++q_) if (l16 == (hf) * 4 + q_) *(LAS f32x4*)(res + (slot) * 128 + 16 * ((hf) * 4 + q_) + 4 * g) = a_[q_]; \
        asm volatile("" ::: "memory"); } while (0)
    for (int s = X.xi; s < 16; s += X.nx) {
        if (nk == 0) continue;
        int id[2][16]; u32x4 hx[2][4]; u32x4 qa[8], qb[8];
        EU_LOADI(id[0], 0); EU_LOADX(hx[0], 0); EU_ISSUE(qa, id[0], 0); EU_ISSUE(qb, id[0], 1);
        EU_LOADI(id[1], 1);
        for (int k0 = 0; k0 < nk; k0 += 8) {
#pragma unroll
            for (int j = 0; j < 8; ++j) { const int k = k0 + j;
                i64_t hb[4];
#pragma unroll
                for (int m = 0; m < 4; ++m) { const u32x4 v = hx[j & 1][m];
                    int lo = __builtin_amdgcn_cvt_pk_fp8_f32(bflo(v[0]), bfhi(v[0]), 0, false); lo = __builtin_amdgcn_cvt_pk_fp8_f32(bflo(v[1]), bfhi(v[1]), lo, true);
                    int hi = __builtin_amdgcn_cvt_pk_fp8_f32(bflo(v[2]), bfhi(v[2]), 0, false); hi = __builtin_amdgcn_cvt_pk_fp8_f32(bflo(v[3]), bfhi(v[3]), hi, true);
                    hb[m] = ((i64_t)(unsigned)hi << 32) | (i64_t)(unsigned)lo; }
                EU_LOADX(hx[(j + 1) & 1], k + 1);
                EU_LOADI(id[j & 1], k + 2);
                EU_CONSUME(qa, 0, j);
                EU_ISSUE(qa, id[(j + 1) & 1], 0);
                EU_CONSUME(qb, 1, j);
                EU_ISSUE(qb, id[(j + 1) & 1], 1);
            }
            { const int u = F.lane >> 3, jj = F.lane & 7, ku = k0 + u;
              if (ku < nk) { float* dst = PART + ((size_t)s * NTOK + tfirst + ku * tstride) * 128 + 16 * jj;
#pragma unroll
                  for (int w = 0; w < 4; ++w) *(f32x4*)(dst + 4 * w) = *(const LAS f32x4*)(res + u * 128 + 16 * jj + 4 * w); }
              asm volatile("" ::: "memory"); }
        }
    }
#undef EU_TOK
#undef EU_LOADI
#undef EU_LOADX
#undef EU_ISSUE
#undef EU_CONSUME
}
__device__ __forceinline__ void phase_experts_combine(const Ctx& F, unsigned char* ws, int ntok) {
    const float* PART = (const float*)(ws + WS_PART); float* GATES = (float*)(ws + WS_GATES);
    for (int idx = F.bid * 512 + F.tid; idx < ntok * 32; idx += F.G * 512) {
        float4 a = make_float4(0.f, 0.f, 0.f, 0.f);
#pragma unroll
        for (int s = 0; s < 16; ++s) { const float4 v = *(const float4*)(PART + (size_t)s * NTOK * 128 + (size_t)idx * 4); a.x += v.x; a.y += v.y; a.z += v.z; a.w += v.w; }
        float4 g = *(const float4*)(GATES + (size_t)idx * 4);
        g.x *= geluf_(a.x * (1.0f / PEER_U_SCALE)); g.y *= geluf_(a.y * (1.0f / PEER_U_SCALE)); g.z *= geluf_(a.z * (1.0f / PEER_U_SCALE)); g.w *= geluf_(a.w * (1.0f / PEER_U_SCALE));
        *(float4*)(GATES + (size_t)idx * 4) = g;
    }
}
__device__ __forceinline__ void phase_experts_v(const Ctx& F, unsigned char* ws, float* out, float* CTXS, int layer, int ntok, const XInfo X) {
    const unsigned char* PV8 = ws + WS_PV + (size_t)layer * 16384 * 2048;
    const int* IDS = (const int*)(ws + WS_IDS); const float* COEF = (const float*)(ws + WS_GATES); const float* MOD = (const float*)(ws + WS_MOD);
    const int e8 = F.lane >> 3, c = F.lane & 7;
    const int tfirst = X.rank * 8 + F.wave, tstride = X.nloc * 8;
    const int nk = tfirst < ntok ? (ntok - tfirst + tstride - 1) / tstride : 0;
    LAS float* res = (LAS float*)(F.lds + F.wave * 4096);
#define EV_TOK(k) (tfirst + min((k), nk - 1) * tstride)
#define EV_LOADI(I, k) do { I[0] = *((const u32x4*)(IDS + (size_t)EV_TOK(k) * 128 + e8 * 16) + (c & 3)); } while (0)
#define EV_LOADC(C, k) do { C[0] = *((const u32x4*)(COEF + (size_t)EV_TOK(k) * 128 + e8 * 16) + (c & 3)); } while (0)
#define EV_QUAD(V) do { const u32x4 own_ = V[0];   \
        _Pragma("unroll") for (int w_ = 0; w_ < 4; ++w_) { V[0][w_] = (unsigned)__builtin_amdgcn_update_dpp(0, (int)own_[w_], 0x00, 0xF, 0xF, true); V[1][w_] = (unsigned)__builtin_amdgcn_update_dpp(0, (int)own_[w_], 0x55, 0xF, 0xF, true); \
            V[2][w_] = (unsigned)__builtin_amdgcn_update_dpp(0, (int)own_[w_], 0xAA, 0xF, 0xF, true); V[3][w_] = (unsigned)__builtin_amdgcn_update_dpp(0, (int)own_[w_], 0xFF, 0xF, 0xF, true); } } while (0)
#define EV_ROW(id) (*(const u32x4*)(PV8 + (size_t)s * 16384 * 128 + (unsigned)((id) * 128 + c * 16)))
#define EV_ISSUE(Q, I, hf) do { _Pragma("unroll") for (int i_ = 0; i_ < 8; ++i_) Q[i_] = EV_ROW(I[(hf) * 2 + (i_ >> 2)][i_ & 3]); } while (0)
#define EV_HALF(Q, C, hf) do { _Pragma("unroll") for (int i_ = 0; i_ < 8; ++i_) { const float cf_ = __uint_as_float(C[(hf) * 2 + (i_ >> 2)][i_ & 3]); const f32x2_t c2_ = {cf_, cf_}; \
            _Pragma("unroll") for (int w_ = 0; w_ < 4; ++w_) { const f32x2_t lo_ = __builtin_amdgcn_cvt_pk_f32_fp8((int)Q[i_][w_], false), hi_ = __builtin_amdgcn_cvt_pk_f32_fp8((int)Q[i_][w_], true); \
                ac2[2 * w_] = lo_ * c2_ + ac2[2 * w_]; ac2[2 * w_ + 1] = hi_ * c2_ + ac2[2 * w_ + 1]; } } } while (0)
    for (int s = X.xi; s < 16; s += X.nx) {
        if (nk == 0) continue;
        u32x4 id[2][4], cf[2][4]; u32x4 qa[8], qb[8];
        EV_LOADI(id[0], 0); EV_LOADC(cf[0], 0); EV_QUAD(id[0]); EV_ISSUE(qa, id[0], 0); EV_ISSUE(qb, id[0], 1);
        EV_LOADI(id[1], 1);
        for (int k0 = 0; k0 < nk; k0 += 8) {
#pragma unroll
            for (int j = 0; j < 8; ++j) { const int k = k0 + j;
                f32x2_t ac2[8];
#pragma unroll
                for (int e = 0; e < 8; ++e) ac2[e] = (f32x2_t){0.f, 0.f};
                EV_QUAD(cf[j & 1]);
                EV_QUAD(id[(j + 1) & 1]);
                EV_LOADC(cf[(j + 1) & 1], k + 1);
                EV_HALF(qa, cf[j & 1], 0);
                EV_ISSUE(qa, id[(j + 1) & 1], 0);
                EV_HALF(qb, cf[j & 1], 1);
                EV_ISSUE(qb, id[(j + 1) & 1], 1);
                EV_LOADI(id[j & 1], k + 2);
                float acc[16];
#pragma unroll
                for (int e = 0; e < 8; ++e) { acc[2 * e] = ac2[e][0]; acc[2 * e + 1] = ac2[e][1]; }
#pragma unroll
                for (int e = 0; e < 16; ++e) { float v = acc[e]; v += dpp_f<0x128>(v); v += xor16_f(v); acc[e] = sum_x32(v); }
                if (e8 == 0) {
#pragma unroll
                    for (int w = 0; w < 4; ++w) *(LAS f32x4*)(res + j * 128 + c * 16 + 4 * w) = (f32x4){acc[4 * w], acc[4 * w + 1], acc[4 * w + 2], acc[4 * w + 3]}; }
                asm volatile("" ::: "memory");
            }
            { const int u = F.lane >> 3, jj = F.lane & 7, ku = k0 + u;
              if (ku < nk) { const int tu = tfirst + ku * tstride;
                  const bool isctx = tu >= NLAT; const int vv = isctx ? 4 : (tu >> 12);
                  float* xr = (isctx ? CTXS + (size_t)(tu - NLAT) * 2048 : out + (size_t)tu * 2048) + s * 128 + jj * 16;
                  const float* m5 = MOD + ((size_t)layer * 5 + vv) * 12288 + 5 * 2048 + s * 128 + jj * 16;
#pragma unroll
                  for (int w = 0; w < 4; ++w) { float4 x = *(const float4*)(xr + 4 * w); const float4 m = *(const float4*)(m5 + 4 * w); const f32x4 a = *(const LAS f32x4*)(res + u * 128 + jj * 16 + 4 * w);
                      x.x += m.x * a[0]; x.y += m.y * a[1]; x.z += m.z * a[2]; x.w += m.w * a[3]; *(float4*)(xr + 4 * w) = x; } }
              asm volatile("" ::: "memory"); }
        }
    }
#undef EV_TOK
#undef EV_LOADI
#undef EV_LOADC
#undef EV_QUAD
#undef EV_ROW
#undef EV_ISSUE
#undef EV_HALF
}

struct Params { const float* in[N_IN]; float* out; unsigned char* ws; };

__device__ __forceinline__ LayerW make_w(ka_t in, int l) {
    LayerW W;
    W.sc_w = in[I_SCW] + (size_t)l * 3 * 512; W.rw_w0 = in[I_RW0] + (size_t)l * 2 * 512; W.rw_wup = in[I_RWUP] + (size_t)l * 2 * 64 * 512;
    W.rw_a0 = in[I_RA0] + (size_t)l * 2 * 512; W.rw_aup = in[I_RAUP] + (size_t)l * 2 * 64 * 512; W.rw_gup = in[I_RGUP] + (size_t)l * 128 * 512;
    W.rw_kk = in[I_RKK] + (size_t)l * 512; W.rw_ka = in[I_RKA] + (size_t)l * 512; W.rw_rk = in[I_RRK] + (size_t)l * 512;
    W.rw_lnw = in[I_RLNW] + (size_t)l * 512; W.rw_lnb = in[I_RLNB] + (size_t)l * 512;
    W.na_q = in[I_NAQ] + (size_t)l * 64; W.na_k = in[I_NAK] + (size_t)l * 64; W.rpb = in[I_RPB] + (size_t)l * 8 * 15 * 31;
    W.s_cw = in[I_SCONVW] + (size_t)l * 3 * 1024; W.s_cb = in[I_SCONVB] + (size_t)l * 1024; W.s_dtb = in[I_SDTB] + (size_t)l * 16; W.s_alog = in[I_SALOG] + (size_t)l * 16;
    W.s_d = in[I_SD] + (size_t)l * 8; W.s_norm = in[I_SNORM] + (size_t)l * 512;
    return W;
}

__global__ void __launch_bounds__(512, 2) hybrid_fwd(Params p) {
    extern __shared__ __attribute__((aligned(16))) unsigned char shm[];
    Ctx F; F.lds = (LAS unsigned char*)shm; F.tid = threadIdx.x; F.lane = F.tid & 63; F.wave = __builtin_amdgcn_readfirstlane(F.tid >> 6); F.bid = blockIdx.x; F.G = gridDim.x;
    volatile LAS unsigned* bst = (volatile LAS unsigned*)(F.lds + LDS_BAR_OFF);
    if (F.tid < 4) bst[F.tid] = 0u;
    __syncthreads();
    (void)xcd_barrier_post((unsigned*)(p.ws + WS_CTL), bst);
    volatile LAS int* lxi = (volatile LAS int*)(F.lds + LDS_XI_OFF);
    if (F.tid == 0) lxi[2] = (int)xb_add((unsigned*)(p.ws + WS_CTL) + CTL_TICKET + 64 * xb_xcc_id(), 1u);
#define RPT_PHASE(id, ...) do { __VA_ARGS__ if (RPT == (id)) { GRID_BAR(); PH_BEGIN(); __VA_ARGS__ } } while (0)
#define GRID_BAR() do { ka_t kb_ = (ka_t)__builtin_amdgcn_kernarg_segment_ptr(); asm volatile("" : "+s"(kb_)); unsigned xx_ = xb_xcc_id(); asm volatile("" : "+s"(xx_)); \
        XcdBarrier b_; b_.bar = (unsigned*)((unsigned char*)kb_[N_IN + 1] + WS_CTL); b_.x = xx_; b_.st = (volatile LAS unsigned*)(F.lds + LDS_BAR_OFF); xcd_barrier(b_); } while (0)
    ka_t in; unsigned char* ws; float* out;
#define PH_BEGIN() do { int t_ = threadIdx.x; asm volatile("; PHASE_MARK" : "+v"(t_)); F.tid = t_; F.lane = t_ & 63; F.wave = __builtin_amdgcn_readfirstlane(t_ >> 6); \
        int b_ = blockIdx.x, g_ = gridDim.x; asm volatile("" : "+s"(b_), "+s"(g_)); F.bid = b_; F.G = g_; \
        ka_t k_ = (ka_t)__builtin_amdgcn_kernarg_segment_ptr(); asm volatile("" : "+s"(k_)); in = k_; \
        out = (float*)in[N_IN]; ws = (unsigned char*)in[N_IN + 1]; } while (0)

    PH_BEGIN();
    RPT_PHASE(1, phase_prologue(F, in, ws););
    GRID_BAR();
    if (F.tid == 0) {
        const unsigned* bw = (const unsigned*)(ws + WS_CTL); const unsigned myx = xb_xcc_id(); int xi = 0, nx = 0, nloc = 1;
        for (unsigned j = 0; j < 16; ++j) { const unsigned cnt = xb_ld((unsigned*)&bw[XB_XCNT(j)]); if (cnt > 0u) { if (j < myx) ++xi; ++nx; } if (j == myx) nloc = (int)cnt; }
        lxi[0] = xi; lxi[1] = nx > 0 ? nx : 1; lxi[3] = nloc > 0 ? nloc : 1; }
    __syncthreads();
    PH_BEGIN();
    phase_modreduce(F, in[I_BADA], (const float*)(ws + WS_MODP), (float*)(ws + WS_MOD));
    GRID_BAR();

#pragma unroll 1
    for (int l = 0; l < 2; ++l) {
        const int M = (l == 0) ? NTOK : NLAT;
        if (l == 0) { PH_BEGIN(); phase_norm(F, in[I_X], in[I_CTX], in[I_NMIX], (const float*)(ws + WS_MOD), 0, 1, (bf16_t*)(ws + WS_XN), NTOK); GRID_BAR(); }

        PH_BEGIN();
        RPT_PHASE(2, { pg8::Gemm g{(const bf16_t*)(ws + WS_XN), (const bf16_t*)(ws + WS_WIN) + (size_t)l * PTP * 2048, NTOK, PTP, 2048}; pg8::StaticOrder S; S.init(NTOK, PTP, F.G, F.bid);
          pg8::EpiBf16 E{(bf16_t*)(ws + WS_P), PTP}; pg8::gemm_phase<pg8::EpiBf16, pg8::StaticOrder>(F.lds, g, S, E, F.tid); });
        GRID_BAR();

        PH_BEGIN();
        { const LayerW W = make_w(in, l); phase_prep(F, W, ws);
            if (RPT == 31) phase_prep(F, W, ws);
            const bf16_t* WUPT = (const bf16_t*)(ws + WS_WUPT) + (size_t)l * 4 * 512 * 64;
            for (int rep = 0; rep < (RPT == 32 ? 2 : 1); ++rep) {
            for (int task = F.bid * 8 + F.wave; task < 4 * 8 * RW_NCHUNK; task += F.G * 8) rwkv_pre_task(F, W, ws, WUPT, task, 0);
            for (int task = F.bid * 8 + F.wave; task < 4 * 8 * RW_NCHUNK; task += F.G * 8) rwkv_pre_task(F, W, ws, WUPT, task, 1); } }
        GRID_BAR();

        PH_BEGIN();
        RPT_PHASE(4, { const LayerW W = make_w(in, l); for (int task = F.bid; task < 4 * 8 * NCH; task += F.G) ssd_task<false>(F, W, ws, task); });
        GRID_BAR();
        PH_BEGIN();
        phase_ssd_combine(F, ws);
        GRID_BAR();

        PH_BEGIN();
        { const int ntile = (l == 0) ? 1088 : 1024, nscan = 64 * 3;
          int nfirst, nstride, nend;
          if (F.bid < 64) { rwkv_scan(F, ws, F.bid); nfirst = ntile - nscan + F.bid; nstride = 64; nend = ntile; }
          else { const LayerW W = make_w(in, l); const int blk = F.bid - 64, nblk = F.G - 64;
            for (int task = blk; task < 4 * 8 * NCH; task += nblk) ssd_task<true>(F, W, ws, task);
            nfirst = blk; nstride = nblk; nend = ntile - nscan; }
          PH_BEGIN();
          { const LayerW W = make_w(in, l); na_phase(F, W, ws, nfirst, nstride, nend); } }
        if (RPT == 5) { GRID_BAR(); PH_BEGIN(); const int ntile = (l == 0) ? 1088 : 1024, nscan = 64 * 3; int nfirst, nstride, nend;
          if (F.bid < 64) { rwkv_scan(F, ws, F.bid); nfirst = ntile - nscan + F.bid; nstride = 64; nend = ntile; }
          else { const LayerW W = make_w(in, l); const int blk = F.bid - 64, nblk = F.G - 64;
            for (int task = blk; task < 4 * 8 * NCH; task += nblk) ssd_task<true>(F, W, ws, task);
            nfirst = blk; nstride = nblk; nend = ntile - nscan; }
          PH_BEGIN();
          { const LayerW W = make_w(in, l); na_phase(F, W, ws, nfirst, nstride, nend); } }
        if (RPT == 51) { GRID_BAR(); PH_BEGIN(); if (F.bid < 64) rwkv_scan(F, ws, F.bid); }
        if (RPT == 52) { GRID_BAR(); PH_BEGIN(); if (F.bid >= 64) { const LayerW W = make_w(in, l); const int blk = F.bid - 64, nblk = F.G - 64;
            for (int task = blk; task < 4 * 8 * NCH; task += nblk) ssd_task<true>(F, W, ws, task); } }
        if (RPT == 53) { GRID_BAR(); PH_BEGIN(); if (F.bid >= 64) { const LayerW W = make_w(in, l); const int blk = F.bid - 64, nblk = F.G - 64;
            na_phase(F, W, ws, blk, nblk, (l == 0) ? 1088 : 1024); } }
        GRID_BAR();

        PH_BEGIN();
        RPT_PHASE(6, { const LayerW W = make_w(in, l); phase_finish(F, W, ws, (const bf16_t*)(ws + WS_GUPT) + (size_t)l * 512 * 128, M); });
        GRID_BAR();

        PH_BEGIN();
        { pg8::Gemm g{(const bf16_t*)(ws + WS_MIX), (const bf16_t*)(ws + WS_WOUT) + (size_t)l * 2048 * 2048, M, 2048, 2048}; pg8::StaticOrder S; S.init(M, 2048, F.G, F.bid);
          float* CTXS = (float*)(ws + WS_CTXS);
          pg8::EpiResid E{l == 0 ? in[I_X] : out, l == 0 ? in[I_CTX] : CTXS, out, CTXS, (const float*)(ws + WS_MOD) + (size_t)l * 5 * 12288 + 2 * 2048};
          pg8::gemm_phase<pg8::EpiResid, pg8::StaticOrder>(F.lds, g, S, E, F.tid); }
        if (l == 0 && F.bid >= 32) PEER_CONVERT_LAYER(F, in, ws, 0, F.bid - 32, F.G - 32);
        GRID_BAR();

        PH_BEGIN();
        RPT_PHASE(7, phase_norm(F, out, (const float*)(ws + WS_CTXS), in[I_NFFN] + (size_t)l * 2048, (const float*)(ws + WS_MOD) + (size_t)l * 5 * 12288, 3, 4, (bf16_t*)(ws + WS_XN), M););
        GRID_BAR();
        PH_BEGIN();
        RPT_PHASE(8, { pg8::Gemm g{(const bf16_t*)(ws + WS_XN), (const bf16_t*)(ws + WS_WQ) + (size_t)l * 2048 * 2048, M, 2048, 2048}; pg8::StaticOrder S; S.init(M, 2048, F.G, F.bid);
          pg8::EpiBf16 E{(bf16_t*)(ws + WS_P), 2048}; pg8::gemm_phase<pg8::EpiBf16, pg8::StaticOrder>(F.lds, g, S, E, F.tid); });
        if (l == 0 && F.bid >= 32) PEER_CONVERT_LAYER(F, in, ws, 1, F.bid - 32, F.G - 32);
        GRID_BAR();
        PH_BEGIN();
        RPT_PHASE(9, phase_scores(F, ws, l, M););
        GRID_BAR();
        PH_BEGIN();
        RPT_PHASE(10, { XInfo X; X.xi = lxi[0]; X.nx = lxi[1]; X.rank = lxi[2]; X.nloc = lxi[3]; phase_experts_u<0x3fff>(F, ws, l, M, X, (float*)(ws + WS_PART)); });
        if (RPT == 101) { GRID_BAR(); PH_BEGIN(); XInfo X; X.xi = lxi[0]; X.nx = lxi[1]; X.rank = lxi[2]; X.nloc = lxi[3]; phase_experts_u<0x3ff>(F, ws, l, M, X, (float*)(ws + WS_P)); }
        if (RPT == 102) { GRID_BAR(); PH_BEGIN(); XInfo X; X.xi = lxi[0]; X.nx = lxi[1]; X.rank = lxi[2]; X.nloc = lxi[3]; phase_experts_u<0x3fff>(F, ws, l, M, X, (float*)(ws + WS_P)); }
        GRID_BAR();
        PH_BEGIN();
        phase_experts_combine(F, ws, M);
        GRID_BAR();
        PH_BEGIN();
        if (RPT == 11) { XInfo X; X.xi = lxi[0]; X.nx = lxi[1]; X.rank = lxi[2]; X.nloc = lxi[3]; phase_experts_v(F, ws, (float*)(ws + WS_P), (float*)(ws + WS_P) + (size_t)NLAT * 2048, l, M, X); GRID_BAR(); PH_BEGIN(); }
        { XInfo X; X.xi = lxi[0]; X.nx = lxi[1]; X.rank = lxi[2]; X.nloc = lxi[3]; phase_experts_v(F, ws, out, (float*)(ws + WS_CTXS), l, M, X); }
        if (l == 0) { GRID_BAR(); PH_BEGIN();
            phase_norm(F, out, (const float*)(ws + WS_CTXS), in[I_NMIX] + 2048, (const float*)(ws + WS_MOD) + (size_t)5 * 12288, 0, 1, (bf16_t*)(ws + WS_XN), NTOK); GRID_BAR(); }
    }
}

extern "C" void kernel_launch(void* const* d_in, const int* in_sizes, int n_in, void* d_out, int out_size, void* d_ws, size_t ws_size, hipStream_t stream) {
    static int grid = 0;
    if (grid == 0) {
        if (n_in != N_IN || out_size != NLAT * DM || ws_size < WS_END) { fprintf(stderr, "kernel_launch: unexpected shapes (n_in %d out %d ws %zu, need %zu)\n", n_in, out_size, ws_size, (size_t)WS_END); grid = -1; return; }
        int dev = 0, cus = 0, per_cu = 0;
        (void)hipGetDevice(&dev); (void)hipDeviceGetAttribute(&cus, hipDeviceAttributeMultiprocessorCount, dev);
        if (hipFuncSetAttribute((const void*)hybrid_fwd, hipFuncAttributeMaxDynamicSharedMemorySize, LDS_BYTES) != hipSuccess) { fprintf(stderr, "kernel_launch: hipFuncSetAttribute failed\n"); grid = -1; return; }
        (void)hipOccupancyMaxActiveBlocksPerMultiprocessor(&per_cu, (const void*)hybrid_fwd, 512, LDS_BYTES);
        (void)hipGetLastError();
        fprintf(stderr, "kernel_launch: %d CUs, occupancy query %d block(s)/CU, ws %zu B (need %zu)\n", cus, per_cu, ws_size, (size_t)WS_END);
        grid = cus;
        if (grid < 136) { fprintf(stderr, "kernel_launch: needs at least 136 CUs\n"); grid = -1; return; }
    }
    if (grid < 0) return;
    (void)hipMemsetAsync((char*)d_ws + WS_CTL, 0, 65536, stream);
    Params p{};
    for (int i = 0; i < N_IN; ++i) p.in[i] = (const float*)d_in[i];
    p.out = (float*)d_out; p.ws = (unsigned char*)d_ws;
    hipLaunchKernelGGL(hybrid_fwd, dim3(grid), dim3(512), LDS_BYTES, stream, p);
}
```

```cpp
#include <hip/hip_runtime.h>
#include <cstdio>
#include <cstdint>
#ifndef RPT
#define RPT 0
#endif

constexpr int DM = 2048, NBATCH = 4, SEQL = 4096, CTXL = 256, NLAT = NBATCH * SEQL, NCTX = NBATCH * CTXL, NTOK = NLAT + NCTX;
constexpr int PT = 6416, PTP = 6656;
constexpr int A_BG = 0, A_CG = 512, A_H = 1024;
constexpr int B_R = 1536, B_K = 2048, B_V = 2560, B_WD = 3072, B_AD = 3136, B_GD = 3200;
constexpr int C_Q = 3328, C_K = 3840, C_V = 4352;
constexpr int D_Z = 4864, D_X = 5376, D_DT = 6400;
constexpr int NPOS = CTXL + SEQL;
constexpr int NCH = 34;
constexpr int KSPL = 32;

enum { I_X = 0, I_C, I_CTX, I_CCTX, I_WADA, I_BADA, I_NMIX, I_NFFN, I_WIN, I_WOUT, I_SCW, I_RW0, I_RWUP, I_RA0, I_RAUP, I_RGUP, I_RKK, I_RKA, I_RRK, I_RLNW, I_RLNB,
       I_NAQ, I_NAK, I_RPB, I_SCONVW, I_SCONVB, I_SDTB, I_SALOG, I_SD, I_SNORM, I_PWQ, I_PKEYS, I_PU, I_PV, N_IN };

constexpr size_t WS_CTL   = 0;
constexpr size_t WS_ROPE  = 65536;
constexpr size_t WS_MODP  = WS_ROPE + 16384;
constexpr size_t WS_MOD   = WS_MODP + (size_t)KSPL * 2 * 5 * 12288 * 4;
constexpr size_t WS_WIN   = WS_MOD + (size_t)2 * 5 * 12288 * 4;
constexpr size_t WS_WOUT  = WS_WIN + (size_t)2 * PTP * DM * 2;
constexpr size_t WS_WQ    = WS_WOUT + (size_t)2 * DM * DM * 2;
constexpr size_t WS_KEYS  = WS_WQ + (size_t)2 * DM * DM * 2;
constexpr size_t WS_WUPT  = WS_KEYS + (size_t)2 * 8 * 2 * 128 * 128 * 2;
constexpr size_t WS_GUPT  = WS_WUPT + (size_t)2 * 4 * 512 * 64 * 2;
constexpr size_t WS_PU    = WS_GUPT + (size_t)2 * 512 * 128 * 2;
constexpr size_t WS_PV    = WS_PU + (size_t)2 * 16384 * DM;
constexpr size_t WS_P     = WS_PV + (size_t)2 * 16384 * DM;
constexpr size_t WS_MIX   = WS_P + (size_t)NTOK * PTP * 2;
constexpr size_t WS_CTXS  = WS_MIX + (size_t)NTOK * DM * 2;
constexpr size_t WS_XN    = WS_CTXS + (size_t)NCTX * DM * 4;
constexpr size_t WS_IDS   = WS_XN + (size_t)NTOK * DM * 2;
constexpr size_t WS_GATES = WS_IDS + (size_t)NTOK * 128 * 4;
constexpr size_t WS_PART  = WS_GATES + (size_t)NTOK * 128 * 4;
constexpr size_t WS_RWF   = WS_XN;
constexpr size_t WS_RWY   = WS_RWF + (size_t)64 * 272 * 13312;
constexpr size_t WS_BON   = WS_RWY + (size_t)2 * NTOK * 512 * 2;
constexpr size_t WS_XBC   = WS_BON + (size_t)2 * NTOK * 8 * 4;
constexpr size_t WS_DTS   = WS_XBC + (size_t)NTOK * 1024 * 2;
constexpr size_t WS_DEC   = WS_DTS + (size_t)NTOK * 16 * 4;
constexpr size_t WS_SST   = WS_DEC + (size_t)NTOK * 16 * 4;
constexpr size_t WS_SCD   = WS_SST + (size_t)64 * NCH * 8192 * 4;
constexpr size_t WS_YS    = WS_SCD + 16384;
constexpr size_t WS_QN    = WS_YS + (size_t)NTOK * 512 * 4;
constexpr size_t WS_KN    = WS_QN + (size_t)NTOK * 512 * 2;
constexpr size_t WS_VTL   = WS_KN + (size_t)NTOK * 512 * 2;
constexpr size_t WS_VTC   = WS_VTL + (size_t)4 * 8 * 64 * 64 * 96 * 2;
constexpr size_t WS_END   = WS_VTC + (size_t)4 * 8 * 64 * 256 * 2;
static_assert(WS_END < (size_t)1020 * 1024 * 1024, "workspace");
static_assert(WS_GATES + (size_t)NTOK * 128 * 4 <= WS_PART && WS_PART + (size_t)16 * NTOK * 128 * 4 <= WS_END, "alias");

constexpr int LDS_BYTES = 147456;
constexpr int LDS_BAR_OFF = LDS_BYTES - 16;
constexpr int LDS_XI_OFF = LDS_BYTES - 48;
constexpr int CTL_TICKET = 8192;

#define LAS __attribute__((address_space(3)))
typedef unsigned short bf16_t;
typedef _Float16 f16_t;
typedef short bf16x8 __attribute__((ext_vector_type(8)));
typedef float f32x4 __attribute__((ext_vector_type(4)));
typedef unsigned u32x4 __attribute__((ext_vector_type(4)));
typedef unsigned u32x2 __attribute__((ext_vector_type(2)));

__device__ __forceinline__ float bf2f(bf16_t h) { return __uint_as_float(((unsigned)h) << 16); }
__device__ __forceinline__ float bflo(unsigned u) { return __uint_as_float(u << 16); }
__device__ __forceinline__ float bfhi(unsigned u) { return __uint_as_float(u & 0xffff0000u); }
__device__ __forceinline__ bf16_t f2bf(float f) { unsigned u = __float_as_uint(f); u += 0x7FFFu + ((u >> 16) & 1u); return (bf16_t)(u >> 16); }
typedef float f32x2_t __attribute__((ext_vector_type(2)));
typedef __bf16 bf16x2_t __attribute__((ext_vector_type(2)));
__device__ __forceinline__ unsigned pk_bf16(float lo, float hi) { const f32x2_t v = {lo, hi}; const bf16x2_t r = __builtin_convertvector(v, bf16x2_t); return __builtin_bit_cast(unsigned, r); }
__device__ __forceinline__ bf16x8 pack8(const f32x4 a, const f32x4 b) { union { bf16x8 v; unsigned u[4]; } r; r.u[0] = pk_bf16(a[0], a[1]); r.u[1] = pk_bf16(a[2], a[3]); r.u[2] = pk_bf16(b[0], b[1]); r.u[3] = pk_bf16(b[2], b[3]); return r.v; }
template <int CTRL> __device__ __forceinline__ float dpp_f(float v) { return __int_as_float(__builtin_amdgcn_update_dpp(0, __float_as_int(v), CTRL, 0xF, 0xF, true)); }
__device__ __forceinline__ float sum4(float x)  { x += dpp_f<0xB1>(x); x += dpp_f<0x4E>(x); return x; }
__device__ __forceinline__ float sum8(float x)  { x = sum4(x); x += dpp_f<0x141>(x); return x; }
__device__ __forceinline__ float sum16(float x) { x = sum8(x); x += dpp_f<0x140>(x); return x; }
__device__ __forceinline__ float xor16_f(float x) { return __int_as_float(__builtin_amdgcn_ds_swizzle(__float_as_int(x), 0x401F)); }
__device__ __forceinline__ float sum_x32(float x) { const auto r = __builtin_amdgcn_permlane32_swap(__float_as_uint(x), __float_as_uint(x), false, false); return __uint_as_float(r[0]) + __uint_as_float(r[1]); }
__device__ __forceinline__ float max_x32(float x) { const auto r = __builtin_amdgcn_permlane32_swap(__float_as_uint(x), __float_as_uint(x), false, false); return fmaxf(__uint_as_float(r[0]), __uint_as_float(r[1])); }
__device__ __forceinline__ float wave_sum(float x) { x = sum16(x); x += xor16_f(x); return sum_x32(x); }
__device__ __forceinline__ float max16(float x) { x = fmaxf(x, dpp_f<0xB1>(x)); x = fmaxf(x, dpp_f<0x4E>(x)); x = fmaxf(x, dpp_f<0x141>(x)); x = fmaxf(x, dpp_f<0x140>(x)); return x; }
__device__ __forceinline__ float wave_max(float x) { x = max16(x); x = fmaxf(x, xor16_f(x)); return max_x32(x); }
__device__ __forceinline__ float rcpf_(float x) { return __builtin_amdgcn_rcpf(x); }
__device__ __forceinline__ float sigmoidf_(float x) { return rcpf_(1.0f + __expf(-x)); }
__device__ __forceinline__ float siluf_(float x) { return x * rcpf_(1.0f + __expf(-x)); }
__device__ __forceinline__ float tanhf_(float x) { const float e = __expf(2.0f * x); return 1.0f - 2.0f * rcpf_(e + 1.0f); }
__device__ __forceinline__ float geluf_(float x) { return 0.5f * x * (1.0f + tanhf_(0.7978845608028654f * (x + 0.044715f * x * x * x))); }

namespace pg8 {
#define PG8_LAS __attribute__((address_space(3)))
typedef unsigned short bf16_t;
typedef short bf16x8 __attribute__((ext_vector_type(8)));
typedef float f32x4 __attribute__((ext_vector_type(4)));
typedef unsigned u32x4 __attribute__((ext_vector_type(4)));
constexpr int BM = 256, BK = 64, HALF = 128, HTB = HALF * BK * 2  , STAGE_BYTES = 8 * HTB, NXCD = 8, WGM = 8;

__host__ __device__ __forceinline__ int lds_byte(int r, int c) { const int st = (r >> 4) * 2 + (c >> 5), rr = r & 15, cc = c & 31, ob = rr * 64 + cc * 2; return st * 1024 + (ob ^ (((ob >> 9) & 1) << 5)); }
__host__ __device__ __forceinline__ void stage_rc(int b, int& R, int& C) { const int st = b / 1024, sb = b % 1024, swz = sb ^ (((sb >> 9) & 1) << 5); R = (st >> 1) * 16 + swz / 64; C = (st & 1) * 32 + (swz % 64) / 2; }
__host__ __device__ __forceinline__ int perm32(int rho) { const int n = rho >> 4, i = rho & 15; return 8 * (i >> 2) + 4 * n + (i & 3); }

struct Unit { int pm, pn; };
struct Gemm { const bf16_t* A; const bf16_t* Bt; int M, N, K; };

struct StaticOrder {
    int nM, nN, nwg, G, c;
    __host__ __device__ void init(int M, int N, int G_, int c_) { nM = M / BM; nN = N / BM; nwg = nM * nN; G = G_; c = c_; }
    __host__ __device__ bool next(int i, Unit& u) const {
        const long L = (long)i * G + c; if (L >= nwg) return false;
        int wgid = (int)L; { const int q = nwg / NXCD, r = nwg % NXCD, xcd = wgid % NXCD, off = wgid / NXCD; wgid = (xcd < r ? xcd * (q + 1) : r * (q + 1) + (xcd - r) * q) + off; }
        const int nig = WGM * nN, gid = wgid / nig, fm = gid * WGM, gsz = (nM - fm) < WGM ? (nM - fm) : WGM;
        u.pm = fm + ((wgid % nig) % gsz); u.pn = (wgid % nig) / gsz; return true;
    }
    __device__ __forceinline__ void a_ready(const Unit&) const {}
    __device__ __forceinline__ void done(const Unit&) const {}
};

__device__ __forceinline__ unsigned cvt_pk_bf16(float lo, float hi) { return ::pk_bf16(lo, hi); }
struct EpiBf16 {
    static constexpr bool PERM = true, AFTER_DRAIN = false;
    bf16_t* O; int ldc;
    __device__ __forceinline__ void operator()(const f32x4 (&acc)[2][2][4][2], const Unit& u, int wr, int wc, int fr, int fq) const {
        const int row0 = u.pm * BM + wr * 64 + fr; const int col0 = u.pn * BM + wc * 32 + 8 * fq;
#pragma unroll
        for (int ai = 0; ai < 2; ++ai)
#pragma unroll
            for (int m = 0; m < 4; ++m) { bf16_t* rowp = O + (size_t)(row0 + ai * HALF + m * 16) * ldc + col0;
#pragma unroll
                for (int bj = 0; bj < 2; ++bj) { const f32x4 v0 = acc[ai][bj][m][0], v1 = acc[ai][bj][m][1];
                    u32x4 w; w.x = cvt_pk_bf16(v0[0], v0[1]); w.y = cvt_pk_bf16(v0[2], v0[3]); w.z = cvt_pk_bf16(v1[0], v1[1]); w.w = cvt_pk_bf16(v1[2], v1[3]);
                    *(u32x4*)(rowp + bj * HALF) = w; } }
    }
};
struct EpiResid {
    static constexpr bool PERM = false, AFTER_DRAIN = false;
    const float* xi_lat; const float* xi_ctx; float* xo_lat; float* xo_ctx; const float* gate;
    __device__ __forceinline__ void operator()(const f32x4 (&acc)[2][2][4][2], const Unit& u, int wr, int wc, int fr, int fq) const {
        const bool isctx = u.pm >= 64; const int v = isctx ? 4 : (u.pm >> 4);
        const int row0 = (isctx ? (u.pm - 64) : u.pm) * BM + wr * 64 + fr, col0 = u.pn * BM + wc * 32 + 4 * fq;
        const float* xi = isctx ? xi_ctx : xi_lat; float* xo = isctx ? xo_ctx : xo_lat;
        const float* gp = gate + (size_t)v * 12288 + col0;
        f32x4 gv[2][2];
#pragma unroll
        for (int bj = 0; bj < 2; ++bj)
#pragma unroll
            for (int n = 0; n < 2; ++n) gv[bj][n] = *(const f32x4*)(gp + bj * HALF + n * 16);
#pragma unroll
        for (int ai = 0; ai < 2; ++ai)
#pragma unroll
            for (int m = 0; m < 4; ++m) { const size_t off = (size_t)(row0 + ai * HALF + m * 16) * 2048 + col0;
#pragma unroll
                for (int bj = 0; bj < 2; ++bj)
#pragma unroll
                    for (int n = 0; n < 2; ++n) { const f32x4 xv = *(const f32x4*)(xi + off + bj * HALF + n * 16);
                        *(f32x4*)(xo + off + bj * HALF + n * 16) = xv + gv[bj][n] * acc[ai][bj][m][n]; }
                asm volatile("" ::: "memory"); }
    }
};

template <class Epi, class Sched>
__device__ __forceinline__ void gemm_phase(PG8_LAS unsigned char* lds, const Gemm g, const Sched& S, const Epi& E, const int tid) {
    const int wid = __builtin_amdgcn_readfirstlane(tid >> 6), lane = tid & 63, wr = wid >> 2, wc = wid & 3, fr = lane & 15, fq = lane >> 4;
    const int K = g.K, nt = K / BK;
    unsigned voffA[2], voffB[2];
#pragma unroll
    for (int i = 0; i < 2; ++i) { int R, C; stage_rc(tid * 16 + i * 8192, R, C); const int Rb = Epi::PERM ? ((R & ~31) + perm32(R & 31)) : R;
        voffA[i] = (unsigned)(R * K + C) * 2u; voffB[i] = (unsigned)(Rb * K + C) * 2u; }
    const size_t kstep = (size_t)(BK * 2);
    const size_t hstep = (size_t)HALF * K * 2;
    const size_t tstep = 2 * hstep;
    const unsigned ldsw = (unsigned)wid * 1024u;
    const int aoff = lds_byte(wr * 64 + fr, fq * 8), boff = lds_byte(wc * 32 + fr, fq * 8);
#define PG8_SA(b, h) (((b) * 2 + (h)) * HTB)
#define PG8_SB(b, h) ((4 + (b) * 2 + (h)) * HTB)
#define PG8_STAGE(bufoff, gbase, voff) do { _Pragma("unroll") for (int _i = 0; _i < 2; ++_i) \
        __builtin_amdgcn_global_load_lds((const unsigned*)((const char*)(gbase) + (voff)[_i]), (PG8_LAS unsigned*)(lds + (bufoff) + ldsw + _i * 8192), 16, 0, 0); } while (0)
#define PG8_LDA(dst, b, h) do { _Pragma("unroll") for (int m = 0; m < 4; ++m) _Pragma("unroll") for (int k = 0; k < 2; ++k) dst[m][k] = *(const PG8_LAS bf16x8*)(lds + PG8_SA(b, h) + aoff + m * 2048 + k * 1024); } while (0)
#define PG8_LDB(dst, b, h) do { _Pragma("unroll") for (int n = 0; n < 2; ++n) _Pragma("unroll") for (int k = 0; k < 2; ++k) dst[n][k] = *(const PG8_LAS bf16x8*)(lds + PG8_SB(b, h) + boff + n * 2048 + k * 1024); } while (0)
#define PG8_MMA(ai, bj, At, Bt) do { __builtin_amdgcn_s_setprio(1); _Pragma("unroll") for (int m = 0; m < 4; ++m) _Pragma("unroll") for (int n = 0; n < 2; ++n) _Pragma("unroll") for (int k = 0; k < 2; ++k) \
        acc[ai][bj][m][n] = __builtin_amdgcn_mfma_f32_16x16x32_bf16(Bt[n][k], At[m][k], acc[ai][bj][m][n], 0, 0, 0); __builtin_amdgcn_s_setprio(0); } while (0)
#define PG8_WAIT_V(n) asm volatile("s_waitcnt vmcnt(" #n ")" ::: "memory")
#define PG8_WAIT_L(n) asm volatile("s_waitcnt lgkmcnt(" #n ")" ::: "memory")
#define PG8_BAR __builtin_amdgcn_s_barrier()
#define PG8_SCHED __builtin_amdgcn_sched_barrier(0)
    Unit cur, nxt; int ui = 0;
    if (!S.next(0, cur)) return;
    f32x4 acc[2][2][4][2];
#pragma unroll
    for (int a = 0; a < 2; ++a)
#pragma unroll
        for (int b = 0; b < 2; ++b)
#pragma unroll
            for (int m = 0; m < 4; ++m)
#pragma unroll
                for (int n = 0; n < 2; ++n) acc[a][b][m][n] = (f32x4){0.f, 0.f, 0.f, 0.f};
    bf16x8 At[4][2], B0[2][2], B1[2][2];
    const char* cA = (const char*)g.A + (size_t)cur.pm * tstep; const char* cB = (const char*)g.Bt + (size_t)cur.pn * tstep;
    S.a_ready(cur);
    PG8_STAGE(PG8_SB(0, 0), cB, voffB); PG8_STAGE(PG8_SA(0, 0), cA, voffA); PG8_STAGE(PG8_SB(0, 1), cB + hstep, voffB); PG8_STAGE(PG8_SA(0, 1), cA + hstep, voffA);
    if (wr == 1) PG8_BAR;
    PG8_WAIT_V(4); PG8_BAR;
    PG8_STAGE(PG8_SB(1, 0), cB + kstep, voffB); PG8_STAGE(PG8_SA(1, 0), cA + kstep, voffA); PG8_STAGE(PG8_SB(1, 1), cB + hstep + kstep, voffB);
    PG8_WAIT_V(6); PG8_BAR;
    for (;;) {
        const bool has_next = S.next(ui + 1, nxt);
        const char* nA = has_next ? (const char*)g.A + (size_t)nxt.pm * tstep : cA; const char* nB = has_next ? (const char*)g.Bt + (size_t)nxt.pn * tstep : cB;
        for (int t = 0; t < nt; t += 2) {
            const bool last = (t == nt - 2);
            const char* a1 = cA + (size_t)(t + 1) * kstep;
            const char* a2 = last ? nA : cA + (size_t)(t + 2) * kstep; const char* b2 = last ? nB : cB + (size_t)(t + 2) * kstep;
            const char* a3 = a2 + kstep; const char* b3 = b2 + kstep;
            if (last && has_next) S.a_ready(nxt);
            PG8_LDB(B0, 0, 0); PG8_SCHED; PG8_LDA(At, 0, 0); PG8_STAGE(PG8_SA(1, 1), a1 + hstep, voffA);
            PG8_WAIT_L(8); PG8_BAR; PG8_WAIT_L(0); PG8_MMA(0, 0, At, B0); PG8_BAR; PG8_SCHED;
            PG8_LDB(B1, 0, 1); PG8_STAGE(PG8_SB(0, 0), b2, voffB);
            PG8_BAR; PG8_WAIT_L(0); PG8_MMA(0, 1, At, B1); PG8_BAR;
            PG8_LDA(At, 0, 1); PG8_STAGE(PG8_SA(0, 0), a2, voffA);
            PG8_BAR; PG8_WAIT_L(0); PG8_MMA(1, 0, At, B0); PG8_BAR; PG8_SCHED;
            PG8_STAGE(PG8_SB(0, 1), b2 + hstep, voffB);
            PG8_WAIT_V(6); PG8_BAR; PG8_MMA(1, 1, At, B1); PG8_BAR;
            PG8_LDB(B0, 1, 0); PG8_SCHED; PG8_LDA(At, 1, 0); PG8_STAGE(PG8_SA(0, 1), a2 + hstep, voffA);
            PG8_WAIT_L(8); PG8_BAR; PG8_WAIT_L(0); PG8_MMA(0, 0, At, B0); PG8_BAR; PG8_SCHED;
            PG8_LDB(B1, 1, 1); PG8_STAGE(PG8_SB(1, 0), b3, voffB);
            PG8_BAR; PG8_WAIT_L(0); PG8_MMA(0, 1, At, B1); PG8_BAR;
            PG8_LDA(At, 1, 1); PG8_STAGE(PG8_SA(1, 0), a3, voffA);
            PG8_BAR; PG8_WAIT_L(0); PG8_MMA(1, 0, At, B0); PG8_BAR; PG8_SCHED;
            PG8_STAGE(PG8_SB(1, 1), b3 + hstep, voffB);
            PG8_WAIT_V(6); PG8_BAR; PG8_MMA(1, 1, At, B1); PG8_BAR;
        }
        if constexpr (!Epi::AFTER_DRAIN) { E(acc, cur, wr, wc, fr, fq); S.done(cur); }
        if (!has_next) break;
#pragma unroll
        for (int a = 0; a < 2; ++a)
#pragma unroll
            for (int b = 0; b < 2; ++b)
#pragma unroll
                for (int m = 0; m < 4; ++m)
#pragma unroll
                    for (int n = 0; n < 2; ++n) acc[a][b][m][n] = (f32x4){0.f, 0.f, 0.f, 0.f};
        cur = nxt; cA = nA; cB = nB; ++ui;
    }
    PG8_WAIT_V(0);
    if (wr == 0) PG8_BAR;
    PG8_BAR;
    if constexpr (Epi::AFTER_DRAIN) { E.fused(acc, cur, wr, wc, fr, fq, lds, wid, lane); S.done(cur); }
#undef PG8_SA
#undef PG8_SB
#undef PG8_STAGE
#undef PG8_LDA
#undef PG8_LDB
#undef PG8_MMA
#undef PG8_WAIT_V
#undef PG8_WAIT_L
#undef PG8_BAR
#undef PG8_SCHED
}
}

#define XB_TMO      128
#define XB_XCNT(j)  (256  + 64 * (j))
#define XB_XSUB(j)  (1280 + 64 * (j))
#define XB_XGEN(j)  (2304 + 64 * (j))
#define XB_TOP      3328
#define XB_TOPGEN   3392
#define XCD_BAR_WORDS 3456
#define XB_SPIN_CAP (1u << 18)
#define LAS __attribute__((address_space(3)))

__device__ __forceinline__ unsigned xb_ld(unsigned* p)              { return __hip_atomic_load(p, __ATOMIC_RELAXED, __HIP_MEMORY_SCOPE_AGENT); }
__device__ __forceinline__ unsigned xb_add(unsigned* p, unsigned v) { return __hip_atomic_fetch_add(p, v, __ATOMIC_RELAXED, __HIP_MEMORY_SCOPE_AGENT); }
__device__ __forceinline__ unsigned xb_xcc_id() { return (unsigned)__builtin_amdgcn_s_getreg((3 << 11) | 20) & 0xFu; }
#define XB_SPIN(cond, bar) do { unsigned _sp = 0; while (cond) { __builtin_amdgcn_s_sleep(1); \
    if ((++_sp & 255u) == 0u) { if (xb_ld(&(bar)[XB_TMO])) break; if (_sp > XB_SPIN_CAP) { atomicAdd(&(bar)[XB_TMO], 1u); break; } } } } while (0)

struct XcdBarrier {
    unsigned* bar; unsigned x;
    volatile LAS unsigned* st;
};

__device__ __forceinline__ XcdBarrier xcd_barrier_post(unsigned* bar, volatile LAS unsigned* st) {
    XcdBarrier b; b.bar = bar; b.x = xb_xcc_id(); b.st = st;
    if (threadIdx.x == 0) (void)xb_add(&bar[XB_XCNT(b.x)], 1u);
    return b;
}
__device__ __forceinline__ void xcd_barrier_complete(unsigned* bar, unsigned x, unsigned& nloc, unsigned& nx) {
    const unsigned G = gridDim.x * gridDim.y * gridDim.z;
    unsigned sum, cnt, mine, sp = 0u;
    for (;;) {
        sum = 0u; cnt = 0u; mine = 0u;
#pragma unroll
        for (unsigned j = 0; j < 16; ++j) { const unsigned c = xb_ld(&bar[XB_XCNT(j)]); sum += c; cnt += (c > 0u) ? 1u : 0u; mine = (j == x) ? c : mine; }
        if (sum == G) break;
        __builtin_amdgcn_s_sleep(1);
        if ((++sp & 255u) == 0u) { if (xb_ld(&bar[XB_TMO])) break; if (sp > XB_SPIN_CAP) { atomicAdd(&bar[XB_TMO], 1u); break; } }
    }
    nloc = mine > 0u ? mine : 1u; nx = cnt > 0u ? cnt : 1u;
}

__device__ __forceinline__ void xcd_barrier(const XcdBarrier& b) {
    asm volatile("s_waitcnt vmcnt(0)" ::: "memory");
    __syncthreads();
    if (threadIdx.x == 0) {
        unsigned* bar = b.bar;
        __builtin_amdgcn_s_waitcnt(0);
        unsigned nloc = b.st[0], nx = b.st[1];
        if (nloc == 0u) { xcd_barrier_complete(bar, b.x, nloc, nx); b.st[0] = nloc; b.st[1] = nx; }
        const unsigned old = xb_add(&bar[XB_XSUB(b.x)], 1u);
        const unsigned gen = old / nloc;
        if (old + 1u == (gen + 1u) * nloc) {
            __builtin_amdgcn_fence(__ATOMIC_RELEASE, "agent");
            asm volatile("s_waitcnt vmcnt(0)" ::: "memory");
            const unsigned og = xb_add(&bar[XB_TOP], 1u);
            const unsigned tg = og / nx;
            if (og + 1u == (tg + 1u) * nx) xb_add(&bar[XB_TOPGEN], 1u);
            else XB_SPIN(xb_ld(&bar[XB_TOPGEN]) == tg, bar);
            __builtin_amdgcn_fence(__ATOMIC_ACQUIRE, "agent");
            xb_add(&bar[XB_XGEN(b.x)], 1u);
            asm volatile("s_waitcnt vmcnt(0)" ::: "memory");
        } else {
            XB_SPIN(xb_ld(&bar[XB_XGEN(b.x)]) == gen, bar);
            __builtin_amdgcn_fence(__ATOMIC_ACQUIRE, "agent");
            asm volatile("s_waitcnt vmcnt(0)" ::: "memory");
        }
    }
    __syncthreads();
}

typedef const float* cfp_t;
typedef __attribute__((address_space(4))) const cfp_t* ka_t;
struct Ctx {
    LAS unsigned char* lds; int tid, lane, wave, bid, G;
};

__device__ __forceinline__ void task_ada(const Ctx& F, const float* c, const float* c_ctx, const float* w_ada, float* modp, int task) {
    LAS float* s_act = (LAS float*)F.lds;
    const int l = task / (KSPL * 6), rem = task % (KSPL * 6), ks = rem / 6, cc = rem % 6;
    __syncthreads();
    if (F.tid < 320) { const int v = F.tid >> 6, k = ks * 64 + (F.tid & 63); const float x = v < 4 ? c[v * 2048 + k] : c_ctx[k]; s_act[F.tid] = siluf_(x); }
    __syncthreads();
    const int col4 = cc * 512 + F.tid;
    const float4* wp = (const float4*)(w_ada + ((size_t)l * 2048 + ks * 64) * 12288) + col4;
    float4 acc[5];
#pragma unroll
    for (int v = 0; v < 5; ++v) acc[v] = make_float4(0.f, 0.f, 0.f, 0.f);
#pragma unroll 8
    for (int k = 0; k < 64; ++k) {
        const float4 w = wp[(size_t)k * 3072];
#pragma unroll
        for (int v = 0; v < 5; ++v) { const float a = s_act[v * 64 + k]; acc[v].x += a * w.x; acc[v].y += a * w.y; acc[v].z += a * w.z; acc[v].w += a * w.w; }
    }
#pragma unroll
    for (int v = 0; v < 5; ++v) ((float4*)(modp + (((size_t)ks * 2 + l) * 5 + v) * 12288))[col4] = acc[v];
}
__device__ __forceinline__ void task_wt(const Ctx& F, const float* W, int N, bf16_t* Wt, int ntile) {
    LAS bf16_t* T = (LAS bf16_t*)F.lds;
    const int nq = F.tid & 15, kr = F.tid >> 4, n0 = ntile * 64;
    for (int kc = 0; kc < 16; ++kc) {
        float4 v[4];
#pragma unroll
        for (int j = 0; j < 4; ++j) { const int k = kc * 128 + kr + 32 * j, n = n0 + 4 * nq;
            v[j] = (n < N) ? *(const float4*)(W + (size_t)k * N + n) : make_float4(0.f, 0.f, 0.f, 0.f); }
        __syncthreads();
#pragma unroll
        for (int j = 0; j < 4; ++j) { const int kl = kr + 32 * j;
            T[(4 * nq + 0) * 136 + kl] = f2bf(v[j].x); T[(4 * nq + 1) * 136 + kl] = f2bf(v[j].y); T[(4 * nq + 2) * 136 + kl] = f2bf(v[j].z); T[(4 * nq + 3) * 136 + kl] = f2bf(v[j].w); }
        __syncthreads();
        { const int n = F.tid >> 3, kg = F.tid & 7;
          const u32x4 a = *(LAS u32x4*)(T + n * 136 + kg * 16), b = *(LAS u32x4*)(T + n * 136 + kg * 16 + 8);
          bf16_t* dst = Wt + (size_t)(n0 + n) * 2048 + kc * 128 + kg * 16; *(u32x4*)dst = a; *(u32x4*)(dst + 8) = b; }
    }
    __syncthreads();
}
__device__ __forceinline__ void task_cvt(const Ctx& F, const float* src, bf16_t* dst, size_t off) {
#pragma unroll 4
    for (int it = 0; it < 16; ++it) { const size_t e = off + (size_t)it * 4096 + F.tid * 8;
        const float4 a = *(const float4*)(src + e), b = *(const float4*)(src + e + 4);
        u32x4 o; o.x = pk_bf16(a.x, a.y); o.y = pk_bf16(a.z, a.w); o.z = pk_bf16(b.x, b.y); o.w = pk_bf16(b.z, b.w);
        *(u32x4*)(dst + e) = o; }
}
__device__ __forceinline__ void task_cvt8(const Ctx& F, const float* src, unsigned char* dst, size_t off, float scale) {
#pragma unroll 2
    for (int it = 0; it < 8; ++it) { const size_t e = off + (size_t)it * 8192 + F.tid * 16;
        u32x4 o;
#pragma unroll
        for (int w = 0; w < 4; ++w) { const float4 a = *(const float4*)(src + e + 4 * w);
            const float x0 = fminf(fmaxf(a.x * scale, -448.f), 448.f), x1 = fminf(fmaxf(a.y * scale, -448.f), 448.f), x2 = fminf(fmaxf(a.z * scale, -448.f), 448.f), x3 = fminf(fmaxf(a.w * scale, -448.f), 448.f);
            int p = __builtin_amdgcn_cvt_pk_fp8_f32(x0, x1, 0, false); p = __builtin_amdgcn_cvt_pk_fp8_f32(x2, x3, p, true); o[w] = (unsigned)p; }
        const size_t row = e >> 11; const int col = (int)(e & 2047);
        *(u32x4*)(dst + (row >> 14) * ((size_t)16384 * 2048) + ((size_t)(col >> 7) * 16384 + (row & 16383)) * 128 + (col & 127)) = o; }
}
constexpr float PEER_U_SCALE = 64.0f;
#define PEER_CONVERT_LAYER(F, in, ws, layer, blk, nblk) do { for (int t_ = (blk); t_ < 1024; t_ += (nblk)) { const bool isv_ = t_ >= 512; \
        task_cvt8(F, in[isv_ ? I_PV : I_PU], ws + (isv_ ? WS_PV : WS_PU), (size_t)(layer) * 16384 * 2048 + (size_t)(t_ & 511) * 65536, isv_ ? 1.0f : PEER_U_SCALE); } } while (0)
__device__ __forceinline__ void task_lorat(const Ctx& F, const float* src, bf16_t* dst, int nj) {
    const int ch = F.tid;
    for (int j8 = 0; j8 < nj / 8; ++j8) { float v[8];
#pragma unroll
        for (int q = 0; q < 8; ++q) v[q] = src[(size_t)(j8 * 8 + q) * 512 + ch];
        u32x4 o; o.x = pk_bf16(v[0], v[1]); o.y = pk_bf16(v[2], v[3]); o.z = pk_bf16(v[4], v[5]); o.w = pk_bf16(v[6], v[7]);
        *(u32x4*)(dst + (size_t)ch * nj + j8 * 8) = o; }
}
constexpr int T_ADA = 2 * KSPL * 6, T_WT1 = 2 * 104, T_WT2 = 2 * 32, T_WT3 = 2 * 32, T_PEER = 0, T_KEYS = 8, T_LORA = 10;
__device__ __forceinline__ void phase_prologue(const Ctx& F, ka_t in, unsigned char* ws) {
    const int total = T_ADA + T_WT1 + T_WT2 + T_WT3 + T_PEER + T_KEYS + T_LORA + 1;
    for (int t0 = F.bid; t0 < total; t0 += F.G) {
        int t = t0;
        if (t < T_ADA) { task_ada(F, in[I_C], in[I_CCTX], in[I_WADA], (float*)(ws + WS_MODP), t); continue; } t -= T_ADA;
        if (t < T_WT1) { const int l = t / 104, nt = t % 104; task_wt(F, in[I_WIN] + (size_t)l * 2048 * PT, PT, (bf16_t*)(ws + WS_WIN) + (size_t)l * PTP * 2048, nt); continue; } t -= T_WT1;
        if (t < T_WT2) { const int l = t / 32, nt = t % 32; task_wt(F, in[I_WOUT] + (size_t)l * 2048 * 2048, 2048, (bf16_t*)(ws + WS_WOUT) + (size_t)l * 2048 * 2048, nt); continue; } t -= T_WT2;
        if (t < T_WT3) { const int l = t / 32, nt = t % 32; task_wt(F, in[I_PWQ] + (size_t)l * 2048 * 2048, 2048, (bf16_t*)(ws + WS_WQ) + (size_t)l * 2048 * 2048, nt); continue; } t -= T_WT3;
        if (t < T_PEER) { const bool isv = t >= 1024; const int c = t & 1023; task_cvt8(F, in[isv ? I_PV : I_PU], ws + (isv ? WS_PV : WS_PU), (size_t)c * 65536, isv ? 1.0f : PEER_U_SCALE); continue; } t -= T_PEER;
        if (t < T_KEYS) { task_cvt(F, in[I_PKEYS], (bf16_t*)(ws + WS_KEYS), (size_t)t * 65536); continue; } t -= T_KEYS;
        if (t < T_LORA) {
            if (t < 8) { const int l = t >> 2, wh = t & 3;
                task_lorat(F, in[wh < 2 ? I_RWUP : I_RAUP] + ((size_t)l * 2 + (wh & 1)) * 64 * 512, (bf16_t*)(ws + WS_WUPT) + ((size_t)l * 4 + wh) * 512 * 64, 64); }
            else { const int l = t - 8; task_lorat(F, in[I_RGUP] + (size_t)l * 128 * 512, (bf16_t*)(ws + WS_GUPT) + (size_t)l * 512 * 128, 128); }
            continue; } t -= T_LORA;
        { float* rope = (float*)(ws + WS_ROPE);
          for (int e = F.tid; e < 2048; e += 512) { const int pos = e >> 5, i = e & 31; const float fr = powf(10000.0f, -(float)i / 32.0f), ang = (float)pos * fr;
              rope[2 * e] = cosf(ang); rope[2 * e + 1] = sinf(ang); } }
    }
}
__device__ __forceinline__ void phase_modreduce(const Ctx& F, const float* b_ada, const float* modp, float* mod) {
    for (int idx = F.bid * 512 + F.tid; idx < 2 * 5 * 12288; idx += F.G * 512) {
        const int l = idx / 61440, rem = idx % 61440, v = rem / 12288, n = rem % 12288;
        float s = b_ada[l * 12288 + n];
        for (int ks = 0; ks < KSPL; ++ks) s += modp[(((size_t)ks * 2 + l) * 5 + v) * 12288 + n];
        mod[idx] = s;
    }
}

__device__ __forceinline__ void norm_store(const float (&x)[32], const float* gw, const float* shift, const float* scale, bf16_t* dst, int lane) {
    float ss = 0.f;
#pragma unroll
    for (int q = 0; q < 32; ++q) ss += x[q] * x[q];
    ss = wave_sum(ss);
    const float rs = rsqrtf(ss * (1.0f / 2048.0f) + 1e-6f);
#pragma unroll
    for (int j = 0; j < 4; ++j) { const int e = j * 512 + lane * 8;
        const float4 g0 = *(const float4*)(gw + e), g1 = *(const float4*)(gw + e + 4), h0 = *(const float4*)(shift + e), h1 = *(const float4*)(shift + e + 4), c0 = *(const float4*)(scale + e), c1 = *(const float4*)(scale + e + 4);
        const float y0 = x[j * 8 + 0] * rs * g0.x * (1.f + c0.x) + h0.x, y1 = x[j * 8 + 1] * rs * g0.y * (1.f + c0.y) + h0.y, y2 = x[j * 8 + 2] * rs * g0.z * (1.f + c0.z) + h0.z, y3 = x[j * 8 + 3] * rs * g0.w * (1.f + c0.w) + h0.w;
        const float y4 = x[j * 8 + 4] * rs * g1.x * (1.f + c1.x) + h1.x, y5 = x[j * 8 + 5] * rs * g1.y * (1.f + c1.y) + h1.y, y6 = x[j * 8 + 6] * rs * g1.z * (1.f + c1.z) + h1.z, y7 = x[j * 8 + 7] * rs * g1.w * (1.f + c1.w) + h1.w;
        u32x4 o; o.x = pk_bf16(y0, y1); o.y = pk_bf16(y2, y3); o.z = pk_bf16(y4, y5); o.w = pk_bf16(y6, y7);
        *(u32x4*)(dst + e) = o; }
}
__device__ __forceinline__ void phase_norm(const Ctx& F, const float* xlat, const float* xctx, const float* gw, const float* mod, int shift_i, int scale_i, bf16_t* dst, int nrows) {
    for (int row = F.bid * 8 + F.wave; row < nrows; row += F.G * 8) {
        const bool isctx = row >= NLAT; const float* xr = isctx ? xctx + (size_t)(row - NLAT) * 2048 : xlat + (size_t)row * 2048;
        const int v = isctx ? 4 : (row >> 12);
        float x[32];
#pragma unroll
        for (int j = 0; j < 4; ++j) { const int e = j * 512 + F.lane * 8; const float4 a = *(const float4*)(xr + e), b = *(const float4*)(xr + e + 4);
            x[j * 8 + 0] = a.x; x[j * 8 + 1] = a.y; x[j * 8 + 2] = a.z; x[j * 8 + 3] = a.w; x[j * 8 + 4] = b.x; x[j * 8 + 5] = b.y; x[j * 8 + 6] = b.z; x[j * 8 + 7] = b.w; }
        norm_store(x, gw, mod + (size_t)v * 12288 + shift_i * 2048, mod + (size_t)v * 12288 + scale_i * 2048, dst + (size_t)row * 2048, F.lane);
    }
}

struct LayerW {
    const float *sc_w, *rw_w0, *rw_wup, *rw_a0, *rw_aup, *rw_gup, *rw_kk, *rw_ka, *rw_rk, *rw_lnw, *rw_lnb, *na_q, *na_k, *rpb, *s_cw, *s_cb, *s_dtb, *s_alog, *s_d, *s_norm;
};
__device__ __forceinline__ void unpack8(const u32x4 q, float (&f)[8]) { f[0] = bflo(q[0]); f[1] = bfhi(q[0]); f[2] = bflo(q[1]); f[3] = bfhi(q[1]); f[4] = bflo(q[2]); f[5] = bfhi(q[2]); f[6] = bflo(q[3]); f[7] = bfhi(q[3]); }
__device__ __forceinline__ u32x4 pack8f(const float (&f)[8]) { u32x4 o; o[0] = pk_bf16(f[0], f[1]); o[1] = pk_bf16(f[2], f[3]); o[2] = pk_bf16(f[4], f[5]); o[3] = pk_bf16(f[6], f[7]); return o; }
__device__ __forceinline__ void load8f(const float* p, float (&f)[8]) { const float4 a = *(const float4*)p, b = *(const float4*)(p + 4); f[0] = a.x; f[1] = a.y; f[2] = a.z; f[3] = a.w; f[4] = b.x; f[5] = b.y; f[6] = b.z; f[7] = b.w; }
__device__ __forceinline__ void phase_prep(const Ctx& F, const LayerW& W, unsigned char* ws) {
    const bf16_t* P = (const bf16_t*)(ws + WS_P);
    bf16_t* MIX = (bf16_t*)(ws + WS_MIX);
    bf16_t* XBC = (bf16_t*)(ws + WS_XBC); float* DTS = (float*)(ws + WS_DTS); float* DEC = (float*)(ws + WS_DEC);
    bf16_t* QN = (bf16_t*)(ws + WS_QN); bf16_t* KN = (bf16_t*)(ws + WS_KN); bf16_t* VTL = (bf16_t*)(ws + WS_VTL); bf16_t* VTC = (bf16_t*)(ws + WS_VTC);
    const float* ROPE = (const float*)(ws + WS_ROPE);
    for (int tile = F.bid; tile < NTOK / 8; tile += F.G) {
        int ln = F.lane; asm volatile("" : "+v"(ln));
        const int ch0 = ln * 8;
        const bool lat = tile < NLAT / 8;
        const int b = lat ? (tile >> 9) : ((tile - NLAT / 8) >> 5);
        const int t0 = lat ? (tile & 511) * 8 : ((tile - NLAT / 8) & 31) * 8;
        const int L = lat ? SEQL : CTXL;
        const int g0 = lat ? b * SEQL + t0 : NLAT + b * CTXL + t0;
        const bf16_t* Pr = P + (size_t)g0 * PTP;
        if (F.wave == 0 || F.wave == 4) {
            const bool gated = F.wave == 0;
            const float* cw = gated ? W.sc_w : W.s_cw; const int cstride = gated ? 512 : 1024;
            float w0[8], w1[8], w2[8], cb[8];
            load8f(cw + ch0, w0); load8f(cw + cstride + ch0, w1); load8f(cw + 2 * cstride + ch0, w2);
            if (gated) {
#pragma unroll
                for (int e = 0; e < 8; ++e) cb[e] = 0.f;
            } else load8f(W.s_cb + ch0, cb);
            const int col = gated ? A_CG : D_X;
#pragma unroll 1
            for (int tb = 0; tb < 8; tb += 4) {
            u32x4 ra[6], rb[6], rg[4];
#pragma unroll
            for (int q = 0; q < 6; ++q) { const int tq = t0 + tb - 1 + q; const bool ok = (tq >= 0) && (tq < L);
                ra[q] = ok ? *(const u32x4*)(Pr + (ptrdiff_t)(tb + q - 1) * PTP + col + ch0) : (u32x4){0u, 0u, 0u, 0u};
                if (gated) rb[q] = ok ? *(const u32x4*)(Pr + (ptrdiff_t)(tb + q - 1) * PTP + A_H + ch0) : (u32x4){0u, 0u, 0u, 0u}; }
            if (gated) {
#pragma unroll
                for (int tt = 0; tt < 4; ++tt) rg[tt] = *(const u32x4*)(Pr + (size_t)(tb + tt) * PTP + A_BG + ch0); }
            float up[8], uc[8], un[8];
            { float x[8], y[8]; unpack8(ra[0], x); if (gated) { unpack8(rb[0], y);
#pragma unroll
                for (int e = 0; e < 8; ++e) x[e] *= y[e]; }
#pragma unroll
              for (int e = 0; e < 8; ++e) up[e] = x[e];
              unpack8(ra[1], x); if (gated) { unpack8(rb[1], y);
#pragma unroll
                for (int e = 0; e < 8; ++e) x[e] *= y[e]; }
#pragma unroll
              for (int e = 0; e < 8; ++e) uc[e] = x[e]; }
#pragma unroll
            for (int tt = 0; tt < 4; ++tt) {
                { float x[8], y[8]; unpack8(ra[tt + 2], x); if (gated) { unpack8(rb[tt + 2], y);
#pragma unroll
                    for (int e = 0; e < 8; ++e) x[e] *= y[e]; }
#pragma unroll
                  for (int e = 0; e < 8; ++e) un[e] = x[e]; }
                float o[8];
                if (gated) { float bg[8]; unpack8(rg[tt], bg);
#pragma unroll
                    for (int e = 0; e < 8; ++e) o[e] = bg[e] * (w0[e] * up[e] + w1[e] * uc[e] + w2[e] * un[e]);
                    *(u32x4*)(MIX + (size_t)(g0 + tb + tt) * 2048 + ch0) = pack8f(o);
                } else {
#pragma unroll
                    for (int e = 0; e < 8; ++e) o[e] = siluf_(w0[e] * up[e] + w1[e] * uc[e] + w2[e] * un[e] + cb[e]);
                    *(u32x4*)(XBC + (size_t)(g0 + tb + tt) * 1024 + ch0) = pack8f(o); }
#pragma unroll
                for (int e = 0; e < 8; ++e) { up[e] = uc[e]; uc[e] = un[e]; }
            }
            }
        } else if (F.wave == 1 || F.wave == 2) {
            const bool isq = F.wave == 1; const int col = isq ? C_Q : C_K; bf16_t* dst = isq ? QN : KN;
            float nw[8]; load8f((isq ? W.na_q : W.na_k) + (ln & 7) * 8, nw);
            const float sc = isq ? 0.125f : 1.0f;
            u32x4 rq[8];
#pragma unroll
            for (int tt = 0; tt < 8; ++tt) rq[tt] = *(const u32x4*)(Pr + (size_t)tt * PTP + col + ch0);
#pragma unroll
            for (int tt = 0; tt < 8; ++tt) { float x[8]; unpack8(rq[tt], x); float ss = 0.f;
#pragma unroll
                for (int e = 0; e < 8; ++e) ss += x[e] * x[e];
                ss = sum8(ss); const float rs = rsqrtf(ss * (1.f / 64.f) + 1e-6f) * sc;
#pragma unroll
                for (int e = 0; e < 8; ++e) x[e] = x[e] * rs * nw[e];
                if (isq) *(u32x4*)(dst + (size_t)(g0 + tt) * 512 + ch0) = pack8f(x);
                else {
                    const int hh = ln >> 3, p = ln & 7, t = t0 + tt;
                    bf16_t* kd = lat ? dst + ((size_t)((((b * 8 + hh) * 64 + (t >> 6)) * 2 + (p >> 2)) * 4 + (p & 3)) * 64 + (t & 63)) * 8
                                     : dst + (size_t)NLAT * 512 + ((size_t)(((b * 8 + hh) * 2 + (p >> 2)) * 4 + (p & 3)) * 256 + t) * 8;
                    *(u32x4*)kd = pack8f(x); } }
        } else if (F.wave == 3) {
            u32x4 rv[8];
#pragma unroll
            for (int tt = 0; tt < 8; ++tt) rv[tt] = *(const u32x4*)(Pr + (size_t)tt * PTP + C_V + ch0);
            const int h = ln >> 3;
#pragma unroll
            for (int e = 0; e < 8; ++e) { const int i = (ln & 7) * 8 + e;
                unsigned short v[8];
#pragma unroll
                for (int tt = 0; tt < 8; ++tt) v[tt] = (unsigned short)((e & 1) ? (rv[tt][e >> 1] >> 16) : (rv[tt][e >> 1] & 0xffffu));
                u32x2 c0; c0.x = (unsigned)v[0] | ((unsigned)v[1] << 16); c0.y = (unsigned)v[2] | ((unsigned)v[3] << 16);
                u32x2 c1; c1.x = (unsigned)v[4] | ((unsigned)v[5] << 16); c1.y = (unsigned)v[6] | ((unsigned)v[7] << 16);
                if (lat) { const int row = t0 >> 6, x0 = (t0 & 63) >> 2, x1 = x0 + 1;
                    bf16_t* base = VTL + ((size_t)((b * 8 + h) * 64 + row) * 12 * 64 + i) * 8;
                    if (x0 <= 11) *(u32x2*)(base + x0 * 512) = c0;
                    if (x0 >= 4)  *(u32x2*)(base + (x0 - 4) * 512 + 4) = c0;
                    if (x1 <= 11) *(u32x2*)(base + x1 * 512) = c1;
                    if (x1 >= 4)  *(u32x2*)(base + (x1 - 4) * 512 + 4) = c1;
                } else { const int m = t0 >> 5, o = t0 & 31, gq = (o & 15) >> 2, hf = (o >> 4) * 4;
                    bf16_t* base = VTC + ((size_t)(((b * 8 + h) * 8 + m) * 4) * 64 + i) * 8;
                    *(u32x2*)(base + gq * 512 + hf) = c0; *(u32x2*)(base + (gq + 1) * 512 + hf) = c1; } }
        } else if (F.wave == 5 || F.wave == 7) {
            {
                const int pg = ln & 15, tb = (ln >> 4) * 2, which = F.wave == 7 ? 1 : 0, gi = (pg >> 3) & 1, half = (pg >> 2) & 1, i0 = (pg & 3) * 8;
                const int c1 = 512 + which * 256 + gi * 128 + half * 64 + i0, c2 = c1 + 32;
                float wa0[8], wa1[8], wa2[8], ba[8], wb0[8], wb1[8], wb2[8], bb[8];
                load8f(W.s_cw + c1, wa0); load8f(W.s_cw + 1024 + c1, wa1); load8f(W.s_cw + 2048 + c1, wa2); load8f(W.s_cb + c1, ba);
                load8f(W.s_cw + c2, wb0); load8f(W.s_cw + 1024 + c2, wb1); load8f(W.s_cw + 2048 + c2, wb2); load8f(W.s_cb + c2, bb);
                u32x4 ra[4], rb[4];
#pragma unroll
                for (int q = 0; q < 4; ++q) { const int tq = t0 + tb - 1 + q; const bool ok = (tq >= 0) && (tq < L);
                    ra[q] = ok ? *(const u32x4*)(Pr + (ptrdiff_t)(tb + q - 1) * PTP + D_X + c1) : (u32x4){0u, 0u, 0u, 0u};
                    rb[q] = ok ? *(const u32x4*)(Pr + (ptrdiff_t)(tb + q - 1) * PTP + D_X + c2) : (u32x4){0u, 0u, 0u, 0u}; }
                float ap[8], ac[8], an[8], bp[8], bc[8], bn[8];
                unpack8(ra[0], ap); unpack8(ra[1], ac); unpack8(rb[0], bp); unpack8(rb[1], bc);
#pragma unroll
                for (int tt = 0; tt < 2; ++tt) { unpack8(ra[tt + 2], an); unpack8(rb[tt + 2], bn);
                    float y1[8], y2[8];
#pragma unroll
                    for (int e = 0; e < 8; ++e) { y1[e] = siluf_(wa0[e] * ap[e] + wa1[e] * ac[e] + wa2[e] * an[e] + ba[e]); y2[e] = siluf_(wb0[e] * bp[e] + wb1[e] * bc[e] + wb2[e] * bn[e] + bb[e]); }
                    if (lat) { const int t = t0 + tb + tt, pos = half ? (t & 63) : (t >> 6);
                        float cs[16];
#pragma unroll
                        for (int q = 0; q < 4; ++q) { const float4 v = *(const float4*)(ROPE + (size_t)(pos * 32 + i0) * 2 + 4 * q); cs[4 * q] = v.x; cs[4 * q + 1] = v.y; cs[4 * q + 2] = v.z; cs[4 * q + 3] = v.w; }
#pragma unroll
                        for (int e = 0; e < 8; ++e) { const float o1 = y1[e] * cs[2 * e] - y2[e] * cs[2 * e + 1], o2 = y1[e] * cs[2 * e + 1] + y2[e] * cs[2 * e]; y1[e] = o1; y2[e] = o2; } }
                    *(u32x4*)(XBC + (size_t)(g0 + tb + tt) * 1024 + c1) = pack8f(y1); *(u32x4*)(XBC + (size_t)(g0 + tb + tt) * 1024 + c2) = pack8f(y2);
#pragma unroll
                    for (int e = 0; e < 8; ++e) { ap[e] = ac[e]; ac[e] = an[e]; bp[e] = bc[e]; bc[e] = bn[e]; }
                }
            }
        } else if (F.wave == 6) {
#pragma unroll
            for (int q = 0; q < 2; ++q) { const int it = ln + 64 * q, tt = it >> 4, j = it & 15;
                const float x = bf2f(Pr[(size_t)tt * PTP + D_DT + j]) + W.s_dtb[j];
                const float sp = fmaxf(x, 0.f) + log1pf(__expf(-fabsf(x)));
                DTS[(size_t)(g0 + tt) * 16 + j] = sp; DEC[(size_t)(g0 + tt) * 16 + j] = -sp * __expf(W.s_alog[j]); }
        }
    }
}

constexpr int SB_PITCH = 136;
__device__ __forceinline__ void ssd_scan_load(const Ctx& F, const float* LA, int g0, int h, float& a0, float& a1) {
    const int d = F.wave, i = F.lane, t0 = d ? 127 - 2 * i : 2 * i, t1 = d ? 126 - 2 * i : 2 * i + 1;
    a0 = LA[(size_t)(g0 + t0) * 16 + d * 8 + h]; a1 = LA[(size_t)(g0 + t1) * 16 + d * 8 + h];
}
__device__ __forceinline__ void ssd_scan_write(const Ctx& F, LAS float* sL, float a0, float a1) {
    const int d = F.wave, i = F.lane, t0 = d ? 127 - 2 * i : 2 * i, t1 = d ? 126 - 2 * i : 2 * i + 1;
    float p = a0 + a1;
    p += dpp_f<0x111>(p); p += dpp_f<0x112>(p); p += dpp_f<0x114>(p); p += dpp_f<0x118>(p);
    const float r0 = __int_as_float(__builtin_amdgcn_readlane(__float_as_int(p), 15)), r1 = __int_as_float(__builtin_amdgcn_readlane(__float_as_int(p), 31)), r2 = __int_as_float(__builtin_amdgcn_readlane(__float_as_int(p), 47));
    const int row = i >> 4; p += (row >= 1 ? r0 : 0.f) + (row >= 2 ? r1 : 0.f) + (row >= 3 ? r2 : 0.f);
    sL[d * 128 + t1] = p; sL[d * 128 + t0] = p - a1;
}
template <bool PASS2>
__device__ __forceinline__ void ssd_task(const Ctx& F, const LayerW& W, unsigned char* ws, int task) {
    const bf16_t* XBC = (const bf16_t*)(ws + WS_XBC); const float* DTS = (const float*)(ws + WS_DTS); const float* LA = (const float*)(ws + WS_DEC);
    float* SST = (float*)(ws + WS_SST); float* SCD = (float*)(ws + WS_SCD); float* YS = (float*)(ws + WS_YS);
    const int c = task % NCH, bh = task / NCH, h = bh & 7, b = bh >> 3, gi = h >> 2;
    const int g0 = c < 2 ? NLAT + b * CTXL + c * 128 : b * SEQL + (c - 2) * 128;
    const int w = F.wave, l16 = F.lane & 15, g = F.lane >> 4;
    const f32x4 z4 = {0.f, 0.f, 0.f, 0.f};
    LAS float* sL = (LAS float*)(F.lds + 131072);
    LAS float* sDT = sL + 256;
    __syncthreads();
    float la0 = 0.f, la1 = 0.f;
    if (w < 2) ssd_scan_load(F, LA, g0, h, la0, la1);
    if (F.tid < 256) { const int s = F.tid >> 1, d = F.tid & 1; sDT[F.tid] = DTS[(size_t)(g0 + s) * 16 + d * 8 + h]; }
    if (!PASS2) {
        if (w < 2) ssd_scan_write(F, sL, la0, la1);
        __syncthreads();
        LAS bf16_t* sBT = (LAS bf16_t*)F.lds;
        LAS bf16_t* sXT = sBT + 128 * SB_PITCH;
#pragma unroll
        for (int q = 0; q < 4; ++q) { const int v = F.tid + 512 * q, s = v >> 4, part = v & 15;
            const u32x4 bv = *(const u32x4*)(XBC + (size_t)(g0 + s) * 1024 + 512 + gi * 128 + part * 8);
#pragma unroll
            for (int e = 0; e < 4; ++e) { sBT[(part * 8 + 2 * e) * SB_PITCH + s] = (bf16_t)(bv[e] & 0xffffu); sBT[(part * 8 + 2 * e + 1) * SB_PITCH + s] = (bf16_t)(bv[e] >> 16); } }
#pragma unroll
        for (int q = 0; q < 2; ++q) { const int v = F.tid + 512 * q, s = v >> 3, part = v & 7;
            const u32x4 xv = *(const u32x4*)(XBC + (size_t)(g0 + s) * 1024 + h * 64 + part * 8);
            const float sc0 = sDT[s * 2] * __expf(sL[127] - sL[s]), sc1 = sDT[s * 2 + 1] * __expf(sL[128] - sL[128 + s]);
#pragma unroll
            for (int e = 0; e < 4; ++e) { const float lo = bflo(xv[e]), hi = bfhi(xv[e]); const int p = part * 8 + 2 * e;
                sXT[p * SB_PITCH + s] = f2bf(lo * sc0); sXT[(p + 1) * SB_PITCH + s] = f2bf(hi * sc0);
                sXT[(64 + p) * SB_PITCH + s] = f2bf(lo * sc1); sXT[(64 + p + 1) * SB_PITCH + s] = f2bf(hi * sc1); } }
        __syncthreads();
        bf16x8 bfr[4];
#pragma unroll
        for (int ks = 0; ks < 4; ++ks) bfr[ks] = *(const LAS bf16x8*)(sBT + (16 * w + l16) * SB_PITCH + 32 * ks + 8 * g);
#pragma unroll
        for (int d = 0; d < 2; ++d) {
            float* st = SST + ((size_t)((b * 8 + h) * 2 + d) * NCH + c) * 8192;
#pragma unroll
            for (int pt = 0; pt < 4; ++pt) { f32x4 acc = z4;
#pragma unroll
                for (int ks = 0; ks < 4; ++ks) acc = __builtin_amdgcn_mfma_f32_16x16x32_bf16(*(const LAS bf16x8*)(sXT + (d * 64 + 16 * pt + l16) * SB_PITCH + 32 * ks + 8 * g), bfr[ks], acc, 0, 0, 0);
#pragma unroll
                for (int r = 0; r < 4; ++r) st[(16 * pt + 4 * g + r) * 128 + 16 * w + l16] = acc[r]; }
            if (F.tid == 0) SCD[((b * 8 + h) * 2 + d) * NCH + c] = __expf(d ? sL[128] : sL[127]);
        }
    } else {
        LAS bf16_t* sB = (LAS bf16_t*)F.lds;
        LAS bf16_t* sC = sB + 128 * SB_PITCH;
        LAS bf16_t* sXT = sC + 128 * SB_PITCH;
        LAS bf16_t* sS = sXT + 64 * SB_PITCH;
#pragma unroll
        for (int q = 0; q < 4; ++q) { const int v = F.tid + 512 * q, s = v >> 4, part = v & 15;
            *(LAS u32x4*)(sB + s * SB_PITCH + part * 8) = *(const u32x4*)(XBC + (size_t)(g0 + s) * 1024 + 512 + gi * 128 + part * 8);
            *(LAS u32x4*)(sC + s * SB_PITCH + part * 8) = *(const u32x4*)(XBC + (size_t)(g0 + s) * 1024 + 768 + gi * 128 + part * 8); }
#pragma unroll
        for (int q = 0; q < 2; ++q) { const int v = F.tid + 512 * q, s = v >> 3, part = v & 7;
            const u32x4 xv = *(const u32x4*)(XBC + (size_t)(g0 + s) * 1024 + h * 64 + part * 8);
#pragma unroll
            for (int e = 0; e < 4; ++e) { sXT[(part * 8 + 2 * e) * SB_PITCH + s] = (bf16_t)(xv[e] & 0xffffu); sXT[(part * 8 + 2 * e + 1) * SB_PITCH + s] = (bf16_t)(xv[e] >> 16); } }
#pragma unroll
        for (int q = 0; q < 4; ++q) { const int v = F.tid + 512 * q, d = v >> 10, p = (v >> 4) & 63, part = v & 15;
            const float* sp = SST + ((size_t)((b * 8 + h) * 2 + d) * NCH + c) * 8192 + p * 128 + part * 8;
            const float4 a0 = *(const float4*)sp, a1 = *(const float4*)(sp + 4);
            u32x4 o; o.x = pk_bf16(a0.x, a0.y); o.y = pk_bf16(a0.z, a0.w); o.z = pk_bf16(a1.x, a1.y); o.w = pk_bf16(a1.z, a1.w);
            *(LAS u32x4*)(sS + (d * 64 + p) * SB_PITCH + part * 8) = o; }
        if (w < 2) ssd_scan_write(F, sL, la0, la1);
        __syncthreads();
        const int t = 16 * w + l16;
        bf16x8 cfr[4];
#pragma unroll
        for (int ks = 0; ks < 4; ++ks) cfr[ks] = *(const LAS bf16x8*)(sC + t * SB_PITCH + 32 * ks + 8 * g);
        f32x4 gt[8];
#pragma unroll
        for (int a = 0; a < 8; ++a) { f32x4 acc = z4;
#pragma unroll
            for (int ks = 0; ks < 4; ++ks) acc = __builtin_amdgcn_mfma_f32_16x16x32_bf16(*(const LAS bf16x8*)(sB + (16 * a + l16) * SB_PITCH + 32 * ks + 8 * g), cfr[ks], acc, 0, 0, 0);
            gt[a] = acc; }
        f32x4 ysum[4] = {z4, z4, z4, z4};
#pragma unroll
        for (int d = 0; d < 2; ++d) {
            const float Lt = sL[d * 128 + t], eLt = __expf(Lt);
            f32x4 acc[4];
#pragma unroll
            for (int pt = 0; pt < 4; ++pt) { f32x4 a = z4;
#pragma unroll
                for (int ks = 0; ks < 4; ++ks) a = __builtin_amdgcn_mfma_f32_16x16x32_bf16(*(const LAS bf16x8*)(sS + (d * 64 + 16 * pt + l16) * SB_PITCH + 32 * ks + 8 * g), cfr[ks], a, 0, 0, 0);
                acc[pt] = a * eLt; }
#pragma unroll
            for (int m = 0; m < 4; ++m) {
                const bool need = d ? (2 * m + 1 >= w) : (2 * m <= w);
                if (need) {
                    f32x4 wt[2];
#pragma unroll
                    for (int u = 0; u < 2; ++u) { const int a = 2 * m + u;
                        const f32x4 Ls = *(const LAS f32x4*)(sL + d * 128 + 16 * a + 4 * g);
#pragma unroll
                        for (int r = 0; r < 4; ++r) { const int s = 16 * a + 4 * g + r; const bool ok = d ? (s >= t) : (s <= t);
                            const float dts = sDT[s * 2 + d];
                            wt[u][r] = ok ? gt[a][r] * __expf(Lt - Ls[r]) * dts : 0.f; } }
                    const bf16x8 bfrag = pack8(wt[0], wt[1]);
#pragma unroll
                    for (int pt = 0; pt < 4; ++pt) { union { bf16x8 v; u32x2 hh[2]; } af;
                        af.hh[0] = *(const LAS u32x2*)(sXT + (16 * pt + l16) * SB_PITCH + 32 * m + 4 * g); af.hh[1] = *(const LAS u32x2*)(sXT + (16 * pt + l16) * SB_PITCH + 32 * m + 16 + 4 * g);
                        acc[pt] = __builtin_amdgcn_mfma_f32_16x16x32_bf16(af.v, bfrag, acc[pt], 0, 0, 0); }
                }
            }
#pragma unroll
            for (int pt = 0; pt < 4; ++pt) ysum[pt] = ysum[pt] + acc[pt];
        }
        const float dsk = W.s_d[h];
#pragma unroll
        for (int pt = 0; pt < 4; ++pt) { const int p = 16 * pt + 4 * g;
            const u32x2 xv = *(const u32x2*)(XBC + (size_t)(g0 + t) * 1024 + h * 64 + p);
            *(float4*)(YS + (size_t)(g0 + t) * 512 + h * 64 + p) = make_float4(ysum[pt][0] + dsk * bflo(xv.x), ysum[pt][1] + dsk * bfhi(xv.x), ysum[pt][2] + dsk * bflo(xv.y), ysum[pt][3] + dsk * bfhi(xv.y)); }
    }
}
template <int D> __device__ __forceinline__ void ssd_combine_one(float4* base, const float* scd) {
    float4 carry = make_float4(0.f, 0.f, 0.f, 0.f);
#pragma unroll
    for (int k0 = 0; k0 < NCH; k0 += 17) {
        float4 tmp[17];
#pragma unroll
        for (int k = 0; k < 17; ++k) { const int kk = k0 + k, c = D ? (kk < 2 ? 1 - kk : 35 - kk) : kk; tmp[k] = base[(size_t)c * 2048]; }
#pragma unroll
        for (int k = 0; k < 17; ++k) { const int kk = k0 + k, c = D ? (kk < 2 ? 1 - kk : 35 - kk) : kk; const float a = scd[c];
            base[(size_t)c * 2048] = carry;
            carry.x = a * carry.x + tmp[k].x; carry.y = a * carry.y + tmp[k].y; carry.z = a * carry.z + tmp[k].z; carry.w = a * carry.w + tmp[k].w; }
    }
}
__device__ __forceinline__ void phase_ssd_combine(const Ctx& F, unsigned char* ws) {
    float4* SST4 = (float4*)(ws + WS_SST); const float* SCD = (const float*)(ws + WS_SCD);
    for (int gt = F.bid * 512 + F.tid; gt < 64 * 2048; gt += F.G * 512) {
        const int sidx = gt >> 11, e4 = gt & 2047;
        float4* base = SST4 + (size_t)sidx * NCH * 2048 + e4;
        if (sidx & 1) ssd_combine_one<1>(base, SCD + sidx * NCH); else ssd_combine_one<0>(base, SCD + sidx * NCH);
    }
}

constexpr int RWF_CHUNK = 13312;
constexpr int RW_NCHUNK = NPOS / 16;
template <int CTRL> __device__ __forceinline__ float dpp_id0(float v) { return __int_as_float(__builtin_amdgcn_update_dpp(0, __float_as_int(v), CTRL, 0xF, 0xF, true)); }
template <int CTRL> __device__ __forceinline__ float dpp_id1(float v) { return __int_as_float(__builtin_amdgcn_update_dpp(0x3f800000, __float_as_int(v), CTRL, 0xF, 0xF, false)); }
__device__ __forceinline__ float sel4(int g, float a, float b, float c, float d) { return g == 0 ? a : (g == 1 ? b : (g == 2 ? c : d)); }

template <int D> __device__ __forceinline__ void rwkv_pre_dir(const bf16_t* wupt, const bf16x8 (&bw)[2], const bf16x8 (&ba)[2], const f32x4 (&kk)[4], const f32x4 (&rr)[4], const f32x4 (&kx)[4],
        const float* w0p, const float* a0p, const float* kap, const float* rkp, float& bon, LAS unsigned char* wl, unsigned char* dst, int l16, int g) {
    LAS float* LT = (LAS float*)wl; LAS float* AT = LT + 256; LAS bf16_t* BT = (LAS bf16_t*)(wl + 2048); LAS bf16_t* KT = BT + 1024;
    const int lane = g * 16 + l16;
    bf16x8* o = (bf16x8*)dst;
    const f32x4 z4 = {0.f, 0.f, 0.f, 0.f};
    bf16x8 af[2], bf[2], kf[2], rf[2];
#pragma unroll
    for (int p = 0; p < 2; ++p) {
        f32x4 al[2], be[2], ka[2], rh[2];
#pragma unroll
        for (int mm = 0; mm < 2; ++mm) { const int m = 2 * p + mm; asm volatile("" ::: "memory");
            const bf16_t* wpw = wupt + ((size_t)D * 512 + 16 * m + l16) * 64 + 8 * g; const bf16_t* wpa = wupt + ((size_t)(2 + D) * 512 + 16 * m + l16) * 64 + 8 * g;
            f32x4 aw = __builtin_amdgcn_mfma_f32_16x16x32_bf16(*(const bf16x8*)wpw, bw[0], z4, 0, 0, 0); aw = __builtin_amdgcn_mfma_f32_16x16x32_bf16(*(const bf16x8*)(wpw + 32), bw[1], aw, 0, 0, 0);
            f32x4 aa = __builtin_amdgcn_mfma_f32_16x16x32_bf16(*(const bf16x8*)wpa, ba[0], z4, 0, 0, 0); aa = __builtin_amdgcn_mfma_f32_16x16x32_bf16(*(const bf16x8*)(wpa + 32), ba[1], aa, 0, 0, 0);
            const float4 w0 = *(const float4*)(w0p + 16 * m + 4 * g), a0 = *(const float4*)(a0p + 16 * m + 4 * g), kav = *(const float4*)(kap + 16 * m + 4 * g), rkv = *(const float4*)(rkp + 16 * m + 4 * g);
            const float w0a[4] = {w0.x, w0.y, w0.z, w0.w}, a0a[4] = {a0.x, a0.y, a0.z, a0.w}, kaa[4] = {kav.x, kav.y, kav.z, kav.w}, rka[4] = {rkv.x, rkv.y, rkv.z, rkv.w};
            f32x4 gcv;
#pragma unroll
            for (int r = 0; r < 4; ++r) {
                const float a = sigmoidf_(a0a[r] + aa[r]);
                const float kd = kx[m][r] * (1.f + (a - 1.f) * kaa[r]), bb = kk[m][r] * a;
                bon += rr[m][r] * kd * rka[r];
                float Lg = -0.8750387749205294f * sigmoidf_(w0a[r] + aw[r]);
                if (D == 0) { Lg += dpp_id0<0x111>(Lg); Lg += dpp_id0<0x112>(Lg); Lg += dpp_id0<0x114>(Lg); Lg += dpp_id0<0x118>(Lg); }
                else        { Lg += dpp_id0<0x101>(Lg); Lg += dpp_id0<0x102>(Lg); Lg += dpp_id0<0x104>(Lg); Lg += dpp_id0<0x108>(Lg); }
                const float Lex = (D == 0) ? dpp_id0<0x111>(Lg) : dpp_id0<0x101>(Lg);
                const float G = __builtin_amdgcn_exp2f(Lg), Gex = __builtin_amdgcn_exp2f(Lex), iG = __builtin_amdgcn_exp2f(-Lg);
                al[mm][r] = Gex * kk[m][r]; be[mm][r] = bb * iG; ka[mm][r] = kd * iG; rh[mm][r] = G * rr[m][r]; gcv[r] = G;
                const int k = 16 * m + 4 * g + r; const unsigned pk_ = pk_bf16(be[mm][r], ka[mm][r]); BT[k * 16 + l16] = (bf16_t)(pk_ & 0xffffu); KT[k * 16 + l16] = (bf16_t)(pk_ >> 16);
            }
            if (l16 == ((D == 0) ? 15 : 0)) *(float4*)((float*)(dst + 12288) + 16 * m + 4 * g) = make_float4(gcv[0], gcv[1], gcv[2], gcv[3]);
        }
        af[p] = pack8(al[0], al[1]); bf[p] = pack8(be[0], be[1]); kf[p] = pack8(ka[0], ka[1]); rf[p] = pack8(rh[0], rh[1]);
        o[64 * p + lane] = af[p]; o[128 + 64 * p + lane] = rf[p];
        __builtin_amdgcn_sched_barrier(0);
    }
    f32x4 Lm = __builtin_amdgcn_mfma_f32_16x16x32_bf16(af[0], bf[0], z4, 0, 0, 0); Lm = __builtin_amdgcn_mfma_f32_16x16x32_bf16(af[1], bf[1], Lm, 0, 0, 0);
    f32x4 Am = __builtin_amdgcn_mfma_f32_16x16x32_bf16(af[0], kf[0], z4, 0, 0, 0); Am = __builtin_amdgcn_mfma_f32_16x16x32_bf16(af[1], kf[1], Am, 0, 0, 0);
    f32x4 Bb = __builtin_amdgcn_mfma_f32_16x16x32_bf16(bf[0], rf[0], z4, 0, 0, 0); Bb = __builtin_amdgcn_mfma_f32_16x16x32_bf16(bf[1], rf[1], Bb, 0, 0, 0);
    f32x4 Bk = __builtin_amdgcn_mfma_f32_16x16x32_bf16(kf[0], rf[0], z4, 0, 0, 0); Bk = __builtin_amdgcn_mfma_f32_16x16x32_bf16(kf[1], rf[1], Bk, 0, 0, 0);
#pragma unroll
    for (int r = 0; r < 4; ++r) { const int row = 4 * g + r;
        const bool strict = (D == 0) ? (l16 < row) : (l16 > row);
        const bool incl = (D == 0) ? (row <= l16) : (row >= l16);
        Lm[r] = strict ? Lm[r] : 0.f; Am[r] = strict ? Am[r] : 0.f; Bb[r] = incl ? Bb[r] : 0.f; Bk[r] = incl ? Bk[r] : 0.f; }
    *(LAS f32x4*)(LT + l16 * 16 + 4 * g) = Lm; *(LAS f32x4*)(AT + l16 * 16 + 4 * g) = Am;
    o[320 + lane] = pack8(Bb, Bk);
    asm volatile("" ::: "memory");
#pragma unroll
    for (int m = 0; m < 4; ++m) { union { bf16x8 v; u32x2 h[2]; } f;
        f.h[0] = *(LAS u32x2*)(BT + (16 * m + l16) * 16 + 4 * g); f.h[1] = *(LAS u32x2*)(KT + (16 * m + l16) * 16 + 4 * g);
        o[384 + 64 * m + lane] = f.v; }
    __builtin_amdgcn_sched_barrier(0);
    float x[16];
    if (D == 0) {
#pragma unroll
        for (int c = 15; c >= 0; --c) { float s = (c == l16) ? 1.f : 0.f; asm volatile("" ::: "memory");
#pragma unroll
            for (int i = c + 1; i < 16; ++i) s -= x[i] * LT[c * 16 + i];
            x[c] = s; }
    } else {
#pragma unroll
        for (int c = 0; c < 16; ++c) { float s = (c == l16) ? 1.f : 0.f; asm volatile("" ::: "memory");
#pragma unroll
            for (int i = 0; i < c; ++i) s -= x[i] * LT[c * 16 + i];
            x[c] = s; }
    }
    f32x4 tm0, tm1;
#pragma unroll
    for (int r = 0; r < 4; ++r) tm0[r] = -sel4(g, x[r], x[4 + r], x[8 + r], x[12 + r]);
#pragma unroll
    for (int r = 0; r < 4; ++r) { const int c = 4 * g + r; float s = 0.f; asm volatile("" ::: "memory");
#pragma unroll
        for (int i = 0; i < 16; i += 4) { const f32x4 a4 = *(LAS f32x4*)(AT + c * 16 + i); s += x[i] * a4[0] + x[i + 1] * a4[1] + x[i + 2] * a4[2] + x[i + 3] * a4[3]; }
        tm1[r] = -s; }
    o[256 + lane] = pack8(tm0, tm1);
    asm volatile("" ::: "memory");
}
__device__ __forceinline__ void rwkv_pre_task(const Ctx& F, const LayerW& W, unsigned char* ws, const bf16_t* WUPT, int task, int dsel) {
    const bf16_t* P = (const bf16_t*)(ws + WS_P); float* BON = (float*)(ws + WS_BON); unsigned char* RWF = ws + WS_RWF;
    const int cidx = task % RW_NCHUNK, bh = task / RW_NCHUNK, h = bh & 7, b = bh >> 3;
    int ln_ = F.lane; asm volatile("" : "+v"(ln_));
    const int l16 = ln_ & 15, g = ln_ >> 4;
    const int pos = cidx * 16 + l16;
    const int tok = pos < CTXL ? NLAT + b * CTXL + pos : b * SEQL + (pos - CTXL);
    const bf16_t* Pr = P + (size_t)tok * PTP;
    LAS unsigned char* wl = F.lds + F.wave * 8192;
    bf16x8 bw[2], ba[2];
#pragma unroll
    for (int p = 0; p < 2; ++p) { const u32x4 q = *(const u32x4*)(Pr + B_WD + 32 * p + 8 * g); union { bf16x8 v; unsigned u[4]; } tq;
#pragma unroll
        for (int e = 0; e < 4; ++e) tq.u[e] = pk_bf16(tanhf_(bflo(q[e])), tanhf_(bfhi(q[e])));
        bw[p] = tq.v; ba[p] = *(const bf16x8*)(Pr + B_AD + 32 * p + 8 * g); }
    f32x4 kk[4], rr[4], kx[4];
    float ssq = 0.f;
#pragma unroll
    for (int m = 0; m < 4; ++m) { const int co = h * 64 + 16 * m + 4 * g;
        const u32x2 rq = *(const u32x2*)(Pr + B_R + co), kq = *(const u32x2*)(Pr + B_K + co); const float4 kkw = *(const float4*)(W.rw_kk + co);
        rr[m] = (f32x4){bflo(rq.x), bfhi(rq.x), bflo(rq.y), bfhi(rq.y)}; kx[m] = (f32x4){bflo(kq.x), bfhi(kq.x), bflo(kq.y), bfhi(kq.y)};
        kk[m] = (f32x4){kx[m][0] * kkw.x, kx[m][1] * kkw.y, kx[m][2] * kkw.z, kx[m][3] * kkw.w};
        ssq += kk[m][0] * kk[m][0] + kk[m][1] * kk[m][1] + kk[m][2] * kk[m][2] + kk[m][3] * kk[m][3]; }
    ssq += xor16_f(ssq); ssq = sum_x32(ssq);
    { const float rn = rsqrtf(ssq + 1e-12f);
#pragma unroll
      for (int m = 0; m < 4; ++m) kk[m] = kk[m] * rn; }
    float bon = 0.f;
    const int co = h * 64;
    const int c0 = cidx, c1 = cidx < 16 ? 15 - cidx : 287 - cidx;
    {
      const int tok0 = cidx < 16 ? NLAT + b * CTXL + cidx * 16 : b * SEQL + cidx * 16 - CTXL;
      const bf16_t* vp = P + (size_t)(tok0 + 4 * g) * PTP + B_V + h * 64 + l16;
      u32x2* vd = (u32x2*)(RWF + ((size_t)(bh * 2 + dsel) * RW_NCHUNK + (dsel ? c1 : c0)) * RWF_CHUNK + 10240) + ln_;
#pragma unroll
      for (int n = 0; n < 4; ++n) { u32x2 w; w.x = (unsigned)vp[16 * n] | ((unsigned)vp[PTP + 16 * n] << 16); w.y = (unsigned)vp[2 * PTP + 16 * n] | ((unsigned)vp[3 * PTP + 16 * n] << 16); vd[64 * n] = w; } }
    if (dsel == 0) rwkv_pre_dir<0>(WUPT + (size_t)co * 64, bw, ba, kk, rr, kx, W.rw_w0 + co, W.rw_a0 + co, W.rw_ka + co, W.rw_rk + co, bon, wl, RWF + ((size_t)(bh * 2 + 0) * RW_NCHUNK + c0) * RWF_CHUNK, l16, g);
    else           rwkv_pre_dir<1>(WUPT + (size_t)co * 64, bw, ba, kk, rr, kx, W.rw_w0 + 512 + co, W.rw_a0 + 512 + co, W.rw_ka + co, W.rw_rk + co, bon, wl, RWF + ((size_t)(bh * 2 + 1) * RW_NCHUNK + c1) * RWF_CHUNK, l16, g);
    bon += xor16_f(bon); bon = sum_x32(bon);
    if (g == 0) BON[((size_t)dsel * NTOK + tok) * 8 + h] = bon;
}
constexpr int RW_R = 10;
constexpr int RW_OP = 144;
struct RwFrag { bf16x8 a0, a1, r0, r1, tm, bb, bk0, bk1, bk2, bk3; f32x4 g0, g1, g2, g3; u32x2 v; };
__device__ __forceinline__ void rwkv_scan(const Ctx& F, unsigned char* ws, int sidx) {
    const unsigned char* base = ws + WS_RWF + (size_t)sidx * RW_NCHUNK * RWF_CHUNK;
    const int d = sidx & 1, h = (sidx >> 1) & 7, b = sidx >> 4;
    const int sgn = 1 - 2 * d, offA = d * 15, offB = d * 287;
    const int tokA = NLAT + b * CTXL, tokB = b * SEQL - CTXL;
    unsigned char* Yb = ws + WS_RWY + (size_t)d * NTOK * 1024;
    if (F.wave >= 4) {
        const int w = F.wave - 4; const unsigned lo = (unsigned)F.lane * 16u;
#define RW_DMA(ch) do { const int ch_ = (ch) < RW_NCHUNK ? (ch) : RW_NCHUNK - 1; const unsigned char* rec_ = base + (size_t)ch_ * RWF_CHUNK; LAS unsigned char* sl_ = F.lds + ((ch) % RW_R) * RWF_CHUNK; \
        _Pragma("unroll") for (int i_ = 0; i_ < 3; ++i_) __builtin_amdgcn_global_load_lds((const unsigned*)(rec_ + (w + 4 * i_) * 1024 + lo), (LAS unsigned*)(sl_ + (w + 4 * i_) * 1024), 16, 0, 0); \
        if (w == 0) __builtin_amdgcn_global_load_lds((const unsigned*)(rec_ + 12288 + lo), (LAS unsigned*)(sl_ + 12288), 16, 0, 0); } while (0)
#pragma unroll 1
        for (int ch = 0; ch < RW_R - 1; ++ch) RW_DMA(ch);
        asm volatile("s_waitcnt vmcnt(%0)" :: "n"(3 * (RW_R - 3)) : "memory");
        __builtin_amdgcn_s_barrier();
#pragma unroll 1
        for (int c = 0; c <= RW_NCHUNK; ++c) {
            asm volatile("s_waitcnt vmcnt(%0)" :: "n"(3 * (RW_R - 3)) : "memory");
            asm volatile("s_waitcnt lgkmcnt(0)" ::: "memory");
            __builtin_amdgcn_s_barrier();
            if (c < RW_NCHUNK) RW_DMA(c + RW_R - 1);
            if (c > 0 && ((c - 1) & 3) == w) {
                const int cp = c - 1, ci = ((cp) < 16 ? offA : offB) + sgn * cp, tk = ((ci) < 16 ? tokA : tokB) + ci * 16;
                const LAS unsigned char* ot = F.lds + RW_R * RWF_CHUNK + (cp & 1) * (16 * RW_OP) + (F.lane >> 2) * RW_OP + (F.lane & 3) * 16;
                const u32x4 v0 = *(const LAS u32x4*)ot, v1 = *(const LAS u32x4*)(ot + 64);
                unsigned char* yp = Yb + ((size_t)(tk + (F.lane >> 2)) * 512 + h * 64) * 2 + (F.lane & 3) * 16;
                *(u32x4*)yp = v0; *(u32x4*)(yp + 64) = v1; }
        }
        asm volatile("s_waitcnt vmcnt(0)" ::: "memory");
#undef RW_DMA
        return;
    }
    const int n = F.wave, l16 = F.lane & 15, g = F.lane >> 4;
    LAS unsigned char* otw = F.lds + RW_R * RWF_CHUNK + (4 * g) * RW_OP + (16 * n + l16) * 2;
#define RW_LDSF(fr, c) do { LAS unsigned char* sl_ = F.lds + ((c) % RW_R) * RWF_CHUNK; const LAS bf16x8* q_ = (const LAS bf16x8*)sl_ + F.lane; \
        fr.a0 = q_[0]; fr.a1 = q_[64]; fr.r0 = q_[128]; fr.r1 = q_[192]; fr.tm = q_[256]; fr.bb = q_[320]; fr.bk0 = q_[384]; fr.bk1 = q_[448]; fr.bk2 = q_[512]; fr.bk3 = q_[576]; \
        fr.v = *((const LAS u32x2*)(sl_ + 10240) + n * 64 + F.lane); \
        const LAS f32x4* gp_ = (const LAS f32x4*)(sl_ + 12288) + g; fr.g0 = gp_[0]; fr.g1 = gp_[4]; fr.g2 = gp_[8]; fr.g3 = gp_[12]; } while (0)
    f32x4 st0 = {0.f, 0.f, 0.f, 0.f}, st1 = st0, st2 = st0, st3 = st0;
    const f32x4 z4 = {0.f, 0.f, 0.f, 0.f};
#define RW_STEP(fr, c) do { \
        const bf16x8 s0_ = pack8(st0, st1), s1_ = pack8(st2, st3); \
        f32x4 x1_ = __builtin_amdgcn_mfma_f32_16x16x32_bf16(fr.a0, s0_, z4, 0, 0, 0); x1_ = __builtin_amdgcn_mfma_f32_16x16x32_bf16(fr.a1, s1_, x1_, 0, 0, 0); \
        f32x4 x2_ = __builtin_amdgcn_mfma_f32_16x16x32_bf16(fr.r0, s0_, z4, 0, 0, 0); x2_ = __builtin_amdgcn_mfma_f32_16x16x32_bf16(fr.r1, s1_, x2_, 0, 0, 0); \
        union { bf16x8 v; unsigned u[4]; } bx_; bx_.u[0] = pk_bf16(x1_[0], x1_[1]); bx_.u[1] = pk_bf16(x1_[2], x1_[3]); bx_.u[2] = fr.v.x; bx_.u[3] = fr.v.y; \
        const f32x4 e_ = __builtin_amdgcn_mfma_f32_16x16x32_bf16(fr.tm, bx_.v, z4, 0, 0, 0); \
        union { bf16x8 v; unsigned u[4]; } be_; be_.u[0] = pk_bf16(e_[0], e_[1]); be_.u[1] = pk_bf16(e_[2], e_[3]); be_.u[2] = fr.v.x; be_.u[3] = fr.v.y; \
        const f32x4 o_ = __builtin_amdgcn_mfma_f32_16x16x32_bf16(fr.bb, be_.v, x2_, 0, 0, 0); \
        st0 = __builtin_amdgcn_mfma_f32_16x16x32_bf16(fr.bk0, be_.v, st0, 0, 0, 0) * fr.g0; st1 = __builtin_amdgcn_mfma_f32_16x16x32_bf16(fr.bk1, be_.v, st1, 0, 0, 0) * fr.g1; \
        st2 = __builtin_amdgcn_mfma_f32_16x16x32_bf16(fr.bk2, be_.v, st2, 0, 0, 0) * fr.g2; st3 = __builtin_amdgcn_mfma_f32_16x16x32_bf16(fr.bk3, be_.v, st3, 0, 0, 0) * fr.g3; \
        const unsigned p01_ = pk_bf16(o_[0], o_[1]), p23_ = pk_bf16(o_[2], o_[3]); LAS unsigned char* ow_ = otw + ((c) & 1) * (16 * RW_OP); \
        *(LAS bf16_t*)ow_ = (bf16_t)(p01_ & 0xffffu); *(LAS bf16_t*)(ow_ + RW_OP) = (bf16_t)(p01_ >> 16); *(LAS bf16_t*)(ow_ + 2 * RW_OP) = (bf16_t)(p23_ & 0xffffu); *(LAS bf16_t*)(ow_ + 3 * RW_OP) = (bf16_t)(p23_ >> 16); } while (0)
    RwFrag fa, fb;
    __builtin_amdgcn_s_barrier(); asm volatile("" ::: "memory");
    RW_LDSF(fa, 0);
#pragma unroll 1
    for (int c = 0; c < RW_NCHUNK; c += 2) {
        asm volatile("s_waitcnt lgkmcnt(0)" ::: "memory"); __builtin_amdgcn_s_barrier(); asm volatile("" ::: "memory");
        RW_LDSF(fb, c + 1); RW_STEP(fa, c);
        asm volatile("s_waitcnt lgkmcnt(0)" ::: "memory"); __builtin_amdgcn_s_barrier(); asm volatile("" ::: "memory");
        RW_LDSF(fa, c + 2); RW_STEP(fb, c + 1);
    }
    asm volatile("s_waitcnt lgkmcnt(0)" ::: "memory"); __builtin_amdgcn_s_barrier();
#undef RW_LDSF
#undef RW_STEP
}

__device__ __forceinline__ void na_tile(const Ctx& F, unsigned char* ws, const LAS float* sBias, int tile) {
    const bf16_t* QN = (const bf16_t*)(ws + WS_QN); const bf16_t* KN = (const bf16_t*)(ws + WS_KN);
    const bf16_t* VTL = (const bf16_t*)(ws + WS_VTL); const bf16_t* VTC = (const bf16_t*)(ws + WS_VTC); bf16_t* MIX = (bf16_t*)(ws + WS_MIX);
    const int h = F.wave, l16 = F.lane & 15, g = F.lane >> 4;
    const bool lat = tile < 1024;
    int b, r = 0, j = 0, gq;
    if (lat) { b = tile >> 8; r = (tile >> 2) & 63; j = tile & 3; gq = b * SEQL + r * 64 + j * 16 + l16; }
    else { const int tc = tile - 1024; b = tc >> 4; gq = NLAT + b * CTXL + (tc & 15) * 16 + l16; }
    const int row0 = min(max(r - 4, 0), 56), col0 = min(max(16 * j - 8, 0), 32);
    bf16x8 qf0, qf1;
    { const bf16_t* qp = QN + (size_t)gq * 512 + h * 64 + g * 8; qf0 = *(const bf16x8*)qp; qf1 = *(const bf16x8*)(qp + 32); }
    const f32x4 zero4 = {0.f, 0.f, 0.f, 0.f};
    const int cq = 16 * j + l16, win0 = min(max(cq - 8, 0), 48);
    const bf16_t* knb = KN + ((size_t)((((b * 8 + h) * 64 + row0) * 2) * 4 + g) * 64 + col0 + l16) * 8;
    const bf16_t* kcx = KN + (size_t)NLAT * 512 + ((size_t)(((b * 8 + h) * 2) * 4 + g) * 256 + l16) * 8;
    const bf16_t* vnb = VTL + ((size_t)(((b * 8 + h) * 64 + row0) * 12 + col0 / 4 + g) * 64 + l16) * 8;
    const bf16_t* vcx = VTC + ((size_t)(((b * 8 + h) * 8) * 4 + g) * 64 + l16) * 8;
    float mrun = -1e30f, lrun = 0.f;
    f32x4 o[4] = {zero4, zero4, zero4, zero4};
#pragma unroll
    for (int hf = 0; hf < 2; ++hf) {
        if (hf == 0 && !lat) continue;
        bf16x8 fr[32];
#pragma unroll
        for (int T = 0; T < 16; ++T) { const bf16_t* kp = hf == 0 ? knb + (size_t)((T >> 1) * 8) * 512 + (T & 1) * 128 : kcx + T * 128;
            fr[2 * T] = *(const bf16x8*)kp; fr[2 * T + 1] = *(const bf16x8*)(kp + (hf == 0 ? 4 * 512 : 4 * 2048)); }
        asm volatile("" ::: "memory");
        f32x4 acc[16];
#pragma unroll
        for (int T = 0; T < 16; ++T) { f32x4 a = __builtin_amdgcn_mfma_f32_16x16x32_bf16(fr[2 * T], qf0, zero4, 0, 0, 0); a = __builtin_amdgcn_mfma_f32_16x16x32_bf16(fr[2 * T + 1], qf1, a, 0, 0, 0);
            if (hf == 0) { const int ir = T >> 1, hh = T & 1, kr = row0 + ir; const LAS float* bias = sBias + (kr - r + 7) * 31;
#pragma unroll
                for (int e = 0; e < 4; ++e) { const int kc = col0 + 16 * hh + 4 * g + e; const bool ok = (kc >= win0) && (kc < win0 + 16);
                    const int dc = min(max(kc - cq + 15, 0), 30); a[e] = ok ? a[e] + bias[dc] : -1e30f; } }
            acc[T] = a; }
#pragma unroll
        for (int m = 0; m < 8; ++m)
#pragma unroll
            for (int dt = 0; dt < 4; ++dt) fr[4 * m + dt] = *(const bf16x8*)(hf == 0 ? vnb + (size_t)m * 12 * 512 + dt * 128 : vcx + (size_t)m * 4 * 512 + dt * 128);
        asm volatile("" ::: "memory");
        float mx = mrun;
#pragma unroll
        for (int T = 0; T < 16; ++T) mx = fmaxf(fmaxf(fmaxf(acc[T][0], acc[T][1]), fmaxf(acc[T][2], acc[T][3])), mx);
        mx = fmaxf(mx, xor16_f(mx)); mx = max_x32(mx);
        const float alpha = __expf(mrun - mx);
        float lsum = 0.f;
#pragma unroll
        for (int T = 0; T < 16; ++T) {
#pragma unroll
            for (int q = 0; q < 4; ++q) { const float pv = __expf(acc[T][q] - mx); acc[T][q] = pv; lsum += pv; } }
        lsum += xor16_f(lsum); lsum = sum_x32(lsum);
        lrun = lrun * alpha + lsum; mrun = mx;
#pragma unroll
        for (int dt = 0; dt < 4; ++dt) o[dt] = o[dt] * alpha;
#pragma unroll
        for (int m = 0; m < 8; ++m) { const bf16x8 pf = pack8(acc[2 * m], acc[2 * m + 1]);
#pragma unroll
            for (int dt = 0; dt < 4; ++dt) o[dt] = __builtin_amdgcn_mfma_f32_16x16x32_bf16(fr[4 * m + dt], pf, o[dt], 0, 0, 0); }
    }
    const float inv = 1.0f / lrun;
#pragma unroll
    for (int dt = 0; dt < 4; ++dt) { u32x2 w; w.x = pk_bf16(o[dt][0] * inv, o[dt][1] * inv); w.y = pk_bf16(o[dt][2] * inv, o[dt][3] * inv);
        *(u32x2*)(MIX + (size_t)gq * 2048 + 1024 + h * 64 + dt * 16 + 4 * g) = w; }
}
__device__ __forceinline__ void na_phase(const Ctx& F, const LayerW& W, unsigned char* ws, int blk, int nblk, int ntile) {
    LAS float* sBias = (LAS float*)(F.lds + F.wave * 2048);
    __syncthreads();
    for (int idx = F.lane; idx < 465; idx += 64) sBias[idx] = W.rpb[F.wave * 465 + idx];
    asm volatile("" ::: "memory");
    for (int tile = blk; tile < ntile; tile += nblk) na_tile(F, ws, sBias, tile);
}

__device__ __forceinline__ void phase_finish(const Ctx& F, const LayerW& W, unsigned char* ws, const bf16_t* GUPT, int ntok) {
    const bf16_t* P = (const bf16_t*)(ws + WS_P); bf16_t* MIX = (bf16_t*)(ws + WS_MIX);
    const bf16_t* RWY = (const bf16_t*)(ws + WS_RWY); const float* BON = (const float*)(ws + WS_BON); const float* YS = (const float*)(ws + WS_YS);
    const f32x4 z4 = {0.f, 0.f, 0.f, 0.f};
    for (int task = F.bid * 8 + F.wave; task < (ntok / 16) * 8; task += F.G * 8) {
        int ln = F.lane; asm volatile("" : "+v"(ln));
        const int l16 = ln & 15, g = ln >> 4, h = task & 7, tok = (task >> 3) * 16 + l16;
        const bf16_t* Pr = P + (size_t)tok * PTP;
        bf16x8 sg[4];
#pragma unroll
        for (int ks = 0; ks < 4; ++ks) { const u32x4 q = *(const u32x4*)(Pr + B_GD + 32 * ks + 8 * g); union { bf16x8 v; unsigned u[4]; } s;
#pragma unroll
            for (int e = 0; e < 4; ++e) s.u[e] = pk_bf16(sigmoidf_(bflo(q[e])), sigmoidf_(bfhi(q[e])));
            sg[ks] = s.v; }
        f32x4 y[4]; float s1 = 0.f;
#pragma unroll
        for (int m = 0; m < 4; ++m) { const int co = h * 64 + 16 * m + 4 * g;
            const u32x2 a = *(const u32x2*)(RWY + (size_t)tok * 512 + co), bq = *(const u32x2*)(RWY + ((size_t)NTOK + tok) * 512 + co);
            y[m] = (f32x4){bflo(a.x) + bflo(bq.x), bfhi(a.x) + bfhi(bq.x), bflo(a.y) + bflo(bq.y), bfhi(a.y) + bfhi(bq.y)};
            s1 += (y[m][0] + y[m][1]) + (y[m][2] + y[m][3]); }
        s1 += xor16_f(s1); s1 = sum_x32(s1);
        const float mu = s1 * (1.f / 64.f); float s2 = 0.f;
#pragma unroll
        for (int m = 0; m < 4; ++m) { y[m] = y[m] - mu; s2 += (y[m][0] * y[m][0] + y[m][1] * y[m][1]) + (y[m][2] * y[m][2] + y[m][3] * y[m][3]); }
        s2 += xor16_f(s2); s2 = sum_x32(s2);
        const float rs = rsqrtf(s2 * (1.f / 64.f) + 64e-5f);
        const float bon = BON[(size_t)tok * 8 + h] + BON[((size_t)NTOK + tok) * 8 + h];
#pragma unroll
        for (int m = 0; m < 4; ++m) { const int co = h * 64 + 16 * m + 4 * g;
            f32x4 ga = z4;
#pragma unroll
            for (int ks = 0; ks < 4; ++ks) ga = __builtin_amdgcn_mfma_f32_16x16x32_bf16(*(const bf16x8*)(GUPT + (size_t)(h * 64 + 16 * m + l16) * 128 + 32 * ks + 8 * g), sg[ks], ga, 0, 0, 0);
            const float4 lw = *(const float4*)(W.rw_lnw + co), lb = *(const float4*)(W.rw_lnb + co); const u32x2 vq = *(const u32x2*)(Pr + B_V + co);
            const float o0 = (y[m][0] * rs * lw.x + lb.x + bon * bflo(vq.x)) * ga[0], o1 = (y[m][1] * rs * lw.y + lb.y + bon * bfhi(vq.x)) * ga[1];
            const float o2 = (y[m][2] * rs * lw.z + lb.z + bon * bflo(vq.y)) * ga[2], o3 = (y[m][3] * rs * lw.w + lb.w + bon * bfhi(vq.y)) * ga[3];
            u32x2 o; o.x = pk_bf16(o0, o1); o.y = pk_bf16(o2, o3);
            *(u32x2*)(MIX + (size_t)tok * 2048 + 512 + co) = o; }
    }
    for (int tok = F.bid * 8 + F.wave; tok < ntok; tok += F.G * 8) {
        const int c0 = F.lane * 8;
        float ys[8], z[8], gw[8];
        load8f(YS + (size_t)tok * 512 + c0, ys); unpack8(*(const u32x4*)(P + (size_t)tok * PTP + D_Z + c0), z); load8f(W.s_norm + c0, gw);
        float ss = 0.f;
#pragma unroll
        for (int e = 0; e < 8; ++e) { ys[e] *= siluf_(z[e]); ss += ys[e] * ys[e]; }
        ss = wave_sum(ss);
        const float rs = rsqrtf(ss * (1.f / 512.f) + 1e-6f);
#pragma unroll
        for (int e = 0; e < 8; ++e) ys[e] = ys[e] * rs * gw[e];
        *(u32x4*)(MIX + (size_t)tok * 2048 + 1536 + c0) = pack8f(ys);
    }
}

constexpr int RADIX_LOW_BIT = 10;
constexpr int RADIX_STEPS = 14;
__device__ __forceinline__ unsigned ordkey(float x) { const unsigned u = __float_as_uint(x); return (u & 0x80000000u) ? ~u : (u | 0x80000000u); }
template <int CTRL> __device__ __forceinline__ int dpp_i0(int v) { return __builtin_amdgcn_update_dpp(0, v, CTRL, 0xF, 0xF, true); }
__device__ __forceinline__ int rowscan_incl(int x) { x += dpp_i0<0x111>(x); x += dpp_i0<0x112>(x); x += dpp_i0<0x114>(x); x += dpp_i0<0x118>(x); return x; }
__device__ __forceinline__ void phase_scores(const Ctx& F, unsigned char* ws, int layer, int ntok) {
    const bf16_t* Q = (const bf16_t*)(ws + WS_P); const bf16_t* KEYS = (const bf16_t*)(ws + WS_KEYS) + (size_t)layer * 8 * 2 * 128 * 128;
    int* IDS = (int*)(ws + WS_IDS); float* GATES = (float*)(ws + WS_GATES);
    LAS bf16_t* sK = (LAS bf16_t*)F.lds;
    LAS float* sVv = (LAS float*)(F.lds + 2 * 128 * 136 * 2 + F.wave * 5120);
    LAS int* sVi = (LAS int*)(sVv + 512);
    const int ntg = ntok / 128, ntask = 8 * ntg;
    const int l16 = F.lane & 15, g = F.lane >> 4;
    const f32x4 z4 = {0.f, 0.f, 0.f, 0.f};
    int cur_h = -1;
    for (int task = F.bid; task < ntask; task += F.G) {
        const int h = task / ntg, tg = task % ntg;
        if (h != cur_h) { __syncthreads();
#pragma unroll
            for (int q = 0; q < 8; ++q) { const int v = F.tid + 512 * q, row = v >> 4, part = v & 15;
                *(LAS u32x4*)(sK + row * 136 + part * 8) = *(const u32x4*)(KEYS + ((size_t)h * 256 + row) * 128 + part * 8); }
            cur_h = h; __syncthreads(); }
        const int t0 = tg * 128 + F.wave * 16;
#pragma unroll 1
        for (int p = 0; p < 2; ++p) {
            bf16x8 qf[4];
#pragma unroll
            for (int ks = 0; ks < 4; ++ks) qf[ks] = *(const bf16x8*)(Q + (size_t)(t0 + l16) * 2048 + h * 256 + p * 128 + 32 * ks + 8 * g);
            f32x4 acc[8];
#pragma unroll
            for (int kt = 0; kt < 8; ++kt) { f32x4 a = z4;
#pragma unroll
                for (int ks = 0; ks < 4; ++ks) a = __builtin_amdgcn_mfma_f32_16x16x32_bf16(qf[ks], *(const LAS bf16x8*)(sK + (p * 128 + 16 * kt + l16) * 136 + 32 * ks + 8 * g), a, 0, 0, 0);
                acc[kt] = a; }
            float lo0, lo1, lo2, lo3, hi0, hi1, hi2, hi3;
            { float m0 = acc[0][0], m1 = acc[0][1], m2 = acc[0][2], m3 = acc[0][3];
#pragma unroll
              for (int kt = 1; kt < 8; ++kt) { m0 = fmaxf(m0, acc[kt][0]); m1 = fmaxf(m1, acc[kt][1]); m2 = fmaxf(m2, acc[kt][2]); m3 = fmaxf(m3, acc[kt][3]); }
              hi0 = max16(m0); hi1 = max16(m1); hi2 = max16(m2); hi3 = max16(m3);
              lo0 = -max16(-m0); lo1 = -max16(-m1); lo2 = -max16(-m2); lo3 = -max16(-m3); }
#pragma unroll 1
            for (int it = 0; it < RADIX_STEPS; ++it) {
                const float c0 = 0.5f * (lo0 + hi0), c1 = 0.5f * (lo1 + hi1), c2 = 0.5f * (lo2 + hi2), c3 = 0.5f * (lo3 + hi3); int n0 = 0, n1 = 0, n2 = 0, n3 = 0;
#pragma unroll
                for (int kt = 0; kt < 8; ++kt) { n0 += acc[kt][0] >= c0; n1 += acc[kt][1] >= c1; n2 += acc[kt][2] >= c2; n3 += acc[kt][3] >= c3; }
                const bool k0 = sum16((float)n0) >= 16.f, k1 = sum16((float)n1) >= 16.f, k2 = sum16((float)n2) >= 16.f, k3 = sum16((float)n3) >= 16.f;
                lo0 = k0 ? c0 : lo0; hi0 = k0 ? hi0 : c0; lo1 = k1 ? c1 : lo1; hi1 = k1 ? hi1 : c1; lo2 = k2 ? c2 : lo2; hi2 = k2 ? hi2 : c2; lo3 = k3 ? c3 : lo3; hi3 = k3 ? hi3 : c3; }
#pragma unroll
            for (int r = 0; r < 4; ++r) { const float T = r == 0 ? lo0 : (r == 1 ? lo1 : (r == 2 ? lo2 : lo3));
                int cl = 0;
#pragma unroll
                for (int kt = 0; kt < 8; ++kt) cl += acc[kt][r] >= T;
                int rank = rowscan_incl(cl) - cl;
                LAS float* dv = sVv + ((4 * g + r) * 2 + p) * 16; LAS int* di = sVi + ((4 * g + r) * 2 + p) * 16;
#pragma unroll
                for (int kt = 0; kt < 8; ++kt) { const bool sel = acc[kt][r] >= T;
                    if (sel && rank < 16) { dv[rank] = acc[kt][r]; di[rank] = 16 * kt + l16; }
                    rank += sel ? 1 : 0; } }
        }
        asm volatile("" ::: "memory");
#pragma unroll 1
        for (int r = 0; r < 4; ++r) { const int tk = 4 * g + r;
            LAS float* sS = (LAS float*)(sVi + 512);
            LAS int* sI = (LAS int*)(sS + 128);
#pragma unroll
            for (int p = 0; p < 2; ++p) { const float v = sVv[(tk * 2 + p) * 16 + l16]; const int ix = sVi[(tk * 2 + p) * 16 + l16];
                const unsigned key = (ordkey(v) & ~15u) | (unsigned)(15 - l16); int rk = 0;
#pragma unroll
                for (int q = 0; q < 4; ++q) { const f32x4 o = *(const LAS f32x4*)(sVv + (tk * 2 + p) * 16 + 4 * q);
#pragma unroll
                    for (int e = 0; e < 4; ++e) rk += ((ordkey(o[e]) & ~15u) | (unsigned)(15 - (4 * q + e))) > key; }
                sS[(g * 2 + p) * 16 + rk] = v; sI[(g * 2 + p) * 16 + rk] = ix; }
            asm volatile("" ::: "memory");
            float cv[4]; int pi[4], pj[4];
#pragma unroll
            for (int q = 0; q < 4; ++q) { const int e = l16 + 16 * q; int i, j;
                if (e < 16) { i = 0; j = e; } else if (e < 24) { i = 1; j = e - 16; } else if (e < 29) { i = 2; j = e - 24; } else if (e < 33) { i = 3; j = e - 29; }
                else if (e < 36) { i = 4; j = e - 33; } else if (e < 42) { i = 5 + ((e - 36) >> 1); j = (e - 36) & 1; } else { i = 8 + (e - 42); j = 0; }
                const bool ok = e < 50; i = ok ? i : 15; j = ok ? j : 15;
                pi[q] = i; pj[q] = j; cv[q] = ok ? sS[(g * 2) * 16 + i] + sS[(g * 2 + 1) * 16 + j] : -3.0e38f; }
            float lo = sS[(g * 2) * 16 + 15] + sS[(g * 2 + 1) * 16], hi = sS[(g * 2) * 16] + sS[(g * 2 + 1) * 16];
            const float mx = hi;
#pragma unroll 1
            for (int it = 0; it < RADIX_STEPS; ++it) { const float cm = 0.5f * (lo + hi); int n = 0;
#pragma unroll
                for (int q = 0; q < 4; ++q) n += cv[q] >= cm;
                const bool kk = sum16((float)n) >= 16.f; lo = kk ? cm : lo; hi = kk ? hi : cm; }
            int cl = 0; float es = 0.f;
#pragma unroll
            for (int q = 0; q < 4; ++q) { const bool sel = cv[q] >= lo; cl += sel; es += sel ? __expf(cv[q] - mx) : 0.f; }
            int rank = rowscan_incl(cl) - cl;
            const float einv = 1.0f / sum16(es);
            const size_t ob = (size_t)(t0 + tk) * 128 + h * 16;
#pragma unroll
            for (int q = 0; q < 4; ++q) { const bool sel = cv[q] >= lo;
                if (sel && rank < 16) { IDS[ob + rank] = sI[(g * 2) * 16 + pi[q]] * 128 + sI[(g * 2 + 1) * 16 + pj[q]]; GATES[ob + rank] = __expf(cv[q] - mx) * einv; }
                rank += sel ? 1 : 0; }
            asm volatile("" ::: "memory");
        }
        asm volatile("" ::: "memory");
    }
}

struct XInfo { int xi, nx, rank, nloc; };
__device__ __forceinline__ void fp8x16_to_f32(const u32x4 q, float (&f)[16]) {
#pragma unroll
    for (int w = 0; w < 4; ++w) { const auto a = __builtin_amdgcn_cvt_pk_f32_fp8((int)q[w], false); const auto b = __builtin_amdgcn_cvt_pk_f32_fp8((int)q[w], true);
        f[4 * w] = a[0]; f[4 * w + 1] = a[1]; f[4 * w + 2] = b[0]; f[4 * w + 3] = b[1]; }
}
typedef long i64_t;
template <int IDMASK> __device__ __forceinline__ void phase_experts_u(const Ctx& F, unsigned char* ws, int layer, int ntok, const XInfo X, float* PART) {
    const bf16_t* H = (const bf16_t*)(ws + WS_XN); const unsigned char* PU8 = ws + WS_PU + (size_t)layer * 16384 * 2048;
    const int* IDS = (const int*)(ws + WS_IDS);
    const int e8 = F.lane >> 3, c = F.lane & 7, l16 = F.lane & 15, g = F.lane >> 4;
    const int tfirst = X.rank * 8 + F.wave, tstride = X.nloc * 8;
    const int nk = tfirst < ntok ? (ntok - tfirst + tstride - 1) / tstride : 0;
    const f32x4 z4 = {0.f, 0.f, 0.f, 0.f};
    LAS unsigned char* buf = F.lds + F.wave * 12288; LAS float* res = (LAS float*)(buf + 8192);
    const int woff = e8 * 128 + c * 16;
    const int srcoff = 16 * (c ^ e8);
    const int roff0 = l16 * 128 + (((2 * g) ^ (l16 & 7)) * 16), roff1 = l16 * 128 + (((2 * g + 1) ^ (l16 & 7)) * 16);
#define EU_TOK(k) (tfirst + min((k), nk - 1) * tstride)
#define EU_LOADI(I, k) do { const int* ip_ = IDS + (size_t)EU_TOK(k) * 128 + e8; _Pragma("unroll") for (int q_ = 0; q_ < 16; ++q_) I[q_] = ip_[8 * q_]; } while (0)
#define EU_LOADX(HX, k) do { const u32x4* hp_ = (const u32x4*)(H + (size_t)EU_TOK(k) * 2048 + s * 128 + 32 * g); HX[0] = hp_[0]; HX[1] = hp_[1]; HX[2] = hp_[2]; HX[3] = hp_[3]; } while (0)
#define EU_ISSUE(Q, I, hf) do { const unsigned char* sb_ = PU8 + (size_t)s * 16384 * 128; _Pragma("unroll") for (int i_ = 0; i_ < 8; ++i_) Q[i_] = *(const u32x4*)(sb_ + (unsigned)(I[(hf) * 8 + i_] * 128 + srcoff)); } while (0)
#define EU_CONSUME(Q, hf, slot) do { _Pragma("unroll") for (int i_ = 0; i_ < 8; ++i_) *(LAS u32x4*)(buf + i_ * 1024 + woff) = Q[i_]; \
        asm volatile("" ::: "memory"); \
        u32x4 p0_[4], p1_[4]; f32x4 a_[4]; \
        _Pragma("unroll") for (int q_ = 0; q_ < 4; ++q_) { p0_[q_] = *(const LAS u32x4*)(buf + q_ * 2048 + roff0); p1_[q_] = *(const LAS u32x4*)(buf + q_ * 2048 + roff1); a_[q_] = z4; } \
          \
        _Pragma("unroll") for (int q_ = 0; q_ < 4; ++q_) a_[q_] = __builtin_amdgcn_mfma_f32_16x16x32_fp8_fp8(((i64_t)p0_[q_][1] << 32) | (i64_t)p0_[q_][0], hb[0], a_[q_], 0, 0, 0); \
        _Pragma("unroll") for (int q_ = 0; q_ < 4; ++q_) a_[q_] = __builtin_amdgcn_mfma_f32_16x16x32_fp8_fp8(((i64_t)p0_[q_][3] << 32) | (i64_t)p0_[q_][2], hb[1], a_[q_], 0, 0, 0); \
        _Pragma("unroll") for (int q_ = 0; q_ < 4; ++q_) a_[q_] = __builtin_amdgcn_mfma_f32_16x16x32_fp8_fp8(((i64_t)p1_[q_][1] << 32) | (i64_t)p1_[q_][0], hb[2], a_[q_], 0, 0, 0); \
        _Pragma("unroll") for (int q_ = 0; q_ < 4; ++q_) a_[q_] = __builtin_amdgcn_mfma_f32_16x16x32_fp8_fp8(((i64_t)p1_[q_][3] << 32) | (i64_t)p1_[q_][2], hb[3], a_[q_], 0, 0, 0); \
        _Pragma("unroll") for (int q_ = 0; q_ < 4; ++q_) if (l16 == (hf) * 4 + q_) *(LAS f32x4*)(res + (slot) * 128 + 16 * ((hf) * 4 + q_) + 4 * g) = a_[q_]; \
        asm volatile("" ::: "memory"); } while (0)
    for (int s = X.xi; s < 16; s += X.nx) {
        if (nk == 0) continue;
        int id[2][16]; u32x4 hx[2][4]; u32x4 qa[8], qb[8];
        EU_LOADI(id[0], 0); EU_LOADX(hx[0], 0); EU_ISSUE(qa, id[0], 0); EU_ISSUE(qb, id[0], 1);
        EU_LOADI(id[1], 1);
        for (int k0 = 0; k0 < nk; k0 += 8) {
#pragma unroll
            for (int j = 0; j < 8; ++j) { const int k = k0 + j;
                i64_t hb[4];
#pragma unroll
                for (int m = 0; m < 4; ++m) { const u32x4 v = hx[j & 1][m];
                    int lo = __builtin_amdgcn_cvt_pk_fp8_f32(bflo(v[0]), bfhi(v[0]), 0, false); lo = __builtin_amdgcn_cvt_pk_fp8_f32(bflo(v[1]), bfhi(v[1]), lo, true);
                    int hi = __builtin_amdgcn_cvt_pk_fp8_f32(bflo(v[2]), bfhi(v[2]), 0, false); hi = __builtin_amdgcn_cvt_pk_fp8_f32(bflo(v[3]), bfhi(v[3]), hi, true);
                    hb[m] = ((i64_t)(unsigned)hi << 32) | (i64_t)(unsigned)lo; }
                EU_LOADX(hx[(j + 1) & 1], k + 1);
                EU_LOADI(id[j & 1], k + 2);
                EU_CONSUME(qa, 0, j);
                EU_ISSUE(qa, id[(j + 1) & 1], 0);
                EU_CONSUME(qb, 1, j);
                EU_ISSUE(qb, id[(j + 1) & 1], 1);
            }
            { const int u = F.lane >> 3, jj = F.lane & 7, ku = k0 + u;
              if (ku < nk) { float* dst = PART + ((size_t)s * NTOK + tfirst + ku * tstride) * 128 + 16 * jj;
#pragma unroll
                  for (int w = 0; w < 4; ++w) *(f32x4*)(dst + 4 * w) = *(const LAS f32x4*)(res + u * 128 + 16 * jj + 4 * w); }
              asm volatile("" ::: "memory"); }
        }
    }
#undef EU_TOK
#undef EU_LOADI
#undef EU_LOADX
#undef EU_ISSUE
#undef EU_CONSUME
}
__device__ __forceinline__ void phase_experts_combine(const Ctx& F, unsigned char* ws, int ntok) {
    const float* PART = (const float*)(ws + WS_PART); float* GATES = (float*)(ws + WS_GATES);
    for (int idx = F.bid * 512 + F.tid; idx < ntok * 32; idx += F.G * 512) {
        float4 a = make_float4(0.f, 0.f, 0.f, 0.f);
#pragma unroll
        for (int s = 0; s < 16; ++s) { const float4 v = *(const float4*)(PART + (size_t)s * NTOK * 128 + (size_t)idx * 4); a.x += v.x; a.y += v.y; a.z += v.z; a.w += v.w; }
        float4 g = *(const float4*)(GATES + (size_t)idx * 4);
        g.x *= geluf_(a.x * (1.0f / PEER_U_SCALE)); g.y *= geluf_(a.y * (1.0f / PEER_U_SCALE)); g.z *= geluf_(a.z * (1.0f / PEER_U_SCALE)); g.w *= geluf_(a.w * (1.0f / PEER_U_SCALE));
        *(float4*)(GATES + (size_t)idx * 4) = g;
    }
}
__device__ __forceinline__ void phase_experts_v(const Ctx& F, unsigned char* ws, float* out, float* CTXS, int layer, int ntok, const XInfo X) {
    const unsigned char* PV8 = ws + WS_PV + (size_t)layer * 16384 * 2048;
    const int* IDS = (const int*)(ws + WS_IDS); const float* COEF = (const float*)(ws + WS_GATES); const float* MOD = (const float*)(ws + WS_MOD);
    const int e8 = F.lane >> 3, c = F.lane & 7;
    const int tfirst = X.rank * 8 + F.wave, tstride = X.nloc * 8;
    const int nk = tfirst < ntok ? (ntok - tfirst + tstride - 1) / tstride : 0;
    LAS float* res = (LAS float*)(F.lds + F.wave * 4096);
#define EV_TOK(k) (tfirst + min((k), nk - 1) * tstride)
#define EV_LOADI(I, k) do { I[0] = *((const u32x4*)(IDS + (size_t)EV_TOK(k) * 128 + e8 * 16) + (c & 3)); } while (0)
#define EV_LOADC(C, k) do { C[0] = *((const u32x4*)(COEF + (size_t)EV_TOK(k) * 128 + e8 * 16) + (c & 3)); } while (0)
#define EV_QUAD(V) do { const u32x4 own_ = V[0];   \
        _Pragma("unroll") for (int w_ = 0; w_ < 4; ++w_) { V[0][w_] = (unsigned)__builtin_amdgcn_update_dpp(0, (int)own_[w_], 0x00, 0xF, 0xF, true); V[1][w_] = (unsigned)__builtin_amdgcn_update_dpp(0, (int)own_[w_], 0x55, 0xF, 0xF, true); \
            V[2][w_] = (unsigned)__builtin_amdgcn_update_dpp(0, (int)own_[w_], 0xAA, 0xF, 0xF, true); V[3][w_] = (unsigned)__builtin_amdgcn_update_dpp(0, (int)own_[w_], 0xFF, 0xF, 0xF, true); } } while (0)
#define EV_ROW(id) (*(const u32x4*)(PV8 + (size_t)s * 16384 * 128 + (unsigned)((id) * 128 + c * 16)))
#define EV_ISSUE(Q, I, hf) do { _Pragma("unroll") for (int i_ = 0; i_ < 8; ++i_) Q[i_] = EV_ROW(I[(hf) * 2 + (i_ >> 2)][i_ & 3]); } while (0)
#define EV_HALF(Q, C, hf) do { _Pragma("unroll") for (int i_ = 0; i_ < 8; ++i_) { const float cf_ = __uint_as_float(C[(hf) * 2 + (i_ >> 2)][i_ & 3]); const f32x2_t c2_ = {cf_, cf_}; \
            _Pragma("unroll") for (int w_ = 0; w_ < 4; ++w_) { const f32x2_t lo_ = __builtin_amdgcn_cvt_pk_f32_fp8((int)Q[i_][w_], false), hi_ = __builtin_amdgcn_cvt_pk_f32_fp8((int)Q[i_][w_], true); \
                ac2[2 * w_] = lo_ * c2_ + ac2[2 * w_]; ac2[2 * w_ + 1] = hi_ * c2_ + ac2[2 * w_ + 1]; } } } while (0)
    for (int s = X.xi; s < 16; s += X.nx) {
        if (nk == 0) continue;
        u32x4 id[2][4], cf[2][4]; u32x4 qa[8], qb[8];
        EV_LOADI(id[0], 0); EV_LOADC(cf[0], 0); EV_QUAD(id[0]); EV_ISSUE(qa, id[0], 0); EV_ISSUE(qb, id[0], 1);
        EV_LOADI(id[1], 1);
        for (int k0 = 0; k0 < nk; k0 += 8) {
#pragma unroll
            for (int j = 0; j < 8; ++j) { const int k = k0 + j;
                f32x2_t ac2[8];
#pragma unroll
                for (int e = 0; e < 8; ++e) ac2[e] = (f32x2_t){0.f, 0.f};
                EV_QUAD(cf[j & 1]);
                EV_QUAD(id[(j + 1) & 1]);
                EV_LOADC(cf[(j + 1) & 1], k + 1);
                EV_HALF(qa, cf[j & 1], 0);
                EV_ISSUE(qa, id[(j + 1) & 1], 0);
                EV_HALF(qb, cf[j & 1], 1);
                EV_ISSUE(qb, id[(j + 1) & 1], 1);
                EV_LOADI(id[j & 1], k + 2);
                float acc[16];
#pragma unroll
                for (int e = 0; e < 8; ++e) { acc[2 * e] = ac2[e][0]; acc[2 * e + 1] = ac2[e][1]; }
#pragma unroll
                for (int e = 0; e < 16; ++e) { float v = acc[e]; v += dpp_f<0x128>(v); v += xor16_f(v); acc[e] = sum_x32(v); }
                if (e8 == 0) {
#pragma unroll
                    for (int w = 0; w < 4; ++w) *(LAS f32x4*)(res + j * 128 + c * 16 + 4 * w) = (f32x4){acc[4 * w], acc[4 * w + 1], acc[4 * w + 2], acc[4 * w + 3]}; }
                asm volatile("" ::: "memory");
            }
            { const int u = F.lane >> 3, jj = F.lane & 7, ku = k0 + u;
              if (ku < nk) { const int tu = tfirst + ku * tstride;
                  const bool isctx = tu >= NLAT; const int vv = isctx ? 4 : (tu >> 12);
                  float* xr = (isctx ? CTXS + (size_t)(tu - NLAT) * 2048 : out + (size_t)tu * 2048) + s * 128 + jj * 16;
                  const float* m5 = MOD + ((size_t)layer * 5 + vv) * 12288 + 5 * 2048 + s * 128 + jj * 16;
#pragma unroll
                  for (int w = 0; w < 4; ++w) { float4 x = *(const float4*)(xr + 4 * w); const float4 m = *(const float4*)(m5 + 4 * w); const f32x4 a = *(const LAS f32x4*)(res + u * 128 + jj * 16 + 4 * w);
                      x.x += m.x * a[0]; x.y += m.y * a[1]; x.z += m.z * a[2]; x.w += m.w * a[3]; *(float4*)(xr + 4 * w) = x; } }
              asm volatile("" ::: "memory"); }
        }
    }
#undef EV_TOK
#undef EV_LOADI
#undef EV_LOADC
#undef EV_QUAD
#undef EV_ROW
#undef EV_ISSUE
#undef EV_HALF
}

struct Params { const float* in[N_IN]; float* out; unsigned char* ws; };

__device__ __forceinline__ LayerW make_w(ka_t in, int l) {
    LayerW W;
    W.sc_w = in[I_SCW] + (size_t)l * 3 * 512; W.rw_w0 = in[I_RW0] + (size_t)l * 2 * 512; W.rw_wup = in[I_RWUP] + (size_t)l * 2 * 64 * 512;
    W.rw_a0 = in[I_RA0] + (size_t)l * 2 * 512; W.rw_aup = in[I_RAUP] + (size_t)l * 2 * 64 * 512; W.rw_gup = in[I_RGUP] + (size_t)l * 128 * 512;
    W.rw_kk = in[I_RKK] + (size_t)l * 512; W.rw_ka = in[I_RKA] + (size_t)l * 512; W.rw_rk = in[I_RRK] + (size_t)l * 512;
    W.rw_lnw = in[I_RLNW] + (size_t)l * 512; W.rw_lnb = in[I_RLNB] + (size_t)l * 512;
    W.na_q = in[I_NAQ] + (size_t)l * 64; W.na_k = in[I_NAK] + (size_t)l * 64; W.rpb = in[I_RPB] + (size_t)l * 8 * 15 * 31;
    W.s_cw = in[I_SCONVW] + (size_t)l * 3 * 1024; W.s_cb = in[I_SCONVB] + (size_t)l * 1024; W.s_dtb = in[I_SDTB] + (size_t)l * 16; W.s_alog = in[I_SALOG] + (size_t)l * 16;
    W.s_d = in[I_SD] + (size_t)l * 8; W.s_norm = in[I_SNORM] + (size_t)l * 512;
    return W;
}

__global__ void __launch_bounds__(512, 2) hybrid_fwd(Params p) {
    extern __shared__ __attribute__((aligned(16))) unsigned char shm[];
    Ctx F; F.lds = (LAS unsigned char*)shm; F.tid = threadIdx.x; F.lane = F.tid & 63; F.wave = __builtin_amdgcn_readfirstlane(F.tid >> 6); F.bid = blockIdx.x; F.G = gridDim.x;
    volatile LAS unsigned* bst = (volatile LAS unsigned*)(F.lds + LDS_BAR_OFF);
    if (F.tid < 4) bst[F.tid] = 0u;
    __syncthreads();
    (void)xcd_barrier_post((unsigned*)(p.ws + WS_CTL), bst);
    volatile LAS int* lxi = (volatile LAS int*)(F.lds + LDS_XI_OFF);
    if (F.tid == 0) lxi[2] = (int)xb_add((unsigned*)(p.ws + WS_CTL) + CTL_TICKET + 64 * xb_xcc_id(), 1u);
#define RPT_PHASE(id, ...) do { __VA_ARGS__ if (RPT == (id)) { GRID_BAR(); PH_BEGIN(); __VA_ARGS__ } } while (0)
#define GRID_BAR() do { ka_t kb_ = (ka_t)__builtin_amdgcn_kernarg_segment_ptr(); asm volatile("" : "+s"(kb_)); unsigned xx_ = xb_xcc_id(); asm volatile("" : "+s"(xx_)); \
        XcdBarrier b_; b_.bar = (unsigned*)((unsigned char*)kb_[N_IN + 1] + WS_CTL); b_.x = xx_; b_.st = (volatile LAS unsigned*)(F.lds + LDS_BAR_OFF); xcd_barrier(b_); } while (0)
    ka_t in; unsigned char* ws; float* out;
#define PH_BEGIN() do { int t_ = threadIdx.x; asm volatile("; PHASE_MARK" : "+v"(t_)); F.tid = t_; F.lane = t_ & 63; F.wave = __builtin_amdgcn_readfirstlane(t_ >> 6); \
        int b_ = blockIdx.x, g_ = gridDim.x; asm volatile("" : "+s"(b_), "+s"(g_)); F.bid = b_; F.G = g_; \
        ka_t k_ = (ka_t)__builtin_amdgcn_kernarg_segment_ptr(); asm volatile("" : "+s"(k_)); in = k_; \
        out = (float*)in[N_IN]; ws = (unsigned char*)in[N_IN + 1]; } while (0)

    PH_BEGIN();
    RPT_PHASE(1, phase_prologue(F, in, ws););
    GRID_BAR();
    if (F.tid == 0) {
        const unsigned* bw = (const unsigned*)(ws + WS_CTL); const unsigned myx = xb_xcc_id(); int xi = 0, nx = 0, nloc = 1;
        for (unsigned j = 0; j < 16; ++j) { const unsigned cnt = xb_ld((unsigned*)&bw[XB_XCNT(j)]); if (cnt > 0u) { if (j < myx) ++xi; ++nx; } if (j == myx) nloc = (int)cnt; }
        lxi[0] = xi; lxi[1] = nx > 0 ? nx : 1; lxi[3] = nloc > 0 ? nloc : 1; }
    __syncthreads();
    PH_BEGIN();
    phase_modreduce(F, in[I_BADA], (const float*)(ws + WS_MODP), (float*)(ws + WS_MOD));
    GRID_BAR();

#pragma unroll 1
    for (int l = 0; l < 2; ++l) {
        const int M = (l == 0) ? NTOK : NLAT;
        if (l == 0) { PH_BEGIN(); phase_norm(F, in[I_X], in[I_CTX], in[I_NMIX], (const float*)(ws + WS_MOD), 0, 1, (bf16_t*)(ws + WS_XN), NTOK); GRID_BAR(); }

        PH_BEGIN();
        RPT_PHASE(2, { pg8::Gemm g{(const bf16_t*)(ws + WS_XN), (const bf16_t*)(ws + WS_WIN) + (size_t)l * PTP * 2048, NTOK, PTP, 2048}; pg8::StaticOrder S; S.init(NTOK, PTP, F.G, F.bid);
          pg8::EpiBf16 E{(bf16_t*)(ws + WS_P), PTP}; pg8::gemm_phase<pg8::EpiBf16, pg8::StaticOrder>(F.lds, g, S, E, F.tid); });
        GRID_BAR();

        PH_BEGIN();
        { const LayerW W = make_w(in, l); phase_prep(F, W, ws);
            if (RPT == 31) phase_prep(F, W, ws);
            const bf16_t* WUPT = (const bf16_t*)(ws + WS_WUPT) + (size_t)l * 4 * 512 * 64;
            for (int rep = 0; rep < (RPT == 32 ? 2 : 1); ++rep) {
            for (int task = F.bid * 8 + F.wave; task < 4 * 8 * RW_NCHUNK; task += F.G * 8) rwkv_pre_task(F, W, ws, WUPT, task, 0);
            for (int task = F.bid * 8 + F.wave; task < 4 * 8 * RW_NCHUNK; task += F.G * 8) rwkv_pre_task(F, W, ws, WUPT, task, 1); } }
        GRID_BAR();

        PH_BEGIN();
        RPT_PHASE(4, { const LayerW W = make_w(in, l); for (int task = F.bid; task < 4 * 8 * NCH; task += F.G) ssd_task<false>(F, W, ws, task); });
        GRID_BAR();
        PH_BEGIN();
        phase_ssd_combine(F, ws);
        GRID_BAR();

        PH_BEGIN();
        { const int ntile = (l == 0) ? 1088 : 1024, nscan = 64 * 3;
          int nfirst, nstride, nend;
          if (F.bid < 64) { rwkv_scan(F, ws, F.bid); nfirst = ntile - nscan + F.bid; nstride = 64; nend = ntile; }
          else { const LayerW W = make_w(in, l); const int blk = F.bid - 64, nblk = F.G - 64;
            for (int task = blk; task < 4 * 8 * NCH; task += nblk) ssd_task<true>(F, W, ws, task);
            nfirst = blk; nstride = nblk; nend = ntile - nscan; }
          PH_BEGIN();
          { const LayerW W = make_w(in, l); na_phase(F, W, ws, nfirst, nstride, nend); } }
        if (RPT == 5) { GRID_BAR(); PH_BEGIN(); const int ntile = (l == 0) ? 1088 : 1024, nscan = 64 * 3; int nfirst, nstride, nend;
          if (F.bid < 64) { rwkv_scan(F, ws, F.bid); nfirst = ntile - nscan + F.bid; nstride = 64; nend = ntile; }
          else { const LayerW W = make_w(in, l); const int blk = F.bid - 64, nblk = F.G - 64;
            for (int task = blk; task < 4 * 8 * NCH; task += nblk) ssd_task<true>(F, W, ws, task);
            nfirst = blk; nstride = nblk; nend = ntile - nscan; }
          PH_BEGIN();
          { const LayerW W = make_w(in, l); na_phase(F, W, ws, nfirst, nstride, nend); } }
        if (RPT == 51) { GRID_BAR(); PH_BEGIN(); if (F.bid < 64) rwkv_scan(F, ws, F.bid); }
        if (RPT == 52) { GRID_BAR(); PH_BEGIN(); if (F.bid >= 64) { const LayerW W = make_w(in, l); const int blk = F.bid - 64, nblk = F.G - 64;
            for (int task = blk; task < 4 * 8 * NCH; task += nblk) ssd_task<true>(F, W, ws, task); } }
        if (RPT == 53) { GRID_BAR(); PH_BEGIN(); if (F.bid >= 64) { const LayerW W = make_w(in, l); const int blk = F.bid - 64, nblk = F.G - 64;
            na_phase(F, W, ws, blk, nblk, (l == 0) ? 1088 : 1024); } }
        GRID_BAR();

        PH_BEGIN();
        RPT_PHASE(6, { const LayerW W = make_w(in, l); phase_finish(F, W, ws, (const bf16_t*)(ws + WS_GUPT) + (size_t)l * 512 * 128, M); });
        GRID_BAR();

        PH_BEGIN();
        { pg8::Gemm g{(const bf16_t*)(ws + WS_MIX), (const bf16_t*)(ws + WS_WOUT) + (size_t)l * 2048 * 2048, M, 2048, 2048}; pg8::StaticOrder S; S.init(M, 2048, F.G, F.bid);
          float* CTXS = (float*)(ws + WS_CTXS);
          pg8::EpiResid E{l == 0 ? in[I_X] : out, l == 0 ? in[I_CTX] : CTXS, out, CTXS, (const float*)(ws + WS_MOD) + (size_t)l * 5 * 12288 + 2 * 2048};
          pg8::gemm_phase<pg8::EpiResid, pg8::StaticOrder>(F.lds, g, S, E, F.tid); }
        if (l == 0 && F.bid >= 32) PEER_CONVERT_LAYER(F, in, ws, 0, F.bid - 32, F.G - 32);
        GRID_BAR();

        PH_BEGIN();
        RPT_PHASE(7, phase_norm(F, out, (const float*)(ws + WS_CTXS), in[I_NFFN] + (size_t)l * 2048, (const float*)(ws + WS_MOD) + (size_t)l * 5 * 12288, 3, 4, (bf16_t*)(ws + WS_XN), M););
        GRID_BAR();
        PH_BEGIN();
        RPT_PHASE(8, { pg8::Gemm g{(const bf16_t*)(ws + WS_XN), (const bf16_t*)(ws + WS_WQ) + (size_t)l * 2048 * 2048, M, 2048, 2048}; pg8::StaticOrder S; S.init(M, 2048, F.G, F.bid);
          pg8::EpiBf16 E{(bf16_t*)(ws + WS_P), 2048}; pg8::gemm_phase<pg8::EpiBf16, pg8::StaticOrder>(F.lds, g, S, E, F.tid); });
        if (l == 0 && F.bid >= 32) PEER_CONVERT_LAYER(F, in, ws, 1, F.bid - 32, F.G - 32);
        GRID_BAR();
        PH_BEGIN();
        RPT_PHASE(9, phase_scores(F, ws, l, M););
        GRID_BAR();
        PH_BEGIN();
        RPT_PHASE(10, { XInfo X; X.xi = lxi[0]; X.nx = lxi[1]; X.rank = lxi[2]; X.nloc = lxi[3]; phase_experts_u<0x3fff>(F, ws, l, M, X, (float*)(ws + WS_PART)); });
        if (RPT == 101) { GRID_BAR(); PH_BEGIN(); XInfo X; X.xi = lxi[0]; X.nx = lxi[1]; X.rank = lxi[2]; X.nloc = lxi[3]; phase_experts_u<0x3ff>(F, ws, l, M, X, (float*)(ws + WS_P)); }
        if (RPT == 102) { GRID_BAR(); PH_BEGIN(); XInfo X; X.xi = lxi[0]; X.nx = lxi[1]; X.rank = lxi[2]; X.nloc = lxi[3]; phase_experts_u<0x3fff>(F, ws, l, M, X, (float*)(ws + WS_P)); }
        GRID_BAR();
        PH_BEGIN();
        phase_experts_combine(F, ws, M);
        GRID_BAR();
        PH_BEGIN();
        if (RPT == 11) { XInfo X; X.xi = lxi[0]; X.nx = lxi[1]; X.rank = lxi[2]; X.nloc = lxi[3]; phase_experts_v(F, ws, (float*)(ws + WS_P), (float*)(ws + WS_P) + (size_t)NLAT * 2048, l, M, X); GRID_BAR(); PH_BEGIN(); }
        { XInfo X; X.xi = lxi[0]; X.nx = lxi[1]; X.rank = lxi[2]; X.nloc = lxi[3]; phase_experts_v(F, ws, out, (float*)(ws + WS_CTXS), l, M, X); }
        if (l == 0) { GRID_BAR(); PH_BEGIN();
            phase_norm(F, out, (const float*)(ws + WS_CTXS), in[I_NMIX] + 2048, (const float*)(ws + WS_MOD) + (size_t)5 * 12288, 0, 1, (bf16_t*)(ws + WS_XN), NTOK); GRID_BAR(); }
    }
}

extern "C" void kernel_launch(void* const* d_in, const int* in_sizes, int n_in, void* d_out, int out_size, void* d_ws, size_t ws_size, hipStream_t stream) {
    static int grid = 0;
    if (grid == 0) {
        if (n_in != N_IN || out_size != NLAT * DM || ws_size < WS_END) { fprintf(stderr, "kernel_launch: unexpected shapes (n_in %d out %d ws %zu, need %zu)\n", n_in, out_size, ws_size, (size_t)WS_END); grid = -1; return; }
        int dev = 0, cus = 0, per_cu = 0;
        (void)hipGetDevice(&dev); (void)hipDeviceGetAttribute(&cus, hipDeviceAttributeMultiprocessorCount, dev);
        if (hipFuncSetAttribute((const void*)hybrid_fwd, hipFuncAttributeMaxDynamicSharedMemorySize, LDS_BYTES) != hipSuccess) { fprintf(stderr, "kernel_launch: hipFuncSetAttribute failed\n"); grid = -1; return; }
        (void)hipOccupancyMaxActiveBlocksPerMultiprocessor(&per_cu, (const void*)hybrid_fwd, 512, LDS_BYTES);
        (void)hipGetLastError();
        fprintf(stderr, "kernel_launch: %d CUs, occupancy query %d block(s)/CU, ws %zu B (need %zu)\n", cus, per_cu, ws_size, (size_t)WS_END);
        grid = cus;
        if (grid < 136) { fprintf(stderr, "kernel_launch: needs at least 136 CUs\n"); grid = -1; return; }
    }
    if (grid < 0) return;
    (void)hipMemsetAsync((char*)d_ws + WS_CTL, 0, 65536, stream);
    Params p{};
    for (int i = 0; i < N_IN; ++i) p.in[i] = (const float*)d_in[i];
    p.out = (float*)d_out; p.ws = (unsigned char*)d_ws;
    hipLaunchKernelGGL(hybrid_fwd, dim3(grid), dim3(512), LDS_BYTES, stream, p);
}
```

```cpp
#include <hip/hip_runtime.h>
#include <cstdio>
#include <cstdint>
#ifndef RPT
#define RPT 0
#endif

constexpr int DM = 2048, NBATCH = 4, SEQL = 4096, CTXL = 256, NLAT = NBATCH * SEQL, NCTX = NBATCH * CTXL, NTOK = NLAT + NCTX;
constexpr int PT = 6416, PTP = 6656;
constexpr int A_BG = 0, A_CG = 512, A_H = 1024;
constexpr int B_R = 1536, B_K = 2048, B_V = 2560, B_WD = 3072, B_AD = 3136, B_GD = 3200;
constexpr int C_Q = 3328, C_K = 3840, C_V = 4352;
constexpr int D_Z = 4864, D_X = 5376, D_DT = 6400;
constexpr int NPOS = CTXL + SEQL;
constexpr int NCH = 34;
constexpr int KSPL = 32;

enum { I_X = 0, I_C, I_CTX, I_CCTX, I_WADA, I_BADA, I_NMIX, I_NFFN, I_WIN, I_WOUT, I_SCW, I_RW0, I_RWUP, I_RA0, I_RAUP, I_RGUP, I_RKK, I_RKA, I_RRK, I_RLNW, I_RLNB,
       I_NAQ, I_NAK, I_RPB, I_SCONVW, I_SCONVB, I_SDTB, I_SALOG, I_SD, I_SNORM, I_PWQ, I_PKEYS, I_PU, I_PV, N_IN };

constexpr size_t WS_CTL   = 0;
constexpr size_t WS_ROPE  = 65536;
constexpr size_t WS_MODP  = WS_ROPE + 16384;
constexpr size_t WS_MOD   = WS_MODP + (size_t)KSPL * 2 * 5 * 12288 * 4;
constexpr size_t WS_WIN   = WS_MOD + (size_t)2 * 5 * 12288 * 4;
constexpr size_t WS_WOUT  = WS_WIN + (size_t)2 * PTP * DM * 2;
constexpr size_t WS_WQ    = WS_WOUT + (size_t)2 * DM * DM * 2;
constexpr size_t WS_KEYS  = WS_WQ + (size_t)2 * DM * DM * 2;
constexpr size_t WS_WUPT  = WS_KEYS + (size_t)2 * 8 * 2 * 128 * 128 * 2;
constexpr size_t WS_GUPT  = WS_WUPT + (size_t)2 * 4 * 512 * 64 * 2;
constexpr size_t WS_PU    = WS_GUPT + (size_t)2 * 512 * 128 * 2;
constexpr size_t WS_PV    = WS_PU + (size_t)2 * 16384 * DM;
constexpr size_t WS_P     = WS_PV + (size_t)2 * 16384 * DM;
constexpr size_t WS_MIX   = WS_P + (size_t)NTOK * PTP * 2;
constexpr size_t WS_CTXS  = WS_MIX + (size_t)NTOK * DM * 2;
constexpr size_t WS_XN    = WS_CTXS + (size_t)NCTX * DM * 4;
constexpr size_t WS_IDS   = WS_XN + (size_t)NTOK * DM * 2;
constexpr size_t WS_GATES = WS_IDS + (size_t)NTOK * 128 * 4;
constexpr size_t WS_PART  = WS_GATES + (size_t)NTOK * 128 * 4;
constexpr size_t WS_RWF   = WS_XN;
constexpr size_t WS_RWY   = WS_RWF + (size_t)64 * 272 * 13312;
constexpr size_t WS_BON   = WS_RWY + (size_t)2 * NTOK * 512 * 2;
constexpr size_t WS_XBC   = WS_BON + (size_t)2 * NTOK * 8 * 4;
constexpr size_t WS_DTS   = WS_XBC + (size_t)NTOK * 1024 * 2;
constexpr size_t WS_DEC   = WS_DTS + (size_t)NTOK * 16 * 4;
constexpr size_t WS_SST   = WS_DEC + (size_t)NTOK * 16 * 4;
constexpr size_t WS_SCD   = WS_SST + (size_t)64 * NCH * 8192 * 4;
constexpr size_t WS_YS    = WS_SCD + 16384;
constexpr size_t WS_QN    = WS_YS + (size_t)NTOK * 512 * 4;
constexpr size_t WS_KN    = WS_QN + (size_t)NTOK * 512 * 2;
constexpr size_t WS_VTL   = WS_KN + (size_t)NTOK * 512 * 2;
constexpr size_t WS_VTC   = WS_VTL + (size_t)4 * 8 * 64 * 64 * 96 * 2;
constexpr size_t WS_END   = WS_VTC + (size_t)4 * 8 * 64 * 256 * 2;
static_assert(WS_END < (size_t)1020 * 1024 * 1024, "workspace");
static_assert(WS_GATES + (size_t)NTOK * 128 * 4 <= WS_PART && WS_PART + (size_t)16 * NTOK * 128 * 4 <= WS_END, "alias");

constexpr int LDS_BYTES = 147456;
constexpr int LDS_BAR_OFF = LDS_BYTES - 16;
constexpr int LDS_XI_OFF = LDS_BYTES - 48;
constexpr int CTL_TICKET = 8192;

#define LAS __attribute__((address_space(3)))
typedef unsigned short bf16_t;
typedef _Float16 f16_t;
typedef short bf16x8 __attribute__((ext_vector_type(8)));
typedef float f32x4 __attribute__((ext_vector_type(4)));
typedef unsigned u32x4 __attribute__((ext_vector_type(4)));
typedef unsigned u32x2 __attribute__((ext_vector_type(2)));

__device__ __forceinline__ float bf2f(bf16_t h) { return __uint_as_float(((unsigned)h) << 16); }
__device__ __forceinline__ float bflo(unsigned u) { return __uint_as_float(u << 16); }
__device__ __forceinline__ float bfhi(unsigned u) { return __uint_as_float(u & 0xffff0000u); }
__device__ __forceinline__ bf16_t f2bf(float f) { unsigned u = __float_as_uint(f); u += 0x7FFFu + ((u >> 16) & 1u); return (bf16_t)(u >> 16); }
typedef float f32x2_t __attribute__((ext_vector_type(2)));
typedef __bf16 bf16x2_t __attribute__((ext_vector_type(2)));
__device__ __forceinline__ unsigned pk_bf16(float lo, float hi) { const f32x2_t v = {lo, hi}; const bf16x2_t r = __builtin_convertvector(v, bf16x2_t); return __builtin_bit_cast(unsigned, r); }
__device__ __forceinline__ bf16x8 pack8(const f32x4 a, const f32x4 b) { union { bf16x8 v; unsigned u[4]; } r; r.u[0] = pk_bf16(a[0], a[1]); r.u[1] = pk_bf16(a[2], a[3]); r.u[2] = pk_bf16(b[0], b[1]); r.u[3] = pk_bf16(b[2], b[3]); return r.v; }
template <int CTRL> __device__ __forceinline__ float dpp_f(float v) { return __int_as_float(__builtin_amdgcn_update_dpp(0, __float_as_int(v), CTRL, 0xF, 0xF, true)); }
__device__ __forceinline__ float sum4(float x)  { x += dpp_f<0xB1>(x); x += dpp_f<0x4E>(x); return x; }
__device__ __forceinline__ float sum8(float x)  { x = sum4(x); x += dpp_f<0x141>(x); return x; }
__device__ __forceinline__ float sum16(float x) { x = sum8(x); x += dpp_f<0x140>(x); return x; }
__device__ __forceinline__ float xor16_f(float x) { return __int_as_float(__builtin_amdgcn_ds_swizzle(__float_as_int(x), 0x401F)); }
__device__ __forceinline__ float sum_x32(float x) { const auto r = __builtin_amdgcn_permlane32_swap(__float_as_uint(x), __float_as_uint(x), false, false); return __uint_as_float(r[0]) + __uint_as_float(r[1]); }
__device__ __forceinline__ float max_x32(float x) { const auto r = __builtin_amdgcn_permlane32_swap(__float_as_uint(x), __float_as_uint(x), false, false); return fmaxf(__uint_as_float(r[0]), __uint_as_float(r[1])); }
__device__ __forceinline__ float wave_sum(float x) { x = sum16(x); x += xor16_f(x); return sum_x32(x); }
__device__ __forceinline__ float max16(float x) { x = fmaxf(x, dpp_f<0xB1>(x)); x = fmaxf(x, dpp_f<0x4E>(x)); x = fmaxf(x, dpp_f<0x141>(x)); x = fmaxf(x, dpp_f<0x140>(x)); return x; }
__device__ __forceinline__ float wave_max(float x) { x = max16(x); x = fmaxf(x, xor16_f(x)); return max_x32(x); }
__device__ __forceinline__ float rcpf_(float x) { return __builtin_amdgcn_rcpf(x); }
__device__ __forceinline__ float sigmoidf_(float x) { return rcpf_(1.0f + __expf(-x)); }
__device__ __forceinline__ float siluf_(float x) { return x * rcpf_(1.0f + __expf(-x)); }
__device__ __forceinline__ float tanhf_(float x) { const float e = __expf(2.0f * x); return 1.0f - 2.0f * rcpf_(e + 1.0f); }
__device__ __forceinline__ float geluf_(float x) { return 0.5f * x * (1.0f + tanhf_(0.7978845608028654f * (x + 0.044715f * x * x * x))); }

namespace pg8 {
#define PG8_LAS __attribute__((address_space(3)))
typedef unsigned short bf16_t;
typedef short bf16x8 __attribute__((ext_vector_type(8)));
typedef float f32x4 __attribute__((ext_vector_type(4)));
typedef unsigned u32x4 __attribute__((ext_vector_type(4)));
constexpr int BM = 256, BK = 64, HALF = 128, HTB = HALF * BK * 2  , STAGE_BYTES = 8 * HTB, NXCD = 8, WGM = 8;

__host__ __device__ __forceinline__ int lds_byte(int r, int c) { const int st = (r >> 4) * 2 + (c >> 5), rr = r & 15, cc = c & 31, ob = rr * 64 + cc * 2; return st * 1024 + (ob ^ (((ob >> 9) & 1) << 5)); }
__host__ __device__ __forceinline__ void stage_rc(int b, int& R, int& C) { const int st = b / 1024, sb = b % 1024, swz = sb ^ (((sb >> 9) & 1) << 5); R = (st >> 1) * 16 + swz / 64; C = (st & 1) * 32 + (swz % 64) / 2; }
__host__ __device__ __forceinline__ int perm32(int rho) { const int n = rho >> 4, i = rho & 15; return 8 * (i >> 2) + 4 * n + (i & 3); }

struct Unit { int pm, pn; };
struct Gemm { const bf16_t* A; const bf16_t* Bt; int M, N, K; };

struct StaticOrder {
    int nM, nN, nwg, G, c;
    __host__ __device__ void init(int M, int N, int G_, int c_) { nM = M / BM; nN = N / BM; nwg = nM * nN; G = G_; c = c_; }
    __host__ __device__ bool next(int i, Unit& u) const {
        const long L = (long)i * G + c; if (L >= nwg) return false;
        int wgid = (int)L; { const int q = nwg / NXCD, r = nwg % NXCD, xcd = wgid % NXCD, off = wgid / NXCD; wgid = (xcd < r ? xcd * (q + 1) : r * (q + 1) + (xcd - r) * q) + off; }
        const int nig = WGM * nN, gid = wgid / nig, fm = gid * WGM, gsz = (nM - fm) < WGM ? (nM - fm) : WGM;
        u.pm = fm + ((wgid % nig) % gsz); u.pn = (wgid % nig) / gsz; return true;
    }
    __device__ __forceinline__ void a_ready(const Unit&) const {}
    __device__ __forceinline__ void done(const Unit&) const {}
};

__device__ __forceinline__ unsigned cvt_pk_bf16(float lo, float hi) { return ::pk_bf16(lo, hi); }
struct EpiBf16 {
    static constexpr bool PERM = true, AFTER_DRAIN = false;
    bf16_t* O; int ldc;
    __device__ __forceinline__ void operator()(const f32x4 (&acc)[2][2][4][2], const Unit& u, int wr, int wc, int fr, int fq) const {
        const int row0 = u.pm * BM + wr * 64 + fr; const int col0 = u.pn * BM + wc * 32 + 8 * fq;
#pragma unroll
        for (int ai = 0; ai < 2; ++ai)
#pragma unroll
            for (int m = 0; m < 4; ++m) { bf16_t* rowp = O + (size_t)(row0 + ai * HALF + m * 16) * ldc + col0;
#pragma unroll
                for (int bj = 0; bj < 2; ++bj) { const f32x4 v0 = acc[ai][bj][m][0], v1 = acc[ai][bj][m][1];
                    u32x4 w; w.x = cvt_pk_bf16(v0[0], v0[1]); w.y = cvt_pk_bf16(v0[2], v0[3]); w.z = cvt_pk_bf16(v1[0], v1[1]); w.w = cvt_pk_bf16(v1[2], v1[3]);
                    *(u32x4*)(rowp + bj * HALF) = w; } }
    }
};
struct EpiResid {
    static constexpr bool PERM = false, AFTER_DRAIN = false;
    const float* xi_lat; const float* xi_ctx; float* xo_lat; float* xo_ctx; const float* gate;
    __device__ __forceinline__ void operator()(const f32x4 (&acc)[2][2][4][2], const Unit& u, int wr, int wc, int fr, int fq) const {
        const bool isctx = u.pm >= 64; const int v = isctx ? 4 : (u.pm >> 4);
        const int row0 = (isctx ? (u.pm - 64) : u.pm) * BM + wr * 64 + fr, col0 = u.pn * BM + wc * 32 + 4 * fq;
        const float* xi = isctx ? xi_ctx : xi_lat; float* xo = isctx ? xo_ctx : xo_lat;
        const float* gp = gate + (size_t)v * 12288 + col0;
        f32x4 gv[2][2];
#pragma unroll
        for (int bj = 0; bj < 2; ++bj)
#pragma unroll
            for (int n = 0; n < 2; ++n) gv[bj][n] = *(const f32x4*)(gp + bj * HALF + n * 16);
#pragma unroll
        for (int ai = 0; ai < 2; ++ai)
#pragma unroll
            for (int m = 0; m < 4; ++m) { const size_t off = (size_t)(row0 + ai * HALF + m * 16) * 2048 + col0;
#pragma unroll
                for (int bj = 0; bj < 2; ++bj)
#pragma unroll
                    for (int n = 0; n < 2; ++n) { const f32x4 xv = *(const f32x4*)(xi + off + bj * HALF + n * 16);
                        *(f32x4*)(xo + off + bj * HALF + n * 16) = xv + gv[bj][n] * acc[ai][bj][m][n]; }
                asm volatile("" ::: "memory"); }
    }
};

template <class Epi, class Sched>
__device__ __forceinline__ void gemm_phase(PG8_LAS unsigned char* lds, const Gemm g, const Sched& S, const Epi& E, const int tid) {
    const int wid = __builtin_amdgcn_readfirstlane(tid >> 6), lane = tid & 63, wr = wid >> 2, wc = wid & 3, fr = lane & 15, fq = lane >> 4;
    const int K = g.K, nt = K / BK;
    unsigned voffA[2], voffB[2];
#pragma unroll
    for (int i = 0; i < 2; ++i) { int R, C; stage_rc(tid * 16 + i * 8192, R, C); const int Rb = Epi::PERM ? ((R & ~31) + perm32(R & 31)) : R;
        voffA[i] = (unsigned)(R * K + C) * 2u; voffB[i] = (unsigned)(Rb * K + C) * 2u; }
    const size_t kstep = (size_t)(BK * 2);
    const size_t hstep = (size_t)HALF * K * 2;
    const size_t tstep = 2 * hstep;
    const unsigned ldsw = (unsigned)wid * 1024u;
    const int aoff = lds_byte(wr * 64 + fr, fq * 8), boff = lds_byte(wc * 32 + fr, fq * 8);
#define PG8_SA(b, h) (((b) * 2 + (h)) * HTB)
#define PG8_SB(b, h) ((4 + (b) * 2 + (h)) * HTB)
#define PG8_STAGE(bufoff, gbase, voff) do { _Pragma("unroll") for (int _i = 0; _i < 2; ++_i) \
        __builtin_amdgcn_global_load_lds((const unsigned*)((const char*)(gbase) + (voff)[_i]), (PG8_LAS unsigned*)(lds + (bufoff) + ldsw + _i * 8192), 16, 0, 0); } while (0)
#define PG8_LDA(dst, b, h) do { _Pragma("unroll") for (int m = 0; m < 4; ++m) _Pragma("unroll") for (int k = 0; k < 2; ++k) dst[m][k] = *(const PG8_LAS bf16x8*)(lds + PG8_SA(b, h) + aoff + m * 2048 + k * 1024); } while (0)
#define PG8_LDB(dst, b, h) do { _Pragma("unroll") for (int n = 0; n < 2; ++n) _Pragma("unroll") for (int k = 0; k < 2; ++k) dst[n][k] = *(const PG8_LAS bf16x8*)(lds + PG8_SB(b, h) + boff + n * 2048 + k * 1024); } while (0)
#define PG8_MMA(ai, bj, At, Bt) do { __builtin_amdgcn_s_setprio(1); _Pragma("unroll") for (int m = 0; m < 4; ++m) _Pragma("unroll") for (int n = 0; n < 2; ++n) _Pragma("unroll") for (int k = 0; k < 2; ++k) \
        acc[ai][bj][m][n] = __builtin_amdgcn_mfma_f32_16x16x32_bf16(Bt[n][k], At[m][k], acc[ai][bj][m][n], 0, 0, 0); __builtin_amdgcn_s_setprio(0); } while (0)
#define PG8_WAIT_V(n) asm volatile("s_waitcnt vmcnt(" #n ")" ::: "memory")
#define PG8_WAIT_L(n) asm volatile("s_waitcnt lgkmcnt(" #n ")" ::: "memory")
#define PG8_BAR __builtin_amdgcn_s_barrier()
#define PG8_SCHED __builtin_amdgcn_sched_barrier(0)
    Unit cur, nxt; int ui = 0;
    if (!S.next(0, cur)) return;
    f32x4 acc[2][2][4][2];
#pragma unroll
    for (int a = 0; a < 2; ++a)
#pragma unroll
        for (int b = 0; b < 2; ++b)
#pragma unroll
            for (int m = 0; m < 4; ++m)
#pragma unroll
                for (int n = 0; n < 2; ++n) acc[a][b][m][n] = (f32x4){0.f, 0.f, 0.f, 0.f};
    bf16x8 At[4][2], B0[2][2], B1[2][2];
    const char* cA = (const char*)g.A + (size_t)cur.pm * tstep; const char* cB = (const char*)g.Bt + (size_t)cur.pn * tstep;
    S.a_ready(cur);
    PG8_STAGE(PG8_SB(0, 0), cB, voffB); PG8_STAGE(PG8_SA(0, 0), cA, voffA); PG8_STAGE(PG8_SB(0, 1), cB + hstep, voffB); PG8_STAGE(PG8_SA(0, 1), cA + hstep, voffA);
    if (wr == 1) PG8_BAR;
    PG8_WAIT_V(4); PG8_BAR;
    PG8_STAGE(PG8_SB(1, 0), cB + kstep, voffB); PG8_STAGE(PG8_SA(1, 0), cA + kstep, voffA); PG8_STAGE(PG8_SB(1, 1), cB + hstep + kstep, voffB);
    PG8_WAIT_V(6); PG8_BAR;
    for (;;) {
        const bool has_next = S.next(ui + 1, nxt);
        const char* nA = has_next ? (const char*)g.A + (size_t)nxt.pm * tstep : cA; const char* nB = has_next ? (const char*)g.Bt + (size_t)nxt.pn * tstep : cB;
        for (int t = 0; t < nt; t += 2) {
            const bool last = (t == nt - 2);
            const char* a1 = cA + (size_t)(t + 1) * kstep;
            const char* a2 = last ? nA : cA + (size_t)(t + 2) * kstep; const char* b2 = last ? nB : cB + (size_t)(t + 2) * kstep;
            const char* a3 = a2 + kstep; const char* b3 = b2 + kstep;
            if (last && has_next) S.a_ready(nxt);
            PG8_LDB(B0, 0, 0); PG8_SCHED; PG8_LDA(At, 0, 0); PG8_STAGE(PG8_SA(1, 1), a1 + hstep, voffA);
            PG8_WAIT_L(8); PG8_BAR; PG8_WAIT_L(0); PG8_MMA(0, 0, At, B0); PG8_BAR; PG8_SCHED;
            PG8_LDB(B1, 0, 1); PG8_STAGE(PG8_SB(0, 0), b2, voffB);
            PG8_BAR; PG8_WAIT_L(0); PG8_MMA(0, 1, At, B1); PG8_BAR;
            PG8_LDA(At, 0, 1); PG8_STAGE(PG8_SA(0, 0), a2, voffA);
            PG8_BAR; PG8_WAIT_L(0); PG8_MMA(1, 0, At, B0); PG8_BAR; PG8_SCHED;
            PG8_STAGE(PG8_SB(0, 1), b2 + hstep, voffB);
            PG8_WAIT_V(6); PG8_BAR; PG8_MMA(1, 1, At, B1); PG8_BAR;
            PG8_LDB(B0, 1, 0); PG8_SCHED; PG8_LDA(At, 1, 0); PG8_STAGE(PG8_SA(0, 1), a2 + hstep, voffA);
            PG8_WAIT_L(8); PG8_BAR; PG8_WAIT_L(0); PG8_MMA(0, 0, At, B0); PG8_BAR; PG8_SCHED;
            PG8_LDB(B1, 1, 1); PG8_STAGE(PG8_SB(1, 0), b3, voffB);
            PG8_BAR; PG8_WAIT_L(0); PG8_MMA(0, 1, At, B1); PG8_BAR;
            PG8_LDA(At, 1, 1); PG8_STAGE(PG8_SA(1, 0), a3, voffA);
            PG8_BAR; PG8_WAIT_L(0); PG8_MMA(1, 0, At, B0); PG8_BAR; PG8_SCHED;
            PG8_STAGE(PG8_SB(1, 1), b3 + hstep, voffB);
            PG8_WAIT_V(6); PG8_BAR; PG8_MMA(1, 1, At, B1); PG8_BAR;
        }
        if constexpr (!Epi::AFTER_DRAIN) { E(acc, cur, wr, wc, fr, fq); S.done(cur); }
        if (!has_next) break;
#pragma unroll
        for (int a = 0; a < 2; ++a)
#pragma unroll
            for (int b = 0; b < 2; ++b)
#pragma unroll
                for (int m = 0; m < 4; ++m)
#pragma unroll
                    for (int n = 0; n < 2; ++n) acc[a][b][m][n] = (f32x4){0.f, 0.f, 0.f, 0.f};
        cur = nxt; cA = nA; cB = nB; ++ui;
    }
    PG8_WAIT_V(0);
    if (wr == 0) PG8_BAR;
    PG8_BAR;
    if constexpr (Epi::AFTER_DRAIN) { E.fused(acc, cur, wr, wc, fr, fq, lds, wid, lane); S.done(cur); }
#undef PG8_SA
#undef PG8_SB
#undef PG8_STAGE
#undef PG8_LDA
#undef PG8_LDB
#undef PG8_MMA
#undef PG8_WAIT_V
#undef PG8_WAIT_L
#undef PG8_BAR
#undef PG8_SCHED
}
}

#define XB_TMO      128
#define XB_XCNT(j)  (256  + 64 * (j))
#define XB_XSUB(j)  (1280 + 64 * (j))
#define XB_XGEN(j)  (2304 + 64 * (j))
#define XB_TOP      3328
#define XB_TOPGEN   3392
#define XCD_BAR_WORDS 3456
#define XB_SPIN_CAP (1u << 18)
#define LAS __attribute__((address_space(3)))

__device__ __forceinline__ unsigned xb_ld(unsigned* p)              { return __hip_atomic_load(p, __ATOMIC_RELAXED, __HIP_MEMORY_SCOPE_AGENT); }
__device__ __forceinline__ unsigned xb_add(unsigned* p, unsigned v) { return __hip_atomic_fetch_add(p, v, __ATOMIC_RELAXED, __HIP_MEMORY_SCOPE_AGENT); }
__device__ __forceinline__ unsigned xb_xcc_id() { return (unsigned)__builtin_amdgcn_s_getreg((3 << 11) | 20) & 0xFu; }
#define XB_SPIN(cond, bar) do { unsigned _sp = 0; while (cond) { __builtin_amdgcn_s_sleep(1); \
    if ((++_sp & 255u) == 0u) { if (xb_ld(&(bar)[XB_TMO])) break; if (_sp > XB_SPIN_CAP) { atomicAdd(&(bar)[XB_TMO], 1u); break; } } } } while (0)

struct XcdBarrier {
    unsigned* bar; unsigned x;
    volatile LAS unsigned* st;
};

__device__ __forceinline__ XcdBarrier xcd_barrier_post(unsigned* bar, volatile LAS unsigned* st) {
    XcdBarrier b; b.bar = bar; b.x = xb_xcc_id(); b.st = st;
    if (threadIdx.x == 0) (void)xb_add(&bar[XB_XCNT(b.x)], 1u);
    return b;
}
__device__ __forceinline__ void xcd_barrier_complete(unsigned* bar, unsigned x, unsigned& nloc, unsigned& nx) {
    const unsigned G = gridDim.x * gridDim.y * gridDim.z;
    unsigned sum, cnt, mine, sp = 0u;
    for (;;) {
        sum = 0u; cnt = 0u; mine = 0u;
#pragma unroll
        for (unsigned j = 0; j < 16; ++j) { const unsigned c = xb_ld(&bar[XB_XCNT(j)]); sum += c; cnt += (c > 0u) ? 1u : 0u; mine = (j == x) ? c : mine; }
        if (sum == G) break;
        __builtin_amdgcn_s_sleep(1);
        if ((++sp & 255u) == 0u) { if (xb_ld(&bar[XB_TMO])) break; if (sp > XB_SPIN_CAP) { atomicAdd(&bar[XB_TMO], 1u); break; } }
    }
    nloc = mine > 0u ? mine : 1u; nx = cnt > 0u ? cnt : 1u;
}

__device__ __forceinline__ void xcd_barrier(const XcdBarrier& b) {
    asm volatile("s_waitcnt vmcnt(0)" ::: "memory");
    __syncthreads();
    if (threadIdx.x == 0) {
        unsigned* bar = b.bar;
        __builtin_amdgcn_s_waitcnt(0);
        unsigned nloc = b.st[0], nx = b.st[1];
        if (nloc == 0u) { xcd_barrier_complete(bar, b.x, nloc, nx); b.st[0] = nloc; b.st[1] = nx; }
        const unsigned old = xb_add(&bar[XB_XSUB(b.x)], 1u);
        const unsigned gen = old / nloc;
        if (old + 1u == (gen + 1u) * nloc) {
            __builtin_amdgcn_fence(__ATOMIC_RELEASE, "agent");
            asm volatile("s_waitcnt vmcnt(0)" ::: "memory");
            const unsigned og = xb_add(&bar[XB_TOP], 1u);
            const unsigned tg = og / nx;
            if (og + 1u == (tg + 1u) * nx) xb_add(&bar[XB_TOPGEN], 1u);
            else XB_SPIN(xb_ld(&bar[XB_TOPGEN]) == tg, bar);
            __builtin_amdgcn_fence(__ATOMIC_ACQUIRE, "agent");
            xb_add(&bar[XB_XGEN(b.x)], 1u);
            asm volatile("s_waitcnt vmcnt(0)" ::: "memory");
        } else {
            XB_SPIN(xb_ld(&bar[XB_XGEN(b.x)]) == gen, bar);
            __builtin_amdgcn_fence(__ATOMIC_ACQUIRE, "agent");
            asm volatile("s_waitcnt vmcnt(0)" ::: "memory");
        }
    }
    __syncthreads();
}

typedef const float* cfp_t;
typedef __attribute__((address_space(4))) const cfp_t* ka_t;
struct Ctx {
    LAS unsigned char* lds; int tid, lane, wave, bid, G;
};

__device__ __forceinline__ void task_ada(const Ctx& F, const float* c, const float* c_ctx, const float* w_ada, float* modp, int task) {
    LAS float* s_act = (LAS float*)F.lds;
    const int l = task / (KSPL * 6), rem = task % (KSPL * 6), ks = rem / 6, cc = rem % 6;
    __syncthreads();
    if (F.tid < 320) { const int v = F.tid >> 6, k = ks * 64 + (F.tid & 63); const float x = v < 4 ? c[v * 2048 + k] : c_ctx[k]; s_act[F.tid] = siluf_(x); }
    __syncthreads();
    const int col4 = cc * 512 + F.tid;
    const float4* wp = (const float4*)(w_ada + ((size_t)l * 2048 + ks * 64) * 12288) + col4;
    float4 acc[5];
#pragma unroll
    for (int v = 0; v < 5; ++v) acc[v] = make_float4(0.f, 0.f, 0.f, 0.f);
#pragma unroll 8
    for (int k = 0; k < 64; ++k) {
        const float4 w = wp[(size_t)k * 3072];
#pragma unroll
        for (int v = 0; v < 5; ++v) { const float a = s_act[v * 64 + k]; acc[v].x += a * w.x; acc[v].y += a * w.y; acc[v].z += a * w.z; acc[v].w += a * w.w; }
    }
#pragma unroll
    for (int v = 0; v < 5; ++v) ((float4*)(modp + (((size_t)ks * 2 + l) * 5 + v) * 12288))[col4] = acc[v];
}
__device__ __forceinline__ void task_wt(const Ctx& F, const float* W, int N, bf16_t* Wt, int ntile) {
    LAS bf16_t* T = (LAS bf16_t*)F.lds;
    const int nq = F.tid & 15, kr = F.tid >> 4, n0 = ntile * 64;
    for (int kc = 0; kc < 16; ++kc) {
        float4 v[4];
#pragma unroll
        for (int j = 0; j < 4; ++j) { const int k = kc * 128 + kr + 32 * j, n = n0 + 4 * nq;
            v[j] = (n < N) ? *(const float4*)(W + (size_t)k * N + n) : make_float4(0.f, 0.f, 0.f, 0.f); }
        __syncthreads();
#pragma unroll
        for (int j = 0; j < 4; ++j) { const int kl = kr + 32 * j;
            T[(4 * nq + 0) * 136 + kl] = f2bf(v[j].x); T[(4 * nq + 1) * 136 + kl] = f2bf(v[j].y); T[(4 * nq + 2) * 136 + kl] = f2bf(v[j].z); T[(4 * nq + 3) * 136 + kl] = f2bf(v[j].w); }
        __syncthreads();
        { const int n = F.tid >> 3, kg = F.tid & 7;
          const u32x4 a = *(LAS u32x4*)(T + n * 136 + kg * 16), b = *(LAS u32x4*)(T + n * 136 + kg * 16 + 8);
          bf16_t* dst = Wt + (size_t)(n0 + n) * 2048 + kc * 128 + kg * 16; *(u32x4*)dst = a; *(u32x4*)(dst + 8) = b; }
    }
    __syncthreads();
}
__device__ __forceinline__ void task_cvt(const Ctx& F, const float* src, bf16_t* dst, size_t off) {
#pragma unroll 4
    for (int it = 0; it < 16; ++it) { const size_t e = off + (size_t)it * 4096 + F.tid * 8;
        const float4 a = *(const float4*)(src + e), b = *(const float4*)(src + e + 4);
        u32x4 o; o.x = pk_bf16(a.x, a.y); o.y = pk_bf16(a.z, a.w); o.z = pk_bf16(b.x, b.y); o.w = pk_bf16(b.z, b.w);
        *(u32x4*)(dst + e) = o; }
}
__device__ __forceinline__ void task_cvt8(const Ctx& F, const float* src, unsigned char* dst, size_t off, float scale) {
#pragma unroll 2
    for (int it = 0; it < 8; ++it) { const size_t e = off + (size_t)it * 8192 + F.tid * 16;
        u32x4 o;
#pragma unroll
        for (int w = 0; w < 4; ++w) { const float4 a = *(const float4*)(src + e + 4 * w);
            const float x0 = fminf(fmaxf(a.x * scale, -448.f), 448.f), x1 = fminf(fmaxf(a.y * scale, -448.f), 448.f), x2 = fminf(fmaxf(a.z * scale, -448.f), 448.f), x3 = fminf(fmaxf(a.w * scale, -448.f), 448.f);
            int p = __builtin_amdgcn_cvt_pk_fp8_f32(x0, x1, 0, false); p = __builtin_amdgcn_cvt_pk_fp8_f32(x2, x3, p, true); o[w] = (unsigned)p; }
        const size_t row = e >> 11; const int col = (int)(e & 2047);
        *(u32x4*)(dst + (row >> 14) * ((size_t)16384 * 2048) + ((size_t)(col >> 7) * 16384 + (row & 16383)) * 128 + (col & 127)) = o; }
}
constexpr float PEER_U_SCALE = 64.0f;
#define PEER_CONVERT_LAYER(F, in, ws, layer, blk, nblk) do { for (int t_ = (blk); t_ < 1024; t_ += (nblk)) { const bool isv_ = t_ >= 512; \
        task_cvt8(F, in[isv_ ? I_PV : I_PU], ws + (isv_ ? WS_PV : WS_PU), (size_t)(layer) * 16384 * 2048 + (size_t)(t_ & 511) * 65536, isv_ ? 1.0f : PEER_U_SCALE); } } while (0)
__device__ __forceinline__ void task_lorat(const Ctx& F, const float* src, bf16_t* dst, int nj) {
    const int ch = F.tid;
    for (int j8 = 0; j8 < nj / 8; ++j8) { float v[8];
#pragma unroll
        for (int q = 0; q < 8; ++q) v[q] = src[(size_t)(j8 * 8 + q) * 512 + ch];
        u32x4 o; o.x = pk_bf16(v[0], v[1]); o.y = pk_bf16(v[2], v[3]); o.z = pk_bf16(v[4], v[5]); o.w = pk_bf16(v[6], v[7]);
        *(u32x4*)(dst + (size_t)ch * nj + j8 * 8) = o; }
}
constexpr int T_ADA = 2 * KSPL * 6, T_WT1 = 2 * 104, T_WT2 = 2 * 32, T_WT3 = 2 * 32, T_PEER = 0, T_KEYS = 8, T_LORA = 10;
__device__ __forceinline__ void phase_prologue(const Ctx& F, ka_t in, unsigned char* ws) {
    const int total = T_ADA + T_WT1 + T_WT2 + T_WT3 + T_PEER + T_KEYS + T_LORA + 1;
    for (int t0 = F.bid; t0 < total; t0 += F.G) {
        int t = t0;
        if (t < T_ADA) { task_ada(F, in[I_C], in[I_CCTX], in[I_WADA], (float*)(ws + WS_MODP), t); continue; } t -= T_ADA;
        if (t < T_WT1) { const int l = t / 104, nt = t % 104; task_wt(F, in[I_WIN] + (size_t)l * 2048 * PT, PT, (bf16_t*)(ws + WS_WIN) + (size_t)l * PTP * 2048, nt); continue; } t -= T_WT1;
        if (t < T_WT2) { const int l = t / 32, nt = t % 32; task_wt(F, in[I_WOUT] + (size_t)l * 2048 * 2048, 2048, (bf16_t*)(ws + WS_WOUT) + (size_t)l * 2048 * 2048, nt); continue; } t -= T_WT2;
        if (t < T_WT3) { const int l = t / 32, nt = t % 32; task_wt(F, in[I_PWQ] + (size_t)l * 2048 * 2048, 2048, (bf16_t*)(ws + WS_WQ) + (size_t)l * 2048 * 2048, nt); continue; } t -= T_WT3;
        if (t < T_PEER) { const bool isv = t >= 1024; const int c = t & 1023; task_cvt8(F, in[isv ? I_PV : I_PU], ws + (isv ? WS_PV : WS_PU), (size_t)c * 65536, isv ? 1.0f : PEER_U_SCALE); continue; } t -= T_PEER;
        if (t < T_KEYS) { task_cvt(F, in[I_PKEYS], (bf16_t*)(ws + WS_KEYS), (size_t)t * 65536); continue; } t -= T_KEYS;
        if (t < T_LORA) {
            if (t < 8) { const int l = t >> 2, wh = t & 3;
                task_lorat(F, in[wh < 2 ? I_RWUP : I_RAUP] + ((size_t)l * 2 + (wh & 1)) * 64 * 512, (bf16_t*)(ws + WS_WUPT) + ((size_t)l * 4 + wh) * 512 * 64, 64); }
            else { const int l = t - 8; task_lorat(F, in[I_RGUP] + (size_t)l * 128 * 512, (bf16_t*)(ws + WS_GUPT) + (size_t)l * 512 * 128, 128); }
            continue; } t -= T_LORA;
        { float* rope = (float*)(ws + WS_ROPE);
          for (int e = F.tid; e < 2048; e += 512) { const int pos = e >> 5, i = e & 31; const float fr = powf(10000.0f, -(float)i / 32.0f), ang = (float)pos * fr;
              rope[2 * e] = cosf(ang); rope[2 * e + 1] = sinf(ang); } }
    }
}
__device__ __forceinline__ void phase_modreduce(const Ctx& F, const float* b_ada, const float* modp, float* mod) {
    for (int idx = F.bid * 512 + F.tid; idx < 2 * 5 * 12288; idx += F.G * 512) {
        const int l = idx / 61440, rem = idx % 61440, v = rem / 12288, n = rem % 12288;
        float s = b_ada[l * 12288 + n];
        for (int ks = 0; ks < KSPL; ++ks) s += modp[(((size_t)ks * 2 + l) * 5 + v) * 12288 + n];
        mod[idx] = s;
    }
}

__device__ __forceinline__ void norm_store(const float (&x)[32], const float* gw, const float* shift, const float* scale, bf16_t* dst, int lane) {
    float ss = 0.f;
#pragma unroll
    for (int q = 0; q < 32; ++q) ss += x[q] * x[q];
    ss = wave_sum(ss);
    const float rs = rsqrtf(ss * (1.0f / 2048.0f) + 1e-6f);
#pragma unroll
    for (int j = 0; j < 4; ++j) { const int e = j * 512 + lane * 8;
        const float4 g0 = *(const float4*)(gw + e), g1 = *(const float4*)(gw + e + 4), h0 = *(const float4*)(shift + e), h1 = *(const float4*)(shift + e + 4), c0 = *(const float4*)(scale + e), c1 = *(const float4*)(scale + e + 4);
        const float y0 = x[j * 8 + 0] * rs * g0.x * (1.f + c0.x) + h0.x, y1 = x[j * 8 + 1] * rs * g0.y * (1.f + c0.y) + h0.y, y2 = x[j * 8 + 2] * rs * g0.z * (1.f + c0.z) + h0.z, y3 = x[j * 8 + 3] * rs * g0.w * (1.f + c0.w) + h0.w;
        const float y4 = x[j * 8 + 4] * rs * g1.x * (1.f + c1.x) + h1.x, y5 = x[j * 8 + 5] * rs * g1.y * (1.f + c1.y) + h1.y, y6 = x[j * 8 + 6] * rs * g1.z * (1.f + c1.z) + h1.z, y7 = x[j * 8 + 7] * rs * g1.w * (1.f + c1.w) + h1.w;
        u32x4 o; o.x = pk_bf16(y0, y1); o.y = pk_bf16(y2, y3); o.z = pk_bf16(y4, y5); o.w = pk_bf16(y6, y7);
        *(u32x4*)(dst + e) = o; }
}
__device__ __forceinline__ void phase_norm(const Ctx& F, const float* xlat, const float* xctx, const float* gw, const float* mod, int shift_i, int scale_i, bf16_t* dst, int nrows) {
    for (int row = F.bid * 8 + F.wave; row < nrows; row += F.G * 8) {
        const bool isctx = row >= NLAT; const float* xr = isctx ? xctx + (size_t)(row - NLAT) * 2048 : xlat + (size_t)row * 2048;
        const int v = isctx ? 4 : (row >> 12);
        float x[32];
#pragma unroll
        for (int j = 0; j < 4; ++j) { const int e = j * 512 + F.lane * 8; const float4 a = *(const float4*)(xr + e), b = *(const float4*)(xr + e + 4);
            x[j * 8 + 0] = a.x; x[j * 8 + 1] = a.y; x[j * 8 + 2] = a.z; x[j * 8 + 3] = a.w; x[j * 8 + 4] = b.x; x[j * 8 + 5] = b.y; x[j * 8 + 6] = b.z; x[j * 8 + 7] = b.w; }
        norm_store(x, gw, mod + (size_t)v * 12288 + shift_i * 2048, mod + (size_t)v * 12288 + scale_i * 2048, dst + (size_t)row * 2048, F.lane);
    }
}

struct LayerW {
    const float *sc_w, *rw_w0, *rw_wup, *rw_a0, *rw_aup, *rw_gup, *rw_kk, *rw_ka, *rw_rk, *rw_lnw, *rw_lnb, *na_q, *na_k, *rpb, *s_cw, *s_cb, *s_dtb, *s_alog, *s_d, *s_norm;
};
__device__ __forceinline__ void unpack8(const u32x4 q, float (&f)[8]) { f[0] = bflo(q[0]); f[1] = bfhi(q[0]); f[2] = bflo(q[1]); f[3] = bfhi(q[1]); f[4] = bflo(q[2]); f[5] = bfhi(q[2]); f[6] = bflo(q[3]); f[7] = bfhi(q[3]); }
__device__ __forceinline__ u32x4 pack8f(const float (&f)[8]) { u32x4 o; o[0] = pk_bf16(f[0], f[1]); o[1] = pk_bf16(f[2], f[3]); o[2] = pk_bf16(f[4], f[5]); o[3] = pk_bf16(f[6], f[7]); return o; }
__device__ __forceinline__ void load8f(const float* p, float (&f)[8]) { const float4 a = *(const float4*)p, b = *(const float4*)(p + 4); f[0] = a.x; f[1] = a.y; f[2] = a.z; f[3] = a.w; f[4] = b.x; f[5] = b.y; f[6] = b.z; f[7] = b.w; }
__device__ __forceinline__ void phase_prep(const Ctx& F, const LayerW& W, unsigned char* ws) {
    const bf16_t* P = (const bf16_t*)(ws + WS_P);
    bf16_t* MIX = (bf16_t*)(ws + WS_MIX);
    bf16_t* XBC = (bf16_t*)(ws + WS_XBC); float* DTS = (float*)(ws + WS_DTS); float* DEC = (float*)(ws + WS_DEC);
    bf16_t* QN = (bf16_t*)(ws + WS_QN); bf16_t* KN = (bf16_t*)(ws + WS_KN); bf16_t* VTL = (bf16_t*)(ws + WS_VTL); bf16_t* VTC = (bf16_t*)(ws + WS_VTC);
    const float* ROPE = (const float*)(ws + WS_ROPE);
    for (int tile = F.bid; tile < NTOK / 8; tile += F.G) {
        int ln = F.lane; asm volatile("" : "+v"(ln));
        const int ch0 = ln * 8;
        const bool lat = tile < NLAT / 8;
        const int b = lat ? (tile >> 9) : ((tile - NLAT / 8) >> 5);
        const int t0 = lat ? (tile & 511) * 8 : ((tile - NLAT / 8) & 31) * 8;
        const int L = lat ? SEQL : CTXL;
        const int g0 = lat ? b * SEQL + t0 : NLAT + b * CTXL + t0;
        const bf16_t* Pr = P + (size_t)g0 * PTP;
        if (F.wave == 0 || F.wave == 4) {
            const bool gated = F.wave == 0;
            const float* cw = gated ? W.sc_w : W.s_cw; const int cstride = gated ? 512 : 1024;
            float w0[8], w1[8], w2[8], cb[8];
            load8f(cw + ch0, w0); load8f(cw + cstride + ch0, w1); load8f(cw + 2 * cstride + ch0, w2);
            if (gated) {
#pragma unroll
                for (int e = 0; e < 8; ++e) cb[e] = 0.f;
            } else load8f(W.s_cb + ch0, cb);
            const int col = gated ? A_CG : D_X;
#pragma unroll 1
            for (int tb = 0; tb < 8; tb += 4) {
            u32x4 ra[6], rb[6], rg[4];
#pragma unroll
            for (int q = 0; q < 6; ++q) { const int tq = t0 + tb - 1 + q; const bool ok = (tq >= 0) && (tq < L);
                ra[q] = ok ? *(const u32x4*)(Pr + (ptrdiff_t)(tb + q - 1) * PTP + col + ch0) : (u32x4){0u, 0u, 0u, 0u};
                if (gated) rb[q] = ok ? *(const u32x4*)(Pr + (ptrdiff_t)(tb + q - 1) * PTP + A_H + ch0) : (u32x4){0u, 0u, 0u, 0u}; }
            if (gated) {
#pragma unroll
                for (int tt = 0; tt < 4; ++tt) rg[tt] = *(const u32x4*)(Pr + (size_t)(tb + tt) * PTP + A_BG + ch0); }
            float up[8], uc[8], un[8];
            { float x[8], y[8]; unpack8(ra[0], x); if (gated) { unpack8(rb[0], y);
#pragma unroll
                for (int e = 0; e < 8; ++e) x[e] *= y[e]; }
#pragma unroll
              for (int e = 0; e < 8; ++e) up[e] = x[e];
              unpack8(ra[1], x); if (gated) { unpack8(rb[1], y);
#pragma unroll
                for (int e = 0; e < 8; ++e) x[e] *= y[e]; }
#pragma unroll
              for (int e = 0; e < 8; ++e) uc[e] = x[e]; }
#pragma unroll
            for (int tt = 0; tt < 4; ++tt) {
                { float x[8], y[8]; unpack8(ra[tt + 2], x); if (gated) { unpack8(rb[tt + 2], y);
#pragma unroll
                    for (int e = 0; e < 8; ++e) x[e] *= y[e]; }
#pragma unroll
                  for (int e = 0; e < 8; ++e) un[e] = x[e]; }
                float o[8];
                if (gated) { float bg[8]; unpack8(rg[tt], bg);
#pragma unroll
                    for (int e = 0; e < 8; ++e) o[e] = bg[e] * (w0[e] * up[e] + w1[e] * uc[e] + w2[e] * un[e]);
                    *(u32x4*)(MIX + (size_t)(g0 + tb + tt) * 2048 + ch0) = pack8f(o);
                } else {
#pragma unroll
                    for (int e = 0; e < 8; ++e) o[e] = siluf_(w0[e] * up[e] + w1[e] * uc[e] + w2[e] * un[e] + cb[e]);
                    *(u32x4*)(XBC + (size_t)(g0 + tb + tt) * 1024 + ch0) = pack8f(o); }
#pragma unroll
                for (int e = 0; e < 8; ++e) { up[e] = uc[e]; uc[e] = un[e]; }
            }
            }
        } else if (F.wave == 1 || F.wave == 2) {
            const bool isq = F.wave == 1; const int col = isq ? C_Q : C_K; bf16_t* dst = isq ? QN : KN;
            float nw[8]; load8f((isq ? W.na_q : W.na_k) + (ln & 7) * 8, nw);
            const float sc = isq ? 0.125f : 1.0f;
            u32x4 rq[8];
#pragma unroll
            for (int tt = 0; tt < 8; ++tt) rq[tt] = *(const u32x4*)(Pr + (size_t)tt * PTP + col + ch0);
#pragma unroll
            for (int tt = 0; tt < 8; ++tt) { float x[8]; unpack8(rq[tt], x); float ss = 0.f;
#pragma unroll
                for (int e = 0; e < 8; ++e) ss += x[e] * x[e];
                ss = sum8(ss); const float rs = rsqrtf(ss * (1.f / 64.f) + 1e-6f) * sc;
#pragma unroll
                for (int e = 0; e < 8; ++e) x[e] = x[e] * rs * nw[e];
                if (isq) *(u32x4*)(dst + (size_t)(g0 + tt) * 512 + ch0) = pack8f(x);
                else {
                    const int hh = ln >> 3, p = ln & 7, t = t0 + tt;
                    bf16_t* kd = lat ? dst + ((size_t)((((b * 8 + hh) * 64 + (t >> 6)) * 2 + (p >> 2)) * 4 + (p & 3)) * 64 + (t & 63)) * 8
                                     : dst + (size_t)NLAT * 512 + ((size_t)(((b * 8 + hh) * 2 + (p >> 2)) * 4 + (p & 3)) * 256 + t) * 8;
                    *(u32x4*)kd = pack8f(x); } }
        } else if (F.wave == 3) {
            u32x4 rv[8];
#pragma unroll
            for (int tt = 0; tt < 8; ++tt) rv[tt] = *(const u32x4*)(Pr + (size_t)tt * PTP + C_V + ch0);
            const int h = ln >> 3;
#pragma unroll
            for (int e = 0; e < 8; ++e) { const int i = (ln & 7) * 8 + e;
                unsigned short v[8];
#pragma unroll
                for (int tt = 0; tt < 8; ++tt) v[tt] = (unsigned short)((e & 1) ? (rv[tt][e >> 1] >> 16) : (rv[tt][e >> 1] & 0xffffu));
                u32x2 c0; c0.x = (unsigned)v[0] | ((unsigned)v[1] << 16); c0.y = (unsigned)v[2] | ((unsigned)v[3] << 16);
                u32x2 c1; c1.x = (unsigned)v[4] | ((unsigned)v[5] << 16); c1.y = (unsigned)v[6] | ((unsigned)v[7] << 16);
                if (lat) { const int row = t0 >> 6, x0 = (t0 & 63) >> 2, x1 = x0 + 1;
                    bf16_t* base = VTL + ((size_t)((b * 8 + h) * 64 + row) * 12 * 64 + i) * 8;
                    if (x0 <= 11) *(u32x2*)(base + x0 * 512) = c0;
                    if (x0 >= 4)  *(u32x2*)(base + (x0 - 4) * 512 + 4) = c0;
                    if (x1 <= 11) *(u32x2*)(base + x1 * 512) = c1;
                    if (x1 >= 4)  *(u32x2*)(base + (x1 - 4) * 512 + 4) = c1;
                } else { const int m = t0 >> 5, o = t0 & 31, gq = (o & 15) >> 2, hf = (o >> 4) * 4;
                    bf16_t* base = VTC + ((size_t)(((b * 8 + h) * 8 + m) * 4) * 64 + i) * 8;
                    *(u32x2*)(base + gq * 512 + hf) = c0; *(u32x2*)(base + (gq + 1) * 512 + hf) = c1; } }
        } else if (F.wave == 5 || F.wave == 7) {
            {
                const int pg = ln & 15, tb = (ln >> 4) * 2, which = F.wave == 7 ? 1 : 0, gi = (pg >> 3) & 1, half = (pg >> 2) & 1, i0 = (pg & 3) * 8;
                const int c1 = 512 + which * 256 + gi * 128 + half * 64 + i0, c2 = c1 + 32;
                float wa0[8], wa1[8], wa2[8], ba[8], wb0[8], wb1[8], wb2[8], bb[8];
                load8f(W.s_cw + c1, wa0); load8f(W.s_cw + 1024 + c1, wa1); load8f(W.s_cw + 2048 + c1, wa2); load8f(W.s_cb + c1, ba);
                load8f(W.s_cw + c2, wb0); load8f(W.s_cw + 1024 + c2, wb1); load8f(W.s_cw + 2048 + c2, wb2); load8f(W.s_cb + c2, bb);
                u32x4 ra[4], rb[4];
#pragma unroll
                for (int q = 0; q < 4; ++q) { const int tq = t0 + tb - 1 + q; const bool ok = (tq >= 0) && (tq < L);
                    ra[q] = ok ? *(const u32x4*)(Pr + (ptrdiff_t)(tb + q - 1) * PTP + D_X + c1) : (u32x4){0u, 0u, 0u, 0u};
                    rb[q] = ok ? *(const u32x4*)(Pr + (ptrdiff_t)(tb + q - 1) * PTP + D_X + c2) : (u32x4){0u, 0u, 0u, 0u}; }
                float ap[8], ac[8], an[8], bp[8], bc[8], bn[8];
                unpack8(ra[0], ap); unpack8(ra[1], ac); unpack8(rb[0], bp); unpack8(rb[1], bc);
#pragma unroll
                for (int tt = 0; tt < 2; ++tt) { unpack8(ra[tt + 2], an); unpack8(rb[tt + 2], bn);
                    float y1[8], y2[8];
#pragma unroll
                    for (int e = 0; e < 8; ++e) { y1[e] = siluf_(wa0[e] * ap[e] + wa1[e] * ac[e] + wa2[e] * an[e] + ba[e]); y2[e] = siluf_(wb0[e] * bp[e] + wb1[e] * bc[e] + wb2[e] * bn[e] + bb[e]); }
                    if (lat) { const int t = t0 + tb + tt, pos = half ? (t & 63) : (t >> 6);
                        float cs[16];
#pragma unroll
                        for (int q = 0; q < 4; ++q) { const float4 v = *(const float4*)(ROPE + (size_t)(pos * 32 + i0) * 2 + 4 * q); cs[4 * q] = v.x; cs[4 * q + 1] = v.y; cs[4 * q + 2] = v.z; cs[4 * q + 3] = v.w; }
#pragma unroll
                        for (int e = 0; e < 8; ++e) { const float o1 = y1[e] * cs[2 * e] - y2[e] * cs[2 * e + 1], o2 = y1[e] * cs[2 * e + 1] + y2[e] * cs[2 * e]; y1[e] = o1; y2[e] = o2; } }
                    *(u32x4*)(XBC + (size_t)(g0 + tb + tt) * 1024 + c1) = pack8f(y1); *(u32x4*)(XBC + (size_t)(g0 + tb + tt) * 1024 + c2) = pack8f(y2);
#pragma unroll
                    for (int e = 0; e < 8; ++e) { ap[e] = ac[e]; ac[e] = an[e]; bp[e] = bc[e]; bc[e] = bn[e]; }
                }
            }
        } else if (F.wave == 6) {
#pragma unroll
            for (int q = 0; q < 2; ++q) { const int it = ln + 64 * q, tt = it >> 4, j = it & 15;
                const float x = bf2f(Pr[(size_t)tt * PTP + D_DT + j]) + W.s_dtb[j];
                const float sp = fmaxf(x, 0.f) + log1pf(__expf(-fabsf(x)));
                DTS[(size_t)(g0 + tt) * 16 + j] = sp; DEC[(size_t)(g0 + tt) * 16 + j] = -sp * __expf(W.s_alog[j]); }
        }
    }
}

constexpr int SB_PITCH = 136;
__device__ __forceinline__ void ssd_scan_load(const Ctx& F, const float* LA, int g0, int h, float& a0, float& a1) {
    const int d = F.wave, i = F.lane, t0 = d ? 127 - 2 * i : 2 * i, t1 = d ? 126 - 2 * i : 2 * i + 1;
    a0 = LA[(size_t)(g0 + t0) * 16 + d * 8 + h]; a1 = LA[(size_t)(g0 + t1) * 16 + d * 8 + h];
}
__device__ __forceinline__ void ssd_scan_write(const Ctx& F, LAS float* sL, float a0, float a1) {
    const int d = F.wave, i = F.lane, t0 = d ? 127 - 2 * i : 2 * i, t1 = d ? 126 - 2 * i : 2 * i + 1;
    float p = a0 + a1;
    p += dpp_f<0x111>(p); p += dpp_f<0x112>(p); p += dpp_f<0x114>(p); p += dpp_f<0x118>(p);
    const float r0 = __int_as_float(__builtin_amdgcn_readlane(__float_as_int(p), 15)), r1 = __int_as_float(__builtin_amdgcn_readlane(__float_as_int(p), 31)), r2 = __int_as_float(__builtin_amdgcn_readlane(__float_as_int(p), 47));
    const int row = i >> 4; p += (row >= 1 ? r0 : 0.f) + (row >= 2 ? r1 : 0.f) + (row >= 3 ? r2 : 0.f);
    sL[d * 128 + t1] = p; sL[d * 128 + t0] = p - a1;
}
template <bool PASS2>
__device__ __forceinline__ void ssd_task(const Ctx& F, const LayerW& W, unsigned char* ws, int task) {
    const bf16_t* XBC = (const bf16_t*)(ws + WS_XBC); const float* DTS = (const float*)(ws + WS_DTS); const float* LA = (const float*)(ws + WS_DEC);
    float* SST = (float*)(ws + WS_SST); float* SCD = (float*)(ws + WS_SCD); float* YS = (float*)(ws + WS_YS);
    const int c = task % NCH, bh = task / NCH, h = bh & 7, b = bh >> 3, gi = h >> 2;
    const int g0 = c < 2 ? NLAT + b * CTXL + c * 128 : b * SEQL + (c - 2) * 128;
    const int w = F.wave, l16 = F.lane & 15, g = F.lane >> 4;
    const f32x4 z4 = {0.f, 0.f, 0.f, 0.f};
    LAS float* sL = (LAS float*)(F.lds + 131072);
    LAS float* sDT = sL + 256;
    __syncthreads();
    float la0 = 0.f, la1 = 0.f;
    if (w < 2) ssd_scan_load(F, LA, g0, h, la0, la1);
    if (F.tid < 256) { const int s = F.tid >> 1, d = F.tid & 1; sDT[F.tid] = DTS[(size_t)(g0 + s) * 16 + d * 8 + h]; }
    if (!PASS2) {
        if (w < 2) ssd_scan_write(F, sL, la0, la1);
        __syncthreads();
        LAS bf16_t* sBT = (LAS bf16_t*)F.lds;
        LAS bf16_t* sXT = sBT + 128 * SB_PITCH;
#pragma unroll
        for (int q = 0; q < 4; ++q) { const int v = F.tid + 512 * q, s = v >> 4, part = v & 15;
            const u32x4 bv = *(const u32x4*)(XBC + (size_t)(g0 + s) * 1024 + 512 + gi * 128 + part * 8);
#pragma unroll
            for (int e = 0; e < 4; ++e) { sBT[(part * 8 + 2 * e) * SB_PITCH + s] = (bf16_t)(bv[e] & 0xffffu); sBT[(part * 8 + 2 * e + 1) * SB_PITCH + s] = (bf16_t)(bv[e] >> 16); } }
#pragma unroll
        for (int q = 0; q < 2; ++q) { const int v = F.tid + 512 * q, s = v >> 3, part = v & 7;
            const u32x4 xv = *(const u32x4*)(XBC + (size_t)(g0 + s) * 1024 + h * 64 + part * 8);
            const float sc0 = sDT[s * 2] * __expf(sL[127] - sL[s]), sc1 = sDT[s * 2 + 1] * __expf(sL[128] - sL[128 + s]);
#pragma unroll
            for (int e = 0; e < 4; ++e) { const float lo = bflo(xv[e]), hi = bfhi(xv[e]); const int p = part * 8 + 2 * e;
                sXT[p * SB_PITCH + s] = f2bf(lo * sc0); sXT[(p + 1) * SB_PITCH + s] = f2bf(hi * sc0);
                sXT[(64 + p) * SB_PITCH + s] = f2bf(lo * sc1); sXT[(64 + p + 1) * SB_PITCH + s] = f2bf(hi * sc1); } }
        __syncthreads();
        bf16x8 bfr[4];
#pragma unroll
        for (int ks = 0; ks < 4; ++ks) bfr[ks] = *(const LAS bf16x8*)(sBT + (16 * w + l16) * SB_PITCH + 32 * ks + 8 * g);
#pragma unroll
        for (int d = 0; d < 2; ++d) {
            float* st = SST + ((size_t)((b * 8 + h) * 2 + d) * NCH + c) * 8192;
#pragma unroll
            for (int pt = 0; pt < 4; ++pt) { f32x4 acc = z4;
#pragma unroll
                for (int ks = 0; ks < 4; ++ks) acc = __builtin_amdgcn_mfma_f32_16x16x32_bf16(*(const LAS bf16x8*)(sXT + (d * 64 + 16 * pt + l16) * SB_PITCH + 32 * ks + 8 * g), bfr[ks], acc, 0, 0, 0);
#pragma unroll
                for (int r = 0; r < 4; ++r) st[(16 * pt + 4 * g + r) * 128 + 16 * w + l16] = acc[r]; }
            if (F.tid == 0) SCD[((b * 8 + h) * 2 + d) * NCH + c] = __expf(d ? sL[128] : sL[127]);
        }
    } else {
        LAS bf16_t* sB = (LAS bf16_t*)F.lds;
        LAS bf16_t* sC = sB + 128 * SB_PITCH;
        LAS bf16_t* sXT = sC + 128 * SB_PITCH;
        LAS bf16_t* sS = sXT + 64 * SB_PITCH;
#pragma unroll
        for (int q = 0; q < 4; ++q) { const int v = F.tid + 512 * q, s = v >> 4, part = v & 15;
            *(LAS u32x4*)(sB + s * SB_PITCH + part * 8) = *(const u32x4*)(XBC + (size_t)(g0 + s) * 1024 + 512 + gi * 128 + part * 8);
            *(LAS u32x4*)(sC + s * SB_PITCH + part * 8) = *(const u32x4*)(XBC + (size_t)(g0 + s) * 1024 + 768 + gi * 128 + part * 8); }
#pragma unroll
        for (int q = 0; q < 2; ++q) { const int v = F.tid + 512 * q, s = v >> 3, part = v & 7;
            const u32x4 xv = *(const u32x4*)(XBC + (size_t)(g0 + s) * 1024 + h * 64 + part * 8);
#pragma unroll
            for (int e = 0; e < 4; ++e) { sXT[(part * 8 + 2 * e) * SB_PITCH + s] = (bf16_t)(xv[e] & 0xffffu); sXT[(part * 8 + 2 * e + 1) * SB_PITCH + s] = (bf16_t)(xv[e] >> 16); } }
#pragma unroll
        for (int q = 0; q < 4; ++q) { const int v = F.tid + 512 * q, d = v >> 10, p = (v >> 4) & 63, part = v & 15;
            const float* sp = SST + ((size_t)((b * 8 + h) * 2 + d) * NCH + c) * 8192 + p * 128 + part * 8;
            const float4 a0 = *(const float4*)sp, a1 = *(const float4*)(sp + 4);
            u32x4 o; o.x = pk_bf16(a0.x, a0.y); o.y = pk_bf16(a0.z, a0.w); o.z = pk_bf16(a1.x, a1.y); o.w = pk_bf16(a1.z, a1.w);
            *(LAS u32x4*)(sS + (d * 64 + p) * SB_PITCH + part * 8) = o; }
        if (w < 2) ssd_scan_write(F, sL, la0, la1);
        __syncthreads();
        const int t = 16 * w + l16;
        bf16x8 cfr[4];
#pragma unroll
        for (int ks = 0; ks < 4; ++ks) cfr[ks] = *(const LAS bf16x8*)(sC + t * SB_PITCH + 32 * ks + 8 * g);
        f32x4 gt[8];
#pragma unroll
        for (int a = 0; a < 8; ++a) { f32x4 acc = z4;
#pragma unroll
            for (int ks = 0; ks < 4; ++ks) acc = __builtin_amdgcn_mfma_f32_16x16x32_bf16(*(const LAS bf16x8*)(sB + (16 * a + l16) * SB_PITCH + 32 * ks + 8 * g), cfr[ks], acc, 0, 0, 0);
            gt[a] = acc; }
        f32x4 ysum[4] = {z4, z4, z4, z4};
#pragma unroll
        for (int d = 0; d < 2; ++d) {
            const float Lt = sL[d * 128 + t], eLt = __expf(Lt);
            f32x4 acc[4];
#pragma unroll
            for (int pt = 0; pt < 4; ++pt) { f32x4 a = z4;
#pragma unroll
                for (int ks = 0; ks < 4; ++ks) a = __builtin_amdgcn_mfma_f32_16x16x32_bf16(*(const LAS bf16x8*)(sS + (d * 64 + 16 * pt + l16) * SB_PITCH + 32 * ks + 8 * g), cfr[ks], a, 0, 0, 0);
                acc[pt] = a * eLt; }
#pragma unroll
            for (int m = 0; m < 4; ++m) {
                const bool need = d ? (2 * m + 1 >= w) : (2 * m <= w);
                if (need) {
                    f32x4 wt[2];
#pragma unroll
                    for (int u = 0; u < 2; ++u) { const int a = 2 * m + u;
                        const f32x4 Ls = *(const LAS f32x4*)(sL + d * 128 + 16 * a + 4 * g);
                        const f32x4 dq0 = *(const LAS f32x4*)(sDT + (16 * a + 4 * g) * 2), dq1 = *(const LAS f32x4*)(sDT + (16 * a + 4 * g) * 2 + 4);
                        const float dts[4] = {dq0[d], dq0[2 + d], dq1[d], dq1[2 + d]};
#pragma unroll
                        for (int r = 0; r < 4; ++r) { const int s = 16 * a + 4 * g + r; const bool ok = d ? (s >= t) : (s <= t);
                            const float okf = ok ? 1.f : 0.f;
                            wt[u][r] = gt[a][r] * __expf(fminf(Lt - Ls[r], 0.f)) * (dts[r] * okf); } }
                    const bf16x8 bfrag = pack8(wt[0], wt[1]);
#pragma unroll
                    for (int pt = 0; pt < 4; ++pt) { union { bf16x8 v; u32x2 hh[2]; } af;
                        af.hh[0] = *(const LAS u32x2*)(sXT + (16 * pt + l16) * SB_PITCH + 32 * m + 4 * g); af.hh[1] = *(const LAS u32x2*)(sXT + (16 * pt + l16) * SB_PITCH + 32 * m + 16 + 4 * g);
                        acc[pt] = __builtin_amdgcn_mfma_f32_16x16x32_bf16(af.v, bfrag, acc[pt], 0, 0, 0); }
                }
            }
#pragma unroll
            for (int pt = 0; pt < 4; ++pt) ysum[pt] = ysum[pt] + acc[pt];
        }
        const float dsk = W.s_d[h];
#pragma unroll
        for (int pt = 0; pt < 4; ++pt) { const int p = 16 * pt + 4 * g;
            const u32x2 xv = *(const u32x2*)(XBC + (size_t)(g0 + t) * 1024 + h * 64 + p);
            *(float4*)(YS + (size_t)(g0 + t) * 512 + h * 64 + p) = make_float4(ysum[pt][0] + dsk * bflo(xv.x), ysum[pt][1] + dsk * bfhi(xv.x), ysum[pt][2] + dsk * bflo(xv.y), ysum[pt][3] + dsk * bfhi(xv.y)); }
    }
}
template <int D> __device__ __forceinline__ void ssd_combine_one(float4* base, const float* scd) {
    float4 carry = make_float4(0.f, 0.f, 0.f, 0.f);
#pragma unroll
    for (int k0 = 0; k0 < NCH; k0 += 17) {
        float4 tmp[17];
#pragma unroll
        for (int k = 0; k < 17; ++k) { const int kk = k0 + k, c = D ? (kk < 2 ? 1 - kk : 35 - kk) : kk; tmp[k] = base[(size_t)c * 2048]; }
#pragma unroll
        for (int k = 0; k < 17; ++k) { const int kk = k0 + k, c = D ? (kk < 2 ? 1 - kk : 35 - kk) : kk; const float a = scd[c];
            base[(size_t)c * 2048] = carry;
            carry.x = a * carry.x + tmp[k].x; carry.y = a * carry.y + tmp[k].y; carry.z = a * carry.z + tmp[k].z; carry.w = a * carry.w + tmp[k].w; }
    }
}
__device__ __forceinline__ void phase_ssd_combine(const Ctx& F, unsigned char* ws) {
    float4* SST4 = (float4*)(ws + WS_SST); const float* SCD = (const float*)(ws + WS_SCD);
    for (int gt = F.bid * 512 + F.tid; gt < 64 * 2048; gt += F.G * 512) {
        const int sidx = gt >> 11, e4 = gt & 2047;
        float4* base = SST4 + (size_t)sidx * NCH * 2048 + e4;
        if (sidx & 1) ssd_combine_one<1>(base, SCD + sidx * NCH); else ssd_combine_one<0>(base, SCD + sidx * NCH);
    }
}

constexpr int RWF_CHUNK = 13312;
constexpr int RW_NCHUNK = NPOS / 16;
template <int CTRL> __device__ __forceinline__ float dpp_id0(float v) { return __int_as_float(__builtin_amdgcn_update_dpp(0, __float_as_int(v), CTRL, 0xF, 0xF, true)); }
template <int CTRL> __device__ __forceinline__ float dpp_id1(float v) { return __int_as_float(__builtin_amdgcn_update_dpp(0x3f800000, __float_as_int(v), CTRL, 0xF, 0xF, false)); }
__device__ __forceinline__ float sel4(int g, float a, float b, float c, float d) { return g == 0 ? a : (g == 1 ? b : (g == 2 ? c : d)); }

template <int D> __device__ __forceinline__ void rwkv_pre_dir(const bf16_t* wupt, const bf16x8 (&bw)[2], const bf16x8 (&ba)[2], const f32x4 (&kk)[4], const f32x4 (&rr)[4], const f32x4 (&kx)[4],
        const float* w0p, const float* a0p, const float* kap, const float* rkp, float& bon, LAS unsigned char* wl, unsigned char* dst, int l16, int g) {
    LAS float* LT = (LAS float*)wl; LAS float* AT = LT + 256; LAS bf16_t* BT = (LAS bf16_t*)(wl + 2048); LAS bf16_t* KT = BT + 1024;
    const int lane = g * 16 + l16;
    bf16x8* o = (bf16x8*)dst;
    const f32x4 z4 = {0.f, 0.f, 0.f, 0.f};
    bf16x8 af[2], bf[2], kf[2], rf[2];
#pragma unroll
    for (int p = 0; p < 2; ++p) {
        f32x4 al[2], be[2], ka[2], rh[2];
#pragma unroll
        for (int mm = 0; mm < 2; ++mm) { const int m = 2 * p + mm; asm volatile("" ::: "memory");
            const bf16_t* wpw = wupt + ((size_t)D * 512 + 16 * m + l16) * 64 + 8 * g; const bf16_t* wpa = wupt + ((size_t)(2 + D) * 512 + 16 * m + l16) * 64 + 8 * g;
            f32x4 aw = __builtin_amdgcn_mfma_f32_16x16x32_bf16(*(const bf16x8*)wpw, bw[0], z4, 0, 0, 0); aw = __builtin_amdgcn_mfma_f32_16x16x32_bf16(*(const bf16x8*)(wpw + 32), bw[1], aw, 0, 0, 0);
            f32x4 aa = __builtin_amdgcn_mfma_f32_16x16x32_bf16(*(const bf16x8*)wpa, ba[0], z4, 0, 0, 0); aa = __builtin_amdgcn_mfma_f32_16x16x32_bf16(*(const bf16x8*)(wpa + 32), ba[1], aa, 0, 0, 0);
            const float4 w0 = *(const float4*)(w0p + 16 * m + 4 * g), a0 = *(const float4*)(a0p + 16 * m + 4 * g), kav = *(const float4*)(kap + 16 * m + 4 * g), rkv = *(const float4*)(rkp + 16 * m + 4 * g);
            const float w0a[4] = {w0.x, w0.y, w0.z, w0.w}, a0a[4] = {a0.x, a0.y, a0.z, a0.w}, kaa[4] = {kav.x, kav.y, kav.z, kav.w}, rka[4] = {rkv.x, rkv.y, rkv.z, rkv.w};
            f32x4 gcv;
#pragma unroll
            for (int r = 0; r < 4; ++r) {
                const float a = sigmoidf_(a0a[r] + aa[r]);
                const float kd = kx[m][r] * (1.f + (a - 1.f) * kaa[r]), bb = kk[m][r] * a;
                bon += rr[m][r] * kd * rka[r];
                float Lg = -0.8750387749205294f * sigmoidf_(w0a[r] + aw[r]);
                if (D == 0) { Lg += dpp_id0<0x111>(Lg); Lg += dpp_id0<0x112>(Lg); Lg += dpp_id0<0x114>(Lg); Lg += dpp_id0<0x118>(Lg); }
                else        { Lg += dpp_id0<0x101>(Lg); Lg += dpp_id0<0x102>(Lg); Lg += dpp_id0<0x104>(Lg); Lg += dpp_id0<0x108>(Lg); }
                const float Lex = (D == 0) ? dpp_id0<0x111>(Lg) : dpp_id0<0x101>(Lg);
                const float G = __builtin_amdgcn_exp2f(Lg), Gex = __builtin_amdgcn_exp2f(Lex), iG = __builtin_amdgcn_exp2f(-Lg);
                al[mm][r] = Gex * kk[m][r]; be[mm][r] = bb * iG; ka[mm][r] = kd * iG; rh[mm][r] = G * rr[m][r]; gcv[r] = G;
                const int k = 16 * m + 4 * g + r; const unsigned pk_ = pk_bf16(be[mm][r], ka[mm][r]); BT[k * 16 + l16] = (bf16_t)(pk_ & 0xffffu); KT[k * 16 + l16] = (bf16_t)(pk_ >> 16);
            }
            if (l16 == ((D == 0) ? 15 : 0)) *(float4*)((float*)(dst + 12288) + 16 * m + 4 * g) = make_float4(gcv[0], gcv[1], gcv[2], gcv[3]);
        }
        af[p] = pack8(al[0], al[1]); bf[p] = pack8(be[0], be[1]); kf[p] = pack8(ka[0], ka[1]); rf[p] = pack8(rh[0], rh[1]);
        o[64 * p + lane] = af[p]; o[128 + 64 * p + lane] = rf[p];
        __builtin_amdgcn_sched_barrier(0);
    }
    f32x4 Lm = __builtin_amdgcn_mfma_f32_16x16x32_bf16(af[0], bf[0], z4, 0, 0, 0); Lm = __builtin_amdgcn_mfma_f32_16x16x32_bf16(af[1], bf[1], Lm, 0, 0, 0);
    f32x4 Am = __builtin_amdgcn_mfma_f32_16x16x32_bf16(af[0], kf[0], z4, 0, 0, 0); Am = __builtin_amdgcn_mfma_f32_16x16x32_bf16(af[1], kf[1], Am, 0, 0, 0);
    f32x4 Bb = __builtin_amdgcn_mfma_f32_16x16x32_bf16(bf[0], rf[0], z4, 0, 0, 0); Bb = __builtin_amdgcn_mfma_f32_16x16x32_bf16(bf[1], rf[1], Bb, 0, 0, 0);
    f32x4 Bk = __builtin_amdgcn_mfma_f32_16x16x32_bf16(kf[0], rf[0], z4, 0, 0, 0); Bk = __builtin_amdgcn_mfma_f32_16x16x32_bf16(kf[1], rf[1], Bk, 0, 0, 0);
#pragma unroll
    for (int r = 0; r < 4; ++r) { const int row = 4 * g + r;
        const bool strict = (D == 0) ? (l16 < row) : (l16 > row);
        const bool incl = (D == 0) ? (row <= l16) : (row >= l16);
        Lm[r] = strict ? Lm[r] : 0.f; Am[r] = strict ? Am[r] : 0.f; Bb[r] = incl ? Bb[r] : 0.f; Bk[r] = incl ? Bk[r] : 0.f; }
    *(LAS f32x4*)(LT + l16 * 16 + 4 * g) = Lm; *(LAS f32x4*)(AT + l16 * 16 + 4 * g) = Am;
    o[320 + lane] = pack8(Bb, Bk);
    asm volatile("" ::: "memory");
#pragma unroll
    for (int m = 0; m < 4; ++m) { union { bf16x8 v; u32x2 h[2]; } f;
        f.h[0] = *(LAS u32x2*)(BT + (16 * m + l16) * 16 + 4 * g); f.h[1] = *(LAS u32x2*)(KT + (16 * m + l16) * 16 + 4 * g);
        o[384 + 64 * m + lane] = f.v; }
    __builtin_amdgcn_sched_barrier(0);
    float x[16];
    if (D == 0) {
#pragma unroll
        for (int c = 15; c >= 0; --c) { float s = (c == l16) ? 1.f : 0.f; asm volatile("" ::: "memory");
#pragma unroll
            for (int i = c + 1; i < 16; ++i) s -= x[i] * LT[c * 16 + i];
            x[c] = s; }
    } else {
#pragma unroll
        for (int c = 0; c < 16; ++c) { float s = (c == l16) ? 1.f : 0.f; asm volatile("" ::: "memory");
#pragma unroll
            for (int i = 0; i < c; ++i) s -= x[i] * LT[c * 16 + i];
            x[c] = s; }
    }
    f32x4 tm0, tm1;
#pragma unroll
    for (int r = 0; r < 4; ++r) tm0[r] = -sel4(g, x[r], x[4 + r], x[8 + r], x[12 + r]);
#pragma unroll
    for (int r = 0; r < 4; ++r) { const int c = 4 * g + r; float s = 0.f; asm volatile("" ::: "memory");
#pragma unroll
        for (int i = 0; i < 16; i += 4) { const f32x4 a4 = *(LAS f32x4*)(AT + c * 16 + i); s += x[i] * a4[0] + x[i + 1] * a4[1] + x[i + 2] * a4[2] + x[i + 3] * a4[3]; }
        tm1[r] = -s; }
    o[256 + lane] = pack8(tm0, tm1);
    asm volatile("" ::: "memory");
}
__device__ __forceinline__ void rwkv_pre_task(const Ctx& F, const LayerW& W, unsigned char* ws, const bf16_t* WUPT, int task, int dsel) {
    const bf16_t* P = (const bf16_t*)(ws + WS_P); float* BON = (float*)(ws + WS_BON); unsigned char* RWF = ws + WS_RWF;
    const int cidx = task % RW_NCHUNK, bh = task / RW_NCHUNK, h = bh & 7, b = bh >> 3;
    int ln_ = F.lane; asm volatile("" : "+v"(ln_));
    const int l16 = ln_ & 15, g = ln_ >> 4;
    const int pos = cidx * 16 + l16;
    const int tok = pos < CTXL ? NLAT + b * CTXL + pos : b * SEQL + (pos - CTXL);
    const bf16_t* Pr = P + (size_t)tok * PTP;
    LAS unsigned char* wl = F.lds + F.wave * 8192;
    bf16x8 bw[2], ba[2];
#pragma unroll
    for (int p = 0; p < 2; ++p) { const u32x4 q = *(const u32x4*)(Pr + B_WD + 32 * p + 8 * g); union { bf16x8 v; unsigned u[4]; } tq;
#pragma unroll
        for (int e = 0; e < 4; ++e) tq.u[e] = pk_bf16(tanhf_(bflo(q[e])), tanhf_(bfhi(q[e])));
        bw[p] = tq.v; ba[p] = *(const bf16x8*)(Pr + B_AD + 32 * p + 8 * g); }
    f32x4 kk[4], rr[4], kx[4];
    float ssq = 0.f;
#pragma unroll
    for (int m = 0; m < 4; ++m) { const int co = h * 64 + 16 * m + 4 * g;
        const u32x2 rq = *(const u32x2*)(Pr + B_R + co), kq = *(const u32x2*)(Pr + B_K + co); const float4 kkw = *(const float4*)(W.rw_kk + co);
        rr[m] = (f32x4){bflo(rq.x), bfhi(rq.x), bflo(rq.y), bfhi(rq.y)}; kx[m] = (f32x4){bflo(kq.x), bfhi(kq.x), bflo(kq.y), bfhi(kq.y)};
        kk[m] = (f32x4){kx[m][0] * kkw.x, kx[m][1] * kkw.y, kx[m][2] * kkw.z, kx[m][3] * kkw.w};
        ssq += kk[m][0] * kk[m][0] + kk[m][1] * kk[m][1] + kk[m][2] * kk[m][2] + kk[m][3] * kk[m][3]; }
    ssq += xor16_f(ssq); ssq = sum_x32(ssq);
    { const float rn = rsqrtf(ssq + 1e-12f);
#pragma unroll
      for (int m = 0; m < 4; ++m) kk[m] = kk[m] * rn; }
    float bon = 0.f;
    const int co = h * 64;
    const int c0 = cidx, c1 = cidx < 16 ? 15 - cidx : 287 - cidx;
    {
      const int tok0 = cidx < 16 ? NLAT + b * CTXL + cidx * 16 : b * SEQL + cidx * 16 - CTXL;
      const bf16_t* vp = P + (size_t)(tok0 + 4 * g) * PTP + B_V + h * 64 + l16;
      u32x2* vd = (u32x2*)(RWF + ((size_t)(bh * 2 + dsel) * RW_NCHUNK + (dsel ? c1 : c0)) * RWF_CHUNK + 10240) + ln_;
#pragma unroll
      for (int n = 0; n < 4; ++n) { u32x2 w; w.x = (unsigned)vp[16 * n] | ((unsigned)vp[PTP + 16 * n] << 16); w.y = (unsigned)vp[2 * PTP + 16 * n] | ((unsigned)vp[3 * PTP + 16 * n] << 16); vd[64 * n] = w; } }
    if (dsel == 0) rwkv_pre_dir<0>(WUPT + (size_t)co * 64, bw, ba, kk, rr, kx, W.rw_w0 + co, W.rw_a0 + co, W.rw_ka + co, W.rw_rk + co, bon, wl, RWF + ((size_t)(bh * 2 + 0) * RW_NCHUNK + c0) * RWF_CHUNK, l16, g);
    else           rwkv_pre_dir<1>(WUPT + (size_t)co * 64, bw, ba, kk, rr, kx, W.rw_w0 + 512 + co, W.rw_a0 + 512 + co, W.rw_ka + co, W.rw_rk + co, bon, wl, RWF + ((size_t)(bh * 2 + 1) * RW_NCHUNK + c1) * RWF_CHUNK, l16, g);
    bon += xor16_f(bon); bon = sum_x32(bon);
    if (g == 0) BON[((size_t)dsel * NTOK + tok) * 8 + h] = bon;
}
constexpr int RW_R = 10;
constexpr int RW_OP = 144;
struct RwFrag { bf16x8 a0, a1, r0, r1, tm, bb, bk0, bk1, bk2, bk3; f32x4 g0, g1, g2, g3; u32x2 v; };
__device__ __forceinline__ void rwkv_scan(const Ctx& F, unsigned char* ws, int sidx) {
    const unsigned char* base = ws + WS_RWF + (size_t)sidx * RW_NCHUNK * RWF_CHUNK;
    const int d = sidx & 1, h = (sidx >> 1) & 7, b = sidx >> 4;
    const int sgn = 1 - 2 * d, offA = d * 15, offB = d * 287;
    const int tokA = NLAT + b * CTXL, tokB = b * SEQL - CTXL;
    unsigned char* Yb = ws + WS_RWY + (size_t)d * NTOK * 1024;
    if (F.wave >= 4) {
        const int w = F.wave - 4; const unsigned lo = (unsigned)F.lane * 16u;
#define RW_DMA(ch) do { const int ch_ = (ch) < RW_NCHUNK ? (ch) : RW_NCHUNK - 1; const unsigned char* rec_ = base + (size_t)ch_ * RWF_CHUNK; LAS unsigned char* sl_ = F.lds + ((ch) % RW_R) * RWF_CHUNK; \
        _Pragma("unroll") for (int i_ = 0; i_ < 3; ++i_) __builtin_amdgcn_global_load_lds((const unsigned*)(rec_ + (w + 4 * i_) * 1024 + lo), (LAS unsigned*)(sl_ + (w + 4 * i_) * 1024), 16, 0, 0); \
        if (w == 0) __builtin_amdgcn_global_load_lds((const unsigned*)(rec_ + 12288 + lo), (LAS unsigned*)(sl_ + 12288), 16, 0, 0); } while (0)
#pragma unroll 1
        for (int ch = 0; ch < RW_R - 1; ++ch) RW_DMA(ch);
        asm volatile("s_waitcnt vmcnt(%0)" :: "n"(3 * (RW_R - 3)) : "memory");
        __builtin_amdgcn_s_barrier();
#pragma unroll 1
        for (int c = 0; c <= RW_NCHUNK; ++c) {
            asm volatile("s_waitcnt vmcnt(%0)" :: "n"(3 * (RW_R - 3)) : "memory");
            asm volatile("s_waitcnt lgkmcnt(0)" ::: "memory");
            __builtin_amdgcn_s_barrier();
            if (c < RW_NCHUNK) RW_DMA(c + RW_R - 1);
            if (c > 0 && ((c - 1) & 3) == w) {
                const int cp = c - 1, ci = ((cp) < 16 ? offA : offB) + sgn * cp, tk = ((ci) < 16 ? tokA : tokB) + ci * 16;
                const LAS unsigned char* ot = F.lds + RW_R * RWF_CHUNK + (cp & 1) * (16 * RW_OP) + (F.lane >> 2) * RW_OP + (F.lane & 3) * 16;
                const u32x4 v0 = *(const LAS u32x4*)ot, v1 = *(const LAS u32x4*)(ot + 64);
                unsigned char* yp = Yb + ((size_t)(tk + (F.lane >> 2)) * 512 + h * 64) * 2 + (F.lane & 3) * 16;
                *(u32x4*)yp = v0; *(u32x4*)(yp + 64) = v1; }
        }
        asm volatile("s_waitcnt vmcnt(0)" ::: "memory");
#undef RW_DMA
        return;
    }
    const int n = F.wave, l16 = F.lane & 15, g = F.lane >> 4;
    LAS unsigned char* otw = F.lds + RW_R * RWF_CHUNK + (4 * g) * RW_OP + (16 * n + l16) * 2;
#define RW_LDSF(fr, c) do { LAS unsigned char* sl_ = F.lds + ((c) % RW_R) * RWF_CHUNK; const LAS bf16x8* q_ = (const LAS bf16x8*)sl_ + F.lane; \
        fr.a0 = q_[0]; fr.a1 = q_[64]; fr.r0 = q_[128]; fr.r1 = q_[192]; fr.tm = q_[256]; fr.bb = q_[320]; fr.bk0 = q_[384]; fr.bk1 = q_[448]; fr.bk2 = q_[512]; fr.bk3 = q_[576]; \
        fr.v = *((const LAS u32x2*)(sl_ + 10240) + n * 64 + F.lane); \
        const LAS f32x4* gp_ = (const LAS f32x4*)(sl_ + 12288) + g; fr.g0 = gp_[0]; fr.g1 = gp_[4]; fr.g2 = gp_[8]; fr.g3 = gp_[12]; } while (0)
    f32x4 st0 = {0.f, 0.f, 0.f, 0.f}, st1 = st0, st2 = st0, st3 = st0;
    const f32x4 z4 = {0.f, 0.f, 0.f, 0.f};
#define RW_STEP(fr, c) do { \
        const bf16x8 s0_ = pack8(st0, st1), s1_ = pack8(st2, st3); \
        f32x4 x1_ = __builtin_amdgcn_mfma_f32_16x16x32_bf16(fr.a0, s0_, z4, 0, 0, 0); x1_ = __builtin_amdgcn_mfma_f32_16x16x32_bf16(fr.a1, s1_, x1_, 0, 0, 0); \
        f32x4 x2_ = __builtin_amdgcn_mfma_f32_16x16x32_bf16(fr.r0, s0_, z4, 0, 0, 0); x2_ = __builtin_amdgcn_mfma_f32_16x16x32_bf16(fr.r1, s1_, x2_, 0, 0, 0); \
        union { bf16x8 v; unsigned u[4]; } bx_; bx_.u[0] = pk_bf16(x1_[0], x1_[1]); bx_.u[1] = pk_bf16(x1_[2], x1_[3]); bx_.u[2] = fr.v.x; bx_.u[3] = fr.v.y; \
        const f32x4 e_ = __builtin_amdgcn_mfma_f32_16x16x32_bf16(fr.tm, bx_.v, z4, 0, 0, 0); \
        union { bf16x8 v; unsigned u[4]; } be_; be_.u[0] = pk_bf16(e_[0], e_[1]); be_.u[1] = pk_bf16(e_[2], e_[3]); be_.u[2] = fr.v.x; be_.u[3] = fr.v.y; \
        const f32x4 o_ = __builtin_amdgcn_mfma_f32_16x16x32_bf16(fr.bb, be_.v, x2_, 0, 0, 0); \
        st0 = __builtin_amdgcn_mfma_f32_16x16x32_bf16(fr.bk0, be_.v, st0, 0, 0, 0) * fr.g0; st1 = __builtin_amdgcn_mfma_f32_16x16x32_bf16(fr.bk1, be_.v, st1, 0, 0, 0) * fr.g1; \
        st2 = __builtin_amdgcn_mfma_f32_16x16x32_bf16(fr.bk2, be_.v, st2, 0, 0, 0) * fr.g2; st3 = __builtin_amdgcn_mfma_f32_16x16x32_bf16(fr.bk3, be_.v, st3, 0, 0, 0) * fr.g3; \
        const unsigned p01_ = pk_bf16(o_[0], o_[1]), p23_ = pk_bf16(o_[2], o_[3]); LAS unsigned char* ow_ = otw + ((c) & 1) * (16 * RW_OP); \
        *(LAS bf16_t*)ow_ = (bf16_t)(p01_ & 0xffffu); *(LAS bf16_t*)(ow_ + RW_OP) = (bf16_t)(p01_ >> 16); *(LAS bf16_t*)(ow_ + 2 * RW_OP) = (bf16_t)(p23_ & 0xffffu); *(LAS bf16_t*)(ow_ + 3 * RW_OP) = (bf16_t)(p23_ >> 16); } while (0)
    RwFrag fa, fb;
    __builtin_amdgcn_s_barrier(); asm volatile("" ::: "memory");
    RW_LDSF(fa, 0);
#pragma unroll 1
    for (int c = 0; c < RW_NCHUNK; c += 2) {
        asm volatile("s_waitcnt lgkmcnt(0)" ::: "memory"); __builtin_amdgcn_s_barrier(); asm volatile("" ::: "memory");
        RW_LDSF(fb, c + 1); RW_STEP(fa, c);
        asm volatile("s_waitcnt lgkmcnt(0)" ::: "memory"); __builtin_amdgcn_s_barrier(); asm volatile("" ::: "memory");
        RW_LDSF(fa, c + 2); RW_STEP(fb, c + 1);
    }
    asm volatile("s_waitcnt lgkmcnt(0)" ::: "memory"); __builtin_amdgcn_s_barrier();
#undef RW_LDSF
#undef RW_STEP
}

__device__ __forceinline__ void na_tile(const Ctx& F, unsigned char* ws, const LAS float* sBias, int tile) {
    const bf16_t* QN = (const bf16_t*)(ws + WS_QN); const bf16_t* KN = (const bf16_t*)(ws + WS_KN);
    const bf16_t* VTL = (const bf16_t*)(ws + WS_VTL); const bf16_t* VTC = (const bf16_t*)(ws + WS_VTC); bf16_t* MIX = (bf16_t*)(ws + WS_MIX);
    const int h = F.wave, l16 = F.lane & 15, g = F.lane >> 4;
    const bool lat = tile < 1024;
    int b, r = 0, j = 0, gq;
    if (lat) { b = tile >> 8; r = (tile >> 2) & 63; j = tile & 3; gq = b * SEQL + r * 64 + j * 16 + l16; }
    else { const int tc = tile - 1024; b = tc >> 4; gq = NLAT + b * CTXL + (tc & 15) * 16 + l16; }
    const int row0 = min(max(r - 4, 0), 56), col0 = min(max(16 * j - 8, 0), 32);
    bf16x8 qf0, qf1;
    { const bf16_t* qp = QN + (size_t)gq * 512 + h * 64 + g * 8; qf0 = *(const bf16x8*)qp; qf1 = *(const bf16x8*)(qp + 32); }
    const f32x4 zero4 = {0.f, 0.f, 0.f, 0.f};
    const int cq = 16 * j + l16, win0 = min(max(cq - 8, 0), 48);
    const bf16_t* knb = KN + ((size_t)((((b * 8 + h) * 64 + row0) * 2) * 4 + g) * 64 + col0 + l16) * 8;
    const bf16_t* kcx = KN + (size_t)NLAT * 512 + ((size_t)(((b * 8 + h) * 2) * 4 + g) * 256 + l16) * 8;
    const bf16_t* vnb = VTL + ((size_t)(((b * 8 + h) * 64 + row0) * 12 + col0 / 4 + g) * 64 + l16) * 8;
    const bf16_t* vcx = VTC + ((size_t)(((b * 8 + h) * 8) * 4 + g) * 64 + l16) * 8;
    float mrun = -1e30f, lrun = 0.f;
    f32x4 o[4] = {zero4, zero4, zero4, zero4};
#pragma unroll
    for (int hf = 0; hf < 2; ++hf) {
        if (hf == 0 && !lat) continue;
        bf16x8 fr[32];
#pragma unroll
        for (int T = 0; T < 16; ++T) { const bf16_t* kp = hf == 0 ? knb + (size_t)((T >> 1) * 8) * 512 + (T & 1) * 128 : kcx + T * 128;
            fr[2 * T] = *(const bf16x8*)kp; fr[2 * T + 1] = *(const bf16x8*)(kp + (hf == 0 ? 4 * 512 : 4 * 2048)); }
        asm volatile("" ::: "memory");
        f32x4 acc[16];
#pragma unroll
        for (int T = 0; T < 16; ++T) { f32x4 a = __builtin_amdgcn_mfma_f32_16x16x32_bf16(fr[2 * T], qf0, zero4, 0, 0, 0); a = __builtin_amdgcn_mfma_f32_16x16x32_bf16(fr[2 * T + 1], qf1, a, 0, 0, 0);
            if (hf == 0) { const int ir = T >> 1, hh = T & 1, kr = row0 + ir; const LAS float* bias = sBias + (kr - r + 7) * 31;
#pragma unroll
                for (int e = 0; e < 4; ++e) { const int kc = col0 + 16 * hh + 4 * g + e; const bool ok = (kc >= win0) && (kc < win0 + 16);
                    const int dc = min(max(kc - cq + 15, 0), 30); a[e] = ok ? a[e] + bias[dc] : -1e30f; } }
            acc[T] = a; }
#pragma unroll
        for (int m = 0; m < 8; ++m)
#pragma unroll
            for (int dt = 0; dt < 4; ++dt) fr[4 * m + dt] = *(const bf16x8*)(hf == 0 ? vnb + (size_t)m * 12 * 512 + dt * 128 : vcx + (size_t)m * 4 * 512 + dt * 128);
        asm volatile("" ::: "memory");
        float mx = mrun;
#pragma unroll
        for (int T = 0; T < 16; ++T) mx = fmaxf(fmaxf(fmaxf(acc[T][0], acc[T][1]), fmaxf(acc[T][2], acc[T][3])), mx);
        mx = fmaxf(mx, xor16_f(mx)); mx = max_x32(mx);
        const float alpha = __expf(mrun - mx);
        float lsum = 0.f;
#pragma unroll
        for (int T = 0; T < 16; ++T) {
#pragma unroll
            for (int q = 0; q < 4; ++q) { const float pv = __expf(acc[T][q] - mx); acc[T][q] = pv; lsum += pv; } }
        lsum += xor16_f(lsum); lsum = sum_x32(lsum);
        lrun = lrun * alpha + lsum; mrun = mx;
#pragma unroll
        for (int dt = 0; dt < 4; ++dt) o[dt] = o[dt] * alpha;
#pragma unroll
        for (int m = 0; m < 8; ++m) { const bf16x8 pf = pack8(acc[2 * m], acc[2 * m + 1]);
#pragma unroll
            for (int dt = 0; dt < 4; ++dt) o[dt] = __builtin_amdgcn_mfma_f32_16x16x32_bf16(fr[4 * m + dt], pf, o[dt], 0, 0, 0); }
    }
    const float inv = 1.0f / lrun;
#pragma unroll
    for (int dt = 0; dt < 4; ++dt) { u32x2 w; w.x = pk_bf16(o[dt][0] * inv, o[dt][1] * inv); w.y = pk_bf16(o[dt][2] * inv, o[dt][3] * inv);
        *(u32x2*)(MIX + (size_t)gq * 2048 + 1024 + h * 64 + dt * 16 + 4 * g) = w; }
}
__device__ __forceinline__ void na_phase(const Ctx& F, const LayerW& W, unsigned char* ws, int blk, int nblk, int ntile) {
    LAS float* sBias = (LAS float*)(F.lds + F.wave * 2048);
    __syncthreads();
    for (int idx = F.lane; idx < 465; idx += 64) sBias[idx] = W.rpb[F.wave * 465 + idx];
    asm volatile("" ::: "memory");
    for (int tile = blk; tile < ntile; tile += nblk) na_tile(F, ws, sBias, tile);
}

__device__ __forceinline__ void phase_finish(const Ctx& F, const LayerW& W, unsigned char* ws, const bf16_t* GUPT, int ntok) {
    const bf16_t* P = (const bf16_t*)(ws + WS_P); bf16_t* MIX = (bf16_t*)(ws + WS_MIX);
    const bf16_t* RWY = (const bf16_t*)(ws + WS_RWY); const float* BON = (const float*)(ws + WS_BON); const float* YS = (const float*)(ws + WS_YS);
    const f32x4 z4 = {0.f, 0.f, 0.f, 0.f};
    for (int task = F.bid * 8 + F.wave; task < (ntok / 16) * 8; task += F.G * 8) {
        int ln = F.lane; asm volatile("" : "+v"(ln));
        const int l16 = ln & 15, g = ln >> 4, h = task & 7, tok = (task >> 3) * 16 + l16;
        const bf16_t* Pr = P + (size_t)tok * PTP;
        bf16x8 sg[4];
#pragma unroll
        for (int ks = 0; ks < 4; ++ks) { const u32x4 q = *(const u32x4*)(Pr + B_GD + 32 * ks + 8 * g); union { bf16x8 v; unsigned u[4]; } s;
#pragma unroll
            for (int e = 0; e < 4; ++e) s.u[e] = pk_bf16(sigmoidf_(bflo(q[e])), sigmoidf_(bfhi(q[e])));
            sg[ks] = s.v; }
        f32x4 y[4]; float s1 = 0.f;
#pragma unroll
        for (int m = 0; m < 4; ++m) { const int co = h * 64 + 16 * m + 4 * g;
            const u32x2 a = *(const u32x2*)(RWY + (size_t)tok * 512 + co), bq = *(const u32x2*)(RWY + ((size_t)NTOK + tok) * 512 + co);
            y[m] = (f32x4){bflo(a.x) + bflo(bq.x), bfhi(a.x) + bfhi(bq.x), bflo(a.y) + bflo(bq.y), bfhi(a.y) + bfhi(bq.y)};
            s1 += (y[m][0] + y[m][1]) + (y[m][2] + y[m][3]); }
        s1 += xor16_f(s1); s1 = sum_x32(s1);
        const float mu = s1 * (1.f / 64.f); float s2 = 0.f;
#pragma unroll
        for (int m = 0; m < 4; ++m) { y[m] = y[m] - mu; s2 += (y[m][0] * y[m][0] + y[m][1] * y[m][1]) + (y[m][2] * y[m][2] + y[m][3] * y[m][3]); }
        s2 += xor16_f(s2); s2 = sum_x32(s2);
        const float rs = rsqrtf(s2 * (1.f / 64.f) + 64e-5f);
        const float bon = BON[(size_t)tok * 8 + h] + BON[((size_t)NTOK + tok) * 8 + h];
#pragma unroll
        for (int m = 0; m < 4; ++m) { const int co = h * 64 + 16 * m + 4 * g;
            f32x4 ga = z4;
#pragma unroll
            for (int ks = 0; ks < 4; ++ks) ga = __builtin_amdgcn_mfma_f32_16x16x32_bf16(*(const bf16x8*)(GUPT + (size_t)(h * 64 + 16 * m + l16) * 128 + 32 * ks + 8 * g), sg[ks], ga, 0, 0, 0);
            const float4 lw = *(const float4*)(W.rw_lnw + co), lb = *(const float4*)(W.rw_lnb + co); const u32x2 vq = *(const u32x2*)(Pr + B_V + co);
            const float o0 = (y[m][0] * rs * lw.x + lb.x + bon * bflo(vq.x)) * ga[0], o1 = (y[m][1] * rs * lw.y + lb.y + bon * bfhi(vq.x)) * ga[1];
            const float o2 = (y[m][2] * rs * lw.z + lb.z + bon * bflo(vq.y)) * ga[2], o3 = (y[m][3] * rs * lw.w + lb.w + bon * bfhi(vq.y)) * ga[3];
            u32x2 o; o.x = pk_bf16(o0, o1); o.y = pk_bf16(o2, o3);
            *(u32x2*)(MIX + (size_t)tok * 2048 + 512 + co) = o; }
    }
    for (int tok = F.bid * 8 + F.wave; tok < ntok; tok += F.G * 8) {
        const int c0 = F.lane * 8;
        float ys[8], z[8], gw[8];
        load8f(YS + (size_t)tok * 512 + c0, ys); unpack8(*(const u32x4*)(P + (size_t)tok * PTP + D_Z + c0), z); load8f(W.s_norm + c0, gw);
        float ss = 0.f;
#pragma unroll
        for (int e = 0; e < 8; ++e) { ys[e] *= siluf_(z[e]); ss += ys[e] * ys[e]; }
        ss = wave_sum(ss);
        const float rs = rsqrtf(ss * (1.f / 512.f) + 1e-6f);
#pragma unroll
        for (int e = 0; e < 8; ++e) ys[e] = ys[e] * rs * gw[e];
        *(u32x4*)(MIX + (size_t)tok * 2048 + 1536 + c0) = pack8f(ys);
    }
}

constexpr int RADIX_LOW_BIT = 10;
constexpr int RADIX_STEPS = 14;
__device__ __forceinline__ unsigned ordkey(float x) { const unsigned u = __float_as_uint(x); return (u & 0x80000000u) ? ~u : (u | 0x80000000u); }
template <int CTRL> __device__ __forceinline__ int dpp_i0(int v) { return __builtin_amdgcn_update_dpp(0, v, CTRL, 0xF, 0xF, true); }
__device__ __forceinline__ int rowscan_incl(int x) { x += dpp_i0<0x111>(x); x += dpp_i0<0x112>(x); x += dpp_i0<0x114>(x); x += dpp_i0<0x118>(x); return x; }
__device__ __forceinline__ void phase_scores(const Ctx& F, unsigned char* ws, int layer, int ntok) {
    const bf16_t* Q = (const bf16_t*)(ws + WS_P); const bf16_t* KEYS = (const bf16_t*)(ws + WS_KEYS) + (size_t)layer * 8 * 2 * 128 * 128;
    int* IDS = (int*)(ws + WS_IDS); float* GATES = (float*)(ws + WS_GATES);
    LAS bf16_t* sK = (LAS bf16_t*)F.lds;
    LAS float* sVv = (LAS float*)(F.lds + 2 * 128 * 136 * 2 + F.wave * 5120);
    LAS int* sVi = (LAS int*)(sVv + 512);
    const int ntg = ntok / 128, ntask = 8 * ntg;
    const int l16 = F.lane & 15, g = F.lane >> 4;
    const f32x4 z4 = {0.f, 0.f, 0.f, 0.f};
    int cur_h = -1;
    for (int task = F.bid; task < ntask; task += F.G) {
        const int h = task / ntg, tg = task % ntg;
        if (h != cur_h) { __syncthreads();
#pragma unroll
            for (int q = 0; q < 8; ++q) { const int v = F.tid + 512 * q, row = v >> 4, part = v & 15;
                *(LAS u32x4*)(sK + row * 136 + part * 8) = *(const u32x4*)(KEYS + ((size_t)h * 256 + row) * 128 + part * 8); }
            cur_h = h; __syncthreads(); }
        const int t0 = tg * 128 + F.wave * 16;
#pragma unroll 1
        for (int p = 0; p < 2; ++p) {
            bf16x8 qf[4];
#pragma unroll
            for (int ks = 0; ks < 4; ++ks) qf[ks] = *(const bf16x8*)(Q + (size_t)(t0 + l16) * 2048 + h * 256 + p * 128 + 32 * ks + 8 * g);
            f32x4 acc[8];
#pragma unroll
            for (int kt = 0; kt < 8; ++kt) { f32x4 a = z4;
#pragma unroll
                for (int ks = 0; ks < 4; ++ks) a = __builtin_amdgcn_mfma_f32_16x16x32_bf16(qf[ks], *(const LAS bf16x8*)(sK + (p * 128 + 16 * kt + l16) * 136 + 32 * ks + 8 * g), a, 0, 0, 0);
                acc[kt] = a; }
            float lo0, lo1, lo2, lo3, hi0, hi1, hi2, hi3;
            { float m0 = acc[0][0], m1 = acc[0][1], m2 = acc[0][2], m3 = acc[0][3];
#pragma unroll
              for (int kt = 1; kt < 8; ++kt) { m0 = fmaxf(m0, acc[kt][0]); m1 = fmaxf(m1, acc[kt][1]); m2 = fmaxf(m2, acc[kt][2]); m3 = fmaxf(m3, acc[kt][3]); }
              hi0 = max16(m0); hi1 = max16(m1); hi2 = max16(m2); hi3 = max16(m3);
              lo0 = -max16(-m0); lo1 = -max16(-m1); lo2 = -max16(-m2); lo3 = -max16(-m3); }
#pragma unroll 1
            for (int it = 0; it < RADIX_STEPS; ++it) {
                const float c0 = 0.5f * (lo0 + hi0), c1 = 0.5f * (lo1 + hi1), c2 = 0.5f * (lo2 + hi2), c3 = 0.5f * (lo3 + hi3); int n0 = 0, n1 = 0, n2 = 0, n3 = 0;
#pragma unroll
                for (int kt = 0; kt < 8; ++kt) { n0 += acc[kt][0] >= c0; n1 += acc[kt][1] >= c1; n2 += acc[kt][2] >= c2; n3 += acc[kt][3] >= c3; }
                const bool k0 = sum16((float)n0) >= 16.f, k1 = sum16((float)n1) >= 16.f, k2 = sum16((float)n2) >= 16.f, k3 = sum16((float)n3) >= 16.f;
                lo0 = k0 ? c0 : lo0; hi0 = k0 ? hi0 : c0; lo1 = k1 ? c1 : lo1; hi1 = k1 ? hi1 : c1; lo2 = k2 ? c2 : lo2; hi2 = k2 ? hi2 : c2; lo3 = k3 ? c3 : lo3; hi3 = k3 ? hi3 : c3; }
#pragma unroll
            for (int r = 0; r < 4; ++r) { const float T = r == 0 ? lo0 : (r == 1 ? lo1 : (r == 2 ? lo2 : lo3));
                int cl = 0;
#pragma unroll
                for (int kt = 0; kt < 8; ++kt) cl += acc[kt][r] >= T;
                int rank = rowscan_incl(cl) - cl;
                LAS float* dv = sVv + ((4 * g + r) * 2 + p) * 16; LAS int* di = sVi + ((4 * g + r) * 2 + p) * 16;
#pragma unroll
                for (int kt = 0; kt < 8; ++kt) { const bool sel = acc[kt][r] >= T;
                    if (sel && rank < 16) { dv[rank] = acc[kt][r]; di[rank] = 16 * kt + l16; }
                    rank += sel ? 1 : 0; } }
        }
        asm volatile("" ::: "memory");
#pragma unroll 1
        for (int r = 0; r < 4; ++r) { const int tk = 4 * g + r;
            LAS float* sS = (LAS float*)(sVi + 512);
            LAS int* sI = (LAS int*)(sS + 128);
#pragma unroll
            for (int p = 0; p < 2; ++p) { const float v = sVv[(tk * 2 + p) * 16 + l16]; const int ix = sVi[(tk * 2 + p) * 16 + l16];
                const unsigned key = (ordkey(v) & ~15u) | (unsigned)(15 - l16); int rk = 0;
#pragma unroll
                for (int q = 0; q < 4; ++q) { const f32x4 o = *(const LAS f32x4*)(sVv + (tk * 2 + p) * 16 + 4 * q);
#pragma unroll
                    for (int e = 0; e < 4; ++e) rk += ((ordkey(o[e]) & ~15u) | (unsigned)(15 - (4 * q + e))) > key; }
                sS[(g * 2 + p) * 16 + rk] = v; sI[(g * 2 + p) * 16 + rk] = ix; }
            asm volatile("" ::: "memory");
            float cv[4]; int pi[4], pj[4];
#pragma unroll
            for (int q = 0; q < 4; ++q) { const int e = l16 + 16 * q; int i, j;
                if (e < 16) { i = 0; j = e; } else if (e < 24) { i = 1; j = e - 16; } else if (e < 29) { i = 2; j = e - 24; } else if (e < 33) { i = 3; j = e - 29; }
                else if (e < 36) { i = 4; j = e - 33; } else if (e < 42) { i = 5 + ((e - 36) >> 1); j = (e - 36) & 1; } else { i = 8 + (e - 42); j = 0; }
                const bool ok = e < 50; i = ok ? i : 15; j = ok ? j : 15;
                pi[q] = i; pj[q] = j; cv[q] = ok ? sS[(g * 2) * 16 + i] + sS[(g * 2 + 1) * 16 + j] : -3.0e38f; }
            float lo = sS[(g * 2) * 16 + 15] + sS[(g * 2 + 1) * 16], hi = sS[(g * 2) * 16] + sS[(g * 2 + 1) * 16];
            const float mx = hi;
#pragma unroll 1
            for (int it = 0; it < RADIX_STEPS; ++it) { const float cm = 0.5f * (lo + hi); int n = 0;
#pragma unroll
                for (int q = 0; q < 4; ++q) n += cv[q] >= cm;
                const bool kk = sum16((float)n) >= 16.f; lo = kk ? cm : lo; hi = kk ? hi : cm; }
            int cl = 0; float es = 0.f;
#pragma unroll
            for (int q = 0; q < 4; ++q) { const bool sel = cv[q] >= lo; cl += sel; es += sel ? __expf(cv[q] - mx) : 0.f; }
            int rank = rowscan_incl(cl) - cl;
            const float einv = 1.0f / sum16(es);
            const size_t ob = (size_t)(t0 + tk) * 128 + h * 16;
#pragma unroll
            for (int q = 0; q < 4; ++q) { const bool sel = cv[q] >= lo;
                if (sel && rank < 16) { IDS[ob + rank] = sI[(g * 2) * 16 + pi[q]] * 128 + sI[(g * 2 + 1) * 16 + pj[q]]; GATES[ob + rank] = __expf(cv[q] - mx) * einv; }
                rank += sel ? 1 : 0; }
            asm volatile("" ::: "memory");
        }
        asm volatile("" ::: "memory");
    }
}

struct XInfo { int xi, nx, rank, nloc; };
__device__ __forceinline__ void fp8x16_to_f32(const u32x4 q, float (&f)[16]) {
#pragma unroll
    for (int w = 0; w < 4; ++w) { const auto a = __builtin_amdgcn_cvt_pk_f32_fp8((int)q[w], false); const auto b = __builtin_amdgcn_cvt_pk_f32_fp8((int)q[w], true);
        f[4 * w] = a[0]; f[4 * w + 1] = a[1]; f[4 * w + 2] = b[0]; f[4 * w + 3] = b[1]; }
}
typedef long i64_t;
template <int IDMASK> __device__ __forceinline__ void phase_experts_u(const Ctx& F, unsigned char* ws, int layer, int ntok, const XInfo X, float* PART) {
    const bf16_t* H = (const bf16_t*)(ws + WS_XN); const unsigned char* PU8 = ws + WS_PU + (size_t)layer * 16384 * 2048;
    const int* IDS = (const int*)(ws + WS_IDS);
    const int e8 = F.lane >> 3, c = F.lane & 7, l16 = F.lane & 15, g = F.lane >> 4;
    const int tfirst = X.rank * 8 + F.wave, tstride = X.nloc * 8;
    const int nk = tfirst < ntok ? (ntok - tfirst + tstride - 1) / tstride : 0;
    const f32x4 z4 = {0.f, 0.f, 0.f, 0.f};
    LAS unsigned char* buf = F.lds + F.wave * 12288; LAS float* res = (LAS float*)(buf + 8192);
    const int woff = e8 * 128 + c * 16;
    const int srcoff = 16 * (c ^ e8);
    const int roff0 = l16 * 128 + (((2 * g) ^ (l16 & 7)) * 16), roff1 = l16 * 128 + (((2 * g + 1) ^ (l16 & 7)) * 16);
#define EU_TOK(k) (tfirst + min((k), nk - 1) * tstride)
#define EU_LOADI(I, k) do { const int* ip_ = IDS + (size_t)EU_TOK(k) * 128 + e8; _Pragma("unroll") for (int q_ = 0; q_ < 16; ++q_) I[q_] = ip_[8 * q_]; } while (0)
#define EU_LOADX(HX, k) do { const u32x4* hp_ = (const u32x4*)(H + (size_t)EU_TOK(k) * 2048 + s * 128 + 32 * g); HX[0] = hp_[0]; HX[1] = hp_[1]; HX[2] = hp_[2]; HX[3] = hp_[3]; } while (0)
#define EU_ISSUE(Q, I, hf) do { const unsigned char* sb_ = PU8 + (size_t)s * 16384 * 128; _Pragma("unroll") for (int i_ = 0; i_ < 8; ++i_) Q[i_] = *(const u32x4*)(sb_ + (unsigned)(I[(hf) * 8 + i_] * 128 + srcoff)); } while (0)
#define EU_CONSUME(Q, hf, slot) do { _Pragma("unroll") for (int i_ = 0; i_ < 8; ++i_) *(LAS u32x4*)(buf + i_ * 1024 + woff) = Q[i_]; \
        asm volatile("" ::: "memory"); \
        u32x4 p0_[4], p1_[4]; f32x4 a_[4]; \
        _Pragma("unroll") for (int q_ = 0; q_ < 4; ++q_) { p0_[q_] = *(const LAS u32x4*)(buf + q_ * 2048 + roff0); p1_[q_] = *(const LAS u32x4*)(buf + q_ * 2048 + roff1); a_[q_] = z4; } \
          \
        _Pragma("unroll") for (int q_ = 0; q_ < 4; ++q_) a_[q_] = __builtin_amdgcn_mfma_f32_16x16x32_fp8_fp8(((i64_t)p0_[q_][1] << 32) | (i64_t)p0_[q_][0], hb[0], a_[q_], 0, 0, 0); \
        _Pragma("unroll") for (int q_ = 0; q_ < 4; ++q_) a_[q_] = __builtin_amdgcn_mfma_f32_16x16x32_fp8_fp8(((i64_t)p0_[q_][3] << 32) | (i64_t)p0_[q_][2], hb[1], a_[q_], 0, 0, 0); \
        _Pragma("unroll") for (int q_ = 0; q_ < 4; ++q_) a_[q_] = __builtin_amdgcn_mfma_f32_16x16x32_fp8_fp8(((i64_t)p1_[q_][1] << 32) | (i64_t)p1_[q_][0], hb[2], a_[q_], 0, 0, 0); \
        _Pragma("unroll") for (int q_ = 0; q_ < 4; ++q_) a_[q_] = __builtin_amdgcn_mfma_f32_16x16x32_fp8_fp8(((i64_t)p1_[q_][3] << 32) | (i64_t)p1_[q_][2], hb[3], a_[q_], 0, 0, 0); \
        _Pragma("unroll") for (int q_ = 0; q_ < 4; ++q_) if (l16 == (hf) * 4 + q_) *(LAS f32x4*)(res + (slot) * 128 + 16 * ((hf) * 4 + q_) + 4 * g) = a_[q_]; \
        asm volatile("" ::: "memory"); } while (0)
    for (int s = X.xi; s < 16; s += X.nx) {
        if (nk == 0) continue;
        int id[2][16]; u32x4 hx[2][4]; u32x4 qa[8], qb[8];
        EU_LOADI(id[0], 0); asm volatile("" ::: "memory"); EU_LOADX(hx[0], 0); EU_LOADI(id[1], 1); asm volatile("" ::: "memory");
        EU_ISSUE(qa, id[0], 0); EU_ISSUE(qb, id[0], 1); asm volatile("" ::: "memory");
        for (int k0 = 0; k0 < nk; k0 += 8) {
#pragma unroll
            for (int j = 0; j < 8; ++j) { const int k = k0 + j;
                i64_t hb[4];
#pragma unroll
                for (int m = 0; m < 4; ++m) { const u32x4 v = hx[j & 1][m];
                    int lo = __builtin_amdgcn_cvt_pk_fp8_f32(bflo(v[0]), bfhi(v[0]), 0, false); lo = __builtin_amdgcn_cvt_pk_fp8_f32(bflo(v[1]), bfhi(v[1]), lo, true);
                    int hi = __builtin_amdgcn_cvt_pk_fp8_f32(bflo(v[2]), bfhi(v[2]), 0, false); hi = __builtin_amdgcn_cvt_pk_fp8_f32(bflo(v[3]), bfhi(v[3]), hi, true);
                    hb[m] = ((i64_t)(unsigned)hi << 32) | (i64_t)(unsigned)lo; }
                EU_LOADX(hx[(j + 1) & 1], k + 1);
                EU_LOADI(id[j & 1], k + 2);
                EU_CONSUME(qa, 0, j);
                EU_ISSUE(qa, id[(j + 1) & 1], 0);
                EU_CONSUME(qb, 1, j);
                EU_ISSUE(qb, id[(j + 1) & 1], 1);
            }
            { const int u = F.lane >> 3, jj = F.lane & 7, ku = k0 + u;
              if (ku < nk) { float* dst = PART + ((size_t)s * NTOK + tfirst + ku * tstride) * 128 + 16 * jj;
#pragma unroll
                  for (int w = 0; w < 4; ++w) *(f32x4*)(dst + 4 * w) = *(const LAS f32x4*)(res + u * 128 + 16 * jj + 4 * w); }
              asm volatile("" ::: "memory"); }
        }
    }
#undef EU_TOK
#undef EU_LOADI
#undef EU_LOADX
#undef EU_ISSUE
#undef EU_CONSUME
}
__device__ __forceinline__ void phase_experts_combine(const Ctx& F, unsigned char* ws, int ntok) {
    const float* PART = (const float*)(ws + WS_PART); float* GATES = (float*)(ws + WS_GATES);
    for (int idx = F.bid * 512 + F.tid; idx < ntok * 32; idx += F.G * 512) {
        float4 a = make_float4(0.f, 0.f, 0.f, 0.f);
#pragma unroll
        for (int s = 0; s < 16; ++s) { const float4 v = *(const float4*)(PART + (size_t)s * NTOK * 128 + (size_t)idx * 4); a.x += v.x; a.y += v.y; a.z += v.z; a.w += v.w; }
        float4 g = *(const float4*)(GATES + (size_t)idx * 4);
        g.x *= geluf_(a.x * (1.0f / PEER_U_SCALE)); g.y *= geluf_(a.y * (1.0f / PEER_U_SCALE)); g.z *= geluf_(a.z * (1.0f / PEER_U_SCALE)); g.w *= geluf_(a.w * (1.0f / PEER_U_SCALE));
        *(float4*)(GATES + (size_t)idx * 4) = g;
    }
}
__device__ __forceinline__ void phase_experts_v(const Ctx& F, unsigned char* ws, float* out, float* CTXS, int layer, int ntok, const XInfo X) {
    const unsigned char* PV8 = ws + WS_PV + (size_t)layer * 16384 * 2048;
    const int* IDS = (const int*)(ws + WS_IDS); const float* COEF = (const float*)(ws + WS_GATES); const float* MOD = (const float*)(ws + WS_MOD);
    const int e8 = F.lane >> 3, c = F.lane & 7;
    const int tfirst = X.rank * 8 + F.wave, tstride = X.nloc * 8;
    const int nk = tfirst < ntok ? (ntok - tfirst + tstride - 1) / tstride : 0;
    LAS float* res = (LAS float*)(F.lds + F.wave * 4096);
#define EV_TOK(k) (tfirst + min((k), nk - 1) * tstride)
#define EV_LOADI(I, k) do { I[0] = *((const u32x4*)(IDS + (size_t)EV_TOK(k) * 128 + e8 * 16) + (c & 3)); } while (0)
#define EV_LOADC(C, k) do { C[0] = *((const u32x4*)(COEF + (size_t)EV_TOK(k) * 128 + e8 * 16) + (c & 3)); } while (0)
#define EV_QUAD(V) do { const u32x4 own_ = V[0];   \
        _Pragma("unroll") for (int w_ = 0; w_ < 4; ++w_) { V[0][w_] = (unsigned)__builtin_amdgcn_update_dpp(0, (int)own_[w_], 0x00, 0xF, 0xF, true); V[1][w_] = (unsigned)__builtin_amdgcn_update_dpp(0, (int)own_[w_], 0x55, 0xF, 0xF, true); \
            V[2][w_] = (unsigned)__builtin_amdgcn_update_dpp(0, (int)own_[w_], 0xAA, 0xF, 0xF, true); V[3][w_] = (unsigned)__builtin_amdgcn_update_dpp(0, (int)own_[w_], 0xFF, 0xF, 0xF, true); } } while (0)
#define EV_ROW(id) (*(const u32x4*)(PV8 + (size_t)s * 16384 * 128 + (unsigned)((id) * 128 + c * 16)))
#define EV_ISSUE(Q, I, hf) do { _Pragma("unroll") for (int i_ = 0; i_ < 8; ++i_) Q[i_] = EV_ROW(I[(hf) * 2 + (i_ >> 2)][i_ & 3]); } while (0)
#define EV_HALF(Q, C, hf) do { _Pragma("unroll") for (int i_ = 0; i_ < 8; ++i_) { const float cf_ = __uint_as_float(C[(hf) * 2 + (i_ >> 2)][i_ & 3]); const f32x2_t c2_ = {cf_, cf_}; \
            _Pragma("unroll") for (int w_ = 0; w_ < 4; ++w_) { const f32x2_t lo_ = __builtin_amdgcn_cvt_pk_f32_fp8((int)Q[i_][w_], false), hi_ = __builtin_amdgcn_cvt_pk_f32_fp8((int)Q[i_][w_], true); \
                ac2[2 * w_] = lo_ * c2_ + ac2[2 * w_]; ac2[2 * w_ + 1] = hi_ * c2_ + ac2[2 * w_ + 1]; } } } while (0)
    for (int s = X.xi; s < 16; s += X.nx) {
        if (nk == 0) continue;
        u32x4 id[2][4], cf[2][4]; u32x4 qa[8], qb[8]; float4 fx[4], fm[4]; float* fxr = out;
        EV_LOADI(id[0], 0); asm volatile("" ::: "memory"); EV_LOADC(cf[0], 0); EV_LOADI(id[1], 1); asm volatile("" ::: "memory");
        EV_QUAD(id[0]); EV_ISSUE(qa, id[0], 0); EV_ISSUE(qb, id[0], 1); asm volatile("" ::: "memory");
        for (int k0 = 0; k0 < nk; k0 += 8) {
#pragma unroll
            for (int j = 0; j < 8; ++j) { const int k = k0 + j;
                f32x2_t ac2[8];
#pragma unroll
                for (int e = 0; e < 8; ++e) ac2[e] = (f32x2_t){0.f, 0.f};
                EV_QUAD(cf[j & 1]);
                EV_QUAD(id[(j + 1) & 1]);
                EV_LOADC(cf[(j + 1) & 1], k + 1);
                EV_LOADI(id[j & 1], k + 2);
                if (j == 7) {
                    const int u = F.lane >> 3, jj = F.lane & 7, tu = tfirst + min(k0 + u, nk - 1) * tstride;
                    const bool isctx = tu >= NLAT; const int vv = isctx ? 4 : (tu >> 12);
                    fxr = (isctx ? CTXS + (size_t)(tu - NLAT) * 2048 : out + (size_t)tu * 2048) + s * 128 + jj * 16;
                    const float* m5 = MOD + ((size_t)layer * 5 + vv) * 12288 + 5 * 2048 + s * 128 + jj * 16;
#pragma unroll
                    for (int w = 0; w < 4; ++w) { fx[w] = *(const float4*)(fxr + 4 * w); fm[w] = *(const float4*)(m5 + 4 * w); } }
                EV_HALF(qa, cf[j & 1], 0);
                EV_ISSUE(qa, id[(j + 1) & 1], 0);
                EV_HALF(qb, cf[j & 1], 1);
                EV_ISSUE(qb, id[(j + 1) & 1], 1);
                float acc[16];
#pragma unroll
                for (int e = 0; e < 8; ++e) { acc[2 * e] = ac2[e][0]; acc[2 * e + 1] = ac2[e][1]; }
#pragma unroll
                for (int e = 0; e < 16; ++e) { float v = acc[e]; v += dpp_f<0x128>(v); v += xor16_f(v); acc[e] = sum_x32(v); }
                if (e8 == 0) {
#pragma unroll
                    for (int w = 0; w < 4; ++w) *(LAS f32x4*)(res + j * 128 + c * 16 + 4 * w) = (f32x4){acc[4 * w], acc[4 * w + 1], acc[4 * w + 2], acc[4 * w + 3]}; }
                asm volatile("" ::: "memory");
            }
            { const int u = F.lane >> 3, jj = F.lane & 7, ku = k0 + u;
              if (ku < nk) {
#pragma unroll
                  for (int w = 0; w < 4; ++w) { float4 x = fx[w]; const float4 m = fm[w]; const f32x4 a = *(const LAS f32x4*)(res + u * 128 + jj * 16 + 4 * w);
                      x.x += m.x * a[0]; x.y += m.y * a[1]; x.z += m.z * a[2]; x.w += m.w * a[3]; *(float4*)(fxr + 4 * w) = x; } }
              asm volatile("" ::: "memory"); }
        }
    }
#undef EV_TOK
#undef EV_LOADI
#undef EV_LOADC
#undef EV_QUAD
#undef EV_ROW
#undef EV_ISSUE
#undef EV_HALF
}

struct Params { const float* in[N_IN]; float* out; unsigned char* ws; };

__device__ __forceinline__ LayerW make_w(ka_t in, int l) {
    LayerW W;
    W.sc_w = in[I_SCW] + (size_t)l * 3 * 512; W.rw_w0 = in[I_RW0] + (size_t)l * 2 * 512; W.rw_wup = in[I_RWUP] + (size_t)l * 2 * 64 * 512;
    W.rw_a0 = in[I_RA0] + (size_t)l * 2 * 512; W.rw_aup = in[I_RAUP] + (size_t)l * 2 * 64 * 512; W.rw_gup = in[I_RGUP] + (size_t)l * 128 * 512;
    W.rw_kk = in[I_RKK] + (size_t)l * 512; W.rw_ka = in[I_RKA] + (size_t)l * 512; W.rw_rk = in[I_RRK] + (size_t)l * 512;
    W.rw_lnw = in[I_RLNW] + (size_t)l * 512; W.rw_lnb = in[I_RLNB] + (size_t)l * 512;
    W.na_q = in[I_NAQ] + (size_t)l * 64; W.na_k = in[I_NAK] + (size_t)l * 64; W.rpb = in[I_RPB] + (size_t)l * 8 * 15 * 31;
    W.s_cw = in[I_SCONVW] + (size_t)l * 3 * 1024; W.s_cb = in[I_SCONVB] + (size_t)l * 1024; W.s_dtb = in[I_SDTB] + (size_t)l * 16; W.s_alog = in[I_SALOG] + (size_t)l * 16;
    W.s_d = in[I_SD] + (size_t)l * 8; W.s_norm = in[I_SNORM] + (size_t)l * 512;
    return W;
}

__global__ void __launch_bounds__(512, 2) hybrid_fwd(Params p) {
    extern __shared__ __attribute__((aligned(16))) unsigned char shm[];
    Ctx F; F.lds = (LAS unsigned char*)shm; F.tid = threadIdx.x; F.lane = F.tid & 63; F.wave = __builtin_amdgcn_readfirstlane(F.tid >> 6); F.bid = blockIdx.x; F.G = gridDim.x;
    volatile LAS unsigned* bst = (volatile LAS unsigned*)(F.lds + LDS_BAR_OFF);
    if (F.tid < 4) bst[F.tid] = 0u;
    __syncthreads();
    (void)xcd_barrier_post((unsigned*)(p.ws + WS_CTL), bst);
    volatile LAS int* lxi = (volatile LAS int*)(F.lds + LDS_XI_OFF);
    if (F.tid == 0) lxi[2] = (int)xb_add((unsigned*)(p.ws + WS_CTL) + CTL_TICKET + 64 * xb_xcc_id(), 1u);
#define RPT_PHASE(id, ...) do { __VA_ARGS__ if (RPT == (id)) { GRID_BAR(); PH_BEGIN(); __VA_ARGS__ } } while (0)
#define GRID_BAR() do { ka_t kb_ = (ka_t)__builtin_amdgcn_kernarg_segment_ptr(); asm volatile("" : "+s"(kb_)); unsigned xx_ = xb_xcc_id(); asm volatile("" : "+s"(xx_)); \
        XcdBarrier b_; b_.bar = (unsigned*)((unsigned char*)kb_[N_IN + 1] + WS_CTL); b_.x = xx_; b_.st = (volatile LAS unsigned*)(F.lds + LDS_BAR_OFF); xcd_barrier(b_); } while (0)
    ka_t in; unsigned char* ws; float* out;
#define PH_BEGIN() do { int t_ = threadIdx.x; asm volatile("; PHASE_MARK" : "+v"(t_)); F.tid = t_; F.lane = t_ & 63; F.wave = __builtin_amdgcn_readfirstlane(t_ >> 6); \
        int b_ = blockIdx.x, g_ = gridDim.x; asm volatile("" : "+s"(b_), "+s"(g_)); F.bid = b_; F.G = g_; \
        ka_t k_ = (ka_t)__builtin_amdgcn_kernarg_segment_ptr(); asm volatile("" : "+s"(k_)); in = k_; \
        out = (float*)in[N_IN]; ws = (unsigned char*)in[N_IN + 1]; } while (0)

    PH_BEGIN();
    RPT_PHASE(1, phase_prologue(F, in, ws););
    GRID_BAR();
    if (F.tid == 0) {
        const unsigned* bw = (const unsigned*)(ws + WS_CTL); const unsigned myx = xb_xcc_id(); int xi = 0, nx = 0, nloc = 1;
        for (unsigned j = 0; j < 16; ++j) { const unsigned cnt = xb_ld((unsigned*)&bw[XB_XCNT(j)]); if (cnt > 0u) { if (j < myx) ++xi; ++nx; } if (j == myx) nloc = (int)cnt; }
        lxi[0] = xi; lxi[1] = nx > 0 ? nx : 1; lxi[3] = nloc > 0 ? nloc : 1; }
    __syncthreads();
    PH_BEGIN();
    phase_modreduce(F, in[I_BADA], (const float*)(ws + WS_MODP), (float*)(ws + WS_MOD));
    GRID_BAR();

#pragma unroll 1
    for (int l = 0; l < 2; ++l) {
        const int M = (l == 0) ? NTOK : NLAT;
        if (l == 0) { PH_BEGIN(); phase_norm(F, in[I_X], in[I_CTX], in[I_NMIX], (const float*)(ws + WS_MOD), 0, 1, (bf16_t*)(ws + WS_XN), NTOK); GRID_BAR(); }

        PH_BEGIN();
        RPT_PHASE(2, { pg8::Gemm g{(const bf16_t*)(ws + WS_XN), (const bf16_t*)(ws + WS_WIN) + (size_t)l * PTP * 2048, NTOK, PTP, 2048}; pg8::StaticOrder S; S.init(NTOK, PTP, F.G, F.bid);
          pg8::EpiBf16 E{(bf16_t*)(ws + WS_P), PTP}; pg8::gemm_phase<pg8::EpiBf16, pg8::StaticOrder>(F.lds, g, S, E, F.tid); });
        GRID_BAR();

        PH_BEGIN();
        { const LayerW W = make_w(in, l); phase_prep(F, W, ws);
            if (RPT == 31) phase_prep(F, W, ws);
            const bf16_t* WUPT = (const bf16_t*)(ws + WS_WUPT) + (size_t)l * 4 * 512 * 64;
            for (int rep = 0; rep < (RPT == 32 ? 2 : 1); ++rep) {
            for (int task = F.bid * 8 + F.wave; task < 4 * 8 * RW_NCHUNK; task += F.G * 8) rwkv_pre_task(F, W, ws, WUPT, task, 0);
            for (int task = F.bid * 8 + F.wave; task < 4 * 8 * RW_NCHUNK; task += F.G * 8) rwkv_pre_task(F, W, ws, WUPT, task, 1); } }
        GRID_BAR();

        PH_BEGIN();
        RPT_PHASE(4, { const LayerW W = make_w(in, l); for (int task = F.bid; task < 4 * 8 * NCH; task += F.G) ssd_task<false>(F, W, ws, task); });
        GRID_BAR();
        PH_BEGIN();
        phase_ssd_combine(F, ws);
        GRID_BAR();

        PH_BEGIN();
        { const int ntile = (l == 0) ? 1088 : 1024, nscan = 64 * 2;
          int nfirst, nstride, nend;
          if (F.bid < 64) { rwkv_scan(F, ws, F.bid); nfirst = ntile - nscan + F.bid; nstride = 64; nend = ntile; }
          else { const LayerW W = make_w(in, l); const int blk = F.bid - 64, nblk = F.G - 64;
            for (int task = blk; task < 4 * 8 * NCH; task += nblk) ssd_task<true>(F, W, ws, task);
            nfirst = blk; nstride = nblk; nend = ntile - nscan; }
          PH_BEGIN();
          { const LayerW W = make_w(in, l); na_phase(F, W, ws, nfirst, nstride, nend); } }
        if (RPT == 5) { GRID_BAR(); PH_BEGIN(); const int ntile = (l == 0) ? 1088 : 1024, nscan = 64 * 2; int nfirst, nstride, nend;
          if (F.bid < 64) { rwkv_scan(F, ws, F.bid); nfirst = ntile - nscan + F.bid; nstride = 64; nend = ntile; }
          else { const LayerW W = make_w(in, l); const int blk = F.bid - 64, nblk = F.G - 64;
            for (int task = blk; task < 4 * 8 * NCH; task += nblk) ssd_task<true>(F, W, ws, task);
            nfirst = blk; nstride = nblk; nend = ntile - nscan; }
          PH_BEGIN();
          { const LayerW W = make_w(in, l); na_phase(F, W, ws, nfirst, nstride, nend); } }
        if (RPT == 51) { GRID_BAR(); PH_BEGIN(); if (F.bid < 64) rwkv_scan(F, ws, F.bid); }
        if (RPT == 52) { GRID_BAR(); PH_BEGIN(); if (F.bid >= 64) { const LayerW W = make_w(in, l); const int blk = F.bid - 64, nblk = F.G - 64;
            for (int task = blk; task < 4 * 8 * NCH; task += nblk) ssd_task<true>(F, W, ws, task); } }
        if (RPT == 53) { GRID_BAR(); PH_BEGIN(); if (F.bid >= 64) { const LayerW W = make_w(in, l); const int blk = F.bid - 64, nblk = F.G - 64;
            na_phase(F, W, ws, blk, nblk, (l == 0) ? 1088 : 1024); } }
        GRID_BAR();

        PH_BEGIN();
        RPT_PHASE(6, { const LayerW W = make_w(in, l); phase_finish(F, W, ws, (const bf16_t*)(ws + WS_GUPT) + (size_t)l * 512 * 128, M); });
        GRID_BAR();

        PH_BEGIN();
        { pg8::Gemm g{(const bf16_t*)(ws + WS_MIX), (const bf16_t*)(ws + WS_WOUT) + (size_t)l * 2048 * 2048, M, 2048, 2048}; pg8::StaticOrder S; S.init(M, 2048, F.G, F.bid);
          float* CTXS = (float*)(ws + WS_CTXS);
          pg8::EpiResid E{l == 0 ? in[I_X] : out, l == 0 ? in[I_CTX] : CTXS, out, CTXS, (const float*)(ws + WS_MOD) + (size_t)l * 5 * 12288 + 2 * 2048};
          pg8::gemm_phase<pg8::EpiResid, pg8::StaticOrder>(F.lds, g, S, E, F.tid); }
        if (l == 0 && F.bid >= 32) PEER_CONVERT_LAYER(F, in, ws, 0, F.bid - 32, F.G - 32);
        GRID_BAR();

        PH_BEGIN();
        RPT_PHASE(7, phase_norm(F, out, (const float*)(ws + WS_CTXS), in[I_NFFN] + (size_t)l * 2048, (const float*)(ws + WS_MOD) + (size_t)l * 5 * 12288, 3, 4, (bf16_t*)(ws + WS_XN), M););
        GRID_BAR();
        PH_BEGIN();
        RPT_PHASE(8, { pg8::Gemm g{(const bf16_t*)(ws + WS_XN), (const bf16_t*)(ws + WS_WQ) + (size_t)l * 2048 * 2048, M, 2048, 2048}; pg8::StaticOrder S; S.init(M, 2048, F.G, F.bid);
          pg8::EpiBf16 E{(bf16_t*)(ws + WS_P), 2048}; pg8::gemm_phase<pg8::EpiBf16, pg8::StaticOrder>(F.lds, g, S, E, F.tid); });
        if (l == 0 && F.bid >= 32) PEER_CONVERT_LAYER(F, in, ws, 1, F.bid - 32, F.G - 32);
        GRID_BAR();
        PH_BEGIN();
        RPT_PHASE(9, phase_scores(F, ws, l, M););
        GRID_BAR();
        PH_BEGIN();
        RPT_PHASE(10, { XInfo X; X.xi = lxi[0]; X.nx = lxi[1]; X.rank = lxi[2]; X.nloc = lxi[3]; phase_experts_u<0x3fff>(F, ws, l, M, X, (float*)(ws + WS_PART)); });
        if (RPT == 101) { GRID_BAR(); PH_BEGIN(); XInfo X; X.xi = lxi[0]; X.nx = lxi[1]; X.rank = lxi[2]; X.nloc = lxi[3]; phase_experts_u<0x3ff>(F, ws, l, M, X, (float*)(ws + WS_P)); }
        if (RPT == 102) { GRID_BAR(); PH_BEGIN(); XInfo X; X.xi = lxi[0]; X.nx = lxi[1]; X.rank = lxi[2]; X.nloc = lxi[3]; phase_experts_u<0x3fff>(F, ws, l, M, X, (float*)(ws + WS_P)); }
        GRID_BAR();
        PH_BEGIN();
        phase_experts_combine(F, ws, M);
        GRID_BAR();
        PH_BEGIN();
        if (RPT == 11) { XInfo X; X.xi = lxi[0]; X.nx = lxi[1]; X.rank = lxi[2]; X.nloc = lxi[3]; phase_experts_v(F, ws, (float*)(ws + WS_P), (float*)(ws + WS_P) + (size_t)NLAT * 2048, l, M, X); GRID_BAR(); PH_BEGIN(); }
        { XInfo X; X.xi = lxi[0]; X.nx = lxi[1]; X.rank = lxi[2]; X.nloc = lxi[3]; phase_experts_v(F, ws, out, (float*)(ws + WS_CTXS), l, M, X); }
        if (l == 0) { GRID_BAR(); PH_BEGIN();
            phase_norm(F, out, (const float*)(ws + WS_CTXS), in[I_NMIX] + 2048, (const float*)(ws + WS_MOD) + (size_t)5 * 12288, 0, 1, (bf16_t*)(ws + WS_XN), NTOK); GRID_BAR(); }
    }
}

extern "C" void kernel_launch(void* const* d_in, const int* in_sizes, int n_in, void* d_out, int out_size, void* d_ws, size_t ws_size, hipStream_t stream) {
    static int grid = 0;
    if (grid == 0) {
        if (n_in != N_IN || out_size != NLAT * DM || ws_size < WS_END) { fprintf(stderr, "kernel_launch: unexpected shapes (n_in %d out %d ws %zu, need %zu)\n", n_in, out_size, ws_size, (size_t)WS_END); grid = -1; return; }
        int dev = 0, cus = 0, per_cu = 0;
        (void)hipGetDevice(&dev); (void)hipDeviceGetAttribute(&cus, hipDeviceAttributeMultiprocessorCount, dev);
        if (hipFuncSetAttribute((const void*)hybrid_fwd, hipFuncAttributeMaxDynamicSharedMemorySize, LDS_BYTES) != hipSuccess) { fprintf(stderr, "kernel_launch: hipFuncSetAttribute failed\n"); grid = -1; return; }
        (void)hipOccupancyMaxActiveBlocksPerMultiprocessor(&per_cu, (const void*)hybrid_fwd, 512, LDS_BYTES);
        (void)hipGetLastError();
        fprintf(stderr, "kernel_launch: %d CUs, occupancy query %d block(s)/CU, ws %zu B (need %zu)\n", cus, per_cu, ws_size, (size_t)WS_END);
        grid = cus;
        if (grid < 136) { fprintf(stderr, "kernel_launch: needs at least 136 CUs\n"); grid = -1; return; }
    }
    if (grid < 0) return;
    (void)hipMemsetAsync((char*)d_ws + WS_CTL, 0, 65536, stream);
    Params p{};
    for (int i = 0; i < N_IN; ++i) p.in[i] = (const float*)d_in[i];
    p.out = (float*)d_out; p.ws = (unsigned char*)d_ws;
    hipLaunchKernelGGL(hybrid_fwd, dim3(grid), dim3(512), LDS_BYTES, stream, p);
}
```
